# Optimizing an MI355X kernel written in HIP

```python
import math
import jax, jax.numpy as jnp
from jax import lax
import numpy as np

D_MODEL = 1024
BATCH = 2
SEQ = 8192
DEPTH = 2

N_HEADS_A = 8
HEAD_DIM_A = 64
WIDTH_A = N_HEADS_A * HEAD_DIM_A
MOBA_BLOCK = 256
MOBA_TOPK = 3
MOBA_Q_CHUNK = 64
N_HEADS_B = 8
QK_NOPE_DIM = 64
QK_ROPE_DIM = 32
V_HEAD_DIM = 64
Q_LORA_RANK = 384
KV_LORA_RANK = 256
WIDTH_B = N_HEADS_B * V_HEAD_DIM
ROPE_THETA = 10000.0
MLA_Q_BLOCK = 128
IN_COLS = 3 * WIDTH_A + Q_LORA_RANK + KV_LORA_RANK + QK_ROPE_DIM + 2 * D_MODEL
N_EXPERTS = 256
TOP_K = 8
N_GROUPS = 8
TOPK_GROUPS = 4
D_EXPERT = 256
D_SHARED = 256
ROUTED_SCALE = 2.5
EXPERT_BLOCK = 128
ALPHA = (2 * DEPTH) ** 0.25
BETA = (8 * DEPTH) ** -0.25
LN_EPS = 1e-5
RMS_EPS = 1e-6

kernel_name = 'hybrid_moba_mla_moe_deepnorm'


def layer_norm(x, g, b):
    xf = x.astype(jnp.float32)
    mu = xf.mean(-1, keepdims=True)
    var = jnp.square(xf - mu).mean(-1, keepdims=True)
    return ((xf - mu) * lax.rsqrt(var + LN_EPS)).astype(x.dtype) * g + b


def rms_norm(x, g):
    xf = x.astype(jnp.float32)
    return (xf * lax.rsqrt(jnp.square(xf).mean(-1, keepdims=True) + RMS_EPS)).astype(x.dtype) * g


def rotate(x, cos, sin):
    x1, x2 = jnp.split(x, 2, axis=-1)
    return jnp.concatenate([x1 * cos - x2 * sin, x2 * cos + x1 * sin], axis=-1)


def alibi_slopes(n_heads):
    return jnp.exp2(-8.0 * (jnp.arange(n_heads, dtype=jnp.float32) + 1.0) / n_heads)


def moba_attention(q, k, v):
    b, s, h, dh = q.shape
    s_pad = -(-s // MOBA_BLOCK) * MOBA_BLOCK
    pad = ((0, 0), (0, s_pad - s), (0, 0), (0, 0))
    q, k, v = (jnp.pad(t, pad).transpose(0, 2, 1, 3) for t in (q, k, v))
    n_blk = s_pad // MOBA_BLOCK
    k_blk = k.reshape(b, h, n_blk, MOBA_BLOCK, dh)
    v_blk = v.reshape(b, h, n_blk, MOBA_BLOCK, dh)
    k_mean = k_blk.mean(axis=3)
    n_sel = min(MOBA_TOPK, n_blk)
    slopes = alibi_slopes(h)[None, :, None, None]
    scale = dh ** -0.5
    offs = jnp.arange(MOBA_BLOCK, dtype=jnp.int32)
    gather = jax.vmap(jax.vmap(lambda blocks, idx: blocks[idx]))

    def chunk(c):
        q0 = c * MOBA_Q_CHUNK
        qc = lax.dynamic_slice_in_dim(q, q0, MOBA_Q_CHUNK, axis=2)
        tq = q0 + jnp.arange(MOBA_Q_CHUNK, dtype=jnp.int32)
        own = q0 // MOBA_BLOCK
        gate = jnp.einsum('bhqd,bhnd->bhqn', qc, k_mean).astype(jnp.float32)
        gate = jnp.where(jnp.arange(n_blk) < own, gate, -jnp.inf)
        _, idx = lax.top_k(gate, n_sel)
        valid = jnp.arange(n_sel) < own
        k_sel = gather(k_blk, idx)
        v_sel = gather(v_blk, idx)
        kpos_sel = idx[..., None] * MOBA_BLOCK + offs
        s_sel = jnp.einsum('bhqd,bhqrkd->bhqrk', qc, k_sel).astype(jnp.float32) * scale
        s_sel = s_sel - slopes[..., None] * (tq[:, None, None] - kpos_sel).astype(jnp.float32)
        s_sel = jnp.where(valid[:, None], s_sel, -jnp.inf)
        k_own = lax.dynamic_index_in_dim(k_blk, own, axis=2, keepdims=False)
        v_own = lax.dynamic_index_in_dim(v_blk, own, axis=2, keepdims=False)
        kpos_own = own * MOBA_BLOCK + offs
        s_own = jnp.einsum('bhqd,bhkd->bhqk', qc, k_own).astype(jnp.float32) * scale
        s_own = s_own - slopes * (tq[:, None] - kpos_own[None, :]).astype(jnp.float32)
        s_own = jnp.where(kpos_own[None, :] <= tq[:, None], s_own, -jnp.inf)
        scores = jnp.concatenate([s_sel.reshape(b, h, MOBA_Q_CHUNK, n_sel * MOBA_BLOCK), s_own], axis=-1)
        p = jax.nn.softmax(scores, axis=-1).astype(v.dtype)
        p_sel = p[..., :n_sel * MOBA_BLOCK].reshape(b, h, MOBA_Q_CHUNK, n_sel, MOBA_BLOCK)
        p_own = p[..., n_sel * MOBA_BLOCK:]
        return (jnp.einsum('bhqrk,bhqrkd->bhqd', p_sel, v_sel)
                + jnp.einsum('bhqk,bhkd->bhqd', p_own, v_own))

    out = lax.map(chunk, jnp.arange(s_pad // MOBA_Q_CHUNK, dtype=jnp.int32))
    out = out.transpose(1, 0, 3, 2, 4).reshape(b, s_pad, h, dh)[:, :s]
    return out.reshape(b, s, h * dh)


def mla_attention(q_nope, q_rope, k_nope, k_rope, v):
    b, s, h, _ = q_nope.shape
    scale = (QK_NOPE_DIM + QK_ROPE_DIM) ** -0.5
    kpos = jnp.arange(s, dtype=jnp.int32)

    def block(c):
        q0 = c * MLA_Q_BLOCK
        qn = lax.dynamic_slice_in_dim(q_nope, q0, MLA_Q_BLOCK, axis=1)
        qr = lax.dynamic_slice_in_dim(q_rope, q0, MLA_Q_BLOCK, axis=1)
        tq = q0 + jnp.arange(MLA_Q_BLOCK, dtype=jnp.int32)
        sc = (jnp.einsum('bqhd,bkhd->bhqk', qn, k_nope)
              + jnp.einsum('bqhd,bkd->bhqk', qr, k_rope)).astype(jnp.float32) * scale
        sc = jnp.where(kpos[None, :] <= tq[:, None], sc, -jnp.inf)
        p = jax.nn.softmax(sc, axis=-1).astype(v.dtype)
        return jnp.einsum('bhqk,bkhd->bqhd', p, v)

    out = lax.map(block, jnp.arange(s // MLA_Q_BLOCK, dtype=jnp.int32))
    return out.transpose(1, 0, 2, 3, 4).reshape(b, s, h * V_HEAD_DIM)


def token_mixer(x, w_in, b_gate, q_norm, w_uq, kv_norm, w_ukv, w_proj_a, w_proj_b, w_out, cos, sin):
    b, s, _ = x.shape
    proj = x @ w_in
    bounds = [WIDTH_A, 2 * WIDTH_A, 3 * WIDTH_A,
              3 * WIDTH_A + Q_LORA_RANK,
              3 * WIDTH_A + Q_LORA_RANK + KV_LORA_RANK,
              3 * WIDTH_A + Q_LORA_RANK + KV_LORA_RANK + QK_ROPE_DIM,
              3 * WIDTH_A + Q_LORA_RANK + KV_LORA_RANK + QK_ROPE_DIM + D_MODEL]
    qa, ka, va, cq, ckv, kr, ga, gb = jnp.split(proj, bounds, axis=-1)
    heads_a = lambda t: t.reshape(b, s, N_HEADS_A, HEAD_DIM_A)
    o_a = moba_attention(heads_a(qa), heads_a(ka), heads_a(va))
    q = (rms_norm(cq, q_norm) @ w_uq).reshape(b, s, N_HEADS_B, QK_NOPE_DIM + QK_ROPE_DIM)
    q_nope, q_rope = q[..., :QK_NOPE_DIM], q[..., QK_NOPE_DIM:]
    q_rope = rotate(q_rope, cos[None, :, None, :], sin[None, :, None, :])
    kv = (rms_norm(ckv, kv_norm) @ w_ukv).reshape(b, s, N_HEADS_B, QK_NOPE_DIM + V_HEAD_DIM)
    k_nope, v_b = kv[..., :QK_NOPE_DIM], kv[..., QK_NOPE_DIM:]
    k_rope = rotate(kr, cos[None], sin[None])
    o_b = mla_attention(q_nope, q_rope, k_nope, k_rope, v_b)
    merged = (jax.nn.sigmoid(ga + b_gate[0]) * (o_a @ w_proj_a)
              + jax.nn.sigmoid(gb + b_gate[1]) * (o_b @ w_proj_b))
    return merged @ w_out


def moe_ffn(x, w_router, router_bias, w_e_gate, w_e_up, w_e_down, w_s_gate, w_s_up, w_s_down):
    b, s, d = x.shape
    t = b * s
    h = x.reshape(t, d)
    shared = (jax.nn.silu(h @ w_s_gate) * (h @ w_s_up)) @ w_s_down
    scores = jax.nn.sigmoid((h @ w_router).astype(jnp.float32))
    choice = scores + router_bias.astype(jnp.float32)
    grp = choice.reshape(t, N_GROUPS, N_EXPERTS // N_GROUPS)
    grp_score = lax.top_k(grp, 2)[0].sum(-1)
    _, grp_idx = lax.top_k(grp_score, TOPK_GROUPS)
    grp_mask = (grp_idx[..., None] == jnp.arange(N_GROUPS)).any(axis=1)
    expert_mask = jnp.repeat(grp_mask, N_EXPERTS // N_GROUPS, axis=1)
    _, top_idx = lax.top_k(jnp.where(expert_mask, choice, -jnp.inf), TOP_K)
    top_w = jnp.take_along_axis(scores, top_idx, axis=1)
    top_w = top_w / top_w.sum(-1, keepdims=True) * ROUTED_SCALE
    m = t * TOP_K
    flat_e = top_idx.reshape(m).astype(jnp.int32)
    flat_tok = jnp.repeat(jnp.arange(t, dtype=jnp.int32), TOP_K)
    flat_w = top_w.reshape(m).astype(x.dtype)
    order = jnp.argsort(flat_e)
    e_sorted, tok_sorted, w_sorted = flat_e[order], flat_tok[order], flat_w[order]
    counts = jnp.bincount(flat_e, length=N_EXPERTS).astype(jnp.int32)
    starts = jnp.cumsum(counts) - counts
    padded = (counts + EXPERT_BLOCK - 1) // EXPERT_BLOCK * EXPERT_BLOCK
    padded_end = jnp.cumsum(padded)
    padded_start = padded_end - padded
    dest = padded_start[e_sorted] + jnp.arange(m, dtype=jnp.int32) - starts[e_sorted]
    n_blocks = -(-(m + N_EXPERTS * (EXPERT_BLOCK - 1)) // EXPERT_BLOCK)
    n_rows = n_blocks * EXPERT_BLOCK
    row_tok = jnp.full((n_rows,), t, jnp.int32).at[dest].set(tok_sorted)
    row_w = jnp.zeros((n_rows,), x.dtype).at[dest].set(w_sorted)
    block_e = jnp.clip(jnp.searchsorted(padded_end, jnp.arange(n_blocks, dtype=jnp.int32) * EXPERT_BLOCK,
                                        side='right'), 0, N_EXPERTS - 1)
    h_pad = jnp.concatenate([h, jnp.zeros((1, d), h.dtype)], axis=0)

    def expert_block(args):
        tok, wgt, e = args
        xb = h_pad[tok]
        a = jax.nn.silu(xb @ w_e_gate[e]) * (xb @ w_e_up[e])
        return (a @ w_e_down[e]) * wgt[:, None]

    out = lax.map(expert_block, (row_tok.reshape(n_blocks, EXPERT_BLOCK),
                                 row_w.reshape(n_blocks, EXPERT_BLOCK), block_e))
    routed = jax.ops.segment_sum(out.reshape(n_rows, d), row_tok, num_segments=t + 1)[:t]
    return (shared + routed).reshape(b, s, d)


def setup_inputs(seed: int = 0) -> dict:
    key = jax.random.key(seed)
    ks = jax.random.split(key, 24)
    L = DEPTH

    def dense(k, shape, fan_in, scale=1.0):
        return jax.random.normal(k, shape, jnp.float32) * (fan_in ** -0.5) * scale

    def gain(k, shape):
        return 1.0 + 0.05 * jax.random.normal(k, shape, jnp.float32)

    def small(k, shape, scale=0.02):
        return scale * jax.random.normal(k, shape, jnp.float32)

    return {
        'x': jax.random.normal(ks[0], (BATCH, SEQ, D_MODEL), jnp.float32),
        'w_in': dense(ks[1], (L, D_MODEL, IN_COLS), D_MODEL),
        'b_gate': small(ks[2], (L, 2, D_MODEL)),
        'q_norm': gain(ks[3], (L, Q_LORA_RANK)),
        'w_uq': dense(ks[4], (L, Q_LORA_RANK, N_HEADS_B * (QK_NOPE_DIM + QK_ROPE_DIM)), Q_LORA_RANK),
        'kv_norm': gain(ks[5], (L, KV_LORA_RANK)),
        'w_ukv': dense(ks[6], (L, KV_LORA_RANK, N_HEADS_B * (QK_NOPE_DIM + V_HEAD_DIM)), KV_LORA_RANK),
        'w_proj_a': dense(ks[7], (L, WIDTH_A, D_MODEL), WIDTH_A),
        'w_proj_b': dense(ks[8], (L, WIDTH_B, D_MODEL), WIDTH_B),
        'w_out': dense(ks[9], (L, D_MODEL, D_MODEL), D_MODEL, BETA),
        'ln1_g': gain(ks[10], (L, D_MODEL)),
        'ln1_b': small(ks[11], (L, D_MODEL)),
        'w_router': dense(ks[12], (L, D_MODEL, N_EXPERTS), D_MODEL),
        'router_bias': small(ks[13], (L, N_EXPERTS), 0.01),
        'w_e_gate': dense(ks[14], (L, N_EXPERTS, D_MODEL, D_EXPERT), D_MODEL),
        'w_e_up': dense(ks[15], (L, N_EXPERTS, D_MODEL, D_EXPERT), D_MODEL),
        'w_e_down': dense(ks[16], (L, N_EXPERTS, D_EXPERT, D_MODEL), D_EXPERT, BETA),
        'w_s_gate': dense(ks[17], (L, D_MODEL, D_SHARED), D_MODEL),
        'w_s_up': dense(ks[18], (L, D_MODEL, D_SHARED), D_MODEL),
        'w_s_down': dense(ks[19], (L, D_SHARED, D_MODEL), D_SHARED, BETA),
        'ln2_g': gain(ks[20], (L, D_MODEL)),
        'ln2_b': small(ks[21], (L, D_MODEL)),
    }


def reference(x, w_in, b_gate, q_norm, w_uq, kv_norm, w_ukv, w_proj_a, w_proj_b, w_out,
              ln1_g, ln1_b, w_router, router_bias, w_e_gate, w_e_up, w_e_down,
              w_s_gate, w_s_up, w_s_down, ln2_g, ln2_b):
    s = x.shape[1]
    pos = jnp.arange(s, dtype=jnp.float32)
    inv_freq = ROPE_THETA ** (-jnp.arange(0, QK_ROPE_DIM, 2, dtype=jnp.float32) / QK_ROPE_DIM)
    ang = pos[:, None] * inv_freq[None, :]
    cos, sin = jnp.cos(ang).astype(x.dtype), jnp.sin(ang).astype(x.dtype)
    for l in range(DEPTH):
        hmix = token_mixer(x, w_in[l], b_gate[l], q_norm[l], w_uq[l], kv_norm[l], w_ukv[l],
                           w_proj_a[l], w_proj_b[l], w_out[l], cos, sin)
        x = layer_norm(ALPHA * x + hmix, ln1_g[l], ln1_b[l])
        hffn = moe_ffn(x, w_router[l], router_bias[l], w_e_gate[l], w_e_up[l], w_e_down[l],
                       w_s_gate[l], w_s_up[l], w_s_down[l])
        x = layer_norm(ALPHA * x + hffn, ln2_g[l], ln2_b[l])
    return x
```

```cpp
#include <hip/hip_runtime.h>
#include <cstdint>
#include <cstdio>

constexpr int NB = 2, SEQ = 8192, T = NB * SEQ, DM = 1024, DEPTH = 2;
constexpr int HA = 8, WA = 512, BLK = 256, NBLK = SEQ / BLK;
constexpr int HB = 8, DN = 64, DR = 32, DV = 64, QL = 384, KVL = 256;
constexpr int INC = 3 * WA + QL + KVL + DR + 2 * DM;
constexpr int C_QA = 0, C_KA = 512, C_VA = 1024, C_CQ = 1536, C_CKV = 1920, C_KR = 2176, C_GA = 2208, C_GB = 3232;
constexpr int NE = 256, TOPK = 8, DE = 256, DSH = 256;
constexpr int NA = T * TOPK;
constexpr float ALPHA = 1.4142135623730951f;
constexpr float LN_EPS = 1e-5f, RMS_EPS = 1e-6f;

namespace ora {
template <class EP>
__global__ void __launch_bounds__(256) sgemm(const float* __restrict__ A, const float* __restrict__ Bm, EP ep, int M, int N, int K, int lda, int ldb, int pad_) {
    __shared__ float As[16][68], Bs[16][68];
    const int tid = threadIdx.x, tx = tid & 15, ty = tid >> 4;
    const int m0 = blockIdx.y * 64, n0 = blockIdx.x * 64;
    float acc[4][4];
#pragma unroll
    for (int i = 0; i < 4; ++i)
#pragma unroll
        for (int j = 0; j < 4; ++j) acc[i][j] = 0.f;
    const int ar = tid >> 2, ak = (tid & 3) * 4;
    const int bk = tid >> 4, bn = (tid & 15) * 4;
    for (int k0 = 0; k0 < K; k0 += 16) {
        const float4 av = *(const float4*)(A + (size_t)(m0 + ar) * lda + k0 + ak);
        float4 bv = make_float4(0.f, 0.f, 0.f, 0.f);
        if (n0 + bn < N) bv = *(const float4*)(Bm + (size_t)(k0 + bk) * ldb + n0 + bn);
        __syncthreads();
        As[ak + 0][ar] = av.x; As[ak + 1][ar] = av.y; As[ak + 2][ar] = av.z; As[ak + 3][ar] = av.w;
        *(float4*)&Bs[bk][bn] = bv;
        __syncthreads();
#pragma unroll
        for (int kk = 0; kk < 16; ++kk) {
            const float4 a = *(const float4*)&As[kk][ty * 4];
            const float4 b = *(const float4*)&Bs[kk][tx * 4];
            const float aa[4] = {a.x, a.y, a.z, a.w}, bb[4] = {b.x, b.y, b.z, b.w};
#pragma unroll
            for (int i = 0; i < 4; ++i)
#pragma unroll
                for (int j = 0; j < 4; ++j) acc[i][j] = fmaf(aa[i], bb[j], acc[i][j]);
        }
    }
#pragma unroll
    for (int i = 0; i < 4; ++i)
#pragma unroll
        for (int j = 0; j < 4; ++j) { const int r = m0 + ty * 4 + i, c = n0 + tx * 4 + j; if (c < N) ep(r, c, acc[i][j]); }
}
struct EpStore { float* C; int ldc; int pad; __device__ void operator()(int r, int c, float v) const { C[(size_t)r * ldc + c] = v; } };
struct EpMerge { const float* proj; const float* bg; const float* pa; float* out;
    __device__ void operator()(int r, int c, float v) const {
        const float ga = proj[(size_t)r * INC + C_GA + c] + bg[c], gb = proj[(size_t)r * INC + C_GB + c] + bg[DM + c];
        const float sa = 1.f / (1.f + expf(-ga)), sb = 1.f / (1.f + expf(-gb));
        out[(size_t)r * DM + c] = sa * pa[(size_t)r * DM + c] + sb * v; } };
struct EpResid { const float* x; float* out; __device__ void operator()(int r, int c, float v) const { out[(size_t)r * DM + c] = ALPHA * x[(size_t)r * DM + c] + v; } };
struct EpSilu { const float* sg; float* out; __device__ void operator()(int r, int c, float v) const { const float g = sg[(size_t)r * DSH + c]; out[(size_t)r * DSH + c] = g / (1.f + expf(-g)) * v; } };

__global__ void __launch_bounds__(256) rowprep(const float* __restrict__ proj, const float* __restrict__ qn, const float* __restrict__ kvn, float* cqn, float* ckvn, float* krr) {
    const int wid = threadIdx.x >> 6, lane = threadIdx.x & 63, row = blockIdx.x * 4 + wid;
    const float* p = proj + (size_t)row * INC;
    float sq = 0.f, sk = 0.f;
    for (int c = lane; c < QL; c += 64) { const float v = p[C_CQ + c]; sq += v * v; }
    for (int c = lane; c < KVL; c += 64) { const float v = p[C_CKV + c]; sk += v * v; }
#pragma unroll
    for (int o = 32; o; o >>= 1) { sq += __shfl_xor(sq, o); sk += __shfl_xor(sk, o); }
    const float rq = rsqrtf(sq / QL + RMS_EPS), rk = rsqrtf(sk / KVL + RMS_EPS);
    for (int c = lane; c < QL; c += 64) cqn[(size_t)row * QL + c] = p[C_CQ + c] * rq * qn[c];
    for (int c = lane; c < KVL; c += 64) ckvn[(size_t)row * KVL + c] = p[C_CKV + c] * rk * kvn[c];
    if (lane < 16) {
        const int pos = row % SEQ;
        const float inv = powf(10000.f, -(float)(2 * lane) / 32.f), ang = (float)pos * inv, cs = cosf(ang), sn = sinf(ang);
        const float x1 = p[C_KR + lane], x2 = p[C_KR + 16 + lane];
        krr[(size_t)row * DR + lane] = x1 * cs - x2 * sn; krr[(size_t)row * DR + 16 + lane] = x2 * cs + x1 * sn;
    }
}
__global__ void __launch_bounds__(256) qrope(float* q) {
    const int idx = blockIdx.x * 256 + threadIdx.x;
    const int i = idx & 15, h = (idx >> 4) & 7, row = idx >> 7, pos = row % SEQ;
    const float inv = powf(10000.f, -(float)(2 * i) / 32.f), ang = (float)pos * inv, cs = cosf(ang), sn = sinf(ang);
    float* p = q + (size_t)row * 768 + h * 96 + 64;
    const float x1 = p[i], x2 = p[16 + i];
    p[i] = x1 * cs - x2 * sn; p[16 + i] = x2 * cs + x1 * sn;
}
__global__ void __launch_bounds__(64) kmean(const float* __restrict__ proj, float* km) {
    const int blk = blockIdx.x, h = blockIdx.y, b = blockIdx.z, c = threadIdx.x;
    float s = 0.f;
    for (int i = 0; i < BLK; ++i) s += proj[(size_t)(b * SEQ + blk * BLK + i) * INC + C_KA + h * 64 + c];
    km[((size_t)(b * HA + h) * NBLK + blk) * 64 + c] = s * (1.f / BLK);
}
__global__ void __launch_bounds__(256) mobasel(const float* __restrict__ proj, const float* __restrict__ km, unsigned* sel) {
    const int idx = blockIdx.x * 256 + threadIdx.x;
    const int h = idx & 7, row = idx >> 3, b = row / SEQ, pos = row % SEQ, own = pos / BLK;
    const float* qp = proj + (size_t)row * INC + C_QA + h * 64;
    float v1 = -INFINITY, v2 = -INFINITY, v3 = -INFINITY; int i1 = -1, i2 = -1, i3 = -1;
    for (int j = 0; j < own; ++j) {
        const float* kp = km + ((size_t)(b * HA + h) * NBLK + j) * 64;
        float g = 0.f;
        for (int c = 0; c < 64; ++c) g = fmaf(qp[c], kp[c], g);
        if (g > v1) { v3 = v2; i3 = i2; v2 = v1; i2 = i1; v1 = g; i1 = j; }
        else if (g > v2) { v3 = v2; i3 = i2; v2 = g; i2 = j; }
        else if (g > v3) { v3 = g; i3 = j; }
    }
    unsigned m = 0;
    if (i1 >= 0) m |= 1u << i1; if (i2 >= 0) m |= 1u << i2; if (i3 >= 0) m |= 1u << i3;
    sel[idx] = m;
}
template <bool MOBA>
__global__ void __launch_bounds__(256) attn(const float* __restrict__ Qb, const float* __restrict__ KVb, const float* __restrict__ KRb, const unsigned* __restrict__ sel, float* O) {
    constexpr int DQK = MOBA ? 64 : 96;
    __shared__ float Qs[64][DQK + 1], Ks[32][DQK + 1], Vs[32][65], Ps[64][33];
    const int qb = blockIdx.x, h = blockIdx.y, b = blockIdx.z, tid = threadIdx.x, qi = tid >> 2, sub = tid & 3;
    const size_t row0 = (size_t)b * SEQ + (size_t)qb * 64;
    for (int idx = tid; idx < 64 * DQK; idx += 256) { const int r = idx / DQK, c = idx % DQK;
        Qs[r][c] = MOBA ? Qb[(row0 + r) * INC + C_QA + h * 64 + c] : Qb[(row0 + r) * 768 + h * 96 + c]; }
    const int tq = qb * 64 + qi, own = tq / BLK;
    const unsigned mask = MOBA ? sel[(row0 + qi) * 8 + h] : 0u;
    const float slope = exp2f(-(float)(h + 1)), scale = MOBA ? 0.125f : 0.10206207261596577f;
    float m = -1e30f, l = 0.f, o[16];
#pragma unroll
    for (int d = 0; d < 16; ++d) o[d] = 0.f;
    const int nkt = (qb * 64 + 64) / 32;
    for (int kt = 0; kt < nkt; ++kt) {
        __syncthreads();
        for (int idx = tid; idx < 32 * DQK; idx += 256) { const int r = idx / DQK, c = idx % DQK; const size_t kr = (size_t)b * SEQ + kt * 32 + r;
            Ks[r][c] = MOBA ? KVb[kr * INC + C_KA + h * 64 + c] : (c < 64 ? KVb[kr * 1024 + h * 128 + c] : KRb[kr * DR + c - 64]); }
        for (int idx = tid; idx < 32 * 64; idx += 256) { const int r = idx >> 6, c = idx & 63; const size_t kr = (size_t)b * SEQ + kt * 32 + r;
            Vs[r][c] = MOBA ? KVb[kr * INC + C_VA + h * 64 + c] : KVb[kr * 1024 + h * 128 + 64 + c]; }
        __syncthreads();
        float s[8]; float rmax = -1e30f;
#pragma unroll
        for (int j = 0; j < 8; ++j) {
            const int kk = sub + 4 * j, kpos = kt * 32 + kk;
            float dot = 0.f;
            for (int c = 0; c < DQK; ++c) dot = fmaf(Qs[qi][c], Ks[kk][c], dot);
            float sc = dot * scale; bool ok;
            if (MOBA) { sc -= slope * (float)(tq - kpos); const int kb = kpos / BLK; ok = (kb == own) ? (kpos <= tq) : (((mask >> kb) & 1u) != 0u); }
            else ok = kpos <= tq;
            s[j] = ok ? sc : -1e30f; rmax = fmaxf(rmax, s[j]);
        }
        rmax = fmaxf(rmax, __shfl_xor(rmax, 1)); rmax = fmaxf(rmax, __shfl_xor(rmax, 2));
        const float mn = fmaxf(m, rmax), alpha = expf(m - mn);
        float psum = 0.f;
#pragma unroll
        for (int j = 0; j < 8; ++j) { const float p = (s[j] > -1e29f) ? expf(s[j] - mn) : 0.f; Ps[qi][sub + 4 * j] = p; psum += p; }
        psum += __shfl_xor(psum, 1); psum += __shfl_xor(psum, 2);
        l = l * alpha + psum; m = mn;
        __syncthreads();
#pragma unroll
        for (int d = 0; d < 16; ++d) o[d] *= alpha;
        for (int kk = 0; kk < 32; ++kk) { const float p = Ps[qi][kk];
#pragma unroll
            for (int d = 0; d < 16; ++d) o[d] = fmaf(p, Vs[kk][sub * 16 + d], o[d]); }
    }
    const float rl = 1.f / l;
#pragma unroll
    for (int d = 0; d < 16; ++d) O[(row0 + qi) * 512 + h * 64 + sub * 16 + d] = o[d] * rl;
}
template <bool COMB>
__global__ void __launch_bounds__(256) lnorm(const float* __restrict__ in, const float* __restrict__ x1, const float* __restrict__ shared_, const float* __restrict__ Y, const float* __restrict__ g, const float* __restrict__ bt, float* out) {
    __shared__ float red[8];
    const int row = blockIdx.x, tid = threadIdx.x;
    float v[4];
#pragma unroll
    for (int i = 0; i < 4; ++i) { const int c = tid + 256 * i;
        if (COMB) { float a = ALPHA * x1[(size_t)row * DM + c] + shared_[(size_t)row * DM + c];
            for (int k = 0; k < TOPK; ++k) a += Y[((size_t)row * TOPK + k) * DM + c];
            v[i] = a; }
        else v[i] = in[(size_t)row * DM + c]; }
    float s = v[0] + v[1] + v[2] + v[3];
#pragma unroll
    for (int o = 32; o; o >>= 1) s += __shfl_xor(s, o);
    if ((tid & 63) == 0) red[tid >> 6] = s;
    __syncthreads();
    const float mu = (red[0] + red[1] + red[2] + red[3]) * (1.f / DM);
    float q = 0.f;
#pragma unroll
    for (int i = 0; i < 4; ++i) { const float d = v[i] - mu; q += d * d; }
#pragma unroll
    for (int o = 32; o; o >>= 1) q += __shfl_xor(q, o);
    if ((tid & 63) == 0) red[4 + (tid >> 6)] = q;
    __syncthreads();
    const float rs = rsqrtf((red[4] + red[5] + red[6] + red[7]) * (1.f / DM) + LN_EPS);
#pragma unroll
    for (int i = 0; i < 4; ++i) { const int c = tid + 256 * i; out[(size_t)row * DM + c] = (v[i] - mu) * rs * g[c] + bt[c]; }
}
__global__ void __launch_bounds__(256) route(const float* __restrict__ logits, const float* __restrict__ rbias, int* tope, float* topw, int* apos, unsigned* cnt) {
    const int wid = threadIdx.x >> 6, lane = threadIdx.x & 63, t = blockIdx.x * 4 + wid;
    const float4 lg = *(const float4*)(logits + (size_t)t * NE + lane * 4), rb = *(const float4*)(rbias + lane * 4);
    float s0 = 1.f / (1.f + expf(-lg.x)), s1 = 1.f / (1.f + expf(-lg.y)), s2 = 1.f / (1.f + expf(-lg.z)), s3 = 1.f / (1.f + expf(-lg.w));
    float c0 = s0 + rb.x, c1 = s1 + rb.y, c2 = s2 + rb.z, c3 = s3 + rb.w;
    float a = fmaxf(c0, c1), bq = fminf(c0, c1);
    { const float hi2 = fmaxf(c2, c3), lo2 = fminf(c2, c3); const float na = fmaxf(a, hi2); const float nb = fmaxf(fminf(a, hi2), fmaxf(bq, lo2)); a = na; bq = nb; }
#pragma unroll
    for (int o = 1; o < 8; o <<= 1) { const float oa = __shfl_xor(a, o), ob = __shfl_xor(bq, o); const float na = fmaxf(a, oa), nb = fmaxf(fminf(a, oa), fmaxf(bq, ob)); a = na; bq = nb; }
    const float gs = a + bq; const int grp = lane >> 3;
    int rank = 0;
#pragma unroll
    for (int j = 0; j < 8; ++j) { const float og = __shfl(gs, j * 8); rank += (og > gs || (og == gs && j < grp)) ? 1 : 0; }
    const bool gsel = rank < 4;
    if (!gsel) { c0 = c1 = c2 = c3 = -INFINITY; }
    float wsum = 0.f, myw = 0.f; int mye = 0;
#pragma unroll
    for (int k = 0; k < TOPK; ++k) {
        float bv = c0; int bi = 0;
        if (c1 > bv) { bv = c1; bi = 1; } if (c2 > bv) { bv = c2; bi = 2; } if (c3 > bv) { bv = c3; bi = 3; }
        int be = lane * 4 + bi;
#pragma unroll
        for (int o = 1; o < 64; o <<= 1) { const float ov = __shfl_xor(bv, o); const int oe = __shfl_xor(be, o); if (ov > bv || (ov == bv && oe < be)) { bv = ov; be = oe; } }
        float sc = 0.f;
        if ((be >> 2) == lane) { const int bi2 = be & 3; sc = bi2 == 0 ? s0 : bi2 == 1 ? s1 : bi2 == 2 ? s2 : s3; if (bi2 == 0) c0 = -INFINITY; else if (bi2 == 1) c1 = -INFINITY; else if (bi2 == 2) c2 = -INFINITY; else c3 = -INFINITY; }
        sc = __shfl(sc, be >> 2);
        wsum += sc;
        if (lane == k) { myw = sc; mye = be; }
    }
    if (lane < TOPK) {
        const int aidx = t * TOPK + lane;
        tope[aidx] = mye; topw[aidx] = myw / wsum * 2.5f;
        apos[aidx] = (int)atomicAdd(&cnt[mye], 1u);
    }
}
template <int TM>
__global__ void __launch_bounds__(256) escan(const unsigned* __restrict__ cnt, int* off, int* toff) {
    __shared__ int sc[256], st[256];
    const int e = threadIdx.x; const int c = (int)cnt[e];
    sc[e] = c; st[e] = (c + TM - 1) / TM;
    __syncthreads();
    if (e == 0) { int a = 0, b = 0; for (int i = 0; i < 256; ++i) { const int ca = sc[i], cb = st[i]; sc[i] = a; st[i] = b; a += ca; b += cb; } off[256] = a; toff[256] = b; }
    __syncthreads();
    off[e] = sc[e]; toff[e] = st[e];
}
__global__ void __launch_bounds__(256) escatter(const int* __restrict__ tope, const int* __restrict__ apos, const int* __restrict__ off, int* rowa) {
    const int a = blockIdx.x * 256 + threadIdx.x;
    rowa[off[tope[a]] + apos[a]] = a;
}
template <int MODE>
__global__ void __launch_bounds__(256) egemm(const float* __restrict__ X, const float* __restrict__ W0, const float* __restrict__ W1, const int* __restrict__ off, const int* __restrict__ toff, const int* __restrict__ rowa,
                                            const float* __restrict__ topw, float* out) {
    __shared__ float As[16][68], Bs[16][68], Cs[16][68];
    __shared__ int se;
    const int tile = blockIdx.y;
    if (tile >= toff[256]) return;
    const int tid = threadIdx.x, tx = tid & 15, ty = tid >> 4;
    if (tid == 0) { int lo = 0, hi = 255; while (lo < hi) { const int mid = (lo + hi + 1) >> 1; if (toff[mid] <= tile) lo = mid; else hi = mid - 1; } se = lo; }
    __syncthreads();
    const int e = se, r0 = off[e] + (tile - toff[e]) * 64, rend = off[e + 1];
    constexpr int K = MODE == 0 ? DM : DE, N = MODE == 0 ? DE : DM;
    const int n0 = blockIdx.x * 64;
    const float* B0 = W0 + (size_t)e * K * N; const float* B1 = MODE == 0 ? W1 + (size_t)e * K * N : nullptr;
    const int ar = tid >> 2, ak = (tid & 3) * 4, bk = tid >> 4, bn = (tid & 15) * 4;
    const int arow = r0 + ar; const bool aval = arow < rend;
    const float* ap = nullptr;
    if (aval) ap = MODE == 0 ? X + (size_t)(rowa[arow] >> 3) * DM : X + (size_t)arow * DE;
    float acc[4][4], acu[4][4];
#pragma unroll
    for (int i = 0; i < 4; ++i)
#pragma unroll
        for (int j = 0; j < 4; ++j) { acc[i][j] = 0.f; acu[i][j] = 0.f; }
    for (int k0 = 0; k0 < K; k0 += 16) {
        float4 av = make_float4(0.f, 0.f, 0.f, 0.f);
        if (aval) av = *(const float4*)(ap + k0 + ak);
        const float4 bv = *(const float4*)(B0 + (size_t)(k0 + bk) * N + n0 + bn);
        float4 cv = make_float4(0.f, 0.f, 0.f, 0.f);
        if (MODE == 0) cv = *(const float4*)(B1 + (size_t)(k0 + bk) * N + n0 + bn);
        __syncthreads();
        As[ak + 0][ar] = av.x; As[ak + 1][ar] = av.y; As[ak + 2][ar] = av.z; As[ak + 3][ar] = av.w;
        *(float4*)&Bs[bk][bn] = bv; if (MODE == 0) *(float4*)&Cs[bk][bn] = cv;
        __syncthreads();
#pragma unroll
        for (int kk = 0; kk < 16; ++kk) {
            const float4 a = *(const float4*)&As[kk][ty * 4];
            const float4 b = *(const float4*)&Bs[kk][tx * 4];
            const float aa[4] = {a.x, a.y, a.z, a.w}, bb[4] = {b.x, b.y, b.z, b.w};
#pragma unroll
            for (int i = 0; i < 4; ++i)
#pragma unroll
                for (int j = 0; j < 4; ++j) acc[i][j] = fmaf(aa[i], bb[j], acc[i][j]);
            if (MODE == 0) { const float4 c = *(const float4*)&Cs[kk][tx * 4]; const float cc[4] = {c.x, c.y, c.z, c.w};
#pragma unroll
                for (int i = 0; i < 4; ++i)
#pragma unroll
                    for (int j = 0; j < 4; ++j) acu[i][j] = fmaf(aa[i], cc[j], acu[i][j]); }
        }
    }
#pragma unroll
    for (int i = 0; i < 4; ++i) { const int r = r0 + ty * 4 + i; if (r < rend) {
        if (MODE == 0) {
#pragma unroll
            for (int j = 0; j < 4; ++j) { const float g = acc[i][j]; out[(size_t)r * DE + n0 + tx * 4 + j] = g / (1.f + expf(-g)) * acu[i][j]; } }
        else { const int a = rowa[r]; const float w = topw[a];
#pragma unroll
            for (int j = 0; j < 4; ++j) out[(size_t)a * DM + n0 + tx * 4 + j] = acc[i][j] * w; } } }
}
}

extern "C" void kernel_launch(void* const* d_in, const int* in_sizes, int n_in, void* d_out, int out_size, void* d_ws, size_t ws_size, hipStream_t stream) {
    using namespace ora;
    const float* x_in = (const float*)d_in[0];
    const float* w_in = (const float*)d_in[1];  const float* b_gate = (const float*)d_in[2]; const float* q_norm = (const float*)d_in[3];
    const float* w_uq = (const float*)d_in[4];  const float* kv_norm = (const float*)d_in[5]; const float* w_ukv = (const float*)d_in[6];
    const float* w_pa = (const float*)d_in[7];  const float* w_pb = (const float*)d_in[8];    const float* w_out = (const float*)d_in[9];
    const float* ln1g = (const float*)d_in[10]; const float* ln1b = (const float*)d_in[11];   const float* w_rt = (const float*)d_in[12];
    const float* rbias = (const float*)d_in[13]; const float* w_eg = (const float*)d_in[14];  const float* w_eu = (const float*)d_in[15];
    const float* w_ed = (const float*)d_in[16]; const float* w_sg = (const float*)d_in[17];   const float* w_su = (const float*)d_in[18];
    const float* w_sd = (const float*)d_in[19]; const float* ln2g = (const float*)d_in[20];   const float* ln2b = (const float*)d_in[21];
    char* ws = (char*)d_ws; size_t o = 0;
    auto carve = [&](size_t bytes) { char* p = ws + o; o += (bytes + 255) & ~(size_t)255; return p; };
    float* proj = (float*)carve((size_t)T * INC * 4);
    float* cqn = (float*)carve((size_t)T * QL * 4);   float* ckvn = (float*)carve((size_t)T * KVL * 4); float* krr = (float*)carve((size_t)T * DR * 4);
    float* qb = (float*)carve((size_t)T * 768 * 4);   float* kvb = (float*)carve((size_t)T * 1024 * 4);
    float* km = (float*)carve((size_t)NB * HA * NBLK * 64 * 4); unsigned* sel = (unsigned*)carve((size_t)T * 8 * 4);
    float* oa = (float*)carve((size_t)T * 512 * 4);   float* ob = (float*)carve((size_t)T * 512 * 4);
    float* pa = (float*)carve((size_t)T * DM * 4);    float* merged = (float*)carve((size_t)T * DM * 4);
    float* pre = (float*)carve((size_t)T * DM * 4);   float* x1 = (float*)carve((size_t)T * DM * 4);   float* x2 = (float*)carve((size_t)T * DM * 4);
    float* logits = (float*)carve((size_t)T * NE * 4); float* sg = (float*)carve((size_t)T * DSH * 4); float* hs = (float*)carve((size_t)T * DSH * 4);
    float* shr = (float*)carve((size_t)T * DM * 4);
    int* tope = (int*)carve((size_t)NA * 4); float* topw = (float*)carve((size_t)NA * 4); int* apos = (int*)carve((size_t)NA * 4); int* rowa = (int*)carve((size_t)NA * 4);
    unsigned* cnt = (unsigned*)carve(256 * 4); int* off = (int*)carve(257 * 4); int* toff = (int*)carve(257 * 4);
    float* he = (float*)carve((size_t)NA * DE * 4);   float* Y = (float*)carve((size_t)NA * DM * 4);
    if (o > ws_size) { fprintf(stderr, "workspace too small: need %zu have %zu\n", o, ws_size); return; }

    const float* xc = x_in;
    for (int l = 0; l < DEPTH; ++l) {
        float* xo = (l == DEPTH - 1) ? (float*)d_out : x2;
        sgemm<<<dim3((INC + 63) / 64, T / 64), 256, 0, stream>>>(xc, w_in + (size_t)l * DM * INC, EpStore{proj, INC, 0}, T, INC, DM, DM, INC, 0);
        rowprep<<<T / 4, 256, 0, stream>>>(proj, q_norm + l * QL, kv_norm + l * KVL, cqn, ckvn, krr);
        sgemm<<<dim3(768 / 64, T / 64), 256, 0, stream>>>(cqn, w_uq + (size_t)l * QL * 768, EpStore{qb, 768, 0}, T, 768, QL, QL, 768, 0);
        sgemm<<<dim3(1024 / 64, T / 64), 256, 0, stream>>>(ckvn, w_ukv + (size_t)l * KVL * 1024, EpStore{kvb, 1024, 0}, T, 1024, KVL, KVL, 1024, 0);
        qrope<<<T * 8 * 16 / 256, 256, 0, stream>>>(qb);
        kmean<<<dim3(NBLK, HA, NB), 64, 0, stream>>>(proj, km);
        mobasel<<<T * 8 / 256, 256, 0, stream>>>(proj, km, sel);
        attn<true><<<dim3(SEQ / 64, HA, NB), 256, 0, stream>>>(proj, proj, nullptr, sel, oa);
        attn<false><<<dim3(SEQ / 64, HB, NB), 256, 0, stream>>>(qb, kvb, krr, nullptr, ob);
        sgemm<<<dim3(DM / 64, T / 64), 256, 0, stream>>>(oa, w_pa + (size_t)l * 512 * DM, EpStore{pa, DM, 0}, T, DM, 512, 512, DM, 0);
        sgemm<<<dim3(DM / 64, T / 64), 256, 0, stream>>>(ob, w_pb + (size_t)l * 512 * DM, EpMerge{proj, b_gate + (size_t)l * 2 * DM, pa, merged}, T, DM, 512, 512, DM, 0);
        sgemm<<<dim3(DM / 64, T / 64), 256, 0, stream>>>(merged, w_out + (size_t)l * DM * DM, EpResid{xc, pre}, T, DM, DM, DM, DM, 0);
        lnorm<false><<<T, 256, 0, stream>>>(pre, nullptr, nullptr, nullptr, ln1g + l * DM, ln1b + l * DM, x1);
        sgemm<<<dim3(NE / 64, T / 64), 256, 0, stream>>>(x1, w_rt + (size_t)l * DM * NE, EpStore{logits, NE, 0}, T, NE, DM, DM, NE, 0);
        sgemm<<<dim3(DSH / 64, T / 64), 256, 0, stream>>>(x1, w_sg + (size_t)l * DM * DSH, EpStore{sg, DSH, 0}, T, DSH, DM, DM, DSH, 0);
        sgemm<<<dim3(DSH / 64, T / 64), 256, 0, stream>>>(x1, w_su + (size_t)l * DM * DSH, EpSilu{sg, hs}, T, DSH, DM, DM, DSH, 0);
        sgemm<<<dim3(DM / 64, T / 64), 256, 0, stream>>>(hs, w_sd + (size_t)l * DSH * DM, EpStore{shr, DM, 0}, T, DM, DSH, DSH, DM, 0);
        (void)hipMemsetAsync(cnt, 0, 256 * 4, stream);
        route<<<T / 4, 256, 0, stream>>>(logits, rbias + l * NE, tope, topw, apos, cnt);
        escan<64><<<1, 256, 0, stream>>>(cnt, off, toff);
        escatter<<<NA / 256, 256, 0, stream>>>(tope, apos, off, rowa);
        egemm<0><<<dim3(DE / 64, NA / 64 + 256), 256, 0, stream>>>(x1, w_eg + (size_t)l * NE * DM * DE, w_eu + (size_t)l * NE * DM * DE, off, toff, rowa, topw, he);
        egemm<1><<<dim3(DM / 64, NA / 64 + 256), 256, 0, stream>>>(he, w_ed + (size_t)l * NE * DE * DM, nullptr, off, toff, rowa, topw, Y);
        lnorm<true><<<T, 256, 0, stream>>>(nullptr, x1, shr, Y, ln2g + l * DM, ln2b + l * DM, xo);
        xc = xo;
    }
}
```

```cpp
#ifndef MK_ONE_LAUNCH
#define MK_ONE_LAUNCH 1
#endif
#include <hip/hip_runtime.h>
#include <cstdint>
#include <cstdio>

constexpr int NB = 2, SEQ = 8192, T = NB * SEQ, DM = 1024, DEPTH = 2;
constexpr int HA = 8, WA = 512, BLK = 256, NBLK = SEQ / BLK;
constexpr int HB = 8, DN = 64, DR = 32, DV = 64, QL = 384, KVL = 256;
constexpr int INC = 3 * WA + QL + KVL + DR + 2 * DM;
constexpr int C_QA = 0, C_KA = 512, C_VA = 1024, C_CQ = 1536, C_CKV = 1920, C_KR = 2176, C_GA = 2208, C_GB = 3232;
constexpr int NE = 256, TOPK = 8, DE = 256, DSH = 256;
constexpr int NA = T * TOPK;
constexpr float ALPHA = 1.4142135623730951f;
constexpr float LN_EPS = 1e-5f, RMS_EPS = 1e-6f;

namespace ora {
template <class EP>
__global__ void __launch_bounds__(256) sgemm(const float* __restrict__ A, const float* __restrict__ Bm, EP ep, int M, int N, int K, int lda, int ldb, int pad_) {
    __shared__ float As[16][68], Bs[16][68];
    const int tid = threadIdx.x, tx = tid & 15, ty = tid >> 4;
    const int m0 = blockIdx.y * 64, n0 = blockIdx.x * 64;
    float acc[4][4];
#pragma unroll
    for (int i = 0; i < 4; ++i)
#pragma unroll
        for (int j = 0; j < 4; ++j) acc[i][j] = 0.f;
    const int ar = tid >> 2, ak = (tid & 3) * 4;
    const int bk = tid >> 4, bn = (tid & 15) * 4;
    for (int k0 = 0; k0 < K; k0 += 16) {
        const float4 av = *(const float4*)(A + (size_t)(m0 + ar) * lda + k0 + ak);
        float4 bv = make_float4(0.f, 0.f, 0.f, 0.f);
        if (n0 + bn < N) bv = *(const float4*)(Bm + (size_t)(k0 + bk) * ldb + n0 + bn);
        __syncthreads();
        As[ak + 0][ar] = av.x; As[ak + 1][ar] = av.y; As[ak + 2][ar] = av.z; As[ak + 3][ar] = av.w;
        *(float4*)&Bs[bk][bn] = bv;
        __syncthreads();
#pragma unroll
        for (int kk = 0; kk < 16; ++kk) {
            const float4 a = *(const float4*)&As[kk][ty * 4];
            const float4 b = *(const float4*)&Bs[kk][tx * 4];
            const float aa[4] = {a.x, a.y, a.z, a.w}, bb[4] = {b.x, b.y, b.z, b.w};
#pragma unroll
            for (int i = 0; i < 4; ++i)
#pragma unroll
                for (int j = 0; j < 4; ++j) acc[i][j] = fmaf(aa[i], bb[j], acc[i][j]);
        }
    }
#pragma unroll
    for (int i = 0; i < 4; ++i)
#pragma unroll
        for (int j = 0; j < 4; ++j) { const int r = m0 + ty * 4 + i, c = n0 + tx * 4 + j; if (c < N) ep(r, c, acc[i][j]); }
}
struct EpStore { float* C; int ldc; int pad; __device__ void operator()(int r, int c, float v) const { C[(size_t)r * ldc + c] = v; } };
struct EpMerge { const float* proj; const float* bg; const float* pa; float* out; int pre; int pad;
    __device__ void operator()(int r, int c, float v) const {
        const float ga = proj[(size_t)r * INC + C_GA + c] + bg[c], gb = proj[(size_t)r * INC + C_GB + c] + bg[DM + c];
        const float sa = pre ? proj[(size_t)r * INC + C_GA + c] : 1.f / (1.f + expf(-ga)), sb = pre ? proj[(size_t)r * INC + C_GB + c] : 1.f / (1.f + expf(-gb));
        out[(size_t)r * DM + c] = sa * pa[(size_t)r * DM + c] + sb * v; } };
struct EpResid { const float* x; float* out; __device__ void operator()(int r, int c, float v) const { out[(size_t)r * DM + c] = ALPHA * x[(size_t)r * DM + c] + v; } };
struct EpSilu { const float* sg; float* out; __device__ void operator()(int r, int c, float v) const { const float g = sg[(size_t)r * DSH + c]; out[(size_t)r * DSH + c] = g / (1.f + expf(-g)) * v; } };

__global__ void __launch_bounds__(256) rowprep(const float* __restrict__ proj, const float* __restrict__ qn, const float* __restrict__ kvn, float* cqn, float* ckvn, float* krr) {
    const int wid = threadIdx.x >> 6, lane = threadIdx.x & 63, row = blockIdx.x * 4 + wid;
    const float* p = proj + (size_t)row * INC;
    float sq = 0.f, sk = 0.f;
    for (int c = lane; c < QL; c += 64) { const float v = p[C_CQ + c]; sq += v * v; }
    for (int c = lane; c < KVL; c += 64) { const float v = p[C_CKV + c]; sk += v * v; }
#pragma unroll
    for (int o = 32; o; o >>= 1) { sq += __shfl_xor(sq, o); sk += __shfl_xor(sk, o); }
    const float rq = rsqrtf(sq / QL + RMS_EPS), rk = rsqrtf(sk / KVL + RMS_EPS);
    for (int c = lane; c < QL; c += 64) cqn[(size_t)row * QL + c] = p[C_CQ + c] * rq * qn[c];
    for (int c = lane; c < KVL; c += 64) ckvn[(size_t)row * KVL + c] = p[C_CKV + c] * rk * kvn[c];
    if (lane < 16) {
        const int pos = row % SEQ;
        const float inv = powf(10000.f, -(float)(2 * lane) / 32.f), ang = (float)pos * inv, cs = cosf(ang), sn = sinf(ang);
        const float x1 = p[C_KR + lane], x2 = p[C_KR + 16 + lane];
        krr[(size_t)row * DR + lane] = x1 * cs - x2 * sn; krr[(size_t)row * DR + 16 + lane] = x2 * cs + x1 * sn;
    }
}
__global__ void __launch_bounds__(256) qrope(float* q) {
    const int idx = blockIdx.x * 256 + threadIdx.x;
    const int i = idx & 15, h = (idx >> 4) & 7, row = idx >> 7, pos = row % SEQ;
    const float inv = powf(10000.f, -(float)(2 * i) / 32.f), ang = (float)pos * inv, cs = cosf(ang), sn = sinf(ang);
    float* p = q + (size_t)row * 768 + h * 96 + 64;
    const float x1 = p[i], x2 = p[16 + i];
    p[i] = x1 * cs - x2 * sn; p[16 + i] = x2 * cs + x1 * sn;
}
__global__ void __launch_bounds__(64) kmean(const float* __restrict__ proj, float* km) {
    const int blk = blockIdx.x, h = blockIdx.y, b = blockIdx.z, c = threadIdx.x;
    float s = 0.f;
    for (int i = 0; i < BLK; ++i) s += proj[(size_t)(b * SEQ + blk * BLK + i) * INC + C_KA + h * 64 + c];
    km[((size_t)(b * HA + h) * NBLK + blk) * 64 + c] = s * (1.f / BLK);
}
__global__ void __launch_bounds__(256) mobasel(const float* __restrict__ proj, const float* __restrict__ km, unsigned* sel) {
    const int idx = blockIdx.x * 256 + threadIdx.x;
    const int h = idx & 7, row = idx >> 3, b = row / SEQ, pos = row % SEQ, own = pos / BLK;
    const float* qp = proj + (size_t)row * INC + C_QA + h * 64;
    float v1 = -INFINITY, v2 = -INFINITY, v3 = -INFINITY; int i1 = -1, i2 = -1, i3 = -1;
    for (int j = 0; j < own; ++j) {
        const float* kp = km + ((size_t)(b * HA + h) * NBLK + j) * 64;
        float g = 0.f;
        for (int c = 0; c < 64; ++c) g = fmaf(qp[c], kp[c], g);
        if (g > v1) { v3 = v2; i3 = i2; v2 = v1; i2 = i1; v1 = g; i1 = j; }
        else if (g > v2) { v3 = v2; i3 = i2; v2 = g; i2 = j; }
        else if (g > v3) { v3 = g; i3 = j; }
    }
    unsigned m = 0;
    if (i1 >= 0) m |= 1u << i1; if (i2 >= 0) m |= 1u << i2; if (i3 >= 0) m |= 1u << i3;
    sel[idx] = m;
}
__device__ __forceinline__ float ldbf(const void* p, size_t i) { return __builtin_bit_cast(float, (unsigned)((const unsigned short*)p)[i] << 16); }
template <bool MOBA, bool FAST>
__global__ void __launch_bounds__(256) attn(const float* __restrict__ Qb, const float* __restrict__ KVb, const float* __restrict__ KRb, const unsigned* __restrict__ sel, float* O) {
    constexpr int DQK = MOBA ? 64 : 96;
    __shared__ float Qs[64][DQK + 1], Ks[32][DQK + 1], Vs[32][65], Ps[64][33];
    const int qb = blockIdx.x, h = blockIdx.y, b = blockIdx.z, tid = threadIdx.x, qi = tid >> 2, sub = tid & 3;
    const size_t row0 = (size_t)b * SEQ + (size_t)qb * 64;
    for (int idx = tid; idx < 64 * DQK; idx += 256) { const int r = idx / DQK, c = idx % DQK;
        if (FAST) Qs[r][c] = MOBA ? ldbf(Qb, (row0 + r) * 4352 + C_QA + h * 64 + c) : ldbf(Qb, (row0 + r) * 768 + h * 96 + c);
        else Qs[r][c] = MOBA ? Qb[(row0 + r) * INC + C_QA + h * 64 + c] : Qb[(row0 + r) * 768 + h * 96 + c]; }
    const int tq = qb * 64 + qi, own = tq / BLK;
    const unsigned mask = MOBA ? sel[(row0 + qi) * 8 + h] : 0u;
    const float slope = exp2f(-(float)(h + 1)), scale = FAST ? 0.6931471805599453f : (MOBA ? 0.125f : 0.10206207261596577f);
    float m = -1e30f, l = 0.f, o[16];
#pragma unroll
    for (int d = 0; d < 16; ++d) o[d] = 0.f;
    const int nkt = (qb * 64 + 64) / 32;
    for (int kt = 0; kt < nkt; ++kt) {
        __syncthreads();
        for (int idx = tid; idx < 32 * DQK; idx += 256) { const int r = idx / DQK, c = idx % DQK; const size_t kr = (size_t)b * SEQ + kt * 32 + r;
            if (FAST) Ks[r][c] = MOBA ? ldbf(KVb, kr * 4352 + C_KA + h * 64 + c) : ldbf(KVb, kr * 768 + h * 96 + c);
            else Ks[r][c] = MOBA ? KVb[kr * INC + C_KA + h * 64 + c] : (c < 64 ? KVb[kr * 1024 + h * 128 + c] : KRb[kr * DR + c - 64]); }
        for (int idx = tid; idx < 32 * 64; idx += 256) { const int r = idx >> 6, c = idx & 63; const size_t kr = (size_t)b * SEQ + kt * 32 + r;
            if (FAST) Vs[r][c] = MOBA ? ldbf(KVb, kr * 4352 + C_VA + h * 64 + c) : ldbf(KRb, kr * 512 + h * 64 + c);
            else Vs[r][c] = MOBA ? KVb[kr * INC + C_VA + h * 64 + c] : KVb[kr * 1024 + h * 128 + 64 + c]; }
        __syncthreads();
        float s[8]; float rmax = -1e30f;
#pragma unroll
        for (int j = 0; j < 8; ++j) {
            const int kk = sub + 4 * j, kpos = kt * 32 + kk;
            float dot = 0.f;
            for (int c = 0; c < DQK; ++c) dot = fmaf(Qs[qi][c], Ks[kk][c], dot);
            float sc = dot * scale; bool ok;
            if (MOBA) { sc -= slope * (float)(tq - kpos); const int kb = kpos / BLK; ok = (kb == own) ? (kpos <= tq) : (((mask >> kb) & 1u) != 0u); }
            else ok = kpos <= tq;
            s[j] = ok ? sc : -1e30f; rmax = fmaxf(rmax, s[j]);
        }
        rmax = fmaxf(rmax, __shfl_xor(rmax, 1)); rmax = fmaxf(rmax, __shfl_xor(rmax, 2));
        const float mn = fmaxf(m, rmax), alpha = expf(m - mn);
        float psum = 0.f;
#pragma unroll
        for (int j = 0; j < 8; ++j) { const float p = (s[j] > -1e29f) ? expf(s[j] - mn) : 0.f; Ps[qi][sub + 4 * j] = p; psum += p; }
        psum += __shfl_xor(psum, 1); psum += __shfl_xor(psum, 2);
        l = l * alpha + psum; m = mn;
        __syncthreads();
#pragma unroll
        for (int d = 0; d < 16; ++d) o[d] *= alpha;
        for (int kk = 0; kk < 32; ++kk) { const float p = Ps[qi][kk];
#pragma unroll
            for (int d = 0; d < 16; ++d) o[d] = fmaf(p, Vs[kk][sub * 16 + d], o[d]); }
    }
    const float rl = 1.f / l;
#pragma unroll
    for (int d = 0; d < 16; ++d) O[(row0 + qi) * 512 + h * 64 + sub * 16 + d] = o[d] * rl;
}
template <bool COMB>
__global__ void __launch_bounds__(256) lnorm(const float* __restrict__ in, const float* __restrict__ x1, const float* __restrict__ shared_, const float* __restrict__ Y, const float* __restrict__ g, const float* __restrict__ bt, float* out) {
    __shared__ float red[8];
    const int row = blockIdx.x, tid = threadIdx.x;
    float v[4];
#pragma unroll
    for (int i = 0; i < 4; ++i) { const int c = tid + 256 * i;
        if (COMB) { float a = ALPHA * x1[(size_t)row * DM + c] + shared_[(size_t)row * DM + c];
            for (int k = 0; k < TOPK; ++k) a += Y[((size_t)row * TOPK + k) * DM + c];
            v[i] = a; }
        else v[i] = in[(size_t)row * DM + c]; }
    float s = v[0] + v[1] + v[2] + v[3];
#pragma unroll
    for (int o = 32; o; o >>= 1) s += __shfl_xor(s, o);
    if ((tid & 63) == 0) red[tid >> 6] = s;
    __syncthreads();
    const float mu = (red[0] + red[1] + red[2] + red[3]) * (1.f / DM);
    float q = 0.f;
#pragma unroll
    for (int i = 0; i < 4; ++i) { const float d = v[i] - mu; q += d * d; }
#pragma unroll
    for (int o = 32; o; o >>= 1) q += __shfl_xor(q, o);
    if ((tid & 63) == 0) red[4 + (tid >> 6)] = q;
    __syncthreads();
    const float rs = rsqrtf((red[4] + red[5] + red[6] + red[7]) * (1.f / DM) + LN_EPS);
#pragma unroll
    for (int i = 0; i < 4; ++i) { const int c = tid + 256 * i; out[(size_t)row * DM + c] = (v[i] - mu) * rs * g[c] + bt[c]; }
}
__global__ void __launch_bounds__(256) route(const float* __restrict__ logits, const float* __restrict__ rbias, int* tope, float* topw, int* apos, unsigned* cnt) {
    const int wid = threadIdx.x >> 6, lane = threadIdx.x & 63, t = blockIdx.x * 4 + wid;
    const float4 lg = *(const float4*)(logits + (size_t)t * NE + lane * 4), rb = *(const float4*)(rbias + lane * 4);
    float s0 = 1.f / (1.f + expf(-lg.x)), s1 = 1.f / (1.f + expf(-lg.y)), s2 = 1.f / (1.f + expf(-lg.z)), s3 = 1.f / (1.f + expf(-lg.w));
    float c0 = s0 + rb.x, c1 = s1 + rb.y, c2 = s2 + rb.z, c3 = s3 + rb.w;
    float a = fmaxf(c0, c1), bq = fminf(c0, c1);
    { const float hi2 = fmaxf(c2, c3), lo2 = fminf(c2, c3); const float na = fmaxf(a, hi2); const float nb = fmaxf(fminf(a, hi2), fmaxf(bq, lo2)); a = na; bq = nb; }
#pragma unroll
    for (int o = 1; o < 8; o <<= 1) { const float oa = __shfl_xor(a, o), ob = __shfl_xor(bq, o); const float na = fmaxf(a, oa), nb = fmaxf(fminf(a, oa), fmaxf(bq, ob)); a = na; bq = nb; }
    const float gs = a + bq; const int grp = lane >> 3;
    int rank = 0;
#pragma unroll
    for (int j = 0; j < 8; ++j) { const float og = __shfl(gs, j * 8); rank += (og > gs || (og == gs && j < grp)) ? 1 : 0; }
    const bool gsel = rank < 4;
    if (!gsel) { c0 = c1 = c2 = c3 = -INFINITY; }
    float wsum = 0.f, myw = 0.f; int mye = 0;
#pragma unroll
    for (int k = 0; k < TOPK; ++k) {
        float bv = c0; int bi = 0;
        if (c1 > bv) { bv = c1; bi = 1; } if (c2 > bv) { bv = c2; bi = 2; } if (c3 > bv) { bv = c3; bi = 3; }
        int be = lane * 4 + bi;
#pragma unroll
        for (int o = 1; o < 64; o <<= 1) { const float ov = __shfl_xor(bv, o); const int oe = __shfl_xor(be, o); if (ov > bv || (ov == bv && oe < be)) { bv = ov; be = oe; } }
        float sc = 0.f;
        if ((be >> 2) == lane) { const int bi2 = be & 3; sc = bi2 == 0 ? s0 : bi2 == 1 ? s1 : bi2 == 2 ? s2 : s3; if (bi2 == 0) c0 = -INFINITY; else if (bi2 == 1) c1 = -INFINITY; else if (bi2 == 2) c2 = -INFINITY; else c3 = -INFINITY; }
        sc = __shfl(sc, be >> 2);
        wsum += sc;
        if (lane == k) { myw = sc; mye = be; }
    }
    if (lane < TOPK) {
        const int aidx = t * TOPK + lane;
        tope[aidx] = mye; topw[aidx] = myw / wsum * 2.5f;
        apos[aidx] = (int)atomicAdd(&cnt[mye], 1u);
    }
}
template <int TM>
__global__ void __launch_bounds__(256) escan(const unsigned* __restrict__ cnt, int* off, int* toff) {
    __shared__ int sc[256], st[256];
    const int e = threadIdx.x; const int c = (int)cnt[e];
    sc[e] = c; st[e] = (c + TM - 1) / TM;
    __syncthreads();
    if (e == 0) { int a = 0, b = 0; for (int i = 0; i < 256; ++i) { const int ca = sc[i], cb = st[i]; sc[i] = a; st[i] = b; a += ca; b += cb; } off[256] = a; toff[256] = b; }
    __syncthreads();
    off[e] = sc[e]; toff[e] = st[e];
}
__global__ void __launch_bounds__(256) escatter(const int* __restrict__ tope, const int* __restrict__ apos, const int* __restrict__ off, int* rowa) {
    const int a = blockIdx.x * 256 + threadIdx.x;
    rowa[off[tope[a]] + apos[a]] = a;
}
template <int MODE>
__global__ void __launch_bounds__(256) egemm(const float* __restrict__ X, const float* __restrict__ W0, const float* __restrict__ W1, const int* __restrict__ off, const int* __restrict__ toff, const int* __restrict__ rowa,
                                            const float* __restrict__ topw, float* out) {
    __shared__ float As[16][68], Bs[16][68], Cs[16][68];
    __shared__ int se;
    const int tile = blockIdx.y;
    if (tile >= toff[256]) return;
    const int tid = threadIdx.x, tx = tid & 15, ty = tid >> 4;
    if (tid == 0) { int lo = 0, hi = 255; while (lo < hi) { const int mid = (lo + hi + 1) >> 1; if (toff[mid] <= tile) lo = mid; else hi = mid - 1; } se = lo; }
    __syncthreads();
    const int e = se, r0 = off[e] + (tile - toff[e]) * 64, rend = off[e + 1];
    constexpr int K = MODE == 0 ? DM : DE, N = MODE == 0 ? DE : DM;
    const int n0 = blockIdx.x * 64;
    const float* B0 = W0 + (size_t)e * K * N; const float* B1 = MODE == 0 ? W1 + (size_t)e * K * N : nullptr;
    const int ar = tid >> 2, ak = (tid & 3) * 4, bk = tid >> 4, bn = (tid & 15) * 4;
    const int arow = r0 + ar; const bool aval = arow < rend;
    const float* ap = nullptr;
    if (aval) ap = MODE == 0 ? X + (size_t)(rowa[arow] >> 3) * DM : X + (size_t)arow * DE;
    float acc[4][4], acu[4][4];
#pragma unroll
    for (int i = 0; i < 4; ++i)
#pragma unroll
        for (int j = 0; j < 4; ++j) { acc[i][j] = 0.f; acu[i][j] = 0.f; }
    for (int k0 = 0; k0 < K; k0 += 16) {
        float4 av = make_float4(0.f, 0.f, 0.f, 0.f);
        if (aval) av = *(const float4*)(ap + k0 + ak);
        const float4 bv = *(const float4*)(B0 + (size_t)(k0 + bk) * N + n0 + bn);
        float4 cv = make_float4(0.f, 0.f, 0.f, 0.f);
        if (MODE == 0) cv = *(const float4*)(B1 + (size_t)(k0 + bk) * N + n0 + bn);
        __syncthreads();
        As[ak + 0][ar] = av.x; As[ak + 1][ar] = av.y; As[ak + 2][ar] = av.z; As[ak + 3][ar] = av.w;
        *(float4*)&Bs[bk][bn] = bv; if (MODE == 0) *(float4*)&Cs[bk][bn] = cv;
        __syncthreads();
#pragma unroll
        for (int kk = 0; kk < 16; ++kk) {
            const float4 a = *(const float4*)&As[kk][ty * 4];
            const float4 b = *(const float4*)&Bs[kk][tx * 4];
            const float aa[4] = {a.x, a.y, a.z, a.w}, bb[4] = {b.x, b.y, b.z, b.w};
#pragma unroll
            for (int i = 0; i < 4; ++i)
#pragma unroll
                for (int j = 0; j < 4; ++j) acc[i][j] = fmaf(aa[i], bb[j], acc[i][j]);
            if (MODE == 0) { const float4 c = *(const float4*)&Cs[kk][tx * 4]; const float cc[4] = {c.x, c.y, c.z, c.w};
#pragma unroll
                for (int i = 0; i < 4; ++i)
#pragma unroll
                    for (int j = 0; j < 4; ++j) acu[i][j] = fmaf(aa[i], cc[j], acu[i][j]); }
        }
    }
#pragma unroll
    for (int i = 0; i < 4; ++i) { const int r = r0 + ty * 4 + i; if (r < rend) {
        if (MODE == 0) {
#pragma unroll
            for (int j = 0; j < 4; ++j) { const float g = acc[i][j]; out[(size_t)r * DE + n0 + tx * 4 + j] = g / (1.f + expf(-g)) * acu[i][j]; } }
        else { const int a = rowa[r]; const float w = topw[a];
#pragma unroll
            for (int j = 0; j < 4; ++j) out[(size_t)a * DM + n0 + tx * 4 + j] = acc[i][j] * w; } } }
}
}


namespace fk {
#define LAS __attribute__((address_space(3)))
#define GAS __attribute__((address_space(1)))
typedef unsigned short bf16_t;
typedef short bf16x8 __attribute__((ext_vector_type(8)));
typedef float f32x4 __attribute__((ext_vector_type(4)));
typedef float f32x2 __attribute__((ext_vector_type(2)));
typedef float f32x16 __attribute__((ext_vector_type(16)));
typedef unsigned u32x4 __attribute__((ext_vector_type(4)));
typedef unsigned u32x2 __attribute__((ext_vector_type(2)));
constexpr int NWAVES = 8, NTHR = 512;
constexpr int INCP = 4352;
constexpr float LOG2E = 1.4426950408889634f;
constexpr float QS_A = 0.125f * LOG2E;
constexpr float QS_B = 0.10206207261596577f * LOG2E;
#define LDS_WAIT() asm volatile("s_waitcnt lgkmcnt(0)" ::: "memory")
#define VM_WAIT() asm volatile("s_waitcnt vmcnt(0)" ::: "memory")
__device__ __forceinline__ unsigned f2bf(float f) { unsigned u = __builtin_bit_cast(unsigned, f); return (u + 0x7fffu + ((u >> 16) & 1u)) >> 16; }
__device__ __forceinline__ unsigned pk2(float lo, float hi) { return f2bf(lo) | (f2bf(hi) << 16); }
__device__ __forceinline__ float bf2f(unsigned short b) { return __builtin_bit_cast(float, (unsigned)b << 16); }
__device__ __forceinline__ float bflo(unsigned w) { return __builtin_bit_cast(float, w << 16); }
__device__ __forceinline__ float bfhi(unsigned w) { return __builtin_bit_cast(float, w & 0xffff0000u); }
__device__ __forceinline__ float sigmoidf_(float x) { return 1.f / (1.f + __expf(-x)); }
__device__ __forceinline__ float wave_sum(float v) {
#pragma unroll
    for (int o = 1; o < 64; o <<= 1) v += __shfl_xor(v, o);
    return v;
}

namespace pg8 {
constexpr int BM = 256, BK = 64, HALF = 128, HTB = HALF * BK * 2, STAGE_BYTES = 8 * HTB, NXCD = 8, WGM = 8;
__host__ __device__ __forceinline__ int lds_byte(int r, int c) { const int st = (r >> 4) * 2 + (c >> 5), rr = r & 15, cc = c & 31, ob = rr * 64 + cc * 2; return st * 1024 + (ob ^ (((ob >> 9) & 1) << 5)); }
__host__ __device__ __forceinline__ void stage_rc(int b, int& R, int& C) { const int st = b / 1024, sb = b % 1024, swz = sb ^ (((sb >> 9) & 1) << 5); R = (st >> 1) * 16 + swz / 64; C = (st & 1) * 32 + (swz % 64) / 2; }
__host__ __device__ __forceinline__ int perm32(int rho) { const int n = rho >> 4, i = rho & 15; return 8 * (i >> 2) + 4 * n + (i & 3); }

struct Unit { int pm, pn, e, r0, rend; };
struct Gemm { const bf16_t* A; const bf16_t* Bt; int M, N, K, lda, ldb; };

struct StaticOrder {
    int nM, nN, nwg, G, c;
    __device__ void init(int M, int N, int G_, int c_) { nM = M / BM; nN = N / BM; nwg = nM * nN; G = G_; c = c_; }
    __device__ bool next(int i, Unit& u) const {
        const long L = (long)i * G + c; if (L >= nwg) return false;
        int wgid = (int)L; { const int q = nwg / NXCD, r = nwg % NXCD, xcd = wgid % NXCD, off = wgid / NXCD; wgid = (xcd < r ? xcd * (q + 1) : r * (q + 1) + (xcd - r) * q) + off; }
        const int nig = WGM * nN, gid = wgid / nig, fm = gid * WGM, gsz = (nM - fm) < WGM ? (nM - fm) : WGM;
        u.pm = fm + ((wgid % nig) % gsz); u.pn = (wgid % nig) / gsz; u.e = 0; u.r0 = u.pm * BM; u.rend = u.r0 + BM; return true;
    }
    __device__ __forceinline__ int a_row(const Unit& u, int r) const { return u.pm * BM + r; }
    __device__ __forceinline__ const char* b_ptr(const Gemm& g, const Unit& u) const { return (const char*)g.Bt + (size_t)u.pn * BM * g.ldb * 2; }
};

__device__ __forceinline__ unsigned cvt_pk_bf16(float lo, float hi) { unsigned r; asm volatile("v_cvt_pk_bf16_f32 %0, %1, %2" : "=v"(r) : "v"(lo), "v"(hi)); return r; }

template <class Epi, class Sched, bool ALIGN_EPI>
__device__ __forceinline__ void gemm_phase(LAS unsigned char* lds, const Gemm g, const Sched& S, const Epi& E) {
    int tid_ = threadIdx.x; asm volatile("" : "+v"(tid_));
    const int tid = tid_, wid = __builtin_amdgcn_readfirstlane(tid >> 6), lane = tid & 63, wr = wid >> 2, wc = wid & 3, fr = lane & 15, fq = lane >> 4;
    const int K = g.K, nt = K / BK;
    int RA[2]; unsigned CA[2], voffB[2];
#pragma unroll
    for (int i = 0; i < 2; ++i) { int R, C; stage_rc(tid * 16 + i * 8192, R, C); const int Rb = (R & ~31) + perm32(R & 31);
        RA[i] = R; CA[i] = (unsigned)C * 2u; voffB[i] = (unsigned)(Rb * g.ldb + C) * 2u; }
    const unsigned lda2 = (unsigned)g.lda * 2u;
    const size_t hstepB = (size_t)HALF * g.ldb * 2;
    const unsigned ldsw = (unsigned)wid * 1024u;
    const int aoff = lds_byte(wr * 64 + fr, fq * 8), boff = lds_byte(wc * 32 + fr, fq * 8);
    const char* const Abase = (const char*)g.A;
#define PG8_SA(b, h) (((b) * 2 + (h)) * HTB)
#define PG8_SB(b, h) ((4 + (b) * 2 + (h)) * HTB)
#define PG8_STAGE_B(bufoff, gbase) do { _Pragma("unroll") for (int _i = 0; _i < 2; ++_i) \
        __builtin_amdgcn_global_load_lds((const unsigned*)((const char*)(gbase) + voffB[_i]), (LAS unsigned*)(lds + (bufoff) + ldsw + _i * 8192), 16, 0, 0); } while (0)
#define PG8_STAGE_A(bufoff, V0, V1, kb) do { \
        __builtin_amdgcn_global_load_lds((const unsigned*)((Abase + (kb)) + (V0)), (LAS unsigned*)(lds + (bufoff) + ldsw), 16, 0, 0); \
        __builtin_amdgcn_global_load_lds((const unsigned*)((Abase + (kb)) + (V1)), (LAS unsigned*)(lds + (bufoff) + ldsw + 8192), 16, 0, 0); } while (0)
#define PG8_LDA(dst, b, h) do { _Pragma("unroll") for (int m = 0; m < 4; ++m) _Pragma("unroll") for (int k = 0; k < 2; ++k) dst[m][k] = *(const LAS bf16x8*)(lds + PG8_SA(b, h) + aoff + m * 2048 + k * 1024); } while (0)
#define PG8_LDB(dst, b, h) do { _Pragma("unroll") for (int n = 0; n < 2; ++n) _Pragma("unroll") for (int k = 0; k < 2; ++k) dst[n][k] = *(const LAS bf16x8*)(lds + PG8_SB(b, h) + boff + n * 2048 + k * 1024); } while (0)
#define PG8_MMA(ai, bj, At, Bt) do { __builtin_amdgcn_s_setprio(1); _Pragma("unroll") for (int m = 0; m < 4; ++m) _Pragma("unroll") for (int n = 0; n < 2; ++n) _Pragma("unroll") for (int k = 0; k < 2; ++k) \
        acc[ai][bj][m][n] = __builtin_amdgcn_mfma_f32_16x16x32_bf16(Bt[n][k], At[m][k], acc[ai][bj][m][n], 0, 0, 0); __builtin_amdgcn_s_setprio(0); } while (0)
#define PG8_WAIT_V(n) asm volatile("s_waitcnt vmcnt(" #n ")" ::: "memory")
#define PG8_WAIT_L(n) asm volatile("s_waitcnt lgkmcnt(" #n ")" ::: "memory")
#define PG8_BAR __builtin_amdgcn_s_barrier()
#define PG8_SCHED __builtin_amdgcn_sched_barrier(0)
#define PG8_VOFF(V, U) do { V##00 = (unsigned)S.a_row(U, RA[0]) * lda2 + CA[0]; V##01 = (unsigned)S.a_row(U, RA[1]) * lda2 + CA[1]; \
        V##10 = (unsigned)S.a_row(U, HALF + RA[0]) * lda2 + CA[0]; V##11 = (unsigned)S.a_row(U, HALF + RA[1]) * lda2 + CA[1]; } while (0)
    Unit cur, nxt; int ui = 0;
    if (!S.next(0, cur)) return;
    f32x4 acc[2][2][4][2];
#pragma unroll
    for (int a = 0; a < 2; ++a)
#pragma unroll
        for (int b = 0; b < 2; ++b)
#pragma unroll
            for (int m = 0; m < 4; ++m)
#pragma unroll
                for (int n = 0; n < 2; ++n) acc[a][b][m][n] = (f32x4){0.f, 0.f, 0.f, 0.f};
    bf16x8 At[4][2], B0[2][2], B1[2][2];
    unsigned vc00, vc01, vc10, vc11;
    PG8_VOFF(vc, cur);
    const char* cB = S.b_ptr(g, cur);
    PG8_STAGE_B(PG8_SB(0, 0), cB); PG8_STAGE_B(PG8_SB(0, 1), cB + hstepB); PG8_STAGE_A(PG8_SA(0, 0), vc00, vc01, 0u); PG8_STAGE_A(PG8_SA(0, 1), vc10, vc11, 0u);
    if (wr == 1) PG8_BAR;
    PG8_WAIT_V(2); PG8_BAR;
    PG8_STAGE_B(PG8_SB(1, 0), cB + 128); PG8_STAGE_A(PG8_SA(1, 0), vc00, vc01, 128u); PG8_STAGE_B(PG8_SB(1, 1), cB + hstepB + 128);
    PG8_WAIT_V(6); PG8_BAR;
    for (;;) {
        const bool has_next = S.next(ui + 1, nxt);
        const char* nB = has_next ? S.b_ptr(g, nxt) : cB;
#pragma unroll 1
        for (int t = 0; t < nt; t += 2) {
            const bool last = (t == nt - 2);
            const unsigned kb1 = (unsigned)(t + 1) * 128u;
            unsigned kb2 = (unsigned)(t + 2) * 128u;
            unsigned s00 = vc00, s01 = vc01, s10 = vc10, s11 = vc11;
            const char* b2 = cB + (size_t)kb2;
            if (last) { kb2 = 0u; b2 = nB; if (has_next) { PG8_VOFF(s, nxt); } }
            const unsigned kb3 = kb2 + 128u; const char* b3 = b2 + 128;
            PG8_LDB(B0, 0, 0); PG8_LDB(B1, 0, 1); PG8_SCHED; PG8_LDA(At, 0, 0); PG8_STAGE_A(PG8_SA(1, 1), vc10, vc11, kb1);
            PG8_WAIT_V(8); PG8_WAIT_L(0); PG8_BAR; PG8_MMA(0, 0, At, B0); PG8_MMA(0, 1, At, B1); PG8_BAR; PG8_SCHED;
            PG8_LDA(At, 0, 1); PG8_STAGE_B(PG8_SB(0, 0), b2); PG8_STAGE_B(PG8_SB(0, 1), b2 + hstepB); PG8_STAGE_A(PG8_SA(0, 0), s00, s01, kb2);
            PG8_WAIT_V(8); PG8_WAIT_L(0); PG8_BAR; PG8_MMA(1, 0, At, B0); PG8_MMA(1, 1, At, B1); PG8_BAR; PG8_SCHED;
            PG8_LDB(B0, 1, 0); PG8_LDB(B1, 1, 1); PG8_SCHED; PG8_LDA(At, 1, 0); PG8_STAGE_A(PG8_SA(0, 1), s10, s11, kb2);
            PG8_WAIT_V(8); PG8_WAIT_L(0); PG8_BAR; PG8_MMA(0, 0, At, B0); PG8_MMA(0, 1, At, B1); PG8_BAR; PG8_SCHED;
            PG8_LDA(At, 1, 1); PG8_STAGE_B(PG8_SB(1, 0), b3); PG8_STAGE_B(PG8_SB(1, 1), b3 + hstepB); PG8_STAGE_A(PG8_SA(1, 0), s00, s01, kb3);
            PG8_WAIT_V(8); PG8_WAIT_L(0); PG8_BAR; PG8_MMA(1, 0, At, B0); PG8_MMA(1, 1, At, B1); PG8_BAR; PG8_SCHED;
        }
        if constexpr (ALIGN_EPI) { if (wr == 0) PG8_BAR; }
        E(acc, cur, wr, wc, fr, fq);
        if (!has_next) break;
#pragma unroll
        for (int a = 0; a < 2; ++a)
#pragma unroll
            for (int b = 0; b < 2; ++b)
#pragma unroll
                for (int m = 0; m < 4; ++m)
#pragma unroll
                    for (int n = 0; n < 2; ++n) acc[a][b][m][n] = (f32x4){0.f, 0.f, 0.f, 0.f};
        cur = nxt; cB = nB; PG8_VOFF(vc, cur); ++ui;
        if constexpr (ALIGN_EPI) { if (wr == 1) PG8_BAR; }
    }
    PG8_WAIT_V(0);
    if constexpr (!ALIGN_EPI) { if (wr == 0) PG8_BAR; }
    PG8_BAR;
#undef PG8_SA
#undef PG8_SB
#undef PG8_STAGE_A
#undef PG8_STAGE_B
#undef PG8_LDA
#undef PG8_LDB
#undef PG8_MMA
#undef PG8_WAIT_V
#undef PG8_WAIT_L
#undef PG8_BAR
#undef PG8_SCHED
#undef PG8_VOFF
}
#define PG8_TILE_BEGIN(acc, wr, wc, fr, fq) \
    _Pragma("unroll") for (int ai = 0; ai < 2; ++ai) _Pragma("unroll") for (int m = 0; m < 4; ++m) _Pragma("unroll") for (int bj = 0; bj < 2; ++bj) { \
        const int trow = ai * 128 + wr * 64 + m * 16 + fr, tcol = bj * 128 + wc * 32 + 8 * fq; f32x4 v0 = acc[ai][bj][m][0], v1 = acc[ai][bj][m][1];
#define PG8_TILE_END }
__device__ __forceinline__ u32x4 pack8(f32x4 v0, f32x4 v1) { u32x4 w; w.x = cvt_pk_bf16(v0[0], v0[1]); w.y = cvt_pk_bf16(v0[2], v0[3]); w.z = cvt_pk_bf16(v1[0], v1[1]); w.w = cvt_pk_bf16(v1[2], v1[3]); return w; }
}

#define XB_TMO      128
#define XB_XCNT(j)  (256  + 64 * (j))
#define XB_XSUB(j)  (1280 + 64 * (j))
#define XB_XGEN(j)  (2304 + 64 * (j))
#define XB_TOP      3328
#define XB_TOPGEN   3392
#define XCD_BAR_WORDS 3456
#define XB_SPIN_CAP (1u << 18)

__device__ __forceinline__ unsigned xb_ld(unsigned* p)              { return __hip_atomic_load(p, __ATOMIC_RELAXED, __HIP_MEMORY_SCOPE_AGENT); }
__device__ __forceinline__ unsigned xb_add(unsigned* p, unsigned v) { return __hip_atomic_fetch_add(p, v, __ATOMIC_RELAXED, __HIP_MEMORY_SCOPE_AGENT); }
__device__ __forceinline__ unsigned xb_xcc_id() { return (unsigned)__builtin_amdgcn_s_getreg((3 << 11) | 20) & 0xFu; }
#define XB_SPIN(cond, bar) do { unsigned _sp = 0; while (cond) { __builtin_amdgcn_s_sleep(1); \
    if ((++_sp & 255u) == 0u) { if (xb_ld(&(bar)[XB_TMO])) break; if (_sp > XB_SPIN_CAP) { atomicAdd(&(bar)[XB_TMO], 1u); break; } } } } while (0)

struct XcdBarrier {
    unsigned* bar; unsigned x;
    volatile LAS unsigned* st;
};

__device__ __forceinline__ XcdBarrier xcd_barrier_post(unsigned* bar, volatile LAS unsigned* st) {
    XcdBarrier b; b.bar = bar; b.x = xb_xcc_id(); b.st = st;
    if (threadIdx.x == 0) (void)xb_add(&bar[XB_XCNT(b.x)], 1u);
    return b;
}
__device__ __forceinline__ void xcd_barrier_complete(unsigned* bar, unsigned x, unsigned& nloc, unsigned& nx) {
    const unsigned G = gridDim.x * gridDim.y * gridDim.z;
    unsigned sum, cnt, mine, sp = 0u;
    for (;;) {
        sum = 0u; cnt = 0u; mine = 0u;
#pragma unroll
        for (unsigned j = 0; j < 16; ++j) { const unsigned c = xb_ld(&bar[XB_XCNT(j)]); sum += c; cnt += (c > 0u) ? 1u : 0u; mine = (j == x) ? c : mine; }
        if (sum == G) break;
        __builtin_amdgcn_s_sleep(1);
        if ((++sp & 255u) == 0u) { if (xb_ld(&bar[XB_TMO])) break; if (sp > XB_SPIN_CAP) { atomicAdd(&bar[XB_TMO], 1u); break; } }
    }
    nloc = mine > 0u ? mine : 1u; nx = cnt > 0u ? cnt : 1u;
}

__device__ __forceinline__ void xcd_barrier(const XcdBarrier& b) {
    asm volatile("s_waitcnt vmcnt(0)" ::: "memory");
    __syncthreads();
    if (threadIdx.x == 0) {
        unsigned* bar = b.bar; asm volatile("" : "+s"(bar));
        __builtin_amdgcn_s_waitcnt(0);
        unsigned nloc = b.st[0], nx = b.st[1];
        if (nloc == 0u) { xcd_barrier_complete(bar, b.x, nloc, nx); b.st[0] = nloc; b.st[1] = nx; }
        const unsigned old = xb_add(&bar[XB_XSUB(b.x)], 1u);
        const unsigned gen = old / nloc;
        if (old + 1u == (gen + 1u) * nloc) {
            __builtin_amdgcn_fence(__ATOMIC_RELEASE, "agent");
            asm volatile("s_waitcnt vmcnt(0)" ::: "memory");
            const unsigned og = xb_add(&bar[XB_TOP], 1u);
            const unsigned tg = og / nx;
            if (og + 1u == (tg + 1u) * nx) xb_add(&bar[XB_TOPGEN], 1u);
            else XB_SPIN(xb_ld(&bar[XB_TOPGEN]) == tg, bar);
            __builtin_amdgcn_fence(__ATOMIC_ACQUIRE, "agent");
            xb_add(&bar[XB_XGEN(b.x)], 1u);
            asm volatile("s_waitcnt vmcnt(0)" ::: "memory");
        } else {
            XB_SPIN(xb_ld(&bar[XB_XGEN(b.x)]) == gen, bar);
            __builtin_amdgcn_fence(__ATOMIC_ACQUIRE, "agent");
            asm volatile("s_waitcnt vmcnt(0)" ::: "memory");
        }
    }
    __syncthreads();
}


struct Params {
    const float* in[22]; float* out; unsigned char* ws;
    int ph_lo, ph_hi;
};
constexpr size_t MiB = 1u << 20;
constexpr size_t WS_CTL = 0, CTL_BYTES = 1 * MiB;
constexpr int CW_BAR = 4096;
constexpr int CW_CNT = 16384;
constexpr size_t WS_WIN = 2 * MiB;
constexpr size_t SZ_WIN = (size_t)INCP * DM;
constexpr size_t SZ_WUQ = (size_t)768 * QL, SZ_WUKV = (size_t)1024 * KVL;
constexpr size_t WS_WUQ = WS_WIN + 2 * SZ_WIN * 2;
constexpr size_t WS_WUKV = WS_WUQ + 2 * SZ_WUQ * 2;
constexpr size_t SZ_WP = (size_t)DM * 512, SZ_WOUT = (size_t)DM * DM;
constexpr size_t WS_WPA = WS_WUKV + 2 * SZ_WUKV * 2;
constexpr size_t WS_WPB = WS_WPA + 2 * SZ_WP * 2;
constexpr size_t WS_WOUT = WS_WPB + 2 * SZ_WP * 2;
constexpr size_t SZ_WRT = (size_t)NE * DM, SZ_WSGU = (size_t)512 * DM, SZ_WSD = (size_t)DM * DSH;
constexpr size_t WS_WRT = WS_WOUT + 2 * SZ_WOUT * 2;
constexpr size_t WS_WSGU = WS_WRT + 2 * SZ_WRT * 2;
constexpr size_t WS_WSD = WS_WSGU + 2 * SZ_WSGU * 2;
constexpr size_t WS_CS = WS_WSD + 2 * SZ_WSD * 2;
constexpr size_t WS_KM = WS_CS + (size_t)SEQ * 16 * 8;
constexpr size_t WS_SEL = WS_KM + (size_t)NB * HA * NBLK * 64 * 4;
constexpr size_t WS_XB = WS_SEL + (size_t)T * 8 * 4;
constexpr size_t WS_CQN = WS_XB + (size_t)T * DM * 2;
constexpr size_t WS_CKVN = WS_CQN + (size_t)T * QL * 2;
constexpr size_t WS_QB = WS_CKVN + (size_t)T * KVL * 2;
constexpr size_t WS_KB = WS_QB + (size_t)T * 768 * 2;
constexpr size_t WS_VB = WS_KB + (size_t)T * 768 * 2;
constexpr size_t WS_OAB = WS_VB + (size_t)T * 512 * 2;
constexpr size_t WS_TMP = WS_OAB + (size_t)T * 1024 * 2;
constexpr size_t WS_MRG = WS_TMP + (size_t)T * 1024 * 2;
constexpr size_t WS_PRE = WS_MRG + (size_t)T * 1024 * 2;
constexpr size_t WS_X1 = WS_PRE + (size_t)T * 1024 * 4;
constexpr size_t WS_X1B = WS_X1 + (size_t)T * 1024 * 4;
constexpr size_t WS_X2 = WS_X1B + (size_t)T * 1024 * 2;
constexpr size_t WS_LOG = WS_X2 + (size_t)T * 1024 * 4;
constexpr size_t WS_HS = WS_LOG + (size_t)T * NE * 4;
constexpr size_t WS_SH = WS_HS + (size_t)T * DSH * 2;
constexpr size_t WS_TOPE = WS_SH + (size_t)T * DM * 2;
constexpr size_t WS_TOPW = WS_TOPE + (size_t)NA * 4;
constexpr size_t WS_APOS = WS_TOPW + (size_t)NA * 4;
constexpr size_t WS_ROWA = WS_APOS + (size_t)NA * 4;
constexpr size_t WS_HE = WS_ROWA + (size_t)NA * 4;
constexpr size_t WS_Y = WS_HE + (size_t)NA * DE * 2;
constexpr size_t WS_PROJ = WS_Y + (size_t)NA * DM * 2;
constexpr size_t SZ_WEGU = (size_t)NE * 512 * DM, SZ_WED = (size_t)NE * DM * DE;
constexpr size_t WS_WEGU = WS_PROJ + (size_t)T * INCP * 2;
constexpr size_t WS_WED = WS_WEGU + 2 * SZ_WEGU * 2;
constexpr size_t WS_FAST_END = WS_WED + 2 * SZ_WED * 2;
constexpr size_t WS_NEED = WS_FAST_END;
static_assert(WS_NEED <= (size_t)2040 * MiB, "ws map");

constexpr int LDS_BYTES = 147456;
constexpr int RING_BYTES = 131072, MISC_OFF = RING_BYTES + 1024, TAB_OFF = RING_BYTES + 2048;

struct Frame { LAS unsigned char* lds; int tid, lane, wave, G, vcu; };

template <class RowMap>
__device__ __forceinline__ void transpose_item(const float* W, int K, int N, bf16_t* WT, int ldk, RowMap rm, LAS float* scr, int item, int lane) {
    const int nblk = N / 32, kb = item / nblk, nb = item % nblk, k0 = 64 * kb, n0 = 32 * nb;
#pragma unroll 8
    for (int i = 0; i < 32; ++i) { const int kk = 2 * i + (lane >> 5); scr[kk * 33 + (lane & 31)] = W[(size_t)(k0 + kk) * N + n0 + (lane & 31)]; }
    LDS_WAIT(); asm volatile("" ::: "memory");
    const int c = lane & 7;
#pragma unroll
    for (int j = 0; j < 4; ++j) { const int n = (lane >> 3) + 8 * j; const LAS float* s = scr + (8 * c) * 33 + n;
        u32x4 o; o.x = pk2(s[0 * 33], s[1 * 33]); o.y = pk2(s[2 * 33], s[3 * 33]); o.z = pk2(s[4 * 33], s[5 * 33]); o.w = pk2(s[6 * 33], s[7 * 33]);
        *(u32x4*)(WT + (size_t)rm(n0 + n) * ldk + k0 + 8 * c) = o; }
    LDS_WAIT(); asm volatile("" ::: "memory");
}
struct RowId { __device__ __forceinline__ int operator()(int n) const { return n; } };

struct EpiProj {
    bf16_t* O; const float* bg;
    __device__ __forceinline__ void operator()(const f32x4 (&acc)[2][2][4][2], const pg8::Unit& u, int wr, int wc, int fr, int fq) const {
        PG8_TILE_BEGIN(acc, wr, wc, fr, fq)
            const int row = u.pm * 256 + trow, col = u.pn * 256 + tcol;
            if (col < C_KA) { v0 = v0 * QS_A; v1 = v1 * QS_A; }
            else if (col >= C_GA && col < INC) { const f32x4 b0 = *(const f32x4*)(bg + col - C_GA), b1 = *(const f32x4*)(bg + col - C_GA + 4);
#pragma unroll
                for (int i = 0; i < 4; ++i) { v0[i] = sigmoidf_(v0[i] + b0[i]); v1[i] = sigmoidf_(v1[i] + b1[i]); } }
            *(u32x4*)(O + (size_t)row * INCP + col) = pg8::pack8(v0, v1);
        PG8_TILE_END
    }
};

struct RowQ { __device__ __forceinline__ int operator()(int n) const { const int h = n / 96, d = n % 96; if (d < 64) return n; const int i = d - 64; return h * 96 + 64 + (i < 16 ? 2 * i : 2 * (i - 16) + 1); } };

struct EpiQ {
    bf16_t* O; const f32x2* CS;
    __device__ __forceinline__ void operator()(const f32x4 (&acc)[2][2][4][2], const pg8::Unit& u, int wr, int wc, int fr, int fq) const {
        PG8_TILE_BEGIN(acc, wr, wc, fr, fq)
            const int row = u.pm * 256 + trow, col = u.pn * 256 + tcol, d = col % 96;
            if (d >= 64) { const int pos = row % SEQ, i0 = (d - 64) >> 1; const f32x2* cs = CS + (size_t)pos * 16 + i0;
                const f32x2 c0 = cs[0], c1 = cs[1], c2 = cs[2], c3 = cs[3];
                const f32x4 a = v0, b = v1;
                v0[0] = a[0] * c0[0] - a[1] * c0[1]; v0[1] = a[1] * c0[0] + a[0] * c0[1]; v0[2] = a[2] * c1[0] - a[3] * c1[1]; v0[3] = a[3] * c1[0] + a[2] * c1[1];
                v1[0] = b[0] * c2[0] - b[1] * c2[1]; v1[1] = b[1] * c2[0] + b[0] * c2[1]; v1[2] = b[2] * c3[0] - b[3] * c3[1]; v1[3] = b[3] * c3[0] + b[2] * c3[1]; }
            v0 = v0 * QS_B; v1 = v1 * QS_B;
            *(u32x4*)(O + (size_t)row * 768 + col) = pg8::pack8(v0, v1);
        PG8_TILE_END
    }
};
struct EpiKV {
    bf16_t* KB; bf16_t* VB;
    __device__ __forceinline__ void operator()(const f32x4 (&acc)[2][2][4][2], const pg8::Unit& u, int wr, int wc, int fr, int fq) const {
        PG8_TILE_BEGIN(acc, wr, wc, fr, fq)
            const int row = u.pm * 256 + trow, col = u.pn * 256 + tcol, h = col >> 7, j = col & 127;
            bf16_t* dst = (j < 64) ? KB + (size_t)row * 768 + h * 96 + j : VB + (size_t)row * 512 + h * 64 + (j - 64);
            *(u32x4*)dst = pg8::pack8(v0, v1);
        PG8_TILE_END
    }
};

__device__ __forceinline__ void prep_phase(const Frame& F, const bf16_t* PROJ, const float* qn, const float* kvn, const f32x2* CS, bf16_t* CQN, bf16_t* CKVN, bf16_t* KB, float* KM) {
    int lane_ = F.lane; asm volatile("" : "+v"(lane_));
    const int gw = F.vcu * NWAVES + F.wave, NGW = F.G * NWAVES, lane = lane_;
    for (int row = gw; row < T; row += NGW) {
        const bf16_t* p = PROJ + (size_t)row * INCP;
        u32x4 a = (u32x4){0u, 0u, 0u, 0u}, b = (u32x4){0u, 0u, 0u, 0u};
        if (lane < 48) a = *(const u32x4*)(p + C_CQ + lane * 8);
        if (lane < 32) b = *(const u32x4*)(p + C_CKV + lane * 8);
        float sq = 0.f, sk = 0.f;
#pragma unroll
        for (int i = 0; i < 4; ++i) { const float x = bflo(a[i]), y = bfhi(a[i]), z = bflo(b[i]), w = bfhi(b[i]); sq += x * x + y * y; sk += z * z + w * w; }
        sq = wave_sum(sq); sk = wave_sum(sk);
        const float rq = rsqrtf(sq * (1.f / QL) + RMS_EPS), rk = rsqrtf(sk * (1.f / KVL) + RMS_EPS);
        if (lane < 48) { const f32x4 g0 = *(const f32x4*)(qn + lane * 8), g1 = *(const f32x4*)(qn + lane * 8 + 4); u32x4 o;
            o.x = pk2(bflo(a.x) * rq * g0[0], bfhi(a.x) * rq * g0[1]); o.y = pk2(bflo(a.y) * rq * g0[2], bfhi(a.y) * rq * g0[3]);
            o.z = pk2(bflo(a.z) * rq * g1[0], bfhi(a.z) * rq * g1[1]); o.w = pk2(bflo(a.w) * rq * g1[2], bfhi(a.w) * rq * g1[3]);
            *(u32x4*)(CQN + (size_t)row * QL + lane * 8) = o; }
        if (lane < 32) { const f32x4 g0 = *(const f32x4*)(kvn + lane * 8), g1 = *(const f32x4*)(kvn + lane * 8 + 4); u32x4 o;
            o.x = pk2(bflo(b.x) * rk * g0[0], bfhi(b.x) * rk * g0[1]); o.y = pk2(bflo(b.y) * rk * g0[2], bfhi(b.y) * rk * g0[3]);
            o.z = pk2(bflo(b.z) * rk * g1[0], bfhi(b.z) * rk * g1[1]); o.w = pk2(bflo(b.w) * rk * g1[2], bfhi(b.w) * rk * g1[3]);
            *(u32x4*)(CKVN + (size_t)row * KVL + lane * 8) = o; }
        if (lane < 16) { const float x1 = bf2f(p[C_KR + lane]), x2 = bf2f(p[C_KR + 16 + lane]); const f32x2 cs = CS[(size_t)(row % SEQ) * 16 + lane];
            const unsigned w = pk2(x1 * cs[0] - x2 * cs[1], x2 * cs[0] + x1 * cs[1]);
#pragma unroll
            for (int h = 0; h < 8; ++h) *(unsigned*)(KB + (size_t)row * 768 + h * 96 + 64 + 2 * lane) = w; }
    }
    for (int it = gw; it < NB * NBLK * HA; it += NGW) {
        const int h = it % HA, blk = (it / HA) % NBLK, b = it / (HA * NBLK), c = lane & 7, r0 = lane >> 3;
        const bf16_t* p = PROJ + ((size_t)b * SEQ + (size_t)blk * BLK + r0) * INCP + C_KA + h * 64 + c * 8;
        float s[8];
#pragma unroll
        for (int i = 0; i < 8; ++i) s[i] = 0.f;
        for (int i = 0; i < 32; ++i) { const u32x4 v = *(const u32x4*)(p + (size_t)i * 8 * INCP);
#pragma unroll
            for (int k = 0; k < 4; ++k) { s[2 * k] += bflo(v[k]); s[2 * k + 1] += bfhi(v[k]); } }
#pragma unroll
        for (int i = 0; i < 8; ++i) { s[i] += __shfl_xor(s[i], 8); s[i] += __shfl_xor(s[i], 16); s[i] += __shfl_xor(s[i], 32); }
        if (lane < 8) { float* o = KM + ((size_t)(b * HA + h) * NBLK + blk) * 64 + c * 8;
            *(f32x4*)o = (f32x4){s[0], s[1], s[2], s[3]} * (1.f / BLK); *(f32x4*)(o + 4) = (f32x4){s[4], s[5], s[6], s[7]} * (1.f / BLK); }
    }
}
__device__ __forceinline__ void mobasel_phase(const Frame& F, const bf16_t* PROJ, const float* KM, unsigned* SEL) {
    int tid_ = F.tid; asm volatile("" : "+v"(tid_));
    for (int idx = blockIdx.x * NTHR + tid_; idx < T * 8; idx += F.G * NTHR) {
        const int h = idx & 7, row = idx >> 3, b = row / SEQ, own = (row % SEQ) / BLK;
        const bf16_t* qp = PROJ + (size_t)row * INCP + C_QA + h * 64;
        float q[64];
#pragma unroll
        for (int i = 0; i < 8; ++i) { const u32x4 v = *(const u32x4*)(qp + i * 8);
#pragma unroll
            for (int k = 0; k < 4; ++k) { q[i * 8 + 2 * k] = bflo(v[k]); q[i * 8 + 2 * k + 1] = bfhi(v[k]); } }
        float v1 = -INFINITY, v2 = -INFINITY, v3 = -INFINITY; int i1 = -1, i2 = -1, i3 = -1;
        for (int j = 0; j < own; ++j) {
            const f32x4* kp = (const f32x4*)(KM + ((size_t)(b * HA + h) * NBLK + j) * 64);
            float g = 0.f;
#pragma unroll
            for (int c = 0; c < 16; ++c) { const f32x4 k4 = kp[c]; g = fmaf(q[4 * c], k4[0], g); g = fmaf(q[4 * c + 1], k4[1], g); g = fmaf(q[4 * c + 2], k4[2], g); g = fmaf(q[4 * c + 3], k4[3], g); }
            if (g > v1) { v3 = v2; i3 = i2; v2 = v1; i2 = i1; v1 = g; i1 = j; }
            else if (g > v2) { v3 = v2; i3 = i2; v2 = g; i2 = j; }
            else if (g > v3) { v3 = g; i3 = j; }
        }
        unsigned m = 0;
        if (i1 >= 0) m |= 1u << i1;
        if (i2 >= 0) m |= 1u << i2;
        if (i3 >= 0) m |= 1u << i3;
        SEL[idx] = m;
    }
}

template <bool SECOND>
struct EpiGate {
    const bf16_t* PROJ; bf16_t* TMP; bf16_t* MRG;
    __device__ __forceinline__ void operator()(const f32x4 (&acc)[2][2][4][2], const pg8::Unit& u, int wr, int wc, int fr, int fq) const {
        PG8_TILE_BEGIN(acc, wr, wc, fr, fq)
            const int row = u.pm * 256 + trow, col = u.pn * 256 + tcol;
            const u32x4 g = *(const u32x4*)(PROJ + (size_t)row * INCP + (SECOND ? C_GB : C_GA) + col);
            v0[0] *= bflo(g.x); v0[1] *= bfhi(g.x); v0[2] *= bflo(g.y); v0[3] *= bfhi(g.y); v1[0] *= bflo(g.z); v1[1] *= bfhi(g.z); v1[2] *= bflo(g.w); v1[3] *= bfhi(g.w);
            if (SECOND) { const u32x4 t = *(const u32x4*)(TMP + (size_t)row * DM + col);
                v0[0] += bflo(t.x); v0[1] += bfhi(t.x); v0[2] += bflo(t.y); v0[3] += bfhi(t.y); v1[0] += bflo(t.z); v1[1] += bfhi(t.z); v1[2] += bflo(t.w); v1[3] += bfhi(t.w);
                *(u32x4*)(MRG + (size_t)row * DM + col) = pg8::pack8(v0, v1); }
            else *(u32x4*)(TMP + (size_t)row * DM + col) = pg8::pack8(v0, v1);
        PG8_TILE_END
    }
};
struct EpiResid {
    const float* X; float* PRE;
    __device__ __forceinline__ void operator()(const f32x4 (&acc)[2][2][4][2], const pg8::Unit& u, int wr, int wc, int fr, int fq) const {
        PG8_TILE_BEGIN(acc, wr, wc, fr, fq)
            const size_t o = (size_t)(u.pm * 256 + trow) * DM + u.pn * 256 + tcol;
            const f32x4 x0 = *(const f32x4*)(X + o), x1 = *(const f32x4*)(X + o + 4);
            *(f32x4*)(PRE + o) = x0 * ALPHA + v0; *(f32x4*)(PRE + o + 4) = x1 * ALPHA + v1;
        PG8_TILE_END
    }
};
__device__ __forceinline__ void ln_phase(const Frame& F, const float* PRE, const float* g, const float* bt, float* X, bf16_t* XBo) {
    int lane_ = F.lane; asm volatile("" : "+v"(lane_));
    const int gw = F.vcu * NWAVES + F.wave, NGW = F.G * NWAVES, lane = lane_;
    for (int row = gw; row < T; row += NGW) {
        const f32x4* pr = (const f32x4*)(PRE + (size_t)row * DM) + lane;
        f32x4 v[4]; float s = 0.f;
#pragma unroll
        for (int j = 0; j < 4; ++j) { v[j] = pr[64 * j]; s += (v[j][0] + v[j][1]) + (v[j][2] + v[j][3]); }
        const float mean = wave_sum(s) * (1.f / DM); float s2 = 0.f;
#pragma unroll
        for (int j = 0; j < 4; ++j) { v[j] = v[j] - mean; s2 += (v[j][0] * v[j][0] + v[j][1] * v[j][1]) + (v[j][2] * v[j][2] + v[j][3] * v[j][3]); }
        const float rstd = rsqrtf(wave_sum(s2) * (1.f / DM) + LN_EPS);
#pragma unroll
        for (int j = 0; j < 4; ++j) { const f32x4 gg = ((const f32x4*)g)[lane + 64 * j], bb = ((const f32x4*)bt)[lane + 64 * j];
            const f32x4 y = v[j] * rstd * gg + bb;
            ((f32x4*)(X + (size_t)row * DM))[lane + 64 * j] = y;
            if (XBo) { u32x2 w; w.x = pk2(y[0], y[1]); w.y = pk2(y[2], y[3]); ((u32x2*)(XBo + (size_t)row * DM))[lane + 64 * j] = w; } }
    }
}

struct RowGU { int off; __device__ __forceinline__ int operator()(int n) const { return 256 * (n >> 7) + off + (n & 127); } };

struct EpiF32 {
    float* O; int ld;
    __device__ __forceinline__ void operator()(const f32x4 (&acc)[2][2][4][2], const pg8::Unit& u, int wr, int wc, int fr, int fq) const {
        PG8_TILE_BEGIN(acc, wr, wc, fr, fq)
            float* o = O + (size_t)(u.pm * 256 + trow) * ld + u.pn * 256 + tcol; *(f32x4*)o = v0; *(f32x4*)(o + 4) = v1;
        PG8_TILE_END
    }
};
struct EpiBf16 {
    bf16_t* O; int ld;
    __device__ __forceinline__ void operator()(const f32x4 (&acc)[2][2][4][2], const pg8::Unit& u, int wr, int wc, int fr, int fq) const {
        PG8_TILE_BEGIN(acc, wr, wc, fr, fq)
            *(u32x4*)(O + (size_t)(u.pm * 256 + trow) * ld + u.pn * 256 + tcol) = pg8::pack8(v0, v1);
        PG8_TILE_END
    }
};
__device__ __forceinline__ float silu_mul(float g, float u) { return g / (1.f + __expf(-g)) * u; }
struct EpiSwiGLU {
    bf16_t* H; int ld;
    __device__ __forceinline__ void operator()(const f32x4 (&acc)[2][2][4][2], const pg8::Unit& u, int wr, int wc, int fr, int fq) const {
#pragma unroll
        for (int ai = 0; ai < 2; ++ai)
#pragma unroll
            for (int m = 0; m < 4; ++m) { const int row = u.r0 + ai * 128 + wr * 64 + m * 16 + fr;
                if (row < u.rend) { f32x4 h0, h1;
#pragma unroll
                    for (int i = 0; i < 4; ++i) { h0[i] = silu_mul(acc[ai][0][m][0][i], acc[ai][1][m][0][i]); h1[i] = silu_mul(acc[ai][0][m][1][i], acc[ai][1][m][1][i]); }
                    *(u32x4*)(H + (size_t)row * ld + 128 * u.pn + wc * 32 + 8 * fq) = pg8::pack8(h0, h1); } }
    }
};
struct EpiExpDown {
    bf16_t* Y; const int* ROWA; const float* TOPW;
    __device__ __forceinline__ void operator()(const f32x4 (&acc)[2][2][4][2], const pg8::Unit& u, int wr, int wc, int fr, int fq) const {
#pragma unroll
        for (int ai = 0; ai < 2; ++ai)
#pragma unroll
            for (int m = 0; m < 4; ++m) { const int row = u.r0 + ai * 128 + wr * 64 + m * 16 + fr;
                if (row < u.rend) { const int a = ROWA[row]; const float w = TOPW[a];
#pragma unroll
                    for (int bj = 0; bj < 2; ++bj) *(u32x4*)(Y + (size_t)a * DM + 256 * u.pn + bj * 128 + wc * 32 + 8 * fq) = pg8::pack8(acc[ai][bj][m][0] * w, acc[ai][bj][m][1] * w); } }
    }
};
template <int NPN, bool GATHER>
struct ExpertOrder {
    const LAS int* off; const LAS int* toff; const int* rowa; int G, c; size_t strideE;
    __device__ __forceinline__ bool next(int i, pg8::Unit& u) const {
        const int L = i * G + c; if (L >= toff[256] * NPN) return false;
        const int tile = L / NPN; u.pn = L % NPN; int lo = 0, hi = 255;
        while (lo < hi) { const int mid = (lo + hi + 1) >> 1; if (toff[mid] <= tile) lo = mid; else hi = mid - 1; }
        u.e = lo; u.r0 = off[lo] + (tile - toff[lo]) * 256; u.rend = off[lo + 1]; u.pm = 0; return true;
    }
    __device__ __forceinline__ int a_row(const pg8::Unit& u, int r) const { const int rr = min(u.r0 + r, u.rend - 1); return GATHER ? (rowa[rr] >> 3) : rr; }
    __device__ __forceinline__ const char* b_ptr(const pg8::Gemm& g, const pg8::Unit& u) const { return (const char*)g.Bt + (size_t)u.e * strideE + (size_t)u.pn * 256 * g.ldb * 2; }
};
__device__ __forceinline__ void expert_tables(const Frame& F, const unsigned* cnt, LAS int* off, LAS int* toff) {
    if (F.tid < 256) { off[F.tid] = (int)cnt[F.tid]; }
    __syncthreads();
    if (F.tid == 0) { int a = 0, b = 0; for (int i = 0; i < 256; ++i) { const int c = off[i]; off[i] = a; toff[i] = b; a += c; b += (c + 255) >> 8; } off[256] = a; toff[256] = b; }
    __syncthreads();
}
__device__ __forceinline__ void route_phase(const Frame& F, const float* LOGITS, const float* rbias, int* TOPE, float* TOPW, int* APOS, unsigned* cnt) {
    int lane_ = F.lane; asm volatile("" : "+v"(lane_));
    const int gw = F.vcu * NWAVES + F.wave, NGW = F.G * NWAVES, lane = lane_;
    const f32x4 rb = *(const f32x4*)(rbias + lane * 4);
    for (int t = gw; t < T; t += NGW) {
        const f32x4 lg = *(const f32x4*)(LOGITS + (size_t)t * NE + lane * 4);
        const float s0 = 1.f / (1.f + expf(-lg[0])), s1 = 1.f / (1.f + expf(-lg[1])), s2 = 1.f / (1.f + expf(-lg[2])), s3 = 1.f / (1.f + expf(-lg[3]));
        float c0 = s0 + rb[0], c1 = s1 + rb[1], c2 = s2 + rb[2], c3 = s3 + rb[3];
        float a = fmaxf(c0, c1), bq = fminf(c0, c1);
        { const float hi2 = fmaxf(c2, c3), lo2 = fminf(c2, c3); const float na = fmaxf(a, hi2), nb = fmaxf(fminf(a, hi2), fmaxf(bq, lo2)); a = na; bq = nb; }
#pragma unroll
        for (int o = 1; o < 8; o <<= 1) { const float oa = __shfl_xor(a, o), ob = __shfl_xor(bq, o); const float na = fmaxf(a, oa), nb = fmaxf(fminf(a, oa), fmaxf(bq, ob)); a = na; bq = nb; }
        const float gs = a + bq; const int grp = lane >> 3;
        int rank = 0;
#pragma unroll
        for (int j = 0; j < 8; ++j) { const float og = __shfl(gs, j * 8); rank += (og > gs || (og == gs && j < grp)) ? 1 : 0; }
        if (rank >= 4) { c0 = c1 = c2 = c3 = -INFINITY; }
        float wsum = 0.f, myw = 0.f; int mye = 0;
#pragma unroll
        for (int k = 0; k < TOPK; ++k) {
            float bv = c0; int bi = 0;
            if (c1 > bv) { bv = c1; bi = 1; }
            if (c2 > bv) { bv = c2; bi = 2; }
            if (c3 > bv) { bv = c3; bi = 3; }
            int be = lane * 4 + bi;
#pragma unroll
            for (int o = 1; o < 64; o <<= 1) { const float ov = __shfl_xor(bv, o); const int oe = __shfl_xor(be, o); if (ov > bv || (ov == bv && oe < be)) { bv = ov; be = oe; } }
            float sc = 0.f;
            if ((be >> 2) == lane) { const int b2 = be & 3; sc = b2 == 0 ? s0 : b2 == 1 ? s1 : b2 == 2 ? s2 : s3; if (b2 == 0) c0 = -INFINITY; else if (b2 == 1) c1 = -INFINITY; else if (b2 == 2) c2 = -INFINITY; else c3 = -INFINITY; }
            sc = __shfl(sc, be >> 2);
            wsum += sc;
            if (lane == k) { myw = sc; mye = be; }
        }
        if (lane < TOPK) { const int aidx = t * TOPK + lane; TOPE[aidx] = mye; TOPW[aidx] = myw / wsum * 2.5f; APOS[aidx] = (int)atomicAdd(&cnt[mye], 1u); }
    }
}
__device__ __forceinline__ void combine_phase(const Frame& F, const float* X1, const bf16_t* SH, const bf16_t* Y, const float* g, const float* bt, float* Xo, bf16_t* XBo) {
    int lane_ = F.lane; asm volatile("" : "+v"(lane_));
    const int gw = F.vcu * NWAVES + F.wave, NGW = F.G * NWAVES, lane = lane_;
    for (int row = gw; row < T; row += NGW) {
        f32x4 v[4]; float s = 0.f;
#pragma unroll
        for (int j = 0; j < 4; ++j) { v[j] = ((const f32x4*)(X1 + (size_t)row * DM))[lane + 64 * j] * ALPHA;
            const u32x2 h = ((const u32x2*)(SH + (size_t)row * DM))[lane + 64 * j]; v[j][0] += bflo(h.x); v[j][1] += bfhi(h.x); v[j][2] += bflo(h.y); v[j][3] += bfhi(h.y); }
#pragma unroll
        for (int k = 0; k < TOPK; ++k) { const u32x2* yr = (const u32x2*)(Y + ((size_t)row * TOPK + k) * DM);
#pragma unroll
            for (int j = 0; j < 4; ++j) { const u32x2 h = yr[lane + 64 * j]; v[j][0] += bflo(h.x); v[j][1] += bfhi(h.x); v[j][2] += bflo(h.y); v[j][3] += bfhi(h.y); } }
#pragma unroll
        for (int j = 0; j < 4; ++j) s += (v[j][0] + v[j][1]) + (v[j][2] + v[j][3]);
        const float mean = wave_sum(s) * (1.f / DM); float s2 = 0.f;
#pragma unroll
        for (int j = 0; j < 4; ++j) { v[j] = v[j] - mean; s2 += (v[j][0] * v[j][0] + v[j][1] * v[j][1]) + (v[j][2] * v[j][2] + v[j][3] * v[j][3]); }
        const float rstd = rsqrtf(wave_sum(s2) * (1.f / DM) + LN_EPS);
#pragma unroll
        for (int j = 0; j < 4; ++j) { const f32x4 gg = ((const f32x4*)g)[lane + 64 * j], bb = ((const f32x4*)bt)[lane + 64 * j];
            const f32x4 y = v[j] * rstd * gg + bb;
            ((f32x4*)(Xo + (size_t)row * DM))[lane + 64 * j] = y;
            if (XBo) { u32x2 w; w.x = pk2(y[0], y[1]); w.y = pk2(y[2], y[3]); ((u32x2*)(XBo + (size_t)row * DM))[lane + 64 * j] = w; } }
    }
}

__device__ __forceinline__ int crow(int r, int hi) { return (r & 3) + 8 * (r >> 2) + 4 * hi; }
typedef short s16x4 __attribute__((ext_vector_type(4)));
__device__ __forceinline__ s16x4 vtr(const LAS unsigned char* p) { return __builtin_bit_cast(s16x4, __builtin_amdgcn_ds_read_tr16_b64_v4i16((LAS s16x4*)p)); }
__device__ __forceinline__ float xhalf_max(float v) { auto rr = __builtin_amdgcn_permlane32_swap(__float_as_uint(v), __float_as_uint(v), false, false); return fmaxf(__uint_as_float(rr[0]), __uint_as_float(rr[1])); }
__device__ __forceinline__ float xhalf_sum(float v) { auto rr = __builtin_amdgcn_permlane32_swap(__float_as_uint(v), __float_as_uint(v), false, false); return __uint_as_float(rr[0]) + __uint_as_float(rr[1]); }

template <int DQK, bool MOBA>
__device__ __forceinline__ void attn_unit(LAS unsigned char* lds, int b, int h, int qb, const bf16_t* Qp, int ldq, const bf16_t* Kp, int ldk, const bf16_t* Vp, int ldv, bf16_t* Op, int ldo, const unsigned* SEL) {
    constexpr int NCH = DQK / 8, KBYTES = NCH * 1024, BUFB = KBYTES + 8192, ND0 = DQK / 16;
    int tid_ = threadIdx.x; asm volatile("" : "+v"(tid_));
    const int lane = tid_ & 63, r32 = lane & 31, hi = lane >> 5, wid = __builtin_amdgcn_readfirstlane(tid_ >> 6);
    const size_t rowbase = (size_t)b * SEQ; const int q0 = qb * 256, NT = 4 * (qb + 1), qrel = wid * 32 + r32;
    const bf16_t* ksrc = Kp + (rowbase + lane) * ldk + h * DQK;
    const bf16_t* vsrc = Vp + (rowbase + 16 * (wid & 3) + (lane >> 2)) * ldv + h * 64 + (wid >> 2) * 32 + (lane & 3) * 8;
#define ATT_ISSUE(t, buf) do { \
        for (int c_ = wid; c_ < NCH; c_ += 8) __builtin_amdgcn_global_load_lds((const unsigned*)(ksrc + (size_t)(t) * 64 * ldk + c_ * 8), (LAS unsigned*)(lds + (buf) * BUFB + c_ * 1024), 16, 0, 0); \
        __builtin_amdgcn_global_load_lds((const unsigned*)(vsrc + (size_t)(t) * 64 * ldv), (LAS unsigned*)(lds + (buf) * BUFB + KBYTES + wid * 1024), 16, 0, 0); } while (0)
    ATT_ISSUE(0, 0);
    bf16x8 qf[ND0];
    { const bf16_t* qrow = Qp + (rowbase + q0 + qrel) * ldq + h * DQK + hi * 8;
#pragma unroll
      for (int d0 = 0; d0 < ND0; ++d0) qf[d0] = *(const bf16x8*)(qrow + d0 * 16); }
    unsigned selmask = 0u; float slope2 = 0.f;
    if (MOBA) { selmask = SEL[(rowbase + q0 + qrel) * 8 + h]; slope2 = exp2f(-(float)(h + 1)) * LOG2E; }
    float m = -1e30f, l = 0.f;
    f32x16 o0, o1;
#pragma unroll
    for (int r = 0; r < 16; ++r) { o0[r] = 0.f; o1[r] = 0.f; }
    const int kfo = hi * 1024 + r32 * 16;
    const int vfo = KBYTES + ((lane >> 4) & 1) * 32 + (lane & 3) * 8 + (4 * hi + ((lane & 15) >> 2)) * 64;
    for (int t = 0; t < NT; ++t) {
        asm volatile("s_waitcnt vmcnt(0) lgkmcnt(0)\n\ts_barrier" ::: "memory");
        if (t + 1 < NT) ATT_ISSUE(t + 1, (t + 1) & 1);
        const LAS unsigned char* kb = lds + (t & 1) * BUFB;
        f32x16 p0, p1;
#pragma unroll
        for (int r = 0; r < 16; ++r) { p0[r] = 0.f; p1[r] = 0.f; }
#pragma unroll
        for (int d0 = 0; d0 < ND0; ++d0) {
            const bf16x8 a0 = *(const LAS bf16x8*)(kb + kfo + d0 * 2048), a1 = *(const LAS bf16x8*)(kb + kfo + d0 * 2048 + 512);
            p0 = __builtin_amdgcn_mfma_f32_32x32x16_bf16(a0, qf[d0], p0, 0, 0, 0);
            p1 = __builtin_amdgcn_mfma_f32_32x32x16_bf16(a1, qf[d0], p1, 0, 0, 0);
        }
        if (MOBA) {
            const int blk = t >> 2;
            const float bb = slope2 * (float)(64 * t + 4 * hi - (q0 + qrel));
#pragma unroll
            for (int r = 0; r < 16; ++r) { const float c = (float)((r & 3) + 8 * (r >> 2)); p0[r] += fmaf(slope2, c, bb); p1[r] += fmaf(slope2, c + 32.f, bb); }
            if (blk == qb) { const int kbs = 64 * (t & 3) + 4 * hi;
#pragma unroll
                for (int r = 0; r < 16; ++r) { const int kv = kbs + (r & 3) + 8 * (r >> 2); if (kv > qrel) p0[r] = -INFINITY; if (kv + 32 > qrel) p1[r] = -INFINITY; } }
            else if (((selmask >> blk) & 1u) == 0u) {
#pragma unroll
                for (int r = 0; r < 16; ++r) { p0[r] = -INFINITY; p1[r] = -INFINITY; } }
        } else if (t >= NT - 4) { const int kbs = 64 * (t - (NT - 4)) + 4 * hi;
#pragma unroll
            for (int r = 0; r < 16; ++r) { const int kv = kbs + (r & 3) + 8 * (r >> 2); if (kv > qrel) p0[r] = -INFINITY; if (kv + 32 > qrel) p1[r] = -INFINITY; } }
        float rm = fmaxf(p0[0], p1[0]);
#pragma unroll
        for (int r = 1; r < 16; ++r) rm = fmaxf(rm, fmaxf(p0[r], p1[r]));
        rm = xhalf_max(rm);
        const float mn = fmaxf(m, rm), alpha = __builtin_amdgcn_exp2f(m - mn);
        m = mn;
        float ls = 0.f;
#pragma unroll
        for (int r = 0; r < 16; ++r) { p0[r] = __builtin_amdgcn_exp2f(p0[r] - mn); p1[r] = __builtin_amdgcn_exp2f(p1[r] - mn); ls += p0[r] + p1[r]; }
        l = l * alpha + ls;
#pragma unroll
        for (int r = 0; r < 16; ++r) { o0[r] *= alpha; o1[r] *= alpha; }
        u32x4 pw0, pw1, pw2, pw3;
        pw0 = (u32x4){pg8::cvt_pk_bf16(p0[0], p0[1]), pg8::cvt_pk_bf16(p0[2], p0[3]), pg8::cvt_pk_bf16(p0[4], p0[5]), pg8::cvt_pk_bf16(p0[6], p0[7])};
        pw1 = (u32x4){pg8::cvt_pk_bf16(p0[8], p0[9]), pg8::cvt_pk_bf16(p0[10], p0[11]), pg8::cvt_pk_bf16(p0[12], p0[13]), pg8::cvt_pk_bf16(p0[14], p0[15])};
        pw2 = (u32x4){pg8::cvt_pk_bf16(p1[0], p1[1]), pg8::cvt_pk_bf16(p1[2], p1[3]), pg8::cvt_pk_bf16(p1[4], p1[5]), pg8::cvt_pk_bf16(p1[6], p1[7])};
        pw3 = (u32x4){pg8::cvt_pk_bf16(p1[8], p1[9]), pg8::cvt_pk_bf16(p1[10], p1[11]), pg8::cvt_pk_bf16(p1[12], p1[13]), pg8::cvt_pk_bf16(p1[14], p1[15])};
        const LAS unsigned char* vb = kb + vfo;
#define ATT_VF(d0, ks) ({ const s16x4 lo_ = vtr(vb + (d0) * 4096 + (ks) * 1024), hi_ = vtr(vb + (d0) * 4096 + (ks) * 1024 + 512); (bf16x8){lo_[0], lo_[1], lo_[2], lo_[3], hi_[0], hi_[1], hi_[2], hi_[3]}; })
        o0 = __builtin_amdgcn_mfma_f32_32x32x16_bf16(ATT_VF(0, 0), __builtin_bit_cast(bf16x8, pw0), o0, 0, 0, 0);
        o1 = __builtin_amdgcn_mfma_f32_32x32x16_bf16(ATT_VF(1, 0), __builtin_bit_cast(bf16x8, pw0), o1, 0, 0, 0);
        o0 = __builtin_amdgcn_mfma_f32_32x32x16_bf16(ATT_VF(0, 1), __builtin_bit_cast(bf16x8, pw1), o0, 0, 0, 0);
        o1 = __builtin_amdgcn_mfma_f32_32x32x16_bf16(ATT_VF(1, 1), __builtin_bit_cast(bf16x8, pw1), o1, 0, 0, 0);
        o0 = __builtin_amdgcn_mfma_f32_32x32x16_bf16(ATT_VF(0, 2), __builtin_bit_cast(bf16x8, pw2), o0, 0, 0, 0);
        o1 = __builtin_amdgcn_mfma_f32_32x32x16_bf16(ATT_VF(1, 2), __builtin_bit_cast(bf16x8, pw2), o1, 0, 0, 0);
        o0 = __builtin_amdgcn_mfma_f32_32x32x16_bf16(ATT_VF(0, 3), __builtin_bit_cast(bf16x8, pw3), o0, 0, 0, 0);
        o1 = __builtin_amdgcn_mfma_f32_32x32x16_bf16(ATT_VF(1, 3), __builtin_bit_cast(bf16x8, pw3), o1, 0, 0, 0);
#undef ATT_VF
    }
    const float inv = 1.f / xhalf_sum(l);
    bf16_t* orow = Op + (rowbase + q0 + qrel) * ldo + h * 64 + 4 * hi;
#pragma unroll
    for (int r4 = 0; r4 < 4; ++r4) {
        u32x2 w0, w1;
        w0.x = pg8::cvt_pk_bf16(o0[4 * r4] * inv, o0[4 * r4 + 1] * inv); w0.y = pg8::cvt_pk_bf16(o0[4 * r4 + 2] * inv, o0[4 * r4 + 3] * inv);
        w1.x = pg8::cvt_pk_bf16(o1[4 * r4] * inv, o1[4 * r4 + 1] * inv); w1.y = pg8::cvt_pk_bf16(o1[4 * r4 + 2] * inv, o1[4 * r4 + 3] * inv);
        *(u32x2*)(orow + 8 * r4) = w0; *(u32x2*)(orow + 32 + 8 * r4) = w1;
    }
    asm volatile("s_waitcnt lgkmcnt(0)\n\ts_barrier" ::: "memory");
#undef ATT_ISSUE
}
template <int DQK, bool MOBA>
__device__ __forceinline__ void attn_phase(const Frame& F, const bf16_t* Qp, int ldq, const bf16_t* Kp, int ldk, const bf16_t* Vp, int ldv, bf16_t* Op, int ldo, const unsigned* SEL) {
    for (int u = 2 * F.vcu; u < 512; u += 2 * F.G) {
#pragma unroll 1
        for (int k = 0; k < 2; ++k) { const int uu = u + k, bh = uu >> 5, w = uu & 31, qb = (w & 1) ? (w >> 1) : 31 - (w >> 1);
            attn_unit<DQK, MOBA>(F.lds, bh >> 3, bh & 7, qb, Qp, ldq, Kp, ldk, Vp, ldv, Op, ldo, SEL); }
    }
}

constexpr int NPH_L = 16;
__global__ void __launch_bounds__(NTHR, 2) mk(Params p) {
    extern __shared__ __attribute__((aligned(16))) unsigned char lds_raw[];
    Frame F;
    F.lds = (LAS unsigned char*)lds_raw;
    F.tid = threadIdx.x; F.lane = F.tid & 63; F.wave = __builtin_amdgcn_readfirstlane(F.tid >> 6);
    F.G = gridDim.x; { const int bx = blockIdx.x; F.vcu = (F.G % 8 == 0) ? (bx % 8) * (F.G / 8) + bx / 8 : bx; }
    volatile LAS unsigned* MISC = (volatile LAS unsigned*)(F.lds + MISC_OFF);
    if (F.tid < 32) MISC[F.tid] = 0u;
    __syncthreads();
    unsigned char* ws = p.ws;
    unsigned* ctl = (unsigned*)(ws + WS_CTL);
    XcdBarrier bar = xcd_barrier_post(ctl + CW_BAR, MISC + 8);
    const int lo = p.ph_lo, hi = p.ph_hi;
#define IN(k) (lo <= (k) && (k) < hi)
#define SEAM(k) do { if (IN(k) && IN((k) + 1)) xcd_barrier(bar); } while (0)
    bf16_t* WinT = (bf16_t*)(ws + WS_WIN);
    bf16_t* XB = (bf16_t*)(ws + WS_XB);
    bf16_t* PROJ = (bf16_t*)(ws + WS_PROJ);
    bf16_t* WuqT = (bf16_t*)(ws + WS_WUQ); bf16_t* WukvT = (bf16_t*)(ws + WS_WUKV);
    f32x2* CS = (f32x2*)(ws + WS_CS); float* KM = (float*)(ws + WS_KM); unsigned* SEL = (unsigned*)(ws + WS_SEL);
    bf16_t* CQN = (bf16_t*)(ws + WS_CQN); bf16_t* CKVN = (bf16_t*)(ws + WS_CKVN);
    bf16_t* WpaT = (bf16_t*)(ws + WS_WPA); bf16_t* WpbT = (bf16_t*)(ws + WS_WPB); bf16_t* WoutT = (bf16_t*)(ws + WS_WOUT);
    bf16_t* TMP = (bf16_t*)(ws + WS_TMP); bf16_t* MRG = (bf16_t*)(ws + WS_MRG); float* PRE = (float*)(ws + WS_PRE); float* X1 = (float*)(ws + WS_X1); bf16_t* X1B = (bf16_t*)(ws + WS_X1B); float* X2 = (float*)(ws + WS_X2);
    bf16_t* WrtT = (bf16_t*)(ws + WS_WRT); bf16_t* WsguT = (bf16_t*)(ws + WS_WSGU); bf16_t* WsdT = (bf16_t*)(ws + WS_WSD); bf16_t* WeguT = (bf16_t*)(ws + WS_WEGU); bf16_t* WedT = (bf16_t*)(ws + WS_WED);
    float* LOGITS = (float*)(ws + WS_LOG); bf16_t* HS = (bf16_t*)(ws + WS_HS); bf16_t* SH = (bf16_t*)(ws + WS_SH);
    int* TOPE = (int*)(ws + WS_TOPE); float* TOPW = (float*)(ws + WS_TOPW); int* APOS = (int*)(ws + WS_APOS); int* ROWA = (int*)(ws + WS_ROWA);
    bf16_t* HE = (bf16_t*)(ws + WS_HE); bf16_t* Yb = (bf16_t*)(ws + WS_Y);
    LAS int* t_off = (LAS int*)(F.lds + TAB_OFF); LAS int* t_toff = t_off + 260;
    bf16_t* QB = (bf16_t*)(ws + WS_QB); bf16_t* KB = (bf16_t*)(ws + WS_KB); bf16_t* VB = (bf16_t*)(ws + WS_VB); bf16_t* OAB = (bf16_t*)(ws + WS_OAB);
    const int gw = F.vcu * NWAVES + F.wave, NGW = F.G * NWAVES;

    if (IN(0)) {
        LAS float* scr = (LAS float*)(F.lds + F.wave * 16384);
        constexpr int I_IN = (DM / 64) * (INC / 32);
        for (int it = gw; it < DEPTH * I_IN; it += NGW) { const int l = it / I_IN, r = it % I_IN;
            transpose_item(p.in[1] + (size_t)l * DM * INC, DM, INC, WinT + (size_t)l * SZ_WIN, DM, RowId{}, scr, r, F.lane); }
        { constexpr int I_UQ = (QL / 64) * (768 / 32), I_UKV = (KVL / 64) * (1024 / 32);
          for (int it = gw; it < DEPTH * (I_UQ + I_UKV); it += NGW) { const int l = it / (I_UQ + I_UKV), r = it % (I_UQ + I_UKV);
            if (r < I_UQ) transpose_item(p.in[4] + (size_t)l * QL * 768, QL, 768, WuqT + (size_t)l * SZ_WUQ, QL, RowQ{}, scr, r, F.lane);
            else transpose_item(p.in[6] + (size_t)l * KVL * 1024, KVL, 1024, WukvT + (size_t)l * SZ_WUKV, KVL, RowId{}, scr, r - I_UQ, F.lane); } }
        { constexpr int I_P = (512 / 64) * (DM / 32), I_O = (DM / 64) * (DM / 32), I_ALL = 2 * I_P + I_O;
          for (int it = gw; it < DEPTH * I_ALL; it += NGW) { const int l = it / I_ALL; int r = it % I_ALL;
            if (r < I_P) { transpose_item(p.in[7] + (size_t)l * 512 * DM, 512, DM, WpaT + (size_t)l * SZ_WP, 512, RowId{}, scr, r, F.lane); continue; } r -= I_P;
            if (r < I_P) { transpose_item(p.in[8] + (size_t)l * 512 * DM, 512, DM, WpbT + (size_t)l * SZ_WP, 512, RowId{}, scr, r, F.lane); continue; } r -= I_P;
            transpose_item(p.in[9] + (size_t)l * DM * DM, DM, DM, WoutT + (size_t)l * SZ_WOUT, DM, RowId{}, scr, r, F.lane); } }
        { constexpr int I_R = (DM / 64) * (NE / 32), I_G = (DM / 64) * (DSH / 32), I_D = (DSH / 64) * (DM / 32), I_ALL = I_R + 2 * I_G + I_D;
          for (int it = gw; it < DEPTH * I_ALL; it += NGW) { const int l = it / I_ALL; int r = it % I_ALL;
            if (r < I_R) { transpose_item(p.in[12] + (size_t)l * DM * NE, DM, NE, WrtT + (size_t)l * SZ_WRT, DM, RowId{}, scr, r, F.lane); continue; } r -= I_R;
            if (r < I_G) { transpose_item(p.in[17] + (size_t)l * DM * DSH, DM, DSH, WsguT + (size_t)l * SZ_WSGU, DM, RowGU{0}, scr, r, F.lane); continue; } r -= I_G;
            if (r < I_G) { transpose_item(p.in[18] + (size_t)l * DM * DSH, DM, DSH, WsguT + (size_t)l * SZ_WSGU, DM, RowGU{128}, scr, r, F.lane); continue; } r -= I_G;
            transpose_item(p.in[19] + (size_t)l * DSH * DM, DSH, DM, WsdT + (size_t)l * SZ_WSD, DSH, RowId{}, scr, r, F.lane); } }
        { constexpr int I_G = (DM / 64) * (DE / 32), I_D = (DE / 64) * (DM / 32), I_E = 2 * I_G + I_D;
          for (int it = gw; it < DEPTH * NE * I_E; it += NGW) { const int le = it / I_E; int r = it % I_E;
            if (r < I_G) { transpose_item(p.in[14] + (size_t)le * DM * DE, DM, DE, WeguT + (size_t)le * 512 * DM, DM, RowGU{0}, scr, r, F.lane); continue; } r -= I_G;
            if (r < I_G) { transpose_item(p.in[15] + (size_t)le * DM * DE, DM, DE, WeguT + (size_t)le * 512 * DM, DM, RowGU{128}, scr, r, F.lane); continue; } r -= I_G;
            transpose_item(p.in[16] + (size_t)le * DE * DM, DE, DM, WedT + (size_t)le * DM * DE, DE, RowId{}, scr, r, F.lane); } }
        for (int i = blockIdx.x * NTHR + F.tid; i < SEQ * 16; i += F.G * NTHR) { const int pos = i >> 4, k = i & 15;
            const float inv = powf(10000.f, -(float)(2 * k) / 32.f), ang = (float)pos * inv; CS[i] = (f32x2){cosf(ang), sinf(ang)}; }
        for (int i = blockIdx.x * NTHR + F.tid; i < DEPTH * 12288; i += F.G * NTHR) { const int l = i / 12288, r = i % 12288;
            *(u32x4*)(WinT + (size_t)l * SZ_WIN + (size_t)INC * DM + (size_t)r * 8) = (u32x4){0u, 0u, 0u, 0u}; }
        for (int i = blockIdx.x * NTHR + F.tid; i < T * DM / 8; i += F.G * NTHR) { const f32x4 a = *(const f32x4*)(p.in[0] + (size_t)i * 8), b = *(const f32x4*)(p.in[0] + (size_t)i * 8 + 4);
            u32x4 w; w.x = pk2(a[0], a[1]); w.y = pk2(a[2], a[3]); w.z = pk2(b[0], b[1]); w.w = pk2(b[2], b[3]); *(u32x4*)(XB + (size_t)i * 8) = w; }
    }
    SEAM(0);

    {
        const int l = 0; const int pb = 1 + l * NPH_L;
        if (IN(pb + 0)) {
            pg8::Gemm g{XB, WinT + (size_t)l * SZ_WIN, T, INCP, DM, DM, DM}; pg8::StaticOrder S; S.init(T, INCP, F.G, (int)blockIdx.x);
            EpiProj E{PROJ, p.in[2] + (size_t)l * 2 * DM};
            pg8::gemm_phase<EpiProj, pg8::StaticOrder, true>(F.lds, g, S, E);
        }
        SEAM(pb + 0);
        if (IN(pb + 1)) prep_phase(F, PROJ, p.in[3] + (size_t)l * QL, p.in[5] + (size_t)l * KVL, CS, CQN, CKVN, KB, KM);
        SEAM(pb + 1);
        if (IN(pb + 2)) {
            mobasel_phase(F, PROJ, KM, SEL);
            { pg8::Gemm g{CKVN, WukvT + (size_t)l * SZ_WUKV, T, 1024, KVL, KVL, KVL}; pg8::StaticOrder S; S.init(T, 1024, F.G, (int)blockIdx.x);
              EpiKV E{KB, VB}; pg8::gemm_phase<EpiKV, pg8::StaticOrder, true>(F.lds, g, S, E); }
            { pg8::Gemm g{CQN, WuqT + (size_t)l * SZ_WUQ, T, 768, QL, QL, QL}; pg8::StaticOrder S; S.init(T, 768, F.G, (int)blockIdx.x);
              EpiQ E{QB, CS}; pg8::gemm_phase<EpiQ, pg8::StaticOrder, true>(F.lds, g, S, E); }
        }
        SEAM(pb + 2);
        if (IN(pb + 3)) {
            attn_phase<96, false>(F, QB, 768, KB, 768, VB, 512, OAB + 512, 1024, nullptr);
            attn_phase<64, true>(F, PROJ + C_QA, INCP, PROJ + C_KA, INCP, PROJ + C_VA, INCP, OAB, 1024, SEL);
        }
        SEAM(pb + 3);
        if (IN(pb + 4)) {
            { pg8::Gemm g{OAB, WpaT + (size_t)l * SZ_WP, T, DM, 512, 1024, 512}; pg8::StaticOrder S; S.init(T, DM, F.G, (int)blockIdx.x);
              EpiGate<false> E{PROJ, TMP, MRG}; pg8::gemm_phase<EpiGate<false>, pg8::StaticOrder, true>(F.lds, g, S, E); }
            { pg8::Gemm g{OAB + 512, WpbT + (size_t)l * SZ_WP, T, DM, 512, 1024, 512}; pg8::StaticOrder S; S.init(T, DM, F.G, (int)blockIdx.x);
              EpiGate<true> E{PROJ, TMP, MRG}; pg8::gemm_phase<EpiGate<true>, pg8::StaticOrder, true>(F.lds, g, S, E); }
        }
        SEAM(pb + 4);
        if (IN(pb + 5)) {
            pg8::Gemm g{MRG, WoutT + (size_t)l * SZ_WOUT, T, DM, DM, DM, DM}; pg8::StaticOrder S; S.init(T, DM, F.G, (int)blockIdx.x);
            EpiResid E{l == 0 ? p.in[0] : X2, PRE}; pg8::gemm_phase<EpiResid, pg8::StaticOrder, true>(F.lds, g, S, E);
        }
        SEAM(pb + 5);
        if (IN(pb + 6)) ln_phase(F, PRE, p.in[10] + (size_t)l * DM, p.in[11] + (size_t)l * DM, X1, X1B);
        SEAM(pb + 6);
        if (IN(pb + 7)) {
            { pg8::Gemm g{X1B, WrtT + (size_t)l * SZ_WRT, T, NE, DM, DM, DM}; pg8::StaticOrder S; S.init(T, NE, F.G, (int)blockIdx.x);
              EpiF32 E{LOGITS, NE}; pg8::gemm_phase<EpiF32, pg8::StaticOrder, true>(F.lds, g, S, E); }
            { pg8::Gemm g{X1B, WsguT + (size_t)l * SZ_WSGU, T, 512, DM, DM, DM}; pg8::StaticOrder S; S.init(T, 512, F.G, (int)((blockIdx.x + F.G / 2) % F.G));
              EpiSwiGLU E{HS, DSH}; pg8::gemm_phase<EpiSwiGLU, pg8::StaticOrder, true>(F.lds, g, S, E); }
        }
        SEAM(pb + 7);
        if (IN(pb + 8)) {
            route_phase(F, LOGITS, p.in[13] + (size_t)l * NE, TOPE, TOPW, APOS, ctl + CW_CNT + l * 256);
            pg8::Gemm g{HS, WsdT + (size_t)l * SZ_WSD, T, DM, DSH, DSH, DSH}; pg8::StaticOrder S; S.init(T, DM, F.G, (int)blockIdx.x);
            EpiBf16 E{SH, DM}; pg8::gemm_phase<EpiBf16, pg8::StaticOrder, true>(F.lds, g, S, E);
        }
        SEAM(pb + 8);
        if (IN(pb + 9)) {
            expert_tables(F, ctl + CW_CNT + l * 256, t_off, t_toff);
            int tid_ = F.tid; asm volatile("" : "+v"(tid_));
            for (int a = blockIdx.x * NTHR + tid_; a < NA; a += F.G * NTHR) ROWA[t_off[TOPE[a]] + APOS[a]] = a;
        }
        SEAM(pb + 9);
        if (IN(pb + 10)) {
            expert_tables(F, ctl + CW_CNT + l * 256, t_off, t_toff);
            pg8::Gemm g{X1B, WeguT + (size_t)l * SZ_WEGU, T, 512, DM, DM, DM};
            ExpertOrder<2, true> S{t_off, t_toff, ROWA, F.G, (int)blockIdx.x, (size_t)512 * DM * 2};
            EpiSwiGLU E{HE, DE}; pg8::gemm_phase<EpiSwiGLU, ExpertOrder<2, true>, true>(F.lds, g, S, E);
        }
        SEAM(pb + 10);
        if (IN(pb + 11)) {
            expert_tables(F, ctl + CW_CNT + l * 256, t_off, t_toff);
            pg8::Gemm g{HE, WedT + (size_t)l * SZ_WED, NA, DM, DE, DE, DE};
            ExpertOrder<4, false> S{t_off, t_toff, ROWA, F.G, (int)blockIdx.x, (size_t)DM * DE * 2};
            EpiExpDown E{Yb, ROWA, TOPW}; pg8::gemm_phase<EpiExpDown, ExpertOrder<4, false>, true>(F.lds, g, S, E);
        }
        SEAM(pb + 11);
        if (IN(pb + 12)) combine_phase(F, X1, SH, Yb, p.in[20] + (size_t)l * DM, p.in[21] + (size_t)l * DM, l == DEPTH - 1 ? p.out : X2, l == DEPTH - 1 ? (bf16_t*)nullptr : XB);
        SEAM(pb + 12);
    }

    {
        const int l = 1; const int pb = 1 + l * NPH_L;
        if (IN(pb + 0)) {
            pg8::Gemm g{XB, WinT + (size_t)l * SZ_WIN, T, INCP, DM, DM, DM}; pg8::StaticOrder S; S.init(T, INCP, F.G, (int)blockIdx.x);
            EpiProj E{PROJ, p.in[2] + (size_t)l * 2 * DM};
            pg8::gemm_phase<EpiProj, pg8::StaticOrder, true>(F.lds, g, S, E);
        }
        SEAM(pb + 0);
        if (IN(pb + 1)) prep_phase(F, PROJ, p.in[3] + (size_t)l * QL, p.in[5] + (size_t)l * KVL, CS, CQN, CKVN, KB, KM);
        SEAM(pb + 1);
        if (IN(pb + 2)) {
            mobasel_phase(F, PROJ, KM, SEL);
            { pg8::Gemm g{CKVN, WukvT + (size_t)l * SZ_WUKV, T, 1024, KVL, KVL, KVL}; pg8::StaticOrder S; S.init(T, 1024, F.G, (int)blockIdx.x);
              EpiKV E{KB, VB}; pg8::gemm_phase<EpiKV, pg8::StaticOrder, true>(F.lds, g, S, E); }
            { pg8::Gemm g{CQN, WuqT + (size_t)l * SZ_WUQ, T, 768, QL, QL, QL}; pg8::StaticOrder S; S.init(T, 768, F.G, (int)blockIdx.x);
              EpiQ E{QB, CS}; pg8::gemm_phase<EpiQ, pg8::StaticOrder, true>(F.lds, g, S, E); }
        }
        SEAM(pb + 2);
        if (IN(pb + 3)) {
            attn_phase<96, false>(F, QB, 768, KB, 768, VB, 512, OAB + 512, 1024, nullptr);
            attn_phase<64, true>(F, PROJ + C_QA, INCP, PROJ + C_KA, INCP, PROJ + C_VA, INCP, OAB, 1024, SEL);
        }
        SEAM(pb + 3);
        if (IN(pb + 4)) {
            { pg8::Gemm g{OAB, WpaT + (size_t)l * SZ_WP, T, DM, 512, 1024, 512}; pg8::StaticOrder S; S.init(T, DM, F.G, (int)blockIdx.x);
              EpiGate<false> E{PROJ, TMP, MRG}; pg8::gemm_phase<EpiGate<false>, pg8::StaticOrder, true>(F.lds, g, S, E); }
            { pg8::Gemm g{OAB + 512, WpbT + (size_t)l * SZ_WP, T, DM, 512, 1024, 512}; pg8::StaticOrder S; S.init(T, DM, F.G, (int)blockIdx.x);
              EpiGate<true> E{PROJ, TMP, MRG}; pg8::gemm_phase<EpiGate<true>, pg8::StaticOrder, true>(F.lds, g, S, E); }
        }
        SEAM(pb + 4);
        if (IN(pb + 5)) {
            pg8::Gemm g{MRG, WoutT + (size_t)l * SZ_WOUT, T, DM, DM, DM, DM}; pg8::StaticOrder S; S.init(T, DM, F.G, (int)blockIdx.x);
            EpiResid E{l == 0 ? p.in[0] : X2, PRE}; pg8::gemm_phase<EpiResid, pg8::StaticOrder, true>(F.lds, g, S, E);
        }
        SEAM(pb + 5);
        if (IN(pb + 6)) ln_phase(F, PRE, p.in[10] + (size_t)l * DM, p.in[11] + (size_t)l * DM, X1, X1B);
        SEAM(pb + 6);
        if (IN(pb + 7)) {
            { pg8::Gemm g{X1B, WrtT + (size_t)l * SZ_WRT, T, NE, DM, DM, DM}; pg8::StaticOrder S; S.init(T, NE, F.G, (int)blockIdx.x);
              EpiF32 E{LOGITS, NE}; pg8::gemm_phase<EpiF32, pg8::StaticOrder, true>(F.lds, g, S, E); }
            { pg8::Gemm g{X1B, WsguT + (size_t)l * SZ_WSGU, T, 512, DM, DM, DM}; pg8::StaticOrder S; S.init(T, 512, F.G, (int)((blockIdx.x + F.G / 2) % F.G));
              EpiSwiGLU E{HS, DSH}; pg8::gemm_phase<EpiSwiGLU, pg8::StaticOrder, true>(F.lds, g, S, E); }
        }
        SEAM(pb + 7);
        if (IN(pb + 8)) {
            route_phase(F, LOGITS, p.in[13] + (size_t)l * NE, TOPE, TOPW, APOS, ctl + CW_CNT + l * 256);
            pg8::Gemm g{HS, WsdT + (size_t)l * SZ_WSD, T, DM, DSH, DSH, DSH}; pg8::StaticOrder S; S.init(T, DM, F.G, (int)blockIdx.x);
            EpiBf16 E{SH, DM}; pg8::gemm_phase<EpiBf16, pg8::StaticOrder, true>(F.lds, g, S, E);
        }
        SEAM(pb + 8);
        if (IN(pb + 9)) {
            expert_tables(F, ctl + CW_CNT + l * 256, t_off, t_toff);
            int tid_ = F.tid; asm volatile("" : "+v"(tid_));
            for (int a = blockIdx.x * NTHR + tid_; a < NA; a += F.G * NTHR) ROWA[t_off[TOPE[a]] + APOS[a]] = a;
        }
        SEAM(pb + 9);
        if (IN(pb + 10)) {
            expert_tables(F, ctl + CW_CNT + l * 256, t_off, t_toff);
            pg8::Gemm g{X1B, WeguT + (size_t)l * SZ_WEGU, T, 512, DM, DM, DM};
            ExpertOrder<2, true> S{t_off, t_toff, ROWA, F.G, (int)blockIdx.x, (size_t)512 * DM * 2};
            EpiSwiGLU E{HE, DE}; pg8::gemm_phase<EpiSwiGLU, ExpertOrder<2, true>, true>(F.lds, g, S, E);
        }
        SEAM(pb + 10);
        if (IN(pb + 11)) {
            expert_tables(F, ctl + CW_CNT + l * 256, t_off, t_toff);
            pg8::Gemm g{HE, WedT + (size_t)l * SZ_WED, NA, DM, DE, DE, DE};
            ExpertOrder<4, false> S{t_off, t_toff, ROWA, F.G, (int)blockIdx.x, (size_t)DM * DE * 2};
            EpiExpDown E{Yb, ROWA, TOPW}; pg8::gemm_phase<EpiExpDown, ExpertOrder<4, false>, true>(F.lds, g, S, E);
        }
        SEAM(pb + 11);
        if (IN(pb + 12)) combine_phase(F, X1, SH, Yb, p.in[20] + (size_t)l * DM, p.in[21] + (size_t)l * DM, l == DEPTH - 1 ? p.out : X2, l == DEPTH - 1 ? (bf16_t*)nullptr : XB);
        SEAM(pb + 12);
    }

#undef IN
#undef SEAM
}

__global__ void __launch_bounds__(256) cvt_proj(const bf16_t* __restrict__ P, float* proj) {
    const size_t i = (size_t)blockIdx.x * 256 + threadIdx.x;
    const int row = (int)(i / INC), c = (int)(i % INC);
    float v = bf2f(P[(size_t)row * INCP + c]);
    if (c < C_KA) v *= (1.f / QS_A);
    proj[i] = v;
}
__global__ void __launch_bounds__(256) cvt_oab(const bf16_t* __restrict__ OAB, float* oa, float* ob) {
    const size_t i = (size_t)blockIdx.x * 256 + threadIdx.x; const size_t row = i >> 10; const int c = (int)(i & 1023);
    const float v = bf2f(OAB[i]);
    if (c < 512) oa[row * 512 + c] = v; else ob[row * 512 + c - 512] = v;
}
__global__ void __launch_bounds__(256) cvt_x(const float* __restrict__ x, bf16_t* XB) {
    const size_t i = (size_t)blockIdx.x * 256 + threadIdx.x;
    const f32x4 a = *(const f32x4*)(x + i * 8), b = *(const f32x4*)(x + i * 8 + 4);
    u32x4 w; w.x = pk2(a[0], a[1]); w.y = pk2(a[2], a[3]); w.z = pk2(b[0], b[1]); w.w = pk2(b[2], b[3]); *(u32x4*)(XB + i * 8) = w;
}
}
static int g_grid = 0;
static bool fast_setup() {
    if (g_grid) return g_grid > 0;
    int dev = 0, cus = 0, per_cu = 0;
    if (hipGetDevice(&dev) != hipSuccess || hipDeviceGetAttribute(&cus, hipDeviceAttributeMultiprocessorCount, dev) != hipSuccess) { g_grid = -1; return false; }
    if (hipFuncSetAttribute((const void*)fk::mk, hipFuncAttributeMaxDynamicSharedMemorySize, fk::LDS_BYTES) != hipSuccess) { fprintf(stderr, "hipFuncSetAttribute failed\n"); g_grid = -1; return false; }
    if (hipOccupancyMaxActiveBlocksPerMultiprocessor(&per_cu, (const void*)fk::mk, fk::NTHR, fk::LDS_BYTES) != hipSuccess || per_cu < 1) { fprintf(stderr, "occupancy query: %d\n", per_cu); }
    (void)hipGetLastError();
    g_grid = cus;
    return true;
}
static void launch_mk(fk::Params& p, int lo, int hi, hipStream_t stream) {
    p.ph_lo = lo; p.ph_hi = hi;
    hipLaunchKernelGGL(fk::mk, dim3(g_grid), dim3(fk::NTHR), fk::LDS_BYTES, stream, p);
}

extern "C" void kernel_launch(void* const* d_in, const int* in_sizes, int n_in, void* d_out, int out_size, void* d_ws, size_t ws_size, hipStream_t stream) {
    if (!fast_setup()) return;
    if (ws_size < fk::WS_NEED) { fprintf(stderr, "workspace too small: need %zu have %zu\n", (size_t)fk::WS_NEED, ws_size); return; }
    (void)hipMemsetAsync((char*)d_ws + fk::WS_CTL, 0, fk::CTL_BYTES, stream);
    fk::Params P{};
    for (int i = 0; i < 22; ++i) P.in[i] = (const float*)d_in[i];
    P.out = (float*)d_out; P.ws = (unsigned char*)d_ws;
#if MK_ONE_LAUNCH
    launch_mk(P, 0, 1 + DEPTH * fk::NPH_L, stream);
#else
    launch_mk(P, 0, 1, stream);
    for (int l = 0; l < DEPTH; ++l) for (int k = 0; k < 13; ++k) launch_mk(P, 1 + l * fk::NPH_L + k, 2 + l * fk::NPH_L + k, stream);
#endif
}
```

```cpp
#ifndef MK_ONE_LAUNCH
#define MK_ONE_LAUNCH 1
#endif
#include <hip/hip_runtime.h>
#include <cstdint>
#include <cstdio>

constexpr int NB = 2, SEQ = 8192, T = NB * SEQ, DM = 1024, DEPTH = 2;
constexpr int HA = 8, WA = 512, BLK = 256, NBLK = SEQ / BLK;
constexpr int HB = 8, DN = 64, DR = 32, DV = 64, QL = 384, KVL = 256;
constexpr int INC = 3 * WA + QL + KVL + DR + 2 * DM;
constexpr int C_QA = 0, C_KA = 512, C_VA = 1024, C_CQ = 1536, C_CKV = 1920, C_KR = 2176, C_GA = 2208, C_GB = 3232;
constexpr int NE = 256, TOPK = 8, DE = 256, DSH = 256;
constexpr int NA = T * TOPK;
constexpr float ALPHA = 1.4142135623730951f;
constexpr float LN_EPS = 1e-5f, RMS_EPS = 1e-6f;

namespace ora {
template <class EP>
__global__ void __launch_bounds__(256) sgemm(const float* __restrict__ A, const float* __restrict__ Bm, EP ep, int M, int N, int K, int lda, int ldb, int pad_) {
    __shared__ float As[16][68], Bs[16][68];
    const int tid = threadIdx.x, tx = tid & 15, ty = tid >> 4;
    const int m0 = blockIdx.y * 64, n0 = blockIdx.x * 64;
    float acc[4][4];
#pragma unroll
    for (int i = 0; i < 4; ++i)
#pragma unroll
        for (int j = 0; j < 4; ++j) acc[i][j] = 0.f;
    const int ar = tid >> 2, ak = (tid & 3) * 4;
    const int bk = tid >> 4, bn = (tid & 15) * 4;
    for (int k0 = 0; k0 < K; k0 += 16) {
        const float4 av = *(const float4*)(A + (size_t)(m0 + ar) * lda + k0 + ak);
        float4 bv = make_float4(0.f, 0.f, 0.f, 0.f);
        if (n0 + bn < N) bv = *(const float4*)(Bm + (size_t)(k0 + bk) * ldb + n0 + bn);
        __syncthreads();
        As[ak + 0][ar] = av.x; As[ak + 1][ar] = av.y; As[ak + 2][ar] = av.z; As[ak + 3][ar] = av.w;
        *(float4*)&Bs[bk][bn] = bv;
        __syncthreads();
#pragma unroll
        for (int kk = 0; kk < 16; ++kk) {
            const float4 a = *(const float4*)&As[kk][ty * 4];
            const float4 b = *(const float4*)&Bs[kk][tx * 4];
            const float aa[4] = {a.x, a.y, a.z, a.w}, bb[4] = {b.x, b.y, b.z, b.w};
#pragma unroll
            for (int i = 0; i < 4; ++i)
#pragma unroll
                for (int j = 0; j < 4; ++j) acc[i][j] = fmaf(aa[i], bb[j], acc[i][j]);
        }
    }
#pragma unroll
    for (int i = 0; i < 4; ++i)
#pragma unroll
        for (int j = 0; j < 4; ++j) { const int r = m0 + ty * 4 + i, c = n0 + tx * 4 + j; if (c < N) ep(r, c, acc[i][j]); }
}
struct EpStore { float* C; int ldc; int pad; __device__ void operator()(int r, int c, float v) const { C[(size_t)r * ldc + c] = v; } };
struct EpMerge { const float* proj; const float* bg; const float* pa; float* out; int pre; int pad;
    __device__ void operator()(int r, int c, float v) const {
        const float ga = proj[(size_t)r * INC + C_GA + c] + bg[c], gb = proj[(size_t)r * INC + C_GB + c] + bg[DM + c];
        const float sa = pre ? proj[(size_t)r * INC + C_GA + c] : 1.f / (1.f + expf(-ga)), sb = pre ? proj[(size_t)r * INC + C_GB + c] : 1.f / (1.f + expf(-gb));
        out[(size_t)r * DM + c] = sa * pa[(size_t)r * DM + c] + sb * v; } };
struct EpResid { const float* x; float* out; __device__ void operator()(int r, int c, float v) const { out[(size_t)r * DM + c] = ALPHA * x[(size_t)r * DM + c] + v; } };
struct EpSilu { const float* sg; float* out; __device__ void operator()(int r, int c, float v) const { const float g = sg[(size_t)r * DSH + c]; out[(size_t)r * DSH + c] = g / (1.f + expf(-g)) * v; } };

__global__ void __launch_bounds__(256) rowprep(const float* __restrict__ proj, const float* __restrict__ qn, const float* __restrict__ kvn, float* cqn, float* ckvn, float* krr) {
    const int wid = threadIdx.x >> 6, lane = threadIdx.x & 63, row = blockIdx.x * 4 + wid;
    const float* p = proj + (size_t)row * INC;
    float sq = 0.f, sk = 0.f;
    for (int c = lane; c < QL; c += 64) { const float v = p[C_CQ + c]; sq += v * v; }
    for (int c = lane; c < KVL; c += 64) { const float v = p[C_CKV + c]; sk += v * v; }
#pragma unroll
    for (int o = 32; o; o >>= 1) { sq += __shfl_xor(sq, o); sk += __shfl_xor(sk, o); }
    const float rq = rsqrtf(sq / QL + RMS_EPS), rk = rsqrtf(sk / KVL + RMS_EPS);
    for (int c = lane; c < QL; c += 64) cqn[(size_t)row * QL + c] = p[C_CQ + c] * rq * qn[c];
    for (int c = lane; c < KVL; c += 64) ckvn[(size_t)row * KVL + c] = p[C_CKV + c] * rk * kvn[c];
    if (lane < 16) {
        const int pos = row % SEQ;
        const float inv = powf(10000.f, -(float)(2 * lane) / 32.f), ang = (float)pos * inv, cs = cosf(ang), sn = sinf(ang);
        const float x1 = p[C_KR + lane], x2 = p[C_KR + 16 + lane];
        krr[(size_t)row * DR + lane] = x1 * cs - x2 * sn; krr[(size_t)row * DR + 16 + lane] = x2 * cs + x1 * sn;
    }
}
__global__ void __launch_bounds__(256) qrope(float* q) {
    const int idx = blockIdx.x * 256 + threadIdx.x;
    const int i = idx & 15, h = (idx >> 4) & 7, row = idx >> 7, pos = row % SEQ;
    const float inv = powf(10000.f, -(float)(2 * i) / 32.f), ang = (float)pos * inv, cs = cosf(ang), sn = sinf(ang);
    float* p = q + (size_t)row * 768 + h * 96 + 64;
    const float x1 = p[i], x2 = p[16 + i];
    p[i] = x1 * cs - x2 * sn; p[16 + i] = x2 * cs + x1 * sn;
}
__global__ void __launch_bounds__(64) kmean(const float* __restrict__ proj, float* km) {
    const int blk = blockIdx.x, h = blockIdx.y, b = blockIdx.z, c = threadIdx.x;
    float s = 0.f;
    for (int i = 0; i < BLK; ++i) s += proj[(size_t)(b * SEQ + blk * BLK + i) * INC + C_KA + h * 64 + c];
    km[((size_t)(b * HA + h) * NBLK + blk) * 64 + c] = s * (1.f / BLK);
}
__global__ void __launch_bounds__(256) mobasel(const float* __restrict__ proj, const float* __restrict__ km, unsigned* sel) {
    const int idx = blockIdx.x * 256 + threadIdx.x;
    const int h = idx & 7, row = idx >> 3, b = row / SEQ, pos = row % SEQ, own = pos / BLK;
    const float* qp = proj + (size_t)row * INC + C_QA + h * 64;
    float v1 = -INFINITY, v2 = -INFINITY, v3 = -INFINITY; int i1 = -1, i2 = -1, i3 = -1;
    for (int j = 0; j < own; ++j) {
        const float* kp = km + ((size_t)(b * HA + h) * NBLK + j) * 64;
        float g = 0.f;
        for (int c = 0; c < 64; ++c) g = fmaf(qp[c], kp[c], g);
        if (g > v1) { v3 = v2; i3 = i2; v2 = v1; i2 = i1; v1 = g; i1 = j; }
        else if (g > v2) { v3 = v2; i3 = i2; v2 = g; i2 = j; }
        else if (g > v3) { v3 = g; i3 = j; }
    }
    unsigned m = 0;
    if (i1 >= 0) m |= 1u << i1; if (i2 >= 0) m |= 1u << i2; if (i3 >= 0) m |= 1u << i3;
    sel[idx] = m;
}
__device__ __forceinline__ float ldbf(const void* p, size_t i) { return __builtin_bit_cast(float, (unsigned)((const unsigned short*)p)[i] << 16); }
template <bool MOBA, bool FAST>
__global__ void __launch_bounds__(256) attn(const float* __restrict__ Qb, const float* __restrict__ KVb, const float* __restrict__ KRb, const unsigned* __restrict__ sel, float* O) {
    constexpr int DQK = MOBA ? 64 : 96;
    __shared__ float Qs[64][DQK + 1], Ks[32][DQK + 1], Vs[32][65], Ps[64][33];
    const int qb = blockIdx.x, h = blockIdx.y, b = blockIdx.z, tid = threadIdx.x, qi = tid >> 2, sub = tid & 3;
    const size_t row0 = (size_t)b * SEQ + (size_t)qb * 64;
    for (int idx = tid; idx < 64 * DQK; idx += 256) { const int r = idx / DQK, c = idx % DQK;
        if (FAST) Qs[r][c] = MOBA ? ldbf(Qb, (row0 + r) * 4352 + C_QA + h * 64 + c) : ldbf(Qb, (row0 + r) * 768 + h * 96 + c);
        else Qs[r][c] = MOBA ? Qb[(row0 + r) * INC + C_QA + h * 64 + c] : Qb[(row0 + r) * 768 + h * 96 + c]; }
    const int tq = qb * 64 + qi, own = tq / BLK;
    const unsigned mask = MOBA ? sel[(row0 + qi) * 8 + h] : 0u;
    const float slope = exp2f(-(float)(h + 1)), scale = FAST ? 0.6931471805599453f : (MOBA ? 0.125f : 0.10206207261596577f);
    float m = -1e30f, l = 0.f, o[16];
#pragma unroll
    for (int d = 0; d < 16; ++d) o[d] = 0.f;
    const int nkt = (qb * 64 + 64) / 32;
    for (int kt = 0; kt < nkt; ++kt) {
        __syncthreads();
        for (int idx = tid; idx < 32 * DQK; idx += 256) { const int r = idx / DQK, c = idx % DQK; const size_t kr = (size_t)b * SEQ + kt * 32 + r;
            if (FAST) Ks[r][c] = MOBA ? ldbf(KVb, kr * 4352 + C_KA + h * 64 + c) : ldbf(KVb, kr * 768 + h * 96 + c);
            else Ks[r][c] = MOBA ? KVb[kr * INC + C_KA + h * 64 + c] : (c < 64 ? KVb[kr * 1024 + h * 128 + c] : KRb[kr * DR + c - 64]); }
        for (int idx = tid; idx < 32 * 64; idx += 256) { const int r = idx >> 6, c = idx & 63; const size_t kr = (size_t)b * SEQ + kt * 32 + r;
            if (FAST) Vs[r][c] = MOBA ? ldbf(KVb, kr * 4352 + C_VA + h * 64 + c) : ldbf(KRb, kr * 512 + h * 64 + c);
            else Vs[r][c] = MOBA ? KVb[kr * INC + C_VA + h * 64 + c] : KVb[kr * 1024 + h * 128 + 64 + c]; }
        __syncthreads();
        float s[8]; float rmax = -1e30f;
#pragma unroll
        for (int j = 0; j < 8; ++j) {
            const int kk = sub + 4 * j, kpos = kt * 32 + kk;
            float dot = 0.f;
            for (int c = 0; c < DQK; ++c) dot = fmaf(Qs[qi][c], Ks[kk][c], dot);
            float sc = dot * scale; bool ok;
            if (MOBA) { sc -= slope * (float)(tq - kpos); const int kb = kpos / BLK; ok = (kb == own) ? (kpos <= tq) : (((mask >> kb) & 1u) != 0u); }
            else ok = kpos <= tq;
            s[j] = ok ? sc : -1e30f; rmax = fmaxf(rmax, s[j]);
        }
        rmax = fmaxf(rmax, __shfl_xor(rmax, 1)); rmax = fmaxf(rmax, __shfl_xor(rmax, 2));
        const float mn = fmaxf(m, rmax), alpha = expf(m - mn);
        float psum = 0.f;
#pragma unroll
        for (int j = 0; j < 8; ++j) { const float p = (s[j] > -1e29f) ? expf(s[j] - mn) : 0.f; Ps[qi][sub + 4 * j] = p; psum += p; }
        psum += __shfl_xor(psum, 1); psum += __shfl_xor(psum, 2);
        l = l * alpha + psum; m = mn;
        __syncthreads();
#pragma unroll
        for (int d = 0; d < 16; ++d) o[d] *= alpha;
        for (int kk = 0; kk < 32; ++kk) { const float p = Ps[qi][kk];
#pragma unroll
            for (int d = 0; d < 16; ++d) o[d] = fmaf(p, Vs[kk][sub * 16 + d], o[d]); }
    }
    const float rl = 1.f / l;
#pragma unroll
    for (int d = 0; d < 16; ++d) O[(row0 + qi) * 512 + h * 64 + sub * 16 + d] = o[d] * rl;
}
template <bool COMB>
__global__ void __launch_bounds__(256) lnorm(const float* __restrict__ in, const float* __restrict__ x1, const float* __restrict__ shared_, const float* __restrict__ Y, const float* __restrict__ g, const float* __restrict__ bt, float* out) {
    __shared__ float red[8];
    const int row = blockIdx.x, tid = threadIdx.x;
    float v[4];
#pragma unroll
    for (int i = 0; i < 4; ++i) { const int c = tid + 256 * i;
        if (COMB) { float a = ALPHA * x1[(size_t)row * DM + c] + shared_[(size_t)row * DM + c];
            for (int k = 0; k < TOPK; ++k) a += Y[((size_t)row * TOPK + k) * DM + c];
            v[i] = a; }
        else v[i] = in[(size_t)row * DM + c]; }
    float s = v[0] + v[1] + v[2] + v[3];
#pragma unroll
    for (int o = 32; o; o >>= 1) s += __shfl_xor(s, o);
    if ((tid & 63) == 0) red[tid >> 6] = s;
    __syncthreads();
    const float mu = (red[0] + red[1] + red[2] + red[3]) * (1.f / DM);
    float q = 0.f;
#pragma unroll
    for (int i = 0; i < 4; ++i) { const float d = v[i] - mu; q += d * d; }
#pragma unroll
    for (int o = 32; o; o >>= 1) q += __shfl_xor(q, o);
    if ((tid & 63) == 0) red[4 + (tid >> 6)] = q;
    __syncthreads();
    const float rs = rsqrtf((red[4] + red[5] + red[6] + red[7]) * (1.f / DM) + LN_EPS);
#pragma unroll
    for (int i = 0; i < 4; ++i) { const int c = tid + 256 * i; out[(size_t)row * DM + c] = (v[i] - mu) * rs * g[c] + bt[c]; }
}
__global__ void __launch_bounds__(256) route(const float* __restrict__ logits, const float* __restrict__ rbias, int* tope, float* topw, int* apos, unsigned* cnt) {
    const int wid = threadIdx.x >> 6, lane = threadIdx.x & 63, t = blockIdx.x * 4 + wid;
    const float4 lg = *(const float4*)(logits + (size_t)t * NE + lane * 4), rb = *(const float4*)(rbias + lane * 4);
    float s0 = 1.f / (1.f + expf(-lg.x)), s1 = 1.f / (1.f + expf(-lg.y)), s2 = 1.f / (1.f + expf(-lg.z)), s3 = 1.f / (1.f + expf(-lg.w));
    float c0 = s0 + rb.x, c1 = s1 + rb.y, c2 = s2 + rb.z, c3 = s3 + rb.w;
    float a = fmaxf(c0, c1), bq = fminf(c0, c1);
    { const float hi2 = fmaxf(c2, c3), lo2 = fminf(c2, c3); const float na = fmaxf(a, hi2); const float nb = fmaxf(fminf(a, hi2), fmaxf(bq, lo2)); a = na; bq = nb; }
#pragma unroll
    for (int o = 1; o < 8; o <<= 1) { const float oa = __shfl_xor(a, o), ob = __shfl_xor(bq, o); const float na = fmaxf(a, oa), nb = fmaxf(fminf(a, oa), fmaxf(bq, ob)); a = na; bq = nb; }
    const float gs = a + bq; const int grp = lane >> 3;
    int rank = 0;
#pragma unroll
    for (int j = 0; j < 8; ++j) { const float og = __shfl(gs, j * 8); rank += (og > gs || (og == gs && j < grp)) ? 1 : 0; }
    const bool gsel = rank < 4;
    if (!gsel) { c0 = c1 = c2 = c3 = -INFINITY; }
    float wsum = 0.f, myw = 0.f; int mye = 0;
#pragma unroll
    for (int k = 0; k < TOPK; ++k) {
        float bv = c0; int bi = 0;
        if (c1 > bv) { bv = c1; bi = 1; } if (c2 > bv) { bv = c2; bi = 2; } if (c3 > bv) { bv = c3; bi = 3; }
        int be = lane * 4 + bi;
#pragma unroll
        for (int o = 1; o < 64; o <<= 1) { const float ov = __shfl_xor(bv, o); const int oe = __shfl_xor(be, o); if (ov > bv || (ov == bv && oe < be)) { bv = ov; be = oe; } }
        float sc = 0.f;
        if ((be >> 2) == lane) { const int bi2 = be & 3; sc = bi2 == 0 ? s0 : bi2 == 1 ? s1 : bi2 == 2 ? s2 : s3; if (bi2 == 0) c0 = -INFINITY; else if (bi2 == 1) c1 = -INFINITY; else if (bi2 == 2) c2 = -INFINITY; else c3 = -INFINITY; }
        sc = __shfl(sc, be >> 2);
        wsum += sc;
        if (lane == k) { myw = sc; mye = be; }
    }
    if (lane < TOPK) {
        const int aidx = t * TOPK + lane;
        tope[aidx] = mye; topw[aidx] = myw / wsum * 2.5f;
        apos[aidx] = (int)atomicAdd(&cnt[mye], 1u);
    }
}
template <int TM>
__global__ void __launch_bounds__(256) escan(const unsigned* __restrict__ cnt, int* off, int* toff) {
    __shared__ int sc[256], st[256];
    const int e = threadIdx.x; const int c = (int)cnt[e];
    sc[e] = c; st[e] = (c + TM - 1) / TM;
    __syncthreads();
    if (e == 0) { int a = 0, b = 0; for (int i = 0; i < 256; ++i) { const int ca = sc[i], cb = st[i]; sc[i] = a; st[i] = b; a += ca; b += cb; } off[256] = a; toff[256] = b; }
    __syncthreads();
    off[e] = sc[e]; toff[e] = st[e];
}
__global__ void __launch_bounds__(256) escatter(const int* __restrict__ tope, const int* __restrict__ apos, const int* __restrict__ off, int* rowa) {
    const int a = blockIdx.x * 256 + threadIdx.x;
    rowa[off[tope[a]] + apos[a]] = a;
}
template <int MODE>
__global__ void __launch_bounds__(256) egemm(const float* __restrict__ X, const float* __restrict__ W0, const float* __restrict__ W1, const int* __restrict__ off, const int* __restrict__ toff, const int* __restrict__ rowa,
                                            const float* __restrict__ topw, float* out) {
    __shared__ float As[16][68], Bs[16][68], Cs[16][68];
    __shared__ int se;
    const int tile = blockIdx.y;
    if (tile >= toff[256]) return;
    const int tid = threadIdx.x, tx = tid & 15, ty = tid >> 4;
    if (tid == 0) { int lo = 0, hi = 255; while (lo < hi) { const int mid = (lo + hi + 1) >> 1; if (toff[mid] <= tile) lo = mid; else hi = mid - 1; } se = lo; }
    __syncthreads();
    const int e = se, r0 = off[e] + (tile - toff[e]) * 64, rend = off[e + 1];
    constexpr int K = MODE == 0 ? DM : DE, N = MODE == 0 ? DE : DM;
    const int n0 = blockIdx.x * 64;
    const float* B0 = W0 + (size_t)e * K * N; const float* B1 = MODE == 0 ? W1 + (size_t)e * K * N : nullptr;
    const int ar = tid >> 2, ak = (tid & 3) * 4, bk = tid >> 4, bn = (tid & 15) * 4;
    const int arow = r0 + ar; const bool aval = arow < rend;
    const float* ap = nullptr;
    if (aval) ap = MODE == 0 ? X + (size_t)(rowa[arow] >> 3) * DM : X + (size_t)arow * DE;
    float acc[4][4], acu[4][4];
#pragma unroll
    for (int i = 0; i < 4; ++i)
#pragma unroll
        for (int j = 0; j < 4; ++j) { acc[i][j] = 0.f; acu[i][j] = 0.f; }
    for (int k0 = 0; k0 < K; k0 += 16) {
        float4 av = make_float4(0.f, 0.f, 0.f, 0.f);
        if (aval) av = *(const float4*)(ap + k0 + ak);
        const float4 bv = *(const float4*)(B0 + (size_t)(k0 + bk) * N + n0 + bn);
        float4 cv = make_float4(0.f, 0.f, 0.f, 0.f);
        if (MODE == 0) cv = *(const float4*)(B1 + (size_t)(k0 + bk) * N + n0 + bn);
        __syncthreads();
        As[ak + 0][ar] = av.x; As[ak + 1][ar] = av.y; As[ak + 2][ar] = av.z; As[ak + 3][ar] = av.w;
        *(float4*)&Bs[bk][bn] = bv; if (MODE == 0) *(float4*)&Cs[bk][bn] = cv;
        __syncthreads();
#pragma unroll
        for (int kk = 0; kk < 16; ++kk) {
            const float4 a = *(const float4*)&As[kk][ty * 4];
            const float4 b = *(const float4*)&Bs[kk][tx * 4];
            const float aa[4] = {a.x, a.y, a.z, a.w}, bb[4] = {b.x, b.y, b.z, b.w};
#pragma unroll
            for (int i = 0; i < 4; ++i)
#pragma unroll
                for (int j = 0; j < 4; ++j) acc[i][j] = fmaf(aa[i], bb[j], acc[i][j]);
            if (MODE == 0) { const float4 c = *(const float4*)&Cs[kk][tx * 4]; const float cc[4] = {c.x, c.y, c.z, c.w};
#pragma unroll
                for (int i = 0; i < 4; ++i)
#pragma unroll
                    for (int j = 0; j < 4; ++j) acu[i][j] = fmaf(aa[i], cc[j], acu[i][j]); }
        }
    }
#pragma unroll
    for (int i = 0; i < 4; ++i) { const int r = r0 + ty * 4 + i; if (r < rend) {
        if (MODE == 0) {
#pragma unroll
            for (int j = 0; j < 4; ++j) { const float g = acc[i][j]; out[(size_t)r * DE + n0 + tx * 4 + j] = g / (1.f + expf(-g)) * acu[i][j]; } }
        else { const int a = rowa[r]; const float w = topw[a];
#pragma unroll
            for (int j = 0; j < 4; ++j) out[(size_t)a * DM + n0 + tx * 4 + j] = acc[i][j] * w; } } }
}
}


namespace fk {
#define LAS __attribute__((address_space(3)))
#define GAS __attribute__((address_space(1)))
typedef unsigned short bf16_t;
typedef short bf16x8 __attribute__((ext_vector_type(8)));
typedef float f32x4 __attribute__((ext_vector_type(4)));
typedef float f32x2 __attribute__((ext_vector_type(2)));
typedef float f32x16 __attribute__((ext_vector_type(16)));
typedef unsigned u32x4 __attribute__((ext_vector_type(4)));
typedef unsigned u32x2 __attribute__((ext_vector_type(2)));
constexpr int NWAVES = 8, NTHR = 512;
constexpr int INCP = 4352;
constexpr float LOG2E = 1.4426950408889634f;
constexpr float QS_A = 0.125f * LOG2E;
constexpr float QS_B = 0.10206207261596577f * LOG2E;
#define LDS_WAIT() asm volatile("s_waitcnt lgkmcnt(0)" ::: "memory")
#define VM_WAIT() asm volatile("s_waitcnt vmcnt(0)" ::: "memory")
__device__ __forceinline__ unsigned f2bf(float f) { unsigned u = __builtin_bit_cast(unsigned, f); return (u + 0x7fffu + ((u >> 16) & 1u)) >> 16; }
__device__ __forceinline__ unsigned pk2(float lo, float hi) { return f2bf(lo) | (f2bf(hi) << 16); }
__device__ __forceinline__ float bf2f(unsigned short b) { return __builtin_bit_cast(float, (unsigned)b << 16); }
__device__ __forceinline__ float bflo(unsigned w) { return __builtin_bit_cast(float, w << 16); }
__device__ __forceinline__ float bfhi(unsigned w) { return __builtin_bit_cast(float, w & 0xffff0000u); }
__device__ __forceinline__ float sigmoidf_(float x) { return __builtin_amdgcn_rcpf(1.f + __expf(-x)); }
__device__ __forceinline__ float wave_sum(float v) {
#pragma unroll
    for (int o = 1; o < 64; o <<= 1) v += __shfl_xor(v, o);
    return v;
}

namespace pg8 {
constexpr int BM = 256, BK = 64, HALF = 128, HTB = HALF * BK * 2, STAGE_BYTES = 8 * HTB, NXCD = 8, WGM = 8;
__host__ __device__ __forceinline__ int lds_byte(int r, int c) { const int st = (r >> 4) * 2 + (c >> 5), rr = r & 15, cc = c & 31, ob = rr * 64 + cc * 2; return st * 1024 + (ob ^ (((ob >> 9) & 1) << 5)); }
__host__ __device__ __forceinline__ void stage_rc(int b, int& R, int& C) { const int st = b / 1024, sb = b % 1024, swz = sb ^ (((sb >> 9) & 1) << 5); R = (st >> 1) * 16 + swz / 64; C = (st & 1) * 32 + (swz % 64) / 2; }
__host__ __device__ __forceinline__ int perm32(int rho) { const int n = rho >> 4, i = rho & 15; return 8 * (i >> 2) + 4 * n + (i & 3); }

struct Unit { int pm, pn, e, r0, rend; };
struct Gemm { const bf16_t* A; const bf16_t* Bt; int M, N, K, lda, ldb; };

struct StaticOrder {
    int nM, nN, nwg, G, c;
    __device__ void init(int M, int N, int G_, int c_) { nM = M / BM; nN = N / BM; nwg = nM * nN; G = G_; c = c_; }
    __device__ bool next(int i, Unit& u) const {
        const long L = (long)i * G + c; if (L >= nwg) return false;
        int wgid = (int)L; { const int q = nwg / NXCD, r = nwg % NXCD, xcd = wgid % NXCD, off = wgid / NXCD; wgid = (xcd < r ? xcd * (q + 1) : r * (q + 1) + (xcd - r) * q) + off; }
        const int nig = WGM * nN, gid = wgid / nig, fm = gid * WGM, gsz = (nM - fm) < WGM ? (nM - fm) : WGM;
        u.pm = fm + ((wgid % nig) % gsz); u.pn = (wgid % nig) / gsz; u.e = 0; u.r0 = u.pm * BM; u.rend = u.r0 + BM; return true;
    }
    __device__ __forceinline__ int a_row(const Unit& u, int r) const { return u.pm * BM + r; }
    __device__ __forceinline__ const char* b_ptr(const Gemm& g, const Unit& u) const { return (const char*)g.Bt + (size_t)u.pn * BM * g.ldb * 2; }
};

__device__ __forceinline__ unsigned cvt_pk_bf16(float lo, float hi) { unsigned r; asm volatile("v_cvt_pk_bf16_f32 %0, %1, %2" : "=v"(r) : "v"(lo), "v"(hi)); return r; }

template <class Epi, class Sched, bool ALIGN_EPI>
__device__ __forceinline__ void gemm_phase(LAS unsigned char* lds, const Gemm g, const Sched& S, const Epi& E) {
    int tid_ = threadIdx.x; asm volatile("" : "+v"(tid_));
    const int tid = tid_, wid = __builtin_amdgcn_readfirstlane(tid >> 6), lane = tid & 63, wr = wid >> 2, wc = wid & 3, fr = lane & 15, fq = lane >> 4;
    const int K = g.K, nt = K / BK;
    int RA[2]; unsigned CA[2], voffB[2];
#pragma unroll
    for (int i = 0; i < 2; ++i) { int R, C; stage_rc(tid * 16 + i * 8192, R, C); const int Rb = (R & ~31) + perm32(R & 31);
        RA[i] = R; CA[i] = (unsigned)C * 2u; voffB[i] = (unsigned)(Rb * g.ldb + C) * 2u; }
    const unsigned lda2 = (unsigned)g.lda * 2u;
    const size_t hstepB = (size_t)HALF * g.ldb * 2;
    const unsigned ldsw = (unsigned)wid * 1024u;
    const int aoff = lds_byte(wr * 64 + fr, fq * 8), boff = lds_byte(wc * 32 + fr, fq * 8);
    const char* const Abase = (const char*)g.A;
#define PG8_SA(b, h) (((b) * 2 + (h)) * HTB)
#define PG8_SB(b, h) ((4 + (b) * 2 + (h)) * HTB)
#define PG8_STAGE_B(bufoff, gbase) do { _Pragma("unroll") for (int _i = 0; _i < 2; ++_i) \
        __builtin_amdgcn_global_load_lds((const unsigned*)((const char*)(gbase) + voffB[_i]), (LAS unsigned*)(lds + (bufoff) + ldsw + _i * 8192), 16, 0, 0); } while (0)
#define PG8_STAGE_A(bufoff, V0, V1, kb) do { \
        __builtin_amdgcn_global_load_lds((const unsigned*)((Abase + (kb)) + (V0)), (LAS unsigned*)(lds + (bufoff) + ldsw), 16, 0, 0); \
        __builtin_amdgcn_global_load_lds((const unsigned*)((Abase + (kb)) + (V1)), (LAS unsigned*)(lds + (bufoff) + ldsw + 8192), 16, 0, 0); } while (0)
#define PG8_LDA(dst, b, h) do { _Pragma("unroll") for (int m = 0; m < 4; ++m) _Pragma("unroll") for (int k = 0; k < 2; ++k) dst[m][k] = *(const LAS bf16x8*)(lds + PG8_SA(b, h) + aoff + m * 2048 + k * 1024); } while (0)
#define PG8_LDB(dst, b, h) do { _Pragma("unroll") for (int n = 0; n < 2; ++n) _Pragma("unroll") for (int k = 0; k < 2; ++k) dst[n][k] = *(const LAS bf16x8*)(lds + PG8_SB(b, h) + boff + n * 2048 + k * 1024); } while (0)
#define PG8_MMA(ai, bj, At, Bt) do { __builtin_amdgcn_s_setprio(1); _Pragma("unroll") for (int m = 0; m < 4; ++m) _Pragma("unroll") for (int n = 0; n < 2; ++n) _Pragma("unroll") for (int k = 0; k < 2; ++k) \
        acc[ai][bj][m][n] = __builtin_amdgcn_mfma_f32_16x16x32_bf16(Bt[n][k], At[m][k], acc[ai][bj][m][n], 0, 0, 0); __builtin_amdgcn_s_setprio(0); } while (0)
#define PG8_WAIT_V(n) asm volatile("s_waitcnt vmcnt(" #n ")" ::: "memory")
#define PG8_WAIT_L(n) asm volatile("s_waitcnt lgkmcnt(" #n ")" ::: "memory")
#define PG8_BAR __builtin_amdgcn_s_barrier()
#define PG8_SCHED __builtin_amdgcn_sched_barrier(0)
#define PG8_VOFF(V, U) do { V##00 = (unsigned)S.a_row(U, RA[0]) * lda2 + CA[0]; V##01 = (unsigned)S.a_row(U, RA[1]) * lda2 + CA[1]; \
        V##10 = (unsigned)S.a_row(U, HALF + RA[0]) * lda2 + CA[0]; V##11 = (unsigned)S.a_row(U, HALF + RA[1]) * lda2 + CA[1]; } while (0)
    Unit cur, nxt; int ui = 0;
    if (!S.next(0, cur)) return;
    f32x4 acc[2][2][4][2];
#pragma unroll
    for (int a = 0; a < 2; ++a)
#pragma unroll
        for (int b = 0; b < 2; ++b)
#pragma unroll
            for (int m = 0; m < 4; ++m)
#pragma unroll
                for (int n = 0; n < 2; ++n) acc[a][b][m][n] = (f32x4){0.f, 0.f, 0.f, 0.f};
    bf16x8 At[4][2], B0[2][2], B1[2][2];
    unsigned vc00, vc01, vc10, vc11;
    PG8_VOFF(vc, cur);
    const char* cB = S.b_ptr(g, cur);
    PG8_STAGE_B(PG8_SB(0, 0), cB); PG8_STAGE_B(PG8_SB(0, 1), cB + hstepB); PG8_STAGE_A(PG8_SA(0, 0), vc00, vc01, 0u); PG8_STAGE_A(PG8_SA(0, 1), vc10, vc11, 0u);
    if (wr == 1) PG8_BAR;
    PG8_WAIT_V(2); PG8_BAR;
    PG8_STAGE_B(PG8_SB(1, 0), cB + 128); PG8_STAGE_A(PG8_SA(1, 0), vc00, vc01, 128u); PG8_STAGE_B(PG8_SB(1, 1), cB + hstepB + 128);
    PG8_WAIT_V(6); PG8_BAR;
    for (;;) {
        const bool has_next = S.next(ui + 1, nxt);
        const char* nB = has_next ? S.b_ptr(g, nxt) : cB;
#pragma unroll 1
        for (int t = 0; t < nt; t += 2) {
            const bool last = (t == nt - 2);
            const unsigned kb1 = (unsigned)(t + 1) * 128u;
            unsigned kb2 = (unsigned)(t + 2) * 128u;
            unsigned s00 = vc00, s01 = vc01, s10 = vc10, s11 = vc11;
            const char* b2 = cB + (size_t)kb2;
            if (last) { kb2 = 0u; b2 = nB; if (has_next) { PG8_VOFF(s, nxt); } }
            const unsigned kb3 = kb2 + 128u; const char* b3 = b2 + 128;
            PG8_LDB(B0, 0, 0); PG8_LDB(B1, 0, 1); PG8_SCHED; PG8_LDA(At, 0, 0); PG8_STAGE_A(PG8_SA(1, 1), vc10, vc11, kb1);
            PG8_WAIT_V(8); PG8_WAIT_L(0); PG8_BAR; PG8_MMA(0, 0, At, B0); PG8_MMA(0, 1, At, B1); PG8_BAR; PG8_SCHED;
            PG8_LDA(At, 0, 1); PG8_STAGE_B(PG8_SB(0, 0), b2); PG8_STAGE_B(PG8_SB(0, 1), b2 + hstepB); PG8_STAGE_A(PG8_SA(0, 0), s00, s01, kb2);
            PG8_WAIT_V(8); PG8_WAIT_L(0); PG8_BAR; PG8_MMA(1, 0, At, B0); PG8_MMA(1, 1, At, B1); PG8_BAR; PG8_SCHED;
            PG8_LDB(B0, 1, 0); PG8_LDB(B1, 1, 1); PG8_SCHED; PG8_LDA(At, 1, 0); PG8_STAGE_A(PG8_SA(0, 1), s10, s11, kb2);
            PG8_WAIT_V(8); PG8_WAIT_L(0); PG8_BAR; PG8_MMA(0, 0, At, B0); PG8_MMA(0, 1, At, B1); PG8_BAR; PG8_SCHED;
            PG8_LDA(At, 1, 1); PG8_STAGE_B(PG8_SB(1, 0), b3); PG8_STAGE_B(PG8_SB(1, 1), b3 + hstepB); PG8_STAGE_A(PG8_SA(1, 0), s00, s01, kb3);
            PG8_WAIT_V(8); PG8_WAIT_L(0); PG8_BAR; PG8_MMA(1, 0, At, B0); PG8_MMA(1, 1, At, B1); PG8_BAR; PG8_SCHED;
        }
        if constexpr (ALIGN_EPI) { if (wr == 0) PG8_BAR; }
        E(acc, cur, wr, wc, fr, fq);
        if (!has_next) break;
#pragma unroll
        for (int a = 0; a < 2; ++a)
#pragma unroll
            for (int b = 0; b < 2; ++b)
#pragma unroll
                for (int m = 0; m < 4; ++m)
#pragma unroll
                    for (int n = 0; n < 2; ++n) acc[a][b][m][n] = (f32x4){0.f, 0.f, 0.f, 0.f};
        cur = nxt; cB = nB; PG8_VOFF(vc, cur); ++ui;
        if constexpr (ALIGN_EPI) { if (wr == 1) PG8_BAR; }
    }
    PG8_WAIT_V(0);
    if constexpr (!ALIGN_EPI) { if (wr == 0) PG8_BAR; }
    PG8_BAR;
#undef PG8_SA
#undef PG8_SB
#undef PG8_STAGE_A
#undef PG8_STAGE_B
#undef PG8_LDA
#undef PG8_LDB
#undef PG8_MMA
#undef PG8_WAIT_V
#undef PG8_WAIT_L
#undef PG8_BAR
#undef PG8_SCHED
#undef PG8_VOFF
}
#define PG8_TILE_BEGIN(acc, wr, wc, fr, fq) \
    _Pragma("unroll") for (int ai = 0; ai < 2; ++ai) _Pragma("unroll") for (int m = 0; m < 4; ++m) _Pragma("unroll") for (int bj = 0; bj < 2; ++bj) { \
        const int trow = ai * 128 + wr * 64 + m * 16 + fr, tcol = bj * 128 + wc * 32 + 8 * fq; f32x4 v0 = acc[ai][bj][m][0], v1 = acc[ai][bj][m][1];
#define PG8_TILE_END }
__device__ __forceinline__ u32x4 pack8(f32x4 v0, f32x4 v1) { u32x4 w; w.x = cvt_pk_bf16(v0[0], v0[1]); w.y = cvt_pk_bf16(v0[2], v0[3]); w.z = cvt_pk_bf16(v1[0], v1[1]); w.w = cvt_pk_bf16(v1[2], v1[3]); return w; }
}

#define XB_TMO      128
#define XB_XCNT(j)  (256  + 64 * (j))
#define XB_XSUB(j)  (1280 + 64 * (j))
#define XB_XGEN(j)  (2304 + 64 * (j))
#define XB_TOP      3328
#define XB_TOPGEN   3392
#define XCD_BAR_WORDS 3456
#define XB_SPIN_CAP (1u << 18)

__device__ __forceinline__ unsigned xb_ld(unsigned* p)              { return __hip_atomic_load(p, __ATOMIC_RELAXED, __HIP_MEMORY_SCOPE_AGENT); }
__device__ __forceinline__ unsigned xb_add(unsigned* p, unsigned v) { return __hip_atomic_fetch_add(p, v, __ATOMIC_RELAXED, __HIP_MEMORY_SCOPE_AGENT); }
__device__ __forceinline__ unsigned xb_xcc_id() { return (unsigned)__builtin_amdgcn_s_getreg((3 << 11) | 20) & 0xFu; }
#define XB_SPIN(cond, bar) do { unsigned _sp = 0; while (cond) { __builtin_amdgcn_s_sleep(1); \
    if ((++_sp & 255u) == 0u) { if (xb_ld(&(bar)[XB_TMO])) break; if (_sp > XB_SPIN_CAP) { atomicAdd(&(bar)[XB_TMO], 1u); break; } } } } while (0)

struct XcdBarrier {
    unsigned* bar; unsigned x;
    volatile LAS unsigned* st;
};

__device__ __forceinline__ XcdBarrier xcd_barrier_post(unsigned* bar, volatile LAS unsigned* st) {
    XcdBarrier b; b.bar = bar; b.x = xb_xcc_id(); b.st = st;
    if (threadIdx.x == 0) (void)xb_add(&bar[XB_XCNT(b.x)], 1u);
    return b;
}
__device__ __forceinline__ void xcd_barrier_complete(unsigned* bar, unsigned x, unsigned& nloc, unsigned& nx) {
    const unsigned G = gridDim.x * gridDim.y * gridDim.z;
    unsigned sum, cnt, mine, sp = 0u;
    for (;;) {
        sum = 0u; cnt = 0u; mine = 0u;
#pragma unroll
        for (unsigned j = 0; j < 16; ++j) { const unsigned c = xb_ld(&bar[XB_XCNT(j)]); sum += c; cnt += (c > 0u) ? 1u : 0u; mine = (j == x) ? c : mine; }
        if (sum == G) break;
        __builtin_amdgcn_s_sleep(1);
        if ((++sp & 255u) == 0u) { if (xb_ld(&bar[XB_TMO])) break; if (sp > XB_SPIN_CAP) { atomicAdd(&bar[XB_TMO], 1u); break; } }
    }
    nloc = mine > 0u ? mine : 1u; nx = cnt > 0u ? cnt : 1u;
}

__device__ __forceinline__ void xcd_barrier(const XcdBarrier& b) {
    asm volatile("s_waitcnt vmcnt(0)" ::: "memory");
    __syncthreads();
    if (threadIdx.x == 0) {
        unsigned* bar = b.bar; asm volatile("" : "+s"(bar));
        __builtin_amdgcn_s_waitcnt(0);
        unsigned nloc = b.st[0], nx = b.st[1];
        if (nloc == 0u) { xcd_barrier_complete(bar, b.x, nloc, nx); b.st[0] = nloc; b.st[1] = nx; }
        const unsigned old = xb_add(&bar[XB_XSUB(b.x)], 1u);
        const unsigned gen = old / nloc;
        if (old + 1u == (gen + 1u) * nloc) {
            __builtin_amdgcn_fence(__ATOMIC_RELEASE, "agent");
            asm volatile("s_waitcnt vmcnt(0)" ::: "memory");
            const unsigned og = xb_add(&bar[XB_TOP], 1u);
            const unsigned tg = og / nx;
            if (og + 1u == (tg + 1u) * nx) xb_add(&bar[XB_TOPGEN], 1u);
            else XB_SPIN(xb_ld(&bar[XB_TOPGEN]) == tg, bar);
            __builtin_amdgcn_fence(__ATOMIC_ACQUIRE, "agent");
            xb_add(&bar[XB_XGEN(b.x)], 1u);
            asm volatile("s_waitcnt vmcnt(0)" ::: "memory");
        } else {
            XB_SPIN(xb_ld(&bar[XB_XGEN(b.x)]) == gen, bar);
            __builtin_amdgcn_fence(__ATOMIC_ACQUIRE, "agent");
            asm volatile("s_waitcnt vmcnt(0)" ::: "memory");
        }
    }
    __syncthreads();
}


struct Params {
    const float* in[22]; float* out; unsigned char* ws;
    int ph_lo, ph_hi;
};
constexpr size_t MiB = 1u << 20;
constexpr size_t WS_CTL = 0, CTL_BYTES = 1 * MiB;
constexpr int CW_BAR = 4096;
constexpr int CW_CNT = 16384;
constexpr size_t WS_WIN = 2 * MiB;
constexpr size_t SZ_WIN = (size_t)INCP * DM;
constexpr size_t SZ_WUQ = (size_t)768 * QL, SZ_WUKV = (size_t)1024 * KVL;
constexpr size_t WS_WUQ = WS_WIN + 2 * SZ_WIN * 2;
constexpr size_t WS_WUKV = WS_WUQ + 2 * SZ_WUQ * 2;
constexpr size_t SZ_WP = (size_t)DM * 512, SZ_WOUT = (size_t)DM * DM;
constexpr size_t WS_WPA = WS_WUKV + 2 * SZ_WUKV * 2;
constexpr size_t WS_WPB = WS_WPA + 2 * SZ_WP * 2;
constexpr size_t WS_WOUT = WS_WPB + 2 * SZ_WP * 2;
constexpr size_t SZ_WRT = (size_t)NE * DM, SZ_WSGU = (size_t)512 * DM, SZ_WSD = (size_t)DM * DSH;
constexpr size_t WS_WRT = WS_WOUT + 2 * SZ_WOUT * 2;
constexpr size_t WS_WSGU = WS_WRT + 2 * SZ_WRT * 2;
constexpr size_t WS_WSD = WS_WSGU + 2 * SZ_WSGU * 2;
constexpr size_t WS_CS = WS_WSD + 2 * SZ_WSD * 2;
constexpr size_t WS_KM = WS_CS + (size_t)SEQ * 16 * 8;
constexpr size_t WS_SEL = WS_KM + (size_t)NB * HA * NBLK * 64 * 4;
constexpr size_t WS_XB = WS_SEL + (size_t)T * 8 * 4;
constexpr size_t WS_CQN = WS_XB + (size_t)T * DM * 2;
constexpr size_t WS_CKVN = WS_CQN + (size_t)T * QL * 2;
constexpr size_t WS_QB = WS_CKVN + (size_t)T * KVL * 2;
constexpr size_t WS_KB = WS_QB + (size_t)T * 768 * 2;
constexpr size_t WS_VB = WS_KB + (size_t)T * 768 * 2;
constexpr size_t WS_OAB = WS_VB + (size_t)T * 512 * 2;
constexpr size_t WS_TMP = WS_OAB + (size_t)T * 1024 * 2;
constexpr size_t WS_MRG = WS_TMP + (size_t)T * 1024 * 2;
constexpr size_t WS_PRE = WS_MRG + (size_t)T * 1024 * 2;
constexpr size_t WS_X1 = WS_PRE + (size_t)T * 1024 * 4;
constexpr size_t WS_X1B = WS_X1 + (size_t)T * 1024 * 4;
constexpr size_t WS_X2 = WS_X1B + (size_t)T * 1024 * 2;
constexpr size_t WS_LOG = WS_X2 + (size_t)T * 1024 * 4;
constexpr size_t WS_HS = WS_LOG + (size_t)T * NE * 4;
constexpr size_t WS_SH = WS_HS + (size_t)T * DSH * 2;
constexpr size_t WS_TOPE = WS_SH + (size_t)T * DM * 2;
constexpr size_t WS_TOPW = WS_TOPE + (size_t)NA * 4;
constexpr size_t WS_APOS = WS_TOPW + (size_t)NA * 4;
constexpr size_t WS_ROWA = WS_APOS + (size_t)NA * 4;
constexpr size_t WS_HIST = WS_ROWA + (size_t)NA * 8;
constexpr size_t WS_PO = WS_HIST + (size_t)1024 * 256 * 4;
constexpr size_t WS_PML = WS_PO + (size_t)T * 8 * 3 * 64 * 2;
constexpr size_t WS_HE = WS_PML + (size_t)T * 8 * 3 * 128;
constexpr size_t WS_Y = WS_HE + (size_t)NA * DE * 2;
constexpr size_t WS_PROJ = WS_Y + (size_t)NA * DM * 2;
constexpr size_t SZ_WEGU = (size_t)NE * 512 * DM, SZ_WED = (size_t)NE * DM * DE;
constexpr size_t WS_WEGU = WS_PROJ + (size_t)T * INCP * 2;
constexpr size_t WS_WED = WS_WEGU + 2 * SZ_WEGU * 2;
constexpr size_t WS_FAST_END = WS_WED + 2 * SZ_WED * 2;
constexpr size_t WS_NEED = WS_FAST_END;
static_assert(WS_NEED <= (size_t)2040 * MiB, "ws map");

constexpr int LDS_BYTES = 147456;
constexpr int RING_BYTES = 131072, MISC_OFF = RING_BYTES + 1024, TAB_OFF = RING_BYTES + 2048;

struct Frame { LAS unsigned char* lds; int tid, lane, wave, G, vcu; };

template <class RowMap>
__device__ __forceinline__ void transpose_item(const float* W, int K, int N, bf16_t* WT, int ldk, RowMap rm, LAS float* scr, int item, int lane) {
    const int nblk = N / 32, kb = item / nblk, nb = item % nblk, k0 = 64 * kb, n0 = 32 * nb;
#pragma unroll 8
    for (int i = 0; i < 32; ++i) { const int kk = 2 * i + (lane >> 5); scr[kk * 33 + (lane & 31)] = W[(size_t)(k0 + kk) * N + n0 + (lane & 31)]; }
    LDS_WAIT(); asm volatile("" ::: "memory");
    const int c = lane & 7;
#pragma unroll
    for (int j = 0; j < 4; ++j) { const int n = (lane >> 3) + 8 * j; const LAS float* s = scr + (8 * c) * 33 + n;
        u32x4 o; o.x = pk2(s[0 * 33], s[1 * 33]); o.y = pk2(s[2 * 33], s[3 * 33]); o.z = pk2(s[4 * 33], s[5 * 33]); o.w = pk2(s[6 * 33], s[7 * 33]);
        *(u32x4*)(WT + (size_t)rm(n0 + n) * ldk + k0 + 8 * c) = o; }
    LDS_WAIT(); asm volatile("" ::: "memory");
}
struct RowId { __device__ __forceinline__ int operator()(int n) const { return n; } };

struct EpiProj {
    bf16_t* O; const float* bg;
    __device__ __forceinline__ void operator()(const f32x4 (&acc)[2][2][4][2], const pg8::Unit& u, int wr, int wc, int fr, int fq) const {
        PG8_TILE_BEGIN(acc, wr, wc, fr, fq)
            const int row = u.pm * 256 + trow, col = u.pn * 256 + tcol;
            if (col < C_KA) { v0 = v0 * QS_A; v1 = v1 * QS_A; }
            else if (col >= C_GA && col < INC) { const f32x4 b0 = *(const f32x4*)(bg + col - C_GA), b1 = *(const f32x4*)(bg + col - C_GA + 4);
#pragma unroll
                for (int i = 0; i < 4; ++i) { v0[i] = sigmoidf_(v0[i] + b0[i]); v1[i] = sigmoidf_(v1[i] + b1[i]); } }
            *(u32x4*)(O + (size_t)row * INCP + col) = pg8::pack8(v0, v1);
        PG8_TILE_END
    }
};

struct RowQ { __device__ __forceinline__ int operator()(int n) const { const int h = n / 96, d = n % 96; if (d < 64) return n; const int i = d - 64; return h * 96 + 64 + (i < 16 ? 2 * i : 2 * (i - 16) + 1); } };

struct EpiQ {
    bf16_t* O; const f32x2* CS;
    __device__ __forceinline__ void operator()(const f32x4 (&acc)[2][2][4][2], const pg8::Unit& u, int wr, int wc, int fr, int fq) const {
        PG8_TILE_BEGIN(acc, wr, wc, fr, fq)
            const int row = u.pm * 256 + trow, col = u.pn * 256 + tcol, d = col % 96;
            if (d >= 64) { const int pos = row % SEQ, i0 = (d - 64) >> 1; const f32x2* cs = CS + (size_t)pos * 16 + i0;
                const f32x2 c0 = cs[0], c1 = cs[1], c2 = cs[2], c3 = cs[3];
                const f32x4 a = v0, b = v1;
                v0[0] = a[0] * c0[0] - a[1] * c0[1]; v0[1] = a[1] * c0[0] + a[0] * c0[1]; v0[2] = a[2] * c1[0] - a[3] * c1[1]; v0[3] = a[3] * c1[0] + a[2] * c1[1];
                v1[0] = b[0] * c2[0] - b[1] * c2[1]; v1[1] = b[1] * c2[0] + b[0] * c2[1]; v1[2] = b[2] * c3[0] - b[3] * c3[1]; v1[3] = b[3] * c3[0] + b[2] * c3[1]; }
            v0 = v0 * QS_B; v1 = v1 * QS_B;
            *(u32x4*)(O + (size_t)row * 768 + col) = pg8::pack8(v0, v1);
        PG8_TILE_END
    }
};
struct EpiKV {
    bf16_t* KB; bf16_t* VB;
    __device__ __forceinline__ void operator()(const f32x4 (&acc)[2][2][4][2], const pg8::Unit& u, int wr, int wc, int fr, int fq) const {
        PG8_TILE_BEGIN(acc, wr, wc, fr, fq)
            const int row = u.pm * 256 + trow, col = u.pn * 256 + tcol, h = col >> 7, j = col & 127;
            bf16_t* dst = (j < 64) ? KB + (size_t)row * 768 + h * 96 + j : VB + (size_t)row * 512 + h * 64 + (j - 64);
            *(u32x4*)dst = pg8::pack8(v0, v1);
        PG8_TILE_END
    }
};

__device__ __forceinline__ void prep_phase(const Frame& F, const bf16_t* PROJ, const float* qn, const float* kvn, const f32x2* CS, bf16_t* CQN, bf16_t* CKVN, bf16_t* KB, float* KM) {
    int lane_ = F.lane; asm volatile("" : "+v"(lane_));
    const int gw = F.vcu * NWAVES + F.wave, NGW = F.G * NWAVES, lane = lane_;
    for (int row = gw; row < T; row += NGW) {
        const bf16_t* p = PROJ + (size_t)row * INCP;
        u32x4 a = (u32x4){0u, 0u, 0u, 0u}, b = (u32x4){0u, 0u, 0u, 0u};
        if (lane < 48) a = *(const u32x4*)(p + C_CQ + lane * 8);
        if (lane < 32) b = *(const u32x4*)(p + C_CKV + lane * 8);
        float sq = 0.f, sk = 0.f;
#pragma unroll
        for (int i = 0; i < 4; ++i) { const float x = bflo(a[i]), y = bfhi(a[i]), z = bflo(b[i]), w = bfhi(b[i]); sq += x * x + y * y; sk += z * z + w * w; }
        sq = wave_sum(sq); sk = wave_sum(sk);
        const float rq = rsqrtf(sq * (1.f / QL) + RMS_EPS), rk = rsqrtf(sk * (1.f / KVL) + RMS_EPS);
        if (lane < 48) { const f32x4 g0 = *(const f32x4*)(qn + lane * 8), g1 = *(const f32x4*)(qn + lane * 8 + 4); u32x4 o;
            o.x = pk2(bflo(a.x) * rq * g0[0], bfhi(a.x) * rq * g0[1]); o.y = pk2(bflo(a.y) * rq * g0[2], bfhi(a.y) * rq * g0[3]);
            o.z = pk2(bflo(a.z) * rq * g1[0], bfhi(a.z) * rq * g1[1]); o.w = pk2(bflo(a.w) * rq * g1[2], bfhi(a.w) * rq * g1[3]);
            *(u32x4*)(CQN + (size_t)row * QL + lane * 8) = o; }
        if (lane < 32) { const f32x4 g0 = *(const f32x4*)(kvn + lane * 8), g1 = *(const f32x4*)(kvn + lane * 8 + 4); u32x4 o;
            o.x = pk2(bflo(b.x) * rk * g0[0], bfhi(b.x) * rk * g0[1]); o.y = pk2(bflo(b.y) * rk * g0[2], bfhi(b.y) * rk * g0[3]);
            o.z = pk2(bflo(b.z) * rk * g1[0], bfhi(b.z) * rk * g1[1]); o.w = pk2(bflo(b.w) * rk * g1[2], bfhi(b.w) * rk * g1[3]);
            *(u32x4*)(CKVN + (size_t)row * KVL + lane * 8) = o; }
        if (lane < 16) { const float x1 = bf2f(p[C_KR + lane]), x2 = bf2f(p[C_KR + 16 + lane]); const f32x2 cs = CS[(size_t)(row % SEQ) * 16 + lane];
            const unsigned w = pk2(x1 * cs[0] - x2 * cs[1], x2 * cs[0] + x1 * cs[1]);
#pragma unroll
            for (int h = 0; h < 8; ++h) *(unsigned*)(KB + (size_t)row * 768 + h * 96 + 64 + 2 * lane) = w; }
    }
    for (int it = gw; it < NB * NBLK * HA; it += NGW) {
        const int h = it % HA, blk = (it / HA) % NBLK, b = it / (HA * NBLK), c = lane & 7, r0 = lane >> 3;
        const bf16_t* p = PROJ + ((size_t)b * SEQ + (size_t)blk * BLK + r0) * INCP + C_KA + h * 64 + c * 8;
        float s[8];
#pragma unroll
        for (int i = 0; i < 8; ++i) s[i] = 0.f;
        for (int i = 0; i < 32; ++i) { const u32x4 v = *(const u32x4*)(p + (size_t)i * 8 * INCP);
#pragma unroll
            for (int k = 0; k < 4; ++k) { s[2 * k] += bflo(v[k]); s[2 * k + 1] += bfhi(v[k]); } }
#pragma unroll
        for (int i = 0; i < 8; ++i) { s[i] += __shfl_xor(s[i], 8); s[i] += __shfl_xor(s[i], 16); s[i] += __shfl_xor(s[i], 32); }
        if (lane < 8) { float* o = KM + ((size_t)(b * HA + h) * NBLK + blk) * 64 + c * 8;
            *(f32x4*)o = (f32x4){s[0], s[1], s[2], s[3]} * (1.f / BLK); *(f32x4*)(o + 4) = (f32x4){s[4], s[5], s[6], s[7]} * (1.f / BLK); }
    }
}
__device__ __forceinline__ void mobasel_phase(const Frame& F, const bf16_t* PROJ, const float* KM, unsigned* SEL) {
    int tid_ = F.tid; asm volatile("" : "+v"(tid_));
    const int TPW = T / F.G, row0 = (int)blockIdx.x * TPW, b = row0 / SEQ, own = (row0 % SEQ) / BLK, hs = own * 64 + 4;
    LAS float* km = (LAS float*)F.lds;
    for (int i = tid_; i < 8 * own * 16; i += NTHR) { const int h = i / (own * 16), r = i % (own * 16);
        *(LAS f32x4*)(km + h * hs + r * 4) = *(const f32x4*)(KM + ((size_t)(b * HA + h) * NBLK) * 64 + r * 4); }
    __syncthreads();
    for (int idx = tid_; idx < TPW * 8; idx += NTHR) {
        const int h = idx & 7, row = row0 + (idx >> 3);
        const bf16_t* qp = PROJ + (size_t)row * INCP + C_QA + h * 64;
        float q[64];
#pragma unroll
        for (int i = 0; i < 8; ++i) { const u32x4 v = *(const u32x4*)(qp + i * 8);
#pragma unroll
            for (int k = 0; k < 4; ++k) { q[i * 8 + 2 * k] = bflo(v[k]); q[i * 8 + 2 * k + 1] = bfhi(v[k]); } }
        float v1 = -INFINITY, v2 = -INFINITY, v3 = -INFINITY; int i1 = -1, i2 = -1, i3 = -1;
        for (int j = 0; j < own; ++j) {
            const LAS f32x4* kp = (const LAS f32x4*)(km + h * hs + j * 64);
            float g0 = 0.f, g1 = 0.f, g2 = 0.f, g3 = 0.f;
#pragma unroll
            for (int c = 0; c < 16; ++c) { const f32x4 k4 = kp[c]; g0 = fmaf(q[4 * c], k4[0], g0); g1 = fmaf(q[4 * c + 1], k4[1], g1); g2 = fmaf(q[4 * c + 2], k4[2], g2); g3 = fmaf(q[4 * c + 3], k4[3], g3); }
            const float g = (g0 + g1) + (g2 + g3);
            if (g > v1) { v3 = v2; i3 = i2; v2 = v1; i2 = i1; v1 = g; i1 = j; }
            else if (g > v2) { v3 = v2; i3 = i2; v2 = g; i2 = j; }
            else if (g > v3) { v3 = g; i3 = j; }
        }
        unsigned m = 0;
        if (i1 >= 0) m |= 1u << i1;
        if (i2 >= 0) m |= 1u << i2;
        if (i3 >= 0) m |= 1u << i3;
        SEL[(size_t)row * 8 + h] = m;
    }
    __syncthreads();
}

template <bool SECOND>
struct EpiGate {
    const bf16_t* PROJ; bf16_t* TMP; bf16_t* MRG;
    __device__ __forceinline__ void operator()(const f32x4 (&acc)[2][2][4][2], const pg8::Unit& u, int wr, int wc, int fr, int fq) const {
        PG8_TILE_BEGIN(acc, wr, wc, fr, fq)
            const int row = u.pm * 256 + trow, col = u.pn * 256 + tcol;
            const u32x4 g = *(const u32x4*)(PROJ + (size_t)row * INCP + (SECOND ? C_GB : C_GA) + col);
            v0[0] *= bflo(g.x); v0[1] *= bfhi(g.x); v0[2] *= bflo(g.y); v0[3] *= bfhi(g.y); v1[0] *= bflo(g.z); v1[1] *= bfhi(g.z); v1[2] *= bflo(g.w); v1[3] *= bfhi(g.w);
            if (SECOND) { const u32x4 t = *(const u32x4*)(TMP + (size_t)row * DM + col);
                v0[0] += bflo(t.x); v0[1] += bfhi(t.x); v0[2] += bflo(t.y); v0[3] += bfhi(t.y); v1[0] += bflo(t.z); v1[1] += bfhi(t.z); v1[2] += bflo(t.w); v1[3] += bfhi(t.w);
                *(u32x4*)(MRG + (size_t)row * DM + col) = pg8::pack8(v0, v1); }
            else *(u32x4*)(TMP + (size_t)row * DM + col) = pg8::pack8(v0, v1);
        PG8_TILE_END
    }
};
struct EpiResid {
    const float* X; float* PRE;
    __device__ __forceinline__ void operator()(const f32x4 (&acc)[2][2][4][2], const pg8::Unit& u, int wr, int wc, int fr, int fq) const {
        PG8_TILE_BEGIN(acc, wr, wc, fr, fq)
            const size_t o = (size_t)(u.pm * 256 + trow) * DM + u.pn * 256 + tcol;
            const f32x4 x0 = *(const f32x4*)(X + o), x1 = *(const f32x4*)(X + o + 4);
            *(f32x4*)(PRE + o) = x0 * ALPHA + v0; *(f32x4*)(PRE + o + 4) = x1 * ALPHA + v1;
        PG8_TILE_END
    }
};
__device__ __forceinline__ void ln_phase(const Frame& F, const float* PRE, const float* g, const float* bt, float* X, bf16_t* XBo) {
    int lane_ = F.lane; asm volatile("" : "+v"(lane_));
    const int gw = F.vcu * NWAVES + F.wave, NGW = F.G * NWAVES, lane = lane_;
    for (int row = gw; row < T; row += NGW) {
        const f32x4* pr = (const f32x4*)(PRE + (size_t)row * DM) + lane;
        f32x4 v[4]; float s = 0.f;
#pragma unroll
        for (int j = 0; j < 4; ++j) { v[j] = pr[64 * j]; s += (v[j][0] + v[j][1]) + (v[j][2] + v[j][3]); }
        const float mean = wave_sum(s) * (1.f / DM); float s2 = 0.f;
#pragma unroll
        for (int j = 0; j < 4; ++j) { v[j] = v[j] - mean; s2 += (v[j][0] * v[j][0] + v[j][1] * v[j][1]) + (v[j][2] * v[j][2] + v[j][3] * v[j][3]); }
        const float rstd = rsqrtf(wave_sum(s2) * (1.f / DM) + LN_EPS);
#pragma unroll
        for (int j = 0; j < 4; ++j) { const f32x4 gg = ((const f32x4*)g)[lane + 64 * j], bb = ((const f32x4*)bt)[lane + 64 * j];
            const f32x4 y = v[j] * rstd * gg + bb;
            ((f32x4*)(X + (size_t)row * DM))[lane + 64 * j] = y;
            if (XBo) { u32x2 w; w.x = pk2(y[0], y[1]); w.y = pk2(y[2], y[3]); ((u32x2*)(XBo + (size_t)row * DM))[lane + 64 * j] = w; } }
    }
}

struct RowGU { int off; __device__ __forceinline__ int operator()(int n) const { return 256 * (n >> 7) + off + (n & 127); } };

struct EpiF32 {
    float* O; int ld;
    __device__ __forceinline__ void operator()(const f32x4 (&acc)[2][2][4][2], const pg8::Unit& u, int wr, int wc, int fr, int fq) const {
        PG8_TILE_BEGIN(acc, wr, wc, fr, fq)
            float* o = O + (size_t)(u.pm * 256 + trow) * ld + u.pn * 256 + tcol; *(f32x4*)o = v0; *(f32x4*)(o + 4) = v1;
        PG8_TILE_END
    }
};
struct EpiBf16 {
    bf16_t* O; int ld;
    __device__ __forceinline__ void operator()(const f32x4 (&acc)[2][2][4][2], const pg8::Unit& u, int wr, int wc, int fr, int fq) const {
        PG8_TILE_BEGIN(acc, wr, wc, fr, fq)
            *(u32x4*)(O + (size_t)(u.pm * 256 + trow) * ld + u.pn * 256 + tcol) = pg8::pack8(v0, v1);
        PG8_TILE_END
    }
};
__device__ __forceinline__ float silu_mul(float g, float u) { return g * __builtin_amdgcn_rcpf(1.f + __expf(-g)) * u; }
struct EpiSwiGLU {
    bf16_t* H; int ld;
    __device__ __forceinline__ void operator()(const f32x4 (&acc)[2][2][4][2], const pg8::Unit& u, int wr, int wc, int fr, int fq) const {
#pragma unroll
        for (int ai = 0; ai < 2; ++ai)
#pragma unroll
            for (int m = 0; m < 4; ++m) { const int row = u.r0 + ai * 128 + wr * 64 + m * 16 + fr;
                if (row < u.rend) { f32x4 h0, h1;
#pragma unroll
                    for (int i = 0; i < 4; ++i) { h0[i] = silu_mul(acc[ai][0][m][0][i], acc[ai][1][m][0][i]); h1[i] = silu_mul(acc[ai][0][m][1][i], acc[ai][1][m][1][i]); }
                    *(u32x4*)(H + (size_t)row * ld + 128 * u.pn + wc * 32 + 8 * fq) = pg8::pack8(h0, h1); } }
    }
};
struct EpiExpDown {
    bf16_t* Y; const int* ROWA;
    __device__ __forceinline__ void operator()(const f32x4 (&acc)[2][2][4][2], const pg8::Unit& u, int wr, int wc, int fr, int fq) const {
        u32x2 aw[2][4];
#pragma unroll
        for (int ai = 0; ai < 2; ++ai)
#pragma unroll
            for (int m = 0; m < 4; ++m) { const int row = min(u.r0 + ai * 128 + wr * 64 + m * 16 + fr, u.rend - 1); aw[ai][m] = *(const u32x2*)(ROWA + 2 * (size_t)row); }
#pragma unroll
        for (int ai = 0; ai < 2; ++ai)
#pragma unroll
            for (int m = 0; m < 4; ++m) { const int row = u.r0 + ai * 128 + wr * 64 + m * 16 + fr;
                if (row < u.rend) { const int a = (int)aw[ai][m].x; const float w = __uint_as_float(aw[ai][m].y);
#pragma unroll
                    for (int bj = 0; bj < 2; ++bj) *(u32x4*)(Y + (size_t)a * DM + 256 * u.pn + bj * 128 + wc * 32 + 8 * fq) = pg8::pack8(acc[ai][bj][m][0] * w, acc[ai][bj][m][1] * w); } }
    }
};
template <int NPN, bool GATHER>
struct ExpertOrder {
    const LAS int* off; const LAS int* toff; const int* rowa; int G, c; size_t strideE;
    __device__ __forceinline__ bool next(int i, pg8::Unit& u) const {
        const int L = i * G + c; if (L >= toff[256] * NPN) return false;
        const int tile = L / NPN; u.pn = L % NPN; int lo = 0, hi = 255;
        while (lo < hi) { const int mid = (lo + hi + 1) >> 1; if (toff[mid] <= tile) lo = mid; else hi = mid - 1; }
        u.e = lo; u.r0 = off[lo] + (tile - toff[lo]) * 256; u.rend = off[lo + 1]; u.pm = 0; return true;
    }
    __device__ __forceinline__ int a_row(const pg8::Unit& u, int r) const { const int rr = min(u.r0 + r, u.rend - 1); return GATHER ? (rowa[2 * rr] >> 3) : rr; }
    __device__ __forceinline__ const char* b_ptr(const pg8::Gemm& g, const pg8::Unit& u) const { return (const char*)g.Bt + (size_t)u.e * strideE + (size_t)u.pn * 256 * g.ldb * 2; }
};
__device__ __forceinline__ void expert_tables(const Frame& F, const unsigned* cnt, LAS int* off, LAS int* toff) {
    if (F.tid < 256) { off[F.tid] = (int)cnt[F.tid]; }
    __syncthreads();
    if (F.tid == 0) { int a = 0, b = 0; for (int i = 0; i < 256; ++i) { const int c = off[i]; off[i] = a; toff[i] = b; a += c; b += (c + 255) >> 8; } off[256] = a; toff[256] = b; }
    __syncthreads();
}
__device__ __forceinline__ void route_phase(const Frame& F, const float* LOGITS, const float* rbias, int* TOPE, float* TOPW, int* APOS, int* HIST, LAS int* lcnt) {
    int lane_ = F.lane; asm volatile("" : "+v"(lane_));
    const int lane = lane_, TPW = T / F.G, t0 = (int)blockIdx.x * TPW;
    if (F.tid < 256) lcnt[F.tid] = 0;
    __syncthreads();
    const f32x4 rb = *(const f32x4*)(rbias + lane * 4);
    for (int t = t0 + F.wave; t < t0 + TPW; t += NWAVES) {
        const f32x4 lg = *(const f32x4*)(LOGITS + (size_t)t * NE + lane * 4);
        const float s0 = 1.f / (1.f + expf(-lg[0])), s1 = 1.f / (1.f + expf(-lg[1])), s2 = 1.f / (1.f + expf(-lg[2])), s3 = 1.f / (1.f + expf(-lg[3]));
        float c0 = s0 + rb[0], c1 = s1 + rb[1], c2 = s2 + rb[2], c3 = s3 + rb[3];
        float a = fmaxf(c0, c1), bq = fminf(c0, c1);
        { const float hi2 = fmaxf(c2, c3), lo2 = fminf(c2, c3); const float na = fmaxf(a, hi2), nb = fmaxf(fminf(a, hi2), fmaxf(bq, lo2)); a = na; bq = nb; }
#pragma unroll
        for (int o = 1; o < 8; o <<= 1) { const float oa = __shfl_xor(a, o), ob = __shfl_xor(bq, o); const float na = fmaxf(a, oa), nb = fmaxf(fminf(a, oa), fmaxf(bq, ob)); a = na; bq = nb; }
        const float gs = a + bq; const int grp = lane >> 3;
        int rank = 0;
#pragma unroll
        for (int j = 0; j < 8; ++j) { const float og = __shfl(gs, j * 8); rank += (og > gs || (og == gs && j < grp)) ? 1 : 0; }
        if (rank >= 4) { c0 = c1 = c2 = c3 = -INFINITY; }
        float wsum = 0.f, myw = 0.f; int mye = 0;
#pragma unroll
        for (int k = 0; k < TOPK; ++k) {
            float bv = c0; int bi = 0;
            if (c1 > bv) { bv = c1; bi = 1; }
            if (c2 > bv) { bv = c2; bi = 2; }
            if (c3 > bv) { bv = c3; bi = 3; }
            int be = lane * 4 + bi;
#pragma unroll
            for (int o = 1; o < 64; o <<= 1) { const float ov = __shfl_xor(bv, o); const int oe = __shfl_xor(be, o); if (ov > bv || (ov == bv && oe < be)) { bv = ov; be = oe; } }
            float sc = 0.f;
            if ((be >> 2) == lane) { const int b2 = be & 3; sc = b2 == 0 ? s0 : b2 == 1 ? s1 : b2 == 2 ? s2 : s3; if (b2 == 0) c0 = -INFINITY; else if (b2 == 1) c1 = -INFINITY; else if (b2 == 2) c2 = -INFINITY; else c3 = -INFINITY; }
            sc = __shfl(sc, be >> 2);
            wsum += sc;
            if (lane == k) { myw = sc; mye = be; }
        }
        if (lane < TOPK) { const int aidx = t * TOPK + lane; TOPE[aidx] = mye; TOPW[aidx] = myw / wsum * 2.5f; APOS[aidx] = __hip_atomic_fetch_add(lcnt + mye, 1, __ATOMIC_RELAXED, __HIP_MEMORY_SCOPE_WORKGROUP); }
    }
    __syncthreads();
    if (F.tid < 256) HIST[(size_t)blockIdx.x * 256 + F.tid] = lcnt[F.tid];
}
__device__ __forceinline__ void combine_phase(const Frame& F, const float* X1, const bf16_t* SH, const bf16_t* Y, const float* g, const float* bt, float* Xo, bf16_t* XBo) {
    int lane_ = F.lane; asm volatile("" : "+v"(lane_));
    const int gw = F.vcu * NWAVES + F.wave, NGW = F.G * NWAVES, lane = lane_;
    for (int row = gw; row < T; row += NGW) {
        f32x4 v[4]; float s = 0.f;
#pragma unroll
        for (int j = 0; j < 4; ++j) { v[j] = ((const f32x4*)(X1 + (size_t)row * DM))[lane + 64 * j] * ALPHA;
            const u32x2 h = ((const u32x2*)(SH + (size_t)row * DM))[lane + 64 * j]; v[j][0] += bflo(h.x); v[j][1] += bfhi(h.x); v[j][2] += bflo(h.y); v[j][3] += bfhi(h.y); }
#pragma unroll
        for (int k = 0; k < TOPK; ++k) { const u32x2* yr = (const u32x2*)(Y + ((size_t)row * TOPK + k) * DM);
#pragma unroll
            for (int j = 0; j < 4; ++j) { const u32x2 h = yr[lane + 64 * j]; v[j][0] += bflo(h.x); v[j][1] += bfhi(h.x); v[j][2] += bflo(h.y); v[j][3] += bfhi(h.y); } }
#pragma unroll
        for (int j = 0; j < 4; ++j) s += (v[j][0] + v[j][1]) + (v[j][2] + v[j][3]);
        const float mean = wave_sum(s) * (1.f / DM); float s2 = 0.f;
#pragma unroll
        for (int j = 0; j < 4; ++j) { v[j] = v[j] - mean; s2 += (v[j][0] * v[j][0] + v[j][1] * v[j][1]) + (v[j][2] * v[j][2] + v[j][3] * v[j][3]); }
        const float rstd = rsqrtf(wave_sum(s2) * (1.f / DM) + LN_EPS);
#pragma unroll
        for (int j = 0; j < 4; ++j) { const f32x4 gg = ((const f32x4*)g)[lane + 64 * j], bb = ((const f32x4*)bt)[lane + 64 * j];
            const f32x4 y = v[j] * rstd * gg + bb;
            ((f32x4*)(Xo + (size_t)row * DM))[lane + 64 * j] = y;
            if (XBo) { u32x2 w; w.x = pk2(y[0], y[1]); w.y = pk2(y[2], y[3]); ((u32x2*)(XBo + (size_t)row * DM))[lane + 64 * j] = w; } }
    }
}

__device__ __forceinline__ int crow(int r, int hi) { return (r & 3) + 8 * (r >> 2) + 4 * hi; }
typedef short s16x4 __attribute__((ext_vector_type(4)));
__device__ __forceinline__ s16x4 vtr(const LAS unsigned char* p) { return __builtin_bit_cast(s16x4, __builtin_amdgcn_ds_read_tr16_b64_v4i16((LAS s16x4*)p)); }
__device__ __forceinline__ float xhalf_max(float v) { auto rr = __builtin_amdgcn_permlane32_swap(__float_as_uint(v), __float_as_uint(v), false, false); return fmaxf(__uint_as_float(rr[0]), __uint_as_float(rr[1])); }
__device__ __forceinline__ float xhalf_sum(float v) { auto rr = __builtin_amdgcn_permlane32_swap(__float_as_uint(v), __float_as_uint(v), false, false); return __uint_as_float(rr[0]) + __uint_as_float(rr[1]); }

template <int DQK, bool MOBA>
__device__ __forceinline__ void attn_unit(LAS unsigned char* lds, int b, int h, int qb, const bf16_t* Qp, int ldq, const bf16_t* Kp, int ldk, const bf16_t* Vp, int ldv, bf16_t* Op, int ldo, const unsigned* SEL) {
    constexpr int NCH = DQK / 8, KBYTES = NCH * 1024, BUFB = KBYTES + 8192, ND0 = DQK / 16;
    int tid_ = threadIdx.x; asm volatile("" : "+v"(tid_));
    const int lane = tid_ & 63, r32 = lane & 31, hi = lane >> 5, wid = __builtin_amdgcn_readfirstlane(tid_ >> 6);
    const size_t rowbase = (size_t)b * SEQ; const int q0 = qb * 256, NT = 4 * (qb + 1), qrel = wid * 32 + r32;
    const bf16_t* ksrc = Kp + (rowbase + lane) * ldk + h * DQK;
    const bf16_t* vsrc = Vp + (rowbase + 16 * (wid & 3) + (lane >> 2)) * ldv + h * 64 + (wid >> 2) * 32 + (lane & 3) * 8;
#define ATT_ISSUE(t, buf) do { \
        for (int c_ = wid; c_ < NCH; c_ += 8) __builtin_amdgcn_global_load_lds((const unsigned*)(ksrc + (size_t)(t) * 64 * ldk + c_ * 8), (LAS unsigned*)(lds + (buf) * BUFB + c_ * 1024), 16, 0, 0); \
        __builtin_amdgcn_global_load_lds((const unsigned*)(vsrc + (size_t)(t) * 64 * ldv), (LAS unsigned*)(lds + (buf) * BUFB + KBYTES + wid * 1024), 16, 0, 0); } while (0)
    ATT_ISSUE(0, 0);
    bf16x8 qf[ND0];
    { const bf16_t* qrow = Qp + (rowbase + q0 + qrel) * ldq + h * DQK + hi * 8;
#pragma unroll
      for (int d0 = 0; d0 < ND0; ++d0) qf[d0] = *(const bf16x8*)(qrow + d0 * 16); }
    unsigned selmask = 0u; float slope2 = 0.f;
    if (MOBA) { selmask = SEL[(rowbase + q0 + qrel) * 8 + h]; slope2 = exp2f(-(float)(h + 1)) * LOG2E; }
    float m = -1e30f, l = 0.f;
    f32x16 o0, o1;
#pragma unroll
    for (int r = 0; r < 16; ++r) { o0[r] = 0.f; o1[r] = 0.f; }
    const int kfo = hi * 1024 + r32 * 16;
    const int vfo = KBYTES + ((lane >> 4) & 1) * 32 + (lane & 3) * 8 + (4 * hi + ((lane & 15) >> 2)) * 64;
    for (int t = 0; t < NT; ++t) {
        asm volatile("s_waitcnt vmcnt(0) lgkmcnt(0)\n\ts_barrier" ::: "memory");
        if (t + 1 < NT) ATT_ISSUE(t + 1, (t + 1) & 1);
        const LAS unsigned char* kb = lds + (t & 1) * BUFB;
        f32x16 p0, p1;
#pragma unroll
        for (int r = 0; r < 16; ++r) { p0[r] = 0.f; p1[r] = 0.f; }
#pragma unroll
        for (int d0 = 0; d0 < ND0; ++d0) {
            const bf16x8 a0 = *(const LAS bf16x8*)(kb + kfo + d0 * 2048), a1 = *(const LAS bf16x8*)(kb + kfo + d0 * 2048 + 512);
            p0 = __builtin_amdgcn_mfma_f32_32x32x16_bf16(a0, qf[d0], p0, 0, 0, 0);
            p1 = __builtin_amdgcn_mfma_f32_32x32x16_bf16(a1, qf[d0], p1, 0, 0, 0);
        }
        if (MOBA) {
            const int blk = t >> 2;
            const float bb = slope2 * (float)(64 * t + 4 * hi - (q0 + qrel));
#pragma unroll
            for (int r = 0; r < 16; ++r) { const float c = (float)((r & 3) + 8 * (r >> 2)); p0[r] += fmaf(slope2, c, bb); p1[r] += fmaf(slope2, c + 32.f, bb); }
            if (blk == qb) { const int kbs = 64 * (t & 3) + 4 * hi;
#pragma unroll
                for (int r = 0; r < 16; ++r) { const int kv = kbs + (r & 3) + 8 * (r >> 2); if (kv > qrel) p0[r] = -INFINITY; if (kv + 32 > qrel) p1[r] = -INFINITY; } }
            else if (((selmask >> blk) & 1u) == 0u) {
#pragma unroll
                for (int r = 0; r < 16; ++r) { p0[r] = -INFINITY; p1[r] = -INFINITY; } }
        } else if (t >= NT - 4) { const int kbs = 64 * (t - (NT - 4)) + 4 * hi;
#pragma unroll
            for (int r = 0; r < 16; ++r) { const int kv = kbs + (r & 3) + 8 * (r >> 2); if (kv > qrel) p0[r] = -INFINITY; if (kv + 32 > qrel) p1[r] = -INFINITY; } }
        float rm = fmaxf(p0[0], p1[0]);
#pragma unroll
        for (int r = 1; r < 16; ++r) rm = fmaxf(rm, fmaxf(p0[r], p1[r]));
        rm = xhalf_max(rm);
        const float mn = fmaxf(m, rm), alpha = __builtin_amdgcn_exp2f(m - mn);
        m = mn;
        float ls = 0.f;
#pragma unroll
        for (int r = 0; r < 16; ++r) { p0[r] = __builtin_amdgcn_exp2f(p0[r] - mn); p1[r] = __builtin_amdgcn_exp2f(p1[r] - mn); ls += p0[r] + p1[r]; }
        l = l * alpha + ls;
#pragma unroll
        for (int r = 0; r < 16; ++r) { o0[r] *= alpha; o1[r] *= alpha; }
        u32x4 pw0, pw1, pw2, pw3;
        pw0 = (u32x4){pg8::cvt_pk_bf16(p0[0], p0[1]), pg8::cvt_pk_bf16(p0[2], p0[3]), pg8::cvt_pk_bf16(p0[4], p0[5]), pg8::cvt_pk_bf16(p0[6], p0[7])};
        pw1 = (u32x4){pg8::cvt_pk_bf16(p0[8], p0[9]), pg8::cvt_pk_bf16(p0[10], p0[11]), pg8::cvt_pk_bf16(p0[12], p0[13]), pg8::cvt_pk_bf16(p0[14], p0[15])};
        pw2 = (u32x4){pg8::cvt_pk_bf16(p1[0], p1[1]), pg8::cvt_pk_bf16(p1[2], p1[3]), pg8::cvt_pk_bf16(p1[4], p1[5]), pg8::cvt_pk_bf16(p1[6], p1[7])};
        pw3 = (u32x4){pg8::cvt_pk_bf16(p1[8], p1[9]), pg8::cvt_pk_bf16(p1[10], p1[11]), pg8::cvt_pk_bf16(p1[12], p1[13]), pg8::cvt_pk_bf16(p1[14], p1[15])};
        const LAS unsigned char* vb = kb + vfo;
#define ATT_VF(d0, ks) ({ const s16x4 lo_ = vtr(vb + (d0) * 4096 + (ks) * 1024), hi_ = vtr(vb + (d0) * 4096 + (ks) * 1024 + 512); (bf16x8){lo_[0], lo_[1], lo_[2], lo_[3], hi_[0], hi_[1], hi_[2], hi_[3]}; })
        o0 = __builtin_amdgcn_mfma_f32_32x32x16_bf16(ATT_VF(0, 0), __builtin_bit_cast(bf16x8, pw0), o0, 0, 0, 0);
        o1 = __builtin_amdgcn_mfma_f32_32x32x16_bf16(ATT_VF(1, 0), __builtin_bit_cast(bf16x8, pw0), o1, 0, 0, 0);
        o0 = __builtin_amdgcn_mfma_f32_32x32x16_bf16(ATT_VF(0, 1), __builtin_bit_cast(bf16x8, pw1), o0, 0, 0, 0);
        o1 = __builtin_amdgcn_mfma_f32_32x32x16_bf16(ATT_VF(1, 1), __builtin_bit_cast(bf16x8, pw1), o1, 0, 0, 0);
        o0 = __builtin_amdgcn_mfma_f32_32x32x16_bf16(ATT_VF(0, 2), __builtin_bit_cast(bf16x8, pw2), o0, 0, 0, 0);
        o1 = __builtin_amdgcn_mfma_f32_32x32x16_bf16(ATT_VF(1, 2), __builtin_bit_cast(bf16x8, pw2), o1, 0, 0, 0);
        o0 = __builtin_amdgcn_mfma_f32_32x32x16_bf16(ATT_VF(0, 3), __builtin_bit_cast(bf16x8, pw3), o0, 0, 0, 0);
        o1 = __builtin_amdgcn_mfma_f32_32x32x16_bf16(ATT_VF(1, 3), __builtin_bit_cast(bf16x8, pw3), o1, 0, 0, 0);
#undef ATT_VF
    }
    const float inv = 1.f / xhalf_sum(l);
    bf16_t* orow = Op + (rowbase + q0 + qrel) * ldo + h * 64 + 4 * hi;
#pragma unroll
    for (int r4 = 0; r4 < 4; ++r4) {
        u32x2 w0, w1;
        w0.x = pg8::cvt_pk_bf16(o0[4 * r4] * inv, o0[4 * r4 + 1] * inv); w0.y = pg8::cvt_pk_bf16(o0[4 * r4 + 2] * inv, o0[4 * r4 + 3] * inv);
        w1.x = pg8::cvt_pk_bf16(o1[4 * r4] * inv, o1[4 * r4 + 1] * inv); w1.y = pg8::cvt_pk_bf16(o1[4 * r4 + 2] * inv, o1[4 * r4 + 3] * inv);
        *(u32x2*)(orow + 8 * r4) = w0; *(u32x2*)(orow + 32 + 8 * r4) = w1;
    }
    asm volatile("s_waitcnt lgkmcnt(0)\n\ts_barrier" ::: "memory");
#undef ATT_ISSUE
}
template <int DQK, bool MOBA>
__device__ __forceinline__ void attn_phase(const Frame& F, const bf16_t* Qp, int ldq, const bf16_t* Kp, int ldk, const bf16_t* Vp, int ldv, bf16_t* Op, int ldo, const unsigned* SEL) {
    for (int u = 2 * F.vcu; u < 512; u += 2 * F.G) {
#pragma unroll 1
        for (int k = 0; k < 2; ++k) { const int uu = u + k, bh = uu >> 5, w = uu & 31, qb = (w & 1) ? (w >> 1) : 31 - (w >> 1);
            attn_unit<DQK, MOBA>(F.lds, bh >> 3, bh & 7, qb, Qp, ldq, Kp, ldk, Vp, ldv, Op, ldo, SEL); }
    }
}

constexpr int NPH_L = 16;
__global__ void __launch_bounds__(NTHR, 2) mk(Params p) {
    extern __shared__ __attribute__((aligned(16))) unsigned char lds_raw[];
    Frame F;
    F.lds = (LAS unsigned char*)lds_raw;
    F.tid = threadIdx.x; F.lane = F.tid & 63; F.wave = __builtin_amdgcn_readfirstlane(F.tid >> 6);
    F.G = gridDim.x; { const int bx = blockIdx.x; F.vcu = (F.G % 8 == 0) ? (bx % 8) * (F.G / 8) + bx / 8 : bx; }
    volatile LAS unsigned* MISC = (volatile LAS unsigned*)(F.lds + MISC_OFF);
    if (F.tid < 32) MISC[F.tid] = 0u;
    __syncthreads();
    unsigned char* ws = p.ws;
    unsigned* ctl = (unsigned*)(ws + WS_CTL);
    XcdBarrier bar = xcd_barrier_post(ctl + CW_BAR, MISC + 8);
    const int lo = p.ph_lo, hi = p.ph_hi;
#define IN(k) (lo <= (k) && (k) < hi)
#define SEAM(k) do { if (IN(k) && IN((k) + 1)) xcd_barrier(bar); } while (0)
    bf16_t* WinT = (bf16_t*)(ws + WS_WIN);
    bf16_t* XB = (bf16_t*)(ws + WS_XB);
    bf16_t* PROJ = (bf16_t*)(ws + WS_PROJ);
    bf16_t* WuqT = (bf16_t*)(ws + WS_WUQ); bf16_t* WukvT = (bf16_t*)(ws + WS_WUKV);
    f32x2* CS = (f32x2*)(ws + WS_CS); float* KM = (float*)(ws + WS_KM); unsigned* SEL = (unsigned*)(ws + WS_SEL);
    bf16_t* CQN = (bf16_t*)(ws + WS_CQN); bf16_t* CKVN = (bf16_t*)(ws + WS_CKVN);
    bf16_t* WpaT = (bf16_t*)(ws + WS_WPA); bf16_t* WpbT = (bf16_t*)(ws + WS_WPB); bf16_t* WoutT = (bf16_t*)(ws + WS_WOUT);
    bf16_t* TMP = (bf16_t*)(ws + WS_TMP); bf16_t* MRG = (bf16_t*)(ws + WS_MRG); float* PRE = (float*)(ws + WS_PRE); float* X1 = (float*)(ws + WS_X1); bf16_t* X1B = (bf16_t*)(ws + WS_X1B); float* X2 = (float*)(ws + WS_X2);
    bf16_t* WrtT = (bf16_t*)(ws + WS_WRT); bf16_t* WsguT = (bf16_t*)(ws + WS_WSGU); bf16_t* WsdT = (bf16_t*)(ws + WS_WSD); bf16_t* WeguT = (bf16_t*)(ws + WS_WEGU); bf16_t* WedT = (bf16_t*)(ws + WS_WED);
    float* LOGITS = (float*)(ws + WS_LOG); bf16_t* HS = (bf16_t*)(ws + WS_HS); bf16_t* SH = (bf16_t*)(ws + WS_SH);
    int* TOPE = (int*)(ws + WS_TOPE); float* TOPW = (float*)(ws + WS_TOPW); int* APOS = (int*)(ws + WS_APOS); int* ROWA = (int*)(ws + WS_ROWA);
    bf16_t* PO = (bf16_t*)(ws + WS_PO); f32x2* PML = (f32x2*)(ws + WS_PML);
    bf16_t* HE = (bf16_t*)(ws + WS_HE); bf16_t* Yb = (bf16_t*)(ws + WS_Y); int* HIST = (int*)(ws + WS_HIST);
    LAS int* t_off = (LAS int*)(F.lds + TAB_OFF); LAS int* t_toff = t_off + 260;
    bf16_t* QB = (bf16_t*)(ws + WS_QB); bf16_t* KB = (bf16_t*)(ws + WS_KB); bf16_t* VB = (bf16_t*)(ws + WS_VB); bf16_t* OAB = (bf16_t*)(ws + WS_OAB);
    const int gw = F.vcu * NWAVES + F.wave, NGW = F.G * NWAVES;

    if (IN(0)) {
        LAS float* scr = (LAS float*)(F.lds + F.wave * 16384);
        constexpr int I_IN = (DM / 64) * (INC / 32);
        for (int it = gw; it < DEPTH * I_IN; it += NGW) { const int l = it / I_IN, r = it % I_IN;
            transpose_item(p.in[1] + (size_t)l * DM * INC, DM, INC, WinT + (size_t)l * SZ_WIN, DM, RowId{}, scr, r, F.lane); }
        { constexpr int I_UQ = (QL / 64) * (768 / 32), I_UKV = (KVL / 64) * (1024 / 32);
          for (int it = gw; it < DEPTH * (I_UQ + I_UKV); it += NGW) { const int l = it / (I_UQ + I_UKV), r = it % (I_UQ + I_UKV);
            if (r < I_UQ) transpose_item(p.in[4] + (size_t)l * QL * 768, QL, 768, WuqT + (size_t)l * SZ_WUQ, QL, RowQ{}, scr, r, F.lane);
            else transpose_item(p.in[6] + (size_t)l * KVL * 1024, KVL, 1024, WukvT + (size_t)l * SZ_WUKV, KVL, RowId{}, scr, r - I_UQ, F.lane); } }
        { constexpr int I_P = (512 / 64) * (DM / 32), I_O = (DM / 64) * (DM / 32), I_ALL = 2 * I_P + I_O;
          for (int it = gw; it < DEPTH * I_ALL; it += NGW) { const int l = it / I_ALL; int r = it % I_ALL;
            if (r < I_P) { transpose_item(p.in[7] + (size_t)l * 512 * DM, 512, DM, WpaT + (size_t)l * SZ_WP, 512, RowId{}, scr, r, F.lane); continue; } r -= I_P;
            if (r < I_P) { transpose_item(p.in[8] + (size_t)l * 512 * DM, 512, DM, WpbT + (size_t)l * SZ_WP, 512, RowId{}, scr, r, F.lane); continue; } r -= I_P;
            transpose_item(p.in[9] + (size_t)l * DM * DM, DM, DM, WoutT + (size_t)l * SZ_WOUT, DM, RowId{}, scr, r, F.lane); } }
        { constexpr int I_R = (DM / 64) * (NE / 32), I_G = (DM / 64) * (DSH / 32), I_D = (DSH / 64) * (DM / 32), I_ALL = I_R + 2 * I_G + I_D;
          for (int it = gw; it < DEPTH * I_ALL; it += NGW) { const int l = it / I_ALL; int r = it % I_ALL;
            if (r < I_R) { transpose_item(p.in[12] + (size_t)l * DM * NE, DM, NE, WrtT + (size_t)l * SZ_WRT, DM, RowId{}, scr, r, F.lane); continue; } r -= I_R;
            if (r < I_G) { transpose_item(p.in[17] + (size_t)l * DM * DSH, DM, DSH, WsguT + (size_t)l * SZ_WSGU, DM, RowGU{0}, scr, r, F.lane); continue; } r -= I_G;
            if (r < I_G) { transpose_item(p.in[18] + (size_t)l * DM * DSH, DM, DSH, WsguT + (size_t)l * SZ_WSGU, DM, RowGU{128}, scr, r, F.lane); continue; } r -= I_G;
            transpose_item(p.in[19] + (size_t)l * DSH * DM, DSH, DM, WsdT + (size_t)l * SZ_WSD, DSH, RowId{}, scr, r, F.lane); } }
        { constexpr int I_G = (DM / 64) * (DE / 32), I_D = (DE / 64) * (DM / 32), I_E = 2 * I_G + I_D;
          for (int it = gw; it < DEPTH * NE * I_E; it += NGW) { const int le = it / I_E; int r = it % I_E;
            if (r < I_G) { transpose_item(p.in[14] + (size_t)le * DM * DE, DM, DE, WeguT + (size_t)le * 512 * DM, DM, RowGU{0}, scr, r, F.lane); continue; } r -= I_G;
            if (r < I_G) { transpose_item(p.in[15] + (size_t)le * DM * DE, DM, DE, WeguT + (size_t)le * 512 * DM, DM, RowGU{128}, scr, r, F.lane); continue; } r -= I_G;
            transpose_item(p.in[16] + (size_t)le * DE * DM, DE, DM, WedT + (size_t)le * DM * DE, DE, RowId{}, scr, r, F.lane); } }
        for (int i = blockIdx.x * NTHR + F.tid; i < SEQ * 16; i += F.G * NTHR) { const int pos = i >> 4, k = i & 15;
            const float inv = powf(10000.f, -(float)(2 * k) / 32.f), ang = (float)pos * inv; CS[i] = (f32x2){cosf(ang), sinf(ang)}; }
        for (int i = blockIdx.x * NTHR + F.tid; i < DEPTH * 12288; i += F.G * NTHR) { const int l = i / 12288, r = i % 12288;
            *(u32x4*)(WinT + (size_t)l * SZ_WIN + (size_t)INC * DM + (size_t)r * 8) = (u32x4){0u, 0u, 0u, 0u}; }
        for (int i = blockIdx.x * NTHR + F.tid; i < T * DM / 8; i += F.G * NTHR) { const f32x4 a = *(const f32x4*)(p.in[0] + (size_t)i * 8), b = *(const f32x4*)(p.in[0] + (size_t)i * 8 + 4);
            u32x4 w; w.x = pk2(a[0], a[1]); w.y = pk2(a[2], a[3]); w.z = pk2(b[0], b[1]); w.w = pk2(b[2], b[3]); *(u32x4*)(XB + (size_t)i * 8) = w; }
    }
    SEAM(0);

    {
        const int l = 0; const int pb = 1 + l * NPH_L;
        if (IN(pb + 0)) {
            pg8::Gemm g{XB, WinT + (size_t)l * SZ_WIN, T, INCP, DM, DM, DM}; pg8::StaticOrder S; S.init(T, INCP, F.G, (int)blockIdx.x);
            EpiProj E{PROJ, p.in[2] + (size_t)l * 2 * DM};
            pg8::gemm_phase<EpiProj, pg8::StaticOrder, true>(F.lds, g, S, E);
        }
        SEAM(pb + 0);
        if (IN(pb + 1)) prep_phase(F, PROJ, p.in[3] + (size_t)l * QL, p.in[5] + (size_t)l * KVL, CS, CQN, CKVN, KB, KM);
        SEAM(pb + 1);
        if (IN(pb + 2)) {
            mobasel_phase(F, PROJ, KM, SEL);
            { pg8::Gemm g{CKVN, WukvT + (size_t)l * SZ_WUKV, T, 1024, KVL, KVL, KVL}; pg8::StaticOrder S; S.init(T, 1024, F.G, (int)blockIdx.x);
              EpiKV E{KB, VB}; pg8::gemm_phase<EpiKV, pg8::StaticOrder, true>(F.lds, g, S, E); }
            { pg8::Gemm g{CQN, WuqT + (size_t)l * SZ_WUQ, T, 768, QL, QL, QL}; pg8::StaticOrder S; S.init(T, 768, F.G, (int)blockIdx.x);
              EpiQ E{QB, CS}; pg8::gemm_phase<EpiQ, pg8::StaticOrder, true>(F.lds, g, S, E); }
        }
        SEAM(pb + 2);
        if (IN(pb + 3)) {
            attn_phase<96, false>(F, QB, 768, KB, 768, VB, 512, OAB + 512, 1024, nullptr);
            attn_phase<64, true>(F, PROJ + C_QA, INCP, PROJ + C_KA, INCP, PROJ + C_VA, INCP, OAB, 1024, SEL);
        }
        SEAM(pb + 3);
        if (IN(pb + 4)) {
            { pg8::Gemm g{OAB, WpaT + (size_t)l * SZ_WP, T, DM, 512, 1024, 512}; pg8::StaticOrder S; S.init(T, DM, F.G, (int)blockIdx.x);
              EpiGate<false> E{PROJ, TMP, MRG}; pg8::gemm_phase<EpiGate<false>, pg8::StaticOrder, true>(F.lds, g, S, E); }
            { pg8::Gemm g{OAB + 512, WpbT + (size_t)l * SZ_WP, T, DM, 512, 1024, 512}; pg8::StaticOrder S; S.init(T, DM, F.G, (int)blockIdx.x);
              EpiGate<true> E{PROJ, TMP, MRG}; pg8::gemm_phase<EpiGate<true>, pg8::StaticOrder, true>(F.lds, g, S, E); }
        }
        SEAM(pb + 4);
        if (IN(pb + 5)) {
            pg8::Gemm g{MRG, WoutT + (size_t)l * SZ_WOUT, T, DM, DM, DM, DM}; pg8::StaticOrder S; S.init(T, DM, F.G, (int)blockIdx.x);
            EpiResid E{l == 0 ? p.in[0] : X2, PRE}; pg8::gemm_phase<EpiResid, pg8::StaticOrder, true>(F.lds, g, S, E);
        }
        SEAM(pb + 5);
        if (IN(pb + 6)) ln_phase(F, PRE, p.in[10] + (size_t)l * DM, p.in[11] + (size_t)l * DM, X1, X1B);
        SEAM(pb + 6);
        if (IN(pb + 7)) {
            { pg8::Gemm g{X1B, WrtT + (size_t)l * SZ_WRT, T, NE, DM, DM, DM}; pg8::StaticOrder S; S.init(T, NE, F.G, (int)blockIdx.x);
              EpiF32 E{LOGITS, NE}; pg8::gemm_phase<EpiF32, pg8::StaticOrder, true>(F.lds, g, S, E); }
            { pg8::Gemm g{X1B, WsguT + (size_t)l * SZ_WSGU, T, 512, DM, DM, DM}; pg8::StaticOrder S; S.init(T, 512, F.G, (int)((blockIdx.x + F.G / 2) % F.G));
              EpiSwiGLU E{HS, DSH}; pg8::gemm_phase<EpiSwiGLU, pg8::StaticOrder, true>(F.lds, g, S, E); }
        }
        SEAM(pb + 7);
        if (IN(pb + 8)) {
            route_phase(F, LOGITS, p.in[13] + (size_t)l * NE, TOPE, TOPW, APOS, HIST, t_off);
            pg8::Gemm g{HS, WsdT + (size_t)l * SZ_WSD, T, DM, DSH, DSH, DSH}; pg8::StaticOrder S; S.init(T, DM, F.G, (int)blockIdx.x);
            EpiBf16 E{SH, DM}; pg8::gemm_phase<EpiBf16, pg8::StaticOrder, true>(F.lds, g, S, E);
        }
        SEAM(pb + 8);
        if (IN(pb + 9)) {
            int tid_ = F.tid; asm volatile("" : "+v"(tid_));
            if (tid_ < 256) { int tot = 0, base = 0; for (int c = 0; c < F.G; ++c) { const int v = HIST[(size_t)c * 256 + tid_]; base += (c < (int)blockIdx.x) ? v : 0; tot += v; }
                t_off[tid_] = tot; t_toff[tid_] = base; if (blockIdx.x == 0) ctl[CW_CNT + l * 256 + tid_] = (unsigned)tot; }
            __syncthreads();
            if (tid_ == 0) { int a = 0; for (int i = 0; i < 256; ++i) { const int c = t_off[i]; t_off[i] = a; a += c; } }
            __syncthreads();
            const int TPW = T / F.G, a0 = (int)blockIdx.x * TPW * TOPK;
            for (int a = a0 + tid_; a < a0 + TPW * TOPK; a += NTHR) { const int e = TOPE[a]; *(u32x2*)(ROWA + 2 * (size_t)(t_off[e] + t_toff[e] + APOS[a])) = (u32x2){(unsigned)a, __float_as_uint(TOPW[a])}; }
            __syncthreads();
        }
        SEAM(pb + 9);
        if (IN(pb + 10)) {
            expert_tables(F, ctl + CW_CNT + l * 256, t_off, t_toff);
            pg8::Gemm g{X1B, WeguT + (size_t)l * SZ_WEGU, T, 512, DM, DM, DM};
            ExpertOrder<2, true> S{t_off, t_toff, ROWA, F.G, (int)blockIdx.x, (size_t)512 * DM * 2};
            EpiSwiGLU E{HE, DE}; pg8::gemm_phase<EpiSwiGLU, ExpertOrder<2, true>, true>(F.lds, g, S, E);
        }
        SEAM(pb + 10);
        if (IN(pb + 11)) {
            expert_tables(F, ctl + CW_CNT + l * 256, t_off, t_toff);
            pg8::Gemm g{HE, WedT + (size_t)l * SZ_WED, NA, DM, DE, DE, DE};
            ExpertOrder<4, false> S{t_off, t_toff, ROWA, F.G, (int)blockIdx.x, (size_t)DM * DE * 2};
            EpiExpDown E{Yb, ROWA}; pg8::gemm_phase<EpiExpDown, ExpertOrder<4, false>, true>(F.lds, g, S, E);
        }
        SEAM(pb + 11);
        if (IN(pb + 12)) combine_phase(F, X1, SH, Yb, p.in[20] + (size_t)l * DM, p.in[21] + (size_t)l * DM, l == DEPTH - 1 ? p.out : X2, l == DEPTH - 1 ? (bf16_t*)nullptr : XB);
        SEAM(pb + 12);
    }

    {
        const int l = 1; const int pb = 1 + l * NPH_L;
        if (IN(pb + 0)) {
            pg8::Gemm g{XB, WinT + (size_t)l * SZ_WIN, T, INCP, DM, DM, DM}; pg8::StaticOrder S; S.init(T, INCP, F.G, (int)blockIdx.x);
            EpiProj E{PROJ, p.in[2] + (size_t)l * 2 * DM};
            pg8::gemm_phase<EpiProj, pg8::StaticOrder, true>(F.lds, g, S, E);
        }
        SEAM(pb + 0);
        if (IN(pb + 1)) prep_phase(F, PROJ, p.in[3] + (size_t)l * QL, p.in[5] + (size_t)l * KVL, CS, CQN, CKVN, KB, KM);
        SEAM(pb + 1);
        if (IN(pb + 2)) {
            mobasel_phase(F, PROJ, KM, SEL);
            { pg8::Gemm g{CKVN, WukvT + (size_t)l * SZ_WUKV, T, 1024, KVL, KVL, KVL}; pg8::StaticOrder S; S.init(T, 1024, F.G, (int)blockIdx.x);
              EpiKV E{KB, VB}; pg8::gemm_phase<EpiKV, pg8::StaticOrder, true>(F.lds, g, S, E); }
            { pg8::Gemm g{CQN, WuqT + (size_t)l * SZ_WUQ, T, 768, QL, QL, QL}; pg8::StaticOrder S; S.init(T, 768, F.G, (int)blockIdx.x);
              EpiQ E{QB, CS}; pg8::gemm_phase<EpiQ, pg8::StaticOrder, true>(F.lds, g, S, E); }
        }
        SEAM(pb + 2);
        if (IN(pb + 3)) {
            attn_phase<96, false>(F, QB, 768, KB, 768, VB, 512, OAB + 512, 1024, nullptr);
            attn_phase<64, true>(F, PROJ + C_QA, INCP, PROJ + C_KA, INCP, PROJ + C_VA, INCP, OAB, 1024, SEL);
        }
        SEAM(pb + 3);
        if (IN(pb + 4)) {
            { pg8::Gemm g{OAB, WpaT + (size_t)l * SZ_WP, T, DM, 512, 1024, 512}; pg8::StaticOrder S; S.init(T, DM, F.G, (int)blockIdx.x);
              EpiGate<false> E{PROJ, TMP, MRG}; pg8::gemm_phase<EpiGate<false>, pg8::StaticOrder, true>(F.lds, g, S, E); }
            { pg8::Gemm g{OAB + 512, WpbT + (size_t)l * SZ_WP, T, DM, 512, 1024, 512}; pg8::StaticOrder S; S.init(T, DM, F.G, (int)blockIdx.x);
              EpiGate<true> E{PROJ, TMP, MRG}; pg8::gemm_phase<EpiGate<true>, pg8::StaticOrder, true>(F.lds, g, S, E); }
        }
        SEAM(pb + 4);
        if (IN(pb + 5)) {
            pg8::Gemm g{MRG, WoutT + (size_t)l * SZ_WOUT, T, DM, DM, DM, DM}; pg8::StaticOrder S; S.init(T, DM, F.G, (int)blockIdx.x);
            EpiResid E{l == 0 ? p.in[0] : X2, PRE}; pg8::gemm_phase<EpiResid, pg8::StaticOrder, true>(F.lds, g, S, E);
        }
        SEAM(pb + 5);
        if (IN(pb + 6)) ln_phase(F, PRE, p.in[10] + (size_t)l * DM, p.in[11] + (size_t)l * DM, X1, X1B);
        SEAM(pb + 6);
        if (IN(pb + 7)) {
            { pg8::Gemm g{X1B, WrtT + (size_t)l * SZ_WRT, T, NE, DM, DM, DM}; pg8::StaticOrder S; S.init(T, NE, F.G, (int)blockIdx.x);
              EpiF32 E{LOGITS, NE}; pg8::gemm_phase<EpiF32, pg8::StaticOrder, true>(F.lds, g, S, E); }
            { pg8::Gemm g{X1B, WsguT + (size_t)l * SZ_WSGU, T, 512, DM, DM, DM}; pg8::StaticOrder S; S.init(T, 512, F.G, (int)((blockIdx.x + F.G / 2) % F.G));
              EpiSwiGLU E{HS, DSH}; pg8::gemm_phase<EpiSwiGLU, pg8::StaticOrder, true>(F.lds, g, S, E); }
        }
        SEAM(pb + 7);
        if (IN(pb + 8)) {
            route_phase(F, LOGITS, p.in[13] + (size_t)l * NE, TOPE, TOPW, APOS, HIST, t_off);
            pg8::Gemm g{HS, WsdT + (size_t)l * SZ_WSD, T, DM, DSH, DSH, DSH}; pg8::StaticOrder S; S.init(T, DM, F.G, (int)blockIdx.x);
            EpiBf16 E{SH, DM}; pg8::gemm_phase<EpiBf16, pg8::StaticOrder, true>(F.lds, g, S, E);
        }
        SEAM(pb + 8);
        if (IN(pb + 9)) {
            int tid_ = F.tid; asm volatile("" : "+v"(tid_));
            if (tid_ < 256) { int tot = 0, base = 0; for (int c = 0; c < F.G; ++c) { const int v = HIST[(size_t)c * 256 + tid_]; base += (c < (int)blockIdx.x) ? v : 0; tot += v; }
                t_off[tid_] = tot; t_toff[tid_] = base; if (blockIdx.x == 0) ctl[CW_CNT + l * 256 + tid_] = (unsigned)tot; }
            __syncthreads();
            if (tid_ == 0) { int a = 0; for (int i = 0; i < 256; ++i) { const int c = t_off[i]; t_off[i] = a; a += c; } }
            __syncthreads();
            const int TPW = T / F.G, a0 = (int)blockIdx.x * TPW * TOPK;
            for (int a = a0 + tid_; a < a0 + TPW * TOPK; a += NTHR) { const int e = TOPE[a]; *(u32x2*)(ROWA + 2 * (size_t)(t_off[e] + t_toff[e] + APOS[a])) = (u32x2){(unsigned)a, __float_as_uint(TOPW[a])}; }
            __syncthreads();
        }
        SEAM(pb + 9);
        if (IN(pb + 10)) {
            expert_tables(F, ctl + CW_CNT + l * 256, t_off, t_toff);
            pg8::Gemm g{X1B, WeguT + (size_t)l * SZ_WEGU, T, 512, DM, DM, DM};
            ExpertOrder<2, true> S{t_off, t_toff, ROWA, F.G, (int)blockIdx.x, (size_t)512 * DM * 2};
            EpiSwiGLU E{HE, DE}; pg8::gemm_phase<EpiSwiGLU, ExpertOrder<2, true>, true>(F.lds, g, S, E);
        }
        SEAM(pb + 10);
        if (IN(pb + 11)) {
            expert_tables(F, ctl + CW_CNT + l * 256, t_off, t_toff);
            pg8::Gemm g{HE, WedT + (size_t)l * SZ_WED, NA, DM, DE, DE, DE};
            ExpertOrder<4, false> S{t_off, t_toff, ROWA, F.G, (int)blockIdx.x, (size_t)DM * DE * 2};
            EpiExpDown E{Yb, ROWA}; pg8::gemm_phase<EpiExpDown, ExpertOrder<4, false>, true>(F.lds, g, S, E);
        }
        SEAM(pb + 11);
        if (IN(pb + 12)) combine_phase(F, X1, SH, Yb, p.in[20] + (size_t)l * DM, p.in[21] + (size_t)l * DM, l == DEPTH - 1 ? p.out : X2, l == DEPTH - 1 ? (bf16_t*)nullptr : XB);
        SEAM(pb + 12);
    }

#undef IN
#undef SEAM
}

__global__ void __launch_bounds__(256) cvt_proj(const bf16_t* __restrict__ P, float* proj) {
    const size_t i = (size_t)blockIdx.x * 256 + threadIdx.x;
    const int row = (int)(i / INC), c = (int)(i % INC);
    float v = bf2f(P[(size_t)row * INCP + c]);
    if (c < C_KA) v *= (1.f / QS_A);
    proj[i] = v;
}
__global__ void __launch_bounds__(256) cvt_oab(const bf16_t* __restrict__ OAB, float* oa, float* ob) {
    const size_t i = (size_t)blockIdx.x * 256 + threadIdx.x; const size_t row = i >> 10; const int c = (int)(i & 1023);
    const float v = bf2f(OAB[i]);
    if (c < 512) oa[row * 512 + c] = v; else ob[row * 512 + c - 512] = v;
}
__global__ void __launch_bounds__(256) cvt_x(const float* __restrict__ x, bf16_t* XB) {
    const size_t i = (size_t)blockIdx.x * 256 + threadIdx.x;
    const f32x4 a = *(const f32x4*)(x + i * 8), b = *(const f32x4*)(x + i * 8 + 4);
    u32x4 w; w.x = pk2(a[0], a[1]); w.y = pk2(a[2], a[3]); w.z = pk2(b[0], b[1]); w.w = pk2(b[2], b[3]); *(u32x4*)(XB + i * 8) = w;
}
}
static int g_grid = 0;
static bool fast_setup() {
    if (g_grid) return g_grid > 0;
    int dev = 0, cus = 0, per_cu = 0;
    if (hipGetDevice(&dev) != hipSuccess || hipDeviceGetAttribute(&cus, hipDeviceAttributeMultiprocessorCount, dev) != hipSuccess) { g_grid = -1; return false; }
    if (hipFuncSetAttribute((const void*)fk::mk, hipFuncAttributeMaxDynamicSharedMemorySize, fk::LDS_BYTES) != hipSuccess) { fprintf(stderr, "hipFuncSetAttribute failed\n"); g_grid = -1; return false; }
    if (hipOccupancyMaxActiveBlocksPerMultiprocessor(&per_cu, (const void*)fk::mk, fk::NTHR, fk::LDS_BYTES) != hipSuccess || per_cu < 1) { fprintf(stderr, "occupancy query: %d\n", per_cu); }
    (void)hipGetLastError();
    g_grid = cus;
    if (cus > 1024 || T % cus != 0 || (T / cus) * 8 > 4096) { fprintf(stderr, "unsupported CU count %d\n", cus); g_grid = -1; return false; }
    return true;
}
static void launch_mk(fk::Params& p, int lo, int hi, hipStream_t stream) {
    p.ph_lo = lo; p.ph_hi = hi;
    hipLaunchKernelGGL(fk::mk, dim3(g_grid), dim3(fk::NTHR), fk::LDS_BYTES, stream, p);
}

extern "C" void kernel_launch(void* const* d_in, const int* in_sizes, int n_in, void* d_out, int out_size, void* d_ws, size_t ws_size, hipStream_t stream) {
    if (!fast_setup()) return;
    if (ws_size < fk::WS_NEED) { fprintf(stderr, "workspace too small: need %zu have %zu\n", (size_t)fk::WS_NEED, ws_size); return; }
    (void)hipMemsetAsync((char*)d_ws + fk::WS_CTL, 0, fk::CTL_BYTES, stream);
    fk::Params P{};
    for (int i = 0; i < 22; ++i) P.in[i] = (const float*)d_in[i];
    P.out = (float*)d_out; P.ws = (unsigned char*)d_ws;
#if MK_ONE_LAUNCH
    launch_mk(P, 0, 1 + DEPTH * fk::NPH_L, stream);
#else
    launch_mk(P, 0, 1, stream);
    for (int l = 0; l < DEPTH; ++l) for (int k = 0; k < 13; ++k) launch_mk(P, 1 + l * fk::NPH_L + k, 2 + l * fk::NPH_L + k, stream);
#endif
}
```

```cpp
#ifndef MK_ONE_LAUNCH
#define MK_ONE_LAUNCH 1
#endif
#include <hip/hip_runtime.h>
#include <cstdint>
#include <cstdio>

constexpr int NB = 2, SEQ = 8192, T = NB * SEQ, DM = 1024, DEPTH = 2;
constexpr int HA = 8, WA = 512, BLK = 256, NBLK = SEQ / BLK;
constexpr int HB = 8, DN = 64, DR = 32, DV = 64, QL = 384, KVL = 256;
constexpr int INC = 3 * WA + QL + KVL + DR + 2 * DM;
constexpr int C_QA = 0, C_KA = 512, C_VA = 1024, C_CQ = 1536, C_CKV = 1920, C_KR = 2176, C_GA = 2208, C_GB = 3232;
constexpr int NE = 256, TOPK = 8, DE = 256, DSH = 256;
constexpr int NA = T * TOPK;
constexpr float ALPHA = 1.4142135623730951f;
constexpr float LN_EPS = 1e-5f, RMS_EPS = 1e-6f;

namespace ora {
template <class EP>
__global__ void __launch_bounds__(256) sgemm(const float* __restrict__ A, const float* __restrict__ Bm, EP ep, int M, int N, int K, int lda, int ldb, int pad_) {
    __shared__ float As[16][68], Bs[16][68];
    const int tid = threadIdx.x, tx = tid & 15, ty = tid >> 4;
    const int m0 = blockIdx.y * 64, n0 = blockIdx.x * 64;
    float acc[4][4];
#pragma unroll
    for (int i = 0; i < 4; ++i)
#pragma unroll
        for (int j = 0; j < 4; ++j) acc[i][j] = 0.f;
    const int ar = tid >> 2, ak = (tid & 3) * 4;
    const int bk = tid >> 4, bn = (tid & 15) * 4;
    for (int k0 = 0; k0 < K; k0 += 16) {
        const float4 av = *(const float4*)(A + (size_t)(m0 + ar) * lda + k0 + ak);
        float4 bv = make_float4(0.f, 0.f, 0.f, 0.f);
        if (n0 + bn < N) bv = *(const float4*)(Bm + (size_t)(k0 + bk) * ldb + n0 + bn);
        __syncthreads();
        As[ak + 0][ar] = av.x; As[ak + 1][ar] = av.y; As[ak + 2][ar] = av.z; As[ak + 3][ar] = av.w;
        *(float4*)&Bs[bk][bn] = bv;
        __syncthreads();
#pragma unroll
        for (int kk = 0; kk < 16; ++kk) {
            const float4 a = *(const float4*)&As[kk][ty * 4];
            const float4 b = *(const float4*)&Bs[kk][tx * 4];
            const float aa[4] = {a.x, a.y, a.z, a.w}, bb[4] = {b.x, b.y, b.z, b.w};
#pragma unroll
            for (int i = 0; i < 4; ++i)
#pragma unroll
                for (int j = 0; j < 4; ++j) acc[i][j] = fmaf(aa[i], bb[j], acc[i][j]);
        }
    }
#pragma unroll
    for (int i = 0; i < 4; ++i)
#pragma unroll
        for (int j = 0; j < 4; ++j) { const int r = m0 + ty * 4 + i, c = n0 + tx * 4 + j; if (c < N) ep(r, c, acc[i][j]); }
}
struct EpStore { float* C; int ldc; int pad; __device__ void operator()(int r, int c, float v) const { C[(size_t)r * ldc + c] = v; } };
struct EpMerge { const float* proj; const float* bg; const float* pa; float* out; int pre; int pad;
    __device__ void operator()(int r, int c, float v) const {
        const float ga = proj[(size_t)r * INC + C_GA + c] + bg[c], gb = proj[(size_t)r * INC + C_GB + c] + bg[DM + c];
        const float sa = pre ? proj[(size_t)r * INC + C_GA + c] : 1.f / (1.f + expf(-ga)), sb = pre ? proj[(size_t)r * INC + C_GB + c] : 1.f / (1.f + expf(-gb));
        out[(size_t)r * DM + c] = sa * pa[(size_t)r * DM + c] + sb * v; } };
struct EpResid { const float* x; float* out; __device__ void operator()(int r, int c, float v) const { out[(size_t)r * DM + c] = ALPHA * x[(size_t)r * DM + c] + v; } };
struct EpSilu { const float* sg; float* out; __device__ void operator()(int r, int c, float v) const { const float g = sg[(size_t)r * DSH + c]; out[(size_t)r * DSH + c] = g / (1.f + expf(-g)) * v; } };

__global__ void __launch_bounds__(256) rowprep(const float* __restrict__ proj, const float* __restrict__ qn, const float* __restrict__ kvn, float* cqn, float* ckvn, float* krr) {
    const int wid = threadIdx.x >> 6, lane = threadIdx.x & 63, row = blockIdx.x * 4 + wid;
    const float* p = proj + (size_t)row * INC;
    float sq = 0.f, sk = 0.f;
    for (int c = lane; c < QL; c += 64) { const float v = p[C_CQ + c]; sq += v * v; }
    for (int c = lane; c < KVL; c += 64) { const float v = p[C_CKV + c]; sk += v * v; }
#pragma unroll
    for (int o = 32; o; o >>= 1) { sq += __shfl_xor(sq, o); sk += __shfl_xor(sk, o); }
    const float rq = rsqrtf(sq / QL + RMS_EPS), rk = rsqrtf(sk / KVL + RMS_EPS);
    for (int c = lane; c < QL; c += 64) cqn[(size_t)row * QL + c] = p[C_CQ + c] * rq * qn[c];
    for (int c = lane; c < KVL; c += 64) ckvn[(size_t)row * KVL + c] = p[C_CKV + c] * rk * kvn[c];
    if (lane < 16) {
        const int pos = row % SEQ;
        const float inv = powf(10000.f, -(float)(2 * lane) / 32.f), ang = (float)pos * inv, cs = cosf(ang), sn = sinf(ang);
        const float x1 = p[C_KR + lane], x2 = p[C_KR + 16 + lane];
        krr[(size_t)row * DR + lane] = x1 * cs - x2 * sn; krr[(size_t)row * DR + 16 + lane] = x2 * cs + x1 * sn;
    }
}
__global__ void __launch_bounds__(256) qrope(float* q) {
    const int idx = blockIdx.x * 256 + threadIdx.x;
    const int i = idx & 15, h = (idx >> 4) & 7, row = idx >> 7, pos = row % SEQ;
    const float inv = powf(10000.f, -(float)(2 * i) / 32.f), ang = (float)pos * inv, cs = cosf(ang), sn = sinf(ang);
    float* p = q + (size_t)row * 768 + h * 96 + 64;
    const float x1 = p[i], x2 = p[16 + i];
    p[i] = x1 * cs - x2 * sn; p[16 + i] = x2 * cs + x1 * sn;
}
__global__ void __launch_bounds__(64) kmean(const float* __restrict__ proj, float* km) {
    const int blk = blockIdx.x, h = blockIdx.y, b = blockIdx.z, c = threadIdx.x;
    float s = 0.f;
    for (int i = 0; i < BLK; ++i) s += proj[(size_t)(b * SEQ + blk * BLK + i) * INC + C_KA + h * 64 + c];
    km[((size_t)(b * HA + h) * NBLK + blk) * 64 + c] = s * (1.f / BLK);
}
__global__ void __launch_bounds__(256) mobasel(const float* __restrict__ proj, const float* __restrict__ km, unsigned* sel) {
    const int idx = blockIdx.x * 256 + threadIdx.x;
    const int h = idx & 7, row = idx >> 3, b = row / SEQ, pos = row % SEQ, own = pos / BLK;
    const float* qp = proj + (size_t)row * INC + C_QA + h * 64;
    float v1 = -INFINITY, v2 = -INFINITY, v3 = -INFINITY; int i1 = -1, i2 = -1, i3 = -1;
    for (int j = 0; j < own; ++j) {
        const float* kp = km + ((size_t)(b * HA + h) * NBLK + j) * 64;
        float g = 0.f;
        for (int c = 0; c < 64; ++c) g = fmaf(qp[c], kp[c], g);
        if (g > v1) { v3 = v2; i3 = i2; v2 = v1; i2 = i1; v1 = g; i1 = j; }
        else if (g > v2) { v3 = v2; i3 = i2; v2 = g; i2 = j; }
        else if (g > v3) { v3 = g; i3 = j; }
    }
    unsigned m = 0;
    if (i1 >= 0) m |= 1u << i1; if (i2 >= 0) m |= 1u << i2; if (i3 >= 0) m |= 1u << i3;
    sel[idx] = m;
}
__device__ __forceinline__ float ldbf(const void* p, size_t i) { return __builtin_bit_cast(float, (unsigned)((const unsigned short*)p)[i] << 16); }
template <bool MOBA, bool FAST>
__global__ void __launch_bounds__(256) attn(const float* __restrict__ Qb, const float* __restrict__ KVb, const float* __restrict__ KRb, const unsigned* __restrict__ sel, float* O) {
    constexpr int DQK = MOBA ? 64 : 96;
    __shared__ float Qs[64][DQK + 1], Ks[32][DQK + 1], Vs[32][65], Ps[64][33];
    const int qb = blockIdx.x, h = blockIdx.y, b = blockIdx.z, tid = threadIdx.x, qi = tid >> 2, sub = tid & 3;
    const size_t row0 = (size_t)b * SEQ + (size_t)qb * 64;
    for (int idx = tid; idx < 64 * DQK; idx += 256) { const int r = idx / DQK, c = idx % DQK;
        if (FAST) Qs[r][c] = MOBA ? ldbf(Qb, (row0 + r) * 4352 + C_QA + h * 64 + c) : ldbf(Qb, (row0 + r) * 768 + h * 96 + c);
        else Qs[r][c] = MOBA ? Qb[(row0 + r) * INC + C_QA + h * 64 + c] : Qb[(row0 + r) * 768 + h * 96 + c]; }
    const int tq = qb * 64 + qi, own = tq / BLK;
    const unsigned mask = MOBA ? sel[(row0 + qi) * 8 + h] : 0u;
    const float slope = exp2f(-(float)(h + 1)), scale = FAST ? 0.6931471805599453f : (MOBA ? 0.125f : 0.10206207261596577f);
    float m = -1e30f, l = 0.f, o[16];
#pragma unroll
    for (int d = 0; d < 16; ++d) o[d] = 0.f;
    const int nkt = (qb * 64 + 64) / 32;
    for (int kt = 0; kt < nkt; ++kt) {
        __syncthreads();
        for (int idx = tid; idx < 32 * DQK; idx += 256) { const int r = idx / DQK, c = idx % DQK; const size_t kr = (size_t)b * SEQ + kt * 32 + r;
            if (FAST) Ks[r][c] = MOBA ? ldbf(KVb, kr * 4352 + C_KA + h * 64 + c) : ldbf(KVb, kr * 768 + h * 96 + c);
            else Ks[r][c] = MOBA ? KVb[kr * INC + C_KA + h * 64 + c] : (c < 64 ? KVb[kr * 1024 + h * 128 + c] : KRb[kr * DR + c - 64]); }
        for (int idx = tid; idx < 32 * 64; idx += 256) { const int r = idx >> 6, c = idx & 63; const size_t kr = (size_t)b * SEQ + kt * 32 + r;
            if (FAST) Vs[r][c] = MOBA ? ldbf(KVb, kr * 4352 + C_VA + h * 64 + c) : ldbf(KRb, kr * 512 + h * 64 + c);
            else Vs[r][c] = MOBA ? KVb[kr * INC + C_VA + h * 64 + c] : KVb[kr * 1024 + h * 128 + 64 + c]; }
        __syncthreads();
        float s[8]; float rmax = -1e30f;
#pragma unroll
        for (int j = 0; j < 8; ++j) {
            const int kk = sub + 4 * j, kpos = kt * 32 + kk;
            float dot = 0.f;
            for (int c = 0; c < DQK; ++c) dot = fmaf(Qs[qi][c], Ks[kk][c], dot);
            float sc = dot * scale; bool ok;
            if (MOBA) { sc -= slope * (float)(tq - kpos); const int kb = kpos / BLK; ok = (kb == own) ? (kpos <= tq) : (((mask >> kb) & 1u) != 0u); }
            else ok = kpos <= tq;
            s[j] = ok ? sc : -1e30f; rmax = fmaxf(rmax, s[j]);
        }
        rmax = fmaxf(rmax, __shfl_xor(rmax, 1)); rmax = fmaxf(rmax, __shfl_xor(rmax, 2));
        const float mn = fmaxf(m, rmax), alpha = expf(m - mn);
        float psum = 0.f;
#pragma unroll
        for (int j = 0; j < 8; ++j) { const float p = (s[j] > -1e29f) ? expf(s[j] - mn) : 0.f; Ps[qi][sub + 4 * j] = p; psum += p; }
        psum += __shfl_xor(psum, 1); psum += __shfl_xor(psum, 2);
        l = l * alpha + psum; m = mn;
        __syncthreads();
#pragma unroll
        for (int d = 0; d < 16; ++d) o[d] *= alpha;
        for (int kk = 0; kk < 32; ++kk) { const float p = Ps[qi][kk];
#pragma unroll
            for (int d = 0; d < 16; ++d) o[d] = fmaf(p, Vs[kk][sub * 16 + d], o[d]); }
    }
    const float rl = 1.f / l;
#pragma unroll
    for (int d = 0; d < 16; ++d) O[(row0 + qi) * 512 + h * 64 + sub * 16 + d] = o[d] * rl;
}
template <bool COMB>
__global__ void __launch_bounds__(256) lnorm(const float* __restrict__ in, const float* __restrict__ x1, const float* __restrict__ shared_, const float* __restrict__ Y, const float* __restrict__ g, const float* __restrict__ bt, float* out) {
    __shared__ float red[8];
    const int row = blockIdx.x, tid = threadIdx.x;
    float v[4];
#pragma unroll
    for (int i = 0; i < 4; ++i) { const int c = tid + 256 * i;
        if (COMB) { float a = ALPHA * x1[(size_t)row * DM + c] + shared_[(size_t)row * DM + c];
            for (int k = 0; k < TOPK; ++k) a += Y[((size_t)row * TOPK + k) * DM + c];
            v[i] = a; }
        else v[i] = in[(size_t)row * DM + c]; }
    float s = v[0] + v[1] + v[2] + v[3];
#pragma unroll
    for (int o = 32; o; o >>= 1) s += __shfl_xor(s, o);
    if ((tid & 63) == 0) red[tid >> 6] = s;
    __syncthreads();
    const float mu = (red[0] + red[1] + red[2] + red[3]) * (1.f / DM);
    float q = 0.f;
#pragma unroll
    for (int i = 0; i < 4; ++i) { const float d = v[i] - mu; q += d * d; }
#pragma unroll
    for (int o = 32; o; o >>= 1) q += __shfl_xor(q, o);
    if ((tid & 63) == 0) red[4 + (tid >> 6)] = q;
    __syncthreads();
    const float rs = rsqrtf((red[4] + red[5] + red[6] + red[7]) * (1.f / DM) + LN_EPS);
#pragma unroll
    for (int i = 0; i < 4; ++i) { const int c = tid + 256 * i; out[(size_t)row * DM + c] = (v[i] - mu) * rs * g[c] + bt[c]; }
}
__global__ void __launch_bounds__(256) route(const float* __restrict__ logits, const float* __restrict__ rbias, int* tope, float* topw, int* apos, unsigned* cnt) {
    const int wid = threadIdx.x >> 6, lane = threadIdx.x & 63, t = blockIdx.x * 4 + wid;
    const float4 lg = *(const float4*)(logits + (size_t)t * NE + lane * 4), rb = *(const float4*)(rbias + lane * 4);
    float s0 = 1.f / (1.f + expf(-lg.x)), s1 = 1.f / (1.f + expf(-lg.y)), s2 = 1.f / (1.f + expf(-lg.z)), s3 = 1.f / (1.f + expf(-lg.w));
    float c0 = s0 + rb.x, c1 = s1 + rb.y, c2 = s2 + rb.z, c3 = s3 + rb.w;
    float a = fmaxf(c0, c1), bq = fminf(c0, c1);
    { const float hi2 = fmaxf(c2, c3), lo2 = fminf(c2, c3); const float na = fmaxf(a, hi2); const float nb = fmaxf(fminf(a, hi2), fmaxf(bq, lo2)); a = na; bq = nb; }
#pragma unroll
    for (int o = 1; o < 8; o <<= 1) { const float oa = __shfl_xor(a, o), ob = __shfl_xor(bq, o); const float na = fmaxf(a, oa), nb = fmaxf(fminf(a, oa), fmaxf(bq, ob)); a = na; bq = nb; }
    const float gs = a + bq; const int grp = lane >> 3;
    int rank = 0;
#pragma unroll
    for (int j = 0; j < 8; ++j) { const float og = __shfl(gs, j * 8); rank += (og > gs || (og == gs && j < grp)) ? 1 : 0; }
    const bool gsel = rank < 4;
    if (!gsel) { c0 = c1 = c2 = c3 = -INFINITY; }
    float wsum = 0.f, myw = 0.f; int mye = 0;
#pragma unroll
    for (int k = 0; k < TOPK; ++k) {
        float bv = c0; int bi = 0;
        if (c1 > bv) { bv = c1; bi = 1; } if (c2 > bv) { bv = c2; bi = 2; } if (c3 > bv) { bv = c3; bi = 3; }
        int be = lane * 4 + bi;
#pragma unroll
        for (int o = 1; o < 64; o <<= 1) { const float ov = __shfl_xor(bv, o); const int oe = __shfl_xor(be, o); if (ov > bv || (ov == bv && oe < be)) { bv = ov; be = oe; } }
        float sc = 0.f;
        if ((be >> 2) == lane) { const int bi2 = be & 3; sc = bi2 == 0 ? s0 : bi2 == 1 ? s1 : bi2 == 2 ? s2 : s3; if (bi2 == 0) c0 = -INFINITY; else if (bi2 == 1) c1 = -INFINITY; else if (bi2 == 2) c2 = -INFINITY; else c3 = -INFINITY; }
        sc = __shfl(sc, be >> 2);
        wsum += sc;
        if (lane == k) { myw = sc; mye = be; }
    }
    if (lane < TOPK) {
        const int aidx = t * TOPK + lane;
        tope[aidx] = mye; topw[aidx] = myw / wsum * 2.5f;
        apos[aidx] = (int)atomicAdd(&cnt[mye], 1u);
    }
}
template <int TM>
__global__ void __launch_bounds__(256) escan(const unsigned* __restrict__ cnt, int* off, int* toff) {
    __shared__ int sc[256], st[256];
    const int e = threadIdx.x; const int c = (int)cnt[e];
    sc[e] = c; st[e] = (c + TM - 1) / TM;
    __syncthreads();
    if (e == 0) { int a = 0, b = 0; for (int i = 0; i < 256; ++i) { const int ca = sc[i], cb = st[i]; sc[i] = a; st[i] = b; a += ca; b += cb; } off[256] = a; toff[256] = b; }
    __syncthreads();
    off[e] = sc[e]; toff[e] = st[e];
}
__global__ void __launch_bounds__(256) escatter(const int* __restrict__ tope, const int* __restrict__ apos, const int* __restrict__ off, int* rowa) {
    const int a = blockIdx.x * 256 + threadIdx.x;
    rowa[off[tope[a]] + apos[a]] = a;
}
template <int MODE>
__global__ void __launch_bounds__(256) egemm(const float* __restrict__ X, const float* __restrict__ W0, const float* __restrict__ W1, const int* __restrict__ off, const int* __restrict__ toff, const int* __restrict__ rowa,
                                            const float* __restrict__ topw, float* out) {
    __shared__ float As[16][68], Bs[16][68], Cs[16][68];
    __shared__ int se;
    const int tile = blockIdx.y;
    if (tile >= toff[256]) return;
    const int tid = threadIdx.x, tx = tid & 15, ty = tid >> 4;
    if (tid == 0) { int lo = 0, hi = 255; while (lo < hi) { const int mid = (lo + hi + 1) >> 1; if (toff[mid] <= tile) lo = mid; else hi = mid - 1; } se = lo; }
    __syncthreads();
    const int e = se, r0 = off[e] + (tile - toff[e]) * 64, rend = off[e + 1];
    constexpr int K = MODE == 0 ? DM : DE, N = MODE == 0 ? DE : DM;
    const int n0 = blockIdx.x * 64;
    const float* B0 = W0 + (size_t)e * K * N; const float* B1 = MODE == 0 ? W1 + (size_t)e * K * N : nullptr;
    const int ar = tid >> 2, ak = (tid & 3) * 4, bk = tid >> 4, bn = (tid & 15) * 4;
    const int arow = r0 + ar; const bool aval = arow < rend;
    const float* ap = nullptr;
    if (aval) ap = MODE == 0 ? X + (size_t)(rowa[arow] >> 3) * DM : X + (size_t)arow * DE;
    float acc[4][4], acu[4][4];
#pragma unroll
    for (int i = 0; i < 4; ++i)
#pragma unroll
        for (int j = 0; j < 4; ++j) { acc[i][j] = 0.f; acu[i][j] = 0.f; }
    for (int k0 = 0; k0 < K; k0 += 16) {
        float4 av = make_float4(0.f, 0.f, 0.f, 0.f);
        if (aval) av = *(const float4*)(ap + k0 + ak);
        const float4 bv = *(const float4*)(B0 + (size_t)(k0 + bk) * N + n0 + bn);
        float4 cv = make_float4(0.f, 0.f, 0.f, 0.f);
        if (MODE == 0) cv = *(const float4*)(B1 + (size_t)(k0 + bk) * N + n0 + bn);
        __syncthreads();
        As[ak + 0][ar] = av.x; As[ak + 1][ar] = av.y; As[ak + 2][ar] = av.z; As[ak + 3][ar] = av.w;
        *(float4*)&Bs[bk][bn] = bv; if (MODE == 0) *(float4*)&Cs[bk][bn] = cv;
        __syncthreads();
#pragma unroll
        for (int kk = 0; kk < 16; ++kk) {
            const float4 a = *(const float4*)&As[kk][ty * 4];
            const float4 b = *(const float4*)&Bs[kk][tx * 4];
            const float aa[4] = {a.x, a.y, a.z, a.w}, bb[4] = {b.x, b.y, b.z, b.w};
#pragma unroll
            for (int i = 0; i < 4; ++i)
#pragma unroll
                for (int j = 0; j < 4; ++j) acc[i][j] = fmaf(aa[i], bb[j], acc[i][j]);
            if (MODE == 0) { const float4 c = *(const float4*)&Cs[kk][tx * 4]; const float cc[4] = {c.x, c.y, c.z, c.w};
#pragma unroll
                for (int i = 0; i < 4; ++i)
#pragma unroll
                    for (int j = 0; j < 4; ++j) acu[i][j] = fmaf(aa[i], cc[j], acu[i][j]); }
        }
    }
#pragma unroll
    for (int i = 0; i < 4; ++i) { const int r = r0 + ty * 4 + i; if (r < rend) {
        if (MODE == 0) {
#pragma unroll
            for (int j = 0; j < 4; ++j) { const float g = acc[i][j]; out[(size_t)r * DE + n0 + tx * 4 + j] = g / (1.f + expf(-g)) * acu[i][j]; } }
        else { const int a = rowa[r]; const float w = topw[a];
#pragma unroll
            for (int j = 0; j < 4; ++j) out[(size_t)a * DM + n0 + tx * 4 + j] = acc[i][j] * w; } } }
}
}


namespace fk {
#define LAS __attribute__((address_space(3)))
#define GAS __attribute__((address_space(1)))
typedef unsigned short bf16_t;
typedef short bf16x8 __attribute__((ext_vector_type(8)));
typedef float f32x4 __attribute__((ext_vector_type(4)));
typedef float f32x2 __attribute__((ext_vector_type(2)));
typedef float f32x16 __attribute__((ext_vector_type(16)));
typedef unsigned u32x4 __attribute__((ext_vector_type(4)));
typedef unsigned u32x2 __attribute__((ext_vector_type(2)));
constexpr int NWAVES = 8, NTHR = 512;
constexpr int INCP = 4352;
constexpr float LOG2E = 1.4426950408889634f;
constexpr float QS_A = 0.125f * LOG2E;
constexpr float QS_B = 0.10206207261596577f * LOG2E;
#define LDS_WAIT() asm volatile("s_waitcnt lgkmcnt(0)" ::: "memory")
#define VM_WAIT() asm volatile("s_waitcnt vmcnt(0)" ::: "memory")
__device__ __forceinline__ unsigned f2bf(float f) { unsigned u = __builtin_bit_cast(unsigned, f); return (u + 0x7fffu + ((u >> 16) & 1u)) >> 16; }
__device__ __forceinline__ unsigned pk2(float lo, float hi) { return f2bf(lo) | (f2bf(hi) << 16); }
__device__ __forceinline__ float bf2f(unsigned short b) { return __builtin_bit_cast(float, (unsigned)b << 16); }
__device__ __forceinline__ float bflo(unsigned w) { return __builtin_bit_cast(float, w << 16); }
__device__ __forceinline__ float bfhi(unsigned w) { return __builtin_bit_cast(float, w & 0xffff0000u); }
__device__ __forceinline__ float sigmoidf_(float x) { return __builtin_amdgcn_rcpf(1.f + __expf(-x)); }
__device__ __forceinline__ float wave_sum(float v) {
#pragma unroll
    for (int o = 1; o < 64; o <<= 1) v += __shfl_xor(v, o);
    return v;
}

namespace pg8 {
constexpr int BM = 256, BK = 64, HALF = 128, HTB = HALF * BK * 2, STAGE_BYTES = 8 * HTB, NXCD = 8, WGM = 8;
__host__ __device__ __forceinline__ int lds_byte(int r, int c) { const int st = (r >> 4) * 2 + (c >> 5), rr = r & 15, cc = c & 31, ob = rr * 64 + cc * 2; return st * 1024 + (ob ^ (((ob >> 9) & 1) << 5)); }
__host__ __device__ __forceinline__ void stage_rc(int b, int& R, int& C) { const int st = b / 1024, sb = b % 1024, swz = sb ^ (((sb >> 9) & 1) << 5); R = (st >> 1) * 16 + swz / 64; C = (st & 1) * 32 + (swz % 64) / 2; }
__host__ __device__ __forceinline__ int perm32(int rho) { const int n = rho >> 4, i = rho & 15; return 8 * (i >> 2) + 4 * n + (i & 3); }

struct Unit { int pm, pn, e, r0, rend; };
struct Gemm { const bf16_t* A; const bf16_t* Bt; int M, N, K, lda, ldb; };

struct StaticOrder {
    int nM, nN, nwg, G, c;
    __device__ void init(int M, int N, int G_, int c_) { nM = M / BM; nN = N / BM; nwg = nM * nN; G = G_; c = c_; }
    __device__ bool next(int i, Unit& u) const {
        const long L = (long)i * G + c; if (L >= nwg) return false;
        int wgid = (int)L; { const int q = nwg / NXCD, r = nwg % NXCD, xcd = wgid % NXCD, off = wgid / NXCD; wgid = (xcd < r ? xcd * (q + 1) : r * (q + 1) + (xcd - r) * q) + off; }
        const int nig = WGM * nN, gid = wgid / nig, fm = gid * WGM, gsz = (nM - fm) < WGM ? (nM - fm) : WGM;
        u.pm = fm + ((wgid % nig) % gsz); u.pn = (wgid % nig) / gsz; u.e = 0; u.r0 = u.pm * BM; u.rend = u.r0 + BM; return true;
    }
    __device__ __forceinline__ int a_row(const Unit& u, int r) const { return u.pm * BM + r; }
    __device__ __forceinline__ const char* b_ptr(const Gemm& g, const Unit& u) const { return (const char*)g.Bt + (size_t)u.pn * BM * g.ldb * 2; }
};

typedef float f32x2_t_ __attribute__((ext_vector_type(2))); typedef __bf16 bf16x2_t_ __attribute__((ext_vector_type(2)));
__device__ __forceinline__ unsigned cvt_pk_bf16(float lo, float hi) { const f32x2_t_ v = {lo, hi}; const bf16x2_t_ b = __builtin_convertvector(v, bf16x2_t_); return __builtin_bit_cast(unsigned, b); }

template <class Epi, class Sched, bool ALIGN_EPI>
__device__ __forceinline__ void gemm_phase(LAS unsigned char* lds, const Gemm g, const Sched& S, const Epi& E) {
    int tid_ = threadIdx.x; asm volatile("" : "+v"(tid_));
    const int tid = tid_, wid = __builtin_amdgcn_readfirstlane(tid >> 6), lane = tid & 63, wr = wid >> 2, wc = wid & 3, fr = lane & 15, fq = lane >> 4;
    const int K = g.K, nt = K / BK;
    int RA[2]; unsigned CA[2], voffB[2];
#pragma unroll
    for (int i = 0; i < 2; ++i) { int R, C; stage_rc(tid * 16 + i * 8192, R, C); const int Rb = (R & ~31) + perm32(R & 31);
        RA[i] = R; CA[i] = (unsigned)C * 2u; voffB[i] = (unsigned)(Rb * g.ldb + C) * 2u; }
    const unsigned lda2 = (unsigned)g.lda * 2u;
    const size_t hstepB = (size_t)HALF * g.ldb * 2;
    const unsigned ldsw = (unsigned)wid * 1024u;
    const int aoff = lds_byte(wr * 64 + fr, fq * 8), boff = lds_byte(wc * 32 + fr, fq * 8);
    const char* const Abase = (const char*)g.A;
#define PG8_SA(b, h) (((b) * 2 + (h)) * HTB)
#define PG8_SB(b, h) ((4 + (b) * 2 + (h)) * HTB)
#define PG8_STAGE_B(bufoff, gbase) do { _Pragma("unroll") for (int _i = 0; _i < 2; ++_i) \
        __builtin_amdgcn_global_load_lds((const unsigned*)((const char*)(gbase) + voffB[_i]), (LAS unsigned*)(lds + (bufoff) + ldsw + _i * 8192), 16, 0, 0); } while (0)
#define PG8_STAGE_A(bufoff, V0, V1, kb) do { \
        __builtin_amdgcn_global_load_lds((const unsigned*)((Abase + (kb)) + (V0)), (LAS unsigned*)(lds + (bufoff) + ldsw), 16, 0, 0); \
        __builtin_amdgcn_global_load_lds((const unsigned*)((Abase + (kb)) + (V1)), (LAS unsigned*)(lds + (bufoff) + ldsw + 8192), 16, 0, 0); } while (0)
#define PG8_LDA(dst, b, h) do { _Pragma("unroll") for (int m = 0; m < 4; ++m) _Pragma("unroll") for (int k = 0; k < 2; ++k) dst[m][k] = *(const LAS bf16x8*)(lds + PG8_SA(b, h) + aoff + m * 2048 + k * 1024); } while (0)
#define PG8_LDB(dst, b, h) do { _Pragma("unroll") for (int n = 0; n < 2; ++n) _Pragma("unroll") for (int k = 0; k < 2; ++k) dst[n][k] = *(const LAS bf16x8*)(lds + PG8_SB(b, h) + boff + n * 2048 + k * 1024); } while (0)
#define PG8_MMA(ai, bj, At, Bt) do { __builtin_amdgcn_s_setprio(1); _Pragma("unroll") for (int m = 0; m < 4; ++m) _Pragma("unroll") for (int n = 0; n < 2; ++n) _Pragma("unroll") for (int k = 0; k < 2; ++k) \
        acc[ai][bj][m][n] = __builtin_amdgcn_mfma_f32_16x16x32_bf16(Bt[n][k], At[m][k], acc[ai][bj][m][n], 0, 0, 0); __builtin_amdgcn_s_setprio(0); } while (0)
#define PG8_WAIT_V(n) asm volatile("s_waitcnt vmcnt(" #n ")" ::: "memory")
#define PG8_WAIT_L(n) asm volatile("s_waitcnt lgkmcnt(" #n ")" ::: "memory")
#define PG8_BAR __builtin_amdgcn_s_barrier()
#define PG8_SCHED __builtin_amdgcn_sched_barrier(0)
#define PG8_VOFF(V, U) do { V##00 = (unsigned)S.a_row(U, RA[0]) * lda2 + CA[0]; V##01 = (unsigned)S.a_row(U, RA[1]) * lda2 + CA[1]; \
        V##10 = (unsigned)S.a_row(U, HALF + RA[0]) * lda2 + CA[0]; V##11 = (unsigned)S.a_row(U, HALF + RA[1]) * lda2 + CA[1]; } while (0)
    Unit cur, nxt; int ui = 0;
    if (!S.next(0, cur)) return;
    f32x4 acc[2][2][4][2];
#pragma unroll
    for (int a = 0; a < 2; ++a)
#pragma unroll
        for (int b = 0; b < 2; ++b)
#pragma unroll
            for (int m = 0; m < 4; ++m)
#pragma unroll
                for (int n = 0; n < 2; ++n) acc[a][b][m][n] = (f32x4){0.f, 0.f, 0.f, 0.f};
    bf16x8 At[4][2], B0[2][2], B1[2][2];
    unsigned vc00, vc01, vc10, vc11;
    PG8_VOFF(vc, cur);
    const char* cB = S.b_ptr(g, cur);
    PG8_STAGE_B(PG8_SB(0, 0), cB); PG8_STAGE_B(PG8_SB(0, 1), cB + hstepB); PG8_STAGE_A(PG8_SA(0, 0), vc00, vc01, 0u); PG8_STAGE_A(PG8_SA(0, 1), vc10, vc11, 0u);
    if (wr == 1) PG8_BAR;
    PG8_WAIT_V(2); PG8_BAR;
    PG8_STAGE_B(PG8_SB(1, 0), cB + 128); PG8_STAGE_A(PG8_SA(1, 0), vc00, vc01, 128u); PG8_STAGE_B(PG8_SB(1, 1), cB + hstepB + 128);
    PG8_WAIT_V(6); PG8_BAR;
    for (;;) {
        const bool has_next = S.next(ui + 1, nxt);
        const char* nB = has_next ? S.b_ptr(g, nxt) : cB;
        const bool half1 = (cur.rend - cur.r0) > HALF;
#pragma unroll 1
        for (int t = 0; t < nt; t += 2) {
            const bool last = (t == nt - 2);
            const unsigned kb1 = (unsigned)(t + 1) * 128u;
            unsigned kb2 = (unsigned)(t + 2) * 128u;
            unsigned s00 = vc00, s01 = vc01, s10 = vc10, s11 = vc11;
            const char* b2 = cB + (size_t)kb2;
            if (last) { kb2 = 0u; b2 = nB; if (has_next) { PG8_VOFF(s, nxt); } }
            const unsigned kb3 = kb2 + 128u; const char* b3 = b2 + 128;
            PG8_LDB(B0, 0, 0); PG8_LDB(B1, 0, 1); PG8_SCHED; PG8_LDA(At, 0, 0); PG8_STAGE_A(PG8_SA(1, 1), vc10, vc11, kb1);
            PG8_WAIT_V(8); PG8_WAIT_L(0); PG8_BAR; PG8_MMA(0, 0, At, B0); PG8_MMA(0, 1, At, B1); PG8_BAR; PG8_SCHED;
            PG8_LDA(At, 0, 1); PG8_STAGE_B(PG8_SB(0, 0), b2); PG8_STAGE_B(PG8_SB(0, 1), b2 + hstepB); PG8_STAGE_A(PG8_SA(0, 0), s00, s01, kb2);
            PG8_WAIT_V(8); PG8_WAIT_L(0); PG8_BAR; if (half1) { PG8_MMA(1, 0, At, B0); PG8_MMA(1, 1, At, B1); } PG8_BAR; PG8_SCHED;
            PG8_LDB(B0, 1, 0); PG8_LDB(B1, 1, 1); PG8_SCHED; PG8_LDA(At, 1, 0); PG8_STAGE_A(PG8_SA(0, 1), s10, s11, kb2);
            PG8_WAIT_V(8); PG8_WAIT_L(0); PG8_BAR; PG8_MMA(0, 0, At, B0); PG8_MMA(0, 1, At, B1); PG8_BAR; PG8_SCHED;
            PG8_LDA(At, 1, 1); PG8_STAGE_B(PG8_SB(1, 0), b3); PG8_STAGE_B(PG8_SB(1, 1), b3 + hstepB); PG8_STAGE_A(PG8_SA(1, 0), s00, s01, kb3);
            PG8_WAIT_V(8); PG8_WAIT_L(0); PG8_BAR; if (half1) { PG8_MMA(1, 0, At, B0); PG8_MMA(1, 1, At, B1); } PG8_BAR; PG8_SCHED;
        }
        if constexpr (ALIGN_EPI) { if (wr == 0) PG8_BAR; }
        E(acc, cur, wr, wc, fr, fq);
        if (!has_next) break;
#pragma unroll
        for (int a = 0; a < 2; ++a)
#pragma unroll
            for (int b = 0; b < 2; ++b)
#pragma unroll
                for (int m = 0; m < 4; ++m)
#pragma unroll
                    for (int n = 0; n < 2; ++n) acc[a][b][m][n] = (f32x4){0.f, 0.f, 0.f, 0.f};
        cur = nxt; cB = nB; PG8_VOFF(vc, cur); ++ui;
        if constexpr (ALIGN_EPI) { if (wr == 1) PG8_BAR; }
    }
    PG8_WAIT_V(0);
    if constexpr (!ALIGN_EPI) { if (wr == 0) PG8_BAR; }
    PG8_BAR;
#undef PG8_SA
#undef PG8_SB
#undef PG8_STAGE_A
#undef PG8_STAGE_B
#undef PG8_LDA
#undef PG8_LDB
#undef PG8_MMA
#undef PG8_WAIT_V
#undef PG8_WAIT_L
#undef PG8_BAR
#undef PG8_SCHED
#undef PG8_VOFF
}
#define PG8_TILE_BEGIN(acc, wr, wc, fr, fq) \
    _Pragma("unroll") for (int ai = 0; ai < 2; ++ai) _Pragma("unroll") for (int m = 0; m < 4; ++m) _Pragma("unroll") for (int bj = 0; bj < 2; ++bj) { \
        const int trow = ai * 128 + wr * 64 + m * 16 + fr, tcol = bj * 128 + wc * 32 + 8 * fq; f32x4 v0 = acc[ai][bj][m][0], v1 = acc[ai][bj][m][1];
#define PG8_TILE_END }
__device__ __forceinline__ u32x4 pack8(f32x4 v0, f32x4 v1) { u32x4 w; w.x = cvt_pk_bf16(v0[0], v0[1]); w.y = cvt_pk_bf16(v0[2], v0[3]); w.z = cvt_pk_bf16(v1[0], v1[1]); w.w = cvt_pk_bf16(v1[2], v1[3]); return w; }
}

#define XB_TMO      128
#define XB_XCNT(j)  (256  + 64 * (j))
#define XB_XSUB(j)  (1280 + 64 * (j))
#define XB_XGEN(j)  (2304 + 64 * (j))
#define XB_TOP      3328
#define XB_TOPGEN   3392
#define XCD_BAR_WORDS 3456
#define XB_SPIN_CAP (1u << 18)

__device__ __forceinline__ unsigned xb_ld(unsigned* p)              { return __hip_atomic_load(p, __ATOMIC_RELAXED, __HIP_MEMORY_SCOPE_AGENT); }
__device__ __forceinline__ unsigned xb_add(unsigned* p, unsigned v) { return __hip_atomic_fetch_add(p, v, __ATOMIC_RELAXED, __HIP_MEMORY_SCOPE_AGENT); }
__device__ __forceinline__ unsigned xb_xcc_id() { return (unsigned)__builtin_amdgcn_s_getreg((3 << 11) | 20) & 0xFu; }
#define XB_SPIN(cond, bar) do { unsigned _sp = 0; while (cond) { __builtin_amdgcn_s_sleep(1); \
    if ((++_sp & 255u) == 0u) { if (xb_ld(&(bar)[XB_TMO])) break; if (_sp > XB_SPIN_CAP) { atomicAdd(&(bar)[XB_TMO], 1u); break; } } } } while (0)

struct XcdBarrier {
    unsigned* bar; unsigned x;
    volatile LAS unsigned* st;
};

__device__ __forceinline__ XcdBarrier xcd_barrier_post(unsigned* bar, volatile LAS unsigned* st) {
    XcdBarrier b; b.bar = bar; b.x = xb_xcc_id(); b.st = st;
    if (threadIdx.x == 0) (void)xb_add(&bar[XB_XCNT(b.x)], 1u);
    return b;
}
__device__ __forceinline__ void xcd_barrier_complete(unsigned* bar, unsigned x, unsigned& nloc, unsigned& nx) {
    const unsigned G = gridDim.x * gridDim.y * gridDim.z;
    unsigned sum, cnt, mine, sp = 0u;
    for (;;) {
        sum = 0u; cnt = 0u; mine = 0u;
#pragma unroll
        for (unsigned j = 0; j < 16; ++j) { const unsigned c = xb_ld(&bar[XB_XCNT(j)]); sum += c; cnt += (c > 0u) ? 1u : 0u; mine = (j == x) ? c : mine; }
        if (sum == G) break;
        __builtin_amdgcn_s_sleep(1);
        if ((++sp & 255u) == 0u) { if (xb_ld(&bar[XB_TMO])) break; if (sp > XB_SPIN_CAP) { atomicAdd(&bar[XB_TMO], 1u); break; } }
    }
    nloc = mine > 0u ? mine : 1u; nx = cnt > 0u ? cnt : 1u;
}

__device__ __forceinline__ void xcd_barrier(const XcdBarrier& b) {
    asm volatile("s_waitcnt vmcnt(0)" ::: "memory");
    __syncthreads();
    if (threadIdx.x == 0) {
        unsigned* bar = b.bar; asm volatile("" : "+s"(bar));
        __builtin_amdgcn_s_waitcnt(0);
        unsigned nloc = b.st[0], nx = b.st[1];
        if (nloc == 0u) { xcd_barrier_complete(bar, b.x, nloc, nx); b.st[0] = nloc; b.st[1] = nx; }
        const unsigned old = xb_add(&bar[XB_XSUB(b.x)], 1u);
        const unsigned gen = old / nloc;
        if (old + 1u == (gen + 1u) * nloc) {
            __builtin_amdgcn_fence(__ATOMIC_RELEASE, "agent");
            asm volatile("s_waitcnt vmcnt(0)" ::: "memory");
            const unsigned og = xb_add(&bar[XB_TOP], 1u);
            const unsigned tg = og / nx;
            if (og + 1u == (tg + 1u) * nx) xb_add(&bar[XB_TOPGEN], 1u);
            else XB_SPIN(xb_ld(&bar[XB_TOPGEN]) == tg, bar);
            __builtin_amdgcn_fence(__ATOMIC_ACQUIRE, "agent");
            xb_add(&bar[XB_XGEN(b.x)], 1u);
            asm volatile("s_waitcnt vmcnt(0)" ::: "memory");
        } else {
            XB_SPIN(xb_ld(&bar[XB_XGEN(b.x)]) == gen, bar);
            __builtin_amdgcn_fence(__ATOMIC_ACQUIRE, "agent");
            asm volatile("s_waitcnt vmcnt(0)" ::: "memory");
        }
    }
    __syncthreads();
}


struct Params {
    const float* in[22]; float* out; unsigned char* ws;
    int ph_lo, ph_hi;
};
constexpr size_t MiB = 1u << 20;
constexpr size_t WS_CTL = 0, CTL_BYTES = 1 * MiB;
constexpr int CW_BAR = 4096;
constexpr int CW_CNT = 16384;
constexpr size_t WS_WIN = 2 * MiB;
constexpr size_t SZ_WIN = (size_t)INCP * DM;
constexpr size_t SZ_WUQ = (size_t)768 * QL, SZ_WUKV = (size_t)1024 * KVL;
constexpr size_t WS_WUQ = WS_WIN + 2 * SZ_WIN * 2;
constexpr size_t WS_WUKV = WS_WUQ + 2 * SZ_WUQ * 2;
constexpr size_t SZ_WP = (size_t)DM * 512, SZ_WOUT = (size_t)DM * DM;
constexpr size_t WS_WPA = WS_WUKV + 2 * SZ_WUKV * 2;
constexpr size_t WS_WPB = WS_WPA + 2 * SZ_WP * 2;
constexpr size_t WS_WOUT = WS_WPB + 2 * SZ_WP * 2;
constexpr size_t SZ_WRT = (size_t)NE * DM, SZ_WSGU = (size_t)512 * DM, SZ_WSD = (size_t)DM * DSH;
constexpr size_t WS_WRT = WS_WOUT + 2 * SZ_WOUT * 2;
constexpr size_t WS_WSGU = WS_WRT + 2 * SZ_WRT * 2;
constexpr size_t WS_WSD = WS_WSGU + 2 * SZ_WSGU * 2;
constexpr size_t WS_CS = WS_WSD + 2 * SZ_WSD * 2;
constexpr size_t WS_KM = WS_CS + (size_t)SEQ * 16 * 8;
constexpr size_t WS_SEL = WS_KM + (size_t)NB * HA * NBLK * 64 * 4;
constexpr size_t WS_XB = WS_SEL + (size_t)T * 8 * 4;
constexpr size_t WS_CQN = WS_XB + (size_t)T * DM * 2;
constexpr size_t WS_CKVN = WS_CQN + (size_t)T * QL * 2;
constexpr size_t WS_QB = WS_CKVN + (size_t)T * KVL * 2;
constexpr size_t WS_KB = WS_QB + (size_t)T * 768 * 2;
constexpr size_t WS_VB = WS_KB + (size_t)T * 768 * 2;
constexpr size_t WS_OAB = WS_VB + (size_t)T * 512 * 2;
constexpr size_t WS_TMP = WS_OAB + (size_t)T * 1024 * 2;
constexpr size_t WS_MRG = WS_TMP + (size_t)T * 1024 * 2;
constexpr size_t WS_PRE = WS_MRG + (size_t)T * 1024 * 2;
constexpr size_t WS_X1 = WS_PRE + (size_t)T * 1024 * 4;
constexpr size_t WS_X1B = WS_X1 + (size_t)T * 1024 * 4;
constexpr size_t WS_X2 = WS_X1B + (size_t)T * 1024 * 2;
constexpr size_t WS_LOG = WS_X2 + (size_t)T * 1024 * 4;
constexpr size_t WS_HS = WS_LOG + (size_t)T * NE * 4;
constexpr size_t WS_SH = WS_HS + (size_t)T * DSH * 2;
constexpr size_t WS_TOPE = WS_SH + (size_t)T * DM * 2;
constexpr size_t WS_TOPW = WS_TOPE + (size_t)NA * 4;
constexpr size_t WS_APOS = WS_TOPW + (size_t)NA * 4;
constexpr size_t WS_ROWA = WS_APOS + (size_t)NA * 4;
constexpr size_t WS_HIST = WS_ROWA + (size_t)NA * 8;
constexpr size_t WS_PO = WS_HIST + (size_t)1024 * 256 * 4;
constexpr size_t WS_PML = WS_PO + (size_t)T * 8 * 3 * 64 * 2;
constexpr size_t WS_HE = WS_PML + (size_t)T * 8 * 3 * 128;
constexpr size_t WS_Y = WS_HE + (size_t)NA * DE * 2;
constexpr size_t WS_PROJ = WS_Y + (size_t)NA * DM * 2;
constexpr size_t SZ_WEGU = (size_t)NE * 512 * DM, SZ_WED = (size_t)NE * DM * DE;
constexpr size_t WS_WEGU = WS_PROJ + (size_t)T * INCP * 2;
constexpr size_t WS_WED = WS_WEGU + 2 * SZ_WEGU * 2;
constexpr size_t WS_FAST_END = WS_WED + 2 * SZ_WED * 2;
constexpr size_t WS_NEED = WS_FAST_END;
static_assert(WS_NEED <= (size_t)2040 * MiB, "ws map");

constexpr int LDS_BYTES = 147456;
constexpr int RING_BYTES = 131072, MISC_OFF = RING_BYTES + 1024, TAB_OFF = RING_BYTES + 2048;

struct Frame { LAS unsigned char* lds; int tid, lane, wave, G, vcu; };

template <class RowMap>
__device__ __forceinline__ void transpose_item(const float* W, int K, int N, bf16_t* WT, int ldk, RowMap rm, LAS float* scr, int item, int lane) {
    const int nblk = N / 32, kb = item / nblk, nb = item % nblk, k0 = 64 * kb, n0 = 32 * nb;
#pragma unroll 8
    for (int i = 0; i < 32; ++i) { const int kk = 2 * i + (lane >> 5); scr[kk * 33 + (lane & 31)] = W[(size_t)(k0 + kk) * N + n0 + (lane & 31)]; }
    LDS_WAIT(); asm volatile("" ::: "memory");
    const int c = lane & 7;
#pragma unroll
    for (int j = 0; j < 4; ++j) { const int n = (lane >> 3) + 8 * j; const LAS float* s = scr + (8 * c) * 33 + n;
        u32x4 o; o.x = pk2(s[0 * 33], s[1 * 33]); o.y = pk2(s[2 * 33], s[3 * 33]); o.z = pk2(s[4 * 33], s[5 * 33]); o.w = pk2(s[6 * 33], s[7 * 33]);
        *(u32x4*)(WT + (size_t)rm(n0 + n) * ldk + k0 + 8 * c) = o; }
    LDS_WAIT(); asm volatile("" ::: "memory");
}
struct RowId { __device__ __forceinline__ int operator()(int n) const { return n; } };

struct EpiProj {
    bf16_t* O; const float* bg;
    __device__ __forceinline__ void operator()(const f32x4 (&acc)[2][2][4][2], const pg8::Unit& u, int wr, int wc, int fr, int fq) const {
        PG8_TILE_BEGIN(acc, wr, wc, fr, fq)
            const int row = u.pm * 256 + trow, col = u.pn * 256 + tcol;
            if (col < C_KA) { v0 = v0 * QS_A; v1 = v1 * QS_A; }
            else if (col >= C_GA && col < INC) { const f32x4 b0 = *(const f32x4*)(bg + col - C_GA), b1 = *(const f32x4*)(bg + col - C_GA + 4);
#pragma unroll
                for (int i = 0; i < 4; ++i) { v0[i] = sigmoidf_(v0[i] + b0[i]); v1[i] = sigmoidf_(v1[i] + b1[i]); } }
            *(u32x4*)(O + (size_t)row * INCP + col) = pg8::pack8(v0, v1);
        PG8_TILE_END
    }
};

struct RowQ { __device__ __forceinline__ int operator()(int n) const { const int h = n / 96, d = n % 96; if (d < 64) return n; const int i = d - 64; return h * 96 + 64 + (i < 16 ? 2 * i : 2 * (i - 16) + 1); } };

struct EpiQ {
    bf16_t* O; const f32x2* CS;
    __device__ __forceinline__ void operator()(const f32x4 (&acc)[2][2][4][2], const pg8::Unit& u, int wr, int wc, int fr, int fq) const {
        PG8_TILE_BEGIN(acc, wr, wc, fr, fq)
            const int row = u.pm * 256 + trow, col = u.pn * 256 + tcol, d = col % 96;
            if (d >= 64) { const int pos = row % SEQ, i0 = (d - 64) >> 1; const f32x2* cs = CS + (size_t)pos * 16 + i0;
                const f32x2 c0 = cs[0], c1 = cs[1], c2 = cs[2], c3 = cs[3];
                const f32x4 a = v0, b = v1;
                v0[0] = a[0] * c0[0] - a[1] * c0[1]; v0[1] = a[1] * c0[0] + a[0] * c0[1]; v0[2] = a[2] * c1[0] - a[3] * c1[1]; v0[3] = a[3] * c1[0] + a[2] * c1[1];
                v1[0] = b[0] * c2[0] - b[1] * c2[1]; v1[1] = b[1] * c2[0] + b[0] * c2[1]; v1[2] = b[2] * c3[0] - b[3] * c3[1]; v1[3] = b[3] * c3[0] + b[2] * c3[1]; }
            v0 = v0 * QS_B; v1 = v1 * QS_B;
            *(u32x4*)(O + (size_t)row * 768 + col) = pg8::pack8(v0, v1);
        PG8_TILE_END
    }
};
struct EpiKV {
    bf16_t* KB; bf16_t* VB;
    __device__ __forceinline__ void operator()(const f32x4 (&acc)[2][2][4][2], const pg8::Unit& u, int wr, int wc, int fr, int fq) const {
        PG8_TILE_BEGIN(acc, wr, wc, fr, fq)
            const int row = u.pm * 256 + trow, col = u.pn * 256 + tcol, h = col >> 7, j = col & 127;
            bf16_t* dst = (j < 64) ? KB + (size_t)row * 768 + h * 96 + j : VB + (size_t)row * 512 + h * 64 + (j - 64);
            *(u32x4*)dst = pg8::pack8(v0, v1);
        PG8_TILE_END
    }
};

__device__ __forceinline__ void prep_phase(const Frame& F, const bf16_t* PROJ, const float* qn, const float* kvn, const f32x2* CS, bf16_t* CQN, bf16_t* CKVN, bf16_t* KB, float* KM) {
    int lane_ = F.lane; asm volatile("" : "+v"(lane_));
    const int gw = F.vcu * NWAVES + F.wave, NGW = F.G * NWAVES, lane = lane_;
    for (int row = gw; row < T; row += NGW) {
        const bf16_t* p = PROJ + (size_t)row * INCP;
        u32x4 a = (u32x4){0u, 0u, 0u, 0u}, b = (u32x4){0u, 0u, 0u, 0u};
        if (lane < 48) a = *(const u32x4*)(p + C_CQ + lane * 8);
        if (lane < 32) b = *(const u32x4*)(p + C_CKV + lane * 8);
        float sq = 0.f, sk = 0.f;
#pragma unroll
        for (int i = 0; i < 4; ++i) { const float x = bflo(a[i]), y = bfhi(a[i]), z = bflo(b[i]), w = bfhi(b[i]); sq += x * x + y * y; sk += z * z + w * w; }
        sq = wave_sum(sq); sk = wave_sum(sk);
        const float rq = rsqrtf(sq * (1.f / QL) + RMS_EPS), rk = rsqrtf(sk * (1.f / KVL) + RMS_EPS);
        if (lane < 48) { const f32x4 g0 = *(const f32x4*)(qn + lane * 8), g1 = *(const f32x4*)(qn + lane * 8 + 4); u32x4 o;
            o.x = pk2(bflo(a.x) * rq * g0[0], bfhi(a.x) * rq * g0[1]); o.y = pk2(bflo(a.y) * rq * g0[2], bfhi(a.y) * rq * g0[3]);
            o.z = pk2(bflo(a.z) * rq * g1[0], bfhi(a.z) * rq * g1[1]); o.w = pk2(bflo(a.w) * rq * g1[2], bfhi(a.w) * rq * g1[3]);
            *(u32x4*)(CQN + (size_t)row * QL + lane * 8) = o; }
        if (lane < 32) { const f32x4 g0 = *(const f32x4*)(kvn + lane * 8), g1 = *(const f32x4*)(kvn + lane * 8 + 4); u32x4 o;
            o.x = pk2(bflo(b.x) * rk * g0[0], bfhi(b.x) * rk * g0[1]); o.y = pk2(bflo(b.y) * rk * g0[2], bfhi(b.y) * rk * g0[3]);
            o.z = pk2(bflo(b.z) * rk * g1[0], bfhi(b.z) * rk * g1[1]); o.w = pk2(bflo(b.w) * rk * g1[2], bfhi(b.w) * rk * g1[3]);
            *(u32x4*)(CKVN + (size_t)row * KVL + lane * 8) = o; }
        if (lane < 16) { const float x1 = bf2f(p[C_KR + lane]), x2 = bf2f(p[C_KR + 16 + lane]); const f32x2 cs = CS[(size_t)(row % SEQ) * 16 + lane];
            const unsigned w = pk2(x1 * cs[0] - x2 * cs[1], x2 * cs[0] + x1 * cs[1]);
#pragma unroll
            for (int h = 0; h < 8; ++h) *(unsigned*)(KB + (size_t)row * 768 + h * 96 + 64 + 2 * lane) = w; }
    }
    for (int it = gw; it < NB * NBLK * HA; it += NGW) {
        const int h = it % HA, blk = (it / HA) % NBLK, b = it / (HA * NBLK), c = lane & 7, r0 = lane >> 3;
        const bf16_t* p = PROJ + ((size_t)b * SEQ + (size_t)blk * BLK + r0) * INCP + C_KA + h * 64 + c * 8;
        float s[8];
#pragma unroll
        for (int i = 0; i < 8; ++i) s[i] = 0.f;
        for (int i = 0; i < 32; ++i) { const u32x4 v = *(const u32x4*)(p + (size_t)i * 8 * INCP);
#pragma unroll
            for (int k = 0; k < 4; ++k) { s[2 * k] += bflo(v[k]); s[2 * k + 1] += bfhi(v[k]); } }
#pragma unroll
        for (int i = 0; i < 8; ++i) { s[i] += __shfl_xor(s[i], 8); s[i] += __shfl_xor(s[i], 16); s[i] += __shfl_xor(s[i], 32); }
        if (lane < 8) { float* o = KM + ((size_t)(b * HA + h) * NBLK + blk) * 64 + c * 8;
            *(f32x4*)o = (f32x4){s[0], s[1], s[2], s[3]} * (1.f / BLK); *(f32x4*)(o + 4) = (f32x4){s[4], s[5], s[6], s[7]} * (1.f / BLK); }
    }
}
__device__ __forceinline__ void mobasel_phase(const Frame& F, const bf16_t* PROJ, const float* KM, unsigned* SEL) {
    int tid_ = F.tid; asm volatile("" : "+v"(tid_));
    const int TPW = T / F.G, row0 = (int)blockIdx.x * TPW, b = row0 / SEQ, own = (row0 % SEQ) / BLK, hs = own * 64 + 4;
    LAS float* km = (LAS float*)F.lds;
    for (int i = tid_; i < 8 * own * 16; i += NTHR) { const int h = i / (own * 16), r = i % (own * 16);
        *(LAS f32x4*)(km + h * hs + r * 4) = *(const f32x4*)(KM + ((size_t)(b * HA + h) * NBLK) * 64 + r * 4); }
    __syncthreads();
    for (int idx = tid_; idx < TPW * 8; idx += NTHR) {
        const int h = idx & 7, row = row0 + (idx >> 3);
        const bf16_t* qp = PROJ + (size_t)row * INCP + C_QA + h * 64;
        float q[64];
#pragma unroll
        for (int i = 0; i < 8; ++i) { const u32x4 v = *(const u32x4*)(qp + i * 8);
#pragma unroll
            for (int k = 0; k < 4; ++k) { q[i * 8 + 2 * k] = bflo(v[k]); q[i * 8 + 2 * k + 1] = bfhi(v[k]); } }
        float v1 = -INFINITY, v2 = -INFINITY, v3 = -INFINITY; int i1 = -1, i2 = -1, i3 = -1;
        for (int j = 0; j < own; ++j) {
            const LAS f32x4* kp = (const LAS f32x4*)(km + h * hs + j * 64);
            float g0 = 0.f, g1 = 0.f, g2 = 0.f, g3 = 0.f;
#pragma unroll
            for (int c = 0; c < 16; ++c) { const f32x4 k4 = kp[c]; g0 = fmaf(q[4 * c], k4[0], g0); g1 = fmaf(q[4 * c + 1], k4[1], g1); g2 = fmaf(q[4 * c + 2], k4[2], g2); g3 = fmaf(q[4 * c + 3], k4[3], g3); }
            const float g = (g0 + g1) + (g2 + g3);
            if (g > v1) { v3 = v2; i3 = i2; v2 = v1; i2 = i1; v1 = g; i1 = j; }
            else if (g > v2) { v3 = v2; i3 = i2; v2 = g; i2 = j; }
            else if (g > v3) { v3 = g; i3 = j; }
        }
        unsigned m = 0;
        if (i1 >= 0) m |= 1u << i1;
        if (i2 >= 0) m |= 1u << i2;
        if (i3 >= 0) m |= 1u << i3;
        SEL[(size_t)row * 8 + h] = m;
    }
    __syncthreads();
}

template <bool SECOND>
struct EpiGate {
    const bf16_t* PROJ; bf16_t* TMP; bf16_t* MRG;
    __device__ __forceinline__ void operator()(const f32x4 (&acc)[2][2][4][2], const pg8::Unit& u, int wr, int wc, int fr, int fq) const {
        PG8_TILE_BEGIN(acc, wr, wc, fr, fq)
            const int row = u.pm * 256 + trow, col = u.pn * 256 + tcol;
            const u32x4 g = *(const u32x4*)(PROJ + (size_t)row * INCP + (SECOND ? C_GB : C_GA) + col);
            v0[0] *= bflo(g.x); v0[1] *= bfhi(g.x); v0[2] *= bflo(g.y); v0[3] *= bfhi(g.y); v1[0] *= bflo(g.z); v1[1] *= bfhi(g.z); v1[2] *= bflo(g.w); v1[3] *= bfhi(g.w);
            if (SECOND) { const u32x4 t = *(const u32x4*)(TMP + (size_t)row * DM + col);
                v0[0] += bflo(t.x); v0[1] += bfhi(t.x); v0[2] += bflo(t.y); v0[3] += bfhi(t.y); v1[0] += bflo(t.z); v1[1] += bfhi(t.z); v1[2] += bflo(t.w); v1[3] += bfhi(t.w);
                *(u32x4*)(MRG + (size_t)row * DM + col) = pg8::pack8(v0, v1); }
            else *(u32x4*)(TMP + (size_t)row * DM + col) = pg8::pack8(v0, v1);
        PG8_TILE_END
    }
};
struct EpiResid {
    const float* X; float* PRE;
    __device__ __forceinline__ void operator()(const f32x4 (&acc)[2][2][4][2], const pg8::Unit& u, int wr, int wc, int fr, int fq) const {
        PG8_TILE_BEGIN(acc, wr, wc, fr, fq)
            const size_t o = (size_t)(u.pm * 256 + trow) * DM + u.pn * 256 + tcol;
            const f32x4 x0 = *(const f32x4*)(X + o), x1 = *(const f32x4*)(X + o + 4);
            *(f32x4*)(PRE + o) = x0 * ALPHA + v0; *(f32x4*)(PRE + o + 4) = x1 * ALPHA + v1;
        PG8_TILE_END
    }
};
__device__ __forceinline__ void ln_phase(const Frame& F, const float* PRE, const float* g, const float* bt, float* X, bf16_t* XBo) {
    int lane_ = F.lane; asm volatile("" : "+v"(lane_));
    const int gw = F.vcu * NWAVES + F.wave, NGW = F.G * NWAVES, lane = lane_;
    for (int row = gw; row < T; row += NGW) {
        const f32x4* pr = (const f32x4*)(PRE + (size_t)row * DM) + lane;
        f32x4 v[4]; float s = 0.f;
#pragma unroll
        for (int j = 0; j < 4; ++j) { v[j] = pr[64 * j]; s += (v[j][0] + v[j][1]) + (v[j][2] + v[j][3]); }
        const float mean = wave_sum(s) * (1.f / DM); float s2 = 0.f;
#pragma unroll
        for (int j = 0; j < 4; ++j) { v[j] = v[j] - mean; s2 += (v[j][0] * v[j][0] + v[j][1] * v[j][1]) + (v[j][2] * v[j][2] + v[j][3] * v[j][3]); }
        const float rstd = rsqrtf(wave_sum(s2) * (1.f / DM) + LN_EPS);
#pragma unroll
        for (int j = 0; j < 4; ++j) { const f32x4 gg = ((const f32x4*)g)[lane + 64 * j], bb = ((const f32x4*)bt)[lane + 64 * j];
            const f32x4 y = v[j] * rstd * gg + bb;
            ((f32x4*)(X + (size_t)row * DM))[lane + 64 * j] = y;
            if (XBo) { u32x2 w; w.x = pk2(y[0], y[1]); w.y = pk2(y[2], y[3]); ((u32x2*)(XBo + (size_t)row * DM))[lane + 64 * j] = w; } }
    }
}

struct RowGU { int off; __device__ __forceinline__ int operator()(int n) const { return 256 * (n >> 7) + off + (n & 127); } };

struct EpiF32 {
    float* O; int ld;
    __device__ __forceinline__ void operator()(const f32x4 (&acc)[2][2][4][2], const pg8::Unit& u, int wr, int wc, int fr, int fq) const {
        PG8_TILE_BEGIN(acc, wr, wc, fr, fq)
            float* o = O + (size_t)(u.pm * 256 + trow) * ld + u.pn * 256 + tcol; *(f32x4*)o = v0; *(f32x4*)(o + 4) = v1;
        PG8_TILE_END
    }
};
struct EpiBf16 {
    bf16_t* O; int ld;
    __device__ __forceinline__ void operator()(const f32x4 (&acc)[2][2][4][2], const pg8::Unit& u, int wr, int wc, int fr, int fq) const {
        PG8_TILE_BEGIN(acc, wr, wc, fr, fq)
            *(u32x4*)(O + (size_t)(u.pm * 256 + trow) * ld + u.pn * 256 + tcol) = pg8::pack8(v0, v1);
        PG8_TILE_END
    }
};
__device__ __forceinline__ float silu_mul(float g, float u) { return g * __builtin_amdgcn_rcpf(1.f + __expf(-g)) * u; }
struct EpiSwiGLU {
    bf16_t* H; int ld;
    __device__ __forceinline__ void operator()(const f32x4 (&acc)[2][2][4][2], const pg8::Unit& u, int wr, int wc, int fr, int fq) const {
#pragma unroll
        for (int ai = 0; ai < 2; ++ai)
#pragma unroll
            for (int m = 0; m < 4; ++m) { const int row = u.r0 + ai * 128 + wr * 64 + m * 16 + fr;
                if (row < u.rend) { f32x4 h0, h1;
#pragma unroll
                    for (int i = 0; i < 4; ++i) { h0[i] = silu_mul(acc[ai][0][m][0][i], acc[ai][1][m][0][i]); h1[i] = silu_mul(acc[ai][0][m][1][i], acc[ai][1][m][1][i]); }
                    *(u32x4*)(H + (size_t)row * ld + 128 * u.pn + wc * 32 + 8 * fq) = pg8::pack8(h0, h1); } }
    }
};
struct EpiExpDown {
    bf16_t* Y; const int* ROWA;
    __device__ __forceinline__ void operator()(const f32x4 (&acc)[2][2][4][2], const pg8::Unit& u, int wr, int wc, int fr, int fq) const {
        u32x2 aw[2][4];
#pragma unroll
        for (int ai = 0; ai < 2; ++ai)
#pragma unroll
            for (int m = 0; m < 4; ++m) { const int row = min(u.r0 + ai * 128 + wr * 64 + m * 16 + fr, u.rend - 1); aw[ai][m] = *(const u32x2*)(ROWA + 2 * (size_t)row); }
#pragma unroll
        for (int ai = 0; ai < 2; ++ai)
#pragma unroll
            for (int m = 0; m < 4; ++m) { const int row = u.r0 + ai * 128 + wr * 64 + m * 16 + fr;
                if (row < u.rend) { const int a = (int)aw[ai][m].x; const float w = __uint_as_float(aw[ai][m].y);
#pragma unroll
                    for (int bj = 0; bj < 2; ++bj) *(u32x4*)(Y + (size_t)a * DM + 256 * u.pn + bj * 128 + wc * 32 + 8 * fq) = pg8::pack8(acc[ai][bj][m][0] * w, acc[ai][bj][m][1] * w); } }
    }
};
template <int NPN, bool GATHER>
struct ExpertOrder {
    const LAS int* off; const LAS int* toff; const int* rowa; int G, c; size_t strideE;
    __device__ __forceinline__ bool next(int i, pg8::Unit& u) const {
        const int L = i * G + c; if (L >= toff[256] * NPN) return false;
        const int tile = L / NPN; u.pn = L % NPN; int lo = 0, hi = 255;
        while (lo < hi) { const int mid = (lo + hi + 1) >> 1; if (toff[mid] <= tile) lo = mid; else hi = mid - 1; }
        u.e = lo; u.r0 = off[lo] + (tile - toff[lo]) * 256; u.rend = off[lo + 1]; u.pm = 0; return true;
    }
    __device__ __forceinline__ int a_row(const pg8::Unit& u, int r) const { const int rr = min(u.r0 + r, u.rend - 1); return GATHER ? (rowa[2 * rr] >> 3) : rr; }
    __device__ __forceinline__ const char* b_ptr(const pg8::Gemm& g, const pg8::Unit& u) const { return (const char*)g.Bt + (size_t)u.e * strideE + (size_t)u.pn * 256 * g.ldb * 2; }
};
__device__ __forceinline__ void expert_tables(const Frame& F, const unsigned* cnt, LAS int* off, LAS int* toff) {
    if (F.tid < 256) { off[F.tid] = (int)cnt[F.tid]; }
    __syncthreads();
    if (F.tid == 0) { int a = 0, b = 0; for (int i = 0; i < 256; ++i) { const int c = off[i]; off[i] = a; toff[i] = b; a += c; b += (c + 255) >> 8; } off[256] = a; toff[256] = b; }
    __syncthreads();
}
__device__ __forceinline__ void route_phase(const Frame& F, const float* LOGITS, const float* rbias, int* TOPE, float* TOPW, int* APOS, int* HIST, LAS int* lcnt) {
    int lane_ = F.lane; asm volatile("" : "+v"(lane_));
    const int lane = lane_, TPW = T / F.G, t0 = (int)blockIdx.x * TPW;
    if (F.tid < 256) lcnt[F.tid] = 0;
    __syncthreads();
    const f32x4 rb = *(const f32x4*)(rbias + lane * 4);
    for (int t = t0 + F.wave; t < t0 + TPW; t += NWAVES) {
        const f32x4 lg = *(const f32x4*)(LOGITS + (size_t)t * NE + lane * 4);
        const float s0 = 1.f / (1.f + expf(-lg[0])), s1 = 1.f / (1.f + expf(-lg[1])), s2 = 1.f / (1.f + expf(-lg[2])), s3 = 1.f / (1.f + expf(-lg[3]));
        float c0 = s0 + rb[0], c1 = s1 + rb[1], c2 = s2 + rb[2], c3 = s3 + rb[3];
        float a = fmaxf(c0, c1), bq = fminf(c0, c1);
        { const float hi2 = fmaxf(c2, c3), lo2 = fminf(c2, c3); const float na = fmaxf(a, hi2), nb = fmaxf(fminf(a, hi2), fmaxf(bq, lo2)); a = na; bq = nb; }
#pragma unroll
        for (int o = 1; o < 8; o <<= 1) { const float oa = __shfl_xor(a, o), ob = __shfl_xor(bq, o); const float na = fmaxf(a, oa), nb = fmaxf(fminf(a, oa), fmaxf(bq, ob)); a = na; bq = nb; }
        const float gs = a + bq; const int grp = lane >> 3;
        int rank = 0;
#pragma unroll
        for (int j = 0; j < 8; ++j) { const float og = __shfl(gs, j * 8); rank += (og > gs || (og == gs && j < grp)) ? 1 : 0; }
        if (rank >= 4) { c0 = c1 = c2 = c3 = -INFINITY; }
        float wsum = 0.f, myw = 0.f; int mye = 0;
#pragma unroll
        for (int k = 0; k < TOPK; ++k) {
            float bv = c0; int bi = 0;
            if (c1 > bv) { bv = c1; bi = 1; }
            if (c2 > bv) { bv = c2; bi = 2; }
            if (c3 > bv) { bv = c3; bi = 3; }
            int be = lane * 4 + bi;
#pragma unroll
            for (int o = 1; o < 64; o <<= 1) { const float ov = __shfl_xor(bv, o); const int oe = __shfl_xor(be, o); if (ov > bv || (ov == bv && oe < be)) { bv = ov; be = oe; } }
            float sc = 0.f;
            if ((be >> 2) == lane) { const int b2 = be & 3; sc = b2 == 0 ? s0 : b2 == 1 ? s1 : b2 == 2 ? s2 : s3; if (b2 == 0) c0 = -INFINITY; else if (b2 == 1) c1 = -INFINITY; else if (b2 == 2) c2 = -INFINITY; else c3 = -INFINITY; }
            sc = __shfl(sc, be >> 2);
            wsum += sc;
            if (lane == k) { myw = sc; mye = be; }
        }
        if (lane < TOPK) { const int aidx = t * TOPK + lane; TOPE[aidx] = mye; TOPW[aidx] = myw / wsum * 2.5f; APOS[aidx] = __hip_atomic_fetch_add(lcnt + mye, 1, __ATOMIC_RELAXED, __HIP_MEMORY_SCOPE_WORKGROUP); }
    }
    __syncthreads();
    if (F.tid < 256) HIST[(size_t)blockIdx.x * 256 + F.tid] = lcnt[F.tid];
}
__device__ __forceinline__ void combine_phase(const Frame& F, const float* X1, const bf16_t* SH, const bf16_t* Y, const float* g, const float* bt, float* Xo, bf16_t* XBo) {
    int lane_ = F.lane; asm volatile("" : "+v"(lane_));
    const int gw = F.vcu * NWAVES + F.wave, NGW = F.G * NWAVES, lane = lane_;
    for (int row = gw; row < T; row += NGW) {
        f32x4 v[4]; float s = 0.f;
#pragma unroll
        for (int j = 0; j < 4; ++j) { v[j] = ((const f32x4*)(X1 + (size_t)row * DM))[lane + 64 * j] * ALPHA;
            const u32x2 h = ((const u32x2*)(SH + (size_t)row * DM))[lane + 64 * j]; v[j][0] += bflo(h.x); v[j][1] += bfhi(h.x); v[j][2] += bflo(h.y); v[j][3] += bfhi(h.y); }
#pragma unroll
        for (int k = 0; k < TOPK; ++k) { const u32x2* yr = (const u32x2*)(Y + ((size_t)row * TOPK + k) * DM);
#pragma unroll
            for (int j = 0; j < 4; ++j) { const u32x2 h = yr[lane + 64 * j]; v[j][0] += bflo(h.x); v[j][1] += bfhi(h.x); v[j][2] += bflo(h.y); v[j][3] += bfhi(h.y); } }
#pragma unroll
        for (int j = 0; j < 4; ++j) s += (v[j][0] + v[j][1]) + (v[j][2] + v[j][3]);
        const float mean = wave_sum(s) * (1.f / DM); float s2 = 0.f;
#pragma unroll
        for (int j = 0; j < 4; ++j) { v[j] = v[j] - mean; s2 += (v[j][0] * v[j][0] + v[j][1] * v[j][1]) + (v[j][2] * v[j][2] + v[j][3] * v[j][3]); }
        const float rstd = rsqrtf(wave_sum(s2) * (1.f / DM) + LN_EPS);
#pragma unroll
        for (int j = 0; j < 4; ++j) { const f32x4 gg = ((const f32x4*)g)[lane + 64 * j], bb = ((const f32x4*)bt)[lane + 64 * j];
            const f32x4 y = v[j] * rstd * gg + bb;
            ((f32x4*)(Xo + (size_t)row * DM))[lane + 64 * j] = y;
            if (XBo) { u32x2 w; w.x = pk2(y[0], y[1]); w.y = pk2(y[2], y[3]); ((u32x2*)(XBo + (size_t)row * DM))[lane + 64 * j] = w; } }
    }
}

__device__ __forceinline__ int crow(int r, int hi) { return (r & 3) + 8 * (r >> 2) + 4 * hi; }
typedef short s16x4 __attribute__((ext_vector_type(4)));
__device__ __forceinline__ s16x4 vtr(const LAS unsigned char* p) { return __builtin_bit_cast(s16x4, __builtin_amdgcn_ds_read_tr16_b64_v4i16((LAS s16x4*)p)); }
__device__ __forceinline__ float xhalf_max(float v) { auto rr = __builtin_amdgcn_permlane32_swap(__float_as_uint(v), __float_as_uint(v), false, false); return fmaxf(__uint_as_float(rr[0]), __uint_as_float(rr[1])); }
__device__ __forceinline__ float xhalf_sum(float v) { auto rr = __builtin_amdgcn_permlane32_swap(__float_as_uint(v), __float_as_uint(v), false, false); return __uint_as_float(rr[0]) + __uint_as_float(rr[1]); }

template <int DQK, bool ALIBI>
__device__ __forceinline__ void attn_tile(const LAS unsigned char* kb, int kfo, int vfo, const bf16x8 (&qf)[DQK / 16], float& m, float& l, f32x16& o0, f32x16& o1, int hi, int tq, int kpos0, float slope2, bool causal) {
    f32x16 p0, p1;
#pragma unroll
    for (int r = 0; r < 16; ++r) { p0[r] = 0.f; p1[r] = 0.f; }
#pragma unroll
    for (int d0 = 0; d0 < DQK / 16; ++d0) {
        const bf16x8 a0 = *(const LAS bf16x8*)(kb + kfo + d0 * 2048), a1 = *(const LAS bf16x8*)(kb + kfo + d0 * 2048 + 512);
        p0 = __builtin_amdgcn_mfma_f32_32x32x16_bf16(a0, qf[d0], p0, 0, 0, 0);
        p1 = __builtin_amdgcn_mfma_f32_32x32x16_bf16(a1, qf[d0], p1, 0, 0, 0);
    }
    const int krel = kpos0 + 4 * hi - tq;
    if (ALIBI) { const float bb = slope2 * (float)krel;
#pragma unroll
        for (int r = 0; r < 16; ++r) { const float c = (float)((r & 3) + 8 * (r >> 2)); p0[r] += fmaf(slope2, c, bb); p1[r] += fmaf(slope2, c + 32.f, bb); } }
    if (causal) {
#pragma unroll
        for (int r = 0; r < 16; ++r) { const int kv = krel + (r & 3) + 8 * (r >> 2); if (kv > 0) p0[r] = -INFINITY; if (kv + 32 > 0) p1[r] = -INFINITY; } }
    float rm = fmaxf(p0[0], p1[0]);
#pragma unroll
    for (int r = 1; r < 16; ++r) rm = fmaxf(rm, fmaxf(p0[r], p1[r]));
    rm = xhalf_max(rm);
    const float mn = fmaxf(m, rm), alpha = __builtin_amdgcn_exp2f(m - mn);
    m = mn;
    float ls = 0.f;
#pragma unroll
    for (int r = 0; r < 16; ++r) { p0[r] = __builtin_amdgcn_exp2f(p0[r] - mn); p1[r] = __builtin_amdgcn_exp2f(p1[r] - mn); ls += p0[r] + p1[r]; }
    l = l * alpha + ls;
#pragma unroll
    for (int r = 0; r < 16; ++r) { o0[r] *= alpha; o1[r] *= alpha; }
    const u32x4 pw0 = (u32x4){pg8::cvt_pk_bf16(p0[0], p0[1]), pg8::cvt_pk_bf16(p0[2], p0[3]), pg8::cvt_pk_bf16(p0[4], p0[5]), pg8::cvt_pk_bf16(p0[6], p0[7])};
    const u32x4 pw1 = (u32x4){pg8::cvt_pk_bf16(p0[8], p0[9]), pg8::cvt_pk_bf16(p0[10], p0[11]), pg8::cvt_pk_bf16(p0[12], p0[13]), pg8::cvt_pk_bf16(p0[14], p0[15])};
    const u32x4 pw2 = (u32x4){pg8::cvt_pk_bf16(p1[0], p1[1]), pg8::cvt_pk_bf16(p1[2], p1[3]), pg8::cvt_pk_bf16(p1[4], p1[5]), pg8::cvt_pk_bf16(p1[6], p1[7])};
    const u32x4 pw3 = (u32x4){pg8::cvt_pk_bf16(p1[8], p1[9]), pg8::cvt_pk_bf16(p1[10], p1[11]), pg8::cvt_pk_bf16(p1[12], p1[13]), pg8::cvt_pk_bf16(p1[14], p1[15])};
    const LAS unsigned char* vb = kb + vfo;
#define ATT_VF(d0, ks) ({ const s16x4 lo_ = vtr(vb + (d0) * 4096 + (ks) * 1024), hi_ = vtr(vb + (d0) * 4096 + (ks) * 1024 + 512); (bf16x8){lo_[0], lo_[1], lo_[2], lo_[3], hi_[0], hi_[1], hi_[2], hi_[3]}; })
    o0 = __builtin_amdgcn_mfma_f32_32x32x16_bf16(ATT_VF(0, 0), __builtin_bit_cast(bf16x8, pw0), o0, 0, 0, 0);
    o1 = __builtin_amdgcn_mfma_f32_32x32x16_bf16(ATT_VF(1, 0), __builtin_bit_cast(bf16x8, pw0), o1, 0, 0, 0);
    o0 = __builtin_amdgcn_mfma_f32_32x32x16_bf16(ATT_VF(0, 1), __builtin_bit_cast(bf16x8, pw1), o0, 0, 0, 0);
    o1 = __builtin_amdgcn_mfma_f32_32x32x16_bf16(ATT_VF(1, 1), __builtin_bit_cast(bf16x8, pw1), o1, 0, 0, 0);
    o0 = __builtin_amdgcn_mfma_f32_32x32x16_bf16(ATT_VF(0, 2), __builtin_bit_cast(bf16x8, pw2), o0, 0, 0, 0);
    o1 = __builtin_amdgcn_mfma_f32_32x32x16_bf16(ATT_VF(1, 2), __builtin_bit_cast(bf16x8, pw2), o1, 0, 0, 0);
    o0 = __builtin_amdgcn_mfma_f32_32x32x16_bf16(ATT_VF(0, 3), __builtin_bit_cast(bf16x8, pw3), o0, 0, 0, 0);
    o1 = __builtin_amdgcn_mfma_f32_32x32x16_bf16(ATT_VF(1, 3), __builtin_bit_cast(bf16x8, pw3), o1, 0, 0, 0);
#undef ATT_VF
}
#define ATT_ISSUE(t, bo) do { \
        for (int c_ = wid; c_ < NCH; c_ += 8) __builtin_amdgcn_global_load_lds((const unsigned*)(ksrc + (size_t)(t) * 64 * ldk + c_ * 8), (LAS unsigned*)(lds + (bo) + c_ * 1024), 16, 0, 0); \
        __builtin_amdgcn_global_load_lds((const unsigned*)(vsrc + (size_t)(t) * 64 * ldv), (LAS unsigned*)(lds + (bo) + KBYTES + wid * 1024), 16, 0, 0); } while (0)

template <int DQK, bool MOBA_OWN>
__device__ __forceinline__ void attn_unit(LAS unsigned char* lds, int b, int h, int qb, const bf16_t* Qp, int ldq, const bf16_t* Kp, int ldk, const bf16_t* Vp, int ldv, bf16_t* Op, int ldo, const bf16_t* PO, const f32x2* PML) {
    constexpr int NCH = DQK / 8, KBYTES = NCH * 1024, BUFB = KBYTES + 8192, ND0 = DQK / 16;
    int tid_ = threadIdx.x; asm volatile("" : "+v"(tid_));
    const int lane = tid_ & 63, r32 = lane & 31, hi = lane >> 5, wid = __builtin_amdgcn_readfirstlane(tid_ >> 6);
    const size_t rowbase = (size_t)b * SEQ; const int q0 = qb * 256, T0 = MOBA_OWN ? 4 * qb : 0, T1 = 4 * (qb + 1), tq = q0 + wid * 32 + r32;
    const bf16_t* ksrc = Kp + (rowbase + lane) * ldk + h * DQK;
    const bf16_t* vsrc = Vp + (rowbase + 16 * (wid & 3) + (lane >> 2)) * ldv + h * 64 + (wid >> 2) * 32 + (lane & 3) * 8;
    ATT_ISSUE(T0, 0);
    bf16x8 qf[ND0];
    { const bf16_t* qrow = Qp + (rowbase + tq) * ldq + h * DQK + hi * 8;
#pragma unroll
      for (int d0 = 0; d0 < ND0; ++d0) qf[d0] = *(const bf16x8*)(qrow + d0 * 16); }
    const float slope2 = MOBA_OWN ? exp2f(-(float)(h + 1)) * LOG2E : 0.f;
    float m = -1e30f, l = 0.f;
    f32x16 o0, o1;
#pragma unroll
    for (int r = 0; r < 16; ++r) { o0[r] = 0.f; o1[r] = 0.f; }
    const int kfo = hi * 1024 + r32 * 16;
    const int vfo = KBYTES + ((lane >> 4) & 1) * 32 + (lane & 3) * 8 + (4 * hi + ((lane & 15) >> 2)) * 64;
#pragma unroll 1
    for (int t = T0; t < T1; ++t) {
        asm volatile("s_waitcnt vmcnt(0) lgkmcnt(0)\n\ts_barrier" ::: "memory");
        if (t + 1 < T1) ATT_ISSUE(t + 1, ((t + 1) & 1) * BUFB);
        attn_tile<DQK, MOBA_OWN>(lds + (t & 1) * BUFB, kfo, vfo, qf, m, l, o0, o1, hi, tq, 64 * t, slope2, t >= T1 - 4);
    }
    float lt = xhalf_sum(l);
    if (MOBA_OWN) {
        const int nsel = qb < 3 ? qb : 3;
        const size_t pidx = ((rowbase + tq) * 8 + h) * 3;
        float ms[3], ws[3], M = m;
#pragma unroll
        for (int sIdx = 0; sIdx < 3; ++sIdx) { ms[sIdx] = -1e30f; ws[sIdx] = 0.f; if (sIdx < nsel) { const f32x2 ml = PML[(pidx + sIdx) * 16]; ms[sIdx] = ml[0]; ws[sIdx] = ml[1]; M = fmaxf(M, ml[0]); } }
        const float w0 = __builtin_amdgcn_exp2f(m - M);
        lt *= w0;
#pragma unroll
        for (int r = 0; r < 16; ++r) { o0[r] *= w0; o1[r] *= w0; }
#pragma unroll
        for (int sIdx = 0; sIdx < 3; ++sIdx) if (sIdx < nsel) {
            const float w = ws[sIdx] * __builtin_amdgcn_exp2f(ms[sIdx] - M); lt += w;
            const bf16_t* po = PO + (pidx + sIdx) * 64 + 4 * hi;
#pragma unroll
            for (int r4 = 0; r4 < 4; ++r4) { const u32x2 a = *(const u32x2*)(po + 8 * r4), c = *(const u32x2*)(po + 32 + 8 * r4);
                o0[4 * r4] += w * bflo(a.x); o0[4 * r4 + 1] += w * bfhi(a.x); o0[4 * r4 + 2] += w * bflo(a.y); o0[4 * r4 + 3] += w * bfhi(a.y);
                o1[4 * r4] += w * bflo(c.x); o1[4 * r4 + 1] += w * bfhi(c.x); o1[4 * r4 + 2] += w * bflo(c.y); o1[4 * r4 + 3] += w * bfhi(c.y); } }
    }
    const float inv = 1.f / lt;
    bf16_t* orow = Op + (rowbase + tq) * ldo + h * 64 + 4 * hi;
#pragma unroll
    for (int r4 = 0; r4 < 4; ++r4) {
        u32x2 w0_, w1_;
        w0_.x = pg8::cvt_pk_bf16(o0[4 * r4] * inv, o0[4 * r4 + 1] * inv); w0_.y = pg8::cvt_pk_bf16(o0[4 * r4 + 2] * inv, o0[4 * r4 + 3] * inv);
        w1_.x = pg8::cvt_pk_bf16(o1[4 * r4] * inv, o1[4 * r4 + 1] * inv); w1_.y = pg8::cvt_pk_bf16(o1[4 * r4 + 2] * inv, o1[4 * r4 + 3] * inv);
        *(u32x2*)(orow + 8 * r4) = w0_; *(u32x2*)(orow + 32 + 8 * r4) = w1_;
    }
    asm volatile("s_waitcnt lgkmcnt(0)\n\ts_barrier" ::: "memory");
}
__device__ __forceinline__ void moba_sel_unit(LAS unsigned char* lds, int b, int h, int j, int slo, int shi, const bf16_t* Qp, const bf16_t* Kp, const bf16_t* Vp, int ldk, const unsigned* SEL, bf16_t* PO, f32x2* PML) {
    constexpr int DQK = 64, NCH = 8, KBYTES = 8192, BUFB = 16384, ldv = INCP; (void)ldv;
    int tid_ = threadIdx.x; asm volatile("" : "+v"(tid_));
    const int lane = tid_ & 63, r32 = lane & 31, hi = lane >> 5, wid = __builtin_amdgcn_readfirstlane(tid_ >> 6);
    const size_t rowbase = (size_t)b * SEQ;
    const bf16_t* ksrc = Kp + (rowbase + lane) * ldk + h * DQK;
    const bf16_t* vsrc = Vp + (rowbase + 16 * (wid & 3) + (lane >> 2)) * ldk + h * 64 + (wid >> 2) * 32 + (lane & 3) * 8;
#pragma unroll
    for (int tt = 0; tt < 4; ++tt) ATT_ISSUE(4 * j + tt, tt * BUFB);
    LAS unsigned short* list = (LAS unsigned short*)(lds + 4 * BUFB);
    LAS int* cnt = (LAS int*)(lds + 4 * BUFB + 4096);
    if (tid_ == 0) *cnt = 0;
    __syncthreads();
    const int nsrc = (shi - slo) * 256;
    for (int i = tid_; i < nsrc; i += NTHR) {
        const unsigned sm = SEL[(rowbase + (size_t)slo * 256 + i) * 8 + h];
        const bool f = ((sm >> j) & 1u) != 0u;
        const unsigned long long bal = __ballot(f);
        const int rank = __builtin_amdgcn_mbcnt_hi((unsigned)(bal >> 32), __builtin_amdgcn_mbcnt_lo((unsigned)bal, 0u));
        int base = 0;
        if (lane == 0) base = __hip_atomic_fetch_add(cnt, (int)__builtin_popcountll(bal), __ATOMIC_RELAXED, __HIP_MEMORY_SCOPE_WORKGROUP);
        base = __builtin_amdgcn_readfirstlane(base);
        if (f) list[base + rank] = (unsigned short)i;
    }
    asm volatile("s_waitcnt vmcnt(0)" ::: "memory");
    __syncthreads();
    const int n = *cnt, nch = (n + 31) >> 5;
    const float slope2 = exp2f(-(float)(h + 1)) * LOG2E;
    const int kfo = hi * 1024 + r32 * 16;
    const int vfo = KBYTES + ((lane >> 4) & 1) * 32 + (lane & 3) * 8 + (4 * hi + ((lane & 15) >> 2)) * 64;
    for (int ch = wid; ch < nch; ch += 8) {
        const int e = ch * 32 + r32; const bool valid = e < n;
        const int tq = slo * 256 + (int)list[valid ? e : n - 1];
        bf16x8 qf[4];
        { const bf16_t* qrow = Qp + (rowbase + tq) * INCP + h * DQK + hi * 8;
#pragma unroll
          for (int d0 = 0; d0 < 4; ++d0) qf[d0] = *(const bf16x8*)(qrow + d0 * 16); }
        const unsigned sm = SEL[(rowbase + tq) * 8 + h];
        float m = -1e30f, l = 0.f;
        f32x16 o0, o1;
#pragma unroll
        for (int r = 0; r < 16; ++r) { o0[r] = 0.f; o1[r] = 0.f; }
#pragma unroll 1
        for (int tt = 0; tt < 4; ++tt) attn_tile<64, true>(lds + tt * BUFB, kfo, vfo, qf, m, l, o0, o1, hi, tq, 256 * j + 64 * tt, slope2, false);
        const float lt = xhalf_sum(l), inv = 1.f / lt;
        if (valid) {
            const size_t pidx = ((rowbase + tq) * 8 + h) * 3 + __builtin_popcount(sm & ((1u << j) - 1u));
            if (hi == 0) PML[pidx * 16] = (f32x2){m, lt};
            bf16_t* po = PO + pidx * 64 + 4 * hi;
#pragma unroll
            for (int r4 = 0; r4 < 4; ++r4) {
                u32x2 w0_, w1_;
                w0_.x = pg8::cvt_pk_bf16(o0[4 * r4] * inv, o0[4 * r4 + 1] * inv); w0_.y = pg8::cvt_pk_bf16(o0[4 * r4 + 2] * inv, o0[4 * r4 + 3] * inv);
                w1_.x = pg8::cvt_pk_bf16(o1[4 * r4] * inv, o1[4 * r4 + 1] * inv); w1_.y = pg8::cvt_pk_bf16(o1[4 * r4 + 2] * inv, o1[4 * r4 + 3] * inv);
                *(u32x2*)(po + 8 * r4) = w0_; *(u32x2*)(po + 32 + 8 * r4) = w1_;
            }
        }
    }
    __syncthreads();
}
#undef ATT_ISSUE
__device__ __forceinline__ void mla_phase(const Frame& F, const bf16_t* QB, const bf16_t* KB, const bf16_t* VB, bf16_t* Op) {
    for (int u = 2 * F.vcu; u < 512; u += 2 * F.G) {
#pragma unroll 1
        for (int k = 0; k < 2; ++k) { const int uu = u + k, bh = uu >> 5, w = uu & 31, qb = (w & 1) ? (w >> 1) : 31 - (w >> 1);
            attn_unit<96, false>(F.lds, bh >> 3, bh & 7, qb, QB, 768, KB, 768, VB, 512, Op, 1024, nullptr, nullptr); }
    }
}
__device__ __forceinline__ void moba_sel_phase(const Frame& F, const bf16_t* PROJ, const unsigned* SEL, bf16_t* PO, f32x2* PML) {
#pragma unroll 1
    for (int u = (int)blockIdx.x; u < 16 * 136; u += F.G) {
        int p = 0; while (16 * (2 * (p + 1) * (p + 1) + (p + 1)) <= u) ++p;
        const int r = u - 16 * (2 * p * p + p), j = r >> 4, bh = r & 15;
        const int slo = (j + 1 > 4 * p) ? j + 1 : 4 * p, shi = 4 * p + 4;
        moba_sel_unit(F.lds, bh >> 3, bh & 7, j, slo, shi, PROJ + C_QA, PROJ + C_KA, PROJ + C_VA, INCP, SEL, PO, PML);
    }
}
__device__ __forceinline__ void moba_own_phase(const Frame& F, const bf16_t* PROJ, bf16_t* Op, const bf16_t* PO, const f32x2* PML) {
#pragma unroll 1
    for (int u = F.vcu; u < 512; u += F.G) { const int bh = u >> 5, qb = u & 31;
        attn_unit<64, true>(F.lds, bh >> 3, bh & 7, qb, PROJ + C_QA, INCP, PROJ + C_KA, INCP, PROJ + C_VA, INCP, Op, 1024, PO, PML); }
}

constexpr int NPH_L = 16;
__global__ void __launch_bounds__(NTHR, 2) mk(Params p) {
    extern __shared__ __attribute__((aligned(16))) unsigned char lds_raw[];
    Frame F;
    F.lds = (LAS unsigned char*)lds_raw;
    F.tid = threadIdx.x; F.lane = F.tid & 63; F.wave = __builtin_amdgcn_readfirstlane(F.tid >> 6);
    F.G = gridDim.x; { const int bx = blockIdx.x; F.vcu = (F.G % 8 == 0) ? (bx % 8) * (F.G / 8) + bx / 8 : bx; }
    volatile LAS unsigned* MISC = (volatile LAS unsigned*)(F.lds + MISC_OFF);
    if (F.tid < 32) MISC[F.tid] = 0u;
    __syncthreads();
    unsigned char* ws = p.ws;
    unsigned* ctl = (unsigned*)(ws + WS_CTL);
    XcdBarrier bar = xcd_barrier_post(ctl + CW_BAR, MISC + 8);
    const int lo = p.ph_lo, hi = p.ph_hi;
#define IN(k) (lo <= (k) && (k) < hi)
#define SEAM(k) do { if (IN(k) && IN((k) + 1)) xcd_barrier(bar); } while (0)
    bf16_t* WinT = (bf16_t*)(ws + WS_WIN);
    bf16_t* XB = (bf16_t*)(ws + WS_XB);
    bf16_t* PROJ = (bf16_t*)(ws + WS_PROJ);
    bf16_t* WuqT = (bf16_t*)(ws + WS_WUQ); bf16_t* WukvT = (bf16_t*)(ws + WS_WUKV);
    f32x2* CS = (f32x2*)(ws + WS_CS); float* KM = (float*)(ws + WS_KM); unsigned* SEL = (unsigned*)(ws + WS_SEL);
    bf16_t* CQN = (bf16_t*)(ws + WS_CQN); bf16_t* CKVN = (bf16_t*)(ws + WS_CKVN);
    bf16_t* WpaT = (bf16_t*)(ws + WS_WPA); bf16_t* WpbT = (bf16_t*)(ws + WS_WPB); bf16_t* WoutT = (bf16_t*)(ws + WS_WOUT);
    bf16_t* TMP = (bf16_t*)(ws + WS_TMP); bf16_t* MRG = (bf16_t*)(ws + WS_MRG); float* PRE = (float*)(ws + WS_PRE); float* X1 = (float*)(ws + WS_X1); bf16_t* X1B = (bf16_t*)(ws + WS_X1B); float* X2 = (float*)(ws + WS_X2);
    bf16_t* WrtT = (bf16_t*)(ws + WS_WRT); bf16_t* WsguT = (bf16_t*)(ws + WS_WSGU); bf16_t* WsdT = (bf16_t*)(ws + WS_WSD); bf16_t* WeguT = (bf16_t*)(ws + WS_WEGU); bf16_t* WedT = (bf16_t*)(ws + WS_WED);
    float* LOGITS = (float*)(ws + WS_LOG); bf16_t* HS = (bf16_t*)(ws + WS_HS); bf16_t* SH = (bf16_t*)(ws + WS_SH);
    int* TOPE = (int*)(ws + WS_TOPE); float* TOPW = (float*)(ws + WS_TOPW); int* APOS = (int*)(ws + WS_APOS); int* ROWA = (int*)(ws + WS_ROWA);
    bf16_t* PO = (bf16_t*)(ws + WS_PO); f32x2* PML = (f32x2*)(ws + WS_PML);
    bf16_t* HE = (bf16_t*)(ws + WS_HE); bf16_t* Yb = (bf16_t*)(ws + WS_Y); int* HIST = (int*)(ws + WS_HIST);
    LAS int* t_off = (LAS int*)(F.lds + TAB_OFF); LAS int* t_toff = t_off + 260;
    bf16_t* QB = (bf16_t*)(ws + WS_QB); bf16_t* KB = (bf16_t*)(ws + WS_KB); bf16_t* VB = (bf16_t*)(ws + WS_VB); bf16_t* OAB = (bf16_t*)(ws + WS_OAB);
    const int gw = F.vcu * NWAVES + F.wave, NGW = F.G * NWAVES;

    if (IN(0)) {
        LAS float* scr = (LAS float*)(F.lds + F.wave * 16384);
        constexpr int I_IN = (DM / 64) * (INC / 32);
        for (int it = gw; it < DEPTH * I_IN; it += NGW) { const int l = it / I_IN, r = it % I_IN;
            transpose_item(p.in[1] + (size_t)l * DM * INC, DM, INC, WinT + (size_t)l * SZ_WIN, DM, RowId{}, scr, r, F.lane); }
        { constexpr int I_UQ = (QL / 64) * (768 / 32), I_UKV = (KVL / 64) * (1024 / 32);
          for (int it = gw; it < DEPTH * (I_UQ + I_UKV); it += NGW) { const int l = it / (I_UQ + I_UKV), r = it % (I_UQ + I_UKV);
            if (r < I_UQ) transpose_item(p.in[4] + (size_t)l * QL * 768, QL, 768, WuqT + (size_t)l * SZ_WUQ, QL, RowQ{}, scr, r, F.lane);
            else transpose_item(p.in[6] + (size_t)l * KVL * 1024, KVL, 1024, WukvT + (size_t)l * SZ_WUKV, KVL, RowId{}, scr, r - I_UQ, F.lane); } }
        { constexpr int I_P = (512 / 64) * (DM / 32), I_O = (DM / 64) * (DM / 32), I_ALL = 2 * I_P + I_O;
          for (int it = gw; it < DEPTH * I_ALL; it += NGW) { const int l = it / I_ALL; int r = it % I_ALL;
            if (r < I_P) { transpose_item(p.in[7] + (size_t)l * 512 * DM, 512, DM, WpaT + (size_t)l * SZ_WP, 512, RowId{}, scr, r, F.lane); continue; } r -= I_P;
            if (r < I_P) { transpose_item(p.in[8] + (size_t)l * 512 * DM, 512, DM, WpbT + (size_t)l * SZ_WP, 512, RowId{}, scr, r, F.lane); continue; } r -= I_P;
            transpose_item(p.in[9] + (size_t)l * DM * DM, DM, DM, WoutT + (size_t)l * SZ_WOUT, DM, RowId{}, scr, r, F.lane); } }
        { constexpr int I_R = (DM / 64) * (NE / 32), I_G = (DM / 64) * (DSH / 32), I_D = (DSH / 64) * (DM / 32), I_ALL = I_R + 2 * I_G + I_D;
          for (int it = gw; it < DEPTH * I_ALL; it += NGW) { const int l = it / I_ALL; int r = it % I_ALL;
            if (r < I_R) { transpose_item(p.in[12] + (size_t)l * DM * NE, DM, NE, WrtT + (size_t)l * SZ_WRT, DM, RowId{}, scr, r, F.lane); continue; } r -= I_R;
            if (r < I_G) { transpose_item(p.in[17] + (size_t)l * DM * DSH, DM, DSH, WsguT + (size_t)l * SZ_WSGU, DM, RowGU{0}, scr, r, F.lane); continue; } r -= I_G;
            if (r < I_G) { transpose_item(p.in[18] + (size_t)l * DM * DSH, DM, DSH, WsguT + (size_t)l * SZ_WSGU, DM, RowGU{128}, scr, r, F.lane); continue; } r -= I_G;
            transpose_item(p.in[19] + (size_t)l * DSH * DM, DSH, DM, WsdT + (size_t)l * SZ_WSD, DSH, RowId{}, scr, r, F.lane); } }
        { constexpr int I_G = (DM / 64) * (DE / 32), I_D = (DE / 64) * (DM / 32), I_E = 2 * I_G + I_D;
          for (int it = gw; it < DEPTH * NE * I_E; it += NGW) { const int le = it / I_E; int r = it % I_E;
            if (r < I_G) { transpose_item(p.in[14] + (size_t)le * DM * DE, DM, DE, WeguT + (size_t)le * 512 * DM, DM, RowGU{0}, scr, r, F.lane); continue; } r -= I_G;
            if (r < I_G) { transpose_item(p.in[15] + (size_t)le * DM * DE, DM, DE, WeguT + (size_t)le * 512 * DM, DM, RowGU{128}, scr, r, F.lane); continue; } r -= I_G;
            transpose_item(p.in[16] + (size_t)le * DE * DM, DE, DM, WedT + (size_t)le * DM * DE, DE, RowId{}, scr, r, F.lane); } }
        for (int i = blockIdx.x * NTHR + F.tid; i < SEQ * 16; i += F.G * NTHR) { const int pos = i >> 4, k = i & 15;
            const float inv = powf(10000.f, -(float)(2 * k) / 32.f), ang = (float)pos * inv; CS[i] = (f32x2){cosf(ang), sinf(ang)}; }
        for (int i = blockIdx.x * NTHR + F.tid; i < DEPTH * 12288; i += F.G * NTHR) { const int l = i / 12288, r = i % 12288;
            *(u32x4*)(WinT + (size_t)l * SZ_WIN + (size_t)INC * DM + (size_t)r * 8) = (u32x4){0u, 0u, 0u, 0u}; }
        for (int i = blockIdx.x * NTHR + F.tid; i < T * DM / 8; i += F.G * NTHR) { const f32x4 a = *(const f32x4*)(p.in[0] + (size_t)i * 8), b = *(const f32x4*)(p.in[0] + (size_t)i * 8 + 4);
            u32x4 w; w.x = pk2(a[0], a[1]); w.y = pk2(a[2], a[3]); w.z = pk2(b[0], b[1]); w.w = pk2(b[2], b[3]); *(u32x4*)(XB + (size_t)i * 8) = w; }
    }
    SEAM(0);

    {
        const int l = 0; const int pb = 1 + l * NPH_L;
        if (IN(pb + 0)) {
            pg8::Gemm g{XB, WinT + (size_t)l * SZ_WIN, T, INCP, DM, DM, DM}; pg8::StaticOrder S; S.init(T, INCP, F.G, (int)blockIdx.x);
            EpiProj E{PROJ, p.in[2] + (size_t)l * 2 * DM};
            pg8::gemm_phase<EpiProj, pg8::StaticOrder, true>(F.lds, g, S, E);
        }
        SEAM(pb + 0);
        if (IN(pb + 1)) prep_phase(F, PROJ, p.in[3] + (size_t)l * QL, p.in[5] + (size_t)l * KVL, CS, CQN, CKVN, KB, KM);
        SEAM(pb + 1);
        if (IN(pb + 2)) {
            mobasel_phase(F, PROJ, KM, SEL);
            { pg8::Gemm g{CKVN, WukvT + (size_t)l * SZ_WUKV, T, 1024, KVL, KVL, KVL}; pg8::StaticOrder S; S.init(T, 1024, F.G, (int)blockIdx.x);
              EpiKV E{KB, VB}; pg8::gemm_phase<EpiKV, pg8::StaticOrder, true>(F.lds, g, S, E); }
            { pg8::Gemm g{CQN, WuqT + (size_t)l * SZ_WUQ, T, 768, QL, QL, QL}; pg8::StaticOrder S; S.init(T, 768, F.G, (int)blockIdx.x);
              EpiQ E{QB, CS}; pg8::gemm_phase<EpiQ, pg8::StaticOrder, true>(F.lds, g, S, E); }
        }
        SEAM(pb + 2);
        if (IN(pb + 3)) {
            mla_phase(F, QB, KB, VB, OAB + 512);
            moba_sel_phase(F, PROJ, SEL, PO, PML);
        }
        SEAM(pb + 3);
        if (IN(pb + 4)) moba_own_phase(F, PROJ, OAB, PO, PML);
        SEAM(pb + 4);
        if (IN(pb + 5)) {
            { pg8::Gemm g{OAB, WpaT + (size_t)l * SZ_WP, T, DM, 512, 1024, 512}; pg8::StaticOrder S; S.init(T, DM, F.G, (int)blockIdx.x);
              EpiGate<false> E{PROJ, TMP, MRG}; pg8::gemm_phase<EpiGate<false>, pg8::StaticOrder, true>(F.lds, g, S, E); }
            { pg8::Gemm g{OAB + 512, WpbT + (size_t)l * SZ_WP, T, DM, 512, 1024, 512}; pg8::StaticOrder S; S.init(T, DM, F.G, (int)blockIdx.x);
              EpiGate<true> E{PROJ, TMP, MRG}; pg8::gemm_phase<EpiGate<true>, pg8::StaticOrder, true>(F.lds, g, S, E); }
        }
        SEAM(pb + 5);
        if (IN(pb + 6)) {
            pg8::Gemm g{MRG, WoutT + (size_t)l * SZ_WOUT, T, DM, DM, DM, DM}; pg8::StaticOrder S; S.init(T, DM, F.G, (int)blockIdx.x);
            EpiResid E{l == 0 ? p.in[0] : X2, PRE}; pg8::gemm_phase<EpiResid, pg8::StaticOrder, true>(F.lds, g, S, E);
        }
        SEAM(pb + 6);
        if (IN(pb + 7)) ln_phase(F, PRE, p.in[10] + (size_t)l * DM, p.in[11] + (size_t)l * DM, X1, X1B);
        SEAM(pb + 7);
        if (IN(pb + 8)) {
            { pg8::Gemm g{X1B, WrtT + (size_t)l * SZ_WRT, T, NE, DM, DM, DM}; pg8::StaticOrder S; S.init(T, NE, F.G, (int)blockIdx.x);
              EpiF32 E{LOGITS, NE}; pg8::gemm_phase<EpiF32, pg8::StaticOrder, true>(F.lds, g, S, E); }
            { pg8::Gemm g{X1B, WsguT + (size_t)l * SZ_WSGU, T, 512, DM, DM, DM}; pg8::StaticOrder S; S.init(T, 512, F.G, (int)((blockIdx.x + F.G / 2) % F.G));
              EpiSwiGLU E{HS, DSH}; pg8::gemm_phase<EpiSwiGLU, pg8::StaticOrder, true>(F.lds, g, S, E); }
        }
        SEAM(pb + 8);
        if (IN(pb + 9)) {
            route_phase(F, LOGITS, p.in[13] + (size_t)l * NE, TOPE, TOPW, APOS, HIST, t_off);
            pg8::Gemm g{HS, WsdT + (size_t)l * SZ_WSD, T, DM, DSH, DSH, DSH}; pg8::StaticOrder S; S.init(T, DM, F.G, (int)blockIdx.x);
            EpiBf16 E{SH, DM}; pg8::gemm_phase<EpiBf16, pg8::StaticOrder, true>(F.lds, g, S, E);
        }
        SEAM(pb + 9);
        if (IN(pb + 10)) {
            int tid_ = F.tid; asm volatile("" : "+v"(tid_));
            if (tid_ < 256) { int tot = 0, base = 0; for (int c = 0; c < F.G; ++c) { const int v = HIST[(size_t)c * 256 + tid_]; base += (c < (int)blockIdx.x) ? v : 0; tot += v; }
                t_off[tid_] = tot; t_toff[tid_] = base; if (blockIdx.x == 0) ctl[CW_CNT + l * 256 + tid_] = (unsigned)tot; }
            __syncthreads();
            if (tid_ == 0) { int a = 0; for (int i = 0; i < 256; ++i) { const int c = t_off[i]; t_off[i] = a; a += c; } }
            __syncthreads();
            const int TPW = T / F.G, a0 = (int)blockIdx.x * TPW * TOPK;
            for (int a = a0 + tid_; a < a0 + TPW * TOPK; a += NTHR) { const int e = TOPE[a]; *(u32x2*)(ROWA + 2 * (size_t)(t_off[e] + t_toff[e] + APOS[a])) = (u32x2){(unsigned)a, __float_as_uint(TOPW[a])}; }
            __syncthreads();
        }
        SEAM(pb + 10);
        if (IN(pb + 11)) {
            expert_tables(F, ctl + CW_CNT + l * 256, t_off, t_toff);
            pg8::Gemm g{X1B, WeguT + (size_t)l * SZ_WEGU, T, 512, DM, DM, DM};
            ExpertOrder<2, true> S{t_off, t_toff, ROWA, F.G, (int)blockIdx.x, (size_t)512 * DM * 2};
            EpiSwiGLU E{HE, DE}; pg8::gemm_phase<EpiSwiGLU, ExpertOrder<2, true>, true>(F.lds, g, S, E);
        }
        SEAM(pb + 11);
        if (IN(pb + 12)) {
            expert_tables(F, ctl + CW_CNT + l * 256, t_off, t_toff);
            pg8::Gemm g{HE, WedT + (size_t)l * SZ_WED, NA, DM, DE, DE, DE};
            ExpertOrder<4, false> S{t_off, t_toff, ROWA, F.G, (int)blockIdx.x, (size_t)DM * DE * 2};
            EpiExpDown E{Yb, ROWA}; pg8::gemm_phase<EpiExpDown, ExpertOrder<4, false>, true>(F.lds, g, S, E);
        }
        SEAM(pb + 12);
        if (IN(pb + 13)) combine_phase(F, X1, SH, Yb, p.in[20] + (size_t)l * DM, p.in[21] + (size_t)l * DM, l == DEPTH - 1 ? p.out : X2, l == DEPTH - 1 ? (bf16_t*)nullptr : XB);
        SEAM(pb + 13);
    }

    {
        const int l = 1; const int pb = 1 + l * NPH_L;
        if (IN(pb + 0)) {
            pg8::Gemm g{XB, WinT + (size_t)l * SZ_WIN, T, INCP, DM, DM, DM}; pg8::StaticOrder S; S.init(T, INCP, F.G, (int)blockIdx.x);
            EpiProj E{PROJ, p.in[2] + (size_t)l * 2 * DM};
            pg8::gemm_phase<EpiProj, pg8::StaticOrder, true>(F.lds, g, S, E);
        }
        SEAM(pb + 0);
        if (IN(pb + 1)) prep_phase(F, PROJ, p.in[3] + (size_t)l * QL, p.in[5] + (size_t)l * KVL, CS, CQN, CKVN, KB, KM);
        SEAM(pb + 1);
        if (IN(pb + 2)) {
            mobasel_phase(F, PROJ, KM, SEL);
            { pg8::Gemm g{CKVN, WukvT + (size_t)l * SZ_WUKV, T, 1024, KVL, KVL, KVL}; pg8::StaticOrder S; S.init(T, 1024, F.G, (int)blockIdx.x);
              EpiKV E{KB, VB}; pg8::gemm_phase<EpiKV, pg8::StaticOrder, true>(F.lds, g, S, E); }
            { pg8::Gemm g{CQN, WuqT + (size_t)l * SZ_WUQ, T, 768, QL, QL, QL}; pg8::StaticOrder S; S.init(T, 768, F.G, (int)blockIdx.x);
              EpiQ E{QB, CS}; pg8::gemm_phase<EpiQ, pg8::StaticOrder, true>(F.lds, g, S, E); }
        }
        SEAM(pb + 2);
        if (IN(pb + 3)) {
            mla_phase(F, QB, KB, VB, OAB + 512);
            moba_sel_phase(F, PROJ, SEL, PO, PML);
        }
        SEAM(pb + 3);
        if (IN(pb + 4)) moba_own_phase(F, PROJ, OAB, PO, PML);
        SEAM(pb + 4);
        if (IN(pb + 5)) {
            { pg8::Gemm g{OAB, WpaT + (size_t)l * SZ_WP, T, DM, 512, 1024, 512}; pg8::StaticOrder S; S.init(T, DM, F.G, (int)blockIdx.x);
              EpiGate<false> E{PROJ, TMP, MRG}; pg8::gemm_phase<EpiGate<false>, pg8::StaticOrder, true>(F.lds, g, S, E); }
            { pg8::Gemm g{OAB + 512, WpbT + (size_t)l * SZ_WP, T, DM, 512, 1024, 512}; pg8::StaticOrder S; S.init(T, DM, F.G, (int)blockIdx.x);
              EpiGate<true> E{PROJ, TMP, MRG}; pg8::gemm_phase<EpiGate<true>, pg8::StaticOrder, true>(F.lds, g, S, E); }
        }
        SEAM(pb + 5);
        if (IN(pb + 6)) {
            pg8::Gemm g{MRG, WoutT + (size_t)l * SZ_WOUT, T, DM, DM, DM, DM}; pg8::StaticOrder S; S.init(T, DM, F.G, (int)blockIdx.x);
            EpiResid E{l == 0 ? p.in[0] : X2, PRE}; pg8::gemm_phase<EpiResid, pg8::StaticOrder, true>(F.lds, g, S, E);
        }
        SEAM(pb + 6);
        if (IN(pb + 7)) ln_phase(F, PRE, p.in[10] + (size_t)l * DM, p.in[11] + (size_t)l * DM, X1, X1B);
        SEAM(pb + 7);
        if (IN(pb + 8)) {
            { pg8::Gemm g{X1B, WrtT + (size_t)l * SZ_WRT, T, NE, DM, DM, DM}; pg8::StaticOrder S; S.init(T, NE, F.G, (int)blockIdx.x);
              EpiF32 E{LOGITS, NE}; pg8::gemm_phase<EpiF32, pg8::StaticOrder, true>(F.lds, g, S, E); }
            { pg8::Gemm g{X1B, WsguT + (size_t)l * SZ_WSGU, T, 512, DM, DM, DM}; pg8::StaticOrder S; S.init(T, 512, F.G, (int)((blockIdx.x + F.G / 2) % F.G));
              EpiSwiGLU E{HS, DSH}; pg8::gemm_phase<EpiSwiGLU, pg8::StaticOrder, true>(F.lds, g, S, E); }
        }
        SEAM(pb + 8);
        if (IN(pb + 9)) {
            route_phase(F, LOGITS, p.in[13] + (size_t)l * NE, TOPE, TOPW, APOS, HIST, t_off);
            pg8::Gemm g{HS, WsdT + (size_t)l * SZ_WSD, T, DM, DSH, DSH, DSH}; pg8::StaticOrder S; S.init(T, DM, F.G, (int)blockIdx.x);
            EpiBf16 E{SH, DM}; pg8::gemm_phase<EpiBf16, pg8::StaticOrder, true>(F.lds, g, S, E);
        }
        SEAM(pb + 9);
        if (IN(pb + 10)) {
            int tid_ = F.tid; asm volatile("" : "+v"(tid_));
            if (tid_ < 256) { int tot = 0, base = 0; for (int c = 0; c < F.G; ++c) { const int v = HIST[(size_t)c * 256 + tid_]; base += (c < (int)blockIdx.x) ? v : 0; tot += v; }
                t_off[tid_] = tot; t_toff[tid_] = base; if (blockIdx.x == 0) ctl[CW_CNT + l * 256 + tid_] = (unsigned)tot; }
            __syncthreads();
            if (tid_ == 0) { int a = 0; for (int i = 0; i < 256; ++i) { const int c = t_off[i]; t_off[i] = a; a += c; } }
            __syncthreads();
            const int TPW = T / F.G, a0 = (int)blockIdx.x * TPW * TOPK;
            for (int a = a0 + tid_; a < a0 + TPW * TOPK; a += NTHR) { const int e = TOPE[a]; *(u32x2*)(ROWA + 2 * (size_t)(t_off[e] + t_toff[e] + APOS[a])) = (u32x2){(unsigned)a, __float_as_uint(TOPW[a])}; }
            __syncthreads();
        }
        SEAM(pb + 10);
        if (IN(pb + 11)) {
            expert_tables(F, ctl + CW_CNT + l * 256, t_off, t_toff);
            pg8::Gemm g{X1B, WeguT + (size_t)l * SZ_WEGU, T, 512, DM, DM, DM};
            ExpertOrder<2, true> S{t_off, t_toff, ROWA, F.G, (int)blockIdx.x, (size_t)512 * DM * 2};
            EpiSwiGLU E{HE, DE}; pg8::gemm_phase<EpiSwiGLU, ExpertOrder<2, true>, true>(F.lds, g, S, E);
        }
        SEAM(pb + 11);
        if (IN(pb + 12)) {
            expert_tables(F, ctl + CW_CNT + l * 256, t_off, t_toff);
            pg8::Gemm g{HE, WedT + (size_t)l * SZ_WED, NA, DM, DE, DE, DE};
            ExpertOrder<4, false> S{t_off, t_toff, ROWA, F.G, (int)blockIdx.x, (size_t)DM * DE * 2};
            EpiExpDown E{Yb, ROWA}; pg8::gemm_phase<EpiExpDown, ExpertOrder<4, false>, true>(F.lds, g, S, E);
        }
        SEAM(pb + 12);
        if (IN(pb + 13)) combine_phase(F, X1, SH, Yb, p.in[20] + (size_t)l * DM, p.in[21] + (size_t)l * DM, l == DEPTH - 1 ? p.out : X2, l == DEPTH - 1 ? (bf16_t*)nullptr : XB);
        SEAM(pb + 13);
    }

#undef IN
#undef SEAM
}

__global__ void __launch_bounds__(256) cvt_proj(const bf16_t* __restrict__ P, float* proj) {
    const size_t i = (size_t)blockIdx.x * 256 + threadIdx.x;
    const int row = (int)(i / INC), c = (int)(i % INC);
    float v = bf2f(P[(size_t)row * INCP + c]);
    if (c < C_KA) v *= (1.f / QS_A);
    proj[i] = v;
}
__global__ void __launch_bounds__(256) cvt_oab(const bf16_t* __restrict__ OAB, float* oa, float* ob) {
    const size_t i = (size_t)blockIdx.x * 256 + threadIdx.x; const size_t row = i >> 10; const int c = (int)(i & 1023);
    const float v = bf2f(OAB[i]);
    if (c < 512) oa[row * 512 + c] = v; else ob[row * 512 + c - 512] = v;
}
__global__ void __launch_bounds__(256) cvt_x(const float* __restrict__ x, bf16_t* XB) {
    const size_t i = (size_t)blockIdx.x * 256 + threadIdx.x;
    const f32x4 a = *(const f32x4*)(x + i * 8), b = *(const f32x4*)(x + i * 8 + 4);
    u32x4 w; w.x = pk2(a[0], a[1]); w.y = pk2(a[2], a[3]); w.z = pk2(b[0], b[1]); w.w = pk2(b[2], b[3]); *(u32x4*)(XB + i * 8) = w;
}
}
static int g_grid = 0;
static bool fast_setup() {
    if (g_grid) return g_grid > 0;
    int dev = 0, cus = 0, per_cu = 0;
    if (hipGetDevice(&dev) != hipSuccess || hipDeviceGetAttribute(&cus, hipDeviceAttributeMultiprocessorCount, dev) != hipSuccess) { g_grid = -1; return false; }
    if (hipFuncSetAttribute((const void*)fk::mk, hipFuncAttributeMaxDynamicSharedMemorySize, fk::LDS_BYTES) != hipSuccess) { fprintf(stderr, "hipFuncSetAttribute failed\n"); g_grid = -1; return false; }
    if (hipOccupancyMaxActiveBlocksPerMultiprocessor(&per_cu, (const void*)fk::mk, fk::NTHR, fk::LDS_BYTES) != hipSuccess || per_cu < 1) { fprintf(stderr, "occupancy query: %d\n", per_cu); }
    (void)hipGetLastError();
    g_grid = cus;
    if (cus > 1024 || T % cus != 0 || (T / cus) * 8 > 4096) { fprintf(stderr, "unsupported CU count %d\n", cus); g_grid = -1; return false; }
    return true;
}
static void launch_mk(fk::Params& p, int lo, int hi, hipStream_t stream) {
    p.ph_lo = lo; p.ph_hi = hi;
    hipLaunchKernelGGL(fk::mk, dim3(g_grid), dim3(fk::NTHR), fk::LDS_BYTES, stream, p);
}

extern "C" void kernel_launch(void* const* d_in, const int* in_sizes, int n_in, void* d_out, int out_size, void* d_ws, size_t ws_size, hipStream_t stream) {
    if (!fast_setup()) return;
    if (ws_size < fk::WS_NEED) { fprintf(stderr, "workspace too small: need %zu have %zu\n", (size_t)fk::WS_NEED, ws_size); return; }
    (void)hipMemsetAsync((char*)d_ws + fk::WS_CTL, 0, fk::CTL_BYTES, stream);
    fk::Params P{};
    for (int i = 0; i < 22; ++i) P.in[i] = (const float*)d_in[i];
    P.out = (float*)d_out; P.ws = (unsigned char*)d_ws;
#if MK_ONE_LAUNCH
    launch_mk(P, 0, 1 + DEPTH * fk::NPH_L, stream);
#else
    launch_mk(P, 0, 1, stream);
    for (int l = 0; l < DEPTH; ++l) for (int k = 0; k < 14; ++k) launch_mk(P, 1 + l * fk::NPH_L + k, 2 + l * fk::NPH_L + k, stream);
#endif
}
```

```cpp
#ifndef MK_ONE_LAUNCH
#define MK_ONE_LAUNCH 1
#endif
#include <hip/hip_runtime.h>
#include <cstdint>
#include <cstdio>

constexpr int NB = 2, SEQ = 8192, T = NB * SEQ, DM = 1024, DEPTH = 2;
constexpr int HA = 8, WA = 512, BLK = 256, NBLK = SEQ / BLK;
constexpr int HB = 8, DN = 64, DR = 32, DV = 64, QL = 384, KVL = 256;
constexpr int INC = 3 * WA + QL + KVL + DR + 2 * DM;
constexpr int C_QA = 0, C_KA = 512, C_VA = 1024, C_CQ = 1536, C_CKV = 1920, C_KR = 2176, C_GA = 2208, C_GB = 3232;
constexpr int NE = 256, TOPK = 8, DE = 256, DSH = 256;
constexpr int NA = T * TOPK;
constexpr float ALPHA = 1.4142135623730951f;
constexpr float LN_EPS = 1e-5f, RMS_EPS = 1e-6f;

namespace ora {
template <class EP>
__global__ void __launch_bounds__(256) sgemm(const float* __restrict__ A, const float* __restrict__ Bm, EP ep, int M, int N, int K, int lda, int ldb, int pad_) {
    __shared__ float As[16][68], Bs[16][68];
    const int tid = threadIdx.x, tx = tid & 15, ty = tid >> 4;
    const int m0 = blockIdx.y * 64, n0 = blockIdx.x * 64;
    float acc[4][4];
#pragma unroll
    for (int i = 0; i < 4; ++i)
#pragma unroll
        for (int j = 0; j < 4; ++j) acc[i][j] = 0.f;
    const int ar = tid >> 2, ak = (tid & 3) * 4;
    const int bk = tid >> 4, bn = (tid & 15) * 4;
    for (int k0 = 0; k0 < K; k0 += 16) {
        const float4 av = *(const float4*)(A + (size_t)(m0 + ar) * lda + k0 + ak);
        float4 bv = make_float4(0.f, 0.f, 0.f, 0.f);
        if (n0 + bn < N) bv = *(const float4*)(Bm + (size_t)(k0 + bk) * ldb + n0 + bn);
        __syncthreads();
        As[ak + 0][ar] = av.x; As[ak + 1][ar] = av.y; As[ak + 2][ar] = av.z; As[ak + 3][ar] = av.w;
        *(float4*)&Bs[bk][bn] = bv;
        __syncthreads();
#pragma unroll
        for (int kk = 0; kk < 16; ++kk) {
            const float4 a = *(const float4*)&As[kk][ty * 4];
            const float4 b = *(const float4*)&Bs[kk][tx * 4];
            const float aa[4] = {a.x, a.y, a.z, a.w}, bb[4] = {b.x, b.y, b.z, b.w};
#pragma unroll
            for (int i = 0; i < 4; ++i)
#pragma unroll
                for (int j = 0; j < 4; ++j) acc[i][j] = fmaf(aa[i], bb[j], acc[i][j]);
        }
    }
#pragma unroll
    for (int i = 0; i < 4; ++i)
#pragma unroll
        for (int j = 0; j < 4; ++j) { const int r = m0 + ty * 4 + i, c = n0 + tx * 4 + j; if (c < N) ep(r, c, acc[i][j]); }
}
struct EpStore { float* C; int ldc; int pad; __device__ void operator()(int r, int c, float v) const { C[(size_t)r * ldc + c] = v; } };
struct EpMerge { const float* proj; const float* bg; const float* pa; float* out; int pre; int pad;
    __device__ void operator()(int r, int c, float v) const {
        const float ga = proj[(size_t)r * INC + C_GA + c] + bg[c], gb = proj[(size_t)r * INC + C_GB + c] + bg[DM + c];
        const float sa = pre ? proj[(size_t)r * INC + C_GA + c] : 1.f / (1.f + expf(-ga)), sb = pre ? proj[(size_t)r * INC + C_GB + c] : 1.f / (1.f + expf(-gb));
        out[(size_t)r * DM + c] = sa * pa[(size_t)r * DM + c] + sb * v; } };
struct EpResid { const float* x; float* out; __device__ void operator()(int r, int c, float v) const { out[(size_t)r * DM + c] = ALPHA * x[(size_t)r * DM + c] + v; } };
struct EpSilu { const float* sg; float* out; __device__ void operator()(int r, int c, float v) const { const float g = sg[(size_t)r * DSH + c]; out[(size_t)r * DSH + c] = g / (1.f + expf(-g)) * v; } };

__global__ void __launch_bounds__(256) rowprep(const float* __restrict__ proj, const float* __restrict__ qn, const float* __restrict__ kvn, float* cqn, float* ckvn, float* krr) {
    const int wid = threadIdx.x >> 6, lane = threadIdx.x & 63, row = blockIdx.x * 4 + wid;
    const float* p = proj + (size_t)row * INC;
    float sq = 0.f, sk = 0.f;
    for (int c = lane; c < QL; c += 64) { const float v = p[C_CQ + c]; sq += v * v; }
    for (int c = lane; c < KVL; c += 64) { const float v = p[C_CKV + c]; sk += v * v; }
#pragma unroll
    for (int o = 32; o; o >>= 1) { sq += __shfl_xor(sq, o); sk += __shfl_xor(sk, o); }
    const float rq = rsqrtf(sq / QL + RMS_EPS), rk = rsqrtf(sk / KVL + RMS_EPS);
    for (int c = lane; c < QL; c += 64) cqn[(size_t)row * QL + c] = p[C_CQ + c] * rq * qn[c];
    for (int c = lane; c < KVL; c += 64) ckvn[(size_t)row * KVL + c] = p[C_CKV + c] * rk * kvn[c];
    if (lane < 16) {
        const int pos = row % SEQ;
        const float inv = powf(10000.f, -(float)(2 * lane) / 32.f), ang = (float)pos * inv, cs = cosf(ang), sn = sinf(ang);
        const float x1 = p[C_KR + lane], x2 = p[C_KR + 16 + lane];
        krr[(size_t)row * DR + lane] = x1 * cs - x2 * sn; krr[(size_t)row * DR + 16 + lane] = x2 * cs + x1 * sn;
    }
}
__global__ void __launch_bounds__(256) qrope(float* q) {
    const int idx = blockIdx.x * 256 + threadIdx.x;
    const int i = idx & 15, h = (idx >> 4) & 7, row = idx >> 7, pos = row % SEQ;
    const float inv = powf(10000.f, -(float)(2 * i) / 32.f), ang = (float)pos * inv, cs = cosf(ang), sn = sinf(ang);
    float* p = q + (size_t)row * 768 + h * 96 + 64;
    const float x1 = p[i], x2 = p[16 + i];
    p[i] = x1 * cs - x2 * sn; p[16 + i] = x2 * cs + x1 * sn;
}
__global__ void __launch_bounds__(64) kmean(const float* __restrict__ proj, float* km) {
    const int blk = blockIdx.x, h = blockIdx.y, b = blockIdx.z, c = threadIdx.x;
    float s = 0.f;
    for (int i = 0; i < BLK; ++i) s += proj[(size_t)(b * SEQ + blk * BLK + i) * INC + C_KA + h * 64 + c];
    km[((size_t)(b * HA + h) * NBLK + blk) * 64 + c] = s * (1.f / BLK);
}
__global__ void __launch_bounds__(256) mobasel(const float* __restrict__ proj, const float* __restrict__ km, unsigned* sel) {
    const int idx = blockIdx.x * 256 + threadIdx.x;
    const int h = idx & 7, row = idx >> 3, b = row / SEQ, pos = row % SEQ, own = pos / BLK;
    const float* qp = proj + (size_t)row * INC + C_QA + h * 64;
    float v1 = -INFINITY, v2 = -INFINITY, v3 = -INFINITY; int i1 = -1, i2 = -1, i3 = -1;
    for (int j = 0; j < own; ++j) {
        const float* kp = km + ((size_t)(b * HA + h) * NBLK + j) * 64;
        float g = 0.f;
        for (int c = 0; c < 64; ++c) g = fmaf(qp[c], kp[c], g);
        if (g > v1) { v3 = v2; i3 = i2; v2 = v1; i2 = i1; v1 = g; i1 = j; }
        else if (g > v2) { v3 = v2; i3 = i2; v2 = g; i2 = j; }
        else if (g > v3) { v3 = g; i3 = j; }
    }
    unsigned m = 0;
    if (i1 >= 0) m |= 1u << i1; if (i2 >= 0) m |= 1u << i2; if (i3 >= 0) m |= 1u << i3;
    sel[idx] = m;
}
__device__ __forceinline__ float ldbf(const void* p, size_t i) { return __builtin_bit_cast(float, (unsigned)((const unsigned short*)p)[i] << 16); }
template <bool MOBA, bool FAST>
__global__ void __launch_bounds__(256) attn(const float* __restrict__ Qb, const float* __restrict__ KVb, const float* __restrict__ KRb, const unsigned* __restrict__ sel, float* O) {
    constexpr int DQK = MOBA ? 64 : 96;
    __shared__ float Qs[64][DQK + 1], Ks[32][DQK + 1], Vs[32][65], Ps[64][33];
    const int qb = blockIdx.x, h = blockIdx.y, b = blockIdx.z, tid = threadIdx.x, qi = tid >> 2, sub = tid & 3;
    const size_t row0 = (size_t)b * SEQ + (size_t)qb * 64;
    for (int idx = tid; idx < 64 * DQK; idx += 256) { const int r = idx / DQK, c = idx % DQK;
        if (FAST) Qs[r][c] = MOBA ? ldbf(Qb, (row0 + r) * 4352 + C_QA + h * 64 + c) : ldbf(Qb, (row0 + r) * 768 + h * 96 + c);
        else Qs[r][c] = MOBA ? Qb[(row0 + r) * INC + C_QA + h * 64 + c] : Qb[(row0 + r) * 768 + h * 96 + c]; }
    const int tq = qb * 64 + qi, own = tq / BLK;
    const unsigned mask = MOBA ? sel[(row0 + qi) * 8 + h] : 0u;
    const float slope = exp2f(-(float)(h + 1)), scale = FAST ? 0.6931471805599453f : (MOBA ? 0.125f : 0.10206207261596577f);
    float m = -1e30f, l = 0.f, o[16];
#pragma unroll
    for (int d = 0; d < 16; ++d) o[d] = 0.f;
    const int nkt = (qb * 64 + 64) / 32;
    for (int kt = 0; kt < nkt; ++kt) {
        __syncthreads();
        for (int idx = tid; idx < 32 * DQK; idx += 256) { const int r = idx / DQK, c = idx % DQK; const size_t kr = (size_t)b * SEQ + kt * 32 + r;
            if (FAST) Ks[r][c] = MOBA ? ldbf(KVb, kr * 4352 + C_KA + h * 64 + c) : ldbf(KVb, kr * 768 + h * 96 + c);
            else Ks[r][c] = MOBA ? KVb[kr * INC + C_KA + h * 64 + c] : (c < 64 ? KVb[kr * 1024 + h * 128 + c] : KRb[kr * DR + c - 64]); }
        for (int idx = tid; idx < 32 * 64; idx += 256) { const int r = idx >> 6, c = idx & 63; const size_t kr = (size_t)b * SEQ + kt * 32 + r;
            if (FAST) Vs[r][c] = MOBA ? ldbf(KVb, kr * 4352 + C_VA + h * 64 + c) : ldbf(KRb, kr * 512 + h * 64 + c);
            else Vs[r][c] = MOBA ? KVb[kr * INC + C_VA + h * 64 + c] : KVb[kr * 1024 + h * 128 + 64 + c]; }
        __syncthreads();
        float s[8]; float rmax = -1e30f;
#pragma unroll
        for (int j = 0; j < 8; ++j) {
            const int kk = sub + 4 * j, kpos = kt * 32 + kk;
            float dot = 0.f;
            for (int c = 0; c < DQK; ++c) dot = fmaf(Qs[qi][c], Ks[kk][c], dot);
            float sc = dot * scale; bool ok;
            if (MOBA) { sc -= slope * (float)(tq - kpos); const int kb = kpos / BLK; ok = (kb == own) ? (kpos <= tq) : (((mask >> kb) & 1u) != 0u); }
            else ok = kpos <= tq;
            s[j] = ok ? sc : -1e30f; rmax = fmaxf(rmax, s[j]);
        }
        rmax = fmaxf(rmax, __shfl_xor(rmax, 1)); rmax = fmaxf(rmax, __shfl_xor(rmax, 2));
        const float mn = fmaxf(m, rmax), alpha = expf(m - mn);
        float psum = 0.f;
#pragma unroll
        for (int j = 0; j < 8; ++j) { const float p = (s[j] > -1e29f) ? expf(s[j] - mn) : 0.f; Ps[qi][sub + 4 * j] = p; psum += p; }
        psum += __shfl_xor(psum, 1); psum += __shfl_xor(psum, 2);
        l = l * alpha + psum; m = mn;
        __syncthreads();
#pragma unroll
        for (int d = 0; d < 16; ++d) o[d] *= alpha;
        for (int kk = 0; kk < 32; ++kk) { const float p = Ps[qi][kk];
#pragma unroll
            for (int d = 0; d < 16; ++d) o[d] = fmaf(p, Vs[kk][sub * 16 + d], o[d]); }
    }
    const float rl = 1.f / l;
#pragma unroll
    for (int d = 0; d < 16; ++d) O[(row0 + qi) * 512 + h * 64 + sub * 16 + d] = o[d] * rl;
}
template <bool COMB>
__global__ void __launch_bounds__(256) lnorm(const float* __restrict__ in, const float* __restrict__ x1, const float* __restrict__ shared_, const float* __restrict__ Y, const float* __restrict__ g, const float* __restrict__ bt, float* out) {
    __shared__ float red[8];
    const int row = blockIdx.x, tid = threadIdx.x;
    float v[4];
#pragma unroll
    for (int i = 0; i < 4; ++i) { const int c = tid + 256 * i;
        if (COMB) { float a = ALPHA * x1[(size_t)row * DM + c] + shared_[(size_t)row * DM + c];
            for (int k = 0; k < TOPK; ++k) a += Y[((size_t)row * TOPK + k) * DM + c];
            v[i] = a; }
        else v[i] = in[(size_t)row * DM + c]; }
    float s = v[0] + v[1] + v[2] + v[3];
#pragma unroll
    for (int o = 32; o; o >>= 1) s += __shfl_xor(s, o);
    if ((tid & 63) == 0) red[tid >> 6] = s;
    __syncthreads();
    const float mu = (red[0] + red[1] + red[2] + red[3]) * (1.f / DM);
    float q = 0.f;
#pragma unroll
    for (int i = 0; i < 4; ++i) { const float d = v[i] - mu; q += d * d; }
#pragma unroll
    for (int o = 32; o; o >>= 1) q += __shfl_xor(q, o);
    if ((tid & 63) == 0) red[4 + (tid >> 6)] = q;
    __syncthreads();
    const float rs = rsqrtf((red[4] + red[5] + red[6] + red[7]) * (1.f / DM) + LN_EPS);
#pragma unroll
    for (int i = 0; i < 4; ++i) { const int c = tid + 256 * i; out[(size_t)row * DM + c] = (v[i] - mu) * rs * g[c] + bt[c]; }
}
__global__ void __launch_bounds__(256) route(const float* __restrict__ logits, const float* __restrict__ rbias, int* tope, float* topw, int* apos, unsigned* cnt) {
    const int wid = threadIdx.x >> 6, lane = threadIdx.x & 63, t = blockIdx.x * 4 + wid;
    const float4 lg = *(const float4*)(logits + (size_t)t * NE + lane * 4), rb = *(const float4*)(rbias + lane * 4);
    float s0 = 1.f / (1.f + expf(-lg.x)), s1 = 1.f / (1.f + expf(-lg.y)), s2 = 1.f / (1.f + expf(-lg.z)), s3 = 1.f / (1.f + expf(-lg.w));
    float c0 = s0 + rb.x, c1 = s1 + rb.y, c2 = s2 + rb.z, c3 = s3 + rb.w;
    float a = fmaxf(c0, c1), bq = fminf(c0, c1);
    { const float hi2 = fmaxf(c2, c3), lo2 = fminf(c2, c3); const float na = fmaxf(a, hi2); const float nb = fmaxf(fminf(a, hi2), fmaxf(bq, lo2)); a = na; bq = nb; }
#pragma unroll
    for (int o = 1; o < 8; o <<= 1) { const float oa = __shfl_xor(a, o), ob = __shfl_xor(bq, o); const float na = fmaxf(a, oa), nb = fmaxf(fminf(a, oa), fmaxf(bq, ob)); a = na; bq = nb; }
    const float gs = a + bq; const int grp = lane >> 3;
    int rank = 0;
#pragma unroll
    for (int j = 0; j < 8; ++j) { const float og = __shfl(gs, j * 8); rank += (og > gs || (og == gs && j < grp)) ? 1 : 0; }
    const bool gsel = rank < 4;
    if (!gsel) { c0 = c1 = c2 = c3 = -INFINITY; }
    float wsum = 0.f, myw = 0.f; int mye = 0;
#pragma unroll
    for (int k = 0; k < TOPK; ++k) {
        float bv = c0; int bi = 0;
        if (c1 > bv) { bv = c1; bi = 1; } if (c2 > bv) { bv = c2; bi = 2; } if (c3 > bv) { bv = c3; bi = 3; }
        int be = lane * 4 + bi;
#pragma unroll
        for (int o = 1; o < 64; o <<= 1) { const float ov = __shfl_xor(bv, o); const int oe = __shfl_xor(be, o); if (ov > bv || (ov == bv && oe < be)) { bv = ov; be = oe; } }
        float sc = 0.f;
        if ((be >> 2) == lane) { const int bi2 = be & 3; sc = bi2 == 0 ? s0 : bi2 == 1 ? s1 : bi2 == 2 ? s2 : s3; if (bi2 == 0) c0 = -INFINITY; else if (bi2 == 1) c1 = -INFINITY; else if (bi2 == 2) c2 = -INFINITY; else c3 = -INFINITY; }
        sc = __shfl(sc, be >> 2);
        wsum += sc;
        if (lane == k) { myw = sc; mye = be; }
    }
    if (lane < TOPK) {
        const int aidx = t * TOPK + lane;
        tope[aidx] = mye; topw[aidx] = myw / wsum * 2.5f;
        apos[aidx] = (int)atomicAdd(&cnt[mye], 1u);
    }
}
template <int TM>
__global__ void __launch_bounds__(256) escan(const unsigned* __restrict__ cnt, int* off, int* toff) {
    __shared__ int sc[256], st[256];
    const int e = threadIdx.x; const int c = (int)cnt[e];
    sc[e] = c; st[e] = (c + TM - 1) / TM;
    __syncthreads();
    if (e == 0) { int a = 0, b = 0; for (int i = 0; i < 256; ++i) { const int ca = sc[i], cb = st[i]; sc[i] = a; st[i] = b; a += ca; b += cb; } off[256] = a; toff[256] = b; }
    __syncthreads();
    off[e] = sc[e]; toff[e] = st[e];
}
__global__ void __launch_bounds__(256) escatter(const int* __restrict__ tope, const int* __restrict__ apos, const int* __restrict__ off, int* rowa) {
    const int a = blockIdx.x * 256 + threadIdx.x;
    rowa[off[tope[a]] + apos[a]] = a;
}
template <int MODE>
__global__ void __launch_bounds__(256) egemm(const float* __restrict__ X, const float* __restrict__ W0, const float* __restrict__ W1, const int* __restrict__ off, const int* __restrict__ toff, const int* __restrict__ rowa,
                                            const float* __restrict__ topw, float* out) {
    __shared__ float As[16][68], Bs[16][68], Cs[16][68];
    __shared__ int se;
    const int tile = blockIdx.y;
    if (tile >= toff[256]) return;
    const int tid = threadIdx.x, tx = tid & 15, ty = tid >> 4;
    if (tid == 0) { int lo = 0, hi = 255; while (lo < hi) { const int mid = (lo + hi + 1) >> 1; if (toff[mid] <= tile) lo = mid; else hi = mid - 1; } se = lo; }
    __syncthreads();
    const int e = se, r0 = off[e] + (tile - toff[e]) * 64, rend = off[e + 1];
    constexpr int K = MODE == 0 ? DM : DE, N = MODE == 0 ? DE : DM;
    const int n0 = blockIdx.x * 64;
    const float* B0 = W0 + (size_t)e * K * N; const float* B1 = MODE == 0 ? W1 + (size_t)e * K * N : nullptr;
    const int ar = tid >> 2, ak = (tid & 3) * 4, bk = tid >> 4, bn = (tid & 15) * 4;
    const int arow = r0 + ar; const bool aval = arow < rend;
    const float* ap = nullptr;
    if (aval) ap = MODE == 0 ? X + (size_t)(rowa[arow] >> 3) * DM : X + (size_t)arow * DE;
    float acc[4][4], acu[4][4];
#pragma unroll
    for (int i = 0; i < 4; ++i)
#pragma unroll
        for (int j = 0; j < 4; ++j) { acc[i][j] = 0.f; acu[i][j] = 0.f; }
    for (int k0 = 0; k0 < K; k0 += 16) {
        float4 av = make_float4(0.f, 0.f, 0.f, 0.f);
        if (aval) av = *(const float4*)(ap + k0 + ak);
        const float4 bv = *(const float4*)(B0 + (size_t)(k0 + bk) * N + n0 + bn);
        float4 cv = make_float4(0.f, 0.f, 0.f, 0.f);
        if (MODE == 0) cv = *(const float4*)(B1 + (size_t)(k0 + bk) * N + n0 + bn);
        __syncthreads();
        As[ak + 0][ar] = av.x; As[ak + 1][ar] = av.y; As[ak + 2][ar] = av.z; As[ak + 3][ar] = av.w;
        *(float4*)&Bs[bk][bn] = bv; if (MODE == 0) *(float4*)&Cs[bk][bn] = cv;
        __syncthreads();
#pragma unroll
        for (int kk = 0; kk < 16; ++kk) {
            const float4 a = *(const float4*)&As[kk][ty * 4];
            const float4 b = *(const float4*)&Bs[kk][tx * 4];
            const float aa[4] = {a.x, a.y, a.z, a.w}, bb[4] = {b.x, b.y, b.z, b.w};
#pragma unroll
            for (int i = 0; i < 4; ++i)
#pragma unroll
                for (int j = 0; j < 4; ++j) acc[i][j] = fmaf(aa[i], bb[j], acc[i][j]);
            if (MODE == 0) { const float4 c = *(const float4*)&Cs[kk][tx * 4]; const float cc[4] = {c.x, c.y, c.z, c.w};
#pragma unroll
                for (int i = 0; i < 4; ++i)
#pragma unroll
                    for (int j = 0; j < 4; ++j) acu[i][j] = fmaf(aa[i], cc[j], acu[i][j]); }
        }
    }
#pragma unroll
    for (int i = 0; i < 4; ++i) { const int r = r0 + ty * 4 + i; if (r < rend) {
        if (MODE == 0) {
#pragma unroll
            for (int j = 0; j < 4; ++j) { const float g = acc[i][j]; out[(size_t)r * DE + n0 + tx * 4 + j] = g / (1.f + expf(-g)) * acu[i][j]; } }
        else { const int a = rowa[r]; const float w = topw[a];
#pragma unroll
            for (int j = 0; j < 4; ++j) out[(size_t)a * DM + n0 + tx * 4 + j] = acc[i][j] * w; } } }
}
}


namespace fk {
#define LAS __attribute__((address_space(3)))
#define GAS __attribute__((address_space(1)))
typedef unsigned short bf16_t;
typedef short bf16x8 __attribute__((ext_vector_type(8)));
typedef float f32x4 __attribute__((ext_vector_type(4)));
typedef float f32x2 __attribute__((ext_vector_type(2)));
typedef float f32x16 __attribute__((ext_vector_type(16)));
typedef unsigned u32x4 __attribute__((ext_vector_type(4)));
typedef unsigned u32x2 __attribute__((ext_vector_type(2)));
constexpr int NWAVES = 8, NTHR = 512;
constexpr int INCP = 4352;
constexpr float LOG2E = 1.4426950408889634f;
constexpr float QS_A = 0.125f * LOG2E;
constexpr float QS_B = 0.10206207261596577f * LOG2E;
#define LDS_WAIT() asm volatile("s_waitcnt lgkmcnt(0)" ::: "memory")
#define VM_WAIT() asm volatile("s_waitcnt vmcnt(0)" ::: "memory")
__device__ __forceinline__ unsigned f2bf(float f) { unsigned u = __builtin_bit_cast(unsigned, f); return (u + 0x7fffu + ((u >> 16) & 1u)) >> 16; }
__device__ __forceinline__ unsigned pk2(float lo, float hi) { return f2bf(lo) | (f2bf(hi) << 16); }
__device__ __forceinline__ float bf2f(unsigned short b) { return __builtin_bit_cast(float, (unsigned)b << 16); }
__device__ __forceinline__ float bflo(unsigned w) { return __builtin_bit_cast(float, w << 16); }
__device__ __forceinline__ float bfhi(unsigned w) { return __builtin_bit_cast(float, w & 0xffff0000u); }
__device__ __forceinline__ float sigmoidf_(float x) { return __builtin_amdgcn_rcpf(1.f + __expf(-x)); }
__device__ __forceinline__ float wave_sum(float v) {
#pragma unroll
    for (int o = 1; o < 64; o <<= 1) v += __shfl_xor(v, o);
    return v;
}

namespace pg8 {
constexpr int BM = 256, BK = 64, HALF = 128, HTB = HALF * BK * 2, STAGE_BYTES = 8 * HTB, NXCD = 8, WGM = 8;
__host__ __device__ __forceinline__ int lds_byte(int r, int c) { const int st = (r >> 4) * 2 + (c >> 5), rr = r & 15, cc = c & 31, ob = rr * 64 + cc * 2; return st * 1024 + (ob ^ (((ob >> 9) & 1) << 5)); }
__host__ __device__ __forceinline__ void stage_rc(int b, int& R, int& C) { const int st = b / 1024, sb = b % 1024, swz = sb ^ (((sb >> 9) & 1) << 5); R = (st >> 1) * 16 + swz / 64; C = (st & 1) * 32 + (swz % 64) / 2; }
__host__ __device__ __forceinline__ int perm32(int rho) { const int n = rho >> 4, i = rho & 15; return 8 * (i >> 2) + 4 * n + (i & 3); }

struct Unit { int pm, pn, e, r0, rend; };
struct Gemm { const bf16_t* A; const bf16_t* Bt; int M, N, K, lda, ldb; };

struct StaticOrder {
    int nM, nN, nwg, G, c;
    __device__ void init(int M, int N, int G_, int c_) { nM = M / BM; nN = N / BM; nwg = nM * nN; G = G_; c = c_; }
    __device__ bool next(int i, Unit& u) const {
        const long L = (long)i * G + c; if (L >= nwg) return false;
        int wgid = (int)L; { const int q = nwg / NXCD, r = nwg % NXCD, xcd = wgid % NXCD, off = wgid / NXCD; wgid = (xcd < r ? xcd * (q + 1) : r * (q + 1) + (xcd - r) * q) + off; }
        const int nig = WGM * nN, gid = wgid / nig, fm = gid * WGM, gsz = (nM - fm) < WGM ? (nM - fm) : WGM;
        u.pm = fm + ((wgid % nig) % gsz); u.pn = (wgid % nig) / gsz; u.e = 0; u.r0 = u.pm * BM; u.rend = u.r0 + BM; return true;
    }
    __device__ __forceinline__ int a_row(const Unit& u, int r) const { return u.pm * BM + r; }
    __device__ __forceinline__ const char* b_ptr(const Gemm& g, const Unit& u) const { return (const char*)g.Bt + (size_t)u.pn * BM * g.ldb * 2; }
};

typedef float f32x2_t_ __attribute__((ext_vector_type(2))); typedef __bf16 bf16x2_t_ __attribute__((ext_vector_type(2)));
__device__ __forceinline__ unsigned cvt_pk_bf16(float lo, float hi) { const f32x2_t_ v = {lo, hi}; const bf16x2_t_ b = __builtin_convertvector(v, bf16x2_t_); return __builtin_bit_cast(unsigned, b); }

template <class Epi, class Sched, bool ALIGN_EPI>
__device__ __forceinline__ void gemm_phase(LAS unsigned char* lds, const Gemm g, const Sched& S, const Epi& E) {
    int tid_ = threadIdx.x; asm volatile("" : "+v"(tid_));
    const int tid = tid_, wid = __builtin_amdgcn_readfirstlane(tid >> 6), lane = tid & 63, wr = wid >> 2, wc = wid & 3, fr = lane & 15, fq = lane >> 4;
    const int K = g.K, nt = K / BK;
    int RA[2]; unsigned CA[2], voffB[2];
#pragma unroll
    for (int i = 0; i < 2; ++i) { int R, C; stage_rc(tid * 16 + i * 8192, R, C); const int Rb = (R & ~31) + perm32(R & 31);
        RA[i] = R; CA[i] = (unsigned)C * 2u; voffB[i] = (unsigned)(Rb * g.ldb + C) * 2u; }
    const unsigned lda2 = (unsigned)g.lda * 2u;
    const size_t hstepB = (size_t)HALF * g.ldb * 2;
    const unsigned ldsw = (unsigned)wid * 1024u;
    const int aoff = lds_byte(wr * 64 + fr, fq * 8), boff = lds_byte(wc * 32 + fr, fq * 8);
    const char* const Abase = (const char*)g.A;
#define PG8_SA(b, h) (((b) * 2 + (h)) * HTB)
#define PG8_SB(b, h) ((4 + (b) * 2 + (h)) * HTB)
#define PG8_STAGE_B(bufoff, gbase) do { _Pragma("unroll") for (int _i = 0; _i < 2; ++_i) \
        __builtin_amdgcn_global_load_lds((const unsigned*)((const char*)(gbase) + voffB[_i]), (LAS unsigned*)(lds + (bufoff) + ldsw + _i * 8192), 16, 0, 0); } while (0)
#define PG8_STAGE_A(bufoff, V0, V1, kb) do { \
        __builtin_amdgcn_global_load_lds((const unsigned*)((Abase + (kb)) + (V0)), (LAS unsigned*)(lds + (bufoff) + ldsw), 16, 0, 0); \
        __builtin_amdgcn_global_load_lds((const unsigned*)((Abase + (kb)) + (V1)), (LAS unsigned*)(lds + (bufoff) + ldsw + 8192), 16, 0, 0); } while (0)
#define PG8_LDA(dst, b, h) do { _Pragma("unroll") for (int m = 0; m < 4; ++m) _Pragma("unroll") for (int k = 0; k < 2; ++k) dst[m][k] = *(const LAS bf16x8*)(lds + PG8_SA(b, h) + aoff + m * 2048 + k * 1024); } while (0)
#define PG8_LDB(dst, b, h) do { _Pragma("unroll") for (int n = 0; n < 2; ++n) _Pragma("unroll") for (int k = 0; k < 2; ++k) dst[n][k] = *(const LAS bf16x8*)(lds + PG8_SB(b, h) + boff + n * 2048 + k * 1024); } while (0)
#define PG8_MMA(ai, bj, At, Bt) do { __builtin_amdgcn_s_setprio(1); _Pragma("unroll") for (int m = 0; m < 4; ++m) _Pragma("unroll") for (int n = 0; n < 2; ++n) _Pragma("unroll") for (int k = 0; k < 2; ++k) \
        acc[ai][bj][m][n] = __builtin_amdgcn_mfma_f32_16x16x32_bf16(Bt[n][k], At[m][k], acc[ai][bj][m][n], 0, 0, 0); __builtin_amdgcn_s_setprio(0); } while (0)
#define PG8_WAIT_V(n) asm volatile("s_waitcnt vmcnt(" #n ")" ::: "memory")
#define PG8_WAIT_L(n) asm volatile("s_waitcnt lgkmcnt(" #n ")" ::: "memory")
#define PG8_BAR __builtin_amdgcn_s_barrier()
#define PG8_SCHED __builtin_amdgcn_sched_barrier(0)
#define PG8_VOFF(V, U) do { V##00 = (unsigned)S.a_row(U, RA[0]) * lda2 + CA[0]; V##01 = (unsigned)S.a_row(U, RA[1]) * lda2 + CA[1]; \
        V##10 = (unsigned)S.a_row(U, HALF + RA[0]) * lda2 + CA[0]; V##11 = (unsigned)S.a_row(U, HALF + RA[1]) * lda2 + CA[1]; } while (0)
    Unit cur, nxt; int ui = 0;
    if (!S.next(0, cur)) return;
    f32x4 acc[2][2][4][2];
#pragma unroll
    for (int a = 0; a < 2; ++a)
#pragma unroll
        for (int b = 0; b < 2; ++b)
#pragma unroll
            for (int m = 0; m < 4; ++m)
#pragma unroll
                for (int n = 0; n < 2; ++n) acc[a][b][m][n] = (f32x4){0.f, 0.f, 0.f, 0.f};
    bf16x8 At[4][2], B0[2][2], B1[2][2];
    unsigned vc00, vc01, vc10, vc11;
    PG8_VOFF(vc, cur);
    const char* cB = S.b_ptr(g, cur);
    PG8_STAGE_B(PG8_SB(0, 0), cB); PG8_STAGE_B(PG8_SB(0, 1), cB + hstepB); PG8_STAGE_A(PG8_SA(0, 0), vc00, vc01, 0u); PG8_STAGE_A(PG8_SA(0, 1), vc10, vc11, 0u);
    if (wr == 1) PG8_BAR;
    PG8_WAIT_V(2); PG8_BAR;
    PG8_STAGE_B(PG8_SB(1, 0), cB + 128); PG8_STAGE_A(PG8_SA(1, 0), vc00, vc01, 128u); PG8_STAGE_B(PG8_SB(1, 1), cB + hstepB + 128);
    PG8_WAIT_V(6); PG8_BAR;
    for (;;) {
        const bool has_next = S.next(ui + 1, nxt);
        const char* nB = has_next ? S.b_ptr(g, nxt) : cB;
        const bool half1 = (cur.rend - cur.r0) > HALF;
#pragma unroll 1
        for (int t = 0; t < nt; t += 2) {
            const bool last = (t == nt - 2);
            const unsigned kb1 = (unsigned)(t + 1) * 128u;
            unsigned kb2 = (unsigned)(t + 2) * 128u;
            unsigned s00 = vc00, s01 = vc01, s10 = vc10, s11 = vc11;
            const char* b2 = cB + (size_t)kb2;
            if (last) { kb2 = 0u; b2 = nB; if (has_next) { PG8_VOFF(s, nxt); } }
            const unsigned kb3 = kb2 + 128u; const char* b3 = b2 + 128;
            PG8_LDB(B0, 0, 0); PG8_LDB(B1, 0, 1); PG8_SCHED; PG8_LDA(At, 0, 0); PG8_STAGE_A(PG8_SA(1, 1), vc10, vc11, kb1);
            PG8_WAIT_V(8); PG8_WAIT_L(0); PG8_BAR; PG8_MMA(0, 0, At, B0); PG8_MMA(0, 1, At, B1); PG8_BAR; PG8_SCHED;
            PG8_LDA(At, 0, 1); PG8_STAGE_B(PG8_SB(0, 0), b2); PG8_STAGE_B(PG8_SB(0, 1), b2 + hstepB); PG8_STAGE_A(PG8_SA(0, 0), s00, s01, kb2);
            PG8_WAIT_V(8); PG8_WAIT_L(0); PG8_BAR; if (half1) { PG8_MMA(1, 0, At, B0); PG8_MMA(1, 1, At, B1); } PG8_BAR; PG8_SCHED;
            PG8_LDB(B0, 1, 0); PG8_LDB(B1, 1, 1); PG8_SCHED; PG8_LDA(At, 1, 0); PG8_STAGE_A(PG8_SA(0, 1), s10, s11, kb2);
            PG8_WAIT_V(8); PG8_WAIT_L(0); PG8_BAR; PG8_MMA(0, 0, At, B0); PG8_MMA(0, 1, At, B1); PG8_BAR; PG8_SCHED;
            PG8_LDA(At, 1, 1); PG8_STAGE_B(PG8_SB(1, 0), b3); PG8_STAGE_B(PG8_SB(1, 1), b3 + hstepB); PG8_STAGE_A(PG8_SA(1, 0), s00, s01, kb3);
            PG8_WAIT_V(8); PG8_WAIT_L(0); PG8_BAR; if (half1) { PG8_MMA(1, 0, At, B0); PG8_MMA(1, 1, At, B1); } PG8_BAR; PG8_SCHED;
        }
        if constexpr (ALIGN_EPI) { if (wr == 0) PG8_BAR; }
        E(acc, cur, wr, wc, fr, fq);
        if (!has_next) break;
#pragma unroll
        for (int a = 0; a < 2; ++a)
#pragma unroll
            for (int b = 0; b < 2; ++b)
#pragma unroll
                for (int m = 0; m < 4; ++m)
#pragma unroll
                    for (int n = 0; n < 2; ++n) acc[a][b][m][n] = (f32x4){0.f, 0.f, 0.f, 0.f};
        cur = nxt; cB = nB; PG8_VOFF(vc, cur); ++ui;
        if constexpr (ALIGN_EPI) { if (wr == 1) PG8_BAR; }
    }
    PG8_WAIT_V(0);
    if constexpr (!ALIGN_EPI) { if (wr == 0) PG8_BAR; }
    PG8_BAR;
#undef PG8_SA
#undef PG8_SB
#undef PG8_STAGE_A
#undef PG8_STAGE_B
#undef PG8_LDA
#undef PG8_LDB
#undef PG8_MMA
#undef PG8_WAIT_V
#undef PG8_WAIT_L
#undef PG8_BAR
#undef PG8_SCHED
#undef PG8_VOFF
}
#define PG8_TILE_BEGIN(acc, wr, wc, fr, fq) \
    _Pragma("unroll") for (int ai = 0; ai < 2; ++ai) _Pragma("unroll") for (int m = 0; m < 4; ++m) _Pragma("unroll") for (int bj = 0; bj < 2; ++bj) { \
        const int trow = ai * 128 + wr * 64 + m * 16 + fr, tcol = bj * 128 + wc * 32 + 8 * fq; f32x4 v0 = acc[ai][bj][m][0], v1 = acc[ai][bj][m][1];
#define PG8_TILE_END }
__device__ __forceinline__ u32x4 pack8(f32x4 v0, f32x4 v1) { u32x4 w; w.x = cvt_pk_bf16(v0[0], v0[1]); w.y = cvt_pk_bf16(v0[2], v0[3]); w.z = cvt_pk_bf16(v1[0], v1[1]); w.w = cvt_pk_bf16(v1[2], v1[3]); return w; }
}

#define XB_TMO      128
#define XB_XCNT(j)  (256  + 64 * (j))
#define XB_XSUB(j)  (1280 + 64 * (j))
#define XB_XGEN(j)  (2304 + 64 * (j))
#define XB_TOP      3328
#define XB_TOPGEN   3392
#define XCD_BAR_WORDS 3456
#define XB_SPIN_CAP (1u << 18)

__device__ __forceinline__ unsigned xb_ld(unsigned* p)              { return __hip_atomic_load(p, __ATOMIC_RELAXED, __HIP_MEMORY_SCOPE_AGENT); }
__device__ __forceinline__ unsigned xb_add(unsigned* p, unsigned v) { return __hip_atomic_fetch_add(p, v, __ATOMIC_RELAXED, __HIP_MEMORY_SCOPE_AGENT); }
__device__ __forceinline__ unsigned xb_xcc_id() { return (unsigned)__builtin_amdgcn_s_getreg((3 << 11) | 20) & 0xFu; }
#define XB_SPIN(cond, bar) do { unsigned _sp = 0; while (cond) { __builtin_amdgcn_s_sleep(1); \
    if ((++_sp & 255u) == 0u) { if (xb_ld(&(bar)[XB_TMO])) break; if (_sp > XB_SPIN_CAP) { atomicAdd(&(bar)[XB_TMO], 1u); break; } } } } while (0)

struct XcdBarrier {
    unsigned* bar; unsigned x;
    volatile LAS unsigned* st;
};

__device__ __forceinline__ XcdBarrier xcd_barrier_post(unsigned* bar, volatile LAS unsigned* st) {
    XcdBarrier b; b.bar = bar; b.x = xb_xcc_id(); b.st = st;
    if (threadIdx.x == 0) (void)xb_add(&bar[XB_XCNT(b.x)], 1u);
    return b;
}
__device__ __forceinline__ void xcd_barrier_complete(unsigned* bar, unsigned x, unsigned& nloc, unsigned& nx) {
    const unsigned G = gridDim.x * gridDim.y * gridDim.z;
    unsigned sum, cnt, mine, sp = 0u;
    for (;;) {
        sum = 0u; cnt = 0u; mine = 0u;
#pragma unroll
        for (unsigned j = 0; j < 16; ++j) { const unsigned c = xb_ld(&bar[XB_XCNT(j)]); sum += c; cnt += (c > 0u) ? 1u : 0u; mine = (j == x) ? c : mine; }
        if (sum == G) break;
        __builtin_amdgcn_s_sleep(1);
        if ((++sp & 255u) == 0u) { if (xb_ld(&bar[XB_TMO])) break; if (sp > XB_SPIN_CAP) { atomicAdd(&bar[XB_TMO], 1u); break; } }
    }
    nloc = mine > 0u ? mine : 1u; nx = cnt > 0u ? cnt : 1u;
}

__device__ __forceinline__ void xcd_barrier(const XcdBarrier& b) {
    asm volatile("s_waitcnt vmcnt(0)" ::: "memory");
    __syncthreads();
    if (threadIdx.x == 0) {
        unsigned* bar = b.bar; asm volatile("" : "+s"(bar));
        __builtin_amdgcn_s_waitcnt(0);
        unsigned nloc = b.st[0], nx = b.st[1];
        if (nloc == 0u) { xcd_barrier_complete(bar, b.x, nloc, nx); b.st[0] = nloc; b.st[1] = nx; }
        const unsigned old = xb_add(&bar[XB_XSUB(b.x)], 1u);
        const unsigned gen = old / nloc;
        if (old + 1u == (gen + 1u) * nloc) {
            __builtin_amdgcn_fence(__ATOMIC_RELEASE, "agent");
            asm volatile("s_waitcnt vmcnt(0)" ::: "memory");
            const unsigned og = xb_add(&bar[XB_TOP], 1u);
            const unsigned tg = og / nx;
            if (og + 1u == (tg + 1u) * nx) xb_add(&bar[XB_TOPGEN], 1u);
            else XB_SPIN(xb_ld(&bar[XB_TOPGEN]) == tg, bar);
            __builtin_amdgcn_fence(__ATOMIC_ACQUIRE, "agent");
            xb_add(&bar[XB_XGEN(b.x)], 1u);
            asm volatile("s_waitcnt vmcnt(0)" ::: "memory");
        } else {
            XB_SPIN(xb_ld(&bar[XB_XGEN(b.x)]) == gen, bar);
            __builtin_amdgcn_fence(__ATOMIC_ACQUIRE, "agent");
            asm volatile("s_waitcnt vmcnt(0)" ::: "memory");
        }
    }
    __syncthreads();
}


struct Params {
    const float* in[22]; float* out; unsigned char* ws;
    int ph_lo, ph_hi;
};
constexpr size_t MiB = 1u << 20;
constexpr size_t WS_CTL = 0, CTL_BYTES = 1 * MiB;
constexpr int CW_BAR = 4096;
constexpr int CW_CNT = 16384;
constexpr size_t WS_WIN = 2 * MiB;
constexpr size_t SZ_WIN = (size_t)INCP * DM;
constexpr size_t SZ_WUQ = (size_t)768 * QL, SZ_WUKV = (size_t)1024 * KVL;
constexpr size_t WS_WUQ = WS_WIN + 2 * SZ_WIN * 2;
constexpr size_t WS_WUKV = WS_WUQ + 2 * SZ_WUQ * 2;
constexpr size_t SZ_WP = (size_t)DM * 512, SZ_WOUT = (size_t)DM * DM;
constexpr size_t WS_WPA = WS_WUKV + 2 * SZ_WUKV * 2;
constexpr size_t WS_WPB = WS_WPA + 2 * SZ_WP * 2;
constexpr size_t WS_WOUT = WS_WPB + 2 * SZ_WP * 2;
constexpr size_t SZ_WRT = (size_t)NE * DM, SZ_WSGU = (size_t)512 * DM, SZ_WSD = (size_t)DM * DSH;
constexpr size_t WS_WRT = WS_WOUT + 2 * SZ_WOUT * 2;
constexpr size_t WS_WSGU = WS_WRT + 2 * SZ_WRT * 2;
constexpr size_t WS_WSD = WS_WSGU + 2 * SZ_WSGU * 2;
constexpr size_t WS_CS = WS_WSD + 2 * SZ_WSD * 2;
constexpr size_t WS_KM = WS_CS + (size_t)SEQ * 16 * 8;
constexpr size_t WS_SEL = WS_KM + (size_t)NB * HA * NBLK * 64 * 4;
constexpr size_t WS_XB = WS_SEL + (size_t)T * 8 * 4;
constexpr size_t WS_CQN = WS_XB + (size_t)T * DM * 2;
constexpr size_t WS_CKVN = WS_CQN + (size_t)T * QL * 2;
constexpr size_t WS_QB = WS_CKVN + (size_t)T * KVL * 2;
constexpr size_t WS_KB = WS_QB + (size_t)T * 768 * 2;
constexpr size_t WS_VB = WS_KB + (size_t)T * 768 * 2;
constexpr size_t WS_OAB = WS_VB + (size_t)T * 512 * 2;
constexpr size_t WS_TMP = WS_OAB + (size_t)T * 1024 * 2;
constexpr size_t WS_MRG = WS_TMP + (size_t)T * 1024 * 2;
constexpr size_t WS_PRE = WS_MRG + (size_t)T * 1024 * 2;
constexpr size_t WS_X1 = WS_PRE + (size_t)T * 1024 * 4;
constexpr size_t WS_X1B = WS_X1 + (size_t)T * 1024 * 4;
constexpr size_t WS_X2 = WS_X1B + (size_t)T * 1024 * 2;
constexpr size_t WS_LOG = WS_X2 + (size_t)T * 1024 * 4;
constexpr size_t WS_HS = WS_LOG + (size_t)T * NE * 4;
constexpr size_t WS_SH = WS_HS + (size_t)T * DSH * 2;
constexpr size_t WS_TOPE = WS_SH + (size_t)T * DM * 2;
constexpr size_t WS_TOPW = WS_TOPE + (size_t)NA * 4;
constexpr size_t WS_APOS = WS_TOPW + (size_t)NA * 4;
constexpr size_t WS_ROWA = WS_APOS + (size_t)NA * 4;
constexpr size_t WS_HIST = WS_ROWA + (size_t)NA * 8;
constexpr size_t WS_PO = WS_HIST + (size_t)1024 * 256 * 4;
constexpr size_t WS_PML = WS_PO + (size_t)T * 8 * 3 * 64 * 2;
constexpr size_t WS_HE = WS_PML + (size_t)T * 8 * 3 * 128;
constexpr size_t WS_Y = WS_HE + (size_t)NA * DE * 2;
constexpr size_t WS_PROJ = WS_Y + (size_t)NA * DM * 2;
constexpr size_t SZ_WEGU = (size_t)NE * 512 * DM, SZ_WED = (size_t)NE * DM * DE;
constexpr size_t WS_WEGU = WS_PROJ + (size_t)T * INCP * 2;
constexpr size_t WS_WED = WS_WEGU + 2 * SZ_WEGU * 2;
constexpr size_t WS_FAST_END = WS_WED + 2 * SZ_WED * 2;
constexpr size_t WS_NEED = WS_FAST_END;
static_assert(WS_NEED <= (size_t)2040 * MiB, "ws map");

constexpr int LDS_BYTES = 147456;
constexpr int RING_BYTES = 131072, MISC_OFF = RING_BYTES + 1024, TAB_OFF = RING_BYTES + 2048;

struct Frame { LAS unsigned char* lds; int tid, lane, wave, G, vcu; };

template <class RowMap>
__device__ __forceinline__ void transpose_item(const float* W, int K, int N, bf16_t* WT, int ldk, RowMap rm, LAS float* scr, int item, int lane) {
    const int nblk = N / 32, kb = item / nblk, nb = item % nblk, k0 = 64 * kb, n0 = 32 * nb;
#pragma unroll 8
    for (int i = 0; i < 32; ++i) { const int kk = 2 * i + (lane >> 5); scr[kk * 33 + (lane & 31)] = W[(size_t)(k0 + kk) * N + n0 + (lane & 31)]; }
    LDS_WAIT(); asm volatile("" ::: "memory");
    const int c = lane & 7;
#pragma unroll
    for (int j = 0; j < 4; ++j) { const int n = (lane >> 3) + 8 * j; const LAS float* s = scr + (8 * c) * 33 + n;
        u32x4 o; o.x = pk2(s[0 * 33], s[1 * 33]); o.y = pk2(s[2 * 33], s[3 * 33]); o.z = pk2(s[4 * 33], s[5 * 33]); o.w = pk2(s[6 * 33], s[7 * 33]);
        *(u32x4*)(WT + (size_t)rm(n0 + n) * ldk + k0 + 8 * c) = o; }
    LDS_WAIT(); asm volatile("" ::: "memory");
}
template <class RowMap>
__device__ __forceinline__ void transpose_item64(const float* W, int K, int N, bf16_t* WT, int ldk, RowMap rm, LAS unsigned short* scr, int item, int lane) {
    const int nblk = N / 64, kb = item / nblk, nb = item % nblk, k0 = 64 * kb, n0 = 64 * nb, r = lane >> 4, c4 = (lane & 15) * 4;
    f32x4 v[16];
#pragma unroll
    for (int i = 0; i < 16; ++i) v[i] = __builtin_nontemporal_load((const f32x4*)(W + (size_t)(k0 + 4 * i + r) * N + n0 + c4));
#pragma unroll
    for (int i = 0; i < 16; ++i) { LAS unsigned* d = (LAS unsigned*)(scr + (4 * i + r) * 66 + c4); d[0] = pk2(v[i][0], v[i][1]); d[1] = pk2(v[i][2], v[i][3]); }
    LDS_WAIT(); asm volatile("" ::: "memory");
    const int c = lane & 7;
#pragma unroll
    for (int j = 0; j < 8; ++j) { const int n = (lane >> 3) + 8 * j; const LAS unsigned short* q = scr + (8 * c) * 66 + n;
        u32x4 o; o.x = (unsigned)q[0] | ((unsigned)q[66] << 16); o.y = (unsigned)q[2 * 66] | ((unsigned)q[3 * 66] << 16); o.z = (unsigned)q[4 * 66] | ((unsigned)q[5 * 66] << 16); o.w = (unsigned)q[6 * 66] | ((unsigned)q[7 * 66] << 16);
        *(u32x4*)(WT + (size_t)rm(n0 + n) * ldk + k0 + 8 * c) = o; }
    LDS_WAIT(); asm volatile("" ::: "memory");
}
struct RowId { __device__ __forceinline__ int operator()(int n) const { return n; } };

struct EpiProj {
    bf16_t* O; const float* bg;
    __device__ __forceinline__ void operator()(const f32x4 (&acc)[2][2][4][2], const pg8::Unit& u, int wr, int wc, int fr, int fq) const {
        PG8_TILE_BEGIN(acc, wr, wc, fr, fq)
            const int row = u.pm * 256 + trow, col = u.pn * 256 + tcol;
            if (col < C_KA) { v0 = v0 * QS_A; v1 = v1 * QS_A; }
            else if (col >= C_GA && col < INC) { const f32x4 b0 = *(const f32x4*)(bg + col - C_GA), b1 = *(const f32x4*)(bg + col - C_GA + 4);
#pragma unroll
                for (int i = 0; i < 4; ++i) { v0[i] = sigmoidf_(v0[i] + b0[i]); v1[i] = sigmoidf_(v1[i] + b1[i]); } }
            *(u32x4*)(O + (size_t)row * INCP + col) = pg8::pack8(v0, v1);
        PG8_TILE_END
    }
};

struct RowQ { __device__ __forceinline__ int operator()(int n) const { const int h = n / 96, d = n % 96; if (d < 64) return n; const int i = d - 64; return h * 96 + 64 + (i < 16 ? 2 * i : 2 * (i - 16) + 1); } };

struct EpiQ {
    bf16_t* O; const f32x2* CS;
    __device__ __forceinline__ void operator()(const f32x4 (&acc)[2][2][4][2], const pg8::Unit& u, int wr, int wc, int fr, int fq) const {
        PG8_TILE_BEGIN(acc, wr, wc, fr, fq)
            const int row = u.pm * 256 + trow, col = u.pn * 256 + tcol, d = col % 96;
            if (d >= 64) { const int pos = row % SEQ, i0 = (d - 64) >> 1; const f32x2* cs = CS + (size_t)pos * 16 + i0;
                const f32x2 c0 = cs[0], c1 = cs[1], c2 = cs[2], c3 = cs[3];
                const f32x4 a = v0, b = v1;
                v0[0] = a[0] * c0[0] - a[1] * c0[1]; v0[1] = a[1] * c0[0] + a[0] * c0[1]; v0[2] = a[2] * c1[0] - a[3] * c1[1]; v0[3] = a[3] * c1[0] + a[2] * c1[1];
                v1[0] = b[0] * c2[0] - b[1] * c2[1]; v1[1] = b[1] * c2[0] + b[0] * c2[1]; v1[2] = b[2] * c3[0] - b[3] * c3[1]; v1[3] = b[3] * c3[0] + b[2] * c3[1]; }
            v0 = v0 * QS_B; v1 = v1 * QS_B;
            *(u32x4*)(O + (size_t)row * 768 + col) = pg8::pack8(v0, v1);
        PG8_TILE_END
    }
};
struct EpiKV {
    bf16_t* KB; bf16_t* VB;
    __device__ __forceinline__ void operator()(const f32x4 (&acc)[2][2][4][2], const pg8::Unit& u, int wr, int wc, int fr, int fq) const {
        PG8_TILE_BEGIN(acc, wr, wc, fr, fq)
            const int row = u.pm * 256 + trow, col = u.pn * 256 + tcol, h = col >> 7, j = col & 127;
            bf16_t* dst = (j < 64) ? KB + (size_t)row * 768 + h * 96 + j : VB + (size_t)row * 512 + h * 64 + (j - 64);
            *(u32x4*)dst = pg8::pack8(v0, v1);
        PG8_TILE_END
    }
};

__device__ __forceinline__ void prep_phase(const Frame& F, const bf16_t* PROJ, const float* qn, const float* kvn, const f32x2* CS, bf16_t* CQN, bf16_t* CKVN, bf16_t* KB, float* KM) {
    int lane_ = F.lane; asm volatile("" : "+v"(lane_));
    const int gw = F.vcu * NWAVES + F.wave, NGW = F.G * NWAVES, lane = lane_;
    for (int row = gw; row < T; row += NGW) {
        const bf16_t* p = PROJ + (size_t)row * INCP;
        u32x4 a = (u32x4){0u, 0u, 0u, 0u}, b = (u32x4){0u, 0u, 0u, 0u};
        if (lane < 48) a = *(const u32x4*)(p + C_CQ + lane * 8);
        if (lane < 32) b = *(const u32x4*)(p + C_CKV + lane * 8);
        float sq = 0.f, sk = 0.f;
#pragma unroll
        for (int i = 0; i < 4; ++i) { const float x = bflo(a[i]), y = bfhi(a[i]), z = bflo(b[i]), w = bfhi(b[i]); sq += x * x + y * y; sk += z * z + w * w; }
        sq = wave_sum(sq); sk = wave_sum(sk);
        const float rq = rsqrtf(sq * (1.f / QL) + RMS_EPS), rk = rsqrtf(sk * (1.f / KVL) + RMS_EPS);
        if (lane < 48) { const f32x4 g0 = *(const f32x4*)(qn + lane * 8), g1 = *(const f32x4*)(qn + lane * 8 + 4); u32x4 o;
            o.x = pk2(bflo(a.x) * rq * g0[0], bfhi(a.x) * rq * g0[1]); o.y = pk2(bflo(a.y) * rq * g0[2], bfhi(a.y) * rq * g0[3]);
            o.z = pk2(bflo(a.z) * rq * g1[0], bfhi(a.z) * rq * g1[1]); o.w = pk2(bflo(a.w) * rq * g1[2], bfhi(a.w) * rq * g1[3]);
            *(u32x4*)(CQN + (size_t)row * QL + lane * 8) = o; }
        if (lane < 32) { const f32x4 g0 = *(const f32x4*)(kvn + lane * 8), g1 = *(const f32x4*)(kvn + lane * 8 + 4); u32x4 o;
            o.x = pk2(bflo(b.x) * rk * g0[0], bfhi(b.x) * rk * g0[1]); o.y = pk2(bflo(b.y) * rk * g0[2], bfhi(b.y) * rk * g0[3]);
            o.z = pk2(bflo(b.z) * rk * g1[0], bfhi(b.z) * rk * g1[1]); o.w = pk2(bflo(b.w) * rk * g1[2], bfhi(b.w) * rk * g1[3]);
            *(u32x4*)(CKVN + (size_t)row * KVL + lane * 8) = o; }
        if (lane < 16) { const float x1 = bf2f(p[C_KR + lane]), x2 = bf2f(p[C_KR + 16 + lane]); const f32x2 cs = CS[(size_t)(row % SEQ) * 16 + lane];
            const unsigned w = pk2(x1 * cs[0] - x2 * cs[1], x2 * cs[0] + x1 * cs[1]);
#pragma unroll
            for (int h = 0; h < 8; ++h) *(unsigned*)(KB + (size_t)row * 768 + h * 96 + 64 + 2 * lane) = w; }
    }
    for (int it = gw; it < NB * NBLK * HA; it += NGW) {
        const int h = it % HA, blk = (it / HA) % NBLK, b = it / (HA * NBLK), c = lane & 7, r0 = lane >> 3;
        const bf16_t* p = PROJ + ((size_t)b * SEQ + (size_t)blk * BLK + r0) * INCP + C_KA + h * 64 + c * 8;
        float s[8];
#pragma unroll
        for (int i = 0; i < 8; ++i) s[i] = 0.f;
        for (int i = 0; i < 32; ++i) { const u32x4 v = *(const u32x4*)(p + (size_t)i * 8 * INCP);
#pragma unroll
            for (int k = 0; k < 4; ++k) { s[2 * k] += bflo(v[k]); s[2 * k + 1] += bfhi(v[k]); } }
#pragma unroll
        for (int i = 0; i < 8; ++i) { s[i] += __shfl_xor(s[i], 8); s[i] += __shfl_xor(s[i], 16); s[i] += __shfl_xor(s[i], 32); }
        if (lane < 8) { float* o = KM + ((size_t)(b * HA + h) * NBLK + blk) * 64 + c * 8;
            *(f32x4*)o = (f32x4){s[0], s[1], s[2], s[3]} * (1.f / BLK); *(f32x4*)(o + 4) = (f32x4){s[4], s[5], s[6], s[7]} * (1.f / BLK); }
    }
}
__device__ __forceinline__ void mobasel_phase(const Frame& F, const bf16_t* PROJ, const float* KM, unsigned* SEL) {
    int tid_ = F.tid; asm volatile("" : "+v"(tid_));
    const int TPW = T / F.G, row0 = (int)blockIdx.x * TPW, b = row0 / SEQ, own = (row0 % SEQ) / BLK, hs = own * 64 + 4;
    LAS float* km = (LAS float*)F.lds;
    for (int i = tid_; i < 8 * own * 16; i += NTHR) { const int h = i / (own * 16), r = i % (own * 16);
        *(LAS f32x4*)(km + h * hs + r * 4) = *(const f32x4*)(KM + ((size_t)(b * HA + h) * NBLK) * 64 + r * 4); }
    __syncthreads();
    for (int idx = tid_; idx < TPW * 8; idx += NTHR) {
        const int h = idx & 7, row = row0 + (idx >> 3);
        const bf16_t* qp = PROJ + (size_t)row * INCP + C_QA + h * 64;
        float q[64];
#pragma unroll
        for (int i = 0; i < 8; ++i) { const u32x4 v = *(const u32x4*)(qp + i * 8);
#pragma unroll
            for (int k = 0; k < 4; ++k) { q[i * 8 + 2 * k] = bflo(v[k]); q[i * 8 + 2 * k + 1] = bfhi(v[k]); } }
        float v1 = -INFINITY, v2 = -INFINITY, v3 = -INFINITY; int i1 = -1, i2 = -1, i3 = -1;
        for (int j = 0; j < own; ++j) {
            const LAS f32x4* kp = (const LAS f32x4*)(km + h * hs + j * 64);
            float g0 = 0.f, g1 = 0.f, g2 = 0.f, g3 = 0.f;
#pragma unroll
            for (int c = 0; c < 16; ++c) { const f32x4 k4 = kp[c]; g0 = fmaf(q[4 * c], k4[0], g0); g1 = fmaf(q[4 * c + 1], k4[1], g1); g2 = fmaf(q[4 * c + 2], k4[2], g2); g3 = fmaf(q[4 * c + 3], k4[3], g3); }
            const float g = (g0 + g1) + (g2 + g3);
            if (g > v1) { v3 = v2; i3 = i2; v2 = v1; i2 = i1; v1 = g; i1 = j; }
            else if (g > v2) { v3 = v2; i3 = i2; v2 = g; i2 = j; }
            else if (g > v3) { v3 = g; i3 = j; }
        }
        unsigned m = 0;
        if (i1 >= 0) m |= 1u << i1;
        if (i2 >= 0) m |= 1u << i2;
        if (i3 >= 0) m |= 1u << i3;
        SEL[(size_t)row * 8 + h] = m;
    }
    __syncthreads();
}

template <bool SECOND>
struct EpiGate {
    const bf16_t* PROJ; bf16_t* TMP; bf16_t* MRG;
    __device__ __forceinline__ void operator()(const f32x4 (&acc)[2][2][4][2], const pg8::Unit& u, int wr, int wc, int fr, int fq) const {
        PG8_TILE_BEGIN(acc, wr, wc, fr, fq)
            const int row = u.pm * 256 + trow, col = u.pn * 256 + tcol;
            const u32x4 g = *(const u32x4*)(PROJ + (size_t)row * INCP + (SECOND ? C_GB : C_GA) + col);
            v0[0] *= bflo(g.x); v0[1] *= bfhi(g.x); v0[2] *= bflo(g.y); v0[3] *= bfhi(g.y); v1[0] *= bflo(g.z); v1[1] *= bfhi(g.z); v1[2] *= bflo(g.w); v1[3] *= bfhi(g.w);
            if (SECOND) { const u32x4 t = *(const u32x4*)(TMP + (size_t)row * DM + col);
                v0[0] += bflo(t.x); v0[1] += bfhi(t.x); v0[2] += bflo(t.y); v0[3] += bfhi(t.y); v1[0] += bflo(t.z); v1[1] += bfhi(t.z); v1[2] += bflo(t.w); v1[3] += bfhi(t.w);
                *(u32x4*)(MRG + (size_t)row * DM + col) = pg8::pack8(v0, v1); }
            else *(u32x4*)(TMP + (size_t)row * DM + col) = pg8::pack8(v0, v1);
        PG8_TILE_END
    }
};
struct EpiResid {
    const bf16_t* X; bf16_t* PRE;
    __device__ __forceinline__ void operator()(const f32x4 (&acc)[2][2][4][2], const pg8::Unit& u, int wr, int wc, int fr, int fq) const {
        PG8_TILE_BEGIN(acc, wr, wc, fr, fq)
            const size_t o = (size_t)(u.pm * 256 + trow) * DM + u.pn * 256 + tcol;
            const u32x4 x = *(const u32x4*)(X + o);
            v0[0] += ALPHA * bflo(x.x); v0[1] += ALPHA * bfhi(x.x); v0[2] += ALPHA * bflo(x.y); v0[3] += ALPHA * bfhi(x.y);
            v1[0] += ALPHA * bflo(x.z); v1[1] += ALPHA * bfhi(x.z); v1[2] += ALPHA * bflo(x.w); v1[3] += ALPHA * bfhi(x.w);
            *(u32x4*)(PRE + o) = pg8::pack8(v0, v1);
        PG8_TILE_END
    }
};
__device__ __forceinline__ void ln_phase(const Frame& F, const bf16_t* PRE, const float* g, const float* bt, bf16_t* XBo) {
    int lane_ = F.lane; asm volatile("" : "+v"(lane_));
    const int gw = F.vcu * NWAVES + F.wave, NGW = F.G * NWAVES, lane = lane_;
    for (int row = gw; row < T; row += NGW) {
        const u32x2* pr = (const u32x2*)(PRE + (size_t)row * DM) + lane;
        f32x4 v[4]; float s = 0.f;
#pragma unroll
        for (int j = 0; j < 4; ++j) { const u32x2 h = pr[64 * j]; v[j] = (f32x4){bflo(h.x), bfhi(h.x), bflo(h.y), bfhi(h.y)}; s += (v[j][0] + v[j][1]) + (v[j][2] + v[j][3]); }
        const float mean = wave_sum(s) * (1.f / DM); float s2 = 0.f;
#pragma unroll
        for (int j = 0; j < 4; ++j) { v[j] = v[j] - mean; s2 += (v[j][0] * v[j][0] + v[j][1] * v[j][1]) + (v[j][2] * v[j][2] + v[j][3] * v[j][3]); }
        const float rstd = rsqrtf(wave_sum(s2) * (1.f / DM) + LN_EPS);
#pragma unroll
        for (int j = 0; j < 4; ++j) { const f32x4 gg = ((const f32x4*)g)[lane + 64 * j], bb = ((const f32x4*)bt)[lane + 64 * j];
            const f32x4 y = v[j] * rstd * gg + bb;
            u32x2 w; w.x = pk2(y[0], y[1]); w.y = pk2(y[2], y[3]); ((u32x2*)(XBo + (size_t)row * DM))[lane + 64 * j] = w; }
    }
}

struct RowGU { int off; __device__ __forceinline__ int operator()(int n) const { return 256 * (n >> 7) + off + (n & 127); } };

struct EpiF32 {
    float* O; int ld;
    __device__ __forceinline__ void operator()(const f32x4 (&acc)[2][2][4][2], const pg8::Unit& u, int wr, int wc, int fr, int fq) const {
        PG8_TILE_BEGIN(acc, wr, wc, fr, fq)
            float* o = O + (size_t)(u.pm * 256 + trow) * ld + u.pn * 256 + tcol; *(f32x4*)o = v0; *(f32x4*)(o + 4) = v1;
        PG8_TILE_END
    }
};
struct EpiBf16 {
    bf16_t* O; int ld;
    __device__ __forceinline__ void operator()(const f32x4 (&acc)[2][2][4][2], const pg8::Unit& u, int wr, int wc, int fr, int fq) const {
        PG8_TILE_BEGIN(acc, wr, wc, fr, fq)
            *(u32x4*)(O + (size_t)(u.pm * 256 + trow) * ld + u.pn * 256 + tcol) = pg8::pack8(v0, v1);
        PG8_TILE_END
    }
};
__device__ __forceinline__ float silu_mul(float g, float u) { return g * __builtin_amdgcn_rcpf(1.f + __expf(-g)) * u; }
struct EpiSwiGLU {
    bf16_t* H; int ld;
    __device__ __forceinline__ void operator()(const f32x4 (&acc)[2][2][4][2], const pg8::Unit& u, int wr, int wc, int fr, int fq) const {
#pragma unroll
        for (int ai = 0; ai < 2; ++ai)
#pragma unroll
            for (int m = 0; m < 4; ++m) { const int row = u.r0 + ai * 128 + wr * 64 + m * 16 + fr;
                if (row < u.rend) { f32x4 h0, h1;
#pragma unroll
                    for (int i = 0; i < 4; ++i) { h0[i] = silu_mul(acc[ai][0][m][0][i], acc[ai][1][m][0][i]); h1[i] = silu_mul(acc[ai][0][m][1][i], acc[ai][1][m][1][i]); }
                    *(u32x4*)(H + (size_t)row * ld + 128 * u.pn + wc * 32 + 8 * fq) = pg8::pack8(h0, h1); } }
    }
};
struct EpiExpDown {
    bf16_t* Y; const int* ROWA;
    __device__ __forceinline__ void operator()(const f32x4 (&acc)[2][2][4][2], const pg8::Unit& u, int wr, int wc, int fr, int fq) const {
        u32x2 aw[2][4];
#pragma unroll
        for (int ai = 0; ai < 2; ++ai)
#pragma unroll
            for (int m = 0; m < 4; ++m) { const int row = min(u.r0 + ai * 128 + wr * 64 + m * 16 + fr, u.rend - 1); aw[ai][m] = *(const u32x2*)(ROWA + 2 * (size_t)row); }
#pragma unroll
        for (int ai = 0; ai < 2; ++ai)
#pragma unroll
            for (int m = 0; m < 4; ++m) { const int row = u.r0 + ai * 128 + wr * 64 + m * 16 + fr;
                if (row < u.rend) { const int a = (int)aw[ai][m].x; const float w = __uint_as_float(aw[ai][m].y);
#pragma unroll
                    for (int bj = 0; bj < 2; ++bj) *(u32x4*)(Y + (size_t)a * DM + 256 * u.pn + bj * 128 + wc * 32 + 8 * fq) = pg8::pack8(acc[ai][bj][m][0] * w, acc[ai][bj][m][1] * w); } }
    }
};
template <int NPN, bool GATHER>
struct ExpertOrder {
    const LAS int* off; const LAS int* toff; const int* rowa; int G, c; size_t strideE;
    __device__ __forceinline__ bool next(int i, pg8::Unit& u) const {
        const int L = i * G + c; if (L >= toff[256] * NPN) return false;
        const int tile = L / NPN; u.pn = L % NPN; int lo = 0, hi = 255;
        while (lo < hi) { const int mid = (lo + hi + 1) >> 1; if (toff[mid] <= tile) lo = mid; else hi = mid - 1; }
        u.e = lo; u.r0 = off[lo] + (tile - toff[lo]) * 256; u.rend = off[lo + 1]; u.pm = 0; return true;
    }
    __device__ __forceinline__ int a_row(const pg8::Unit& u, int r) const { const int rr = min(u.r0 + r, u.rend - 1); return GATHER ? (rowa[2 * rr] >> 3) : rr; }
    __device__ __forceinline__ const char* b_ptr(const pg8::Gemm& g, const pg8::Unit& u) const { return (const char*)g.Bt + (size_t)u.e * strideE + (size_t)u.pn * 256 * g.ldb * 2; }
};
__device__ __forceinline__ void expert_tables(const Frame& F, const unsigned* cnt, LAS int* off, LAS int* toff) {
    if (F.tid < 256) { off[F.tid] = (int)cnt[F.tid]; }
    __syncthreads();
    if (F.tid == 0) { int a = 0, b = 0; for (int i = 0; i < 256; ++i) { const int c = off[i]; off[i] = a; toff[i] = b; a += c; b += (c + 255) >> 8; } off[256] = a; toff[256] = b; }
    __syncthreads();
}
__device__ __forceinline__ void route_phase(const Frame& F, const float* LOGITS, const float* rbias, int* TOPE, float* TOPW, int* APOS, int* HIST, LAS int* lcnt) {
    int lane_ = F.lane; asm volatile("" : "+v"(lane_));
    const int lane = lane_, TPW = T / F.G, t0 = (int)blockIdx.x * TPW;
    if (F.tid < 256) lcnt[F.tid] = 0;
    __syncthreads();
    const f32x4 rb = *(const f32x4*)(rbias + lane * 4);
    for (int t = t0 + F.wave; t < t0 + TPW; t += NWAVES) {
        const f32x4 lg = *(const f32x4*)(LOGITS + (size_t)t * NE + lane * 4);
        const float s0 = 1.f / (1.f + expf(-lg[0])), s1 = 1.f / (1.f + expf(-lg[1])), s2 = 1.f / (1.f + expf(-lg[2])), s3 = 1.f / (1.f + expf(-lg[3]));
        float c0 = s0 + rb[0], c1 = s1 + rb[1], c2 = s2 + rb[2], c3 = s3 + rb[3];
        float a = fmaxf(c0, c1), bq = fminf(c0, c1);
        { const float hi2 = fmaxf(c2, c3), lo2 = fminf(c2, c3); const float na = fmaxf(a, hi2), nb = fmaxf(fminf(a, hi2), fmaxf(bq, lo2)); a = na; bq = nb; }
#pragma unroll
        for (int o = 1; o < 8; o <<= 1) { const float oa = __shfl_xor(a, o), ob = __shfl_xor(bq, o); const float na = fmaxf(a, oa), nb = fmaxf(fminf(a, oa), fmaxf(bq, ob)); a = na; bq = nb; }
        const float gs = a + bq; const int grp = lane >> 3;
        int rank = 0;
#pragma unroll
        for (int j = 0; j < 8; ++j) { const float og = __shfl(gs, j * 8); rank += (og > gs || (og == gs && j < grp)) ? 1 : 0; }
        if (rank >= 4) { c0 = c1 = c2 = c3 = -INFINITY; }
        float wsum = 0.f, myw = 0.f; int mye = 0;
#pragma unroll
        for (int k = 0; k < TOPK; ++k) {
            float bv = c0; int bi = 0;
            if (c1 > bv) { bv = c1; bi = 1; }
            if (c2 > bv) { bv = c2; bi = 2; }
            if (c3 > bv) { bv = c3; bi = 3; }
            int be = lane * 4 + bi;
#pragma unroll
            for (int o = 1; o < 64; o <<= 1) { const float ov = __shfl_xor(bv, o); const int oe = __shfl_xor(be, o); if (ov > bv || (ov == bv && oe < be)) { bv = ov; be = oe; } }
            float sc = 0.f;
            if ((be >> 2) == lane) { const int b2 = be & 3; sc = b2 == 0 ? s0 : b2 == 1 ? s1 : b2 == 2 ? s2 : s3; if (b2 == 0) c0 = -INFINITY; else if (b2 == 1) c1 = -INFINITY; else if (b2 == 2) c2 = -INFINITY; else c3 = -INFINITY; }
            sc = __shfl(sc, be >> 2);
            wsum += sc;
            if (lane == k) { myw = sc; mye = be; }
        }
        if (lane < TOPK) { const int aidx = t * TOPK + lane; TOPE[aidx] = mye; TOPW[aidx] = myw / wsum * 2.5f; APOS[aidx] = __hip_atomic_fetch_add(lcnt + mye, 1, __ATOMIC_RELAXED, __HIP_MEMORY_SCOPE_WORKGROUP); }
    }
    __syncthreads();
    if (F.tid < 256) HIST[(size_t)blockIdx.x * 256 + F.tid] = lcnt[F.tid];
}
__device__ __forceinline__ void combine_phase(const Frame& F, const bf16_t* X1, const bf16_t* SH, const bf16_t* Y, const float* g, const float* bt, float* Xo, bf16_t* XBo) {
    int lane_ = F.lane; asm volatile("" : "+v"(lane_));
    const int gw = F.vcu * NWAVES + F.wave, NGW = F.G * NWAVES, lane = lane_;
    for (int row = gw; row < T; row += NGW) {
        f32x4 v[4]; float s = 0.f;
#pragma unroll
        for (int j = 0; j < 4; ++j) { const u32x2 x = ((const u32x2*)(X1 + (size_t)row * DM))[lane + 64 * j]; v[j] = (f32x4){bflo(x.x), bfhi(x.x), bflo(x.y), bfhi(x.y)} * ALPHA;
            const u32x2 h = ((const u32x2*)(SH + (size_t)row * DM))[lane + 64 * j]; v[j][0] += bflo(h.x); v[j][1] += bfhi(h.x); v[j][2] += bflo(h.y); v[j][3] += bfhi(h.y); }
#pragma unroll
        for (int k = 0; k < TOPK; ++k) { const u32x2* yr = (const u32x2*)(Y + ((size_t)row * TOPK + k) * DM);
#pragma unroll
            for (int j = 0; j < 4; ++j) { const u32x2 h = yr[lane + 64 * j]; v[j][0] += bflo(h.x); v[j][1] += bfhi(h.x); v[j][2] += bflo(h.y); v[j][3] += bfhi(h.y); } }
#pragma unroll
        for (int j = 0; j < 4; ++j) s += (v[j][0] + v[j][1]) + (v[j][2] + v[j][3]);
        const float mean = wave_sum(s) * (1.f / DM); float s2 = 0.f;
#pragma unroll
        for (int j = 0; j < 4; ++j) { v[j] = v[j] - mean; s2 += (v[j][0] * v[j][0] + v[j][1] * v[j][1]) + (v[j][2] * v[j][2] + v[j][3] * v[j][3]); }
        const float rstd = rsqrtf(wave_sum(s2) * (1.f / DM) + LN_EPS);
#pragma unroll
        for (int j = 0; j < 4; ++j) { const f32x4 gg = ((const f32x4*)g)[lane + 64 * j], bb = ((const f32x4*)bt)[lane + 64 * j];
            const f32x4 y = v[j] * rstd * gg + bb;
            if (Xo) ((f32x4*)(Xo + (size_t)row * DM))[lane + 64 * j] = y;
            if (XBo) { u32x2 w; w.x = pk2(y[0], y[1]); w.y = pk2(y[2], y[3]); ((u32x2*)(XBo + (size_t)row * DM))[lane + 64 * j] = w; } }
    }
}

__device__ __forceinline__ int crow(int r, int hi) { return (r & 3) + 8 * (r >> 2) + 4 * hi; }
typedef short s16x4 __attribute__((ext_vector_type(4)));
__device__ __forceinline__ s16x4 vtr(const LAS unsigned char* p) { return __builtin_bit_cast(s16x4, __builtin_amdgcn_ds_read_tr16_b64_v4i16((LAS s16x4*)p)); }
__device__ __forceinline__ float xhalf_max(float v) { auto rr = __builtin_amdgcn_permlane32_swap(__float_as_uint(v), __float_as_uint(v), false, false); return fmaxf(__uint_as_float(rr[0]), __uint_as_float(rr[1])); }
__device__ __forceinline__ float xhalf_sum(float v) { auto rr = __builtin_amdgcn_permlane32_swap(__float_as_uint(v), __float_as_uint(v), false, false); return __uint_as_float(rr[0]) + __uint_as_float(rr[1]); }

template <int DQK, bool ALIBI>
__device__ __forceinline__ void attn_tile(const LAS unsigned char* kb, int kfo, int vfo, const bf16x8 (&qf)[DQK / 16], float& m, float& l, f32x16& o0, f32x16& o1, int hi, int tq, int kpos0, float slope2, bool causal) {
    f32x16 p0, p1;
#pragma unroll
    for (int r = 0; r < 16; ++r) { p0[r] = 0.f; p1[r] = 0.f; }
#pragma unroll
    for (int d0 = 0; d0 < DQK / 16; ++d0) {
        const bf16x8 a0 = *(const LAS bf16x8*)(kb + kfo + d0 * 2048), a1 = *(const LAS bf16x8*)(kb + kfo + d0 * 2048 + 512);
        p0 = __builtin_amdgcn_mfma_f32_32x32x16_bf16(a0, qf[d0], p0, 0, 0, 0);
        p1 = __builtin_amdgcn_mfma_f32_32x32x16_bf16(a1, qf[d0], p1, 0, 0, 0);
    }
    const int krel = kpos0 + 4 * hi - tq;
    if (ALIBI) { const float bb = slope2 * (float)krel;
#pragma unroll
        for (int r = 0; r < 16; ++r) { const float c = (float)((r & 3) + 8 * (r >> 2)); p0[r] += fmaf(slope2, c, bb); p1[r] += fmaf(slope2, c + 32.f, bb); } }
    if (causal) {
#pragma unroll
        for (int r = 0; r < 16; ++r) { const int kv = krel + (r & 3) + 8 * (r >> 2); if (kv > 0) p0[r] = -INFINITY; if (kv + 32 > 0) p1[r] = -INFINITY; } }
    float rm = fmaxf(p0[0], p1[0]);
#pragma unroll
    for (int r = 1; r < 16; ++r) rm = fmaxf(rm, fmaxf(p0[r], p1[r]));
    rm = xhalf_max(rm);
    const float mn = fmaxf(m, rm), alpha = __builtin_amdgcn_exp2f(m - mn);
    m = mn;
    float ls = 0.f;
#pragma unroll
    for (int r = 0; r < 16; ++r) { p0[r] = __builtin_amdgcn_exp2f(p0[r] - mn); p1[r] = __builtin_amdgcn_exp2f(p1[r] - mn); ls += p0[r] + p1[r]; }
    l = l * alpha + ls;
#pragma unroll
    for (int r = 0; r < 16; ++r) { o0[r] *= alpha; o1[r] *= alpha; }
    const u32x4 pw0 = (u32x4){pg8::cvt_pk_bf16(p0[0], p0[1]), pg8::cvt_pk_bf16(p0[2], p0[3]), pg8::cvt_pk_bf16(p0[4], p0[5]), pg8::cvt_pk_bf16(p0[6], p0[7])};
    const u32x4 pw1 = (u32x4){pg8::cvt_pk_bf16(p0[8], p0[9]), pg8::cvt_pk_bf16(p0[10], p0[11]), pg8::cvt_pk_bf16(p0[12], p0[13]), pg8::cvt_pk_bf16(p0[14], p0[15])};
    const u32x4 pw2 = (u32x4){pg8::cvt_pk_bf16(p1[0], p1[1]), pg8::cvt_pk_bf16(p1[2], p1[3]), pg8::cvt_pk_bf16(p1[4], p1[5]), pg8::cvt_pk_bf16(p1[6], p1[7])};
    const u32x4 pw3 = (u32x4){pg8::cvt_pk_bf16(p1[8], p1[9]), pg8::cvt_pk_bf16(p1[10], p1[11]), pg8::cvt_pk_bf16(p1[12], p1[13]), pg8::cvt_pk_bf16(p1[14], p1[15])};
    const LAS unsigned char* vb = kb + vfo;
#define ATT_VF(d0, ks) ({ const s16x4 lo_ = vtr(vb + (d0) * 4096 + (ks) * 1024), hi_ = vtr(vb + (d0) * 4096 + (ks) * 1024 + 512); (bf16x8){lo_[0], lo_[1], lo_[2], lo_[3], hi_[0], hi_[1], hi_[2], hi_[3]}; })
    o0 = __builtin_amdgcn_mfma_f32_32x32x16_bf16(ATT_VF(0, 0), __builtin_bit_cast(bf16x8, pw0), o0, 0, 0, 0);
    o1 = __builtin_amdgcn_mfma_f32_32x32x16_bf16(ATT_VF(1, 0), __builtin_bit_cast(bf16x8, pw0), o1, 0, 0, 0);
    o0 = __builtin_amdgcn_mfma_f32_32x32x16_bf16(ATT_VF(0, 1), __builtin_bit_cast(bf16x8, pw1), o0, 0, 0, 0);
    o1 = __builtin_amdgcn_mfma_f32_32x32x16_bf16(ATT_VF(1, 1), __builtin_bit_cast(bf16x8, pw1), o1, 0, 0, 0);
    o0 = __builtin_amdgcn_mfma_f32_32x32x16_bf16(ATT_VF(0, 2), __builtin_bit_cast(bf16x8, pw2), o0, 0, 0, 0);
    o1 = __builtin_amdgcn_mfma_f32_32x32x16_bf16(ATT_VF(1, 2), __builtin_bit_cast(bf16x8, pw2), o1, 0, 0, 0);
    o0 = __builtin_amdgcn_mfma_f32_32x32x16_bf16(ATT_VF(0, 3), __builtin_bit_cast(bf16x8, pw3), o0, 0, 0, 0);
    o1 = __builtin_amdgcn_mfma_f32_32x32x16_bf16(ATT_VF(1, 3), __builtin_bit_cast(bf16x8, pw3), o1, 0, 0, 0);
#undef ATT_VF
}
#define ATT_ISSUE(t, bo) do { \
        for (int c_ = wid; c_ < NCH; c_ += 8) __builtin_amdgcn_global_load_lds((const unsigned*)(ksrc + (size_t)(t) * 64 * ldk + c_ * 8), (LAS unsigned*)(lds + (bo) + c_ * 1024), 16, 0, 0); \
        __builtin_amdgcn_global_load_lds((const unsigned*)(vsrc + (size_t)(t) * 64 * ldv), (LAS unsigned*)(lds + (bo) + KBYTES + wid * 1024), 16, 0, 0); } while (0)

template <int DQK, bool MOBA_OWN>
__device__ __forceinline__ void attn_unit(LAS unsigned char* lds, int b, int h, int qb, const bf16_t* Qp, int ldq, const bf16_t* Kp, int ldk, const bf16_t* Vp, int ldv, bf16_t* Op, int ldo, const bf16_t* PO, const f32x2* PML) {
    constexpr int NCH = DQK / 8, KBYTES = NCH * 1024, BUFB = KBYTES + 8192, ND0 = DQK / 16;
    int tid_ = threadIdx.x; asm volatile("" : "+v"(tid_));
    const int lane = tid_ & 63, r32 = lane & 31, hi = lane >> 5, wid = __builtin_amdgcn_readfirstlane(tid_ >> 6);
    const size_t rowbase = (size_t)b * SEQ; const int q0 = qb * 256, T0 = MOBA_OWN ? 4 * qb : 0, T1 = 4 * (qb + 1), tq = q0 + wid * 32 + r32;
    const bf16_t* ksrc = Kp + (rowbase + lane) * ldk + h * DQK;
    const bf16_t* vsrc = Vp + (rowbase + 16 * (wid & 3) + (lane >> 2)) * ldv + h * 64 + (wid >> 2) * 32 + (lane & 3) * 8;
    ATT_ISSUE(T0, 0);
    bf16x8 qf[ND0];
    { const bf16_t* qrow = Qp + (rowbase + tq) * ldq + h * DQK + hi * 8;
#pragma unroll
      for (int d0 = 0; d0 < ND0; ++d0) qf[d0] = *(const bf16x8*)(qrow + d0 * 16); }
    const float slope2 = MOBA_OWN ? exp2f(-(float)(h + 1)) * LOG2E : 0.f;
    float m = -1e30f, l = 0.f;
    f32x16 o0, o1;
#pragma unroll
    for (int r = 0; r < 16; ++r) { o0[r] = 0.f; o1[r] = 0.f; }
    const int kfo = hi * 1024 + r32 * 16;
    const int vfo = KBYTES + ((lane >> 4) & 1) * 32 + (lane & 3) * 8 + (4 * hi + ((lane & 15) >> 2)) * 64;
#pragma unroll 1
    for (int t = T0; t < T1; ++t) {
        asm volatile("s_waitcnt vmcnt(0) lgkmcnt(0)\n\ts_barrier" ::: "memory");
        if (t + 1 < T1) ATT_ISSUE(t + 1, ((t + 1) & 1) * BUFB);
        attn_tile<DQK, MOBA_OWN>(lds + (t & 1) * BUFB, kfo, vfo, qf, m, l, o0, o1, hi, tq, 64 * t, slope2, t >= T1 - 4);
    }
    float lt = xhalf_sum(l);
    if (MOBA_OWN) {
        const int nsel = qb < 3 ? qb : 3;
        const size_t pidx = ((rowbase + tq) * 8 + h) * 3;
        float ms[3], ws[3], M = m;
#pragma unroll
        for (int sIdx = 0; sIdx < 3; ++sIdx) { ms[sIdx] = -1e30f; ws[sIdx] = 0.f; if (sIdx < nsel) { const f32x2 ml = PML[(pidx + sIdx) * 16]; ms[sIdx] = ml[0]; ws[sIdx] = ml[1]; M = fmaxf(M, ml[0]); } }
        const float w0 = __builtin_amdgcn_exp2f(m - M);
        lt *= w0;
#pragma unroll
        for (int r = 0; r < 16; ++r) { o0[r] *= w0; o1[r] *= w0; }
#pragma unroll
        for (int sIdx = 0; sIdx < 3; ++sIdx) if (sIdx < nsel) {
            const float w = ws[sIdx] * __builtin_amdgcn_exp2f(ms[sIdx] - M); lt += w;
            const bf16_t* po = PO + (pidx + sIdx) * 64 + 4 * hi;
#pragma unroll
            for (int r4 = 0; r4 < 4; ++r4) { const u32x2 a = *(const u32x2*)(po + 8 * r4), c = *(const u32x2*)(po + 32 + 8 * r4);
                o0[4 * r4] += w * bflo(a.x); o0[4 * r4 + 1] += w * bfhi(a.x); o0[4 * r4 + 2] += w * bflo(a.y); o0[4 * r4 + 3] += w * bfhi(a.y);
                o1[4 * r4] += w * bflo(c.x); o1[4 * r4 + 1] += w * bfhi(c.x); o1[4 * r4 + 2] += w * bflo(c.y); o1[4 * r4 + 3] += w * bfhi(c.y); } }
    }
    const float inv = 1.f / lt;
    bf16_t* orow = Op + (rowbase + tq) * ldo + h * 64 + 4 * hi;
#pragma unroll
    for (int r4 = 0; r4 < 4; ++r4) {
        u32x2 w0_, w1_;
        w0_.x = pg8::cvt_pk_bf16(o0[4 * r4] * inv, o0[4 * r4 + 1] * inv); w0_.y = pg8::cvt_pk_bf16(o0[4 * r4 + 2] * inv, o0[4 * r4 + 3] * inv);
        w1_.x = pg8::cvt_pk_bf16(o1[4 * r4] * inv, o1[4 * r4 + 1] * inv); w1_.y = pg8::cvt_pk_bf16(o1[4 * r4 + 2] * inv, o1[4 * r4 + 3] * inv);
        *(u32x2*)(orow + 8 * r4) = w0_; *(u32x2*)(orow + 32 + 8 * r4) = w1_;
    }
    asm volatile("s_waitcnt lgkmcnt(0)\n\ts_barrier" ::: "memory");
}
__device__ __forceinline__ void moba_sel_unit(LAS unsigned char* lds, int b, int h, int j, int slo, int shi, const bf16_t* Qp, const bf16_t* Kp, const bf16_t* Vp, int ldk, const unsigned* SEL, bf16_t* PO, f32x2* PML) {
    constexpr int DQK = 64, NCH = 8, KBYTES = 8192, BUFB = 16384, ldv = INCP; (void)ldv;
    int tid_ = threadIdx.x; asm volatile("" : "+v"(tid_));
    const int lane = tid_ & 63, r32 = lane & 31, hi = lane >> 5, wid = __builtin_amdgcn_readfirstlane(tid_ >> 6);
    const size_t rowbase = (size_t)b * SEQ;
    const bf16_t* ksrc = Kp + (rowbase + lane) * ldk + h * DQK;
    const bf16_t* vsrc = Vp + (rowbase + 16 * (wid & 3) + (lane >> 2)) * ldk + h * 64 + (wid >> 2) * 32 + (lane & 3) * 8;
#pragma unroll
    for (int tt = 0; tt < 4; ++tt) ATT_ISSUE(4 * j + tt, tt * BUFB);
    LAS unsigned short* list = (LAS unsigned short*)(lds + 4 * BUFB);
    LAS int* cnt = (LAS int*)(lds + 4 * BUFB + 4096);
    if (tid_ == 0) *cnt = 0;
    __syncthreads();
    const int nsrc = (shi - slo) * 256;
    for (int i = tid_; i < nsrc; i += NTHR) {
        const unsigned sm = SEL[(rowbase + (size_t)slo * 256 + i) * 8 + h];
        const bool f = ((sm >> j) & 1u) != 0u;
        const unsigned long long bal = __ballot(f);
        const int rank = __builtin_amdgcn_mbcnt_hi((unsigned)(bal >> 32), __builtin_amdgcn_mbcnt_lo((unsigned)bal, 0u));
        int base = 0;
        if (lane == 0) base = __hip_atomic_fetch_add(cnt, (int)__builtin_popcountll(bal), __ATOMIC_RELAXED, __HIP_MEMORY_SCOPE_WORKGROUP);
        base = __builtin_amdgcn_readfirstlane(base);
        if (f) list[base + rank] = (unsigned short)i;
    }
    asm volatile("s_waitcnt vmcnt(0)" ::: "memory");
    __syncthreads();
    const int n = *cnt, nch = (n + 31) >> 5;
    const float slope2 = exp2f(-(float)(h + 1)) * LOG2E;
    const int kfo = hi * 1024 + r32 * 16;
    const int vfo = KBYTES + ((lane >> 4) & 1) * 32 + (lane & 3) * 8 + (4 * hi + ((lane & 15) >> 2)) * 64;
    for (int ch = wid; ch < nch; ch += 8) {
        const int e = ch * 32 + r32; const bool valid = e < n;
        const int tq = slo * 256 + (int)list[valid ? e : n - 1];
        bf16x8 qf[4];
        { const bf16_t* qrow = Qp + (rowbase + tq) * INCP + h * DQK + hi * 8;
#pragma unroll
          for (int d0 = 0; d0 < 4; ++d0) qf[d0] = *(const bf16x8*)(qrow + d0 * 16); }
        const unsigned sm = SEL[(rowbase + tq) * 8 + h];
        float m = -1e30f, l = 0.f;
        f32x16 o0, o1;
#pragma unroll
        for (int r = 0; r < 16; ++r) { o0[r] = 0.f; o1[r] = 0.f; }
#pragma unroll 1
        for (int tt = 0; tt < 4; ++tt) attn_tile<64, true>(lds + tt * BUFB, kfo, vfo, qf, m, l, o0, o1, hi, tq, 256 * j + 64 * tt, slope2, false);
        const float lt = xhalf_sum(l), inv = 1.f / lt;
        if (valid) {
            const size_t pidx = ((rowbase + tq) * 8 + h) * 3 + __builtin_popcount(sm & ((1u << j) - 1u));
            if (hi == 0) PML[pidx * 16] = (f32x2){m, lt};
            bf16_t* po = PO + pidx * 64 + 4 * hi;
#pragma unroll
            for (int r4 = 0; r4 < 4; ++r4) {
                u32x2 w0_, w1_;
                w0_.x = pg8::cvt_pk_bf16(o0[4 * r4] * inv, o0[4 * r4 + 1] * inv); w0_.y = pg8::cvt_pk_bf16(o0[4 * r4 + 2] * inv, o0[4 * r4 + 3] * inv);
                w1_.x = pg8::cvt_pk_bf16(o1[4 * r4] * inv, o1[4 * r4 + 1] * inv); w1_.y = pg8::cvt_pk_bf16(o1[4 * r4 + 2] * inv, o1[4 * r4 + 3] * inv);
                *(u32x2*)(po + 8 * r4) = w0_; *(u32x2*)(po + 32 + 8 * r4) = w1_;
            }
        }
    }
    __syncthreads();
}
#undef ATT_ISSUE
__device__ __forceinline__ void mla_phase(const Frame& F, const bf16_t* QB, const bf16_t* KB, const bf16_t* VB, bf16_t* Op) {
    for (int u = 2 * F.vcu; u < 512; u += 2 * F.G) {
#pragma unroll 1
        for (int k = 0; k < 2; ++k) { const int uu = u + k, bh = uu >> 5, w = uu & 31, qb = (w & 1) ? (w >> 1) : 31 - (w >> 1);
            attn_unit<96, false>(F.lds, bh >> 3, bh & 7, qb, QB, 768, KB, 768, VB, 512, Op, 1024, nullptr, nullptr); }
    }
}
__device__ __forceinline__ void moba_sel_phase(const Frame& F, const bf16_t* PROJ, const unsigned* SEL, bf16_t* PO, f32x2* PML) {
#pragma unroll 1
    for (int u = (int)blockIdx.x; u < 16 * 136; u += F.G) {
        int p = 0; while (16 * (2 * (p + 1) * (p + 1) + (p + 1)) <= u) ++p;
        const int r = u - 16 * (2 * p * p + p), j = r >> 4, bh = r & 15;
        const int slo = (j + 1 > 4 * p) ? j + 1 : 4 * p, shi = 4 * p + 4;
        moba_sel_unit(F.lds, bh >> 3, bh & 7, j, slo, shi, PROJ + C_QA, PROJ + C_KA, PROJ + C_VA, INCP, SEL, PO, PML);
    }
}
__device__ __forceinline__ void moba_own_phase(const Frame& F, const bf16_t* PROJ, bf16_t* Op, const bf16_t* PO, const f32x2* PML) {
#pragma unroll 1
    for (int u = F.vcu; u < 512; u += F.G) { const int bh = u >> 5, qb = u & 31;
        attn_unit<64, true>(F.lds, bh >> 3, bh & 7, qb, PROJ + C_QA, INCP, PROJ + C_KA, INCP, PROJ + C_VA, INCP, Op, 1024, PO, PML); }
}

constexpr int NPH_L = 16;
__global__ void __launch_bounds__(NTHR, 2) mk(Params p) {
    extern __shared__ __attribute__((aligned(16))) unsigned char lds_raw[];
    Frame F;
    F.lds = (LAS unsigned char*)lds_raw;
    F.tid = threadIdx.x; F.lane = F.tid & 63; F.wave = __builtin_amdgcn_readfirstlane(F.tid >> 6);
    F.G = gridDim.x; { const int bx = blockIdx.x; F.vcu = (F.G % 8 == 0) ? (bx % 8) * (F.G / 8) + bx / 8 : bx; }
    volatile LAS unsigned* MISC = (volatile LAS unsigned*)(F.lds + MISC_OFF);
    if (F.tid < 32) MISC[F.tid] = 0u;
    __syncthreads();
    unsigned char* ws = p.ws;
    unsigned* ctl = (unsigned*)(ws + WS_CTL);
    XcdBarrier bar = xcd_barrier_post(ctl + CW_BAR, MISC + 8);
    const int lo = p.ph_lo, hi = p.ph_hi;
#define IN(k) (lo <= (k) && (k) < hi)
#define SEAM(k) do { if (IN(k) && IN((k) + 1)) xcd_barrier(bar); } while (0)
    bf16_t* WinT = (bf16_t*)(ws + WS_WIN);
    bf16_t* XB = (bf16_t*)(ws + WS_XB);
    bf16_t* PROJ = (bf16_t*)(ws + WS_PROJ);
    bf16_t* WuqT = (bf16_t*)(ws + WS_WUQ); bf16_t* WukvT = (bf16_t*)(ws + WS_WUKV);
    f32x2* CS = (f32x2*)(ws + WS_CS); float* KM = (float*)(ws + WS_KM); unsigned* SEL = (unsigned*)(ws + WS_SEL);
    bf16_t* CQN = (bf16_t*)(ws + WS_CQN); bf16_t* CKVN = (bf16_t*)(ws + WS_CKVN);
    bf16_t* WpaT = (bf16_t*)(ws + WS_WPA); bf16_t* WpbT = (bf16_t*)(ws + WS_WPB); bf16_t* WoutT = (bf16_t*)(ws + WS_WOUT);
    bf16_t* TMP = (bf16_t*)(ws + WS_TMP); bf16_t* MRG = (bf16_t*)(ws + WS_MRG); bf16_t* PRE = (bf16_t*)(ws + WS_PRE); bf16_t* X1B = (bf16_t*)(ws + WS_X1B);
    bf16_t* WrtT = (bf16_t*)(ws + WS_WRT); bf16_t* WsguT = (bf16_t*)(ws + WS_WSGU); bf16_t* WsdT = (bf16_t*)(ws + WS_WSD); bf16_t* WeguT = (bf16_t*)(ws + WS_WEGU); bf16_t* WedT = (bf16_t*)(ws + WS_WED);
    float* LOGITS = (float*)(ws + WS_LOG); bf16_t* HS = (bf16_t*)(ws + WS_HS); bf16_t* SH = (bf16_t*)(ws + WS_SH);
    int* TOPE = (int*)(ws + WS_TOPE); float* TOPW = (float*)(ws + WS_TOPW); int* APOS = (int*)(ws + WS_APOS); int* ROWA = (int*)(ws + WS_ROWA);
    bf16_t* PO = (bf16_t*)(ws + WS_PO); f32x2* PML = (f32x2*)(ws + WS_PML);
    bf16_t* HE = (bf16_t*)(ws + WS_HE); bf16_t* Yb = (bf16_t*)(ws + WS_Y); int* HIST = (int*)(ws + WS_HIST);
    LAS int* t_off = (LAS int*)(F.lds + TAB_OFF); LAS int* t_toff = t_off + 260;
    bf16_t* QB = (bf16_t*)(ws + WS_QB); bf16_t* KB = (bf16_t*)(ws + WS_KB); bf16_t* VB = (bf16_t*)(ws + WS_VB); bf16_t* OAB = (bf16_t*)(ws + WS_OAB);
    const int gw = F.vcu * NWAVES + F.wave, NGW = F.G * NWAVES;

    if (IN(0)) {
        LAS float* scr = (LAS float*)(F.lds + F.wave * 16384);
        constexpr int I_IN = (DM / 64) * (INC / 32);
        for (int it = gw; it < DEPTH * I_IN; it += NGW) { const int l = it / I_IN, r = it % I_IN;
            transpose_item(p.in[1] + (size_t)l * DM * INC, DM, INC, WinT + (size_t)l * SZ_WIN, DM, RowId{}, scr, r, F.lane); }
        { constexpr int I_UQ = (QL / 64) * (768 / 32), I_UKV = (KVL / 64) * (1024 / 32);
          for (int it = gw; it < DEPTH * (I_UQ + I_UKV); it += NGW) { const int l = it / (I_UQ + I_UKV), r = it % (I_UQ + I_UKV);
            if (r < I_UQ) transpose_item(p.in[4] + (size_t)l * QL * 768, QL, 768, WuqT + (size_t)l * SZ_WUQ, QL, RowQ{}, scr, r, F.lane);
            else transpose_item(p.in[6] + (size_t)l * KVL * 1024, KVL, 1024, WukvT + (size_t)l * SZ_WUKV, KVL, RowId{}, scr, r - I_UQ, F.lane); } }
        { constexpr int I_P = (512 / 64) * (DM / 32), I_O = (DM / 64) * (DM / 32), I_ALL = 2 * I_P + I_O;
          for (int it = gw; it < DEPTH * I_ALL; it += NGW) { const int l = it / I_ALL; int r = it % I_ALL;
            if (r < I_P) { transpose_item(p.in[7] + (size_t)l * 512 * DM, 512, DM, WpaT + (size_t)l * SZ_WP, 512, RowId{}, scr, r, F.lane); continue; } r -= I_P;
            if (r < I_P) { transpose_item(p.in[8] + (size_t)l * 512 * DM, 512, DM, WpbT + (size_t)l * SZ_WP, 512, RowId{}, scr, r, F.lane); continue; } r -= I_P;
            transpose_item(p.in[9] + (size_t)l * DM * DM, DM, DM, WoutT + (size_t)l * SZ_WOUT, DM, RowId{}, scr, r, F.lane); } }
        { constexpr int I_R = (DM / 64) * (NE / 32), I_G = (DM / 64) * (DSH / 32), I_D = (DSH / 64) * (DM / 32), I_ALL = I_R + 2 * I_G + I_D;
          for (int it = gw; it < DEPTH * I_ALL; it += NGW) { const int l = it / I_ALL; int r = it % I_ALL;
            if (r < I_R) { transpose_item(p.in[12] + (size_t)l * DM * NE, DM, NE, WrtT + (size_t)l * SZ_WRT, DM, RowId{}, scr, r, F.lane); continue; } r -= I_R;
            if (r < I_G) { transpose_item(p.in[17] + (size_t)l * DM * DSH, DM, DSH, WsguT + (size_t)l * SZ_WSGU, DM, RowGU{0}, scr, r, F.lane); continue; } r -= I_G;
            if (r < I_G) { transpose_item(p.in[18] + (size_t)l * DM * DSH, DM, DSH, WsguT + (size_t)l * SZ_WSGU, DM, RowGU{128}, scr, r, F.lane); continue; } r -= I_G;
            transpose_item(p.in[19] + (size_t)l * DSH * DM, DSH, DM, WsdT + (size_t)l * SZ_WSD, DSH, RowId{}, scr, r, F.lane); } }
        { constexpr int I_G = (DM / 64) * (DE / 64), I_D = (DE / 64) * (DM / 64), I_E = 2 * I_G + I_D;
          LAS unsigned short* scr16 = (LAS unsigned short*)(F.lds + F.wave * 16384);
          for (int it = gw; it < DEPTH * NE * I_E; it += NGW) { const int le = it / I_E; int r = it % I_E;
            if (r < I_G) { transpose_item64(p.in[14] + (size_t)le * DM * DE, DM, DE, WeguT + (size_t)le * 512 * DM, DM, RowGU{0}, scr16, r, F.lane); continue; } r -= I_G;
            if (r < I_G) { transpose_item64(p.in[15] + (size_t)le * DM * DE, DM, DE, WeguT + (size_t)le * 512 * DM, DM, RowGU{128}, scr16, r, F.lane); continue; } r -= I_G;
            transpose_item64(p.in[16] + (size_t)le * DE * DM, DE, DM, WedT + (size_t)le * DM * DE, DE, RowId{}, scr16, r, F.lane); } }
        for (int i = blockIdx.x * NTHR + F.tid; i < SEQ * 16; i += F.G * NTHR) { const int pos = i >> 4, k = i & 15;
            const float inv = powf(10000.f, -(float)(2 * k) / 32.f), ang = (float)pos * inv; CS[i] = (f32x2){cosf(ang), sinf(ang)}; }
        for (int i = blockIdx.x * NTHR + F.tid; i < DEPTH * 12288; i += F.G * NTHR) { const int l = i / 12288, r = i % 12288;
            *(u32x4*)(WinT + (size_t)l * SZ_WIN + (size_t)INC * DM + (size_t)r * 8) = (u32x4){0u, 0u, 0u, 0u}; }
        for (int i = blockIdx.x * NTHR + F.tid; i < T * DM / 8; i += F.G * NTHR) { const f32x4 a = *(const f32x4*)(p.in[0] + (size_t)i * 8), b = *(const f32x4*)(p.in[0] + (size_t)i * 8 + 4);
            u32x4 w; w.x = pk2(a[0], a[1]); w.y = pk2(a[2], a[3]); w.z = pk2(b[0], b[1]); w.w = pk2(b[2], b[3]); *(u32x4*)(XB + (size_t)i * 8) = w; }
    }
    SEAM(0);

    {
        const int l = 0; const int pb = 1 + l * NPH_L;
        if (IN(pb + 0)) {
            pg8::Gemm g{XB, WinT + (size_t)l * SZ_WIN, T, INCP, DM, DM, DM}; pg8::StaticOrder S; S.init(T, INCP, F.G, (int)blockIdx.x);
            EpiProj E{PROJ, p.in[2] + (size_t)l * 2 * DM};
            pg8::gemm_phase<EpiProj, pg8::StaticOrder, true>(F.lds, g, S, E);
        }
        SEAM(pb + 0);
        if (IN(pb + 1)) prep_phase(F, PROJ, p.in[3] + (size_t)l * QL, p.in[5] + (size_t)l * KVL, CS, CQN, CKVN, KB, KM);
        SEAM(pb + 1);
        if (IN(pb + 2)) {
            mobasel_phase(F, PROJ, KM, SEL);
            { pg8::Gemm g{CKVN, WukvT + (size_t)l * SZ_WUKV, T, 1024, KVL, KVL, KVL}; pg8::StaticOrder S; S.init(T, 1024, F.G, (int)blockIdx.x);
              EpiKV E{KB, VB}; pg8::gemm_phase<EpiKV, pg8::StaticOrder, true>(F.lds, g, S, E); }
            { pg8::Gemm g{CQN, WuqT + (size_t)l * SZ_WUQ, T, 768, QL, QL, QL}; pg8::StaticOrder S; S.init(T, 768, F.G, (int)blockIdx.x);
              EpiQ E{QB, CS}; pg8::gemm_phase<EpiQ, pg8::StaticOrder, true>(F.lds, g, S, E); }
        }
        SEAM(pb + 2);
        if (IN(pb + 3)) {
            mla_phase(F, QB, KB, VB, OAB + 512);
            moba_sel_phase(F, PROJ, SEL, PO, PML);
        }
        SEAM(pb + 3);
        if (IN(pb + 4)) moba_own_phase(F, PROJ, OAB, PO, PML);
        SEAM(pb + 4);
        if (IN(pb + 5)) {
            { pg8::Gemm g{OAB, WpaT + (size_t)l * SZ_WP, T, DM, 512, 1024, 512}; pg8::StaticOrder S; S.init(T, DM, F.G, (int)blockIdx.x);
              EpiGate<false> E{PROJ, TMP, MRG}; pg8::gemm_phase<EpiGate<false>, pg8::StaticOrder, true>(F.lds, g, S, E); }
            { pg8::Gemm g{OAB + 512, WpbT + (size_t)l * SZ_WP, T, DM, 512, 1024, 512}; pg8::StaticOrder S; S.init(T, DM, F.G, (int)blockIdx.x);
              EpiGate<true> E{PROJ, TMP, MRG}; pg8::gemm_phase<EpiGate<true>, pg8::StaticOrder, true>(F.lds, g, S, E); }
        }
        SEAM(pb + 5);
        if (IN(pb + 6)) {
            pg8::Gemm g{MRG, WoutT + (size_t)l * SZ_WOUT, T, DM, DM, DM, DM}; pg8::StaticOrder S; S.init(T, DM, F.G, (int)blockIdx.x);
            EpiResid E{XB, PRE}; pg8::gemm_phase<EpiResid, pg8::StaticOrder, true>(F.lds, g, S, E);
        }
        SEAM(pb + 6);
        if (IN(pb + 7)) ln_phase(F, PRE, p.in[10] + (size_t)l * DM, p.in[11] + (size_t)l * DM, X1B);
        SEAM(pb + 7);
        if (IN(pb + 8)) {
            { pg8::Gemm g{X1B, WrtT + (size_t)l * SZ_WRT, T, NE, DM, DM, DM}; pg8::StaticOrder S; S.init(T, NE, F.G, (int)blockIdx.x);
              EpiF32 E{LOGITS, NE}; pg8::gemm_phase<EpiF32, pg8::StaticOrder, true>(F.lds, g, S, E); }
            { pg8::Gemm g{X1B, WsguT + (size_t)l * SZ_WSGU, T, 512, DM, DM, DM}; pg8::StaticOrder S; S.init(T, 512, F.G, (int)((blockIdx.x + F.G / 2) % F.G));
              EpiSwiGLU E{HS, DSH}; pg8::gemm_phase<EpiSwiGLU, pg8::StaticOrder, true>(F.lds, g, S, E); }
        }
        SEAM(pb + 8);
        if (IN(pb + 9)) {
            route_phase(F, LOGITS, p.in[13] + (size_t)l * NE, TOPE, TOPW, APOS, HIST, t_off);
            pg8::Gemm g{HS, WsdT + (size_t)l * SZ_WSD, T, DM, DSH, DSH, DSH}; pg8::StaticOrder S; S.init(T, DM, F.G, (int)blockIdx.x);
            EpiBf16 E{SH, DM}; pg8::gemm_phase<EpiBf16, pg8::StaticOrder, true>(F.lds, g, S, E);
        }
        SEAM(pb + 9);
        if (IN(pb + 10)) {
            int tid_ = F.tid; asm volatile("" : "+v"(tid_));
            if (tid_ < 256) { int tot = 0, base = 0; for (int c = 0; c < F.G; ++c) { const int v = HIST[(size_t)c * 256 + tid_]; base += (c < (int)blockIdx.x) ? v : 0; tot += v; }
                t_off[tid_] = tot; t_toff[tid_] = base; if (blockIdx.x == 0) ctl[CW_CNT + l * 256 + tid_] = (unsigned)tot; }
            __syncthreads();
            if (tid_ == 0) { int a = 0; for (int i = 0; i < 256; ++i) { const int c = t_off[i]; t_off[i] = a; a += c; } }
            __syncthreads();
            const int TPW = T / F.G, a0 = (int)blockIdx.x * TPW * TOPK;
            for (int a = a0 + tid_; a < a0 + TPW * TOPK; a += NTHR) { const int e = TOPE[a]; *(u32x2*)(ROWA + 2 * (size_t)(t_off[e] + t_toff[e] + APOS[a])) = (u32x2){(unsigned)a, __float_as_uint(TOPW[a])}; }
            __syncthreads();
        }
        SEAM(pb + 10);
        if (IN(pb + 11)) {
            expert_tables(F, ctl + CW_CNT + l * 256, t_off, t_toff);
            pg8::Gemm g{X1B, WeguT + (size_t)l * SZ_WEGU, T, 512, DM, DM, DM};
            ExpertOrder<2, true> S{t_off, t_toff, ROWA, F.G, (int)blockIdx.x, (size_t)512 * DM * 2};
            EpiSwiGLU E{HE, DE}; pg8::gemm_phase<EpiSwiGLU, ExpertOrder<2, true>, true>(F.lds, g, S, E);
        }
        SEAM(pb + 11);
        if (IN(pb + 12)) {
            expert_tables(F, ctl + CW_CNT + l * 256, t_off, t_toff);
            pg8::Gemm g{HE, WedT + (size_t)l * SZ_WED, NA, DM, DE, DE, DE};
            ExpertOrder<4, false> S{t_off, t_toff, ROWA, F.G, (int)blockIdx.x, (size_t)DM * DE * 2};
            EpiExpDown E{Yb, ROWA}; pg8::gemm_phase<EpiExpDown, ExpertOrder<4, false>, true>(F.lds, g, S, E);
        }
        SEAM(pb + 12);
        if (IN(pb + 13)) combine_phase(F, X1B, SH, Yb, p.in[20] + (size_t)l * DM, p.in[21] + (size_t)l * DM, l == DEPTH - 1 ? p.out : (float*)nullptr, l == DEPTH - 1 ? (bf16_t*)nullptr : XB);
        SEAM(pb + 13);
    }

    {
        const int l = 1; const int pb = 1 + l * NPH_L;
        if (IN(pb + 0)) {
            pg8::Gemm g{XB, WinT + (size_t)l * SZ_WIN, T, INCP, DM, DM, DM}; pg8::StaticOrder S; S.init(T, INCP, F.G, (int)blockIdx.x);
            EpiProj E{PROJ, p.in[2] + (size_t)l * 2 * DM};
            pg8::gemm_phase<EpiProj, pg8::StaticOrder, true>(F.lds, g, S, E);
        }
        SEAM(pb + 0);
        if (IN(pb + 1)) prep_phase(F, PROJ, p.in[3] + (size_t)l * QL, p.in[5] + (size_t)l * KVL, CS, CQN, CKVN, KB, KM);
        SEAM(pb + 1);
        if (IN(pb + 2)) {
            mobasel_phase(F, PROJ, KM, SEL);
            { pg8::Gemm g{CKVN, WukvT + (size_t)l * SZ_WUKV, T, 1024, KVL, KVL, KVL}; pg8::StaticOrder S; S.init(T, 1024, F.G, (int)blockIdx.x);
              EpiKV E{KB, VB}; pg8::gemm_phase<EpiKV, pg8::StaticOrder, true>(F.lds, g, S, E); }
            { pg8::Gemm g{CQN, WuqT + (size_t)l * SZ_WUQ, T, 768, QL, QL, QL}; pg8::StaticOrder S; S.init(T, 768, F.G, (int)blockIdx.x);
              EpiQ E{QB, CS}; pg8::gemm_phase<EpiQ, pg8::StaticOrder, true>(F.lds, g, S, E); }
        }
        SEAM(pb + 2);
        if (IN(pb + 3)) {
            mla_phase(F, QB, KB, VB, OAB + 512);
            moba_sel_phase(F, PROJ, SEL, PO, PML);
        }
        SEAM(pb + 3);
        if (IN(pb + 4)) moba_own_phase(F, PROJ, OAB, PO, PML);
        SEAM(pb + 4);
        if (IN(pb + 5)) {
            { pg8::Gemm g{OAB, WpaT + (size_t)l * SZ_WP, T, DM, 512, 1024, 512}; pg8::StaticOrder S; S.init(T, DM, F.G, (int)blockIdx.x);
              EpiGate<false> E{PROJ, TMP, MRG}; pg8::gemm_phase<EpiGate<false>, pg8::StaticOrder, true>(F.lds, g, S, E); }
            { pg8::Gemm g{OAB + 512, WpbT + (size_t)l * SZ_WP, T, DM, 512, 1024, 512}; pg8::StaticOrder S; S.init(T, DM, F.G, (int)blockIdx.x);
              EpiGate<true> E{PROJ, TMP, MRG}; pg8::gemm_phase<EpiGate<true>, pg8::StaticOrder, true>(F.lds, g, S, E); }
        }
        SEAM(pb + 5);
        if (IN(pb + 6)) {
            pg8::Gemm g{MRG, WoutT + (size_t)l * SZ_WOUT, T, DM, DM, DM, DM}; pg8::StaticOrder S; S.init(T, DM, F.G, (int)blockIdx.x);
            EpiResid E{XB, PRE}; pg8::gemm_phase<EpiResid, pg8::StaticOrder, true>(F.lds, g, S, E);
        }
        SEAM(pb + 6);
        if (IN(pb + 7)) ln_phase(F, PRE, p.in[10] + (size_t)l * DM, p.in[11] + (size_t)l * DM, X1B);
        SEAM(pb + 7);
        if (IN(pb + 8)) {
            { pg8::Gemm g{X1B, WrtT + (size_t)l * SZ_WRT, T, NE, DM, DM, DM}; pg8::StaticOrder S; S.init(T, NE, F.G, (int)blockIdx.x);
              EpiF32 E{LOGITS, NE}; pg8::gemm_phase<EpiF32, pg8::StaticOrder, true>(F.lds, g, S, E); }
            { pg8::Gemm g{X1B, WsguT + (size_t)l * SZ_WSGU, T, 512, DM, DM, DM}; pg8::StaticOrder S; S.init(T, 512, F.G, (int)((blockIdx.x + F.G / 2) % F.G));
              EpiSwiGLU E{HS, DSH}; pg8::gemm_phase<EpiSwiGLU, pg8::StaticOrder, true>(F.lds, g, S, E); }
        }
        SEAM(pb + 8);
        if (IN(pb + 9)) {
            route_phase(F, LOGITS, p.in[13] + (size_t)l * NE, TOPE, TOPW, APOS, HIST, t_off);
            pg8::Gemm g{HS, WsdT + (size_t)l * SZ_WSD, T, DM, DSH, DSH, DSH}; pg8::StaticOrder S; S.init(T, DM, F.G, (int)blockIdx.x);
            EpiBf16 E{SH, DM}; pg8::gemm_phase<EpiBf16, pg8::StaticOrder, true>(F.lds, g, S, E);
        }
        SEAM(pb + 9);
        if (IN(pb + 10)) {
            int tid_ = F.tid; asm volatile("" : "+v"(tid_));
            if (tid_ < 256) { int tot = 0, base = 0; for (int c = 0; c < F.G; ++c) { const int v = HIST[(size_t)c * 256 + tid_]; base += (c < (int)blockIdx.x) ? v : 0; tot += v; }
                t_off[tid_] = tot; t_toff[tid_] = base; if (blockIdx.x == 0) ctl[CW_CNT + l * 256 + tid_] = (unsigned)tot; }
            __syncthreads();
            if (tid_ == 0) { int a = 0; for (int i = 0; i < 256; ++i) { const int c = t_off[i]; t_off[i] = a; a += c; } }
            __syncthreads();
            const int TPW = T / F.G, a0 = (int)blockIdx.x * TPW * TOPK;
            for (int a = a0 + tid_; a < a0 + TPW * TOPK; a += NTHR) { const int e = TOPE[a]; *(u32x2*)(ROWA + 2 * (size_t)(t_off[e] + t_toff[e] + APOS[a])) = (u32x2){(unsigned)a, __float_as_uint(TOPW[a])}; }
            __syncthreads();
        }
        SEAM(pb + 10);
        if (IN(pb + 11)) {
            expert_tables(F, ctl + CW_CNT + l * 256, t_off, t_toff);
            pg8::Gemm g{X1B, WeguT + (size_t)l * SZ_WEGU, T, 512, DM, DM, DM};
            ExpertOrder<2, true> S{t_off, t_toff, ROWA, F.G, (int)blockIdx.x, (size_t)512 * DM * 2};
            EpiSwiGLU E{HE, DE}; pg8::gemm_phase<EpiSwiGLU, ExpertOrder<2, true>, true>(F.lds, g, S, E);
        }
        SEAM(pb + 11);
        if (IN(pb + 12)) {
            expert_tables(F, ctl + CW_CNT + l * 256, t_off, t_toff);
            pg8::Gemm g{HE, WedT + (size_t)l * SZ_WED, NA, DM, DE, DE, DE};
            ExpertOrder<4, false> S{t_off, t_toff, ROWA, F.G, (int)blockIdx.x, (size_t)DM * DE * 2};
            EpiExpDown E{Yb, ROWA}; pg8::gemm_phase<EpiExpDown, ExpertOrder<4, false>, true>(F.lds, g, S, E);
        }
        SEAM(pb + 12);
        if (IN(pb + 13)) combine_phase(F, X1B, SH, Yb, p.in[20] + (size_t)l * DM, p.in[21] + (size_t)l * DM, l == DEPTH - 1 ? p.out : (float*)nullptr, l == DEPTH - 1 ? (bf16_t*)nullptr : XB);
        SEAM(pb + 13);
    }

#undef IN
#undef SEAM
}

__global__ void __launch_bounds__(256) cvt_proj(const bf16_t* __restrict__ P, float* proj) {
    const size_t i = (size_t)blockIdx.x * 256 + threadIdx.x;
    const int row = (int)(i / INC), c = (int)(i % INC);
    float v = bf2f(P[(size_t)row * INCP + c]);
    if (c < C_KA) v *= (1.f / QS_A);
    proj[i] = v;
}
__global__ void __launch_bounds__(256) cvt_oab(const bf16_t* __restrict__ OAB, float* oa, float* ob) {
    const size_t i = (size_t)blockIdx.x * 256 + threadIdx.x; const size_t row = i >> 10; const int c = (int)(i & 1023);
    const float v = bf2f(OAB[i]);
    if (c < 512) oa[row * 512 + c] = v; else ob[row * 512 + c - 512] = v;
}
__global__ void __launch_bounds__(256) cvt_x(const float* __restrict__ x, bf16_t* XB) {
    const size_t i = (size_t)blockIdx.x * 256 + threadIdx.x;
    const f32x4 a = *(const f32x4*)(x + i * 8), b = *(const f32x4*)(x + i * 8 + 4);
    u32x4 w; w.x = pk2(a[0], a[1]); w.y = pk2(a[2], a[3]); w.z = pk2(b[0], b[1]); w.w = pk2(b[2], b[3]); *(u32x4*)(XB + i * 8) = w;
}
}
static int g_grid = 0;
static bool fast_setup() {
    if (g_grid) return g_grid > 0;
    int dev = 0, cus = 0, per_cu = 0;
    if (hipGetDevice(&dev) != hipSuccess || hipDeviceGetAttribute(&cus, hipDeviceAttributeMultiprocessorCount, dev) != hipSuccess) { g_grid = -1; return false; }
    if (hipFuncSetAttribute((const void*)fk::mk, hipFuncAttributeMaxDynamicSharedMemorySize, fk::LDS_BYTES) != hipSuccess) { fprintf(stderr, "hipFuncSetAttribute failed\n"); g_grid = -1; return false; }
    if (hipOccupancyMaxActiveBlocksPerMultiprocessor(&per_cu, (const void*)fk::mk, fk::NTHR, fk::LDS_BYTES) != hipSuccess || per_cu < 1) { fprintf(stderr, "occupancy query: %d\n", per_cu); }
    (void)hipGetLastError();
    g_grid = cus;
    if (cus > 1024 || T % cus != 0 || (T / cus) * 8 > 4096) { fprintf(stderr, "unsupported CU count %d\n", cus); g_grid = -1; return false; }
    return true;
}
static void launch_mk(fk::Params& p, int lo, int hi, hipStream_t stream) {
    p.ph_lo = lo; p.ph_hi = hi;
    hipLaunchKernelGGL(fk::mk, dim3(g_grid), dim3(fk::NTHR), fk::LDS_BYTES, stream, p);
}

extern "C" void kernel_launch(void* const* d_in, const int* in_sizes, int n_in, void* d_out, int out_size, void* d_ws, size_t ws_size, hipStream_t stream) {
    if (!fast_setup()) return;
    if (ws_size < fk::WS_NEED) { fprintf(stderr, "workspace too small: need %zu have %zu\n", (size_t)fk::WS_NEED, ws_size); return; }
    (void)hipMemsetAsync((char*)d_ws + fk::WS_CTL, 0, fk::CTL_BYTES, stream);
    fk::Params P{};
    for (int i = 0; i < 22; ++i) P.in[i] = (const float*)d_in[i];
    P.out = (float*)d_out; P.ws = (unsigned char*)d_ws;
#if MK_ONE_LAUNCH
    launch_mk(P, 0, 1 + DEPTH * fk::NPH_L, stream);
#else
    launch_mk(P, 0, 1, stream);
    for (int l = 0; l < DEPTH; ++l) for (int k = 0; k < 14; ++k) launch_mk(P, 1 + l * fk::NPH_L + k, 2 + l * fk::NPH_L + k, stream);
#endif
}
```

```cpp
#ifndef MK_ONE_LAUNCH
#define MK_ONE_LAUNCH 1
#endif
#include <hip/hip_runtime.h>
#include <cstdint>
#include <cstdio>

constexpr int NB = 2, SEQ = 8192, T = NB * SEQ, DM = 1024, DEPTH = 2;
constexpr int HA = 8, WA = 512, BLK = 256, NBLK = SEQ / BLK;
constexpr int HB = 8, DN = 64, DR = 32, DV = 64, QL = 384, KVL = 256;
constexpr int INC = 3 * WA + QL + KVL + DR + 2 * DM;
constexpr int C_QA = 0, C_KA = 512, C_VA = 1024, C_CQ = 1536, C_CKV = 1920, C_KR = 2176, C_GA = 2208, C_GB = 3232;
constexpr int NE = 256, TOPK = 8, DE = 256, DSH = 256;
constexpr int NA = T * TOPK;
constexpr float ALPHA = 1.4142135623730951f;
constexpr float LN_EPS = 1e-5f, RMS_EPS = 1e-6f;

namespace ora {
template <class EP>
__global__ void __launch_bounds__(256) sgemm(const float* __restrict__ A, const float* __restrict__ Bm, EP ep, int M, int N, int K, int lda, int ldb, int pad_) {
    __shared__ float As[16][68], Bs[16][68];
    const int tid = threadIdx.x, tx = tid & 15, ty = tid >> 4;
    const int m0 = blockIdx.y * 64, n0 = blockIdx.x * 64;
    float acc[4][4];
#pragma unroll
    for (int i = 0; i < 4; ++i)
#pragma unroll
        for (int j = 0; j < 4; ++j) acc[i][j] = 0.f;
    const int ar = tid >> 2, ak = (tid & 3) * 4;
    const int bk = tid >> 4, bn = (tid & 15) * 4;
    for (int k0 = 0; k0 < K; k0 += 16) {
        const float4 av = *(const float4*)(A + (size_t)(m0 + ar) * lda + k0 + ak);
        float4 bv = make_float4(0.f, 0.f, 0.f, 0.f);
        if (n0 + bn < N) bv = *(const float4*)(Bm + (size_t)(k0 + bk) * ldb + n0 + bn);
        __syncthreads();
        As[ak + 0][ar] = av.x; As[ak + 1][ar] = av.y; As[ak + 2][ar] = av.z; As[ak + 3][ar] = av.w;
        *(float4*)&Bs[bk][bn] = bv;
        __syncthreads();
#pragma unroll
        for (int kk = 0; kk < 16; ++kk) {
            const float4 a = *(const float4*)&As[kk][ty * 4];
            const float4 b = *(const float4*)&Bs[kk][tx * 4];
            const float aa[4] = {a.x, a.y, a.z, a.w}, bb[4] = {b.x, b.y, b.z, b.w};
#pragma unroll
            for (int i = 0; i < 4; ++i)
#pragma unroll
                for (int j = 0; j < 4; ++j) acc[i][j] = fmaf(aa[i], bb[j], acc[i][j]);
        }
    }
#pragma unroll
    for (int i = 0; i < 4; ++i)
#pragma unroll
        for (int j = 0; j < 4; ++j) { const int r = m0 + ty * 4 + i, c = n0 + tx * 4 + j; if (c < N) ep(r, c, acc[i][j]); }
}
struct EpStore { float* C; int ldc; int pad; __device__ void operator()(int r, int c, float v) const { C[(size_t)r * ldc + c] = v; } };
struct EpMerge { const float* proj; const float* bg; const float* pa; float* out; int pre; int pad;
    __device__ void operator()(int r, int c, float v) const {
        const float ga = proj[(size_t)r * INC + C_GA + c] + bg[c], gb = proj[(size_t)r * INC + C_GB + c] + bg[DM + c];
        const float sa = pre ? proj[(size_t)r * INC + C_GA + c] : 1.f / (1.f + expf(-ga)), sb = pre ? proj[(size_t)r * INC + C_GB + c] : 1.f / (1.f + expf(-gb));
        out[(size_t)r * DM + c] = sa * pa[(size_t)r * DM + c] + sb * v; } };
struct EpResid { const float* x; float* out; __device__ void operator()(int r, int c, float v) const { out[(size_t)r * DM + c] = ALPHA * x[(size_t)r * DM + c] + v; } };
struct EpSilu { const float* sg; float* out; __device__ void operator()(int r, int c, float v) const { const float g = sg[(size_t)r * DSH + c]; out[(size_t)r * DSH + c] = g / (1.f + expf(-g)) * v; } };

__global__ void __launch_bounds__(256) rowprep(const float* __restrict__ proj, const float* __restrict__ qn, const float* __restrict__ kvn, float* cqn, float* ckvn, float* krr) {
    const int wid = threadIdx.x >> 6, lane = threadIdx.x & 63, row = blockIdx.x * 4 + wid;
    const float* p = proj + (size_t)row * INC;
    float sq = 0.f, sk = 0.f;
    for (int c = lane; c < QL; c += 64) { const float v = p[C_CQ + c]; sq += v * v; }
    for (int c = lane; c < KVL; c += 64) { const float v = p[C_CKV + c]; sk += v * v; }
#pragma unroll
    for (int o = 32; o; o >>= 1) { sq += __shfl_xor(sq, o); sk += __shfl_xor(sk, o); }
    const float rq = rsqrtf(sq / QL + RMS_EPS), rk = rsqrtf(sk / KVL + RMS_EPS);
    for (int c = lane; c < QL; c += 64) cqn[(size_t)row * QL + c] = p[C_CQ + c] * rq * qn[c];
    for (int c = lane; c < KVL; c += 64) ckvn[(size_t)row * KVL + c] = p[C_CKV + c] * rk * kvn[c];
    if (lane < 16) {
        const int pos = row % SEQ;
        const float inv = powf(10000.f, -(float)(2 * lane) / 32.f), ang = (float)pos * inv, cs = cosf(ang), sn = sinf(ang);
        const float x1 = p[C_KR + lane], x2 = p[C_KR + 16 + lane];
        krr[(size_t)row * DR + lane] = x1 * cs - x2 * sn; krr[(size_t)row * DR + 16 + lane] = x2 * cs + x1 * sn;
    }
}
__global__ void __launch_bounds__(256) qrope(float* q) {
    const int idx = blockIdx.x * 256 + threadIdx.x;
    const int i = idx & 15, h = (idx >> 4) & 7, row = idx >> 7, pos = row % SEQ;
    const float inv = powf(10000.f, -(float)(2 * i) / 32.f), ang = (float)pos * inv, cs = cosf(ang), sn = sinf(ang);
    float* p = q + (size_t)row * 768 + h * 96 + 64;
    const float x1 = p[i], x2 = p[16 + i];
    p[i] = x1 * cs - x2 * sn; p[16 + i] = x2 * cs + x1 * sn;
}
__global__ void __launch_bounds__(64) kmean(const float* __restrict__ proj, float* km) {
    const int blk = blockIdx.x, h = blockIdx.y, b = blockIdx.z, c = threadIdx.x;
    float s = 0.f;
    for (int i = 0; i < BLK; ++i) s += proj[(size_t)(b * SEQ + blk * BLK + i) * INC + C_KA + h * 64 + c];
    km[((size_t)(b * HA + h) * NBLK + blk) * 64 + c] = s * (1.f / BLK);
}
__global__ void __launch_bounds__(256) mobasel(const float* __restrict__ proj, const float* __restrict__ km, unsigned* sel) {
    const int idx = blockIdx.x * 256 + threadIdx.x;
    const int h = idx & 7, row = idx >> 3, b = row / SEQ, pos = row % SEQ, own = pos / BLK;
    const float* qp = proj + (size_t)row * INC + C_QA + h * 64;
    float v1 = -INFINITY, v2 = -INFINITY, v3 = -INFINITY; int i1 = -1, i2 = -1, i3 = -1;
    for (int j = 0; j < own; ++j) {
        const float* kp = km + ((size_t)(b * HA + h) * NBLK + j) * 64;
        float g = 0.f;
        for (int c = 0; c < 64; ++c) g = fmaf(qp[c], kp[c], g);
        if (g > v1) { v3 = v2; i3 = i2; v2 = v1; i2 = i1; v1 = g; i1 = j; }
        else if (g > v2) { v3 = v2; i3 = i2; v2 = g; i2 = j; }
        else if (g > v3) { v3 = g; i3 = j; }
    }
    unsigned m = 0;
    if (i1 >= 0) m |= 1u << i1; if (i2 >= 0) m |= 1u << i2; if (i3 >= 0) m |= 1u << i3;
    sel[idx] = m;
}
__device__ __forceinline__ float ldbf(const void* p, size_t i) { return __builtin_bit_cast(float, (unsigned)((const unsigned short*)p)[i] << 16); }
template <bool MOBA, bool FAST>
__global__ void __launch_bounds__(256) attn(const float* __restrict__ Qb, const float* __restrict__ KVb, const float* __restrict__ KRb, const unsigned* __restrict__ sel, float* O) {
    constexpr int DQK = MOBA ? 64 : 96;
    __shared__ float Qs[64][DQK + 1], Ks[32][DQK + 1], Vs[32][65], Ps[64][33];
    const int qb = blockIdx.x, h = blockIdx.y, b = blockIdx.z, tid = threadIdx.x, qi = tid >> 2, sub = tid & 3;
    const size_t row0 = (size_t)b * SEQ + (size_t)qb * 64;
    for (int idx = tid; idx < 64 * DQK; idx += 256) { const int r = idx / DQK, c = idx % DQK;
        if (FAST) Qs[r][c] = MOBA ? ldbf(Qb, (row0 + r) * 4352 + C_QA + h * 64 + c) : ldbf(Qb, (row0 + r) * 768 + h * 96 + c);
        else Qs[r][c] = MOBA ? Qb[(row0 + r) * INC + C_QA + h * 64 + c] : Qb[(row0 + r) * 768 + h * 96 + c]; }
    const int tq = qb * 64 + qi, own = tq / BLK;
    const unsigned mask = MOBA ? sel[(row0 + qi) * 8 + h] : 0u;
    const float slope = exp2f(-(float)(h + 1)), scale = FAST ? 0.6931471805599453f : (MOBA ? 0.125f : 0.10206207261596577f);
    float m = -1e30f, l = 0.f, o[16];
#pragma unroll
    for (int d = 0; d < 16; ++d) o[d] = 0.f;
    const int nkt = (qb * 64 + 64) / 32;
    for (int kt = 0; kt < nkt; ++kt) {
        __syncthreads();
        for (int idx = tid; idx < 32 * DQK; idx += 256) { const int r = idx / DQK, c = idx % DQK; const size_t kr = (size_t)b * SEQ + kt * 32 + r;
            if (FAST) Ks[r][c] = MOBA ? ldbf(KVb, kr * 4352 + C_KA + h * 64 + c) : ldbf(KVb, kr * 768 + h * 96 + c);
            else Ks[r][c] = MOBA ? KVb[kr * INC + C_KA + h * 64 + c] : (c < 64 ? KVb[kr * 1024 + h * 128 + c] : KRb[kr * DR + c - 64]); }
        for (int idx = tid; idx < 32 * 64; idx += 256) { const int r = idx >> 6, c = idx & 63; const size_t kr = (size_t)b * SEQ + kt * 32 + r;
            if (FAST) Vs[r][c] = MOBA ? ldbf(KVb, kr * 4352 + C_VA + h * 64 + c) : ldbf(KRb, kr * 512 + h * 64 + c);
            else Vs[r][c] = MOBA ? KVb[kr * INC + C_VA + h * 64 + c] : KVb[kr * 1024 + h * 128 + 64 + c]; }
        __syncthreads();
        float s[8]; float rmax = -1e30f;
#pragma unroll
        for (int j = 0; j < 8; ++j) {
            const int kk = sub + 4 * j, kpos = kt * 32 + kk;
            float dot = 0.f;
            for (int c = 0; c < DQK; ++c) dot = fmaf(Qs[qi][c], Ks[kk][c], dot);
            float sc = dot * scale; bool ok;
            if (MOBA) { sc -= slope * (float)(tq - kpos); const int kb = kpos / BLK; ok = (kb == own) ? (kpos <= tq) : (((mask >> kb) & 1u) != 0u); }
            else ok = kpos <= tq;
            s[j] = ok ? sc : -1e30f; rmax = fmaxf(rmax, s[j]);
        }
        rmax = fmaxf(rmax, __shfl_xor(rmax, 1)); rmax = fmaxf(rmax, __shfl_xor(rmax, 2));
        const float mn = fmaxf(m, rmax), alpha = expf(m - mn);
        float psum = 0.f;
#pragma unroll
        for (int j = 0; j < 8; ++j) { const float p = (s[j] > -1e29f) ? expf(s[j] - mn) : 0.f; Ps[qi][sub + 4 * j] = p; psum += p; }
        psum += __shfl_xor(psum, 1); psum += __shfl_xor(psum, 2);
        l = l * alpha + psum; m = mn;
        __syncthreads();
#pragma unroll
        for (int d = 0; d < 16; ++d) o[d] *= alpha;
        for (int kk = 0; kk < 32; ++kk) { const float p = Ps[qi][kk];
#pragma unroll
            for (int d = 0; d < 16; ++d) o[d] = fmaf(p, Vs[kk][sub * 16 + d], o[d]); }
    }
    const float rl = 1.f / l;
#pragma unroll
    for (int d = 0; d < 16; ++d) O[(row0 + qi) * 512 + h * 64 + sub * 16 + d] = o[d] * rl;
}
template <bool COMB>
__global__ void __launch_bounds__(256) lnorm(const float* __restrict__ in, const float* __restrict__ x1, const float* __restrict__ shared_, const float* __restrict__ Y, const float* __restrict__ g, const float* __restrict__ bt, float* out) {
    __shared__ float red[8];
    const int row = blockIdx.x, tid = threadIdx.x;
    float v[4];
#pragma unroll
    for (int i = 0; i < 4; ++i) { const int c = tid + 256 * i;
        if (COMB) { float a = ALPHA * x1[(size_t)row * DM + c] + shared_[(size_t)row * DM + c];
            for (int k = 0; k < TOPK; ++k) a += Y[((size_t)row * TOPK + k) * DM + c];
            v[i] = a; }
        else v[i] = in[(size_t)row * DM + c]; }
    float s = v[0] + v[1] + v[2] + v[3];
#pragma unroll
    for (int o = 32; o; o >>= 1) s += __shfl_xor(s, o);
    if ((tid & 63) == 0) red[tid >> 6] = s;
    __syncthreads();
    const float mu = (red[0] + red[1] + red[2] + red[3]) * (1.f / DM);
    float q = 0.f;
#pragma unroll
    for (int i = 0; i < 4; ++i) { const float d = v[i] - mu; q += d * d; }
#pragma unroll
    for (int o = 32; o; o >>= 1) q += __shfl_xor(q, o);
    if ((tid & 63) == 0) red[4 + (tid >> 6)] = q;
    __syncthreads();
    const float rs = rsqrtf((red[4] + red[5] + red[6] + red[7]) * (1.f / DM) + LN_EPS);
#pragma unroll
    for (int i = 0; i < 4; ++i) { const int c = tid + 256 * i; out[(size_t)row * DM + c] = (v[i] - mu) * rs * g[c] + bt[c]; }
}
__global__ void __launch_bounds__(256) route(const float* __restrict__ logits, const float* __restrict__ rbias, int* tope, float* topw, int* apos, unsigned* cnt) {
    const int wid = threadIdx.x >> 6, lane = threadIdx.x & 63, t = blockIdx.x * 4 + wid;
    const float4 lg = *(const float4*)(logits + (size_t)t * NE + lane * 4), rb = *(const float4*)(rbias + lane * 4);
    float s0 = 1.f / (1.f + expf(-lg.x)), s1 = 1.f / (1.f + expf(-lg.y)), s2 = 1.f / (1.f + expf(-lg.z)), s3 = 1.f / (1.f + expf(-lg.w));
    float c0 = s0 + rb.x, c1 = s1 + rb.y, c2 = s2 + rb.z, c3 = s3 + rb.w;
    float a = fmaxf(c0, c1), bq = fminf(c0, c1);
    { const float hi2 = fmaxf(c2, c3), lo2 = fminf(c2, c3); const float na = fmaxf(a, hi2); const float nb = fmaxf(fminf(a, hi2), fmaxf(bq, lo2)); a = na; bq = nb; }
#pragma unroll
    for (int o = 1; o < 8; o <<= 1) { const float oa = __shfl_xor(a, o), ob = __shfl_xor(bq, o); const float na = fmaxf(a, oa), nb = fmaxf(fminf(a, oa), fmaxf(bq, ob)); a = na; bq = nb; }
    const float gs = a + bq; const int grp = lane >> 3;
    int rank = 0;
#pragma unroll
    for (int j = 0; j < 8; ++j) { const float og = __shfl(gs, j * 8); rank += (og > gs || (og == gs && j < grp)) ? 1 : 0; }
    const bool gsel = rank < 4;
    if (!gsel) { c0 = c1 = c2 = c3 = -INFINITY; }
    float wsum = 0.f, myw = 0.f; int mye = 0;
#pragma unroll
    for (int k = 0; k < TOPK; ++k) {
        float bv = c0; int bi = 0;
        if (c1 > bv) { bv = c1; bi = 1; } if (c2 > bv) { bv = c2; bi = 2; } if (c3 > bv) { bv = c3; bi = 3; }
        int be = lane * 4 + bi;
#pragma unroll
        for (int o = 1; o < 64; o <<= 1) { const float ov = __shfl_xor(bv, o); const int oe = __shfl_xor(be, o); if (ov > bv || (ov == bv && oe < be)) { bv = ov; be = oe; } }
        float sc = 0.f;
        if ((be >> 2) == lane) { const int bi2 = be & 3; sc = bi2 == 0 ? s0 : bi2 == 1 ? s1 : bi2 == 2 ? s2 : s3; if (bi2 == 0) c0 = -INFINITY; else if (bi2 == 1) c1 = -INFINITY; else if (bi2 == 2) c2 = -INFINITY; else c3 = -INFINITY; }
        sc = __shfl(sc, be >> 2);
        wsum += sc;
        if (lane == k) { myw = sc; mye = be; }
    }
    if (lane < TOPK) {
        const int aidx = t * TOPK + lane;
        tope[aidx] = mye; topw[aidx] = myw / wsum * 2.5f;
        apos[aidx] = (int)atomicAdd(&cnt[mye], 1u);
    }
}
template <int TM>
__global__ void __launch_bounds__(256) escan(const unsigned* __restrict__ cnt, int* off, int* toff) {
    __shared__ int sc[256], st[256];
    const int e = threadIdx.x; const int c = (int)cnt[e];
    sc[e] = c; st[e] = (c + TM - 1) / TM;
    __syncthreads();
    if (e == 0) { int a = 0, b = 0; for (int i = 0; i < 256; ++i) { const int ca = sc[i], cb = st[i]; sc[i] = a; st[i] = b; a += ca; b += cb; } off[256] = a; toff[256] = b; }
    __syncthreads();
    off[e] = sc[e]; toff[e] = st[e];
}
__global__ void __launch_bounds__(256) escatter(const int* __restrict__ tope, const int* __restrict__ apos, const int* __restrict__ off, int* rowa) {
    const int a = blockIdx.x * 256 + threadIdx.x;
    rowa[off[tope[a]] + apos[a]] = a;
}
template <int MODE>
__global__ void __launch_bounds__(256) egemm(const float* __restrict__ X, const float* __restrict__ W0, const float* __restrict__ W1, const int* __restrict__ off, const int* __restrict__ toff, const int* __restrict__ rowa,
                                            const float* __restrict__ topw, float* out) {
    __shared__ float As[16][68], Bs[16][68], Cs[16][68];
    __shared__ int se;
    const int tile = blockIdx.y;
    if (tile >= toff[256]) return;
    const int tid = threadIdx.x, tx = tid & 15, ty = tid >> 4;
    if (tid == 0) { int lo = 0, hi = 255; while (lo < hi) { const int mid = (lo + hi + 1) >> 1; if (toff[mid] <= tile) lo = mid; else hi = mid - 1; } se = lo; }
    __syncthreads();
    const int e = se, r0 = off[e] + (tile - toff[e]) * 64, rend = off[e + 1];
    constexpr int K = MODE == 0 ? DM : DE, N = MODE == 0 ? DE : DM;
    const int n0 = blockIdx.x * 64;
    const float* B0 = W0 + (size_t)e * K * N; const float* B1 = MODE == 0 ? W1 + (size_t)e * K * N : nullptr;
    const int ar = tid >> 2, ak = (tid & 3) * 4, bk = tid >> 4, bn = (tid & 15) * 4;
    const int arow = r0 + ar; const bool aval = arow < rend;
    const float* ap = nullptr;
    if (aval) ap = MODE == 0 ? X + (size_t)(rowa[arow] >> 3) * DM : X + (size_t)arow * DE;
    float acc[4][4], acu[4][4];
#pragma unroll
    for (int i = 0; i < 4; ++i)
#pragma unroll
        for (int j = 0; j < 4; ++j) { acc[i][j] = 0.f; acu[i][j] = 0.f; }
    for (int k0 = 0; k0 < K; k0 += 16) {
        float4 av = make_float4(0.f, 0.f, 0.f, 0.f);
        if (aval) av = *(const float4*)(ap + k0 + ak);
        const float4 bv = *(const float4*)(B0 + (size_t)(k0 + bk) * N + n0 + bn);
        float4 cv = make_float4(0.f, 0.f, 0.f, 0.f);
        if (MODE == 0) cv = *(const float4*)(B1 + (size_t)(k0 + bk) * N + n0 + bn);
        __syncthreads();
        As[ak + 0][ar] = av.x; As[ak + 1][ar] = av.y; As[ak + 2][ar] = av.z; As[ak + 3][ar] = av.w;
        *(float4*)&Bs[bk][bn] = bv; if (MODE == 0) *(float4*)&Cs[bk][bn] = cv;
        __syncthreads();
#pragma unroll
        for (int kk = 0; kk < 16; ++kk) {
            const float4 a = *(const float4*)&As[kk][ty * 4];
            const float4 b = *(const float4*)&Bs[kk][tx * 4];
            const float aa[4] = {a.x, a.y, a.z, a.w}, bb[4] = {b.x, b.y, b.z, b.w};
#pragma unroll
            for (int i = 0; i < 4; ++i)
#pragma unroll
                for (int j = 0; j < 4; ++j) acc[i][j] = fmaf(aa[i], bb[j], acc[i][j]);
            if (MODE == 0) { const float4 c = *(const float4*)&Cs[kk][tx * 4]; const float cc[4] = {c.x, c.y, c.z, c.w};
#pragma unroll
                for (int i = 0; i < 4; ++i)
#pragma unroll
                    for (int j = 0; j < 4; ++j) acu[i][j] = fmaf(aa[i], cc[j], acu[i][j]); }
        }
    }
#pragma unroll
    for (int i = 0; i < 4; ++i) { const int r = r0 + ty * 4 + i; if (r < rend) {
        if (MODE == 0) {
#pragma unroll
            for (int j = 0; j < 4; ++j) { const float g = acc[i][j]; out[(size_t)r * DE + n0 + tx * 4 + j] = g / (1.f + expf(-g)) * acu[i][j]; } }
        else { const int a = rowa[r]; const float w = topw[a];
#pragma unroll
            for (int j = 0; j < 4; ++j) out[(size_t)a * DM + n0 + tx * 4 + j] = acc[i][j] * w; } } }
}
}


namespace fk {
#define LAS __attribute__((address_space(3)))
#define GAS __attribute__((address_space(1)))
typedef unsigned short bf16_t;
typedef short bf16x8 __attribute__((ext_vector_type(8)));
typedef float f32x4 __attribute__((ext_vector_type(4)));
typedef float f32x2 __attribute__((ext_vector_type(2)));
typedef float f32x16 __attribute__((ext_vector_type(16)));
typedef unsigned u32x4 __attribute__((ext_vector_type(4)));
typedef unsigned u32x2 __attribute__((ext_vector_type(2)));
constexpr int NWAVES = 8, NTHR = 512;
constexpr int INCP = 4352;
constexpr float LOG2E = 1.4426950408889634f;
constexpr float QS_A = 0.125f * LOG2E;
constexpr float QS_B = 0.10206207261596577f * LOG2E;
#define LDS_WAIT() asm volatile("s_waitcnt lgkmcnt(0)" ::: "memory")
#define VM_WAIT() asm volatile("s_waitcnt vmcnt(0)" ::: "memory")
__device__ __forceinline__ unsigned f2bf(float f) { unsigned u = __builtin_bit_cast(unsigned, f); return (u + 0x7fffu + ((u >> 16) & 1u)) >> 16; }
__device__ __forceinline__ unsigned pk2(float lo, float hi) { return f2bf(lo) | (f2bf(hi) << 16); }
__device__ __forceinline__ float bf2f(unsigned short b) { return __builtin_bit_cast(float, (unsigned)b << 16); }
__device__ __forceinline__ float bflo(unsigned w) { return __builtin_bit_cast(float, w << 16); }
__device__ __forceinline__ float bfhi(unsigned w) { return __builtin_bit_cast(float, w & 0xffff0000u); }
__device__ __forceinline__ float sigmoidf_(float x) { return __builtin_amdgcn_rcpf(1.f + __expf(-x)); }
__device__ __forceinline__ float wave_sum(float v) {
#pragma unroll
    for (int o = 1; o < 64; o <<= 1) v += __shfl_xor(v, o);
    return v;
}

namespace pg8 {
constexpr int BM = 256, BK = 64, HALF = 128, HTB = HALF * BK * 2, STAGE_BYTES = 8 * HTB, NXCD = 8, WGM = 8;
__host__ __device__ __forceinline__ int lds_byte(int r, int c) { const int st = (r >> 4) * 2 + (c >> 5), rr = r & 15, cc = c & 31, ob = rr * 64 + cc * 2; return st * 1024 + (ob ^ (((ob >> 9) & 1) << 5)); }
__host__ __device__ __forceinline__ void stage_rc(int b, int& R, int& C) { const int st = b / 1024, sb = b % 1024, swz = sb ^ (((sb >> 9) & 1) << 5); R = (st >> 1) * 16 + swz / 64; C = (st & 1) * 32 + (swz % 64) / 2; }
__host__ __device__ __forceinline__ int perm32(int rho) { const int n = rho >> 4, i = rho & 15; return 8 * (i >> 2) + 4 * n + (i & 3); }

struct Unit { int pm, pn, e, r0, rend; };
struct Gemm { const bf16_t* A; const bf16_t* Bt; int M, N, K, lda, ldb; };

struct StaticOrder {
    int nM, nN, nwg, G, c;
    __device__ void init(int M, int N, int G_, int c_) { nM = M / BM; nN = N / BM; nwg = nM * nN; G = G_; c = c_; }
    __device__ bool next(int i, Unit& u) const {
        const long L = (long)i * G + c; if (L >= nwg) return false;
        int wgid = (int)L; { const int q = nwg / NXCD, r = nwg % NXCD, xcd = wgid % NXCD, off = wgid / NXCD; wgid = (xcd < r ? xcd * (q + 1) : r * (q + 1) + (xcd - r) * q) + off; }
        const int nig = WGM * nN, gid = wgid / nig, fm = gid * WGM, gsz = (nM - fm) < WGM ? (nM - fm) : WGM;
        u.pm = fm + ((wgid % nig) % gsz); u.pn = (wgid % nig) / gsz; u.e = 0; u.r0 = u.pm * BM; u.rend = u.r0 + BM; return true;
    }
    __device__ __forceinline__ int a_row(const Unit& u, int r) const { return u.pm * BM + r; }
    __device__ __forceinline__ const char* b_ptr(const Gemm& g, const Unit& u) const { return (const char*)g.Bt + (size_t)u.pn * BM * g.ldb * 2; }
};

typedef float f32x2_t_ __attribute__((ext_vector_type(2))); typedef __bf16 bf16x2_t_ __attribute__((ext_vector_type(2)));
__device__ __forceinline__ unsigned cvt_pk_bf16(float lo, float hi) { const f32x2_t_ v = {lo, hi}; const bf16x2_t_ b = __builtin_convertvector(v, bf16x2_t_); return __builtin_bit_cast(unsigned, b); }

template <class Epi, class Sched, bool ALIGN_EPI>
__device__ __forceinline__ void gemm_phase(LAS unsigned char* lds, const Gemm g, const Sched& S, const Epi& E) {
    int tid_ = threadIdx.x; asm volatile("" : "+v"(tid_));
    const int tid = tid_, wid = __builtin_amdgcn_readfirstlane(tid >> 6), lane = tid & 63, wr = wid >> 2, wc = wid & 3, fr = lane & 15, fq = lane >> 4;
    const int K = g.K, nt = K / BK;
    int RA[2]; unsigned CA[2], voffB[2];
#pragma unroll
    for (int i = 0; i < 2; ++i) { int R, C; stage_rc(tid * 16 + i * 8192, R, C); const int Rb = (R & ~31) + perm32(R & 31);
        RA[i] = R; CA[i] = (unsigned)C * 2u; voffB[i] = (unsigned)(Rb * g.ldb + C) * 2u; }
    const unsigned lda2 = (unsigned)g.lda * 2u;
    const size_t hstepB = (size_t)HALF * g.ldb * 2;
    const unsigned ldsw = (unsigned)wid * 1024u;
    const int aoff = lds_byte(wr * 64 + fr, fq * 8), boff = lds_byte(wc * 32 + fr, fq * 8);
    const char* const Abase = (const char*)g.A;
#define PG8_SA(b, h) (((b) * 2 + (h)) * HTB)
#define PG8_SB(b, h) ((4 + (b) * 2 + (h)) * HTB)
#define PG8_STAGE_B(bufoff, gbase) do { _Pragma("unroll") for (int _i = 0; _i < 2; ++_i) \
        __builtin_amdgcn_global_load_lds((const unsigned*)((const char*)(gbase) + voffB[_i]), (LAS unsigned*)(lds + (bufoff) + ldsw + _i * 8192), 16, 0, 0); } while (0)
#define PG8_STAGE_A(bufoff, V0, V1, kb) do { \
        __builtin_amdgcn_global_load_lds((const unsigned*)((Abase + (kb)) + (V0)), (LAS unsigned*)(lds + (bufoff) + ldsw), 16, 0, 0); \
        __builtin_amdgcn_global_load_lds((const unsigned*)((Abase + (kb)) + (V1)), (LAS unsigned*)(lds + (bufoff) + ldsw + 8192), 16, 0, 0); } while (0)
#define PG8_LDA(dst, b, h) do { _Pragma("unroll") for (int m = 0; m < 4; ++m) _Pragma("unroll") for (int k = 0; k < 2; ++k) dst[m][k] = *(const LAS bf16x8*)(lds + PG8_SA(b, h) + aoff + m * 2048 + k * 1024); } while (0)
#define PG8_LDB(dst, b, h) do { _Pragma("unroll") for (int n = 0; n < 2; ++n) _Pragma("unroll") for (int k = 0; k < 2; ++k) dst[n][k] = *(const LAS bf16x8*)(lds + PG8_SB(b, h) + boff + n * 2048 + k * 1024); } while (0)
#define PG8_MMA(ai, bj, At, Bt) do { __builtin_amdgcn_s_setprio(1); _Pragma("unroll") for (int m = 0; m < 4; ++m) _Pragma("unroll") for (int n = 0; n < 2; ++n) _Pragma("unroll") for (int k = 0; k < 2; ++k) \
        acc[ai][bj][m][n] = __builtin_amdgcn_mfma_f32_16x16x32_bf16(Bt[n][k], At[m][k], acc[ai][bj][m][n], 0, 0, 0); __builtin_amdgcn_s_setprio(0); } while (0)
#define PG8_WAIT_V(n) asm volatile("s_waitcnt vmcnt(" #n ")" ::: "memory")
#define PG8_WAIT_L(n) asm volatile("s_waitcnt lgkmcnt(" #n ")" ::: "memory")
#define PG8_BAR __builtin_amdgcn_s_barrier()
#define PG8_SCHED __builtin_amdgcn_sched_barrier(0)
#define PG8_VOFF(V, U) do { V##00 = (unsigned)S.a_row(U, RA[0]) * lda2 + CA[0]; V##01 = (unsigned)S.a_row(U, RA[1]) * lda2 + CA[1]; \
        V##10 = (unsigned)S.a_row(U, HALF + RA[0]) * lda2 + CA[0]; V##11 = (unsigned)S.a_row(U, HALF + RA[1]) * lda2 + CA[1]; } while (0)
    Unit cur, nxt; int ui = 0;
    if (!S.next(0, cur)) return;
    f32x4 acc[2][2][4][2];
#pragma unroll
    for (int a = 0; a < 2; ++a)
#pragma unroll
        for (int b = 0; b < 2; ++b)
#pragma unroll
            for (int m = 0; m < 4; ++m)
#pragma unroll
                for (int n = 0; n < 2; ++n) acc[a][b][m][n] = (f32x4){0.f, 0.f, 0.f, 0.f};
    bf16x8 At[4][2], B0[2][2], B1[2][2];
    unsigned vc00, vc01, vc10, vc11;
    PG8_VOFF(vc, cur);
    const char* cB = S.b_ptr(g, cur);
    PG8_STAGE_B(PG8_SB(0, 0), cB); PG8_STAGE_B(PG8_SB(0, 1), cB + hstepB); PG8_STAGE_A(PG8_SA(0, 0), vc00, vc01, 0u); PG8_STAGE_A(PG8_SA(0, 1), vc10, vc11, 0u);
    if (wr == 1) PG8_BAR;
    PG8_WAIT_V(2); PG8_BAR;
    PG8_STAGE_B(PG8_SB(1, 0), cB + 128); PG8_STAGE_A(PG8_SA(1, 0), vc00, vc01, 128u); PG8_STAGE_B(PG8_SB(1, 1), cB + hstepB + 128);
    PG8_WAIT_V(6); PG8_BAR;
    for (;;) {
        const bool has_next = S.next(ui + 1, nxt);
        const char* nB = has_next ? S.b_ptr(g, nxt) : cB;
        const bool half1 = (cur.rend - cur.r0) > HALF;
#pragma unroll 1
        for (int t = 0; t < nt; t += 2) {
            const bool last = (t == nt - 2);
            const unsigned kb1 = (unsigned)(t + 1) * 128u;
            unsigned kb2 = (unsigned)(t + 2) * 128u;
            unsigned s00 = vc00, s01 = vc01, s10 = vc10, s11 = vc11;
            const char* b2 = cB + (size_t)kb2;
            if (last) { kb2 = 0u; b2 = nB; if (has_next) { PG8_VOFF(s, nxt); } }
            const unsigned kb3 = kb2 + 128u; const char* b3 = b2 + 128;
            PG8_LDB(B0, 0, 0); PG8_LDB(B1, 0, 1); PG8_SCHED; PG8_LDA(At, 0, 0); PG8_STAGE_A(PG8_SA(1, 1), vc10, vc11, kb1);
            PG8_WAIT_V(8); PG8_WAIT_L(0); PG8_BAR; PG8_MMA(0, 0, At, B0); PG8_MMA(0, 1, At, B1); PG8_BAR; PG8_SCHED;
            PG8_LDA(At, 0, 1); PG8_STAGE_B(PG8_SB(0, 0), b2); PG8_STAGE_B(PG8_SB(0, 1), b2 + hstepB); PG8_STAGE_A(PG8_SA(0, 0), s00, s01, kb2);
            PG8_WAIT_V(8); PG8_WAIT_L(0); PG8_BAR; if (half1) { PG8_MMA(1, 0, At, B0); PG8_MMA(1, 1, At, B1); } PG8_BAR; PG8_SCHED;
            PG8_LDB(B0, 1, 0); PG8_LDB(B1, 1, 1); PG8_SCHED; PG8_LDA(At, 1, 0); PG8_STAGE_A(PG8_SA(0, 1), s10, s11, kb2);
            PG8_WAIT_V(8); PG8_WAIT_L(0); PG8_BAR; PG8_MMA(0, 0, At, B0); PG8_MMA(0, 1, At, B1); PG8_BAR; PG8_SCHED;
            PG8_LDA(At, 1, 1); PG8_STAGE_B(PG8_SB(1, 0), b3); PG8_STAGE_B(PG8_SB(1, 1), b3 + hstepB); PG8_STAGE_A(PG8_SA(1, 0), s00, s01, kb3);
            PG8_WAIT_V(8); PG8_WAIT_L(0); PG8_BAR; if (half1) { PG8_MMA(1, 0, At, B0); PG8_MMA(1, 1, At, B1); } PG8_BAR; PG8_SCHED;
        }
        if constexpr (ALIGN_EPI) { if (wr == 0) PG8_BAR; }
        E(acc, cur, wr, wc, fr, fq);
        if (!has_next) break;
#pragma unroll
        for (int a = 0; a < 2; ++a)
#pragma unroll
            for (int b = 0; b < 2; ++b)
#pragma unroll
                for (int m = 0; m < 4; ++m)
#pragma unroll
                    for (int n = 0; n < 2; ++n) acc[a][b][m][n] = (f32x4){0.f, 0.f, 0.f, 0.f};
        cur = nxt; cB = nB; PG8_VOFF(vc, cur); ++ui;
        if constexpr (ALIGN_EPI) { if (wr == 1) PG8_BAR; }
    }
    PG8_WAIT_V(0);
    if constexpr (!ALIGN_EPI) { if (wr == 0) PG8_BAR; }
    PG8_BAR;
#undef PG8_SA
#undef PG8_SB
#undef PG8_STAGE_A
#undef PG8_STAGE_B
#undef PG8_LDA
#undef PG8_LDB
#undef PG8_MMA
#undef PG8_WAIT_V
#undef PG8_WAIT_L
#undef PG8_BAR
#undef PG8_SCHED
#undef PG8_VOFF
}
#define PG8_TILE_BEGIN(acc, wr, wc, fr, fq) \
    _Pragma("unroll") for (int ai = 0; ai < 2; ++ai) _Pragma("unroll") for (int m = 0; m < 4; ++m) _Pragma("unroll") for (int bj = 0; bj < 2; ++bj) { \
        const int trow = ai * 128 + wr * 64 + m * 16 + fr, tcol = bj * 128 + wc * 32 + 8 * fq; f32x4 v0 = acc[ai][bj][m][0], v1 = acc[ai][bj][m][1];
#define PG8_TILE_END }
__device__ __forceinline__ u32x4 pack8(f32x4 v0, f32x4 v1) { u32x4 w; w.x = cvt_pk_bf16(v0[0], v0[1]); w.y = cvt_pk_bf16(v0[2], v0[3]); w.z = cvt_pk_bf16(v1[0], v1[1]); w.w = cvt_pk_bf16(v1[2], v1[3]); return w; }
}

#define XB_TMO      128
#define XB_XCNT(j)  (256  + 64 * (j))
#define XB_XSUB(j)  (1280 + 64 * (j))
#define XB_XGEN(j)  (2304 + 64 * (j))
#define XB_TOP      3328
#define XB_TOPGEN   3392
#define XCD_BAR_WORDS 3456
#define XB_SPIN_CAP (1u << 18)

__device__ __forceinline__ unsigned xb_ld(unsigned* p)              { return __hip_atomic_load(p, __ATOMIC_RELAXED, __HIP_MEMORY_SCOPE_AGENT); }
__device__ __forceinline__ unsigned xb_add(unsigned* p, unsigned v) { return __hip_atomic_fetch_add(p, v, __ATOMIC_RELAXED, __HIP_MEMORY_SCOPE_AGENT); }
__device__ __forceinline__ unsigned xb_xcc_id() { return (unsigned)__builtin_amdgcn_s_getreg((3 << 11) | 20) & 0xFu; }
#define XB_SPIN(cond, bar) do { unsigned _sp = 0; while (cond) { __builtin_amdgcn_s_sleep(1); \
    if ((++_sp & 255u) == 0u) { if (xb_ld(&(bar)[XB_TMO])) break; if (_sp > XB_SPIN_CAP) { atomicAdd(&(bar)[XB_TMO], 1u); break; } } } } while (0)

struct XcdBarrier {
    unsigned* bar; unsigned x;
    volatile LAS unsigned* st;
};

__device__ __forceinline__ XcdBarrier xcd_barrier_post(unsigned* bar, volatile LAS unsigned* st) {
    XcdBarrier b; b.bar = bar; b.x = xb_xcc_id(); b.st = st;
    if (threadIdx.x == 0) (void)xb_add(&bar[XB_XCNT(b.x)], 1u);
    return b;
}
__device__ __forceinline__ void xcd_barrier_complete(unsigned* bar, unsigned x, unsigned& nloc, unsigned& nx) {
    const unsigned G = gridDim.x * gridDim.y * gridDim.z;
    unsigned sum, cnt, mine, sp = 0u;
    for (;;) {
        sum = 0u; cnt = 0u; mine = 0u;
#pragma unroll
        for (unsigned j = 0; j < 16; ++j) { const unsigned c = xb_ld(&bar[XB_XCNT(j)]); sum += c; cnt += (c > 0u) ? 1u : 0u; mine = (j == x) ? c : mine; }
        if (sum == G) break;
        __builtin_amdgcn_s_sleep(1);
        if ((++sp & 255u) == 0u) { if (xb_ld(&bar[XB_TMO])) break; if (sp > XB_SPIN_CAP) { atomicAdd(&bar[XB_TMO], 1u); break; } }
    }
    nloc = mine > 0u ? mine : 1u; nx = cnt > 0u ? cnt : 1u;
}

__device__ __forceinline__ void xcd_barrier(const XcdBarrier& b) {
    asm volatile("s_waitcnt vmcnt(0)" ::: "memory");
    __syncthreads();
    if (threadIdx.x == 0) {
        unsigned* bar = b.bar; asm volatile("" : "+s"(bar));
        __builtin_amdgcn_s_waitcnt(0);
        unsigned nloc = b.st[0], nx = b.st[1];
        if (nloc == 0u) { xcd_barrier_complete(bar, b.x, nloc, nx); b.st[0] = nloc; b.st[1] = nx; }
        const unsigned old = xb_add(&bar[XB_XSUB(b.x)], 1u);
        const unsigned gen = old / nloc;
        if (old + 1u == (gen + 1u) * nloc) {
            __builtin_amdgcn_fence(__ATOMIC_RELEASE, "agent");
            asm volatile("s_waitcnt vmcnt(0)" ::: "memory");
            const unsigned og = xb_add(&bar[XB_TOP], 1u);
            const unsigned tg = og / nx;
            if (og + 1u == (tg + 1u) * nx) xb_add(&bar[XB_TOPGEN], 1u);
            else XB_SPIN(xb_ld(&bar[XB_TOPGEN]) == tg, bar);
            __builtin_amdgcn_fence(__ATOMIC_ACQUIRE, "agent");
            xb_add(&bar[XB_XGEN(b.x)], 1u);
            asm volatile("s_waitcnt vmcnt(0)" ::: "memory");
        } else {
            XB_SPIN(xb_ld(&bar[XB_XGEN(b.x)]) == gen, bar);
            __builtin_amdgcn_fence(__ATOMIC_ACQUIRE, "agent");
            asm volatile("s_waitcnt vmcnt(0)" ::: "memory");
        }
    }
    __syncthreads();
}


struct Params {
    const float* in[22]; float* out; unsigned char* ws;
    int ph_lo, ph_hi;
};
constexpr size_t MiB = 1u << 20;
constexpr size_t WS_CTL = 0, CTL_BYTES = 1 * MiB;
constexpr int CW_BAR = 4096;
constexpr int CW_CNT = 16384;
constexpr size_t WS_WIN = 2 * MiB;
constexpr size_t SZ_WIN = (size_t)INCP * DM;
constexpr size_t SZ_WUQ = (size_t)768 * QL, SZ_WUKV = (size_t)1024 * KVL;
constexpr size_t WS_WUQ = WS_WIN + 2 * SZ_WIN * 2;
constexpr size_t WS_WUKV = WS_WUQ + 2 * SZ_WUQ * 2;
constexpr size_t SZ_WP = (size_t)DM * 512, SZ_WOUT = (size_t)DM * DM;
constexpr size_t WS_WPA = WS_WUKV + 2 * SZ_WUKV * 2;
constexpr size_t WS_WPB = WS_WPA + 2 * SZ_WP * 2;
constexpr size_t WS_WOUT = WS_WPB + 2 * SZ_WP * 2;
constexpr size_t SZ_WRT = (size_t)NE * DM, SZ_WSGU = (size_t)512 * DM, SZ_WSD = (size_t)DM * DSH;
constexpr size_t WS_WRT = WS_WOUT + 2 * SZ_WOUT * 2;
constexpr size_t WS_WSGU = WS_WRT + 2 * SZ_WRT * 2;
constexpr size_t WS_WSD = WS_WSGU + 2 * SZ_WSGU * 2;
constexpr size_t WS_CS = WS_WSD + 2 * SZ_WSD * 2;
constexpr size_t WS_KM = WS_CS + (size_t)SEQ * 16 * 8;
constexpr size_t WS_SEL = WS_KM + (size_t)NB * HA * NBLK * 64 * 4;
constexpr size_t WS_XB = WS_SEL + (size_t)T * 8 * 4;
constexpr size_t WS_CQN = WS_XB + (size_t)T * DM * 2;
constexpr size_t WS_CKVN = WS_CQN + (size_t)T * QL * 2;
constexpr size_t WS_QB = WS_CKVN + (size_t)T * KVL * 2;
constexpr size_t WS_KB = WS_QB + (size_t)T * 768 * 2;
constexpr size_t WS_VB = WS_KB + (size_t)T * 768 * 2;
constexpr size_t WS_OAB = WS_VB + (size_t)T * 512 * 2;
constexpr size_t WS_TMP = WS_OAB + (size_t)T * 1024 * 2;
constexpr size_t WS_MRG = WS_TMP + (size_t)T * 1024 * 2;
constexpr size_t WS_PRE = WS_MRG + (size_t)T * 1024 * 2;
constexpr size_t WS_X1 = WS_PRE + (size_t)T * 1024 * 4;
constexpr size_t WS_X1B = WS_X1 + (size_t)T * 1024 * 4;
constexpr size_t WS_X2 = WS_X1B + (size_t)T * 1024 * 2;
constexpr size_t WS_LOG = WS_X2 + (size_t)T * 1024 * 4;
constexpr size_t WS_HS = WS_LOG + (size_t)T * NE * 4;
constexpr size_t WS_SH = WS_HS + (size_t)T * DSH * 2;
constexpr size_t WS_TOPE = WS_SH + (size_t)T * DM * 2;
constexpr size_t WS_TOPW = WS_TOPE + (size_t)NA * 4;
constexpr size_t WS_APOS = WS_TOPW + (size_t)NA * 4;
constexpr size_t WS_ROWA = WS_APOS + (size_t)NA * 4;
constexpr size_t WS_HIST = WS_ROWA + (size_t)NA * 8;
constexpr size_t WS_PO = WS_HIST + (size_t)1024 * 256 * 4;
constexpr size_t WS_PML = WS_PO + (size_t)T * 8 * 3 * 64 * 2;
constexpr size_t WS_HE = WS_PML + (size_t)T * 8 * 3 * 128;
constexpr size_t WS_Y = WS_HE + (size_t)NA * DE * 2;
constexpr size_t WS_PROJ = WS_Y + (size_t)NA * DM * 2;
constexpr size_t SZ_WEGU = (size_t)NE * 512 * DM, SZ_WED = (size_t)NE * DM * DE;
constexpr size_t WS_WEGU = WS_PROJ + (size_t)T * INCP * 2;
constexpr size_t WS_WED = WS_WEGU + 2 * SZ_WEGU * 2;
constexpr size_t WS_FAST_END = WS_WED + 2 * SZ_WED * 2;
constexpr size_t WS_NEED = WS_FAST_END;
static_assert(WS_NEED <= (size_t)2040 * MiB, "ws map");

constexpr int LDS_BYTES = 147456;
constexpr int RING_BYTES = 131072, MISC_OFF = RING_BYTES + 1024, TAB_OFF = RING_BYTES + 2048;

struct Frame { LAS unsigned char* lds; int tid, lane, wave, G, vcu; };

template <class RowMap>
__device__ __forceinline__ void transpose_item(const float* W, int K, int N, bf16_t* WT, int ldk, RowMap rm, LAS float* scr, int item, int lane) {
    const int nblk = N / 32, kb = item / nblk, nb = item % nblk, k0 = 64 * kb, n0 = 32 * nb;
#pragma unroll 8
    for (int i = 0; i < 32; ++i) { const int kk = 2 * i + (lane >> 5); scr[kk * 33 + (lane & 31)] = W[(size_t)(k0 + kk) * N + n0 + (lane & 31)]; }
    LDS_WAIT(); asm volatile("" ::: "memory");
    const int c = lane & 7;
#pragma unroll
    for (int j = 0; j < 4; ++j) { const int n = (lane >> 3) + 8 * j; const LAS float* s = scr + (8 * c) * 33 + n;
        u32x4 o; o.x = pk2(s[0 * 33], s[1 * 33]); o.y = pk2(s[2 * 33], s[3 * 33]); o.z = pk2(s[4 * 33], s[5 * 33]); o.w = pk2(s[6 * 33], s[7 * 33]);
        *(u32x4*)(WT + (size_t)rm(n0 + n) * ldk + k0 + 8 * c) = o; }
    LDS_WAIT(); asm volatile("" ::: "memory");
}
template <class RowMap>
__device__ __forceinline__ void transpose_item64(const float* W, int K, int N, bf16_t* WT, int ldk, RowMap rm, LAS unsigned short* scr, int item, int lane) {
    const int nblk = N / 64, kb = item / nblk, nb = item % nblk, k0 = 64 * kb, n0 = 64 * nb, r = lane >> 4, c4 = (lane & 15) * 4;
    f32x4 v[16];
#pragma unroll
    for (int i = 0; i < 16; ++i) v[i] = __builtin_nontemporal_load((const f32x4*)(W + (size_t)(k0 + 4 * i + r) * N + n0 + c4));
#pragma unroll
    for (int i = 0; i < 16; ++i) { LAS unsigned* d = (LAS unsigned*)(scr + (4 * i + r) * 66 + c4); d[0] = pk2(v[i][0], v[i][1]); d[1] = pk2(v[i][2], v[i][3]); }
    LDS_WAIT(); asm volatile("" ::: "memory");
    const int c = lane & 7;
#pragma unroll
    for (int j = 0; j < 8; ++j) { const int n = (lane >> 3) + 8 * j; const LAS unsigned short* q = scr + (8 * c) * 66 + n;
        u32x4 o; o.x = (unsigned)q[0] | ((unsigned)q[66] << 16); o.y = (unsigned)q[2 * 66] | ((unsigned)q[3 * 66] << 16); o.z = (unsigned)q[4 * 66] | ((unsigned)q[5 * 66] << 16); o.w = (unsigned)q[6 * 66] | ((unsigned)q[7 * 66] << 16);
        *(u32x4*)(WT + (size_t)rm(n0 + n) * ldk + k0 + 8 * c) = o; }
    LDS_WAIT(); asm volatile("" ::: "memory");
}
struct RowId { __device__ __forceinline__ int operator()(int n) const { return n; } };

struct EpiProj {
    bf16_t* O; const float* bg;
    __device__ __forceinline__ void operator()(const f32x4 (&acc)[2][2][4][2], const pg8::Unit& u, int wr, int wc, int fr, int fq) const {
        PG8_TILE_BEGIN(acc, wr, wc, fr, fq)
            const int row = u.pm * 256 + trow, col = u.pn * 256 + tcol;
            if (col < C_KA) { v0 = v0 * QS_A; v1 = v1 * QS_A; }
            else if (col >= C_GA && col < INC) { const f32x4 b0 = *(const f32x4*)(bg + col - C_GA), b1 = *(const f32x4*)(bg + col - C_GA + 4);
#pragma unroll
                for (int i = 0; i < 4; ++i) { v0[i] = sigmoidf_(v0[i] + b0[i]); v1[i] = sigmoidf_(v1[i] + b1[i]); } }
            *(u32x4*)(O + (size_t)row * INCP + col) = pg8::pack8(v0, v1);
        PG8_TILE_END
    }
};

struct RowQ { __device__ __forceinline__ int operator()(int n) const { const int h = n / 96, d = n % 96; if (d < 64) return n; const int i = d - 64; return h * 96 + 64 + (i < 16 ? 2 * i : 2 * (i - 16) + 1); } };

struct EpiQ {
    bf16_t* O; const f32x2* CS;
    __device__ __forceinline__ void operator()(const f32x4 (&acc)[2][2][4][2], const pg8::Unit& u, int wr, int wc, int fr, int fq) const {
        PG8_TILE_BEGIN(acc, wr, wc, fr, fq)
            const int row = u.pm * 256 + trow, col = u.pn * 256 + tcol, d = col % 96;
            if (d >= 64) { const int pos = row % SEQ, i0 = (d - 64) >> 1; const f32x2* cs = CS + (size_t)pos * 16 + i0;
                const f32x2 c0 = cs[0], c1 = cs[1], c2 = cs[2], c3 = cs[3];
                const f32x4 a = v0, b = v1;
                v0[0] = a[0] * c0[0] - a[1] * c0[1]; v0[1] = a[1] * c0[0] + a[0] * c0[1]; v0[2] = a[2] * c1[0] - a[3] * c1[1]; v0[3] = a[3] * c1[0] + a[2] * c1[1];
                v1[0] = b[0] * c2[0] - b[1] * c2[1]; v1[1] = b[1] * c2[0] + b[0] * c2[1]; v1[2] = b[2] * c3[0] - b[3] * c3[1]; v1[3] = b[3] * c3[0] + b[2] * c3[1]; }
            v0 = v0 * QS_B; v1 = v1 * QS_B;
            *(u32x4*)(O + (size_t)row * 768 + col) = pg8::pack8(v0, v1);
        PG8_TILE_END
    }
};
struct EpiKV {
    bf16_t* KB; bf16_t* VB;
    __device__ __forceinline__ void operator()(const f32x4 (&acc)[2][2][4][2], const pg8::Unit& u, int wr, int wc, int fr, int fq) const {
        PG8_TILE_BEGIN(acc, wr, wc, fr, fq)
            const int row = u.pm * 256 + trow, col = u.pn * 256 + tcol, h = col >> 7, j = col & 127;
            bf16_t* dst = (j < 64) ? KB + (size_t)row * 768 + h * 96 + j : VB + (size_t)row * 512 + h * 64 + (j - 64);
            *(u32x4*)dst = pg8::pack8(v0, v1);
        PG8_TILE_END
    }
};

__device__ __forceinline__ void prep_phase(const Frame& F, const bf16_t* PROJ, const float* qn, const float* kvn, const f32x2* CS, bf16_t* CQN, bf16_t* CKVN, bf16_t* KB, float* KM) {
    int lane_ = F.lane; asm volatile("" : "+v"(lane_));
    const int gw = F.vcu * NWAVES + F.wave, NGW = F.G * NWAVES, lane = lane_;
    for (int row = gw; row < T; row += NGW) {
        const bf16_t* p = PROJ + (size_t)row * INCP;
        u32x4 a = (u32x4){0u, 0u, 0u, 0u}, b = (u32x4){0u, 0u, 0u, 0u};
        if (lane < 48) a = *(const u32x4*)(p + C_CQ + lane * 8);
        if (lane < 32) b = *(const u32x4*)(p + C_CKV + lane * 8);
        float sq = 0.f, sk = 0.f;
#pragma unroll
        for (int i = 0; i < 4; ++i) { const float x = bflo(a[i]), y = bfhi(a[i]), z = bflo(b[i]), w = bfhi(b[i]); sq += x * x + y * y; sk += z * z + w * w; }
        sq = wave_sum(sq); sk = wave_sum(sk);
        const float rq = rsqrtf(sq * (1.f / QL) + RMS_EPS), rk = rsqrtf(sk * (1.f / KVL) + RMS_EPS);
        if (lane < 48) { const f32x4 g0 = *(const f32x4*)(qn + lane * 8), g1 = *(const f32x4*)(qn + lane * 8 + 4); u32x4 o;
            o.x = pk2(bflo(a.x) * rq * g0[0], bfhi(a.x) * rq * g0[1]); o.y = pk2(bflo(a.y) * rq * g0[2], bfhi(a.y) * rq * g0[3]);
            o.z = pk2(bflo(a.z) * rq * g1[0], bfhi(a.z) * rq * g1[1]); o.w = pk2(bflo(a.w) * rq * g1[2], bfhi(a.w) * rq * g1[3]);
            *(u32x4*)(CQN + (size_t)row * QL + lane * 8) = o; }
        if (lane < 32) { const f32x4 g0 = *(const f32x4*)(kvn + lane * 8), g1 = *(const f32x4*)(kvn + lane * 8 + 4); u32x4 o;
            o.x = pk2(bflo(b.x) * rk * g0[0], bfhi(b.x) * rk * g0[1]); o.y = pk2(bflo(b.y) * rk * g0[2], bfhi(b.y) * rk * g0[3]);
            o.z = pk2(bflo(b.z) * rk * g1[0], bfhi(b.z) * rk * g1[1]); o.w = pk2(bflo(b.w) * rk * g1[2], bfhi(b.w) * rk * g1[3]);
            *(u32x4*)(CKVN + (size_t)row * KVL + lane * 8) = o; }
        if (lane < 16) { const float x1 = bf2f(p[C_KR + lane]), x2 = bf2f(p[C_KR + 16 + lane]); const f32x2 cs = CS[(size_t)(row % SEQ) * 16 + lane];
            const unsigned w = pk2(x1 * cs[0] - x2 * cs[1], x2 * cs[0] + x1 * cs[1]);
#pragma unroll
            for (int h = 0; h < 8; ++h) *(unsigned*)(KB + (size_t)row * 768 + h * 96 + 64 + 2 * lane) = w; }
    }
    for (int it = gw; it < NB * NBLK * HA; it += NGW) {
        const int h = it % HA, blk = (it / HA) % NBLK, b = it / (HA * NBLK), c = lane & 7, r0 = lane >> 3;
        const bf16_t* p = PROJ + ((size_t)b * SEQ + (size_t)blk * BLK + r0) * INCP + C_KA + h * 64 + c * 8;
        float s[8];
#pragma unroll
        for (int i = 0; i < 8; ++i) s[i] = 0.f;
        for (int i = 0; i < 32; ++i) { const u32x4 v = *(const u32x4*)(p + (size_t)i * 8 * INCP);
#pragma unroll
            for (int k = 0; k < 4; ++k) { s[2 * k] += bflo(v[k]); s[2 * k + 1] += bfhi(v[k]); } }
#pragma unroll
        for (int i = 0; i < 8; ++i) { s[i] += __shfl_xor(s[i], 8); s[i] += __shfl_xor(s[i], 16); s[i] += __shfl_xor(s[i], 32); }
        if (lane < 8) { float* o = KM + ((size_t)(b * HA + h) * NBLK + blk) * 64 + c * 8;
            *(f32x4*)o = (f32x4){s[0], s[1], s[2], s[3]} * (1.f / BLK); *(f32x4*)(o + 4) = (f32x4){s[4], s[5], s[6], s[7]} * (1.f / BLK); }
    }
}
__device__ __forceinline__ void mobasel_phase(const Frame& F, const bf16_t* PROJ, const float* KM, unsigned* SEL) {
    int tid_ = F.tid; asm volatile("" : "+v"(tid_));
    const int TPW = T / F.G, row0 = (int)blockIdx.x * TPW, b = row0 / SEQ, own = (row0 % SEQ) / BLK, hs = own * 64 + 4;
    LAS float* km = (LAS float*)F.lds;
    for (int i = tid_; i < 8 * own * 16; i += NTHR) { const int h = i / (own * 16), r = i % (own * 16);
        *(LAS f32x4*)(km + h * hs + r * 4) = *(const f32x4*)(KM + ((size_t)(b * HA + h) * NBLK) * 64 + r * 4); }
    __syncthreads();
    for (int idx = tid_; idx < TPW * 8; idx += NTHR) {
        const int h = idx & 7, row = row0 + (idx >> 3);
        const bf16_t* qp = PROJ + (size_t)row * INCP + C_QA + h * 64;
        float q[64];
#pragma unroll
        for (int i = 0; i < 8; ++i) { const u32x4 v = *(const u32x4*)(qp + i * 8);
#pragma unroll
            for (int k = 0; k < 4; ++k) { q[i * 8 + 2 * k] = bflo(v[k]); q[i * 8 + 2 * k + 1] = bfhi(v[k]); } }
        float v1 = -INFINITY, v2 = -INFINITY, v3 = -INFINITY; int i1 = -1, i2 = -1, i3 = -1;
        for (int j = 0; j < own; ++j) {
            const LAS f32x4* kp = (const LAS f32x4*)(km + h * hs + j * 64);
            float g0 = 0.f, g1 = 0.f, g2 = 0.f, g3 = 0.f;
#pragma unroll
            for (int c = 0; c < 16; ++c) { const f32x4 k4 = kp[c]; g0 = fmaf(q[4 * c], k4[0], g0); g1 = fmaf(q[4 * c + 1], k4[1], g1); g2 = fmaf(q[4 * c + 2], k4[2], g2); g3 = fmaf(q[4 * c + 3], k4[3], g3); }
            const float g = (g0 + g1) + (g2 + g3);
            if (g > v1) { v3 = v2; i3 = i2; v2 = v1; i2 = i1; v1 = g; i1 = j; }
            else if (g > v2) { v3 = v2; i3 = i2; v2 = g; i2 = j; }
            else if (g > v3) { v3 = g; i3 = j; }
        }
        unsigned m = 0;
        if (i1 >= 0) m |= 1u << i1;
        if (i2 >= 0) m |= 1u << i2;
        if (i3 >= 0) m |= 1u << i3;
        SEL[(size_t)row * 8 + h] = m;
    }
    __syncthreads();
}

template <bool SECOND>
struct EpiGate {
    const bf16_t* PROJ; bf16_t* TMP; bf16_t* MRG;
    __device__ __forceinline__ void operator()(const f32x4 (&acc)[2][2][4][2], const pg8::Unit& u, int wr, int wc, int fr, int fq) const {
        PG8_TILE_BEGIN(acc, wr, wc, fr, fq)
            const int row = u.pm * 256 + trow, col = u.pn * 256 + tcol;
            const u32x4 g = *(const u32x4*)(PROJ + (size_t)row * INCP + (SECOND ? C_GB : C_GA) + col);
            v0[0] *= bflo(g.x); v0[1] *= bfhi(g.x); v0[2] *= bflo(g.y); v0[3] *= bfhi(g.y); v1[0] *= bflo(g.z); v1[1] *= bfhi(g.z); v1[2] *= bflo(g.w); v1[3] *= bfhi(g.w);
            if (SECOND) { const u32x4 t = *(const u32x4*)(TMP + (size_t)row * DM + col);
                v0[0] += bflo(t.x); v0[1] += bfhi(t.x); v0[2] += bflo(t.y); v0[3] += bfhi(t.y); v1[0] += bflo(t.z); v1[1] += bfhi(t.z); v1[2] += bflo(t.w); v1[3] += bfhi(t.w);
                *(u32x4*)(MRG + (size_t)row * DM + col) = pg8::pack8(v0, v1); }
            else *(u32x4*)(TMP + (size_t)row * DM + col) = pg8::pack8(v0, v1);
        PG8_TILE_END
    }
};
struct EpiResid {
    const bf16_t* X; bf16_t* PRE;
    __device__ __forceinline__ void operator()(const f32x4 (&acc)[2][2][4][2], const pg8::Unit& u, int wr, int wc, int fr, int fq) const {
        PG8_TILE_BEGIN(acc, wr, wc, fr, fq)
            const size_t o = (size_t)(u.pm * 256 + trow) * DM + u.pn * 256 + tcol;
            const u32x4 x = *(const u32x4*)(X + o);
            v0[0] += ALPHA * bflo(x.x); v0[1] += ALPHA * bfhi(x.x); v0[2] += ALPHA * bflo(x.y); v0[3] += ALPHA * bfhi(x.y);
            v1[0] += ALPHA * bflo(x.z); v1[1] += ALPHA * bfhi(x.z); v1[2] += ALPHA * bflo(x.w); v1[3] += ALPHA * bfhi(x.w);
            *(u32x4*)(PRE + o) = pg8::pack8(v0, v1);
        PG8_TILE_END
    }
};
__device__ __forceinline__ void ln_phase(const Frame& F, const bf16_t* PRE, const float* g, const float* bt, bf16_t* XBo) {
    int lane_ = F.lane; asm volatile("" : "+v"(lane_));
    const int gw = F.vcu * NWAVES + F.wave, NGW = F.G * NWAVES, lane = lane_;
    for (int row = gw; row < T; row += NGW) {
        const u32x2* pr = (const u32x2*)(PRE + (size_t)row * DM) + lane;
        f32x4 v[4]; float s = 0.f;
#pragma unroll
        for (int j = 0; j < 4; ++j) { const u32x2 h = pr[64 * j]; v[j] = (f32x4){bflo(h.x), bfhi(h.x), bflo(h.y), bfhi(h.y)}; s += (v[j][0] + v[j][1]) + (v[j][2] + v[j][3]); }
        const float mean = wave_sum(s) * (1.f / DM); float s2 = 0.f;
#pragma unroll
        for (int j = 0; j < 4; ++j) { v[j] = v[j] - mean; s2 += (v[j][0] * v[j][0] + v[j][1] * v[j][1]) + (v[j][2] * v[j][2] + v[j][3] * v[j][3]); }
        const float rstd = rsqrtf(wave_sum(s2) * (1.f / DM) + LN_EPS);
#pragma unroll
        for (int j = 0; j < 4; ++j) { const f32x4 gg = ((const f32x4*)g)[lane + 64 * j], bb = ((const f32x4*)bt)[lane + 64 * j];
            const f32x4 y = v[j] * rstd * gg + bb;
            u32x2 w; w.x = pk2(y[0], y[1]); w.y = pk2(y[2], y[3]); ((u32x2*)(XBo + (size_t)row * DM))[lane + 64 * j] = w; }
    }
}

struct RowGU { int off; __device__ __forceinline__ int operator()(int n) const { return 256 * (n >> 7) + off + (n & 127); } };

struct EpiF32 {
    float* O; int ld;
    __device__ __forceinline__ void operator()(const f32x4 (&acc)[2][2][4][2], const pg8::Unit& u, int wr, int wc, int fr, int fq) const {
        PG8_TILE_BEGIN(acc, wr, wc, fr, fq)
            float* o = O + (size_t)(u.pm * 256 + trow) * ld + u.pn * 256 + tcol; *(f32x4*)o = v0; *(f32x4*)(o + 4) = v1;
        PG8_TILE_END
    }
};
struct EpiBf16 {
    bf16_t* O; int ld;
    __device__ __forceinline__ void operator()(const f32x4 (&acc)[2][2][4][2], const pg8::Unit& u, int wr, int wc, int fr, int fq) const {
        PG8_TILE_BEGIN(acc, wr, wc, fr, fq)
            *(u32x4*)(O + (size_t)(u.pm * 256 + trow) * ld + u.pn * 256 + tcol) = pg8::pack8(v0, v1);
        PG8_TILE_END
    }
};
__device__ __forceinline__ float silu_mul(float g, float u) { return g * __builtin_amdgcn_rcpf(1.f + __expf(-g)) * u; }
struct EpiSwiGLU {
    bf16_t* H; int ld;
    __device__ __forceinline__ void operator()(const f32x4 (&acc)[2][2][4][2], const pg8::Unit& u, int wr, int wc, int fr, int fq) const {
#pragma unroll
        for (int ai = 0; ai < 2; ++ai)
#pragma unroll
            for (int m = 0; m < 4; ++m) { const int row = u.r0 + ai * 128 + wr * 64 + m * 16 + fr;
                if (row < u.rend) { f32x4 h0, h1;
#pragma unroll
                    for (int i = 0; i < 4; ++i) { h0[i] = silu_mul(acc[ai][0][m][0][i], acc[ai][1][m][0][i]); h1[i] = silu_mul(acc[ai][0][m][1][i], acc[ai][1][m][1][i]); }
                    *(u32x4*)(H + (size_t)row * ld + 128 * u.pn + wc * 32 + 8 * fq) = pg8::pack8(h0, h1); } }
    }
};
struct EpiExpDown {
    bf16_t* Y; const int* ROWA;
    __device__ __forceinline__ void operator()(const f32x4 (&acc)[2][2][4][2], const pg8::Unit& u, int wr, int wc, int fr, int fq) const {
        u32x2 aw[2][4];
#pragma unroll
        for (int ai = 0; ai < 2; ++ai)
#pragma unroll
            for (int m = 0; m < 4; ++m) { const int row = min(u.r0 + ai * 128 + wr * 64 + m * 16 + fr, u.rend - 1); aw[ai][m] = *(const u32x2*)(ROWA + 2 * (size_t)row); }
#pragma unroll
        for (int ai = 0; ai < 2; ++ai)
#pragma unroll
            for (int m = 0; m < 4; ++m) { const int row = u.r0 + ai * 128 + wr * 64 + m * 16 + fr;
                if (row < u.rend) { const int a = (int)aw[ai][m].x; const float w = __uint_as_float(aw[ai][m].y);
#pragma unroll
                    for (int bj = 0; bj < 2; ++bj) *(u32x4*)(Y + (size_t)a * DM + 256 * u.pn + bj * 128 + wc * 32 + 8 * fq) = pg8::pack8(acc[ai][bj][m][0] * w, acc[ai][bj][m][1] * w); } }
    }
};
template <int NPN, bool GATHER>
struct ExpertOrder {
    const LAS int* off; const LAS int* toff; const int* rowa; int G, c; size_t strideE;
    __device__ __forceinline__ bool next(int i, pg8::Unit& u) const {
        const int L = i * G + c; if (L >= toff[256] * NPN) return false;
        const int tile = L / NPN; u.pn = L % NPN; int lo = 0, hi = 255;
        while (lo < hi) { const int mid = (lo + hi + 1) >> 1; if (toff[mid] <= tile) lo = mid; else hi = mid - 1; }
        u.e = lo; u.r0 = off[lo] + (tile - toff[lo]) * 256; u.rend = off[lo + 1]; u.pm = 0; return true;
    }
    __device__ __forceinline__ int a_row(const pg8::Unit& u, int r) const { const int rr = min(u.r0 + r, u.rend - 1); return GATHER ? (rowa[2 * rr] >> 3) : rr; }
    __device__ __forceinline__ const char* b_ptr(const pg8::Gemm& g, const pg8::Unit& u) const { return (const char*)g.Bt + (size_t)u.e * strideE + (size_t)u.pn * 256 * g.ldb * 2; }
};
__device__ __forceinline__ void expert_tables(const Frame& F, const unsigned* cnt, LAS int* off, LAS int* toff) {
    if (F.tid < 256) { off[F.tid] = (int)cnt[F.tid]; }
    __syncthreads();
    if (F.tid == 0) { int a = 0, b = 0; for (int i = 0; i < 256; ++i) { const int c = off[i]; off[i] = a; toff[i] = b; a += c; b += (c + 255) >> 8; } off[256] = a; toff[256] = b; }
    __syncthreads();
}
__device__ __forceinline__ void route_phase(const Frame& F, const float* LOGITS, const float* rbias, int* TOPE, float* TOPW, int* APOS, int* HIST, LAS int* lcnt) {
    int lane_ = F.lane; asm volatile("" : "+v"(lane_));
    const int lane = lane_, TPW = T / F.G, t0 = (int)blockIdx.x * TPW;
    if (F.tid < 256) lcnt[F.tid] = 0;
    __syncthreads();
    const f32x4 rb = *(const f32x4*)(rbias + lane * 4);
    for (int t = t0 + F.wave; t < t0 + TPW; t += NWAVES) {
        const f32x4 lg = *(const f32x4*)(LOGITS + (size_t)t * NE + lane * 4);
        const float s0 = 1.f / (1.f + expf(-lg[0])), s1 = 1.f / (1.f + expf(-lg[1])), s2 = 1.f / (1.f + expf(-lg[2])), s3 = 1.f / (1.f + expf(-lg[3]));
        float c0 = s0 + rb[0], c1 = s1 + rb[1], c2 = s2 + rb[2], c3 = s3 + rb[3];
        float a = fmaxf(c0, c1), bq = fminf(c0, c1);
        { const float hi2 = fmaxf(c2, c3), lo2 = fminf(c2, c3); const float na = fmaxf(a, hi2), nb = fmaxf(fminf(a, hi2), fmaxf(bq, lo2)); a = na; bq = nb; }
#pragma unroll
        for (int o = 1; o < 8; o <<= 1) { const float oa = __shfl_xor(a, o), ob = __shfl_xor(bq, o); const float na = fmaxf(a, oa), nb = fmaxf(fminf(a, oa), fmaxf(bq, ob)); a = na; bq = nb; }
        const float gs = a + bq; const int grp = lane >> 3;
        int rank = 0;
#pragma unroll
        for (int j = 0; j < 8; ++j) { const float og = __shfl(gs, j * 8); rank += (og > gs || (og == gs && j < grp)) ? 1 : 0; }
        if (rank >= 4) { c0 = c1 = c2 = c3 = -INFINITY; }
        float wsum = 0.f, myw = 0.f; int mye = 0;
#pragma unroll
        for (int k = 0; k < TOPK; ++k) {
            float bv = c0; int bi = 0;
            if (c1 > bv) { bv = c1; bi = 1; }
            if (c2 > bv) { bv = c2; bi = 2; }
            if (c3 > bv) { bv = c3; bi = 3; }
            int be = lane * 4 + bi;
#pragma unroll
            for (int o = 1; o < 64; o <<= 1) { const float ov = __shfl_xor(bv, o); const int oe = __shfl_xor(be, o); if (ov > bv || (ov == bv && oe < be)) { bv = ov; be = oe; } }
            float sc = 0.f;
            if ((be >> 2) == lane) { const int b2 = be & 3; sc = b2 == 0 ? s0 : b2 == 1 ? s1 : b2 == 2 ? s2 : s3; if (b2 == 0) c0 = -INFINITY; else if (b2 == 1) c1 = -INFINITY; else if (b2 == 2) c2 = -INFINITY; else c3 = -INFINITY; }
            sc = __shfl(sc, be >> 2);
            wsum += sc;
            if (lane == k) { myw = sc; mye = be; }
        }
        if (lane < TOPK) { const int aidx = t * TOPK + lane; TOPE[aidx] = mye; TOPW[aidx] = myw / wsum * 2.5f; APOS[aidx] = __hip_atomic_fetch_add(lcnt + mye, 1, __ATOMIC_RELAXED, __HIP_MEMORY_SCOPE_WORKGROUP); }
    }
    __syncthreads();
    if (F.tid < 256) HIST[(size_t)blockIdx.x * 256 + F.tid] = lcnt[F.tid];
}
__device__ __forceinline__ void combine_phase(const Frame& F, const bf16_t* X1, const bf16_t* SH, const bf16_t* Y, const float* g, const float* bt, float* Xo, bf16_t* XBo) {
    int lane_ = F.lane; asm volatile("" : "+v"(lane_));
    const int gw = F.vcu * NWAVES + F.wave, NGW = F.G * NWAVES, lane = lane_;
    for (int row = gw; row < T; row += NGW) {
        f32x4 v[4]; float s = 0.f;
#pragma unroll
        for (int j = 0; j < 4; ++j) { const u32x2 x = ((const u32x2*)(X1 + (size_t)row * DM))[lane + 64 * j]; v[j] = (f32x4){bflo(x.x), bfhi(x.x), bflo(x.y), bfhi(x.y)} * ALPHA;
            const u32x2 h = ((const u32x2*)(SH + (size_t)row * DM))[lane + 64 * j]; v[j][0] += bflo(h.x); v[j][1] += bfhi(h.x); v[j][2] += bflo(h.y); v[j][3] += bfhi(h.y); }
#pragma unroll
        for (int k = 0; k < TOPK; ++k) { const u32x2* yr = (const u32x2*)(Y + ((size_t)row * TOPK + k) * DM);
#pragma unroll
            for (int j = 0; j < 4; ++j) { const u32x2 h = yr[lane + 64 * j]; v[j][0] += bflo(h.x); v[j][1] += bfhi(h.x); v[j][2] += bflo(h.y); v[j][3] += bfhi(h.y); } }
#pragma unroll
        for (int j = 0; j < 4; ++j) s += (v[j][0] + v[j][1]) + (v[j][2] + v[j][3]);
        const float mean = wave_sum(s) * (1.f / DM); float s2 = 0.f;
#pragma unroll
        for (int j = 0; j < 4; ++j) { v[j] = v[j] - mean; s2 += (v[j][0] * v[j][0] + v[j][1] * v[j][1]) + (v[j][2] * v[j][2] + v[j][3] * v[j][3]); }
        const float rstd = rsqrtf(wave_sum(s2) * (1.f / DM) + LN_EPS);
#pragma unroll
        for (int j = 0; j < 4; ++j) { const f32x4 gg = ((const f32x4*)g)[lane + 64 * j], bb = ((const f32x4*)bt)[lane + 64 * j];
            const f32x4 y = v[j] * rstd * gg + bb;
            if (Xo) ((f32x4*)(Xo + (size_t)row * DM))[lane + 64 * j] = y;
            if (XBo) { u32x2 w; w.x = pk2(y[0], y[1]); w.y = pk2(y[2], y[3]); ((u32x2*)(XBo + (size_t)row * DM))[lane + 64 * j] = w; } }
    }
}

__device__ __forceinline__ int crow(int r, int hi) { return (r & 3) + 8 * (r >> 2) + 4 * hi; }
typedef short s16x4 __attribute__((ext_vector_type(4)));
__device__ __forceinline__ s16x4 vtr(const LAS unsigned char* p) { return __builtin_bit_cast(s16x4, __builtin_amdgcn_ds_read_tr16_b64_v4i16((LAS s16x4*)p)); }
__device__ __forceinline__ float xhalf_max(float v) { auto rr = __builtin_amdgcn_permlane32_swap(__float_as_uint(v), __float_as_uint(v), false, false); return fmaxf(__uint_as_float(rr[0]), __uint_as_float(rr[1])); }
__device__ __forceinline__ float xhalf_sum(float v) { auto rr = __builtin_amdgcn_permlane32_swap(__float_as_uint(v), __float_as_uint(v), false, false); return __uint_as_float(rr[0]) + __uint_as_float(rr[1]); }

template <int DQK, bool ALIBI>
__device__ __forceinline__ void attn_tile(const LAS unsigned char* kb, int kfo, int vfo, const bf16x8 (&qf)[DQK / 16], float& m, float& l, f32x16& o0, f32x16& o1, int hi, int tq, int kpos0, float slope2, bool causal) {
    constexpr int ND0 = DQK / 16;
    bf16x8 ka[ND0], kc[ND0];
#pragma unroll
    for (int d0 = 0; d0 < ND0; ++d0) { ka[d0] = *(const LAS bf16x8*)(kb + kfo + d0 * 2048); kc[d0] = *(const LAS bf16x8*)(kb + kfo + d0 * 2048 + 512); }
    __builtin_amdgcn_sched_barrier(0);
    f32x16 p0, p1;
#pragma unroll
    for (int r = 0; r < 16; ++r) { p0[r] = 0.f; p1[r] = 0.f; }
#pragma unroll
    for (int d0 = 0; d0 < ND0; ++d0) {
        p0 = __builtin_amdgcn_mfma_f32_32x32x16_bf16(ka[d0], qf[d0], p0, 0, 0, 0);
        p1 = __builtin_amdgcn_mfma_f32_32x32x16_bf16(kc[d0], qf[d0], p1, 0, 0, 0);
    }
    s16x4 vlo[8], vhi[8];
    { const unsigned va = (unsigned)(uintptr_t)(kb + vfo);
#pragma unroll
      for (int i = 0; i < 8; ++i) {
        asm volatile("ds_read_b64_tr_b16 %0, %1 offset:%c2" : "=&v"(vlo[i]) : "v"(va), "i"((i >> 2) * 4096 + (i & 3) * 1024) : "memory");
        asm volatile("ds_read_b64_tr_b16 %0, %1 offset:%c2" : "=&v"(vhi[i]) : "v"(va), "i"((i >> 2) * 4096 + (i & 3) * 1024 + 512) : "memory"); } }
    const int krel = kpos0 + 4 * hi - tq;
    if (ALIBI) { const float bb = slope2 * (float)krel;
#pragma unroll
        for (int r = 0; r < 16; ++r) { const float c = (float)((r & 3) + 8 * (r >> 2)); p0[r] += fmaf(slope2, c, bb); p1[r] += fmaf(slope2, c + 32.f, bb); } }
    if (causal) {
#pragma unroll
        for (int r = 0; r < 16; ++r) { const int kv = krel + (r & 3) + 8 * (r >> 2); if (kv > 0) p0[r] = -INFINITY; if (kv + 32 > 0) p1[r] = -INFINITY; } }
    float rm = fmaxf(p0[0], p1[0]);
#pragma unroll
    for (int r = 1; r < 16; ++r) rm = fmaxf(rm, fmaxf(p0[r], p1[r]));
    rm = xhalf_max(rm);
    const float mn = fmaxf(m, rm), alpha = __builtin_amdgcn_exp2f(m - mn);
    m = mn;
    float ls = 0.f;
#pragma unroll
    for (int r = 0; r < 16; ++r) { p0[r] = __builtin_amdgcn_exp2f(p0[r] - mn); p1[r] = __builtin_amdgcn_exp2f(p1[r] - mn); ls += p0[r] + p1[r]; }
    l = l * alpha + ls;
#pragma unroll
    for (int r = 0; r < 16; ++r) { o0[r] *= alpha; o1[r] *= alpha; }
    const u32x4 pw0 = (u32x4){pg8::cvt_pk_bf16(p0[0], p0[1]), pg8::cvt_pk_bf16(p0[2], p0[3]), pg8::cvt_pk_bf16(p0[4], p0[5]), pg8::cvt_pk_bf16(p0[6], p0[7])};
    const u32x4 pw1 = (u32x4){pg8::cvt_pk_bf16(p0[8], p0[9]), pg8::cvt_pk_bf16(p0[10], p0[11]), pg8::cvt_pk_bf16(p0[12], p0[13]), pg8::cvt_pk_bf16(p0[14], p0[15])};
    const u32x4 pw2 = (u32x4){pg8::cvt_pk_bf16(p1[0], p1[1]), pg8::cvt_pk_bf16(p1[2], p1[3]), pg8::cvt_pk_bf16(p1[4], p1[5]), pg8::cvt_pk_bf16(p1[6], p1[7])};
    const u32x4 pw3 = (u32x4){pg8::cvt_pk_bf16(p1[8], p1[9]), pg8::cvt_pk_bf16(p1[10], p1[11]), pg8::cvt_pk_bf16(p1[12], p1[13]), pg8::cvt_pk_bf16(p1[14], p1[15])};
    asm volatile("s_waitcnt lgkmcnt(0)" ::: "memory"); __builtin_amdgcn_sched_barrier(0);
#define ATT_VF(i) (bf16x8){vlo[i][0], vlo[i][1], vlo[i][2], vlo[i][3], vhi[i][0], vhi[i][1], vhi[i][2], vhi[i][3]}
    o0 = __builtin_amdgcn_mfma_f32_32x32x16_bf16(ATT_VF(0), __builtin_bit_cast(bf16x8, pw0), o0, 0, 0, 0);
    o1 = __builtin_amdgcn_mfma_f32_32x32x16_bf16(ATT_VF(4), __builtin_bit_cast(bf16x8, pw0), o1, 0, 0, 0);
    o0 = __builtin_amdgcn_mfma_f32_32x32x16_bf16(ATT_VF(1), __builtin_bit_cast(bf16x8, pw1), o0, 0, 0, 0);
    o1 = __builtin_amdgcn_mfma_f32_32x32x16_bf16(ATT_VF(5), __builtin_bit_cast(bf16x8, pw1), o1, 0, 0, 0);
    o0 = __builtin_amdgcn_mfma_f32_32x32x16_bf16(ATT_VF(2), __builtin_bit_cast(bf16x8, pw2), o0, 0, 0, 0);
    o1 = __builtin_amdgcn_mfma_f32_32x32x16_bf16(ATT_VF(6), __builtin_bit_cast(bf16x8, pw2), o1, 0, 0, 0);
    o0 = __builtin_amdgcn_mfma_f32_32x32x16_bf16(ATT_VF(3), __builtin_bit_cast(bf16x8, pw3), o0, 0, 0, 0);
    o1 = __builtin_amdgcn_mfma_f32_32x32x16_bf16(ATT_VF(7), __builtin_bit_cast(bf16x8, pw3), o1, 0, 0, 0);
#undef ATT_VF
}
#define ATT_ISSUE(t, bo) do { \
        for (int c_ = wid; c_ < NCH; c_ += 8) __builtin_amdgcn_global_load_lds((const unsigned*)(ksrc + (size_t)(t) * 64 * ldk + c_ * 8), (LAS unsigned*)(lds + (bo) + c_ * 1024), 16, 0, 0); \
        __builtin_amdgcn_global_load_lds((const unsigned*)(vsrc + (size_t)(t) * 64 * ldv), (LAS unsigned*)(lds + (bo) + KBYTES + wid * 1024), 16, 0, 0); } while (0)

template <int DQK, bool MOBA_OWN>
__device__ __forceinline__ void attn_unit(LAS unsigned char* lds, int b, int h, int qb, const bf16_t* Qp, int ldq, const bf16_t* Kp, int ldk, const bf16_t* Vp, int ldv, bf16_t* Op, int ldo, const bf16_t* PO, const f32x2* PML) {
    constexpr int NCH = DQK / 8, KBYTES = NCH * 1024, BUFB = KBYTES + 8192, ND0 = DQK / 16;
    int tid_ = threadIdx.x; asm volatile("" : "+v"(tid_));
    const int lane = tid_ & 63, r32 = lane & 31, hi = lane >> 5, wid = __builtin_amdgcn_readfirstlane(tid_ >> 6);
    const size_t rowbase = (size_t)b * SEQ; const int q0 = qb * 256, T0 = MOBA_OWN ? 4 * qb : 0, T1 = 4 * (qb + 1), tq = q0 + wid * 32 + r32;
    const bf16_t* ksrc = Kp + (rowbase + lane) * ldk + h * DQK;
    const bf16_t* vsrc = Vp + (rowbase + 16 * (wid & 3) + (lane >> 2)) * ldv + h * 64 + (wid >> 2) * 32 + (lane & 3) * 8;
    ATT_ISSUE(T0, 0);
    bf16x8 qf[ND0];
    { const bf16_t* qrow = Qp + (rowbase + tq) * ldq + h * DQK + hi * 8;
#pragma unroll
      for (int d0 = 0; d0 < ND0; ++d0) qf[d0] = *(const bf16x8*)(qrow + d0 * 16); }
    const float slope2 = MOBA_OWN ? exp2f(-(float)(h + 1)) * LOG2E : 0.f;
    float m = -1e30f, l = 0.f;
    f32x16 o0, o1;
#pragma unroll
    for (int r = 0; r < 16; ++r) { o0[r] = 0.f; o1[r] = 0.f; }
    const int kfo = hi * 1024 + r32 * 16;
    const int vfo = KBYTES + ((lane >> 4) & 1) * 32 + (lane & 3) * 8 + (4 * hi + ((lane & 15) >> 2)) * 64;
#pragma unroll 1
    for (int t = T0; t < T1; ++t) {
        asm volatile("s_waitcnt vmcnt(0) lgkmcnt(0)\n\ts_barrier" ::: "memory");
        if (t + 1 < T1) ATT_ISSUE(t + 1, ((t + 1) & 1) * BUFB);
        attn_tile<DQK, MOBA_OWN>(lds + (t & 1) * BUFB, kfo, vfo, qf, m, l, o0, o1, hi, tq, 64 * t, slope2, t >= T1 - 4);
    }
    float lt = xhalf_sum(l);
    if (MOBA_OWN) {
        const int nsel = qb < 3 ? qb : 3;
        const size_t pidx = ((rowbase + tq) * 8 + h) * 3;
        float ms[3], ws[3], M = m;
#pragma unroll
        for (int sIdx = 0; sIdx < 3; ++sIdx) { ms[sIdx] = -1e30f; ws[sIdx] = 0.f; if (sIdx < nsel) { const f32x2 ml = PML[(pidx + sIdx) * 16]; ms[sIdx] = ml[0]; ws[sIdx] = ml[1]; M = fmaxf(M, ml[0]); } }
        const float w0 = __builtin_amdgcn_exp2f(m - M);
        lt *= w0;
#pragma unroll
        for (int r = 0; r < 16; ++r) { o0[r] *= w0; o1[r] *= w0; }
#pragma unroll
        for (int sIdx = 0; sIdx < 3; ++sIdx) if (sIdx < nsel) {
            const float w = ws[sIdx] * __builtin_amdgcn_exp2f(ms[sIdx] - M); lt += w;
            const bf16_t* po = PO + (pidx + sIdx) * 64 + 4 * hi;
#pragma unroll
            for (int r4 = 0; r4 < 4; ++r4) { const u32x2 a = *(const u32x2*)(po + 8 * r4), c = *(const u32x2*)(po + 32 + 8 * r4);
                o0[4 * r4] += w * bflo(a.x); o0[4 * r4 + 1] += w * bfhi(a.x); o0[4 * r4 + 2] += w * bflo(a.y); o0[4 * r4 + 3] += w * bfhi(a.y);
                o1[4 * r4] += w * bflo(c.x); o1[4 * r4 + 1] += w * bfhi(c.x); o1[4 * r4 + 2] += w * bflo(c.y); o1[4 * r4 + 3] += w * bfhi(c.y); } }
    }
    const float inv = 1.f / lt;
    bf16_t* orow = Op + (rowbase + tq) * ldo + h * 64 + 4 * hi;
#pragma unroll
    for (int r4 = 0; r4 < 4; ++r4) {
        u32x2 w0_, w1_;
        w0_.x = pg8::cvt_pk_bf16(o0[4 * r4] * inv, o0[4 * r4 + 1] * inv); w0_.y = pg8::cvt_pk_bf16(o0[4 * r4 + 2] * inv, o0[4 * r4 + 3] * inv);
        w1_.x = pg8::cvt_pk_bf16(o1[4 * r4] * inv, o1[4 * r4 + 1] * inv); w1_.y = pg8::cvt_pk_bf16(o1[4 * r4 + 2] * inv, o1[4 * r4 + 3] * inv);
        *(u32x2*)(orow + 8 * r4) = w0_; *(u32x2*)(orow + 32 + 8 * r4) = w1_;
    }
    asm volatile("s_waitcnt lgkmcnt(0)\n\ts_barrier" ::: "memory");
}
__device__ __forceinline__ void moba_sel_unit(LAS unsigned char* lds, int b, int h, int j, int slo, int shi, const bf16_t* Qp, const bf16_t* Kp, const bf16_t* Vp, int ldk, const unsigned* SEL, bf16_t* PO, f32x2* PML) {
    constexpr int DQK = 64, NCH = 8, KBYTES = 8192, BUFB = 16384, ldv = INCP; (void)ldv;
    int tid_ = threadIdx.x; asm volatile("" : "+v"(tid_));
    const int lane = tid_ & 63, r32 = lane & 31, hi = lane >> 5, wid = __builtin_amdgcn_readfirstlane(tid_ >> 6);
    const size_t rowbase = (size_t)b * SEQ;
    const bf16_t* ksrc = Kp + (rowbase + lane) * ldk + h * DQK;
    const bf16_t* vsrc = Vp + (rowbase + 16 * (wid & 3) + (lane >> 2)) * ldk + h * 64 + (wid >> 2) * 32 + (lane & 3) * 8;
#pragma unroll
    for (int tt = 0; tt < 4; ++tt) ATT_ISSUE(4 * j + tt, tt * BUFB);
    LAS unsigned short* list = (LAS unsigned short*)(lds + 4 * BUFB);
    LAS int* cnt = (LAS int*)(lds + 4 * BUFB + 4096);
    if (tid_ == 0) *cnt = 0;
    __syncthreads();
    const int nsrc = (shi - slo) * 256;
    for (int i = tid_; i < nsrc; i += NTHR) {
        const unsigned sm = SEL[(rowbase + (size_t)slo * 256 + i) * 8 + h];
        const bool f = ((sm >> j) & 1u) != 0u;
        const unsigned long long bal = __ballot(f);
        const int rank = __builtin_amdgcn_mbcnt_hi((unsigned)(bal >> 32), __builtin_amdgcn_mbcnt_lo((unsigned)bal, 0u));
        int base = 0;
        if (lane == 0) base = __hip_atomic_fetch_add(cnt, (int)__builtin_popcountll(bal), __ATOMIC_RELAXED, __HIP_MEMORY_SCOPE_WORKGROUP);
        base = __builtin_amdgcn_readfirstlane(base);
        if (f) list[base + rank] = (unsigned short)i;
    }
    asm volatile("s_waitcnt vmcnt(0)" ::: "memory");
    __syncthreads();
    const int n = *cnt, nch = (n + 31) >> 5;
    const float slope2 = exp2f(-(float)(h + 1)) * LOG2E;
    const int kfo = hi * 1024 + r32 * 16;
    const int vfo = KBYTES + ((lane >> 4) & 1) * 32 + (lane & 3) * 8 + (4 * hi + ((lane & 15) >> 2)) * 64;
    for (int ch = wid; ch < nch; ch += 8) {
        const int e = ch * 32 + r32; const bool valid = e < n;
        const int tq = slo * 256 + (int)list[valid ? e : n - 1];
        bf16x8 qf[4];
        { const bf16_t* qrow = Qp + (rowbase + tq) * INCP + h * DQK + hi * 8;
#pragma unroll
          for (int d0 = 0; d0 < 4; ++d0) qf[d0] = *(const bf16x8*)(qrow + d0 * 16); }
        const unsigned sm = SEL[(rowbase + tq) * 8 + h];
        float m = -1e30f, l = 0.f;
        f32x16 o0, o1;
#pragma unroll
        for (int r = 0; r < 16; ++r) { o0[r] = 0.f; o1[r] = 0.f; }
#pragma unroll 1
        for (int tt = 0; tt < 4; ++tt) attn_tile<64, true>(lds + tt * BUFB, kfo, vfo, qf, m, l, o0, o1, hi, tq, 256 * j + 64 * tt, slope2, false);
        const float lt = xhalf_sum(l), inv = 1.f / lt;
        if (valid) {
            const size_t pidx = ((rowbase + tq) * 8 + h) * 3 + __builtin_popcount(sm & ((1u << j) - 1u));
            if (hi == 0) PML[pidx * 16] = (f32x2){m, lt};
            bf16_t* po = PO + pidx * 64 + 4 * hi;
#pragma unroll
            for (int r4 = 0; r4 < 4; ++r4) {
                u32x2 w0_, w1_;
                w0_.x = pg8::cvt_pk_bf16(o0[4 * r4] * inv, o0[4 * r4 + 1] * inv); w0_.y = pg8::cvt_pk_bf16(o0[4 * r4 + 2] * inv, o0[4 * r4 + 3] * inv);
                w1_.x = pg8::cvt_pk_bf16(o1[4 * r4] * inv, o1[4 * r4 + 1] * inv); w1_.y = pg8::cvt_pk_bf16(o1[4 * r4 + 2] * inv, o1[4 * r4 + 3] * inv);
                *(u32x2*)(po + 8 * r4) = w0_; *(u32x2*)(po + 32 + 8 * r4) = w1_;
            }
        }
    }
    __syncthreads();
}
#undef ATT_ISSUE
__device__ __forceinline__ void mla_phase(const Frame& F, const bf16_t* QB, const bf16_t* KB, const bf16_t* VB, bf16_t* Op) {
    for (int u = 2 * F.vcu; u < 512; u += 2 * F.G) {
#pragma unroll 1
        for (int k = 0; k < 2; ++k) { const int uu = u + k, bh = uu >> 5, w = uu & 31, qb = (w & 1) ? (w >> 1) : 31 - (w >> 1);
            attn_unit<96, false>(F.lds, bh >> 3, bh & 7, qb, QB, 768, KB, 768, VB, 512, Op, 1024, nullptr, nullptr); }
    }
}
__device__ __forceinline__ void moba_sel_phase(const Frame& F, const bf16_t* PROJ, const unsigned* SEL, bf16_t* PO, f32x2* PML) {
    const bool xl = (F.G == 256);
    const int v = xl ? (F.vcu & 31) : (int)blockIdx.x, step = xl ? 32 : F.G, nloc = xl ? 272 : 16 * 136, x2 = xl ? 2 * (F.vcu >> 5) : 0;
#pragma unroll 1
    for (int idx = v; idx < nloc; idx += step) {
        const int pj = xl ? (idx >> 1) : (idx >> 4), bh = xl ? x2 + (idx & 1) : (idx & 15);
        int p = 0; while (2 * (p + 1) * (p + 1) + (p + 1) <= pj) ++p;
        const int j = pj - (2 * p * p + p);
        const int slo = (j + 1 > 4 * p) ? j + 1 : 4 * p, shi = 4 * p + 4;
        moba_sel_unit(F.lds, bh >> 3, bh & 7, j, slo, shi, PROJ + C_QA, PROJ + C_KA, PROJ + C_VA, INCP, SEL, PO, PML);
    }
}
__device__ __forceinline__ void moba_own_phase(const Frame& F, const bf16_t* PROJ, bf16_t* Op, const bf16_t* PO, const f32x2* PML) {
#pragma unroll 1
    for (int u = F.vcu; u < 512; u += F.G) { const int bh = u >> 5, qb = u & 31;
        attn_unit<64, true>(F.lds, bh >> 3, bh & 7, qb, PROJ + C_QA, INCP, PROJ + C_KA, INCP, PROJ + C_VA, INCP, Op, 1024, PO, PML); }
}

constexpr int NPH_L = 16;
__global__ void __launch_bounds__(NTHR, 2) mk(Params p) {
    extern __shared__ __attribute__((aligned(16))) unsigned char lds_raw[];
    Frame F;
    F.lds = (LAS unsigned char*)lds_raw;
    F.tid = threadIdx.x; F.lane = F.tid & 63; F.wave = __builtin_amdgcn_readfirstlane(F.tid >> 6);
    F.G = gridDim.x; { const int bx = blockIdx.x; F.vcu = (F.G % 8 == 0) ? (bx % 8) * (F.G / 8) + bx / 8 : bx; }
    volatile LAS unsigned* MISC = (volatile LAS unsigned*)(F.lds + MISC_OFF);
    if (F.tid < 32) MISC[F.tid] = 0u;
    __syncthreads();
    unsigned char* ws = p.ws;
    unsigned* ctl = (unsigned*)(ws + WS_CTL);
    XcdBarrier bar = xcd_barrier_post(ctl + CW_BAR, MISC + 8);
    const int lo = p.ph_lo, hi = p.ph_hi;
#define IN(k) (lo <= (k) && (k) < hi)
#define SEAM(k) do { if (IN(k) && IN((k) + 1)) xcd_barrier(bar); } while (0)
    bf16_t* WinT = (bf16_t*)(ws + WS_WIN);
    bf16_t* XB = (bf16_t*)(ws + WS_XB);
    bf16_t* PROJ = (bf16_t*)(ws + WS_PROJ);
    bf16_t* WuqT = (bf16_t*)(ws + WS_WUQ); bf16_t* WukvT = (bf16_t*)(ws + WS_WUKV);
    f32x2* CS = (f32x2*)(ws + WS_CS); float* KM = (float*)(ws + WS_KM); unsigned* SEL = (unsigned*)(ws + WS_SEL);
    bf16_t* CQN = (bf16_t*)(ws + WS_CQN); bf16_t* CKVN = (bf16_t*)(ws + WS_CKVN);
    bf16_t* WpaT = (bf16_t*)(ws + WS_WPA); bf16_t* WpbT = (bf16_t*)(ws + WS_WPB); bf16_t* WoutT = (bf16_t*)(ws + WS_WOUT);
    bf16_t* TMP = (bf16_t*)(ws + WS_TMP); bf16_t* MRG = (bf16_t*)(ws + WS_MRG); bf16_t* PRE = (bf16_t*)(ws + WS_PRE); bf16_t* X1B = (bf16_t*)(ws + WS_X1B);
    bf16_t* WrtT = (bf16_t*)(ws + WS_WRT); bf16_t* WsguT = (bf16_t*)(ws + WS_WSGU); bf16_t* WsdT = (bf16_t*)(ws + WS_WSD); bf16_t* WeguT = (bf16_t*)(ws + WS_WEGU); bf16_t* WedT = (bf16_t*)(ws + WS_WED);
    float* LOGITS = (float*)(ws + WS_LOG); bf16_t* HS = (bf16_t*)(ws + WS_HS); bf16_t* SH = (bf16_t*)(ws + WS_SH);
    int* TOPE = (int*)(ws + WS_TOPE); float* TOPW = (float*)(ws + WS_TOPW); int* APOS = (int*)(ws + WS_APOS); int* ROWA = (int*)(ws + WS_ROWA);
    bf16_t* PO = (bf16_t*)(ws + WS_PO); f32x2* PML = (f32x2*)(ws + WS_PML);
    bf16_t* HE = (bf16_t*)(ws + WS_HE); bf16_t* Yb = (bf16_t*)(ws + WS_Y); int* HIST = (int*)(ws + WS_HIST);
    LAS int* t_off = (LAS int*)(F.lds + TAB_OFF); LAS int* t_toff = t_off + 260;
    bf16_t* QB = (bf16_t*)(ws + WS_QB); bf16_t* KB = (bf16_t*)(ws + WS_KB); bf16_t* VB = (bf16_t*)(ws + WS_VB); bf16_t* OAB = (bf16_t*)(ws + WS_OAB);
    const int gw = F.vcu * NWAVES + F.wave, NGW = F.G * NWAVES;

    if (IN(0)) {
        LAS float* scr = (LAS float*)(F.lds + F.wave * 16384);
        constexpr int I_IN = (DM / 64) * (INC / 32);
        for (int it = gw; it < DEPTH * I_IN; it += NGW) { const int l = it / I_IN, r = it % I_IN;
            transpose_item(p.in[1] + (size_t)l * DM * INC, DM, INC, WinT + (size_t)l * SZ_WIN, DM, RowId{}, scr, r, F.lane); }
        { constexpr int I_UQ = (QL / 64) * (768 / 32), I_UKV = (KVL / 64) * (1024 / 32);
          for (int it = gw; it < DEPTH * (I_UQ + I_UKV); it += NGW) { const int l = it / (I_UQ + I_UKV), r = it % (I_UQ + I_UKV);
            if (r < I_UQ) transpose_item(p.in[4] + (size_t)l * QL * 768, QL, 768, WuqT + (size_t)l * SZ_WUQ, QL, RowQ{}, scr, r, F.lane);
            else transpose_item(p.in[6] + (size_t)l * KVL * 1024, KVL, 1024, WukvT + (size_t)l * SZ_WUKV, KVL, RowId{}, scr, r - I_UQ, F.lane); } }
        { constexpr int I_P = (512 / 64) * (DM / 32), I_O = (DM / 64) * (DM / 32), I_ALL = 2 * I_P + I_O;
          for (int it = gw; it < DEPTH * I_ALL; it += NGW) { const int l = it / I_ALL; int r = it % I_ALL;
            if (r < I_P) { transpose_item(p.in[7] + (size_t)l * 512 * DM, 512, DM, WpaT + (size_t)l * SZ_WP, 512, RowId{}, scr, r, F.lane); continue; } r -= I_P;
            if (r < I_P) { transpose_item(p.in[8] + (size_t)l * 512 * DM, 512, DM, WpbT + (size_t)l * SZ_WP, 512, RowId{}, scr, r, F.lane); continue; } r -= I_P;
            transpose_item(p.in[9] + (size_t)l * DM * DM, DM, DM, WoutT + (size_t)l * SZ_WOUT, DM, RowId{}, scr, r, F.lane); } }
        { constexpr int I_R = (DM / 64) * (NE / 32), I_G = (DM / 64) * (DSH / 32), I_D = (DSH / 64) * (DM / 32), I_ALL = I_R + 2 * I_G + I_D;
          for (int it = gw; it < DEPTH * I_ALL; it += NGW) { const int l = it / I_ALL; int r = it % I_ALL;
            if (r < I_R) { transpose_item(p.in[12] + (size_t)l * DM * NE, DM, NE, WrtT + (size_t)l * SZ_WRT, DM, RowId{}, scr, r, F.lane); continue; } r -= I_R;
            if (r < I_G) { transpose_item(p.in[17] + (size_t)l * DM * DSH, DM, DSH, WsguT + (size_t)l * SZ_WSGU, DM, RowGU{0}, scr, r, F.lane); continue; } r -= I_G;
            if (r < I_G) { transpose_item(p.in[18] + (size_t)l * DM * DSH, DM, DSH, WsguT + (size_t)l * SZ_WSGU, DM, RowGU{128}, scr, r, F.lane); continue; } r -= I_G;
            transpose_item(p.in[19] + (size_t)l * DSH * DM, DSH, DM, WsdT + (size_t)l * SZ_WSD, DSH, RowId{}, scr, r, F.lane); } }
        { constexpr int I_G = (DM / 64) * (DE / 64), I_D = (DE / 64) * (DM / 64), I_E = 2 * I_G + I_D;
          LAS unsigned short* scr16 = (LAS unsigned short*)(F.lds + F.wave * 16384);
          for (int it = gw; it < DEPTH * NE * I_E; it += NGW) { const int le = it / I_E; int r = it % I_E;
            if (r < I_G) { transpose_item64(p.in[14] + (size_t)le * DM * DE, DM, DE, WeguT + (size_t)le * 512 * DM, DM, RowGU{0}, scr16, r, F.lane); continue; } r -= I_G;
            if (r < I_G) { transpose_item64(p.in[15] + (size_t)le * DM * DE, DM, DE, WeguT + (size_t)le * 512 * DM, DM, RowGU{128}, scr16, r, F.lane); continue; } r -= I_G;
            transpose_item64(p.in[16] + (size_t)le * DE * DM, DE, DM, WedT + (size_t)le * DM * DE, DE, RowId{}, scr16, r, F.lane); } }
        for (int i = blockIdx.x * NTHR + F.tid; i < SEQ * 16; i += F.G * NTHR) { const int pos = i >> 4, k = i & 15;
            const float inv = powf(10000.f, -(float)(2 * k) / 32.f), ang = (float)pos * inv; CS[i] = (f32x2){cosf(ang), sinf(ang)}; }
        for (int i = blockIdx.x * NTHR + F.tid; i < DEPTH * 12288; i += F.G * NTHR) { const int l = i / 12288, r = i % 12288;
            *(u32x4*)(WinT + (size_t)l * SZ_WIN + (size_t)INC * DM + (size_t)r * 8) = (u32x4){0u, 0u, 0u, 0u}; }
        for (int i = blockIdx.x * NTHR + F.tid; i < T * DM / 8; i += F.G * NTHR) { const f32x4 a = *(const f32x4*)(p.in[0] + (size_t)i * 8), b = *(const f32x4*)(p.in[0] + (size_t)i * 8 + 4);
            u32x4 w; w.x = pk2(a[0], a[1]); w.y = pk2(a[2], a[3]); w.z = pk2(b[0], b[1]); w.w = pk2(b[2], b[3]); *(u32x4*)(XB + (size_t)i * 8) = w; }
    }
    SEAM(0);

    {
        const int l = 0; const int pb = 1 + l * NPH_L;
        if (IN(pb + 0)) {
            pg8::Gemm g{XB, WinT + (size_t)l * SZ_WIN, T, INCP, DM, DM, DM}; pg8::StaticOrder S; S.init(T, INCP, F.G, (int)blockIdx.x);
            EpiProj E{PROJ, p.in[2] + (size_t)l * 2 * DM};
            pg8::gemm_phase<EpiProj, pg8::StaticOrder, true>(F.lds, g, S, E);
        }
        SEAM(pb + 0);
        if (IN(pb + 1)) prep_phase(F, PROJ, p.in[3] + (size_t)l * QL, p.in[5] + (size_t)l * KVL, CS, CQN, CKVN, KB, KM);
        SEAM(pb + 1);
        if (IN(pb + 2)) {
            mobasel_phase(F, PROJ, KM, SEL);
            { pg8::Gemm g{CKVN, WukvT + (size_t)l * SZ_WUKV, T, 1024, KVL, KVL, KVL}; pg8::StaticOrder S; S.init(T, 1024, F.G, (int)blockIdx.x);
              EpiKV E{KB, VB}; pg8::gemm_phase<EpiKV, pg8::StaticOrder, true>(F.lds, g, S, E); }
            { pg8::Gemm g{CQN, WuqT + (size_t)l * SZ_WUQ, T, 768, QL, QL, QL}; pg8::StaticOrder S; S.init(T, 768, F.G, (int)blockIdx.x);
              EpiQ E{QB, CS}; pg8::gemm_phase<EpiQ, pg8::StaticOrder, true>(F.lds, g, S, E); }
        }
        SEAM(pb + 2);
        if (IN(pb + 3)) {
            mla_phase(F, QB, KB, VB, OAB + 512);
            moba_sel_phase(F, PROJ, SEL, PO, PML);
        }
        SEAM(pb + 3);
        if (IN(pb + 4)) moba_own_phase(F, PROJ, OAB, PO, PML);
        SEAM(pb + 4);
        if (IN(pb + 5)) {
            { pg8::Gemm g{OAB, WpaT + (size_t)l * SZ_WP, T, DM, 512, 1024, 512}; pg8::StaticOrder S; S.init(T, DM, F.G, (int)blockIdx.x);
              EpiGate<false> E{PROJ, TMP, MRG}; pg8::gemm_phase<EpiGate<false>, pg8::StaticOrder, true>(F.lds, g, S, E); }
            { pg8::Gemm g{OAB + 512, WpbT + (size_t)l * SZ_WP, T, DM, 512, 1024, 512}; pg8::StaticOrder S; S.init(T, DM, F.G, (int)blockIdx.x);
              EpiGate<true> E{PROJ, TMP, MRG}; pg8::gemm_phase<EpiGate<true>, pg8::StaticOrder, true>(F.lds, g, S, E); }
        }
        SEAM(pb + 5);
        if (IN(pb + 6)) {
            pg8::Gemm g{MRG, WoutT + (size_t)l * SZ_WOUT, T, DM, DM, DM, DM}; pg8::StaticOrder S; S.init(T, DM, F.G, (int)blockIdx.x);
            EpiResid E{XB, PRE}; pg8::gemm_phase<EpiResid, pg8::StaticOrder, true>(F.lds, g, S, E);
        }
        SEAM(pb + 6);
        if (IN(pb + 7)) ln_phase(F, PRE, p.in[10] + (size_t)l * DM, p.in[11] + (size_t)l * DM, X1B);
        SEAM(pb + 7);
        if (IN(pb + 8)) {
            { pg8::Gemm g{X1B, WrtT + (size_t)l * SZ_WRT, T, NE, DM, DM, DM}; pg8::StaticOrder S; S.init(T, NE, F.G, (int)blockIdx.x);
              EpiF32 E{LOGITS, NE}; pg8::gemm_phase<EpiF32, pg8::StaticOrder, true>(F.lds, g, S, E); }
            { pg8::Gemm g{X1B, WsguT + (size_t)l * SZ_WSGU, T, 512, DM, DM, DM}; pg8::StaticOrder S; S.init(T, 512, F.G, (int)((blockIdx.x + F.G / 2) % F.G));
              EpiSwiGLU E{HS, DSH}; pg8::gemm_phase<EpiSwiGLU, pg8::StaticOrder, true>(F.lds, g, S, E); }
        }
        SEAM(pb + 8);
        if (IN(pb + 9)) {
            route_phase(F, LOGITS, p.in[13] + (size_t)l * NE, TOPE, TOPW, APOS, HIST, t_off);
            pg8::Gemm g{HS, WsdT + (size_t)l * SZ_WSD, T, DM, DSH, DSH, DSH}; pg8::StaticOrder S; S.init(T, DM, F.G, (int)blockIdx.x);
            EpiBf16 E{SH, DM}; pg8::gemm_phase<EpiBf16, pg8::StaticOrder, true>(F.lds, g, S, E);
        }
        SEAM(pb + 9);
        if (IN(pb + 10)) {
            int tid_ = F.tid; asm volatile("" : "+v"(tid_));
            if (tid_ < 256) { int tot = 0, base = 0; for (int c = 0; c < F.G; ++c) { const int v = HIST[(size_t)c * 256 + tid_]; base += (c < (int)blockIdx.x) ? v : 0; tot += v; }
                t_off[tid_] = tot; t_toff[tid_] = base; if (blockIdx.x == 0) ctl[CW_CNT + l * 256 + tid_] = (unsigned)tot; }
            __syncthreads();
            if (tid_ == 0) { int a = 0; for (int i = 0; i < 256; ++i) { const int c = t_off[i]; t_off[i] = a; a += c; } }
            __syncthreads();
            const int TPW = T / F.G, a0 = (int)blockIdx.x * TPW * TOPK;
            for (int a = a0 + tid_; a < a0 + TPW * TOPK; a += NTHR) { const int e = TOPE[a]; *(u32x2*)(ROWA + 2 * (size_t)(t_off[e] + t_toff[e] + APOS[a])) = (u32x2){(unsigned)a, __float_as_uint(TOPW[a])}; }
            __syncthreads();
        }
        SEAM(pb + 10);
        if (IN(pb + 11)) {
            expert_tables(F, ctl + CW_CNT + l * 256, t_off, t_toff);
            pg8::Gemm g{X1B, WeguT + (size_t)l * SZ_WEGU, T, 512, DM, DM, DM};
            ExpertOrder<2, true> S{t_off, t_toff, ROWA, F.G, F.vcu, (size_t)512 * DM * 2};
            EpiSwiGLU E{HE, DE}; pg8::gemm_phase<EpiSwiGLU, ExpertOrder<2, true>, true>(F.lds, g, S, E);
        }
        SEAM(pb + 11);
        if (IN(pb + 12)) {
            expert_tables(F, ctl + CW_CNT + l * 256, t_off, t_toff);
            pg8::Gemm g{HE, WedT + (size_t)l * SZ_WED, NA, DM, DE, DE, DE};
            ExpertOrder<4, false> S{t_off, t_toff, ROWA, F.G, F.vcu, (size_t)DM * DE * 2};
            EpiExpDown E{Yb, ROWA}; pg8::gemm_phase<EpiExpDown, ExpertOrder<4, false>, true>(F.lds, g, S, E);
        }
        SEAM(pb + 12);
        if (IN(pb + 13)) combine_phase(F, X1B, SH, Yb, p.in[20] + (size_t)l * DM, p.in[21] + (size_t)l * DM, l == DEPTH - 1 ? p.out : (float*)nullptr, l == DEPTH - 1 ? (bf16_t*)nullptr : XB);
        SEAM(pb + 13);
    }

    {
        const int l = 1; const int pb = 1 + l * NPH_L;
        if (IN(pb + 0)) {
            pg8::Gemm g{XB, WinT + (size_t)l * SZ_WIN, T, INCP, DM, DM, DM}; pg8::StaticOrder S; S.init(T, INCP, F.G, (int)blockIdx.x);
            EpiProj E{PROJ, p.in[2] + (size_t)l * 2 * DM};
            pg8::gemm_phase<EpiProj, pg8::StaticOrder, true>(F.lds, g, S, E);
        }
        SEAM(pb + 0);
        if (IN(pb + 1)) prep_phase(F, PROJ, p.in[3] + (size_t)l * QL, p.in[5] + (size_t)l * KVL, CS, CQN, CKVN, KB, KM);
        SEAM(pb + 1);
        if (IN(pb + 2)) {
            mobasel_phase(F, PROJ, KM, SEL);
            { pg8::Gemm g{CKVN, WukvT + (size_t)l * SZ_WUKV, T, 1024, KVL, KVL, KVL}; pg8::StaticOrder S; S.init(T, 1024, F.G, (int)blockIdx.x);
              EpiKV E{KB, VB}; pg8::gemm_phase<EpiKV, pg8::StaticOrder, true>(F.lds, g, S, E); }
            { pg8::Gemm g{CQN, WuqT + (size_t)l * SZ_WUQ, T, 768, QL, QL, QL}; pg8::StaticOrder S; S.init(T, 768, F.G, (int)blockIdx.x);
              EpiQ E{QB, CS}; pg8::gemm_phase<EpiQ, pg8::StaticOrder, true>(F.lds, g, S, E); }
        }
        SEAM(pb + 2);
        if (IN(pb + 3)) {
            mla_phase(F, QB, KB, VB, OAB + 512);
            moba_sel_phase(F, PROJ, SEL, PO, PML);
        }
        SEAM(pb + 3);
        if (IN(pb + 4)) moba_own_phase(F, PROJ, OAB, PO, PML);
        SEAM(pb + 4);
        if (IN(pb + 5)) {
            { pg8::Gemm g{OAB, WpaT + (size_t)l * SZ_WP, T, DM, 512, 1024, 512}; pg8::StaticOrder S; S.init(T, DM, F.G, (int)blockIdx.x);
              EpiGate<false> E{PROJ, TMP, MRG}; pg8::gemm_phase<EpiGate<false>, pg8::StaticOrder, true>(F.lds, g, S, E); }
            { pg8::Gemm g{OAB + 512, WpbT + (size_t)l * SZ_WP, T, DM, 512, 1024, 512}; pg8::StaticOrder S; S.init(T, DM, F.G, (int)blockIdx.x);
              EpiGate<true> E{PROJ, TMP, MRG}; pg8::gemm_phase<EpiGate<true>, pg8::StaticOrder, true>(F.lds, g, S, E); }
        }
        SEAM(pb + 5);
        if (IN(pb + 6)) {
            pg8::Gemm g{MRG, WoutT + (size_t)l * SZ_WOUT, T, DM, DM, DM, DM}; pg8::StaticOrder S; S.init(T, DM, F.G, (int)blockIdx.x);
            EpiResid E{XB, PRE}; pg8::gemm_phase<EpiResid, pg8::StaticOrder, true>(F.lds, g, S, E);
        }
        SEAM(pb + 6);
        if (IN(pb + 7)) ln_phase(F, PRE, p.in[10] + (size_t)l * DM, p.in[11] + (size_t)l * DM, X1B);
        SEAM(pb + 7);
        if (IN(pb + 8)) {
            { pg8::Gemm g{X1B, WrtT + (size_t)l * SZ_WRT, T, NE, DM, DM, DM}; pg8::StaticOrder S; S.init(T, NE, F.G, (int)blockIdx.x);
              EpiF32 E{LOGITS, NE}; pg8::gemm_phase<EpiF32, pg8::StaticOrder, true>(F.lds, g, S, E); }
            { pg8::Gemm g{X1B, WsguT + (size_t)l * SZ_WSGU, T, 512, DM, DM, DM}; pg8::StaticOrder S; S.init(T, 512, F.G, (int)((blockIdx.x + F.G / 2) % F.G));
              EpiSwiGLU E{HS, DSH}; pg8::gemm_phase<EpiSwiGLU, pg8::StaticOrder, true>(F.lds, g, S, E); }
        }
        SEAM(pb + 8);
        if (IN(pb + 9)) {
            route_phase(F, LOGITS, p.in[13] + (size_t)l * NE, TOPE, TOPW, APOS, HIST, t_off);
            pg8::Gemm g{HS, WsdT + (size_t)l * SZ_WSD, T, DM, DSH, DSH, DSH}; pg8::StaticOrder S; S.init(T, DM, F.G, (int)blockIdx.x);
            EpiBf16 E{SH, DM}; pg8::gemm_phase<EpiBf16, pg8::StaticOrder, true>(F.lds, g, S, E);
        }
        SEAM(pb + 9);
        if (IN(pb + 10)) {
            int tid_ = F.tid; asm volatile("" : "+v"(tid_));
            if (tid_ < 256) { int tot = 0, base = 0; for (int c = 0; c < F.G; ++c) { const int v = HIST[(size_t)c * 256 + tid_]; base += (c < (int)blockIdx.x) ? v : 0; tot += v; }
                t_off[tid_] = tot; t_toff[tid_] = base; if (blockIdx.x == 0) ctl[CW_CNT + l * 256 + tid_] = (unsigned)tot; }
            __syncthreads();
            if (tid_ == 0) { int a = 0; for (int i = 0; i < 256; ++i) { const int c = t_off[i]; t_off[i] = a; a += c; } }
            __syncthreads();
            const int TPW = T / F.G, a0 = (int)blockIdx.x * TPW * TOPK;
            for (int a = a0 + tid_; a < a0 + TPW * TOPK; a += NTHR) { const int e = TOPE[a]; *(u32x2*)(ROWA + 2 * (size_t)(t_off[e] + t_toff[e] + APOS[a])) = (u32x2){(unsigned)a, __float_as_uint(TOPW[a])}; }
            __syncthreads();
        }
        SEAM(pb + 10);
        if (IN(pb + 11)) {
            expert_tables(F, ctl + CW_CNT + l * 256, t_off, t_toff);
            pg8::Gemm g{X1B, WeguT + (size_t)l * SZ_WEGU, T, 512, DM, DM, DM};
            ExpertOrder<2, true> S{t_off, t_toff, ROWA, F.G, F.vcu, (size_t)512 * DM * 2};
            EpiSwiGLU E{HE, DE}; pg8::gemm_phase<EpiSwiGLU, ExpertOrder<2, true>, true>(F.lds, g, S, E);
        }
        SEAM(pb + 11);
        if (IN(pb + 12)) {
            expert_tables(F, ctl + CW_CNT + l * 256, t_off, t_toff);
            pg8::Gemm g{HE, WedT + (size_t)l * SZ_WED, NA, DM, DE, DE, DE};
            ExpertOrder<4, false> S{t_off, t_toff, ROWA, F.G, F.vcu, (size_t)DM * DE * 2};
            EpiExpDown E{Yb, ROWA}; pg8::gemm_phase<EpiExpDown, ExpertOrder<4, false>, true>(F.lds, g, S, E);
        }
        SEAM(pb + 12);
        if (IN(pb + 13)) combine_phase(F, X1B, SH, Yb, p.in[20] + (size_t)l * DM, p.in[21] + (size_t)l * DM, l == DEPTH - 1 ? p.out : (float*)nullptr, l == DEPTH - 1 ? (bf16_t*)nullptr : XB);
        SEAM(pb + 13);
    }

#undef IN
#undef SEAM
}

__global__ void __launch_bounds__(256) cvt_proj(const bf16_t* __restrict__ P, float* proj) {
    const size_t i = (size_t)blockIdx.x * 256 + threadIdx.x;
    const int row = (int)(i / INC), c = (int)(i % INC);
    float v = bf2f(P[(size_t)row * INCP + c]);
    if (c < C_KA) v *= (1.f / QS_A);
    proj[i] = v;
}
__global__ void __launch_bounds__(256) cvt_oab(const bf16_t* __restrict__ OAB, float* oa, float* ob) {
    const size_t i = (size_t)blockIdx.x * 256 + threadIdx.x; const size_t row = i >> 10; const int c = (int)(i & 1023);
    const float v = bf2f(OAB[i]);
    if (c < 512) oa[row * 512 + c] = v; else ob[row * 512 + c - 512] = v;
}
__global__ void __launch_bounds__(256) cvt_x(const float* __restrict__ x, bf16_t* XB) {
    const size_t i = (size_t)blockIdx.x * 256 + threadIdx.x;
    const f32x4 a = *(const f32x4*)(x + i * 8), b = *(const f32x4*)(x + i * 8 + 4);
    u32x4 w; w.x = pk2(a[0], a[1]); w.y = pk2(a[2], a[3]); w.z = pk2(b[0], b[1]); w.w = pk2(b[2], b[3]); *(u32x4*)(XB + i * 8) = w;
}
}
static int g_grid = 0;
static bool fast_setup() {
    if (g_grid) return g_grid > 0;
    int dev = 0, cus = 0, per_cu = 0;
    if (hipGetDevice(&dev) != hipSuccess || hipDeviceGetAttribute(&cus, hipDeviceAttributeMultiprocessorCount, dev) != hipSuccess) { g_grid = -1; return false; }
    if (hipFuncSetAttribute((const void*)fk::mk, hipFuncAttributeMaxDynamicSharedMemorySize, fk::LDS_BYTES) != hipSuccess) { fprintf(stderr, "hipFuncSetAttribute failed\n"); g_grid = -1; return false; }
    if (hipOccupancyMaxActiveBlocksPerMultiprocessor(&per_cu, (const void*)fk::mk, fk::NTHR, fk::LDS_BYTES) != hipSuccess || per_cu < 1) { fprintf(stderr, "occupancy query: %d\n", per_cu); }
    (void)hipGetLastError();
    g_grid = cus;
    if (cus > 1024 || T % cus != 0 || (T / cus) * 8 > 4096) { fprintf(stderr, "unsupported CU count %d\n", cus); g_grid = -1; return false; }
    return true;
}
static void launch_mk(fk::Params& p, int lo, int hi, hipStream_t stream) {
    p.ph_lo = lo; p.ph_hi = hi;
    hipLaunchKernelGGL(fk::mk, dim3(g_grid), dim3(fk::NTHR), fk::LDS_BYTES, stream, p);
}

extern "C" void kernel_launch(void* const* d_in, const int* in_sizes, int n_in, void* d_out, int out_size, void* d_ws, size_t ws_size, hipStream_t stream) {
    if (!fast_setup()) return;
    if (ws_size < fk::WS_NEED) { fprintf(stderr, "workspace too small: need %zu have %zu\n", (size_t)fk::WS_NEED, ws_size); return; }
    (void)hipMemsetAsync((char*)d_ws + fk::WS_CTL, 0, fk::CTL_BYTES, stream);
    fk::Params P{};
    for (int i = 0; i < 22; ++i) P.in[i] = (const float*)d_in[i];
    P.out = (float*)d_out; P.ws = (unsigned char*)d_ws;
#if MK_ONE_LAUNCH
    launch_mk(P, 0, 1 + DEPTH * fk::NPH_L, stream);
#else
    launch_mk(P, 0, 1, stream);
    for (int l = 0; l < DEPTH; ++l) for (int k = 0; k < 14; ++k) launch_mk(P, 1 + l * fk::NPH_L + k, 2 + l * fk::NPH_L + k, stream);
#endif
}
```

```cpp
#ifndef MK_ONE_LAUNCH
#define MK_ONE_LAUNCH 1
#endif
#include <hip/hip_runtime.h>
#include <cstdint>
#include <cstdio>

constexpr int NB = 2, SEQ = 8192, T = NB * SEQ, DM = 1024, DEPTH = 2;
constexpr int HA = 8, WA = 512, BLK = 256, NBLK = SEQ / BLK;
constexpr int HB = 8, DN = 64, DR = 32, DV = 64, QL = 384, KVL = 256;
constexpr int INC = 3 * WA + QL + KVL + DR + 2 * DM;
constexpr int C_QA = 0, C_KA = 512, C_VA = 1024, C_CQ = 1536, C_CKV = 1920, C_KR = 2176, C_GA = 2208, C_GB = 3232;
constexpr int NE = 256, TOPK = 8, DE = 256, DSH = 256;
constexpr int NA = T * TOPK;
constexpr float ALPHA = 1.4142135623730951f;
constexpr float LN_EPS = 1e-5f, RMS_EPS = 1e-6f;

namespace ora {
template <class EP>
__global__ void __launch_bounds__(256) sgemm(const float* __restrict__ A, const float* __restrict__ Bm, EP ep, int M, int N, int K, int lda, int ldb, int pad_) {
    __shared__ float As[16][68], Bs[16][68];
    const int tid = threadIdx.x, tx = tid & 15, ty = tid >> 4;
    const int m0 = blockIdx.y * 64, n0 = blockIdx.x * 64;
    float acc[4][4];
#pragma unroll
    for (int i = 0; i < 4; ++i)
#pragma unroll
        for (int j = 0; j < 4; ++j) acc[i][j] = 0.f;
    const int ar = tid >> 2, ak = (tid & 3) * 4;
    const int bk = tid >> 4, bn = (tid & 15) * 4;
    for (int k0 = 0; k0 < K; k0 += 16) {
        const float4 av = *(const float4*)(A + (size_t)(m0 + ar) * lda + k0 + ak);
        float4 bv = make_float4(0.f, 0.f, 0.f, 0.f);
        if (n0 + bn < N) bv = *(const float4*)(Bm + (size_t)(k0 + bk) * ldb + n0 + bn);
        __syncthreads();
        As[ak + 0][ar] = av.x; As[ak + 1][ar] = av.y; As[ak + 2][ar] = av.z; As[ak + 3][ar] = av.w;
        *(float4*)&Bs[bk][bn] = bv;
        __syncthreads();
#pragma unroll
        for (int kk = 0; kk < 16; ++kk) {
            const float4 a = *(const float4*)&As[kk][ty * 4];
            const float4 b = *(const float4*)&Bs[kk][tx * 4];
            const float aa[4] = {a.x, a.y, a.z, a.w}, bb[4] = {b.x, b.y, b.z, b.w};
#pragma unroll
            for (int i = 0; i < 4; ++i)
#pragma unroll
                for (int j = 0; j < 4; ++j) acc[i][j] = fmaf(aa[i], bb[j], acc[i][j]);
        }
    }
#pragma unroll
    for (int i = 0; i < 4; ++i)
#pragma unroll
        for (int j = 0; j < 4; ++j) { const int r = m0 + ty * 4 + i, c = n0 + tx * 4 + j; if (c < N) ep(r, c, acc[i][j]); }
}
struct EpStore { float* C; int ldc; int pad; __device__ void operator()(int r, int c, float v) const { C[(size_t)r * ldc + c] = v; } };
struct EpMerge { const float* proj; const float* bg; const float* pa; float* out; int pre; int pad;
    __device__ void operator()(int r, int c, float v) const {
        const float ga = proj[(size_t)r * INC + C_GA + c] + bg[c], gb = proj[(size_t)r * INC + C_GB + c] + bg[DM + c];
        const float sa = pre ? proj[(size_t)r * INC + C_GA + c] : 1.f / (1.f + expf(-ga)), sb = pre ? proj[(size_t)r * INC + C_GB + c] : 1.f / (1.f + expf(-gb));
        out[(size_t)r * DM + c] = sa * pa[(size_t)r * DM + c] + sb * v; } };
struct EpResid { const float* x; float* out; __device__ void operator()(int r, int c, float v) const { out[(size_t)r * DM + c] = ALPHA * x[(size_t)r * DM + c] + v; } };
struct EpSilu { const float* sg; float* out; __device__ void operator()(int r, int c, float v) const { const float g = sg[(size_t)r * DSH + c]; out[(size_t)r * DSH + c] = g / (1.f + expf(-g)) * v; } };

__global__ void __launch_bounds__(256) rowprep(const float* __restrict__ proj, const float* __restrict__ qn, const float* __restrict__ kvn, float* cqn, float* ckvn, float* krr) {
    const int wid = threadIdx.x >> 6, lane = threadIdx.x & 63, row = blockIdx.x * 4 + wid;
    const float* p = proj + (size_t)row * INC;
    float sq = 0.f, sk = 0.f;
    for (int c = lane; c < QL; c += 64) { const float v = p[C_CQ + c]; sq += v * v; }
    for (int c = lane; c < KVL; c += 64) { const float v = p[C_CKV + c]; sk += v * v; }
#pragma unroll
    for (int o = 32; o; o >>= 1) { sq += __shfl_xor(sq, o); sk += __shfl_xor(sk, o); }
    const float rq = rsqrtf(sq / QL + RMS_EPS), rk = rsqrtf(sk / KVL + RMS_EPS);
    for (int c = lane; c < QL; c += 64) cqn[(size_t)row * QL + c] = p[C_CQ + c] * rq * qn[c];
    for (int c = lane; c < KVL; c += 64) ckvn[(size_t)row * KVL + c] = p[C_CKV + c] * rk * kvn[c];
    if (lane < 16) {
        const int pos = row % SEQ;
        const float inv = powf(10000.f, -(float)(2 * lane) / 32.f), ang = (float)pos * inv, cs = cosf(ang), sn = sinf(ang);
        const float x1 = p[C_KR + lane], x2 = p[C_KR + 16 + lane];
        krr[(size_t)row * DR + lane] = x1 * cs - x2 * sn; krr[(size_t)row * DR + 16 + lane] = x2 * cs + x1 * sn;
    }
}
__global__ void __launch_bounds__(256) qrope(float* q) {
    const int idx = blockIdx.x * 256 + threadIdx.x;
    const int i = idx & 15, h = (idx >> 4) & 7, row = idx >> 7, pos = row % SEQ;
    const float inv = powf(10000.f, -(float)(2 * i) / 32.f), ang = (float)pos * inv, cs = cosf(ang), sn = sinf(ang);
    float* p = q + (size_t)row * 768 + h * 96 + 64;
    const float x1 = p[i], x2 = p[16 + i];
    p[i] = x1 * cs - x2 * sn; p[16 + i] = x2 * cs + x1 * sn;
}
__global__ void __launch_bounds__(64) kmean(const float* __restrict__ proj, float* km) {
    const int blk = blockIdx.x, h = blockIdx.y, b = blockIdx.z, c = threadIdx.x;
    float s = 0.f;
    for (int i = 0; i < BLK; ++i) s += proj[(size_t)(b * SEQ + blk * BLK + i) * INC + C_KA + h * 64 + c];
    km[((size_t)(b * HA + h) * NBLK + blk) * 64 + c] = s * (1.f / BLK);
}
__global__ void __launch_bounds__(256) mobasel(const float* __restrict__ proj, const float* __restrict__ km, unsigned* sel) {
    const int idx = blockIdx.x * 256 + threadIdx.x;
    const int h = idx & 7, row = idx >> 3, b = row / SEQ, pos = row % SEQ, own = pos / BLK;
    const float* qp = proj + (size_t)row * INC + C_QA + h * 64;
    float v1 = -INFINITY, v2 = -INFINITY, v3 = -INFINITY; int i1 = -1, i2 = -1, i3 = -1;
    for (int j = 0; j < own; ++j) {
        const float* kp = km + ((size_t)(b * HA + h) * NBLK + j) * 64;
        float g = 0.f;
        for (int c = 0; c < 64; ++c) g = fmaf(qp[c], kp[c], g);
        if (g > v1) { v3 = v2; i3 = i2; v2 = v1; i2 = i1; v1 = g; i1 = j; }
        else if (g > v2) { v3 = v2; i3 = i2; v2 = g; i2 = j; }
        else if (g > v3) { v3 = g; i3 = j; }
    }
    unsigned m = 0;
    if (i1 >= 0) m |= 1u << i1; if (i2 >= 0) m |= 1u << i2; if (i3 >= 0) m |= 1u << i3;
    sel[idx] = m;
}
__device__ __forceinline__ float ldbf(const void* p, size_t i) { return __builtin_bit_cast(float, (unsigned)((const unsigned short*)p)[i] << 16); }
template <bool MOBA, bool FAST>
__global__ void __launch_bounds__(256) attn(const float* __restrict__ Qb, const float* __restrict__ KVb, const float* __restrict__ KRb, const unsigned* __restrict__ sel, float* O) {
    constexpr int DQK = MOBA ? 64 : 96;
    __shared__ float Qs[64][DQK + 1], Ks[32][DQK + 1], Vs[32][65], Ps[64][33];
    const int qb = blockIdx.x, h = blockIdx.y, b = blockIdx.z, tid = threadIdx.x, qi = tid >> 2, sub = tid & 3;
    const size_t row0 = (size_t)b * SEQ + (size_t)qb * 64;
    for (int idx = tid; idx < 64 * DQK; idx += 256) { const int r = idx / DQK, c = idx % DQK;
        if (FAST) Qs[r][c] = MOBA ? ldbf(Qb, (row0 + r) * 4352 + C_QA + h * 64 + c) : ldbf(Qb, (row0 + r) * 768 + h * 96 + c);
        else Qs[r][c] = MOBA ? Qb[(row0 + r) * INC + C_QA + h * 64 + c] : Qb[(row0 + r) * 768 + h * 96 + c]; }
    const int tq = qb * 64 + qi, own = tq / BLK;
    const unsigned mask = MOBA ? sel[(row0 + qi) * 8 + h] : 0u;
    const float slope = exp2f(-(float)(h + 1)), scale = FAST ? 0.6931471805599453f : (MOBA ? 0.125f : 0.10206207261596577f);
    float m = -1e30f, l = 0.f, o[16];
#pragma unroll
    for (int d = 0; d < 16; ++d) o[d] = 0.f;
    const int nkt = (qb * 64 + 64) / 32;
    for (int kt = 0; kt < nkt; ++kt) {
        __syncthreads();
        for (int idx = tid; idx < 32 * DQK; idx += 256) { const int r = idx / DQK, c = idx % DQK; const size_t kr = (size_t)b * SEQ + kt * 32 + r;
            if (FAST) Ks[r][c] = MOBA ? ldbf(KVb, kr * 4352 + C_KA + h * 64 + c) : ldbf(KVb, kr * 768 + h * 96 + c);
            else Ks[r][c] = MOBA ? KVb[kr * INC + C_KA + h * 64 + c] : (c < 64 ? KVb[kr * 1024 + h * 128 + c] : KRb[kr * DR + c - 64]); }
        for (int idx = tid; idx < 32 * 64; idx += 256) { const int r = idx >> 6, c = idx & 63; const size_t kr = (size_t)b * SEQ + kt * 32 + r;
            if (FAST) Vs[r][c] = MOBA ? ldbf(KVb, kr * 4352 + C_VA + h * 64 + c) : ldbf(KRb, kr * 512 + h * 64 + c);
            else Vs[r][c] = MOBA ? KVb[kr * INC + C_VA + h * 64 + c] : KVb[kr * 1024 + h * 128 + 64 + c]; }
        __syncthreads();
        float s[8]; float rmax = -1e30f;
#pragma unroll
        for (int j = 0; j < 8; ++j) {
            const int kk = sub + 4 * j, kpos = kt * 32 + kk;
            float dot = 0.f;
            for (int c = 0; c < DQK; ++c) dot = fmaf(Qs[qi][c], Ks[kk][c], dot);
            float sc = dot * scale; bool ok;
            if (MOBA) { sc -= slope * (float)(tq - kpos); const int kb = kpos / BLK; ok = (kb == own) ? (kpos <= tq) : (((mask >> kb) & 1u) != 0u); }
            else ok = kpos <= tq;
            s[j] = ok ? sc : -1e30f; rmax = fmaxf(rmax, s[j]);
        }
        rmax = fmaxf(rmax, __shfl_xor(rmax, 1)); rmax = fmaxf(rmax, __shfl_xor(rmax, 2));
        const float mn = fmaxf(m, rmax), alpha = expf(m - mn);
        float psum = 0.f;
#pragma unroll
        for (int j = 0; j < 8; ++j) { const float p = (s[j] > -1e29f) ? expf(s[j] - mn) : 0.f; Ps[qi][sub + 4 * j] = p; psum += p; }
        psum += __shfl_xor(psum, 1); psum += __shfl_xor(psum, 2);
        l = l * alpha + psum; m = mn;
        __syncthreads();
#pragma unroll
        for (int d = 0; d < 16; ++d) o[d] *= alpha;
        for (int kk = 0; kk < 32; ++kk) { const float p = Ps[qi][kk];
#pragma unroll
            for (int d = 0; d < 16; ++d) o[d] = fmaf(p, Vs[kk][sub * 16 + d], o[d]); }
    }
    const float rl = 1.f / l;
#pragma unroll
    for (int d = 0; d < 16; ++d) O[(row0 + qi) * 512 + h * 64 + sub * 16 + d] = o[d] * rl;
}
template <bool COMB>
__global__ void __launch_bounds__(256) lnorm(const float* __restrict__ in, const float* __restrict__ x1, const float* __restrict__ shared_, const float* __restrict__ Y, const float* __restrict__ g, const float* __restrict__ bt, float* out) {
    __shared__ float red[8];
    const int row = blockIdx.x, tid = threadIdx.x;
    float v[4];
#pragma unroll
    for (int i = 0; i < 4; ++i) { const int c = tid + 256 * i;
        if (COMB) { float a = ALPHA * x1[(size_t)row * DM + c] + shared_[(size_t)row * DM + c];
            for (int k = 0; k < TOPK; ++k) a += Y[((size_t)row * TOPK + k) * DM + c];
            v[i] = a; }
        else v[i] = in[(size_t)row * DM + c]; }
    float s = v[0] + v[1] + v[2] + v[3];
#pragma unroll
    for (int o = 32; o; o >>= 1) s += __shfl_xor(s, o);
    if ((tid & 63) == 0) red[tid >> 6] = s;
    __syncthreads();
    const float mu = (red[0] + red[1] + red[2] + red[3]) * (1.f / DM);
    float q = 0.f;
#pragma unroll
    for (int i = 0; i < 4; ++i) { const float d = v[i] - mu; q += d * d; }
#pragma unroll
    for (int o = 32; o; o >>= 1) q += __shfl_xor(q, o);
    if ((tid & 63) == 0) red[4 + (tid >> 6)] = q;
    __syncthreads();
    const float rs = rsqrtf((red[4] + red[5] + red[6] + red[7]) * (1.f / DM) + LN_EPS);
#pragma unroll
    for (int i = 0; i < 4; ++i) { const int c = tid + 256 * i; out[(size_t)row * DM + c] = (v[i] - mu) * rs * g[c] + bt[c]; }
}
__global__ void __launch_bounds__(256) route(const float* __restrict__ logits, const float* __restrict__ rbias, int* tope, float* topw, int* apos, unsigned* cnt) {
    const int wid = threadIdx.x >> 6, lane = threadIdx.x & 63, t = blockIdx.x * 4 + wid;
    const float4 lg = *(const float4*)(logits + (size_t)t * NE + lane * 4), rb = *(const float4*)(rbias + lane * 4);
    float s0 = 1.f / (1.f + expf(-lg.x)), s1 = 1.f / (1.f + expf(-lg.y)), s2 = 1.f / (1.f + expf(-lg.z)), s3 = 1.f / (1.f + expf(-lg.w));
    float c0 = s0 + rb.x, c1 = s1 + rb.y, c2 = s2 + rb.z, c3 = s3 + rb.w;
    float a = fmaxf(c0, c1), bq = fminf(c0, c1);
    { const float hi2 = fmaxf(c2, c3), lo2 = fminf(c2, c3); const float na = fmaxf(a, hi2); const float nb = fmaxf(fminf(a, hi2), fmaxf(bq, lo2)); a = na; bq = nb; }
#pragma unroll
    for (int o = 1; o < 8; o <<= 1) { const float oa = __shfl_xor(a, o), ob = __shfl_xor(bq, o); const float na = fmaxf(a, oa), nb = fmaxf(fminf(a, oa), fmaxf(bq, ob)); a = na; bq = nb; }
    const float gs = a + bq; const int grp = lane >> 3;
    int rank = 0;
#pragma unroll
    for (int j = 0; j < 8; ++j) { const float og = __shfl(gs, j * 8); rank += (og > gs || (og == gs && j < grp)) ? 1 : 0; }
    const bool gsel = rank < 4;
    if (!gsel) { c0 = c1 = c2 = c3 = -INFINITY; }
    float wsum = 0.f, myw = 0.f; int mye = 0;
#pragma unroll
    for (int k = 0; k < TOPK; ++k) {
        float bv = c0; int bi = 0;
        if (c1 > bv) { bv = c1; bi = 1; } if (c2 > bv) { bv = c2; bi = 2; } if (c3 > bv) { bv = c3; bi = 3; }
        int be = lane * 4 + bi;
#pragma unroll
        for (int o = 1; o < 64; o <<= 1) { const float ov = __shfl_xor(bv, o); const int oe = __shfl_xor(be, o); if (ov > bv || (ov == bv && oe < be)) { bv = ov; be = oe; } }
        float sc = 0.f;
        if ((be >> 2) == lane) { const int bi2 = be & 3; sc = bi2 == 0 ? s0 : bi2 == 1 ? s1 : bi2 == 2 ? s2 : s3; if (bi2 == 0) c0 = -INFINITY; else if (bi2 == 1) c1 = -INFINITY; else if (bi2 == 2) c2 = -INFINITY; else c3 = -INFINITY; }
        sc = __shfl(sc, be >> 2);
        wsum += sc;
        if (lane == k) { myw = sc; mye = be; }
    }
    if (lane < TOPK) {
        const int aidx = t * TOPK + lane;
        tope[aidx] = mye; topw[aidx] = myw / wsum * 2.5f;
        apos[aidx] = (int)atomicAdd(&cnt[mye], 1u);
    }
}
template <int TM>
__global__ void __launch_bounds__(256) escan(const unsigned* __restrict__ cnt, int* off, int* toff) {
    __shared__ int sc[256], st[256];
    const int e = threadIdx.x; const int c = (int)cnt[e];
    sc[e] = c; st[e] = (c + TM - 1) / TM;
    __syncthreads();
    if (e == 0) { int a = 0, b = 0; for (int i = 0; i < 256; ++i) { const int ca = sc[i], cb = st[i]; sc[i] = a; st[i] = b; a += ca; b += cb; } off[256] = a; toff[256] = b; }
    __syncthreads();
    off[e] = sc[e]; toff[e] = st[e];
}
__global__ void __launch_bounds__(256) escatter(const int* __restrict__ tope, const int* __restrict__ apos, const int* __restrict__ off, int* rowa) {
    const int a = blockIdx.x * 256 + threadIdx.x;
    rowa[off[tope[a]] + apos[a]] = a;
}
template <int MODE>
__global__ void __launch_bounds__(256) egemm(const float* __restrict__ X, const float* __restrict__ W0, const float* __restrict__ W1, const int* __restrict__ off, const int* __restrict__ toff, const int* __restrict__ rowa,
                                            const float* __restrict__ topw, float* out) {
    __shared__ float As[16][68], Bs[16][68], Cs[16][68];
    __shared__ int se;
    const int tile = blockIdx.y;
    if (tile >= toff[256]) return;
    const int tid = threadIdx.x, tx = tid & 15, ty = tid >> 4;
    if (tid == 0) { int lo = 0, hi = 255; while (lo < hi) { const int mid = (lo + hi + 1) >> 1; if (toff[mid] <= tile) lo = mid; else hi = mid - 1; } se = lo; }
    __syncthreads();
    const int e = se, r0 = off[e] + (tile - toff[e]) * 64, rend = off[e + 1];
    constexpr int K = MODE == 0 ? DM : DE, N = MODE == 0 ? DE : DM;
    const int n0 = blockIdx.x * 64;
    const float* B0 = W0 + (size_t)e * K * N; const float* B1 = MODE == 0 ? W1 + (size_t)e * K * N : nullptr;
    const int ar = tid >> 2, ak = (tid & 3) * 4, bk = tid >> 4, bn = (tid & 15) * 4;
    const int arow = r0 + ar; const bool aval = arow < rend;
    const float* ap = nullptr;
    if (aval) ap = MODE == 0 ? X + (size_t)(rowa[arow] >> 3) * DM : X + (size_t)arow * DE;
    float acc[4][4], acu[4][4];
#pragma unroll
    for (int i = 0; i < 4; ++i)
#pragma unroll
        for (int j = 0; j < 4; ++j) { acc[i][j] = 0.f; acu[i][j] = 0.f; }
    for (int k0 = 0; k0 < K; k0 += 16) {
        float4 av = make_float4(0.f, 0.f, 0.f, 0.f);
        if (aval) av = *(const float4*)(ap + k0 + ak);
        const float4 bv = *(const float4*)(B0 + (size_t)(k0 + bk) * N + n0 + bn);
        float4 cv = make_float4(0.f, 0.f, 0.f, 0.f);
        if (MODE == 0) cv = *(const float4*)(B1 + (size_t)(k0 + bk) * N + n0 + bn);
        __syncthreads();
        As[ak + 0][ar] = av.x; As[ak + 1][ar] = av.y; As[ak + 2][ar] = av.z; As[ak + 3][ar] = av.w;
        *(float4*)&Bs[bk][bn] = bv; if (MODE == 0) *(float4*)&Cs[bk][bn] = cv;
        __syncthreads();
#pragma unroll
        for (int kk = 0; kk < 16; ++kk) {
            const float4 a = *(const float4*)&As[kk][ty * 4];
            const float4 b = *(const float4*)&Bs[kk][tx * 4];
            const float aa[4] = {a.x, a.y, a.z, a.w}, bb[4] = {b.x, b.y, b.z, b.w};
#pragma unroll
            for (int i = 0; i < 4; ++i)
#pragma unroll
                for (int j = 0; j < 4; ++j) acc[i][j] = fmaf(aa[i], bb[j], acc[i][j]);
            if (MODE == 0) { const float4 c = *(const float4*)&Cs[kk][tx * 4]; const float cc[4] = {c.x, c.y, c.z, c.w};
#pragma unroll
                for (int i = 0; i < 4; ++i)
#pragma unroll
                    for (int j = 0; j < 4; ++j) acu[i][j] = fmaf(aa[i], cc[j], acu[i][j]); }
        }
    }
#pragma unroll
    for (int i = 0; i < 4; ++i) { const int r = r0 + ty * 4 + i; if (r < rend) {
        if (MODE == 0) {
#pragma unroll
            for (int j = 0; j < 4; ++j) { const float g = acc[i][j]; out[(size_t)r * DE + n0 + tx * 4 + j] = g / (1.f + expf(-g)) * acu[i][j]; } }
        else { const int a = rowa[r]; const float w = topw[a];
#pragma unroll
            for (int j = 0; j < 4; ++j) out[(size_t)a * DM + n0 + tx * 4 + j] = acc[i][j] * w; } } }
}
}


namespace fk {
#define LAS __attribute__((address_space(3)))
#define GAS __attribute__((address_space(1)))
typedef unsigned short bf16_t;
typedef short bf16x8 __attribute__((ext_vector_type(8)));
typedef float f32x4 __attribute__((ext_vector_type(4)));
typedef float f32x2 __attribute__((ext_vector_type(2)));
typedef float f32x16 __attribute__((ext_vector_type(16)));
typedef unsigned u32x4 __attribute__((ext_vector_type(4)));
typedef unsigned u32x2 __attribute__((ext_vector_type(2)));
constexpr int NWAVES = 8, NTHR = 512;
constexpr int INCP = 4352;
constexpr float LOG2E = 1.4426950408889634f;
constexpr float QS_A = 0.125f * LOG2E;
constexpr float QS_B = 0.10206207261596577f * LOG2E;
#define LDS_WAIT() asm volatile("s_waitcnt lgkmcnt(0)" ::: "memory")
#define VM_WAIT() asm volatile("s_waitcnt vmcnt(0)" ::: "memory")
__device__ __forceinline__ unsigned f2bf(float f) { unsigned u = __builtin_bit_cast(unsigned, f); return (u + 0x7fffu + ((u >> 16) & 1u)) >> 16; }
__device__ __forceinline__ unsigned pk2(float lo, float hi) { return f2bf(lo) | (f2bf(hi) << 16); }
__device__ __forceinline__ float bf2f(unsigned short b) { return __builtin_bit_cast(float, (unsigned)b << 16); }
__device__ __forceinline__ float bflo(unsigned w) { return __builtin_bit_cast(float, w << 16); }
__device__ __forceinline__ float bfhi(unsigned w) { return __builtin_bit_cast(float, w & 0xffff0000u); }
__device__ __forceinline__ float sigmoidf_(float x) { return __builtin_amdgcn_rcpf(1.f + __expf(-x)); }
__device__ __forceinline__ float wave_sum(float v) {
#pragma unroll
    for (int o = 1; o < 64; o <<= 1) v += __shfl_xor(v, o);
    return v;
}

namespace pg8 {
constexpr int BM = 256, BK = 64, HALF = 128, HTB = HALF * BK * 2, STAGE_BYTES = 8 * HTB, NXCD = 8, WGM = 8;
__host__ __device__ __forceinline__ int lds_byte(int r, int c) { const int st = (r >> 4) * 2 + (c >> 5), rr = r & 15, cc = c & 31, ob = rr * 64 + cc * 2; return st * 1024 + (ob ^ (((ob >> 9) & 1) << 5)); }
__host__ __device__ __forceinline__ void stage_rc(int b, int& R, int& C) { const int st = b / 1024, sb = b % 1024, swz = sb ^ (((sb >> 9) & 1) << 5); R = (st >> 1) * 16 + swz / 64; C = (st & 1) * 32 + (swz % 64) / 2; }
__host__ __device__ __forceinline__ int perm32(int rho) { const int n = rho >> 4, i = rho & 15; return 8 * (i >> 2) + 4 * n + (i & 3); }

struct Unit { int pm, pn, e, r0, rend; };
struct Gemm { const bf16_t* A; const bf16_t* Bt; int M, N, K, lda, ldb; };

struct StaticOrder {
    int nM, nN, nwg, G, c;
    __device__ void init(int M, int N, int G_, int c_) { nM = M / BM; nN = N / BM; nwg = nM * nN; G = G_; c = c_; }
    __device__ bool next(int i, Unit& u) const {
        const long L = (long)i * G + c; if (L >= nwg) return false;
        int wgid = (int)L; { const int q = nwg / NXCD, r = nwg % NXCD, xcd = wgid % NXCD, off = wgid / NXCD; wgid = (xcd < r ? xcd * (q + 1) : r * (q + 1) + (xcd - r) * q) + off; }
        const int nig = WGM * nN, gid = wgid / nig, fm = gid * WGM, gsz = (nM - fm) < WGM ? (nM - fm) : WGM;
        u.pm = fm + ((wgid % nig) % gsz); u.pn = (wgid % nig) / gsz; u.e = 0; u.r0 = u.pm * BM; u.rend = u.r0 + BM; return true;
    }
    __device__ __forceinline__ int a_row(const Unit& u, int r) const { return u.pm * BM + r; }
    __device__ __forceinline__ const char* b_ptr(const Gemm& g, const Unit& u) const { return (const char*)g.Bt + (size_t)u.pn * BM * g.ldb * 2; }
};

typedef float f32x2_t_ __attribute__((ext_vector_type(2))); typedef __bf16 bf16x2_t_ __attribute__((ext_vector_type(2)));
__device__ __forceinline__ unsigned cvt_pk_bf16(float lo, float hi) { const f32x2_t_ v = {lo, hi}; const bf16x2_t_ b = __builtin_convertvector(v, bf16x2_t_); return __builtin_bit_cast(unsigned, b); }

template <class Epi, class Sched, bool ALIGN_EPI>
__device__ __forceinline__ void gemm_phase(LAS unsigned char* lds, const Gemm g, const Sched& S, const Epi& E) {
    int tid_ = threadIdx.x; asm volatile("" : "+v"(tid_));
    const int tid = tid_, wid = __builtin_amdgcn_readfirstlane(tid >> 6), lane = tid & 63, wr = wid >> 2, wc = wid & 3, fr = lane & 15, fq = lane >> 4;
    const int K = g.K, nt = K / BK;
    int RA[2]; unsigned CA[2], voffB[2];
#pragma unroll
    for (int i = 0; i < 2; ++i) { int R, C; stage_rc(tid * 16 + i * 8192, R, C); const int Rb = (R & ~31) + perm32(R & 31);
        RA[i] = R; CA[i] = (unsigned)C * 2u; voffB[i] = (unsigned)(Rb * g.ldb + C) * 2u; }
    const unsigned lda2 = (unsigned)g.lda * 2u;
    const size_t hstepB = (size_t)HALF * g.ldb * 2;
    const unsigned ldsw = (unsigned)wid * 1024u;
    const int aoff = lds_byte(wr * 64 + fr, fq * 8), boff = lds_byte(wc * 32 + fr, fq * 8);
    const char* const Abase = (const char*)g.A;
#define PG8_SA(b, h) (((b) * 2 + (h)) * HTB)
#define PG8_SB(b, h) ((4 + (b) * 2 + (h)) * HTB)
#define PG8_STAGE_B(bufoff, gbase) do { _Pragma("unroll") for (int _i = 0; _i < 2; ++_i) \
        __builtin_amdgcn_global_load_lds((const unsigned*)((const char*)(gbase) + voffB[_i]), (LAS unsigned*)(lds + (bufoff) + ldsw + _i * 8192), 16, 0, 0); } while (0)
#define PG8_STAGE_A(bufoff, V0, V1, kb) do { \
        __builtin_amdgcn_global_load_lds((const unsigned*)((Abase + (kb)) + (V0)), (LAS unsigned*)(lds + (bufoff) + ldsw), 16, 0, 0); \
        __builtin_amdgcn_global_load_lds((const unsigned*)((Abase + (kb)) + (V1)), (LAS unsigned*)(lds + (bufoff) + ldsw + 8192), 16, 0, 0); } while (0)
#define PG8_LDA(dst, b, h) do { _Pragma("unroll") for (int m = 0; m < 4; ++m) _Pragma("unroll") for (int k = 0; k < 2; ++k) dst[m][k] = *(const LAS bf16x8*)(lds + PG8_SA(b, h) + aoff + m * 2048 + k * 1024); } while (0)
#define PG8_LDB(dst, b, h) do { _Pragma("unroll") for (int n = 0; n < 2; ++n) _Pragma("unroll") for (int k = 0; k < 2; ++k) dst[n][k] = *(const LAS bf16x8*)(lds + PG8_SB(b, h) + boff + n * 2048 + k * 1024); } while (0)
#define PG8_MMA(ai, bj, At, Bt) do { __builtin_amdgcn_s_setprio(1); _Pragma("unroll") for (int m = 0; m < 4; ++m) _Pragma("unroll") for (int n = 0; n < 2; ++n) _Pragma("unroll") for (int k = 0; k < 2; ++k) \
        acc[ai][bj][m][n] = __builtin_amdgcn_mfma_f32_16x16x32_bf16(Bt[n][k], At[m][k], acc[ai][bj][m][n], 0, 0, 0); __builtin_amdgcn_s_setprio(0); } while (0)
#define PG8_WAIT_V(n) asm volatile("s_waitcnt vmcnt(" #n ")" ::: "memory")
#define PG8_WAIT_L(n) asm volatile("s_waitcnt lgkmcnt(" #n ")" ::: "memory")
#define PG8_BAR __builtin_amdgcn_s_barrier()
#define PG8_SCHED __builtin_amdgcn_sched_barrier(0)
#define PG8_VOFF(V, U) do { V##00 = (unsigned)S.a_row(U, RA[0]) * lda2 + CA[0]; V##01 = (unsigned)S.a_row(U, RA[1]) * lda2 + CA[1]; \
        V##10 = (unsigned)S.a_row(U, HALF + RA[0]) * lda2 + CA[0]; V##11 = (unsigned)S.a_row(U, HALF + RA[1]) * lda2 + CA[1]; } while (0)
    Unit cur, nxt; int ui = 0;
    if (!S.next(0, cur)) return;
    f32x4 acc[2][2][4][2];
#pragma unroll
    for (int a = 0; a < 2; ++a)
#pragma unroll
        for (int b = 0; b < 2; ++b)
#pragma unroll
            for (int m = 0; m < 4; ++m)
#pragma unroll
                for (int n = 0; n < 2; ++n) acc[a][b][m][n] = (f32x4){0.f, 0.f, 0.f, 0.f};
    bf16x8 At[4][2], B0[2][2], B1[2][2];
    unsigned vc00, vc01, vc10, vc11;
    PG8_VOFF(vc, cur);
    const char* cB = S.b_ptr(g, cur);
    PG8_STAGE_B(PG8_SB(0, 0), cB); PG8_STAGE_B(PG8_SB(0, 1), cB + hstepB); PG8_STAGE_A(PG8_SA(0, 0), vc00, vc01, 0u); PG8_STAGE_A(PG8_SA(0, 1), vc10, vc11, 0u);
    if (wr == 1) PG8_BAR;
    PG8_WAIT_V(2); PG8_BAR;
    PG8_STAGE_B(PG8_SB(1, 0), cB + 128); PG8_STAGE_A(PG8_SA(1, 0), vc00, vc01, 128u); PG8_STAGE_B(PG8_SB(1, 1), cB + hstepB + 128);
    PG8_WAIT_V(6); PG8_BAR;
    for (;;) {
        const bool has_next = S.next(ui + 1, nxt);
        const char* nB = has_next ? S.b_ptr(g, nxt) : cB;
        unsigned vn00 = vc00, vn01 = vc01, vn10 = vc10, vn11 = vc11;
        if (has_next) { PG8_VOFF(vn, nxt); }
        const bool half1 = (cur.rend - cur.r0) > HALF;
#pragma unroll 1
        for (int t = 0; t < nt; t += 2) {
            if constexpr (Epi::MIDK > 0) { if (t == Epi::MIDK) E.mid(acc, cur, wr, wc, fr, fq); }
            const bool last = (t == nt - 2);
            const unsigned kb1 = (unsigned)(t + 1) * 128u;
            unsigned kb2 = (unsigned)(t + 2) * 128u;
            unsigned s00 = vc00, s01 = vc01, s10 = vc10, s11 = vc11;
            const char* b2 = cB + (size_t)kb2;
            if (last) { kb2 = 0u; b2 = nB; s00 = vn00; s01 = vn01; s10 = vn10; s11 = vn11; }
            const unsigned kb3 = kb2 + 128u; const char* b3 = b2 + 128;
            PG8_LDB(B0, 0, 0); PG8_LDB(B1, 0, 1); PG8_SCHED; PG8_LDA(At, 0, 0); PG8_STAGE_A(PG8_SA(1, 1), vc10, vc11, kb1);
            PG8_WAIT_V(8); PG8_WAIT_L(0); PG8_BAR; PG8_MMA(0, 0, At, B0); PG8_MMA(0, 1, At, B1); PG8_BAR; PG8_SCHED;
            PG8_LDA(At, 0, 1); PG8_STAGE_B(PG8_SB(0, 0), b2); PG8_STAGE_B(PG8_SB(0, 1), b2 + hstepB); PG8_STAGE_A(PG8_SA(0, 0), s00, s01, kb2);
            PG8_WAIT_V(8); PG8_WAIT_L(0); PG8_BAR; if (half1) { PG8_MMA(1, 0, At, B0); PG8_MMA(1, 1, At, B1); } PG8_BAR; PG8_SCHED;
            PG8_LDB(B0, 1, 0); PG8_LDB(B1, 1, 1); PG8_SCHED; PG8_LDA(At, 1, 0); PG8_STAGE_A(PG8_SA(0, 1), s10, s11, kb2);
            PG8_WAIT_V(8); PG8_WAIT_L(0); PG8_BAR; PG8_MMA(0, 0, At, B0); PG8_MMA(0, 1, At, B1); PG8_BAR; PG8_SCHED;
            PG8_LDA(At, 1, 1); PG8_STAGE_B(PG8_SB(1, 0), b3); PG8_STAGE_B(PG8_SB(1, 1), b3 + hstepB); PG8_STAGE_A(PG8_SA(1, 0), s00, s01, kb3);
            PG8_WAIT_V(8); PG8_WAIT_L(0); PG8_BAR; if (half1) { PG8_MMA(1, 0, At, B0); PG8_MMA(1, 1, At, B1); } PG8_BAR; PG8_SCHED;
        }
        if constexpr (ALIGN_EPI) { if (wr == 0) PG8_BAR; }
        E(acc, cur, wr, wc, fr, fq);
        if (!has_next) break;
#pragma unroll
        for (int a = 0; a < 2; ++a)
#pragma unroll
            for (int b = 0; b < 2; ++b)
#pragma unroll
                for (int m = 0; m < 4; ++m)
#pragma unroll
                    for (int n = 0; n < 2; ++n) acc[a][b][m][n] = (f32x4){0.f, 0.f, 0.f, 0.f};
        cur = nxt; cB = nB; vc00 = vn00; vc01 = vn01; vc10 = vn10; vc11 = vn11; ++ui;
        if constexpr (ALIGN_EPI) { if (wr == 1) PG8_BAR; }
    }
    PG8_WAIT_V(0);
    if constexpr (!ALIGN_EPI) { if (wr == 0) PG8_BAR; }
    PG8_BAR;
#undef PG8_SA
#undef PG8_SB
#undef PG8_STAGE_A
#undef PG8_STAGE_B
#undef PG8_LDA
#undef PG8_LDB
#undef PG8_MMA
#undef PG8_WAIT_V
#undef PG8_WAIT_L
#undef PG8_BAR
#undef PG8_SCHED
#undef PG8_VOFF
}
#define PG8_TILE_BEGIN(acc, wr, wc, fr, fq) \
    _Pragma("unroll") for (int ai = 0; ai < 2; ++ai) _Pragma("unroll") for (int m = 0; m < 4; ++m) _Pragma("unroll") for (int bj = 0; bj < 2; ++bj) { \
        const int trow = ai * 128 + wr * 64 + m * 16 + fr, tcol = bj * 128 + wc * 32 + 8 * fq; f32x4 v0 = acc[ai][bj][m][0], v1 = acc[ai][bj][m][1];
#define PG8_TILE_END }
__device__ __forceinline__ u32x4 pack8(f32x4 v0, f32x4 v1) { u32x4 w; w.x = cvt_pk_bf16(v0[0], v0[1]); w.y = cvt_pk_bf16(v0[2], v0[3]); w.z = cvt_pk_bf16(v1[0], v1[1]); w.w = cvt_pk_bf16(v1[2], v1[3]); return w; }
}

#define XB_TMO      128
#define XB_XCNT(j)  (256  + 64 * (j))
#define XB_XSUB(j)  (1280 + 64 * (j))
#define XB_XGEN(j)  (2304 + 64 * (j))
#define XB_TOP      3328
#define XB_TOPGEN   3392
#define XCD_BAR_WORDS 3456
#define XB_SPIN_CAP (1u << 18)

__device__ __forceinline__ unsigned xb_ld(unsigned* p)              { return __hip_atomic_load(p, __ATOMIC_RELAXED, __HIP_MEMORY_SCOPE_AGENT); }
__device__ __forceinline__ unsigned xb_add(unsigned* p, unsigned v) { return __hip_atomic_fetch_add(p, v, __ATOMIC_RELAXED, __HIP_MEMORY_SCOPE_AGENT); }
__device__ __forceinline__ unsigned xb_xcc_id() { return (unsigned)__builtin_amdgcn_s_getreg((3 << 11) | 20) & 0xFu; }
#define XB_SPIN(cond, bar) do { unsigned _sp = 0; while (cond) { __builtin_amdgcn_s_sleep(1); \
    if ((++_sp & 255u) == 0u) { if (xb_ld(&(bar)[XB_TMO])) break; if (_sp > XB_SPIN_CAP) { atomicAdd(&(bar)[XB_TMO], 1u); break; } } } } while (0)

struct XcdBarrier {
    unsigned* bar; unsigned x;
    volatile LAS unsigned* st;
};

__device__ __forceinline__ XcdBarrier xcd_barrier_post(unsigned* bar, volatile LAS unsigned* st) {
    XcdBarrier b; b.bar = bar; b.x = xb_xcc_id(); b.st = st;
    if (threadIdx.x == 0) (void)xb_add(&bar[XB_XCNT(b.x)], 1u);
    return b;
}
__device__ __forceinline__ void xcd_barrier_complete(unsigned* bar, unsigned x, unsigned& nloc, unsigned& nx) {
    const unsigned G = gridDim.x * gridDim.y * gridDim.z;
    unsigned sum, cnt, mine, sp = 0u;
    for (;;) {
        sum = 0u; cnt = 0u; mine = 0u;
#pragma unroll
        for (unsigned j = 0; j < 16; ++j) { const unsigned c = xb_ld(&bar[XB_XCNT(j)]); sum += c; cnt += (c > 0u) ? 1u : 0u; mine = (j == x) ? c : mine; }
        if (sum == G) break;
        __builtin_amdgcn_s_sleep(1);
        if ((++sp & 255u) == 0u) { if (xb_ld(&bar[XB_TMO])) break; if (sp > XB_SPIN_CAP) { atomicAdd(&bar[XB_TMO], 1u); break; } }
    }
    nloc = mine > 0u ? mine : 1u; nx = cnt > 0u ? cnt : 1u;
}

__device__ __forceinline__ void xcd_barrier(const XcdBarrier& b) {
    asm volatile("s_waitcnt vmcnt(0)" ::: "memory");
    __syncthreads();
    if (threadIdx.x == 0) {
        unsigned* bar = b.bar; asm volatile("" : "+s"(bar));
        __builtin_amdgcn_s_waitcnt(0);
        unsigned nloc = b.st[0], nx = b.st[1];
        if (nloc == 0u) { xcd_barrier_complete(bar, b.x, nloc, nx); b.st[0] = nloc; b.st[1] = nx; }
        const unsigned old = xb_add(&bar[XB_XSUB(b.x)], 1u);
        const unsigned gen = old / nloc;
        if (old + 1u == (gen + 1u) * nloc) {
            __builtin_amdgcn_fence(__ATOMIC_RELEASE, "agent");
            asm volatile("s_waitcnt vmcnt(0)" ::: "memory");
            const unsigned og = xb_add(&bar[XB_TOP], 1u);
            const unsigned tg = og / nx;
            if (og + 1u == (tg + 1u) * nx) xb_add(&bar[XB_TOPGEN], 1u);
            else XB_SPIN(xb_ld(&bar[XB_TOPGEN]) == tg, bar);
            __builtin_amdgcn_fence(__ATOMIC_ACQUIRE, "agent");
            xb_add(&bar[XB_XGEN(b.x)], 1u);
            asm volatile("s_waitcnt vmcnt(0)" ::: "memory");
        } else {
            XB_SPIN(xb_ld(&bar[XB_XGEN(b.x)]) == gen, bar);
            __builtin_amdgcn_fence(__ATOMIC_ACQUIRE, "agent");
            asm volatile("s_waitcnt vmcnt(0)" ::: "memory");
        }
    }
    __syncthreads();
}


struct Params {
    const float* in[22]; float* out; unsigned char* ws;
    int ph_lo, ph_hi;
};
constexpr size_t MiB = 1u << 20;
constexpr size_t WS_CTL = 0, CTL_BYTES = 1 * MiB;
constexpr int CW_BAR = 4096;
constexpr int CW_CNT = 16384;
constexpr size_t WS_WIN = 2 * MiB;
constexpr size_t SZ_WIN = (size_t)INCP * DM;
constexpr size_t SZ_WUQ = (size_t)768 * QL, SZ_WUKV = (size_t)1024 * KVL;
constexpr size_t WS_WUQ = WS_WIN + 2 * SZ_WIN * 2;
constexpr size_t WS_WUKV = WS_WUQ + 2 * SZ_WUQ * 2;
constexpr size_t SZ_WP = (size_t)DM * 512, SZ_WOUT = (size_t)DM * DM;
constexpr size_t WS_WPA = WS_WUKV + 2 * SZ_WUKV * 2;
constexpr size_t WS_WPB = WS_WPA + 2 * SZ_WP * 2;
constexpr size_t WS_WOUT = WS_WPB + 2 * SZ_WP * 2;
constexpr size_t SZ_WRT = (size_t)NE * DM, SZ_WSGU = (size_t)512 * DM, SZ_WSD = (size_t)DM * DSH;
constexpr size_t WS_WRT = WS_WOUT + 2 * SZ_WOUT * 2;
constexpr size_t WS_WSGU = WS_WRT + 2 * SZ_WRT * 2;
constexpr size_t WS_WSD = WS_WSGU + 2 * SZ_WSGU * 2;
constexpr size_t WS_CS = WS_WSD + 2 * SZ_WSD * 2;
constexpr size_t WS_KM = WS_CS + (size_t)SEQ * 16 * 8;
constexpr size_t WS_SEL = WS_KM + (size_t)NB * HA * NBLK * 64 * 4;
constexpr size_t WS_XB = WS_SEL + (size_t)T * 8 * 4;
constexpr size_t WS_CQN = WS_XB + (size_t)T * DM * 2;
constexpr size_t WS_CKVN = WS_CQN + (size_t)T * QL * 2;
constexpr size_t WS_QB = WS_CKVN + (size_t)T * KVL * 2;
constexpr size_t WS_KB = WS_QB + (size_t)T * 768 * 2;
constexpr size_t WS_VB = WS_KB + (size_t)T * 768 * 2;
constexpr size_t WS_OAB = WS_VB + (size_t)T * 512 * 2;
constexpr size_t WS_TMP = WS_OAB + (size_t)T * 1024 * 2;
constexpr size_t WS_MRG = WS_TMP + (size_t)T * 1024 * 2;
constexpr size_t WS_PRE = WS_MRG + (size_t)T * 1024 * 2;
constexpr size_t WS_X1 = WS_PRE + (size_t)T * 1024 * 4;
constexpr size_t WS_X1B = WS_X1 + (size_t)T * 1024 * 4;
constexpr size_t WS_X2 = WS_X1B + (size_t)T * 1024 * 2;
constexpr size_t WS_LOG = WS_X2 + (size_t)T * 1024 * 4;
constexpr size_t WS_HS = WS_LOG + (size_t)T * NE * 4;
constexpr size_t WS_SH = WS_HS + (size_t)T * DSH * 2;
constexpr size_t WS_TOPE = WS_SH + (size_t)T * DM * 2;
constexpr size_t WS_TOPW = WS_TOPE + (size_t)NA * 4;
constexpr size_t WS_APOS = WS_TOPW + (size_t)NA * 4;
constexpr size_t WS_ROWA = WS_APOS + (size_t)NA * 4;
constexpr size_t WS_HIST = WS_ROWA + (size_t)NA * 8;
constexpr size_t WS_PO = WS_HIST + (size_t)1024 * 256 * 4;
constexpr size_t WS_PML = WS_PO + (size_t)T * 8 * 3 * 64 * 2;
constexpr size_t WS_HE = WS_PML + (size_t)T * 8 * 3 * 128;
constexpr size_t WS_Y = WS_HE + (size_t)NA * DE * 2;
constexpr size_t WS_PROJ = WS_Y + (size_t)NA * DM * 2;
constexpr size_t SZ_WEGU = (size_t)NE * 512 * DM, SZ_WED = (size_t)NE * DM * DE;
constexpr size_t WS_WEGU = WS_PROJ + (size_t)T * INCP * 2;
constexpr size_t WS_WED = WS_WEGU + 2 * SZ_WEGU * 2;
constexpr size_t WS_FAST_END = WS_WED + 2 * SZ_WED * 2;
constexpr size_t WS_NEED = WS_FAST_END;
static_assert(WS_NEED <= (size_t)2040 * MiB, "ws map");

constexpr int LDS_BYTES = 147456;
constexpr int RING_BYTES = 131072, MISC_OFF = RING_BYTES + 1024, TAB_OFF = RING_BYTES + 2048;

struct Frame { LAS unsigned char* lds; int tid, lane, wave, G, vcu; };

template <class RowMap>
__device__ __forceinline__ void transpose_item(const float* W, int K, int N, bf16_t* WT, int ldk, RowMap rm, LAS float* scr, int item, int lane) {
    const int nblk = N / 32, kb = item / nblk, nb = item % nblk, k0 = 64 * kb, n0 = 32 * nb;
#pragma unroll 8
    for (int i = 0; i < 32; ++i) { const int kk = 2 * i + (lane >> 5); scr[kk * 33 + (lane & 31)] = W[(size_t)(k0 + kk) * N + n0 + (lane & 31)]; }
    LDS_WAIT(); asm volatile("" ::: "memory");
    const int c = lane & 7;
#pragma unroll
    for (int j = 0; j < 4; ++j) { const int n = (lane >> 3) + 8 * j; const LAS float* s = scr + (8 * c) * 33 + n;
        u32x4 o; o.x = pk2(s[0 * 33], s[1 * 33]); o.y = pk2(s[2 * 33], s[3 * 33]); o.z = pk2(s[4 * 33], s[5 * 33]); o.w = pk2(s[6 * 33], s[7 * 33]);
        *(u32x4*)(WT + (size_t)rm(n0 + n) * ldk + k0 + 8 * c) = o; }
    LDS_WAIT(); asm volatile("" ::: "memory");
}
template <class RowMap>
__device__ __forceinline__ void transpose_item64(const float* W, int K, int N, bf16_t* WT, int ldk, RowMap rm, LAS unsigned short* scr, int item, int lane) {
    const int nblk = N / 64, kb = item / nblk, nb = item % nblk, k0 = 64 * kb, n0 = 64 * nb, r = lane >> 4, c4 = (lane & 15) * 4;
    f32x4 v[16];
#pragma unroll
    for (int i = 0; i < 16; ++i) v[i] = __builtin_nontemporal_load((const f32x4*)(W + (size_t)(k0 + 4 * i + r) * N + n0 + c4));
#pragma unroll
    for (int i = 0; i < 16; ++i) { LAS unsigned* d = (LAS unsigned*)(scr + (4 * i + r) * 66 + c4); d[0] = pk2(v[i][0], v[i][1]); d[1] = pk2(v[i][2], v[i][3]); }
    LDS_WAIT(); asm volatile("" ::: "memory");
    const int c = lane & 7;
#pragma unroll
    for (int j = 0; j < 8; ++j) { const int n = (lane >> 3) + 8 * j; const LAS unsigned short* q = scr + (8 * c) * 66 + n;
        u32x4 o; o.x = (unsigned)q[0] | ((unsigned)q[66] << 16); o.y = (unsigned)q[2 * 66] | ((unsigned)q[3 * 66] << 16); o.z = (unsigned)q[4 * 66] | ((unsigned)q[5 * 66] << 16); o.w = (unsigned)q[6 * 66] | ((unsigned)q[7 * 66] << 16);
        *(u32x4*)(WT + (size_t)rm(n0 + n) * ldk + k0 + 8 * c) = o; }
    LDS_WAIT(); asm volatile("" ::: "memory");
}
struct RowId { __device__ __forceinline__ int operator()(int n) const { return n; } };

struct EpiProj {
    static constexpr int MIDK = 0;
    bf16_t* O; const float* bg;
    __device__ __forceinline__ void operator()(const f32x4 (&acc)[2][2][4][2], const pg8::Unit& u, int wr, int wc, int fr, int fq) const {
        PG8_TILE_BEGIN(acc, wr, wc, fr, fq)
            const int row = u.pm * 256 + trow, col = u.pn * 256 + tcol;
            if (col < C_KA) { v0 = v0 * QS_A; v1 = v1 * QS_A; }
            else if (col >= C_GA && col < INC) { const f32x4 b0 = *(const f32x4*)(bg + col - C_GA), b1 = *(const f32x4*)(bg + col - C_GA + 4);
#pragma unroll
                for (int i = 0; i < 4; ++i) { v0[i] = sigmoidf_(v0[i] + b0[i]); v1[i] = sigmoidf_(v1[i] + b1[i]); } }
            *(u32x4*)(O + (size_t)row * INCP + col) = pg8::pack8(v0, v1);
        PG8_TILE_END
    }
};

struct RowQ { __device__ __forceinline__ int operator()(int n) const { const int h = n / 96, d = n % 96; if (d < 64) return n; const int i = d - 64; return h * 96 + 64 + (i < 16 ? 2 * i : 2 * (i - 16) + 1); } };

struct EpiQ {
    static constexpr int MIDK = 0;
    bf16_t* O; const f32x2* CS;
    __device__ __forceinline__ void operator()(const f32x4 (&acc)[2][2][4][2], const pg8::Unit& u, int wr, int wc, int fr, int fq) const {
        PG8_TILE_BEGIN(acc, wr, wc, fr, fq)
            const int row = u.pm * 256 + trow, col = u.pn * 256 + tcol, d = col % 96;
            if (d >= 64) { const int pos = row % SEQ, i0 = (d - 64) >> 1; const f32x2* cs = CS + (size_t)pos * 16 + i0;
                const f32x2 c0 = cs[0], c1 = cs[1], c2 = cs[2], c3 = cs[3];
                const f32x4 a = v0, b = v1;
                v0[0] = a[0] * c0[0] - a[1] * c0[1]; v0[1] = a[1] * c0[0] + a[0] * c0[1]; v0[2] = a[2] * c1[0] - a[3] * c1[1]; v0[3] = a[3] * c1[0] + a[2] * c1[1];
                v1[0] = b[0] * c2[0] - b[1] * c2[1]; v1[1] = b[1] * c2[0] + b[0] * c2[1]; v1[2] = b[2] * c3[0] - b[3] * c3[1]; v1[3] = b[3] * c3[0] + b[2] * c3[1]; }
            v0 = v0 * QS_B; v1 = v1 * QS_B;
            *(u32x4*)(O + (size_t)row * 768 + col) = pg8::pack8(v0, v1);
        PG8_TILE_END
    }
};
struct EpiKV {
    static constexpr int MIDK = 0;
    bf16_t* KB; bf16_t* VB;
    __device__ __forceinline__ void operator()(const f32x4 (&acc)[2][2][4][2], const pg8::Unit& u, int wr, int wc, int fr, int fq) const {
        PG8_TILE_BEGIN(acc, wr, wc, fr, fq)
            const int row = u.pm * 256 + trow, col = u.pn * 256 + tcol, h = col >> 7, j = col & 127;
            bf16_t* dst = (j < 64) ? KB + (size_t)row * 768 + h * 96 + j : VB + (size_t)row * 512 + h * 64 + (j - 64);
            *(u32x4*)dst = pg8::pack8(v0, v1);
        PG8_TILE_END
    }
};

__device__ __forceinline__ void prep_phase(const Frame& F, const bf16_t* PROJ, const float* qn, const float* kvn, const f32x2* CS, bf16_t* CQN, bf16_t* CKVN, bf16_t* KB, float* KM) {
    int lane_ = F.lane; asm volatile("" : "+v"(lane_));
    const int gw = F.vcu * NWAVES + F.wave, NGW = F.G * NWAVES, lane = lane_;
    for (int row = gw; row < T; row += NGW) {
        const bf16_t* p = PROJ + (size_t)row * INCP;
        u32x4 a = (u32x4){0u, 0u, 0u, 0u}, b = (u32x4){0u, 0u, 0u, 0u};
        if (lane < 48) a = *(const u32x4*)(p + C_CQ + lane * 8);
        if (lane < 32) b = *(const u32x4*)(p + C_CKV + lane * 8);
        float sq = 0.f, sk = 0.f;
#pragma unroll
        for (int i = 0; i < 4; ++i) { const float x = bflo(a[i]), y = bfhi(a[i]), z = bflo(b[i]), w = bfhi(b[i]); sq += x * x + y * y; sk += z * z + w * w; }
        sq = wave_sum(sq); sk = wave_sum(sk);
        const float rq = rsqrtf(sq * (1.f / QL) + RMS_EPS), rk = rsqrtf(sk * (1.f / KVL) + RMS_EPS);
        if (lane < 48) { const f32x4 g0 = *(const f32x4*)(qn + lane * 8), g1 = *(const f32x4*)(qn + lane * 8 + 4); u32x4 o;
            o.x = pk2(bflo(a.x) * rq * g0[0], bfhi(a.x) * rq * g0[1]); o.y = pk2(bflo(a.y) * rq * g0[2], bfhi(a.y) * rq * g0[3]);
            o.z = pk2(bflo(a.z) * rq * g1[0], bfhi(a.z) * rq * g1[1]); o.w = pk2(bflo(a.w) * rq * g1[2], bfhi(a.w) * rq * g1[3]);
            *(u32x4*)(CQN + (size_t)row * QL + lane * 8) = o; }
        if (lane < 32) { const f32x4 g0 = *(const f32x4*)(kvn + lane * 8), g1 = *(const f32x4*)(kvn + lane * 8 + 4); u32x4 o;
            o.x = pk2(bflo(b.x) * rk * g0[0], bfhi(b.x) * rk * g0[1]); o.y = pk2(bflo(b.y) * rk * g0[2], bfhi(b.y) * rk * g0[3]);
            o.z = pk2(bflo(b.z) * rk * g1[0], bfhi(b.z) * rk * g1[1]); o.w = pk2(bflo(b.w) * rk * g1[2], bfhi(b.w) * rk * g1[3]);
            *(u32x4*)(CKVN + (size_t)row * KVL + lane * 8) = o; }
        if (lane < 16) { const float x1 = bf2f(p[C_KR + lane]), x2 = bf2f(p[C_KR + 16 + lane]); const f32x2 cs = CS[(size_t)(row % SEQ) * 16 + lane];
            const unsigned w = pk2(x1 * cs[0] - x2 * cs[1], x2 * cs[0] + x1 * cs[1]);
#pragma unroll
            for (int h = 0; h < 8; ++h) *(unsigned*)(KB + (size_t)row * 768 + h * 96 + 64 + 2 * lane) = w; }
    }
    for (int it = gw; it < NB * NBLK * HA; it += NGW) {
        const int h = it % HA, blk = (it / HA) % NBLK, b = it / (HA * NBLK), c = lane & 7, r0 = lane >> 3;
        const bf16_t* p = PROJ + ((size_t)b * SEQ + (size_t)blk * BLK + r0) * INCP + C_KA + h * 64 + c * 8;
        float s[8];
#pragma unroll
        for (int i = 0; i < 8; ++i) s[i] = 0.f;
        for (int i = 0; i < 32; ++i) { const u32x4 v = *(const u32x4*)(p + (size_t)i * 8 * INCP);
#pragma unroll
            for (int k = 0; k < 4; ++k) { s[2 * k] += bflo(v[k]); s[2 * k + 1] += bfhi(v[k]); } }
#pragma unroll
        for (int i = 0; i < 8; ++i) { s[i] += __shfl_xor(s[i], 8); s[i] += __shfl_xor(s[i], 16); s[i] += __shfl_xor(s[i], 32); }
        if (lane < 8) { float* o = KM + ((size_t)(b * HA + h) * NBLK + blk) * 64 + c * 8;
            *(f32x4*)o = (f32x4){s[0], s[1], s[2], s[3]} * (1.f / BLK); *(f32x4*)(o + 4) = (f32x4){s[4], s[5], s[6], s[7]} * (1.f / BLK); }
    }
}
__device__ __forceinline__ void mobasel_phase(const Frame& F, const bf16_t* PROJ, const float* KM, unsigned* SEL) {
    int tid_ = F.tid; asm volatile("" : "+v"(tid_));
    const int TPW = T / F.G, row0 = (int)blockIdx.x * TPW, b = row0 / SEQ, own = (row0 % SEQ) / BLK, hs = own * 64 + 4;
    LAS float* km = (LAS float*)F.lds;
    for (int i = tid_; i < 8 * own * 16; i += NTHR) { const int h = i / (own * 16), r = i % (own * 16);
        *(LAS f32x4*)(km + h * hs + r * 4) = *(const f32x4*)(KM + ((size_t)(b * HA + h) * NBLK) * 64 + r * 4); }
    __syncthreads();
    for (int idx = tid_; idx < TPW * 8; idx += NTHR) {
        const int h = idx & 7, row = row0 + (idx >> 3);
        const bf16_t* qp = PROJ + (size_t)row * INCP + C_QA + h * 64;
        float q[64];
#pragma unroll
        for (int i = 0; i < 8; ++i) { const u32x4 v = *(const u32x4*)(qp + i * 8);
#pragma unroll
            for (int k = 0; k < 4; ++k) { q[i * 8 + 2 * k] = bflo(v[k]); q[i * 8 + 2 * k + 1] = bfhi(v[k]); } }
        float v1 = -INFINITY, v2 = -INFINITY, v3 = -INFINITY; int i1 = -1, i2 = -1, i3 = -1;
        for (int j = 0; j < own; ++j) {
            const LAS f32x4* kp = (const LAS f32x4*)(km + h * hs + j * 64);
            float g0 = 0.f, g1 = 0.f, g2 = 0.f, g3 = 0.f;
#pragma unroll
            for (int c = 0; c < 16; ++c) { const f32x4 k4 = kp[c]; g0 = fmaf(q[4 * c], k4[0], g0); g1 = fmaf(q[4 * c + 1], k4[1], g1); g2 = fmaf(q[4 * c + 2], k4[2], g2); g3 = fmaf(q[4 * c + 3], k4[3], g3); }
            const float g = (g0 + g1) + (g2 + g3);
            if (g > v1) { v3 = v2; i3 = i2; v2 = v1; i2 = i1; v1 = g; i1 = j; }
            else if (g > v2) { v3 = v2; i3 = i2; v2 = g; i2 = j; }
            else if (g > v3) { v3 = g; i3 = j; }
        }
        unsigned m = 0;
        if (i1 >= 0) m |= 1u << i1;
        if (i2 >= 0) m |= 1u << i2;
        if (i3 >= 0) m |= 1u << i3;
        SEL[(size_t)row * 8 + h] = m;
    }
    __syncthreads();
}

struct EpiGate2 {
    static constexpr int MIDK = 8;
    const bf16_t* PROJ; bf16_t* MRG;
    __device__ __forceinline__ void mid(f32x4 (&acc)[2][2][4][2], const pg8::Unit& u, int wr, int wc, int fr_, int fq) const {
        int fr = fr_; asm volatile("" : "+v"(fr));
#pragma unroll
        for (int ai = 0; ai < 2; ++ai)
#pragma unroll
            for (int m = 0; m < 4; ++m)
#pragma unroll
                for (int bj = 0; bj < 2; ++bj) { const size_t o = (size_t)(u.pm * 256 + ai * 128 + wr * 64 + m * 16 + fr) * INCP + u.pn * 256 + bj * 128 + wc * 32 + 8 * fq;
                    const u32x4 ga = *(const u32x4*)(PROJ + o + C_GA), gb = *(const u32x4*)(PROJ + o + C_GB);
#pragma unroll
                    for (int i = 0; i < 4; ++i) { const float r0 = bflo(ga[i]) * __builtin_amdgcn_rcpf(bflo(gb[i])), r1 = bfhi(ga[i]) * __builtin_amdgcn_rcpf(bfhi(gb[i]));
                        acc[ai][bj][m][i >> 1][2 * (i & 1)] *= r0; acc[ai][bj][m][i >> 1][2 * (i & 1) + 1] *= r1; }
                    __builtin_amdgcn_sched_barrier(0); }
    }
    __device__ __forceinline__ void operator()(const f32x4 (&acc)[2][2][4][2], const pg8::Unit& u, int wr, int wc, int fr, int fq) const {
        PG8_TILE_BEGIN(acc, wr, wc, fr, fq)
            const int row = u.pm * 256 + trow, col = u.pn * 256 + tcol;
            const u32x4 g = *(const u32x4*)(PROJ + (size_t)row * INCP + C_GB + col);
            v0[0] *= bflo(g.x); v0[1] *= bfhi(g.x); v0[2] *= bflo(g.y); v0[3] *= bfhi(g.y); v1[0] *= bflo(g.z); v1[1] *= bfhi(g.z); v1[2] *= bflo(g.w); v1[3] *= bfhi(g.w);
            *(u32x4*)(MRG + (size_t)row * DM + col) = pg8::pack8(v0, v1);
        PG8_TILE_END
    }
};
struct EpiResid {
    static constexpr int MIDK = 0;
    const bf16_t* X; bf16_t* PRE;
    __device__ __forceinline__ void operator()(const f32x4 (&acc)[2][2][4][2], const pg8::Unit& u, int wr, int wc, int fr, int fq) const {
        PG8_TILE_BEGIN(acc, wr, wc, fr, fq)
            const size_t o = (size_t)(u.pm * 256 + trow) * DM + u.pn * 256 + tcol;
            const u32x4 x = *(const u32x4*)(X + o);
            v0[0] += ALPHA * bflo(x.x); v0[1] += ALPHA * bfhi(x.x); v0[2] += ALPHA * bflo(x.y); v0[3] += ALPHA * bfhi(x.y);
            v1[0] += ALPHA * bflo(x.z); v1[1] += ALPHA * bfhi(x.z); v1[2] += ALPHA * bflo(x.w); v1[3] += ALPHA * bfhi(x.w);
            *(u32x4*)(PRE + o) = pg8::pack8(v0, v1);
        PG8_TILE_END
    }
};
__device__ __forceinline__ void ln_phase(const Frame& F, const bf16_t* PRE, const float* g, const float* bt, bf16_t* XBo) {
    int lane_ = F.lane; asm volatile("" : "+v"(lane_));
    const int gw = F.vcu * NWAVES + F.wave, NGW = F.G * NWAVES, lane = lane_;
    for (int row = gw; row < T; row += NGW) {
        const u32x2* pr = (const u32x2*)(PRE + (size_t)row * DM) + lane;
        f32x4 v[4]; float s = 0.f;
#pragma unroll
        for (int j = 0; j < 4; ++j) { const u32x2 h = pr[64 * j]; v[j] = (f32x4){bflo(h.x), bfhi(h.x), bflo(h.y), bfhi(h.y)}; s += (v[j][0] + v[j][1]) + (v[j][2] + v[j][3]); }
        const float mean = wave_sum(s) * (1.f / DM); float s2 = 0.f;
#pragma unroll
        for (int j = 0; j < 4; ++j) { v[j] = v[j] - mean; s2 += (v[j][0] * v[j][0] + v[j][1] * v[j][1]) + (v[j][2] * v[j][2] + v[j][3] * v[j][3]); }
        const float rstd = rsqrtf(wave_sum(s2) * (1.f / DM) + LN_EPS);
#pragma unroll
        for (int j = 0; j < 4; ++j) { const f32x4 gg = ((const f32x4*)g)[lane + 64 * j], bb = ((const f32x4*)bt)[lane + 64 * j];
            const f32x4 y = v[j] * rstd * gg + bb;
            u32x2 w; w.x = pk2(y[0], y[1]); w.y = pk2(y[2], y[3]); ((u32x2*)(XBo + (size_t)row * DM))[lane + 64 * j] = w; }
    }
}

struct RowGU { int off; __device__ __forceinline__ int operator()(int n) const { return 256 * (n >> 7) + off + (n & 127); } };

struct EpiF32 {
    static constexpr int MIDK = 0;
    float* O; int ld;
    __device__ __forceinline__ void operator()(const f32x4 (&acc)[2][2][4][2], const pg8::Unit& u, int wr, int wc, int fr, int fq) const {
        PG8_TILE_BEGIN(acc, wr, wc, fr, fq)
            float* o = O + (size_t)(u.pm * 256 + trow) * ld + u.pn * 256 + tcol; *(f32x4*)o = v0; *(f32x4*)(o + 4) = v1;
        PG8_TILE_END
    }
};
struct EpiBf16 {
    static constexpr int MIDK = 0;
    bf16_t* O; int ld;
    __device__ __forceinline__ void operator()(const f32x4 (&acc)[2][2][4][2], const pg8::Unit& u, int wr, int wc, int fr, int fq) const {
        PG8_TILE_BEGIN(acc, wr, wc, fr, fq)
            *(u32x4*)(O + (size_t)(u.pm * 256 + trow) * ld + u.pn * 256 + tcol) = pg8::pack8(v0, v1);
        PG8_TILE_END
    }
};
__device__ __forceinline__ float silu_mul(float g, float u) { return g * __builtin_amdgcn_rcpf(1.f + __expf(-g)) * u; }
struct EpiSwiGLU {
    static constexpr int MIDK = 0;
    bf16_t* H; int ld;
    __device__ __forceinline__ void operator()(const f32x4 (&acc)[2][2][4][2], const pg8::Unit& u, int wr, int wc, int fr, int fq) const {
#pragma unroll
        for (int ai = 0; ai < 2; ++ai)
#pragma unroll
            for (int m = 0; m < 4; ++m) { const int row = u.r0 + ai * 128 + wr * 64 + m * 16 + fr;
                if (row < u.rend) { f32x4 h0, h1;
#pragma unroll
                    for (int i = 0; i < 4; ++i) { h0[i] = silu_mul(acc[ai][0][m][0][i], acc[ai][1][m][0][i]); h1[i] = silu_mul(acc[ai][0][m][1][i], acc[ai][1][m][1][i]); }
                    *(u32x4*)(H + (size_t)row * ld + 128 * u.pn + wc * 32 + 8 * fq) = pg8::pack8(h0, h1); } }
    }
};
struct EpiExpDown {
    static constexpr int MIDK = 0;
    bf16_t* Y; const int* ROWA;
    __device__ __forceinline__ void operator()(const f32x4 (&acc)[2][2][4][2], const pg8::Unit& u, int wr, int wc, int fr, int fq) const {
        u32x2 aw[2][4];
#pragma unroll
        for (int ai = 0; ai < 2; ++ai)
#pragma unroll
            for (int m = 0; m < 4; ++m) { const int row = min(u.r0 + ai * 128 + wr * 64 + m * 16 + fr, u.rend - 1); aw[ai][m] = *(const u32x2*)(ROWA + 2 * (size_t)row); }
#pragma unroll
        for (int ai = 0; ai < 2; ++ai)
#pragma unroll
            for (int m = 0; m < 4; ++m) { const int row = u.r0 + ai * 128 + wr * 64 + m * 16 + fr;
                if (row < u.rend) { const int a = (int)aw[ai][m].x; const float w = __uint_as_float(aw[ai][m].y);
#pragma unroll
                    for (int bj = 0; bj < 2; ++bj) *(u32x4*)(Y + (size_t)a * DM + 256 * u.pn + bj * 128 + wc * 32 + 8 * fq) = pg8::pack8(acc[ai][bj][m][0] * w, acc[ai][bj][m][1] * w); } }
    }
};
template <int NPN, bool GATHER>
struct ExpertOrder {
    const LAS int* off; const LAS int* toff; const int* rowa; int G, c; size_t strideE;
    __device__ __forceinline__ bool next(int i, pg8::Unit& u) const {
        const int L = i * G + c; if (L >= toff[256] * NPN) return false;
        const int tile = L / NPN; u.pn = L % NPN; int lo = 0, hi = 255;
        while (lo < hi) { const int mid = (lo + hi + 1) >> 1; if (toff[mid] <= tile) lo = mid; else hi = mid - 1; }
        u.e = lo; u.r0 = off[lo] + (tile - toff[lo]) * 256; u.rend = off[lo + 1]; u.pm = 0; return true;
    }
    __device__ __forceinline__ int a_row(const pg8::Unit& u, int r) const { const int rr = min(u.r0 + r, u.rend - 1); return GATHER ? (rowa[2 * rr] >> 3) : rr; }
    __device__ __forceinline__ const char* b_ptr(const pg8::Gemm& g, const pg8::Unit& u) const { return (const char*)g.Bt + (size_t)u.e * strideE + (size_t)u.pn * 256 * g.ldb * 2; }
};
__device__ __forceinline__ void expert_tables(const Frame& F, const unsigned* cnt, LAS int* off, LAS int* toff) {
    if (F.tid < 256) { off[F.tid] = (int)cnt[F.tid]; }
    __syncthreads();
    if (F.tid == 0) { int a = 0, b = 0; for (int i = 0; i < 256; ++i) { const int c = off[i]; off[i] = a; toff[i] = b; a += c; b += (c + 255) >> 8; } off[256] = a; toff[256] = b; }
    __syncthreads();
}
__device__ __forceinline__ void route_phase(const Frame& F, const float* LOGITS, const float* rbias, int* TOPE, float* TOPW, int* APOS, int* HIST, LAS int* lcnt) {
    int lane_ = F.lane; asm volatile("" : "+v"(lane_));
    const int lane = lane_, TPW = T / F.G, t0 = (int)blockIdx.x * TPW;
    if (F.tid < 256) lcnt[F.tid] = 0;
    __syncthreads();
    const f32x4 rb = *(const f32x4*)(rbias + lane * 4);
    for (int t = t0 + F.wave; t < t0 + TPW; t += NWAVES) {
        const f32x4 lg = *(const f32x4*)(LOGITS + (size_t)t * NE + lane * 4);
        const float s0 = 1.f / (1.f + expf(-lg[0])), s1 = 1.f / (1.f + expf(-lg[1])), s2 = 1.f / (1.f + expf(-lg[2])), s3 = 1.f / (1.f + expf(-lg[3]));
        float c0 = s0 + rb[0], c1 = s1 + rb[1], c2 = s2 + rb[2], c3 = s3 + rb[3];
        float a = fmaxf(c0, c1), bq = fminf(c0, c1);
        { const float hi2 = fmaxf(c2, c3), lo2 = fminf(c2, c3); const float na = fmaxf(a, hi2), nb = fmaxf(fminf(a, hi2), fmaxf(bq, lo2)); a = na; bq = nb; }
#pragma unroll
        for (int o = 1; o < 8; o <<= 1) { const float oa = __shfl_xor(a, o), ob = __shfl_xor(bq, o); const float na = fmaxf(a, oa), nb = fmaxf(fminf(a, oa), fmaxf(bq, ob)); a = na; bq = nb; }
        const float gs = a + bq; const int grp = lane >> 3;
        int rank = 0;
#pragma unroll
        for (int j = 0; j < 8; ++j) { const float og = __shfl(gs, j * 8); rank += (og > gs || (og == gs && j < grp)) ? 1 : 0; }
        if (rank >= 4) { c0 = c1 = c2 = c3 = -INFINITY; }
        float wsum = 0.f, myw = 0.f; int mye = 0;
#pragma unroll
        for (int k = 0; k < TOPK; ++k) {
            float bv = c0; int bi = 0;
            if (c1 > bv) { bv = c1; bi = 1; }
            if (c2 > bv) { bv = c2; bi = 2; }
            if (c3 > bv) { bv = c3; bi = 3; }
            int be = lane * 4 + bi;
#pragma unroll
            for (int o = 1; o < 64; o <<= 1) { const float ov = __shfl_xor(bv, o); const int oe = __shfl_xor(be, o); if (ov > bv || (ov == bv && oe < be)) { bv = ov; be = oe; } }
            float sc = 0.f;
            if ((be >> 2) == lane) { const int b2 = be & 3; sc = b2 == 0 ? s0 : b2 == 1 ? s1 : b2 == 2 ? s2 : s3; if (b2 == 0) c0 = -INFINITY; else if (b2 == 1) c1 = -INFINITY; else if (b2 == 2) c2 = -INFINITY; else c3 = -INFINITY; }
            sc = __shfl(sc, be >> 2);
            wsum += sc;
            if (lane == k) { myw = sc; mye = be; }
        }
        if (lane < TOPK) { const int aidx = t * TOPK + lane; TOPE[aidx] = mye; TOPW[aidx] = myw / wsum * 2.5f; APOS[aidx] = __hip_atomic_fetch_add(lcnt + mye, 1, __ATOMIC_RELAXED, __HIP_MEMORY_SCOPE_WORKGROUP); }
    }
    __syncthreads();
    if (F.tid < 256) HIST[(size_t)blockIdx.x * 256 + F.tid] = lcnt[F.tid];
}
__device__ __forceinline__ void combine_phase(const Frame& F, const bf16_t* X1, const bf16_t* SH, const bf16_t* Y, const float* g, const float* bt, float* Xo, bf16_t* XBo) {
    int lane_ = F.lane; asm volatile("" : "+v"(lane_));
    const int gw = F.vcu * NWAVES + F.wave, NGW = F.G * NWAVES, lane = lane_;
    for (int row = gw; row < T; row += NGW) {
        f32x4 v[4]; float s = 0.f;
#pragma unroll
        for (int j = 0; j < 4; ++j) { const u32x2 x = ((const u32x2*)(X1 + (size_t)row * DM))[lane + 64 * j]; v[j] = (f32x4){bflo(x.x), bfhi(x.x), bflo(x.y), bfhi(x.y)} * ALPHA;
            const u32x2 h = ((const u32x2*)(SH + (size_t)row * DM))[lane + 64 * j]; v[j][0] += bflo(h.x); v[j][1] += bfhi(h.x); v[j][2] += bflo(h.y); v[j][3] += bfhi(h.y); }
#pragma unroll
        for (int k = 0; k < TOPK; ++k) { const u32x2* yr = (const u32x2*)(Y + ((size_t)row * TOPK + k) * DM);
#pragma unroll
            for (int j = 0; j < 4; ++j) { const u32x2 h = yr[lane + 64 * j]; v[j][0] += bflo(h.x); v[j][1] += bfhi(h.x); v[j][2] += bflo(h.y); v[j][3] += bfhi(h.y); } }
#pragma unroll
        for (int j = 0; j < 4; ++j) s += (v[j][0] + v[j][1]) + (v[j][2] + v[j][3]);
        const float mean = wave_sum(s) * (1.f / DM); float s2 = 0.f;
#pragma unroll
        for (int j = 0; j < 4; ++j) { v[j] = v[j] - mean; s2 += (v[j][0] * v[j][0] + v[j][1] * v[j][1]) + (v[j][2] * v[j][2] + v[j][3] * v[j][3]); }
        const float rstd = rsqrtf(wave_sum(s2) * (1.f / DM) + LN_EPS);
#pragma unroll
        for (int j = 0; j < 4; ++j) { const f32x4 gg = ((const f32x4*)g)[lane + 64 * j], bb = ((const f32x4*)bt)[lane + 64 * j];
            const f32x4 y = v[j] * rstd * gg + bb;
            if (Xo) ((f32x4*)(Xo + (size_t)row * DM))[lane + 64 * j] = y;
            if (XBo) { u32x2 w; w.x = pk2(y[0], y[1]); w.y = pk2(y[2], y[3]); ((u32x2*)(XBo + (size_t)row * DM))[lane + 64 * j] = w; } }
    }
}

__device__ __forceinline__ int crow(int r, int hi) { return (r & 3) + 8 * (r >> 2) + 4 * hi; }
typedef short s16x4 __attribute__((ext_vector_type(4)));
__device__ __forceinline__ s16x4 vtr(const LAS unsigned char* p) { return __builtin_bit_cast(s16x4, __builtin_amdgcn_ds_read_tr16_b64_v4i16((LAS s16x4*)p)); }
__device__ __forceinline__ float xhalf_max(float v) { auto rr = __builtin_amdgcn_permlane32_swap(__float_as_uint(v), __float_as_uint(v), false, false); return fmaxf(__uint_as_float(rr[0]), __uint_as_float(rr[1])); }
__device__ __forceinline__ float xhalf_sum(float v) { auto rr = __builtin_amdgcn_permlane32_swap(__float_as_uint(v), __float_as_uint(v), false, false); return __uint_as_float(rr[0]) + __uint_as_float(rr[1]); }

template <int DQK, bool ALIBI>
__device__ __forceinline__ void attn_tile(const LAS unsigned char* kb, int kfo, int vfo, const bf16x8 (&qf)[DQK / 16], float& m, float& l, f32x16& o0, f32x16& o1, int hi, int tq, int kpos0, float slope2, bool causal) {
    constexpr int ND0 = DQK / 16;
    bf16x8 ka[ND0], kc[ND0];
#pragma unroll
    for (int d0 = 0; d0 < ND0; ++d0) { ka[d0] = *(const LAS bf16x8*)(kb + kfo + d0 * 2048); kc[d0] = *(const LAS bf16x8*)(kb + kfo + d0 * 2048 + 512); }
    __builtin_amdgcn_sched_barrier(0);
    f32x16 p0, p1;
#pragma unroll
    for (int r = 0; r < 16; ++r) { p0[r] = 0.f; p1[r] = 0.f; }
#pragma unroll
    for (int d0 = 0; d0 < ND0; ++d0) {
        p0 = __builtin_amdgcn_mfma_f32_32x32x16_bf16(ka[d0], qf[d0], p0, 0, 0, 0);
        p1 = __builtin_amdgcn_mfma_f32_32x32x16_bf16(kc[d0], qf[d0], p1, 0, 0, 0);
    }
    s16x4 vlo[8], vhi[8];
    { const unsigned va = (unsigned)(uintptr_t)(kb + vfo);
#pragma unroll
      for (int i = 0; i < 8; ++i) {
        asm volatile("ds_read_b64_tr_b16 %0, %1 offset:%c2" : "=&v"(vlo[i]) : "v"(va), "i"((i >> 2) * 4096 + (i & 3) * 1024) : "memory");
        asm volatile("ds_read_b64_tr_b16 %0, %1 offset:%c2" : "=&v"(vhi[i]) : "v"(va), "i"((i >> 2) * 4096 + (i & 3) * 1024 + 512) : "memory"); } }
    const int krel = kpos0 + 4 * hi - tq;
    if (ALIBI) { const float bb = slope2 * (float)krel;
#pragma unroll
        for (int r = 0; r < 16; ++r) { const float c = (float)((r & 3) + 8 * (r >> 2)); p0[r] += fmaf(slope2, c, bb); p1[r] += fmaf(slope2, c + 32.f, bb); } }
    if (causal) {
#pragma unroll
        for (int r = 0; r < 16; ++r) { const int kv = krel + (r & 3) + 8 * (r >> 2); if (kv > 0) p0[r] = -INFINITY; if (kv + 32 > 0) p1[r] = -INFINITY; } }
    float rm = fmaxf(p0[0], p1[0]);
#pragma unroll
    for (int r = 1; r < 16; ++r) rm = fmaxf(rm, fmaxf(p0[r], p1[r]));
    rm = xhalf_max(rm);
    const float mn = fmaxf(m, rm), alpha = __builtin_amdgcn_exp2f(m - mn);
    m = mn;
    float ls = 0.f;
#pragma unroll
    for (int r = 0; r < 16; ++r) { p0[r] = __builtin_amdgcn_exp2f(p0[r] - mn); p1[r] = __builtin_amdgcn_exp2f(p1[r] - mn); ls += p0[r] + p1[r]; }
    l = l * alpha + ls;
#pragma unroll
    for (int r = 0; r < 16; ++r) { o0[r] *= alpha; o1[r] *= alpha; }
    const u32x4 pw0 = (u32x4){pg8::cvt_pk_bf16(p0[0], p0[1]), pg8::cvt_pk_bf16(p0[2], p0[3]), pg8::cvt_pk_bf16(p0[4], p0[5]), pg8::cvt_pk_bf16(p0[6], p0[7])};
    const u32x4 pw1 = (u32x4){pg8::cvt_pk_bf16(p0[8], p0[9]), pg8::cvt_pk_bf16(p0[10], p0[11]), pg8::cvt_pk_bf16(p0[12], p0[13]), pg8::cvt_pk_bf16(p0[14], p0[15])};
    const u32x4 pw2 = (u32x4){pg8::cvt_pk_bf16(p1[0], p1[1]), pg8::cvt_pk_bf16(p1[2], p1[3]), pg8::cvt_pk_bf16(p1[4], p1[5]), pg8::cvt_pk_bf16(p1[6], p1[7])};
    const u32x4 pw3 = (u32x4){pg8::cvt_pk_bf16(p1[8], p1[9]), pg8::cvt_pk_bf16(p1[10], p1[11]), pg8::cvt_pk_bf16(p1[12], p1[13]), pg8::cvt_pk_bf16(p1[14], p1[15])};
    asm volatile("s_waitcnt lgkmcnt(0)" ::: "memory"); __builtin_amdgcn_sched_barrier(0);
#define ATT_VF(i) (bf16x8){vlo[i][0], vlo[i][1], vlo[i][2], vlo[i][3], vhi[i][0], vhi[i][1], vhi[i][2], vhi[i][3]}
    o0 = __builtin_amdgcn_mfma_f32_32x32x16_bf16(ATT_VF(0), __builtin_bit_cast(bf16x8, pw0), o0, 0, 0, 0);
    o1 = __builtin_amdgcn_mfma_f32_32x32x16_bf16(ATT_VF(4), __builtin_bit_cast(bf16x8, pw0), o1, 0, 0, 0);
    o0 = __builtin_amdgcn_mfma_f32_32x32x16_bf16(ATT_VF(1), __builtin_bit_cast(bf16x8, pw1), o0, 0, 0, 0);
    o1 = __builtin_amdgcn_mfma_f32_32x32x16_bf16(ATT_VF(5), __builtin_bit_cast(bf16x8, pw1), o1, 0, 0, 0);
    o0 = __builtin_amdgcn_mfma_f32_32x32x16_bf16(ATT_VF(2), __builtin_bit_cast(bf16x8, pw2), o0, 0, 0, 0);
    o1 = __builtin_amdgcn_mfma_f32_32x32x16_bf16(ATT_VF(6), __builtin_bit_cast(bf16x8, pw2), o1, 0, 0, 0);
    o0 = __builtin_amdgcn_mfma_f32_32x32x16_bf16(ATT_VF(3), __builtin_bit_cast(bf16x8, pw3), o0, 0, 0, 0);
    o1 = __builtin_amdgcn_mfma_f32_32x32x16_bf16(ATT_VF(7), __builtin_bit_cast(bf16x8, pw3), o1, 0, 0, 0);
#undef ATT_VF
}
#define ATT_ISSUE(t, bo) do { \
        for (int c_ = wid; c_ < NCH; c_ += 8) __builtin_amdgcn_global_load_lds((const unsigned*)(ksrc + (size_t)(t) * 64 * ldk + c_ * 8), (LAS unsigned*)(lds + (bo) + c_ * 1024), 16, 0, 0); \
        __builtin_amdgcn_global_load_lds((const unsigned*)(vsrc + (size_t)(t) * 64 * ldv), (LAS unsigned*)(lds + (bo) + KBYTES + wid * 1024), 16, 0, 0); } while (0)

template <int DQK, bool MOBA_OWN>
__device__ __forceinline__ void attn_unit(LAS unsigned char* lds, int b, int h, int qb, const bf16_t* Qp, int ldq, const bf16_t* Kp, int ldk, const bf16_t* Vp, int ldv, bf16_t* Op, int ldo, const bf16_t* PO, const f32x2* PML) {
    constexpr int NCH = DQK / 8, KBYTES = NCH * 1024, BUFB = KBYTES + 8192, ND0 = DQK / 16;
    int tid_ = threadIdx.x; asm volatile("" : "+v"(tid_));
    const int lane = tid_ & 63, r32 = lane & 31, hi = lane >> 5, wid = __builtin_amdgcn_readfirstlane(tid_ >> 6);
    const size_t rowbase = (size_t)b * SEQ; const int q0 = qb * 256, T0 = MOBA_OWN ? 4 * qb : 0, T1 = 4 * (qb + 1), tq = q0 + wid * 32 + r32;
    const bf16_t* ksrc = Kp + (rowbase + lane) * ldk + h * DQK;
    const bf16_t* vsrc = Vp + (rowbase + 16 * (wid & 3) + (lane >> 2)) * ldv + h * 64 + (wid >> 2) * 32 + (lane & 3) * 8;
    ATT_ISSUE(T0, 0);
    bf16x8 qf[ND0];
    { const bf16_t* qrow = Qp + (rowbase + tq) * ldq + h * DQK + hi * 8;
#pragma unroll
      for (int d0 = 0; d0 < ND0; ++d0) qf[d0] = *(const bf16x8*)(qrow + d0 * 16); }
    const float slope2 = MOBA_OWN ? exp2f(-(float)(h + 1)) * LOG2E : 0.f;
    float m = -1e30f, l = 0.f;
    f32x16 o0, o1;
#pragma unroll
    for (int r = 0; r < 16; ++r) { o0[r] = 0.f; o1[r] = 0.f; }
    const int kfo = hi * 1024 + r32 * 16;
    const int vfo = KBYTES + ((lane >> 4) & 1) * 32 + (lane & 3) * 8 + (4 * hi + ((lane & 15) >> 2)) * 64;
#pragma unroll 1
    for (int t = T0; t < T1; ++t) {
        asm volatile("s_waitcnt vmcnt(0) lgkmcnt(0)\n\ts_barrier" ::: "memory");
        if (t + 1 < T1) ATT_ISSUE(t + 1, ((t + 1) & 1) * BUFB);
        attn_tile<DQK, MOBA_OWN>(lds + (t & 1) * BUFB, kfo, vfo, qf, m, l, o0, o1, hi, tq, 64 * t, slope2, t >= T1 - 4);
    }
    float lt = xhalf_sum(l);
    if (MOBA_OWN) {
        const int nsel = qb < 3 ? qb : 3;
        const size_t pidx = ((rowbase + tq) * 8 + h) * 3;
        float ms[3], ws[3], M = m;
#pragma unroll
        for (int sIdx = 0; sIdx < 3; ++sIdx) { ms[sIdx] = -1e30f; ws[sIdx] = 0.f; if (sIdx < nsel) { const f32x2 ml = PML[(pidx + sIdx) * 16]; ms[sIdx] = ml[0]; ws[sIdx] = ml[1]; M = fmaxf(M, ml[0]); } }
        const float w0 = __builtin_amdgcn_exp2f(m - M);
        lt *= w0;
#pragma unroll
        for (int r = 0; r < 16; ++r) { o0[r] *= w0; o1[r] *= w0; }
#pragma unroll
        for (int sIdx = 0; sIdx < 3; ++sIdx) if (sIdx < nsel) {
            const float w = ws[sIdx] * __builtin_amdgcn_exp2f(ms[sIdx] - M); lt += w;
            const bf16_t* po = PO + (pidx + sIdx) * 64 + 4 * hi;
#pragma unroll
            for (int r4 = 0; r4 < 4; ++r4) { const u32x2 a = *(const u32x2*)(po + 8 * r4), c = *(const u32x2*)(po + 32 + 8 * r4);
                o0[4 * r4] += w * bflo(a.x); o0[4 * r4 + 1] += w * bfhi(a.x); o0[4 * r4 + 2] += w * bflo(a.y); o0[4 * r4 + 3] += w * bfhi(a.y);
                o1[4 * r4] += w * bflo(c.x); o1[4 * r4 + 1] += w * bfhi(c.x); o1[4 * r4 + 2] += w * bflo(c.y); o1[4 * r4 + 3] += w * bfhi(c.y); } }
    }
    const float inv = 1.f / lt;
    bf16_t* orow = Op + (rowbase + tq) * ldo + h * 64 + 4 * hi;
#pragma unroll
    for (int r4 = 0; r4 < 4; ++r4) {
        u32x2 w0_, w1_;
        w0_.x = pg8::cvt_pk_bf16(o0[4 * r4] * inv, o0[4 * r4 + 1] * inv); w0_.y = pg8::cvt_pk_bf16(o0[4 * r4 + 2] * inv, o0[4 * r4 + 3] * inv);
        w1_.x = pg8::cvt_pk_bf16(o1[4 * r4] * inv, o1[4 * r4 + 1] * inv); w1_.y = pg8::cvt_pk_bf16(o1[4 * r4 + 2] * inv, o1[4 * r4 + 3] * inv);
        *(u32x2*)(orow + 8 * r4) = w0_; *(u32x2*)(orow + 32 + 8 * r4) = w1_;
    }
    asm volatile("s_waitcnt lgkmcnt(0)\n\ts_barrier" ::: "memory");
}
__device__ __forceinline__ void moba_sel_unit(LAS unsigned char* lds, int b, int h, int j, int slo, int shi, const bf16_t* Qp, const bf16_t* Kp, const bf16_t* Vp, int ldk, const unsigned* SEL, bf16_t* PO, f32x2* PML) {
    constexpr int DQK = 64, NCH = 8, KBYTES = 8192, BUFB = 16384, ldv = INCP; (void)ldv;
    int tid_ = threadIdx.x; asm volatile("" : "+v"(tid_));
    const int lane = tid_ & 63, r32 = lane & 31, hi = lane >> 5, wid = __builtin_amdgcn_readfirstlane(tid_ >> 6);
    const size_t rowbase = (size_t)b * SEQ;
    const bf16_t* ksrc = Kp + (rowbase + lane) * ldk + h * DQK;
    const bf16_t* vsrc = Vp + (rowbase + 16 * (wid & 3) + (lane >> 2)) * ldk + h * 64 + (wid >> 2) * 32 + (lane & 3) * 8;
#pragma unroll
    for (int tt = 0; tt < 4; ++tt) ATT_ISSUE(4 * j + tt, tt * BUFB);
    LAS unsigned short* list = (LAS unsigned short*)(lds + 4 * BUFB);
    LAS int* cnt = (LAS int*)(lds + 4 * BUFB + 4096);
    if (tid_ == 0) *cnt = 0;
    __syncthreads();
    const int nsrc = (shi - slo) * 256;
    for (int i = tid_; i < nsrc; i += NTHR) {
        const unsigned sm = SEL[(rowbase + (size_t)slo * 256 + i) * 8 + h];
        const bool f = ((sm >> j) & 1u) != 0u;
        const unsigned long long bal = __ballot(f);
        const int rank = __builtin_amdgcn_mbcnt_hi((unsigned)(bal >> 32), __builtin_amdgcn_mbcnt_lo((unsigned)bal, 0u));
        int base = 0;
        if (lane == 0) base = __hip_atomic_fetch_add(cnt, (int)__builtin_popcountll(bal), __ATOMIC_RELAXED, __HIP_MEMORY_SCOPE_WORKGROUP);
        base = __builtin_amdgcn_readfirstlane(base);
        if (f) list[base + rank] = (unsigned short)i;
    }
    asm volatile("s_waitcnt vmcnt(0)" ::: "memory");
    __syncthreads();
    const int n = *cnt, nch = (n + 31) >> 5;
    const float slope2 = exp2f(-(float)(h + 1)) * LOG2E;
    const int kfo = hi * 1024 + r32 * 16;
    const int vfo = KBYTES + ((lane >> 4) & 1) * 32 + (lane & 3) * 8 + (4 * hi + ((lane & 15) >> 2)) * 64;
    for (int ch = wid; ch < nch; ch += 8) {
        const int e = ch * 32 + r32; const bool valid = e < n;
        const int tq = slo * 256 + (int)list[valid ? e : n - 1];
        bf16x8 qf[4];
        { const bf16_t* qrow = Qp + (rowbase + tq) * INCP + h * DQK + hi * 8;
#pragma unroll
          for (int d0 = 0; d0 < 4; ++d0) qf[d0] = *(const bf16x8*)(qrow + d0 * 16); }
        const unsigned sm = SEL[(rowbase + tq) * 8 + h];
        float m = -1e30f, l = 0.f;
        f32x16 o0, o1;
#pragma unroll
        for (int r = 0; r < 16; ++r) { o0[r] = 0.f; o1[r] = 0.f; }
#pragma unroll 1
        for (int tt = 0; tt < 4; ++tt) attn_tile<64, true>(lds + tt * BUFB, kfo, vfo, qf, m, l, o0, o1, hi, tq, 256 * j + 64 * tt, slope2, false);
        const float lt = xhalf_sum(l), inv = 1.f / lt;
        if (valid) {
            const size_t pidx = ((rowbase + tq) * 8 + h) * 3 + __builtin_popcount(sm & ((1u << j) - 1u));
            if (hi == 0) PML[pidx * 16] = (f32x2){m, lt};
            bf16_t* po = PO + pidx * 64 + 4 * hi;
#pragma unroll
            for (int r4 = 0; r4 < 4; ++r4) {
                u32x2 w0_, w1_;
                w0_.x = pg8::cvt_pk_bf16(o0[4 * r4] * inv, o0[4 * r4 + 1] * inv); w0_.y = pg8::cvt_pk_bf16(o0[4 * r4 + 2] * inv, o0[4 * r4 + 3] * inv);
                w1_.x = pg8::cvt_pk_bf16(o1[4 * r4] * inv, o1[4 * r4 + 1] * inv); w1_.y = pg8::cvt_pk_bf16(o1[4 * r4 + 2] * inv, o1[4 * r4 + 3] * inv);
                *(u32x2*)(po + 8 * r4) = w0_; *(u32x2*)(po + 32 + 8 * r4) = w1_;
            }
        }
    }
    __syncthreads();
}
#undef ATT_ISSUE
__device__ __forceinline__ void mla_phase(const Frame& F, const bf16_t* QB, const bf16_t* KB, const bf16_t* VB, bf16_t* Op) {
    for (int u = 2 * F.vcu; u < 512; u += 2 * F.G) {
#pragma unroll 1
        for (int k = 0; k < 2; ++k) { const int uu = u + k, bh = uu >> 5, w = uu & 31, qb = (w & 1) ? (w >> 1) : 31 - (w >> 1);
            attn_unit<96, false>(F.lds, bh >> 3, bh & 7, qb, QB, 768, KB, 768, VB, 512, Op, 1024, nullptr, nullptr); }
    }
}
__device__ __forceinline__ void moba_sel_phase(const Frame& F, const bf16_t* PROJ, const unsigned* SEL, bf16_t* PO, f32x2* PML) {
#pragma unroll 1
    for (int u = (int)blockIdx.x; u < 16 * 136; u += F.G) {
        int p = 0; while (16 * (2 * (p + 1) * (p + 1) + (p + 1)) <= u) ++p;
        const int r = u - 16 * (2 * p * p + p), j = r >> 4, bh = r & 15;
        const int slo = (j + 1 > 4 * p) ? j + 1 : 4 * p, shi = 4 * p + 4;
        moba_sel_unit(F.lds, bh >> 3, bh & 7, j, slo, shi, PROJ + C_QA, PROJ + C_KA, PROJ + C_VA, INCP, SEL, PO, PML);
    }
}
__device__ __forceinline__ void moba_own_phase(const Frame& F, const bf16_t* PROJ, bf16_t* Op, const bf16_t* PO, const f32x2* PML) {
#pragma unroll 1
    for (int u = F.vcu; u < 512; u += F.G) { const int bh = u >> 5, qb = u & 31;
        attn_unit<64, true>(F.lds, bh >> 3, bh & 7, qb, PROJ + C_QA, INCP, PROJ + C_KA, INCP, PROJ + C_VA, INCP, Op, 1024, PO, PML); }
}

constexpr int NPH_L = 16;
__global__ void __launch_bounds__(NTHR, 2) mk(Params p) {
    extern __shared__ __attribute__((aligned(16))) unsigned char lds_raw[];
    Frame F;
    F.lds = (LAS unsigned char*)lds_raw;
    F.tid = threadIdx.x; F.lane = F.tid & 63; F.wave = __builtin_amdgcn_readfirstlane(F.tid >> 6);
    F.G = gridDim.x; { const int bx = blockIdx.x; F.vcu = (F.G % 8 == 0) ? (bx % 8) * (F.G / 8) + bx / 8 : bx; }
    volatile LAS unsigned* MISC = (volatile LAS unsigned*)(F.lds + MISC_OFF);
    if (F.tid < 32) MISC[F.tid] = 0u;
    __syncthreads();
    unsigned char* ws = p.ws;
    unsigned* ctl = (unsigned*)(ws + WS_CTL);
    XcdBarrier bar = xcd_barrier_post(ctl + CW_BAR, MISC + 8);
    const int lo = p.ph_lo, hi = p.ph_hi;
#define IN(k) (lo <= (k) && (k) < hi)
#define SEAM(k) do { if (IN(k) && IN((k) + 1)) xcd_barrier(bar); } while (0)
    bf16_t* WinT = (bf16_t*)(ws + WS_WIN);
    bf16_t* XB = (bf16_t*)(ws + WS_XB);
    bf16_t* PROJ = (bf16_t*)(ws + WS_PROJ);
    bf16_t* WuqT = (bf16_t*)(ws + WS_WUQ); bf16_t* WukvT = (bf16_t*)(ws + WS_WUKV);
    f32x2* CS = (f32x2*)(ws + WS_CS); float* KM = (float*)(ws + WS_KM); unsigned* SEL = (unsigned*)(ws + WS_SEL);
    bf16_t* CQN = (bf16_t*)(ws + WS_CQN); bf16_t* CKVN = (bf16_t*)(ws + WS_CKVN);
    bf16_t* WpaT = (bf16_t*)(ws + WS_WPA); bf16_t* WpbT = (bf16_t*)(ws + WS_WPB); bf16_t* WoutT = (bf16_t*)(ws + WS_WOUT);
    bf16_t* TMP = (bf16_t*)(ws + WS_TMP); bf16_t* MRG = (bf16_t*)(ws + WS_MRG); bf16_t* PRE = (bf16_t*)(ws + WS_PRE); bf16_t* X1B = (bf16_t*)(ws + WS_X1B);
    bf16_t* WrtT = (bf16_t*)(ws + WS_WRT); bf16_t* WsguT = (bf16_t*)(ws + WS_WSGU); bf16_t* WsdT = (bf16_t*)(ws + WS_WSD); bf16_t* WeguT = (bf16_t*)(ws + WS_WEGU); bf16_t* WedT = (bf16_t*)(ws + WS_WED);
    float* LOGITS = (float*)(ws + WS_LOG); bf16_t* HS = (bf16_t*)(ws + WS_HS); bf16_t* SH = (bf16_t*)(ws + WS_SH);
    int* TOPE = (int*)(ws + WS_TOPE); float* TOPW = (float*)(ws + WS_TOPW); int* APOS = (int*)(ws + WS_APOS); int* ROWA = (int*)(ws + WS_ROWA);
    bf16_t* PO = (bf16_t*)(ws + WS_PO); f32x2* PML = (f32x2*)(ws + WS_PML);
    bf16_t* HE = (bf16_t*)(ws + WS_HE); bf16_t* Yb = (bf16_t*)(ws + WS_Y); int* HIST = (int*)(ws + WS_HIST);
    LAS int* t_off = (LAS int*)(F.lds + TAB_OFF); LAS int* t_toff = t_off + 260;
    bf16_t* QB = (bf16_t*)(ws + WS_QB); bf16_t* KB = (bf16_t*)(ws + WS_KB); bf16_t* VB = (bf16_t*)(ws + WS_VB); bf16_t* OAB = (bf16_t*)(ws + WS_OAB);
    const int gw = F.vcu * NWAVES + F.wave, NGW = F.G * NWAVES;

    if (IN(0)) {
        LAS float* scr = (LAS float*)(F.lds + F.wave * 16384);
        constexpr int I_IN = (DM / 64) * (INC / 32);
        for (int it = gw; it < DEPTH * I_IN; it += NGW) { const int l = it / I_IN, r = it % I_IN;
            transpose_item(p.in[1] + (size_t)l * DM * INC, DM, INC, WinT + (size_t)l * SZ_WIN, DM, RowId{}, scr, r, F.lane); }
        { constexpr int I_UQ = (QL / 64) * (768 / 32), I_UKV = (KVL / 64) * (1024 / 32);
          for (int it = gw; it < DEPTH * (I_UQ + I_UKV); it += NGW) { const int l = it / (I_UQ + I_UKV), r = it % (I_UQ + I_UKV);
            if (r < I_UQ) transpose_item(p.in[4] + (size_t)l * QL * 768, QL, 768, WuqT + (size_t)l * SZ_WUQ, QL, RowQ{}, scr, r, F.lane);
            else transpose_item(p.in[6] + (size_t)l * KVL * 1024, KVL, 1024, WukvT + (size_t)l * SZ_WUKV, KVL, RowId{}, scr, r - I_UQ, F.lane); } }
        { constexpr int I_P = (512 / 64) * (DM / 32), I_O = (DM / 64) * (DM / 32), I_ALL = 2 * I_P + I_O;
          for (int it = gw; it < DEPTH * I_ALL; it += NGW) { const int l = it / I_ALL; int r = it % I_ALL;
            if (r < I_P) { transpose_item(p.in[7] + (size_t)l * 512 * DM, 512, DM, WpaT + (size_t)l * 2 * SZ_WP, 1024, RowId{}, scr, r, F.lane); continue; } r -= I_P;
            if (r < I_P) { transpose_item(p.in[8] + (size_t)l * 512 * DM, 512, DM, WpaT + (size_t)l * 2 * SZ_WP + 512, 1024, RowId{}, scr, r, F.lane); continue; } r -= I_P;
            transpose_item(p.in[9] + (size_t)l * DM * DM, DM, DM, WoutT + (size_t)l * SZ_WOUT, DM, RowId{}, scr, r, F.lane); } }
        { constexpr int I_R = (DM / 64) * (NE / 32), I_G = (DM / 64) * (DSH / 32), I_D = (DSH / 64) * (DM / 32), I_ALL = I_R + 2 * I_G + I_D;
          for (int it = gw; it < DEPTH * I_ALL; it += NGW) { const int l = it / I_ALL; int r = it % I_ALL;
            if (r < I_R) { transpose_item(p.in[12] + (size_t)l * DM * NE, DM, NE, WrtT + (size_t)l * SZ_WRT, DM, RowId{}, scr, r, F.lane); continue; } r -= I_R;
            if (r < I_G) { transpose_item(p.in[17] + (size_t)l * DM * DSH, DM, DSH, WsguT + (size_t)l * SZ_WSGU, DM, RowGU{0}, scr, r, F.lane); continue; } r -= I_G;
            if (r < I_G) { transpose_item(p.in[18] + (size_t)l * DM * DSH, DM, DSH, WsguT + (size_t)l * SZ_WSGU, DM, RowGU{128}, scr, r, F.lane); continue; } r -= I_G;
            transpose_item(p.in[19] + (size_t)l * DSH * DM, DSH, DM, WsdT + (size_t)l * SZ_WSD, DSH, RowId{}, scr, r, F.lane); } }
        { constexpr int I_G = (DM / 64) * (DE / 64), I_D = (DE / 64) * (DM / 64), I_E = 2 * I_G + I_D;
          LAS unsigned short* scr16 = (LAS unsigned short*)(F.lds + F.wave * 16384);
          for (int it = gw; it < DEPTH * NE * I_E; it += NGW) { const int le = it / I_E; int r = it % I_E;
            if (r < I_G) { transpose_item64(p.in[14] + (size_t)le * DM * DE, DM, DE, WeguT + (size_t)le * 512 * DM, DM, RowGU{0}, scr16, r, F.lane); continue; } r -= I_G;
            if (r < I_G) { transpose_item64(p.in[15] + (size_t)le * DM * DE, DM, DE, WeguT + (size_t)le * 512 * DM, DM, RowGU{128}, scr16, r, F.lane); continue; } r -= I_G;
            transpose_item64(p.in[16] + (size_t)le * DE * DM, DE, DM, WedT + (size_t)le * DM * DE, DE, RowId{}, scr16, r, F.lane); } }
        for (int i = blockIdx.x * NTHR + F.tid; i < SEQ * 16; i += F.G * NTHR) { const int pos = i >> 4, k = i & 15;
            const float inv = powf(10000.f, -(float)(2 * k) / 32.f), ang = (float)pos * inv; CS[i] = (f32x2){cosf(ang), sinf(ang)}; }
        for (int i = blockIdx.x * NTHR + F.tid; i < DEPTH * 12288; i += F.G * NTHR) { const int l = i / 12288, r = i % 12288;
            *(u32x4*)(WinT + (size_t)l * SZ_WIN + (size_t)INC * DM + (size_t)r * 8) = (u32x4){0u, 0u, 0u, 0u}; }
        for (int i = blockIdx.x * NTHR + F.tid; i < T * DM / 8; i += F.G * NTHR) { const f32x4 a = *(const f32x4*)(p.in[0] + (size_t)i * 8), b = *(const f32x4*)(p.in[0] + (size_t)i * 8 + 4);
            u32x4 w; w.x = pk2(a[0], a[1]); w.y = pk2(a[2], a[3]); w.z = pk2(b[0], b[1]); w.w = pk2(b[2], b[3]); *(u32x4*)(XB + (size_t)i * 8) = w; }
    }
    SEAM(0);

    {
        const int l = 0; const int pb = 1 + l * NPH_L;
        if (IN(pb + 0)) {
            pg8::Gemm g{XB, WinT + (size_t)l * SZ_WIN, T, INCP, DM, DM, DM}; pg8::StaticOrder S; S.init(T, INCP, F.G, (int)blockIdx.x);
            EpiProj E{PROJ, p.in[2] + (size_t)l * 2 * DM};
            pg8::gemm_phase<EpiProj, pg8::StaticOrder, true>(F.lds, g, S, E);
        }
        SEAM(pb + 0);
        if (IN(pb + 1)) prep_phase(F, PROJ, p.in[3] + (size_t)l * QL, p.in[5] + (size_t)l * KVL, CS, CQN, CKVN, KB, KM);
        SEAM(pb + 1);
        if (IN(pb + 2)) {
            mobasel_phase(F, PROJ, KM, SEL);
            { pg8::Gemm g{CKVN, WukvT + (size_t)l * SZ_WUKV, T, 1024, KVL, KVL, KVL}; pg8::StaticOrder S; S.init(T, 1024, F.G, (int)blockIdx.x);
              EpiKV E{KB, VB}; pg8::gemm_phase<EpiKV, pg8::StaticOrder, true>(F.lds, g, S, E); }
            { pg8::Gemm g{CQN, WuqT + (size_t)l * SZ_WUQ, T, 768, QL, QL, QL}; pg8::StaticOrder S; S.init(T, 768, F.G, (int)blockIdx.x);
              EpiQ E{QB, CS}; pg8::gemm_phase<EpiQ, pg8::StaticOrder, true>(F.lds, g, S, E); }
        }
        SEAM(pb + 2);
        if (IN(pb + 3)) {
            mla_phase(F, QB, KB, VB, OAB + 512);
            moba_sel_phase(F, PROJ, SEL, PO, PML);
        }
        SEAM(pb + 3);
        if (IN(pb + 4)) moba_own_phase(F, PROJ, OAB, PO, PML);
        SEAM(pb + 4);
        if (IN(pb + 5)) {
            pg8::Gemm g{OAB, WpaT + (size_t)l * 2 * SZ_WP, T, DM, DM, 1024, 1024}; pg8::StaticOrder S; S.init(T, DM, F.G, (int)blockIdx.x);
            EpiGate2 E{PROJ, MRG}; pg8::gemm_phase<EpiGate2, pg8::StaticOrder, true>(F.lds, g, S, E);
        }
        SEAM(pb + 5);
        if (IN(pb + 6)) {
            pg8::Gemm g{MRG, WoutT + (size_t)l * SZ_WOUT, T, DM, DM, DM, DM}; pg8::StaticOrder S; S.init(T, DM, F.G, (int)blockIdx.x);
            EpiResid E{XB, PRE}; pg8::gemm_phase<EpiResid, pg8::StaticOrder, true>(F.lds, g, S, E);
        }
        SEAM(pb + 6);
        if (IN(pb + 7)) ln_phase(F, PRE, p.in[10] + (size_t)l * DM, p.in[11] + (size_t)l * DM, X1B);
        SEAM(pb + 7);
        if (IN(pb + 8)) {
            { pg8::Gemm g{X1B, WrtT + (size_t)l * SZ_WRT, T, NE, DM, DM, DM}; pg8::StaticOrder S; S.init(T, NE, F.G, (int)blockIdx.x);
              EpiF32 E{LOGITS, NE}; pg8::gemm_phase<EpiF32, pg8::StaticOrder, true>(F.lds, g, S, E); }
            { pg8::Gemm g{X1B, WsguT + (size_t)l * SZ_WSGU, T, 512, DM, DM, DM}; pg8::StaticOrder S; S.init(T, 512, F.G, (int)((blockIdx.x + F.G / 2) % F.G));
              EpiSwiGLU E{HS, DSH}; pg8::gemm_phase<EpiSwiGLU, pg8::StaticOrder, true>(F.lds, g, S, E); }
        }
        SEAM(pb + 8);
        if (IN(pb + 9)) {
            route_phase(F, LOGITS, p.in[13] + (size_t)l * NE, TOPE, TOPW, APOS, HIST, t_off);
            pg8::Gemm g{HS, WsdT + (size_t)l * SZ_WSD, T, DM, DSH, DSH, DSH}; pg8::StaticOrder S; S.init(T, DM, F.G, (int)blockIdx.x);
            EpiBf16 E{SH, DM}; pg8::gemm_phase<EpiBf16, pg8::StaticOrder, true>(F.lds, g, S, E);
        }
        SEAM(pb + 9);
        if (IN(pb + 10)) {
            int tid_ = F.tid; asm volatile("" : "+v"(tid_));
            if (tid_ < 256) { int tot = 0, base = 0; for (int c = 0; c < F.G; ++c) { const int v = HIST[(size_t)c * 256 + tid_]; base += (c < (int)blockIdx.x) ? v : 0; tot += v; }
                t_off[tid_] = tot; t_toff[tid_] = base; if (blockIdx.x == 0) ctl[CW_CNT + l * 256 + tid_] = (unsigned)tot; }
            __syncthreads();
            if (tid_ == 0) { int a = 0; for (int i = 0; i < 256; ++i) { const int c = t_off[i]; t_off[i] = a; a += c; } }
            __syncthreads();
            const int TPW = T / F.G, a0 = (int)blockIdx.x * TPW * TOPK;
            for (int a = a0 + tid_; a < a0 + TPW * TOPK; a += NTHR) { const int e = TOPE[a]; *(u32x2*)(ROWA + 2 * (size_t)(t_off[e] + t_toff[e] + APOS[a])) = (u32x2){(unsigned)a, __float_as_uint(TOPW[a])}; }
            __syncthreads();
        }
        SEAM(pb + 10);
        if (IN(pb + 11)) {
            expert_tables(F, ctl + CW_CNT + l * 256, t_off, t_toff);
            pg8::Gemm g{X1B, WeguT + (size_t)l * SZ_WEGU, T, 512, DM, DM, DM};
            ExpertOrder<2, true> S{t_off, t_toff, ROWA, F.G, F.vcu, (size_t)512 * DM * 2};
            EpiSwiGLU E{HE, DE}; pg8::gemm_phase<EpiSwiGLU, ExpertOrder<2, true>, true>(F.lds, g, S, E);
        }
        SEAM(pb + 11);
        if (IN(pb + 12)) {
            expert_tables(F, ctl + CW_CNT + l * 256, t_off, t_toff);
            pg8::Gemm g{HE, WedT + (size_t)l * SZ_WED, NA, DM, DE, DE, DE};
            ExpertOrder<4, false> S{t_off, t_toff, ROWA, F.G, F.vcu, (size_t)DM * DE * 2};
            EpiExpDown E{Yb, ROWA}; pg8::gemm_phase<EpiExpDown, ExpertOrder<4, false>, true>(F.lds, g, S, E);
        }
        SEAM(pb + 12);
        if (IN(pb + 13)) combine_phase(F, X1B, SH, Yb, p.in[20] + (size_t)l * DM, p.in[21] + (size_t)l * DM, l == DEPTH - 1 ? p.out : (float*)nullptr, l == DEPTH - 1 ? (bf16_t*)nullptr : XB);
        SEAM(pb + 13);
    }

    {
        const int l = 1; const int pb = 1 + l * NPH_L;
        if (IN(pb + 0)) {
            pg8::Gemm g{XB, WinT + (size_t)l * SZ_WIN, T, INCP, DM, DM, DM}; pg8::StaticOrder S; S.init(T, INCP, F.G, (int)blockIdx.x);
            EpiProj E{PROJ, p.in[2] + (size_t)l * 2 * DM};
            pg8::gemm_phase<EpiProj, pg8::StaticOrder, true>(F.lds, g, S, E);
        }
        SEAM(pb + 0);
        if (IN(pb + 1)) prep_phase(F, PROJ, p.in[3] + (size_t)l * QL, p.in[5] + (size_t)l * KVL, CS, CQN, CKVN, KB, KM);
        SEAM(pb + 1);
        if (IN(pb + 2)) {
            mobasel_phase(F, PROJ, KM, SEL);
            { pg8::Gemm g{CKVN, WukvT + (size_t)l * SZ_WUKV, T, 1024, KVL, KVL, KVL}; pg8::StaticOrder S; S.init(T, 1024, F.G, (int)blockIdx.x);
              EpiKV E{KB, VB}; pg8::gemm_phase<EpiKV, pg8::StaticOrder, true>(F.lds, g, S, E); }
            { pg8::Gemm g{CQN, WuqT + (size_t)l * SZ_WUQ, T, 768, QL, QL, QL}; pg8::StaticOrder S; S.init(T, 768, F.G, (int)blockIdx.x);
              EpiQ E{QB, CS}; pg8::gemm_phase<EpiQ, pg8::StaticOrder, true>(F.lds, g, S, E); }
        }
        SEAM(pb + 2);
        if (IN(pb + 3)) {
            mla_phase(F, QB, KB, VB, OAB + 512);
            moba_sel_phase(F, PROJ, SEL, PO, PML);
        }
        SEAM(pb + 3);
        if (IN(pb + 4)) moba_own_phase(F, PROJ, OAB, PO, PML);
        SEAM(pb + 4);
        if (IN(pb + 5)) {
            pg8::Gemm g{OAB, WpaT + (size_t)l * 2 * SZ_WP, T, DM, DM, 1024, 1024}; pg8::StaticOrder S; S.init(T, DM, F.G, (int)blockIdx.x);
            EpiGate2 E{PROJ, MRG}; pg8::gemm_phase<EpiGate2, pg8::StaticOrder, true>(F.lds, g, S, E);
        }
        SEAM(pb + 5);
        if (IN(pb + 6)) {
            pg8::Gemm g{MRG, WoutT + (size_t)l * SZ_WOUT, T, DM, DM, DM, DM}; pg8::StaticOrder S; S.init(T, DM, F.G, (int)blockIdx.x);
            EpiResid E{XB, PRE}; pg8::gemm_phase<EpiResid, pg8::StaticOrder, true>(F.lds, g, S, E);
        }
        SEAM(pb + 6);
        if (IN(pb + 7)) ln_phase(F, PRE, p.in[10] + (size_t)l * DM, p.in[11] + (size_t)l * DM, X1B);
        SEAM(pb + 7);
        if (IN(pb + 8)) {
            { pg8::Gemm g{X1B, WrtT + (size_t)l * SZ_WRT, T, NE, DM, DM, DM}; pg8::StaticOrder S; S.init(T, NE, F.G, (int)blockIdx.x);
              EpiF32 E{LOGITS, NE}; pg8::gemm_phase<EpiF32, pg8::StaticOrder, true>(F.lds, g, S, E); }
            { pg8::Gemm g{X1B, WsguT + (size_t)l * SZ_WSGU, T, 512, DM, DM, DM}; pg8::StaticOrder S; S.init(T, 512, F.G, (int)((blockIdx.x + F.G / 2) % F.G));
              EpiSwiGLU E{HS, DSH}; pg8::gemm_phase<EpiSwiGLU, pg8::StaticOrder, true>(F.lds, g, S, E); }
        }
        SEAM(pb + 8);
        if (IN(pb + 9)) {
            route_phase(F, LOGITS, p.in[13] + (size_t)l * NE, TOPE, TOPW, APOS, HIST, t_off);
            pg8::Gemm g{HS, WsdT + (size_t)l * SZ_WSD, T, DM, DSH, DSH, DSH}; pg8::StaticOrder S; S.init(T, DM, F.G, (int)blockIdx.x);
            EpiBf16 E{SH, DM}; pg8::gemm_phase<EpiBf16, pg8::StaticOrder, true>(F.lds, g, S, E);
        }
        SEAM(pb + 9);
        if (IN(pb + 10)) {
            int tid_ = F.tid; asm volatile("" : "+v"(tid_));
            if (tid_ < 256) { int tot = 0, base = 0; for (int c = 0; c < F.G; ++c) { const int v = HIST[(size_t)c * 256 + tid_]; base += (c < (int)blockIdx.x) ? v : 0; tot += v; }
                t_off[tid_] = tot; t_toff[tid_] = base; if (blockIdx.x == 0) ctl[CW_CNT + l * 256 + tid_] = (unsigned)tot; }
            __syncthreads();
            if (tid_ == 0) { int a = 0; for (int i = 0; i < 256; ++i) { const int c = t_off[i]; t_off[i] = a; a += c; } }
            __syncthreads();
            const int TPW = T / F.G, a0 = (int)blockIdx.x * TPW * TOPK;
            for (int a = a0 + tid_; a < a0 + TPW * TOPK; a += NTHR) { const int e = TOPE[a]; *(u32x2*)(ROWA + 2 * (size_t)(t_off[e] + t_toff[e] + APOS[a])) = (u32x2){(unsigned)a, __float_as_uint(TOPW[a])}; }
            __syncthreads();
        }
        SEAM(pb + 10);
        if (IN(pb + 11)) {
            expert_tables(F, ctl + CW_CNT + l * 256, t_off, t_toff);
            pg8::Gemm g{X1B, WeguT + (size_t)l * SZ_WEGU, T, 512, DM, DM, DM};
            ExpertOrder<2, true> S{t_off, t_toff, ROWA, F.G, F.vcu, (size_t)512 * DM * 2};
            EpiSwiGLU E{HE, DE}; pg8::gemm_phase<EpiSwiGLU, ExpertOrder<2, true>, true>(F.lds, g, S, E);
        }
        SEAM(pb + 11);
        if (IN(pb + 12)) {
            expert_tables(F, ctl + CW_CNT + l * 256, t_off, t_toff);
            pg8::Gemm g{HE, WedT + (size_t)l * SZ_WED, NA, DM, DE, DE, DE};
            ExpertOrder<4, false> S{t_off, t_toff, ROWA, F.G, F.vcu, (size_t)DM * DE * 2};
            EpiExpDown E{Yb, ROWA}; pg8::gemm_phase<EpiExpDown, ExpertOrder<4, false>, true>(F.lds, g, S, E);
        }
        SEAM(pb + 12);
        if (IN(pb + 13)) combine_phase(F, X1B, SH, Yb, p.in[20] + (size_t)l * DM, p.in[21] + (size_t)l * DM, l == DEPTH - 1 ? p.out : (float*)nullptr, l == DEPTH - 1 ? (bf16_t*)nullptr : XB);
        SEAM(pb + 13);
    }

#undef IN
#undef SEAM
}

__global__ void __launch_bounds__(256) cvt_proj(const bf16_t* __restrict__ P, float* proj) {
    const size_t i = (size_t)blockIdx.x * 256 + threadIdx.x;
    const int row = (int)(i / INC), c = (int)(i % INC);
    float v = bf2f(P[(size_t)row * INCP + c]);
    if (c < C_KA) v *= (1.f / QS_A);
    proj[i] = v;
}
__global__ void __launch_bounds__(256) cvt_oab(const bf16_t* __restrict__ OAB, float* oa, float* ob) {
    const size_t i = (size_t)blockIdx.x * 256 + threadIdx.x; const size_t row = i >> 10; const int c = (int)(i & 1023);
    const float v = bf2f(OAB[i]);
    if (c < 512) oa[row * 512 + c] = v; else ob[row * 512 + c - 512] = v;
}
__global__ void __launch_bounds__(256) cvt_x(const float* __restrict__ x, bf16_t* XB) {
    const size_t i = (size_t)blockIdx.x * 256 + threadIdx.x;
    const f32x4 a = *(const f32x4*)(x + i * 8), b = *(const f32x4*)(x + i * 8 + 4);
    u32x4 w; w.x = pk2(a[0], a[1]); w.y = pk2(a[2], a[3]); w.z = pk2(b[0], b[1]); w.w = pk2(b[2], b[3]); *(u32x4*)(XB + i * 8) = w;
}
}
static int g_grid = 0;
static bool fast_setup() {
    if (g_grid) return g_grid > 0;
    int dev = 0, cus = 0, per_cu = 0;
    if (hipGetDevice(&dev) != hipSuccess || hipDeviceGetAttribute(&cus, hipDeviceAttributeMultiprocessorCount, dev) != hipSuccess) { g_grid = -1; return false; }
    if (hipFuncSetAttribute((const void*)fk::mk, hipFuncAttributeMaxDynamicSharedMemorySize, fk::LDS_BYTES) != hipSuccess) { fprintf(stderr, "hipFuncSetAttribute failed\n"); g_grid = -1; return false; }
    if (hipOccupancyMaxActiveBlocksPerMultiprocessor(&per_cu, (const void*)fk::mk, fk::NTHR, fk::LDS_BYTES) != hipSuccess || per_cu < 1) { fprintf(stderr, "occupancy query: %d\n", per_cu); }
    (void)hipGetLastError();
    g_grid = cus;
    if (cus > 1024 || T % cus != 0 || (T / cus) > 64) { fprintf(stderr, "unsupported CU count %d\n", cus); g_grid = -1; return false; }
    return true;
}
static void launch_mk(fk::Params& p, int lo, int hi, hipStream_t stream) {
    p.ph_lo = lo; p.ph_hi = hi;
    hipLaunchKernelGGL(fk::mk, dim3(g_grid), dim3(fk::NTHR), fk::LDS_BYTES, stream, p);
}

extern "C" void kernel_launch(void* const* d_in, const int* in_sizes, int n_in, void* d_out, int out_size, void* d_ws, size_t ws_size, hipStream_t stream) {
    if (!fast_setup()) return;
    if (ws_size < fk::WS_NEED) { fprintf(stderr, "workspace too small: need %zu have %zu\n", (size_t)fk::WS_NEED, ws_size); return; }
    (void)hipMemsetAsync((char*)d_ws + fk::WS_CTL, 0, fk::CTL_BYTES, stream);
    fk::Params P{};
    for (int i = 0; i < 22; ++i) P.in[i] = (const float*)d_in[i];
    P.out = (float*)d_out; P.ws = (unsigned char*)d_ws;
#if MK_ONE_LAUNCH
    launch_mk(P, 0, 1 + DEPTH * fk::NPH_L, stream);
#else
    launch_mk(P, 0, 1, stream);
    for (int l = 0; l < DEPTH; ++l) for (int k = 0; k < 14; ++k) launch_mk(P, 1 + l * fk::NPH_L + k, 2 + l * fk::NPH_L + k, stream);
#endif
}
```

```cpp
#ifndef MK_ONE_LAUNCH
#define MK_ONE_LAUNCH 1
#endif
#include <hip/hip_runtime.h>
#include <cstdint>
#include <cstdio>

constexpr int NB = 2, SEQ = 8192, T = NB * SEQ, DM = 1024, DEPTH = 2;
constexpr int HA = 8, WA = 512, BLK = 256, NBLK = SEQ / BLK;
constexpr int HB = 8, DN = 64, DR = 32, DV = 64, QL = 384, KVL = 256;
constexpr int INC = 3 * WA + QL + KVL + DR + 2 * DM;
constexpr int C_QA = 0, C_KA = 512, C_VA = 1024, C_CQ = 1536, C_CKV = 1920, C_KR = 2176, C_GA = 2208, C_GB = 3232;
constexpr int NE = 256, TOPK = 8, DE = 256, DSH = 256;
constexpr int NA = T * TOPK;
constexpr float ALPHA = 1.4142135623730951f;
constexpr float LN_EPS = 1e-5f, RMS_EPS = 1e-6f;

namespace ora {
template <class EP>
__global__ void __launch_bounds__(256) sgemm(const float* __restrict__ A, const float* __restrict__ Bm, EP ep, int M, int N, int K, int lda, int ldb, int pad_) {
    __shared__ float As[16][68], Bs[16][68];
    const int tid = threadIdx.x, tx = tid & 15, ty = tid >> 4;
    const int m0 = blockIdx.y * 64, n0 = blockIdx.x * 64;
    float acc[4][4];
#pragma unroll
    for (int i = 0; i < 4; ++i)
#pragma unroll
        for (int j = 0; j < 4; ++j) acc[i][j] = 0.f;
    const int ar = tid >> 2, ak = (tid & 3) * 4;
    const int bk = tid >> 4, bn = (tid & 15) * 4;
    for (int k0 = 0; k0 < K; k0 += 16) {
        const float4 av = *(const float4*)(A + (size_t)(m0 + ar) * lda + k0 + ak);
        float4 bv = make_float4(0.f, 0.f, 0.f, 0.f);
        if (n0 + bn < N) bv = *(const float4*)(Bm + (size_t)(k0 + bk) * ldb + n0 + bn);
        __syncthreads();
        As[ak + 0][ar] = av.x; As[ak + 1][ar] = av.y; As[ak + 2][ar] = av.z; As[ak + 3][ar] = av.w;
        *(float4*)&Bs[bk][bn] = bv;
        __syncthreads();
#pragma unroll
        for (int kk = 0; kk < 16; ++kk) {
            const float4 a = *(const float4*)&As[kk][ty * 4];
            const float4 b = *(const float4*)&Bs[kk][tx * 4];
            const float aa[4] = {a.x, a.y, a.z, a.w}, bb[4] = {b.x, b.y, b.z, b.w};
#pragma unroll
            for (int i = 0; i < 4; ++i)
#pragma unroll
                for (int j = 0; j < 4; ++j) acc[i][j] = fmaf(aa[i], bb[j], acc[i][j]);
        }
    }
#pragma unroll
    for (int i = 0; i < 4; ++i)
#pragma unroll
        for (int j = 0; j < 4; ++j) { const int r = m0 + ty * 4 + i, c = n0 + tx * 4 + j; if (c < N) ep(r, c, acc[i][j]); }
}
struct EpStore { float* C; int ldc; int pad; __device__ void operator()(int r, int c, float v) const { C[(size_t)r * ldc + c] = v; } };
struct EpMerge { const float* proj; const float* bg; const float* pa; float* out; int pre; int pad;
    __device__ void operator()(int r, int c, float v) const {
        const float ga = proj[(size_t)r * INC + C_GA + c] + bg[c], gb = proj[(size_t)r * INC + C_GB + c] + bg[DM + c];
        const float sa = pre ? proj[(size_t)r * INC + C_GA + c] : 1.f / (1.f + expf(-ga)), sb = pre ? proj[(size_t)r * INC + C_GB + c] : 1.f / (1.f + expf(-gb));
        out[(size_t)r * DM + c] = sa * pa[(size_t)r * DM + c] + sb * v; } };
struct EpResid { const float* x; float* out; __device__ void operator()(int r, int c, float v) const { out[(size_t)r * DM + c] = ALPHA * x[(size_t)r * DM + c] + v; } };
struct EpSilu { const float* sg; float* out; __device__ void operator()(int r, int c, float v) const { const float g = sg[(size_t)r * DSH + c]; out[(size_t)r * DSH + c] = g / (1.f + expf(-g)) * v; } };

__global__ void __launch_bounds__(256) rowprep(const float* __restrict__ proj, const float* __restrict__ qn, const float* __restrict__ kvn, float* cqn, float* ckvn, float* krr) {
    const int wid = threadIdx.x >> 6, lane = threadIdx.x & 63, row = blockIdx.x * 4 + wid;
    const float* p = proj + (size_t)row * INC;
    float sq = 0.f, sk = 0.f;
    for (int c = lane; c < QL; c += 64) { const float v = p[C_CQ + c]; sq += v * v; }
    for (int c = lane; c < KVL; c += 64) { const float v = p[C_CKV + c]; sk += v * v; }
#pragma unroll
    for (int o = 32; o; o >>= 1) { sq += __shfl_xor(sq, o); sk += __shfl_xor(sk, o); }
    const float rq = rsqrtf(sq / QL + RMS_EPS), rk = rsqrtf(sk / KVL + RMS_EPS);
    for (int c = lane; c < QL; c += 64) cqn[(size_t)row * QL + c] = p[C_CQ + c] * rq * qn[c];
    for (int c = lane; c < KVL; c += 64) ckvn[(size_t)row * KVL + c] = p[C_CKV + c] * rk * kvn[c];
    if (lane < 16) {
        const int pos = row % SEQ;
        const float inv = powf(10000.f, -(float)(2 * lane) / 32.f), ang = (float)pos * inv, cs = cosf(ang), sn = sinf(ang);
        const float x1 = p[C_KR + lane], x2 = p[C_KR + 16 + lane];
        krr[(size_t)row * DR + lane] = x1 * cs - x2 * sn; krr[(size_t)row * DR + 16 + lane] = x2 * cs + x1 * sn;
    }
}
__global__ void __launch_bounds__(256) qrope(float* q) {
    const int idx = blockIdx.x * 256 + threadIdx.x;
    const int i = idx & 15, h = (idx >> 4) & 7, row = idx >> 7, pos = row % SEQ;
    const float inv = powf(10000.f, -(float)(2 * i) / 32.f), ang = (float)pos * inv, cs = cosf(ang), sn = sinf(ang);
    float* p = q + (size_t)row * 768 + h * 96 + 64;
    const float x1 = p[i], x2 = p[16 + i];
    p[i] = x1 * cs - x2 * sn; p[16 + i] = x2 * cs + x1 * sn;
}
__global__ void __launch_bounds__(64) kmean(const float* __restrict__ proj, float* km) {
    const int blk = blockIdx.x, h = blockIdx.y, b = blockIdx.z, c = threadIdx.x;
    float s = 0.f;
    for (int i = 0; i < BLK; ++i) s += proj[(size_t)(b * SEQ + blk * BLK + i) * INC + C_KA + h * 64 + c];
    km[((size_t)(b * HA + h) * NBLK + blk) * 64 + c] = s * (1.f / BLK);
}
__global__ void __launch_bounds__(256) mobasel(const float* __restrict__ proj, const float* __restrict__ km, unsigned* sel) {
    const int idx = blockIdx.x * 256 + threadIdx.x;
    const int h = idx & 7, row = idx >> 3, b = row / SEQ, pos = row % SEQ, own = pos / BLK;
    const float* qp = proj + (size_t)row * INC + C_QA + h * 64;
    float v1 = -INFINITY, v2 = -INFINITY, v3 = -INFINITY; int i1 = -1, i2 = -1, i3 = -1;
    for (int j = 0; j < own; ++j) {
        const float* kp = km + ((size_t)(b * HA + h) * NBLK + j) * 64;
        float g = 0.f;
        for (int c = 0; c < 64; ++c) g = fmaf(qp[c], kp[c], g);
        if (g > v1) { v3 = v2; i3 = i2; v2 = v1; i2 = i1; v1 = g; i1 = j; }
        else if (g > v2) { v3 = v2; i3 = i2; v2 = g; i2 = j; }
        else if (g > v3) { v3 = g; i3 = j; }
    }
    unsigned m = 0;
    if (i1 >= 0) m |= 1u << i1; if (i2 >= 0) m |= 1u << i2; if (i3 >= 0) m |= 1u << i3;
    sel[idx] = m;
}
__device__ __forceinline__ float ldbf(const void* p, size_t i) { return __builtin_bit_cast(float, (unsigned)((const unsigned short*)p)[i] << 16); }
template <bool MOBA, bool FAST>
__global__ void __launch_bounds__(256) attn(const float* __restrict__ Qb, const float* __restrict__ KVb, const float* __restrict__ KRb, const unsigned* __restrict__ sel, float* O) {
    constexpr int DQK = MOBA ? 64 : 96;
    __shared__ float Qs[64][DQK + 1], Ks[32][DQK + 1], Vs[32][65], Ps[64][33];
    const int qb = blockIdx.x, h = blockIdx.y, b = blockIdx.z, tid = threadIdx.x, qi = tid >> 2, sub = tid & 3;
    const size_t row0 = (size_t)b * SEQ + (size_t)qb * 64;
    for (int idx = tid; idx < 64 * DQK; idx += 256) { const int r = idx / DQK, c = idx % DQK;
        if (FAST) Qs[r][c] = MOBA ? ldbf(Qb, (row0 + r) * 4352 + C_QA + h * 64 + c) : ldbf(Qb, (row0 + r) * 768 + h * 96 + c);
        else Qs[r][c] = MOBA ? Qb[(row0 + r) * INC + C_QA + h * 64 + c] : Qb[(row0 + r) * 768 + h * 96 + c]; }
    const int tq = qb * 64 + qi, own = tq / BLK;
    const unsigned mask = MOBA ? sel[(row0 + qi) * 8 + h] : 0u;
    const float slope = exp2f(-(float)(h + 1)), scale = FAST ? 0.6931471805599453f : (MOBA ? 0.125f : 0.10206207261596577f);
    float m = -1e30f, l = 0.f, o[16];
#pragma unroll
    for (int d = 0; d < 16; ++d) o[d] = 0.f;
    const int nkt = (qb * 64 + 64) / 32;
    for (int kt = 0; kt < nkt; ++kt) {
        __syncthreads();
        for (int idx = tid; idx < 32 * DQK; idx += 256) { const int r = idx / DQK, c = idx % DQK; const size_t kr = (size_t)b * SEQ + kt * 32 + r;
            if (FAST) Ks[r][c] = MOBA ? ldbf(KVb, kr * 4352 + C_KA + h * 64 + c) : ldbf(KVb, kr * 768 + h * 96 + c);
            else Ks[r][c] = MOBA ? KVb[kr * INC + C_KA + h * 64 + c] : (c < 64 ? KVb[kr * 1024 + h * 128 + c] : KRb[kr * DR + c - 64]); }
        for (int idx = tid; idx < 32 * 64; idx += 256) { const int r = idx >> 6, c = idx & 63; const size_t kr = (size_t)b * SEQ + kt * 32 + r;
            if (FAST) Vs[r][c] = MOBA ? ldbf(KVb, kr * 4352 + C_VA + h * 64 + c) : ldbf(KRb, kr * 512 + h * 64 + c);
            else Vs[r][c] = MOBA ? KVb[kr * INC + C_VA + h * 64 + c] : KVb[kr * 1024 + h * 128 + 64 + c]; }
        __syncthreads();
        float s[8]; float rmax = -1e30f;
#pragma unroll
        for (int j = 0; j < 8; ++j) {
            const int kk = sub + 4 * j, kpos = kt * 32 + kk;
            float dot = 0.f;
            for (int c = 0; c < DQK; ++c) dot = fmaf(Qs[qi][c], Ks[kk][c], dot);
            float sc = dot * scale; bool ok;
            if (MOBA) { sc -= slope * (float)(tq - kpos); const int kb = kpos / BLK; ok = (kb == own) ? (kpos <= tq) : (((mask >> kb) & 1u) != 0u); }
            else ok = kpos <= tq;
            s[j] = ok ? sc : -1e30f; rmax = fmaxf(rmax, s[j]);
        }
        rmax = fmaxf(rmax, __shfl_xor(rmax, 1)); rmax = fmaxf(rmax, __shfl_xor(rmax, 2));
        const float mn = fmaxf(m, rmax), alpha = expf(m - mn);
        float psum = 0.f;
#pragma unroll
        for (int j = 0; j < 8; ++j) { const float p = (s[j] > -1e29f) ? expf(s[j] - mn) : 0.f; Ps[qi][sub + 4 * j] = p; psum += p; }
        psum += __shfl_xor(psum, 1); psum += __shfl_xor(psum, 2);
        l = l * alpha + psum; m = mn;
        __syncthreads();
#pragma unroll
        for (int d = 0; d < 16; ++d) o[d] *= alpha;
        for (int kk = 0; kk < 32; ++kk) { const float p = Ps[qi][kk];
#pragma unroll
            for (int d = 0; d < 16; ++d) o[d] = fmaf(p, Vs[kk][sub * 16 + d], o[d]); }
    }
    const float rl = 1.f / l;
#pragma unroll
    for (int d = 0; d < 16; ++d) O[(row0 + qi) * 512 + h * 64 + sub * 16 + d] = o[d] * rl;
}
template <bool COMB>
__global__ void __launch_bounds__(256) lnorm(const float* __restrict__ in, const float* __restrict__ x1, const float* __restrict__ shared_, const float* __restrict__ Y, const float* __restrict__ g, const float* __restrict__ bt, float* out) {
    __shared__ float red[8];
    const int row = blockIdx.x, tid = threadIdx.x;
    float v[4];
#pragma unroll
    for (int i = 0; i < 4; ++i) { const int c = tid + 256 * i;
        if (COMB) { float a = ALPHA * x1[(size_t)row * DM + c] + shared_[(size_t)row * DM + c];
            for (int k = 0; k < TOPK; ++k) a += Y[((size_t)row * TOPK + k) * DM + c];
            v[i] = a; }
        else v[i] = in[(size_t)row * DM + c]; }
    float s = v[0] + v[1] + v[2] + v[3];
#pragma unroll
    for (int o = 32; o; o >>= 1) s += __shfl_xor(s, o);
    if ((tid & 63) == 0) red[tid >> 6] = s;
    __syncthreads();
    const float mu = (red[0] + red[1] + red[2] + red[3]) * (1.f / DM);
    float q = 0.f;
#pragma unroll
    for (int i = 0; i < 4; ++i) { const float d = v[i] - mu; q += d * d; }
#pragma unroll
    for (int o = 32; o; o >>= 1) q += __shfl_xor(q, o);
    if ((tid & 63) == 0) red[4 + (tid >> 6)] = q;
    __syncthreads();
    const float rs = rsqrtf((red[4] + red[5] + red[6] + red[7]) * (1.f / DM) + LN_EPS);
#pragma unroll
    for (int i = 0; i < 4; ++i) { const int c = tid + 256 * i; out[(size_t)row * DM + c] = (v[i] - mu) * rs * g[c] + bt[c]; }
}
__global__ void __launch_bounds__(256) route(const float* __restrict__ logits, const float* __restrict__ rbias, int* tope, float* topw, int* apos, unsigned* cnt) {
    const int wid = threadIdx.x >> 6, lane = threadIdx.x & 63, t = blockIdx.x * 4 + wid;
    const float4 lg = *(const float4*)(logits + (size_t)t * NE + lane * 4), rb = *(const float4*)(rbias + lane * 4);
    float s0 = 1.f / (1.f + expf(-lg.x)), s1 = 1.f / (1.f + expf(-lg.y)), s2 = 1.f / (1.f + expf(-lg.z)), s3 = 1.f / (1.f + expf(-lg.w));
    float c0 = s0 + rb.x, c1 = s1 + rb.y, c2 = s2 + rb.z, c3 = s3 + rb.w;
    float a = fmaxf(c0, c1), bq = fminf(c0, c1);
    { const float hi2 = fmaxf(c2, c3), lo2 = fminf(c2, c3); const float na = fmaxf(a, hi2); const float nb = fmaxf(fminf(a, hi2), fmaxf(bq, lo2)); a = na; bq = nb; }
#pragma unroll
    for (int o = 1; o < 8; o <<= 1) { const float oa = __shfl_xor(a, o), ob = __shfl_xor(bq, o); const float na = fmaxf(a, oa), nb = fmaxf(fminf(a, oa), fmaxf(bq, ob)); a = na; bq = nb; }
    const float gs = a + bq; const int grp = lane >> 3;
    int rank = 0;
#pragma unroll
    for (int j = 0; j < 8; ++j) { const float og = __shfl(gs, j * 8); rank += (og > gs || (og == gs && j < grp)) ? 1 : 0; }
    const bool gsel = rank < 4;
    if (!gsel) { c0 = c1 = c2 = c3 = -INFINITY; }
    float wsum = 0.f, myw = 0.f; int mye = 0;
#pragma unroll
    for (int k = 0; k < TOPK; ++k) {
        float bv = c0; int bi = 0;
        if (c1 > bv) { bv = c1; bi = 1; } if (c2 > bv) { bv = c2; bi = 2; } if (c3 > bv) { bv = c3; bi = 3; }
        int be = lane * 4 + bi;
#pragma unroll
        for (int o = 1; o < 64; o <<= 1) { const float ov = __shfl_xor(bv, o); const int oe = __shfl_xor(be, o); if (ov > bv || (ov == bv && oe < be)) { bv = ov; be = oe; } }
        float sc = 0.f;
        if ((be >> 2) == lane) { const int bi2 = be & 3; sc = bi2 == 0 ? s0 : bi2 == 1 ? s1 : bi2 == 2 ? s2 : s3; if (bi2 == 0) c0 = -INFINITY; else if (bi2 == 1) c1 = -INFINITY; else if (bi2 == 2) c2 = -INFINITY; else c3 = -INFINITY; }
        sc = __shfl(sc, be >> 2);
        wsum += sc;
        if (lane == k) { myw = sc; mye = be; }
    }
    if (lane < TOPK) {
        const int aidx = t * TOPK + lane;
        tope[aidx] = mye; topw[aidx] = myw / wsum * 2.5f;
        apos[aidx] = (int)atomicAdd(&cnt[mye], 1u);
    }
}
template <int TM>
__global__ void __launch_bounds__(256) escan(const unsigned* __restrict__ cnt, int* off, int* toff) {
    __shared__ int sc[256], st[256];
    const int e = threadIdx.x; const int c = (int)cnt[e];
    sc[e] = c; st[e] = (c + TM - 1) / TM;
    __syncthreads();
    if (e == 0) { int a = 0, b = 0; for (int i = 0; i < 256; ++i) { const int ca = sc[i], cb = st[i]; sc[i] = a; st[i] = b; a += ca; b += cb; } off[256] = a; toff[256] = b; }
    __syncthreads();
    off[e] = sc[e]; toff[e] = st[e];
}
__global__ void __launch_bounds__(256) escatter(const int* __restrict__ tope, const int* __restrict__ apos, const int* __restrict__ off, int* rowa) {
    const int a = blockIdx.x * 256 + threadIdx.x;
    rowa[off[tope[a]] + apos[a]] = a;
}
template <int MODE>
__global__ void __launch_bounds__(256) egemm(const float* __restrict__ X, const float* __restrict__ W0, const float* __restrict__ W1, const int* __restrict__ off, const int* __restrict__ toff, const int* __restrict__ rowa,
                                            const float* __restrict__ topw, float* out) {
    __shared__ float As[16][68], Bs[16][68], Cs[16][68];
    __shared__ int se;
    const int tile = blockIdx.y;
    if (tile >= toff[256]) return;
    const int tid = threadIdx.x, tx = tid & 15, ty = tid >> 4;
    if (tid == 0) { int lo = 0, hi = 255; while (lo < hi) { const int mid = (lo + hi + 1) >> 1; if (toff[mid] <= tile) lo = mid; else hi = mid - 1; } se = lo; }
    __syncthreads();
    const int e = se, r0 = off[e] + (tile - toff[e]) * 64, rend = off[e + 1];
    constexpr int K = MODE == 0 ? DM : DE, N = MODE == 0 ? DE : DM;
    const int n0 = blockIdx.x * 64;
    const float* B0 = W0 + (size_t)e * K * N; const float* B1 = MODE == 0 ? W1 + (size_t)e * K * N : nullptr;
    const int ar = tid >> 2, ak = (tid & 3) * 4, bk = tid >> 4, bn = (tid & 15) * 4;
    const int arow = r0 + ar; const bool aval = arow < rend;
    const float* ap = nullptr;
    if (aval) ap = MODE == 0 ? X + (size_t)(rowa[arow] >> 3) * DM : X + (size_t)arow * DE;
    float acc[4][4], acu[4][4];
#pragma unroll
    for (int i = 0; i < 4; ++i)
#pragma unroll
        for (int j = 0; j < 4; ++j) { acc[i][j] = 0.f; acu[i][j] = 0.f; }
    for (int k0 = 0; k0 < K; k0 += 16) {
        float4 av = make_float4(0.f, 0.f, 0.f, 0.f);
        if (aval) av = *(const float4*)(ap + k0 + ak);
        const float4 bv = *(const float4*)(B0 + (size_t)(k0 + bk) * N + n0 + bn);
        float4 cv = make_float4(0.f, 0.f, 0.f, 0.f);
        if (MODE == 0) cv = *(const float4*)(B1 + (size_t)(k0 + bk) * N + n0 + bn);
        __syncthreads();
        As[ak + 0][ar] = av.x; As[ak + 1][ar] = av.y; As[ak + 2][ar] = av.z; As[ak + 3][ar] = av.w;
        *(float4*)&Bs[bk][bn] = bv; if (MODE == 0) *(float4*)&Cs[bk][bn] = cv;
        __syncthreads();
#pragma unroll
        for (int kk = 0; kk < 16; ++kk) {
            const float4 a = *(const float4*)&As[kk][ty * 4];
            const float4 b = *(const float4*)&Bs[kk][tx * 4];
            const float aa[4] = {a.x, a.y, a.z, a.w}, bb[4] = {b.x, b.y, b.z, b.w};
#pragma unroll
            for (int i = 0; i < 4; ++i)
#pragma unroll
                for (int j = 0; j < 4; ++j) acc[i][j] = fmaf(aa[i], bb[j], acc[i][j]);
            if (MODE == 0) { const float4 c = *(const float4*)&Cs[kk][tx * 4]; const float cc[4] = {c.x, c.y, c.z, c.w};
#pragma unroll
                for (int i = 0; i < 4; ++i)
#pragma unroll
                    for (int j = 0; j < 4; ++j) acu[i][j] = fmaf(aa[i], cc[j], acu[i][j]); }
        }
    }
#pragma unroll
    for (int i = 0; i < 4; ++i) { const int r = r0 + ty * 4 + i; if (r < rend) {
        if (MODE == 0) {
#pragma unroll
            for (int j = 0; j < 4; ++j) { const float g = acc[i][j]; out[(size_t)r * DE + n0 + tx * 4 + j] = g / (1.f + expf(-g)) * acu[i][j]; } }
        else { const int a = rowa[r]; const float w = topw[a];
#pragma unroll
            for (int j = 0; j < 4; ++j) out[(size_t)a * DM + n0 + tx * 4 + j] = acc[i][j] * w; } } }
}
}


namespace fk {
#define LAS __attribute__((address_space(3)))
#define GAS __attribute__((address_space(1)))
typedef unsigned short bf16_t;
typedef short bf16x8 __attribute__((ext_vector_type(8)));
typedef float f32x4 __attribute__((ext_vector_type(4)));
typedef float f32x2 __attribute__((ext_vector_type(2)));
typedef float f32x16 __attribute__((ext_vector_type(16)));
typedef unsigned u32x4 __attribute__((ext_vector_type(4)));
typedef unsigned u32x2 __attribute__((ext_vector_type(2)));
constexpr int NWAVES = 8, NTHR = 512;
constexpr int INCP = 4352;
constexpr float LOG2E = 1.4426950408889634f;
constexpr float QS_A = 0.125f * LOG2E;
constexpr float QS_B = 0.10206207261596577f * LOG2E;
#define LDS_WAIT() asm volatile("s_waitcnt lgkmcnt(0)" ::: "memory")
#define VM_WAIT() asm volatile("s_waitcnt vmcnt(0)" ::: "memory")
__device__ __forceinline__ unsigned f2bf(float f) { unsigned u = __builtin_bit_cast(unsigned, f); return (u + 0x7fffu + ((u >> 16) & 1u)) >> 16; }
__device__ __forceinline__ unsigned pk2(float lo, float hi) { return f2bf(lo) | (f2bf(hi) << 16); }
__device__ __forceinline__ float bf2f(unsigned short b) { return __builtin_bit_cast(float, (unsigned)b << 16); }
__device__ __forceinline__ float bflo(unsigned w) { return __builtin_bit_cast(float, w << 16); }
__device__ __forceinline__ float bfhi(unsigned w) { return __builtin_bit_cast(float, w & 0xffff0000u); }
__device__ __forceinline__ float sigmoidf_(float x) { return __builtin_amdgcn_rcpf(1.f + __expf(-x)); }
__device__ __forceinline__ float wave_sum(float v) {
#pragma unroll
    for (int o = 1; o < 64; o <<= 1) v += __shfl_xor(v, o);
    return v;
}

namespace pg8 {
constexpr int BM = 256, BK = 64, HALF = 128, HTB = HALF * BK * 2, STAGE_BYTES = 8 * HTB, NXCD = 8, WGM = 8;
__host__ __device__ __forceinline__ int lds_byte(int r, int c) { const int st = (r >> 4) * 2 + (c >> 5), rr = r & 15, cc = c & 31, ob = rr * 64 + cc * 2; return st * 1024 + (ob ^ (((ob >> 9) & 1) << 5)); }
__host__ __device__ __forceinline__ void stage_rc(int b, int& R, int& C) { const int st = b / 1024, sb = b % 1024, swz = sb ^ (((sb >> 9) & 1) << 5); R = (st >> 1) * 16 + swz / 64; C = (st & 1) * 32 + (swz % 64) / 2; }
__host__ __device__ __forceinline__ int perm32(int rho) { const int n = rho >> 4, i = rho & 15; return 8 * (i >> 2) + 4 * n + (i & 3); }

struct Unit { int pm, pn, e, r0, rend; };
struct Gemm { const bf16_t* A; const bf16_t* Bt; int M, N, K, lda, ldb; };

struct StaticOrder {
    int nM, nN, nwg, G, c;
    __device__ void init(int M, int N, int G_, int c_) { nM = M / BM; nN = N / BM; nwg = nM * nN; G = G_; c = c_; }
    __device__ bool next(int i, Unit& u) const {
        const long L = (long)i * G + c; if (L >= nwg) return false;
        int wgid = (int)L; { const int q = nwg / NXCD, r = nwg % NXCD, xcd = wgid % NXCD, off = wgid / NXCD; wgid = (xcd < r ? xcd * (q + 1) : r * (q + 1) + (xcd - r) * q) + off; }
        const int nig = WGM * nN, gid = wgid / nig, fm = gid * WGM, gsz = (nM - fm) < WGM ? (nM - fm) : WGM;
        u.pm = fm + ((wgid % nig) % gsz); u.pn = (wgid % nig) / gsz; u.e = 0; u.r0 = u.pm * BM; u.rend = u.r0 + BM; return true;
    }
    __device__ __forceinline__ int a_row(const Unit& u, int r) const { return u.pm * BM + r; }
    __device__ __forceinline__ const char* b_ptr(const Gemm& g, const Unit& u) const { return (const char*)g.Bt + (size_t)u.pn * BM * g.ldb * 2; }
};

typedef float f32x2_t_ __attribute__((ext_vector_type(2))); typedef __bf16 bf16x2_t_ __attribute__((ext_vector_type(2)));
__device__ __forceinline__ unsigned cvt_pk_bf16(float lo, float hi) { const f32x2_t_ v = {lo, hi}; const bf16x2_t_ b = __builtin_convertvector(v, bf16x2_t_); return __builtin_bit_cast(unsigned, b); }

template <class Epi, class Sched, bool ALIGN_EPI>
__device__ __forceinline__ void gemm_phase(LAS unsigned char* lds, const Gemm g, const Sched& S, const Epi& E) {
    int tid_ = threadIdx.x; asm volatile("" : "+v"(tid_));
    const int tid = tid_, wid = __builtin_amdgcn_readfirstlane(tid >> 6), lane = tid & 63, wr = wid >> 2, wc = wid & 3, fr = lane & 15, fq = lane >> 4;
    const int K = g.K, nt = K / BK;
    int RA[2]; unsigned CA[2], voffB[2];
#pragma unroll
    for (int i = 0; i < 2; ++i) { int R, C; stage_rc(tid * 16 + i * 8192, R, C); const int Rb = (R & ~31) + perm32(R & 31);
        RA[i] = R; CA[i] = (unsigned)C * 2u; voffB[i] = (unsigned)(Rb * g.ldb + C) * 2u; }
    const unsigned lda2 = (unsigned)g.lda * 2u;
    const size_t hstepB = (size_t)HALF * g.ldb * 2;
    const unsigned ldsw = (unsigned)wid * 1024u;
    const int aoff = lds_byte(wr * 64 + fr, fq * 8), boff = lds_byte(wc * 32 + fr, fq * 8);
    const char* const Abase = (const char*)g.A;
#define PG8_SA(b, h) (((b) * 2 + (h)) * HTB)
#define PG8_SB(b, h) ((4 + (b) * 2 + (h)) * HTB)
#define PG8_STAGE_B(bufoff, gbase) do { _Pragma("unroll") for (int _i = 0; _i < 2; ++_i) \
        __builtin_amdgcn_global_load_lds((const unsigned*)((const char*)(gbase) + voffB[_i]), (LAS unsigned*)(lds + (bufoff) + ldsw + _i * 8192), 16, 0, 0); } while (0)
#define PG8_STAGE_A(bufoff, V0, V1, kb) do { \
        __builtin_amdgcn_global_load_lds((const unsigned*)((Abase + (kb)) + (V0)), (LAS unsigned*)(lds + (bufoff) + ldsw), 16, 0, 0); \
        __builtin_amdgcn_global_load_lds((const unsigned*)((Abase + (kb)) + (V1)), (LAS unsigned*)(lds + (bufoff) + ldsw + 8192), 16, 0, 0); } while (0)
#define PG8_LDA(dst, b, h) do { _Pragma("unroll") for (int m = 0; m < 4; ++m) _Pragma("unroll") for (int k = 0; k < 2; ++k) dst[m][k] = *(const LAS bf16x8*)(lds + PG8_SA(b, h) + aoff + m * 2048 + k * 1024); } while (0)
#define PG8_LDB(dst, b, h) do { _Pragma("unroll") for (int n = 0; n < 2; ++n) _Pragma("unroll") for (int k = 0; k < 2; ++k) dst[n][k] = *(const LAS bf16x8*)(lds + PG8_SB(b, h) + boff + n * 2048 + k * 1024); } while (0)
#define PG8_MMA(ai, bj, At, Bt) do { __builtin_amdgcn_s_setprio(1); _Pragma("unroll") for (int m = 0; m < 4; ++m) _Pragma("unroll") for (int n = 0; n < 2; ++n) _Pragma("unroll") for (int k = 0; k < 2; ++k) \
        acc[ai][bj][m][n] = __builtin_amdgcn_mfma_f32_16x16x32_bf16(Bt[n][k], At[m][k], acc[ai][bj][m][n], 0, 0, 0); __builtin_amdgcn_s_setprio(0); } while (0)
#define PG8_WAIT_V(n) asm volatile("s_waitcnt vmcnt(" #n ")" ::: "memory")
#define PG8_WAIT_L(n) asm volatile("s_waitcnt lgkmcnt(" #n ")" ::: "memory")
#define PG8_BAR __builtin_amdgcn_s_barrier()
#define PG8_SCHED __builtin_amdgcn_sched_barrier(0)
#define PG8_VOFF(V, U) do { V##00 = (unsigned)S.a_row(U, RA[0]) * lda2 + CA[0]; V##01 = (unsigned)S.a_row(U, RA[1]) * lda2 + CA[1]; \
        V##10 = (unsigned)S.a_row(U, HALF + RA[0]) * lda2 + CA[0]; V##11 = (unsigned)S.a_row(U, HALF + RA[1]) * lda2 + CA[1]; } while (0)
    Unit cur, nxt; int ui = 0;
    if (!S.next(0, cur)) return;
    f32x4 acc[2][2][4][2];
#pragma unroll
    for (int a = 0; a < 2; ++a)
#pragma unroll
        for (int b = 0; b < 2; ++b)
#pragma unroll
            for (int m = 0; m < 4; ++m)
#pragma unroll
                for (int n = 0; n < 2; ++n) acc[a][b][m][n] = (f32x4){0.f, 0.f, 0.f, 0.f};
    bf16x8 At[4][2], B0[2][2], B1[2][2];
    unsigned vc00, vc01, vc10, vc11;
    PG8_VOFF(vc, cur);
    const char* cB = S.b_ptr(g, cur);
    PG8_STAGE_B(PG8_SB(0, 0), cB); PG8_STAGE_B(PG8_SB(0, 1), cB + hstepB); PG8_STAGE_A(PG8_SA(0, 0), vc00, vc01, 0u); PG8_STAGE_A(PG8_SA(0, 1), vc10, vc11, 0u);
    if (wr == 1) PG8_BAR;
    PG8_WAIT_V(2); PG8_BAR;
    PG8_STAGE_B(PG8_SB(1, 0), cB + 128); PG8_STAGE_A(PG8_SA(1, 0), vc00, vc01, 128u); PG8_STAGE_B(PG8_SB(1, 1), cB + hstepB + 128);
    PG8_WAIT_V(6); PG8_BAR;
    for (;;) {
        const bool has_next = S.next(ui + 1, nxt);
        const char* nB = has_next ? S.b_ptr(g, nxt) : cB;
        unsigned vn00 = vc00, vn01 = vc01, vn10 = vc10, vn11 = vc11;
        if (has_next) { PG8_VOFF(vn, nxt); }
        const bool half1 = (cur.rend - cur.r0) > HALF;
#pragma unroll 1
        for (int t = 0; t < nt; t += 2) {
            if constexpr (Epi::MIDK > 0) { if (t == Epi::MIDK) E.mid(acc, cur, wr, wc, fr, fq); }
            const bool last = (t == nt - 2);
            const unsigned kb1 = (unsigned)(t + 1) * 128u;
            unsigned kb2 = (unsigned)(t + 2) * 128u;
            unsigned s00 = vc00, s01 = vc01, s10 = vc10, s11 = vc11;
            const char* b2 = cB + (size_t)kb2;
            if (last) { kb2 = 0u; b2 = nB; s00 = vn00; s01 = vn01; s10 = vn10; s11 = vn11; }
            const unsigned kb3 = kb2 + 128u; const char* b3 = b2 + 128;
            PG8_LDB(B0, 0, 0); PG8_LDB(B1, 0, 1); PG8_SCHED; PG8_LDA(At, 0, 0); PG8_STAGE_A(PG8_SA(1, 1), vc10, vc11, kb1);
            PG8_WAIT_V(8); PG8_WAIT_L(0); PG8_BAR; PG8_MMA(0, 0, At, B0); PG8_MMA(0, 1, At, B1); PG8_BAR; PG8_SCHED;
            PG8_LDA(At, 0, 1); PG8_STAGE_B(PG8_SB(0, 0), b2); PG8_STAGE_B(PG8_SB(0, 1), b2 + hstepB); PG8_STAGE_A(PG8_SA(0, 0), s00, s01, kb2);
            PG8_WAIT_V(8); PG8_WAIT_L(0); PG8_BAR; if (half1) { PG8_MMA(1, 0, At, B0); PG8_MMA(1, 1, At, B1); } PG8_BAR; PG8_SCHED;
            PG8_LDB(B0, 1, 0); PG8_LDB(B1, 1, 1); PG8_SCHED; PG8_LDA(At, 1, 0); PG8_STAGE_A(PG8_SA(0, 1), s10, s11, kb2);
            PG8_WAIT_V(8); PG8_WAIT_L(0); PG8_BAR; PG8_MMA(0, 0, At, B0); PG8_MMA(0, 1, At, B1); PG8_BAR; PG8_SCHED;
            PG8_LDA(At, 1, 1); PG8_STAGE_B(PG8_SB(1, 0), b3); PG8_STAGE_B(PG8_SB(1, 1), b3 + hstepB); PG8_STAGE_A(PG8_SA(1, 0), s00, s01, kb3);
            PG8_WAIT_V(8); PG8_WAIT_L(0); PG8_BAR; if (half1) { PG8_MMA(1, 0, At, B0); PG8_MMA(1, 1, At, B1); } PG8_BAR; PG8_SCHED;
        }
        if constexpr (ALIGN_EPI) { if (wr == 0) PG8_BAR; }
        E(acc, cur, wr, wc, fr, fq);
        if (!has_next) break;
#pragma unroll
        for (int a = 0; a < 2; ++a)
#pragma unroll
            for (int b = 0; b < 2; ++b)
#pragma unroll
                for (int m = 0; m < 4; ++m)
#pragma unroll
                    for (int n = 0; n < 2; ++n) acc[a][b][m][n] = (f32x4){0.f, 0.f, 0.f, 0.f};
        cur = nxt; cB = nB; vc00 = vn00; vc01 = vn01; vc10 = vn10; vc11 = vn11; ++ui;
        if constexpr (ALIGN_EPI) { if (wr == 1) PG8_BAR; }
    }
    PG8_WAIT_V(0);
    if constexpr (!ALIGN_EPI) { if (wr == 0) PG8_BAR; }
    PG8_BAR;
#undef PG8_SA
#undef PG8_SB
#undef PG8_STAGE_A
#undef PG8_STAGE_B
#undef PG8_LDA
#undef PG8_LDB
#undef PG8_MMA
#undef PG8_WAIT_V
#undef PG8_WAIT_L
#undef PG8_BAR
#undef PG8_SCHED
#undef PG8_VOFF
}
#define PG8_TILE_BEGIN(acc, wr, wc, fr, fq) \
    _Pragma("unroll") for (int ai = 0; ai < 2; ++ai) _Pragma("unroll") for (int m = 0; m < 4; ++m) _Pragma("unroll") for (int bj = 0; bj < 2; ++bj) { \
        const int trow = ai * 128 + wr * 64 + m * 16 + fr, tcol = bj * 128 + wc * 32 + 8 * fq; f32x4 v0 = acc[ai][bj][m][0], v1 = acc[ai][bj][m][1];
#define PG8_TILE_END }
__device__ __forceinline__ u32x4 pack8(f32x4 v0, f32x4 v1) { u32x4 w; w.x = cvt_pk_bf16(v0[0], v0[1]); w.y = cvt_pk_bf16(v0[2], v0[3]); w.z = cvt_pk_bf16(v1[0], v1[1]); w.w = cvt_pk_bf16(v1[2], v1[3]); return w; }
}

#define XB_TMO      128
#define XB_XCNT(j)  (256  + 64 * (j))
#define XB_XSUB(j)  (1280 + 64 * (j))
#define XB_XGEN(j)  (2304 + 64 * (j))
#define XB_TOP      3328
#define XB_TOPGEN   3392
#define XCD_BAR_WORDS 3456
#define XB_SPIN_CAP (1u << 18)

__device__ __forceinline__ unsigned xb_ld(unsigned* p)              { return __hip_atomic_load(p, __ATOMIC_RELAXED, __HIP_MEMORY_SCOPE_AGENT); }
__device__ __forceinline__ unsigned xb_add(unsigned* p, unsigned v) { return __hip_atomic_fetch_add(p, v, __ATOMIC_RELAXED, __HIP_MEMORY_SCOPE_AGENT); }
__device__ __forceinline__ unsigned xb_xcc_id() { return (unsigned)__builtin_amdgcn_s_getreg((3 << 11) | 20) & 0xFu; }
#define XB_SPIN(cond, bar) do { unsigned _sp = 0; while (cond) { __builtin_amdgcn_s_sleep(1); \
    if ((++_sp & 255u) == 0u) { if (xb_ld(&(bar)[XB_TMO])) break; if (_sp > XB_SPIN_CAP) { atomicAdd(&(bar)[XB_TMO], 1u); break; } } } } while (0)

struct XcdBarrier {
    unsigned* bar; unsigned x;
    volatile LAS unsigned* st;
};

__device__ __forceinline__ XcdBarrier xcd_barrier_post(unsigned* bar, volatile LAS unsigned* st) {
    XcdBarrier b; b.bar = bar; b.x = xb_xcc_id(); b.st = st;
    if (threadIdx.x == 0) (void)xb_add(&bar[XB_XCNT(b.x)], 1u);
    return b;
}
__device__ __forceinline__ void xcd_barrier_complete(unsigned* bar, unsigned x, unsigned& nloc, unsigned& nx) {
    const unsigned G = gridDim.x * gridDim.y * gridDim.z;
    unsigned sum, cnt, mine, sp = 0u;
    for (;;) {
        sum = 0u; cnt = 0u; mine = 0u;
#pragma unroll
        for (unsigned j = 0; j < 16; ++j) { const unsigned c = xb_ld(&bar[XB_XCNT(j)]); sum += c; cnt += (c > 0u) ? 1u : 0u; mine = (j == x) ? c : mine; }
        if (sum == G) break;
        __builtin_amdgcn_s_sleep(1);
        if ((++sp & 255u) == 0u) { if (xb_ld(&bar[XB_TMO])) break; if (sp > XB_SPIN_CAP) { atomicAdd(&bar[XB_TMO], 1u); break; } }
    }
    nloc = mine > 0u ? mine : 1u; nx = cnt > 0u ? cnt : 1u;
}

__device__ __forceinline__ void xcd_barrier(const XcdBarrier& b) {
    asm volatile("s_waitcnt vmcnt(0)" ::: "memory");
    __syncthreads();
    if (threadIdx.x == 0) {
        unsigned* bar = b.bar; asm volatile("" : "+s"(bar));
        __builtin_amdgcn_s_waitcnt(0);
        unsigned nloc = b.st[0], nx = b.st[1];
        if (nloc == 0u) { xcd_barrier_complete(bar, b.x, nloc, nx); b.st[0] = nloc; b.st[1] = nx; }
        const unsigned old = xb_add(&bar[XB_XSUB(b.x)], 1u);
        const unsigned gen = old / nloc;
        if (old + 1u == (gen + 1u) * nloc) {
            __builtin_amdgcn_fence(__ATOMIC_RELEASE, "agent");
            asm volatile("s_waitcnt vmcnt(0)" ::: "memory");
            const unsigned og = xb_add(&bar[XB_TOP], 1u);
            const unsigned tg = og / nx;
            if (og + 1u == (tg + 1u) * nx) xb_add(&bar[XB_TOPGEN], 1u);
            else XB_SPIN(xb_ld(&bar[XB_TOPGEN]) == tg, bar);
            __builtin_amdgcn_fence(__ATOMIC_ACQUIRE, "agent");
            xb_add(&bar[XB_XGEN(b.x)], 1u);
            asm volatile("s_waitcnt vmcnt(0)" ::: "memory");
        } else {
            XB_SPIN(xb_ld(&bar[XB_XGEN(b.x)]) == gen, bar);
            __builtin_amdgcn_fence(__ATOMIC_ACQUIRE, "agent");
            asm volatile("s_waitcnt vmcnt(0)" ::: "memory");
        }
    }
    __syncthreads();
}


struct Params {
    const float* in[22]; float* out; unsigned char* ws;
    int ph_lo, ph_hi;
};
constexpr size_t MiB = 1u << 20;
constexpr size_t WS_CTL = 0, CTL_BYTES = 1 * MiB;
constexpr int CW_BAR = 4096;
constexpr int CW_CNT = 16384;
constexpr size_t WS_WIN = 2 * MiB;
constexpr size_t SZ_WIN = (size_t)INCP * DM;
constexpr size_t SZ_WUQ = (size_t)768 * QL, SZ_WUKV = (size_t)1024 * KVL;
constexpr size_t WS_WUQ = WS_WIN + 2 * SZ_WIN * 2;
constexpr size_t WS_WUKV = WS_WUQ + 2 * SZ_WUQ * 2;
constexpr size_t SZ_WP = (size_t)DM * 512, SZ_WOUT = (size_t)DM * DM;
constexpr size_t WS_WPA = WS_WUKV + 2 * SZ_WUKV * 2;
constexpr size_t WS_WPB = WS_WPA + 2 * SZ_WP * 2;
constexpr size_t WS_WOUT = WS_WPB + 2 * SZ_WP * 2;
constexpr size_t SZ_WRT = (size_t)NE * DM, SZ_WSGU = (size_t)512 * DM, SZ_WSD = (size_t)DM * DSH;
constexpr size_t WS_WRT = WS_WOUT + 2 * SZ_WOUT * 2;
constexpr size_t WS_WSGU = WS_WRT + 2 * SZ_WRT * 2;
constexpr size_t WS_WSD = WS_WSGU + 2 * SZ_WSGU * 2;
constexpr size_t WS_CS = WS_WSD + 2 * SZ_WSD * 2;
constexpr size_t WS_KM = WS_CS + (size_t)SEQ * 16 * 8;
constexpr size_t WS_SEL = WS_KM + (size_t)NB * HA * NBLK * 64 * 4;
constexpr size_t WS_XB = WS_SEL + (size_t)T * 8 * 4;
constexpr size_t WS_CQN = WS_XB + (size_t)T * DM * 2;
constexpr size_t WS_CKVN = WS_CQN + (size_t)T * QL * 2;
constexpr size_t WS_QB = WS_CKVN + (size_t)T * KVL * 2;
constexpr size_t WS_KB = WS_QB + (size_t)T * 768 * 2;
constexpr size_t WS_VB = WS_KB + (size_t)T * 768 * 2;
constexpr size_t WS_OAB = WS_VB + (size_t)T * 512 * 2;
constexpr size_t WS_TMP = WS_OAB + (size_t)T * 1024 * 2;
constexpr size_t WS_MRG = WS_TMP + (size_t)T * 1024 * 2;
constexpr size_t WS_PRE = WS_MRG + (size_t)T * 1024 * 2;
constexpr size_t WS_X1 = WS_PRE + (size_t)T * 1024 * 4;
constexpr size_t WS_X1B = WS_X1 + (size_t)T * 1024 * 4;
constexpr size_t WS_X2 = WS_X1B + (size_t)T * 1024 * 2;
constexpr size_t WS_LOG = WS_X2 + (size_t)T * 1024 * 4;
constexpr size_t WS_HS = WS_LOG + (size_t)T * NE * 4;
constexpr size_t WS_SH = WS_HS + (size_t)T * DSH * 2;
constexpr size_t WS_TOPE = WS_SH + (size_t)T * DM * 2;
constexpr size_t WS_TOPW = WS_TOPE + (size_t)NA * 4;
constexpr size_t WS_APOS = WS_TOPW + (size_t)NA * 4;
constexpr size_t WS_ROWA = WS_APOS + (size_t)NA * 4;
constexpr size_t WS_HIST = WS_ROWA + (size_t)NA * 8;
constexpr size_t WS_PO = WS_HIST + (size_t)1024 * 256 * 4;
constexpr size_t WS_PML = WS_PO + (size_t)T * 8 * 3 * 64 * 2;
constexpr size_t WS_HE = WS_PML + (size_t)T * 8 * 3 * 128;
constexpr size_t WS_Y = WS_HE + (size_t)NA * DE * 2;
constexpr size_t WS_PROJ = WS_Y + (size_t)NA * DM * 2;
constexpr size_t SZ_WEGU = (size_t)NE * 512 * DM, SZ_WED = (size_t)NE * DM * DE;
constexpr size_t WS_WEGU = WS_PROJ + (size_t)T * INCP * 2;
constexpr size_t WS_WED = WS_WEGU + 2 * SZ_WEGU * 2;
constexpr size_t WS_FAST_END = WS_WED + 2 * SZ_WED * 2;
constexpr size_t WS_NEED = WS_FAST_END;
static_assert(WS_NEED <= (size_t)2040 * MiB, "ws map");

constexpr int LDS_BYTES = 147456;
constexpr int RING_BYTES = 131072, MISC_OFF = RING_BYTES + 1024, TAB_OFF = RING_BYTES + 2048;

struct Frame { LAS unsigned char* lds; int tid, lane, wave, G, vcu; };

template <class RowMap>
__device__ __forceinline__ void transpose_item(const float* W, int K, int N, bf16_t* WT, int ldk, RowMap rm, LAS float* scr, int item, int lane) {
    const int nblk = N / 32, kb = item / nblk, nb = item % nblk, k0 = 64 * kb, n0 = 32 * nb;
#pragma unroll 8
    for (int i = 0; i < 32; ++i) { const int kk = 2 * i + (lane >> 5); scr[kk * 33 + (lane & 31)] = W[(size_t)(k0 + kk) * N + n0 + (lane & 31)]; }
    LDS_WAIT(); asm volatile("" ::: "memory");
    const int c = lane & 7;
#pragma unroll
    for (int j = 0; j < 4; ++j) { const int n = (lane >> 3) + 8 * j; const LAS float* s = scr + (8 * c) * 33 + n;
        u32x4 o; o.x = pk2(s[0 * 33], s[1 * 33]); o.y = pk2(s[2 * 33], s[3 * 33]); o.z = pk2(s[4 * 33], s[5 * 33]); o.w = pk2(s[6 * 33], s[7 * 33]);
        *(u32x4*)(WT + (size_t)rm(n0 + n) * ldk + k0 + 8 * c) = o; }
    LDS_WAIT(); asm volatile("" ::: "memory");
}
template <class RowMap>
__device__ __forceinline__ void transpose_item64(const float* W, int K, int N, bf16_t* WT, int ldk, RowMap rm, LAS unsigned short* scr, int item, int lane) {
    const int nblk = N / 64, kb = item / nblk, nb = item % nblk, k0 = 64 * kb, n0 = 64 * nb, r = lane >> 4, c4 = (lane & 15) * 4;
    f32x4 v[16];
#pragma unroll
    for (int i = 0; i < 16; ++i) v[i] = __builtin_nontemporal_load((const f32x4*)(W + (size_t)(k0 + 4 * i + r) * N + n0 + c4));
#pragma unroll
    for (int i = 0; i < 16; ++i) { LAS unsigned* d = (LAS unsigned*)(scr + (4 * i + r) * 66 + c4); d[0] = pk2(v[i][0], v[i][1]); d[1] = pk2(v[i][2], v[i][3]); }
    LDS_WAIT(); asm volatile("" ::: "memory");
    const int c = lane & 7;
#pragma unroll
    for (int j = 0; j < 8; ++j) { const int n = (lane >> 3) + 8 * j; const LAS unsigned short* q = scr + (8 * c) * 66 + n;
        u32x4 o; o.x = (unsigned)q[0] | ((unsigned)q[66] << 16); o.y = (unsigned)q[2 * 66] | ((unsigned)q[3 * 66] << 16); o.z = (unsigned)q[4 * 66] | ((unsigned)q[5 * 66] << 16); o.w = (unsigned)q[6 * 66] | ((unsigned)q[7 * 66] << 16);
        *(u32x4*)(WT + (size_t)rm(n0 + n) * ldk + k0 + 8 * c) = o; }
    LDS_WAIT(); asm volatile("" ::: "memory");
}
struct RowId { __device__ __forceinline__ int operator()(int n) const { return n; } };

struct EpiProj {
    static constexpr int MIDK = 0;
    bf16_t* O; const float* bg;
    __device__ __forceinline__ void operator()(const f32x4 (&acc)[2][2][4][2], const pg8::Unit& u, int wr, int wc, int fr, int fq) const {
        PG8_TILE_BEGIN(acc, wr, wc, fr, fq)
            const int row = u.pm * 256 + trow, col = u.pn * 256 + tcol;
            if (col < C_KA) { v0 = v0 * QS_A; v1 = v1 * QS_A; }
            else if (col >= C_GA && col < INC) { const f32x4 b0 = *(const f32x4*)(bg + col - C_GA), b1 = *(const f32x4*)(bg + col - C_GA + 4);
#pragma unroll
                for (int i = 0; i < 4; ++i) { v0[i] = sigmoidf_(v0[i] + b0[i]); v1[i] = sigmoidf_(v1[i] + b1[i]); } }
            *(u32x4*)(O + (size_t)row * INCP + col) = pg8::pack8(v0, v1);
        PG8_TILE_END
    }
};

struct RowQ { __device__ __forceinline__ int operator()(int n) const { const int h = n / 96, d = n % 96; if (d < 64) return n; const int i = d - 64; return h * 96 + 64 + (i < 16 ? 2 * i : 2 * (i - 16) + 1); } };

struct EpiQ {
    static constexpr int MIDK = 0;
    bf16_t* O; const f32x2* CS;
    __device__ __forceinline__ void operator()(const f32x4 (&acc)[2][2][4][2], const pg8::Unit& u, int wr, int wc, int fr, int fq) const {
        PG8_TILE_BEGIN(acc, wr, wc, fr, fq)
            const int row = u.pm * 256 + trow, col = u.pn * 256 + tcol, d = col % 96;
            if (d >= 64) { const int pos = row % SEQ, i0 = (d - 64) >> 1; const f32x2* cs = CS + (size_t)pos * 16 + i0;
                const f32x2 c0 = cs[0], c1 = cs[1], c2 = cs[2], c3 = cs[3];
                const f32x4 a = v0, b = v1;
                v0[0] = a[0] * c0[0] - a[1] * c0[1]; v0[1] = a[1] * c0[0] + a[0] * c0[1]; v0[2] = a[2] * c1[0] - a[3] * c1[1]; v0[3] = a[3] * c1[0] + a[2] * c1[1];
                v1[0] = b[0] * c2[0] - b[1] * c2[1]; v1[1] = b[1] * c2[0] + b[0] * c2[1]; v1[2] = b[2] * c3[0] - b[3] * c3[1]; v1[3] = b[3] * c3[0] + b[2] * c3[1]; }
            v0 = v0 * QS_B; v1 = v1 * QS_B;
            *(u32x4*)(O + (size_t)row * 768 + col) = pg8::pack8(v0, v1);
        PG8_TILE_END
    }
};
struct EpiKV {
    static constexpr int MIDK = 0;
    bf16_t* KB; bf16_t* VB;
    __device__ __forceinline__ void operator()(const f32x4 (&acc)[2][2][4][2], const pg8::Unit& u, int wr, int wc, int fr, int fq) const {
        PG8_TILE_BEGIN(acc, wr, wc, fr, fq)
            const int row = u.pm * 256 + trow, col = u.pn * 256 + tcol, h = col >> 7, j = col & 127;
            bf16_t* dst = (j < 64) ? KB + (size_t)row * 768 + h * 96 + j : VB + (size_t)row * 512 + h * 64 + (j - 64);
            *(u32x4*)dst = pg8::pack8(v0, v1);
        PG8_TILE_END
    }
};

__device__ __forceinline__ void prep_phase(const Frame& F, const bf16_t* PROJ, const float* qn, const float* kvn, const f32x2* CS, bf16_t* CQN, bf16_t* CKVN, bf16_t* KB, float* KM) {
    int lane_ = F.lane; asm volatile("" : "+v"(lane_));
    const int gw = F.vcu * NWAVES + F.wave, NGW = F.G * NWAVES, lane = lane_;
    for (int row = gw; row < T; row += NGW) {
        const bf16_t* p = PROJ + (size_t)row * INCP;
        u32x4 a = (u32x4){0u, 0u, 0u, 0u}, b = (u32x4){0u, 0u, 0u, 0u};
        if (lane < 48) a = *(const u32x4*)(p + C_CQ + lane * 8);
        if (lane < 32) b = *(const u32x4*)(p + C_CKV + lane * 8);
        float sq = 0.f, sk = 0.f;
#pragma unroll
        for (int i = 0; i < 4; ++i) { const float x = bflo(a[i]), y = bfhi(a[i]), z = bflo(b[i]), w = bfhi(b[i]); sq += x * x + y * y; sk += z * z + w * w; }
        sq = wave_sum(sq); sk = wave_sum(sk);
        const float rq = rsqrtf(sq * (1.f / QL) + RMS_EPS), rk = rsqrtf(sk * (1.f / KVL) + RMS_EPS);
        if (lane < 48) { const f32x4 g0 = *(const f32x4*)(qn + lane * 8), g1 = *(const f32x4*)(qn + lane * 8 + 4); u32x4 o;
            o.x = pk2(bflo(a.x) * rq * g0[0], bfhi(a.x) * rq * g0[1]); o.y = pk2(bflo(a.y) * rq * g0[2], bfhi(a.y) * rq * g0[3]);
            o.z = pk2(bflo(a.z) * rq * g1[0], bfhi(a.z) * rq * g1[1]); o.w = pk2(bflo(a.w) * rq * g1[2], bfhi(a.w) * rq * g1[3]);
            *(u32x4*)(CQN + (size_t)row * QL + lane * 8) = o; }
        if (lane < 32) { const f32x4 g0 = *(const f32x4*)(kvn + lane * 8), g1 = *(const f32x4*)(kvn + lane * 8 + 4); u32x4 o;
            o.x = pk2(bflo(b.x) * rk * g0[0], bfhi(b.x) * rk * g0[1]); o.y = pk2(bflo(b.y) * rk * g0[2], bfhi(b.y) * rk * g0[3]);
            o.z = pk2(bflo(b.z) * rk * g1[0], bfhi(b.z) * rk * g1[1]); o.w = pk2(bflo(b.w) * rk * g1[2], bfhi(b.w) * rk * g1[3]);
            *(u32x4*)(CKVN + (size_t)row * KVL + lane * 8) = o; }
        if (lane < 16) { const float x1 = bf2f(p[C_KR + lane]), x2 = bf2f(p[C_KR + 16 + lane]); const f32x2 cs = CS[(size_t)(row % SEQ) * 16 + lane];
            const unsigned w = pk2(x1 * cs[0] - x2 * cs[1], x2 * cs[0] + x1 * cs[1]);
#pragma unroll
            for (int h = 0; h < 8; ++h) *(unsigned*)(KB + (size_t)row * 768 + h * 96 + 64 + 2 * lane) = w; }
    }
    for (int it = gw; it < NB * NBLK * HA; it += NGW) {
        const int h = it % HA, blk = (it / HA) % NBLK, b = it / (HA * NBLK), c = lane & 7, r0 = lane >> 3;
        const bf16_t* p = PROJ + ((size_t)b * SEQ + (size_t)blk * BLK + r0) * INCP + C_KA + h * 64 + c * 8;
        float s[8];
#pragma unroll
        for (int i = 0; i < 8; ++i) s[i] = 0.f;
        for (int i = 0; i < 32; ++i) { const u32x4 v = *(const u32x4*)(p + (size_t)i * 8 * INCP);
#pragma unroll
            for (int k = 0; k < 4; ++k) { s[2 * k] += bflo(v[k]); s[2 * k + 1] += bfhi(v[k]); } }
#pragma unroll
        for (int i = 0; i < 8; ++i) { s[i] += __shfl_xor(s[i], 8); s[i] += __shfl_xor(s[i], 16); s[i] += __shfl_xor(s[i], 32); }
        if (lane < 8) { float* o = KM + ((size_t)(b * HA + h) * NBLK + blk) * 64 + c * 8;
            *(f32x4*)o = (f32x4){s[0], s[1], s[2], s[3]} * (1.f / BLK); *(f32x4*)(o + 4) = (f32x4){s[4], s[5], s[6], s[7]} * (1.f / BLK); }
    }
}
__device__ __forceinline__ void mobasel_phase(const Frame& F, const bf16_t* PROJ, const float* KM, unsigned* SEL) {
    int tid_ = F.tid; asm volatile("" : "+v"(tid_));
    const int TPW = T / F.G, row0 = (int)blockIdx.x * TPW, b = row0 / SEQ, own = (row0 % SEQ) / BLK, hs = own * 64 + 4;
    LAS float* km = (LAS float*)F.lds;
    for (int i = tid_; i < 8 * own * 16; i += NTHR) { const int h = i / (own * 16), r = i % (own * 16);
        *(LAS f32x4*)(km + h * hs + r * 4) = *(const f32x4*)(KM + ((size_t)(b * HA + h) * NBLK) * 64 + r * 4); }
    __syncthreads();
    for (int idx = tid_; idx < TPW * 8; idx += NTHR) {
        const int h = idx & 7, row = row0 + (idx >> 3);
        const bf16_t* qp = PROJ + (size_t)row * INCP + C_QA + h * 64;
        float q[64];
#pragma unroll
        for (int i = 0; i < 8; ++i) { const u32x4 v = *(const u32x4*)(qp + i * 8);
#pragma unroll
            for (int k = 0; k < 4; ++k) { q[i * 8 + 2 * k] = bflo(v[k]); q[i * 8 + 2 * k + 1] = bfhi(v[k]); } }
        float v1 = -INFINITY, v2 = -INFINITY, v3 = -INFINITY; int i1 = -1, i2 = -1, i3 = -1;
        for (int j = 0; j < own; ++j) {
            const LAS f32x4* kp = (const LAS f32x4*)(km + h * hs + j * 64);
            float g0 = 0.f, g1 = 0.f, g2 = 0.f, g3 = 0.f;
#pragma unroll
            for (int c = 0; c < 16; ++c) { const f32x4 k4 = kp[c]; g0 = fmaf(q[4 * c], k4[0], g0); g1 = fmaf(q[4 * c + 1], k4[1], g1); g2 = fmaf(q[4 * c + 2], k4[2], g2); g3 = fmaf(q[4 * c + 3], k4[3], g3); }
            const float g = (g0 + g1) + (g2 + g3);
            if (g > v1) { v3 = v2; i3 = i2; v2 = v1; i2 = i1; v1 = g; i1 = j; }
            else if (g > v2) { v3 = v2; i3 = i2; v2 = g; i2 = j; }
            else if (g > v3) { v3 = g; i3 = j; }
        }
        unsigned m = 0;
        if (i1 >= 0) m |= 1u << i1;
        if (i2 >= 0) m |= 1u << i2;
        if (i3 >= 0) m |= 1u << i3;
        SEL[(size_t)row * 8 + h] = m;
    }
    __syncthreads();
}

struct EpiGate2 {
    static constexpr int MIDK = 8;
    const bf16_t* PROJ; bf16_t* MRG;
    __device__ __forceinline__ void mid(f32x4 (&acc)[2][2][4][2], const pg8::Unit& u, int wr, int wc, int fr_, int fq) const {
        int fr = fr_; asm volatile("" : "+v"(fr));
#pragma unroll
        for (int ai = 0; ai < 2; ++ai)
#pragma unroll
            for (int m = 0; m < 4; ++m)
#pragma unroll
                for (int bj = 0; bj < 2; ++bj) { const size_t o = (size_t)(u.pm * 256 + ai * 128 + wr * 64 + m * 16 + fr) * INCP + u.pn * 256 + bj * 128 + wc * 32 + 8 * fq;
                    const u32x4 ga = *(const u32x4*)(PROJ + o + C_GA), gb = *(const u32x4*)(PROJ + o + C_GB);
#pragma unroll
                    for (int i = 0; i < 4; ++i) { const float r0 = bflo(ga[i]) * __builtin_amdgcn_rcpf(bflo(gb[i])), r1 = bfhi(ga[i]) * __builtin_amdgcn_rcpf(bfhi(gb[i]));
                        acc[ai][bj][m][i >> 1][2 * (i & 1)] *= r0; acc[ai][bj][m][i >> 1][2 * (i & 1) + 1] *= r1; }
                    __builtin_amdgcn_sched_barrier(0); }
    }
    __device__ __forceinline__ void operator()(const f32x4 (&acc)[2][2][4][2], const pg8::Unit& u, int wr, int wc, int fr, int fq) const {
        PG8_TILE_BEGIN(acc, wr, wc, fr, fq)
            const int row = u.pm * 256 + trow, col = u.pn * 256 + tcol;
            const u32x4 g = *(const u32x4*)(PROJ + (size_t)row * INCP + C_GB + col);
            v0[0] *= bflo(g.x); v0[1] *= bfhi(g.x); v0[2] *= bflo(g.y); v0[3] *= bfhi(g.y); v1[0] *= bflo(g.z); v1[1] *= bfhi(g.z); v1[2] *= bflo(g.w); v1[3] *= bfhi(g.w);
            *(u32x4*)(MRG + (size_t)row * DM + col) = pg8::pack8(v0, v1);
        PG8_TILE_END
    }
};
struct EpiResid {
    static constexpr int MIDK = 0;
    const bf16_t* X; bf16_t* PRE;
    __device__ __forceinline__ void operator()(const f32x4 (&acc)[2][2][4][2], const pg8::Unit& u, int wr, int wc, int fr, int fq) const {
        PG8_TILE_BEGIN(acc, wr, wc, fr, fq)
            const size_t o = (size_t)(u.pm * 256 + trow) * DM + u.pn * 256 + tcol;
            const u32x4 x = *(const u32x4*)(X + o);
            v0[0] += ALPHA * bflo(x.x); v0[1] += ALPHA * bfhi(x.x); v0[2] += ALPHA * bflo(x.y); v0[3] += ALPHA * bfhi(x.y);
            v1[0] += ALPHA * bflo(x.z); v1[1] += ALPHA * bfhi(x.z); v1[2] += ALPHA * bflo(x.w); v1[3] += ALPHA * bfhi(x.w);
            *(u32x4*)(PRE + o) = pg8::pack8(v0, v1);
        PG8_TILE_END
    }
};
__device__ __forceinline__ void ln_phase(const Frame& F, const bf16_t* PRE, const float* g, const float* bt, bf16_t* XBo) {
    int lane_ = F.lane; asm volatile("" : "+v"(lane_));
    const int gw = F.vcu * NWAVES + F.wave, NGW = F.G * NWAVES, lane = lane_;
    for (int row = gw; row < T; row += NGW) {
        const u32x2* pr = (const u32x2*)(PRE + (size_t)row * DM) + lane;
        f32x4 v[4]; float s = 0.f;
#pragma unroll
        for (int j = 0; j < 4; ++j) { const u32x2 h = pr[64 * j]; v[j] = (f32x4){bflo(h.x), bfhi(h.x), bflo(h.y), bfhi(h.y)}; s += (v[j][0] + v[j][1]) + (v[j][2] + v[j][3]); }
        const float mean = wave_sum(s) * (1.f / DM); float s2 = 0.f;
#pragma unroll
        for (int j = 0; j < 4; ++j) { v[j] = v[j] - mean; s2 += (v[j][0] * v[j][0] + v[j][1] * v[j][1]) + (v[j][2] * v[j][2] + v[j][3] * v[j][3]); }
        const float rstd = rsqrtf(wave_sum(s2) * (1.f / DM) + LN_EPS);
#pragma unroll
        for (int j = 0; j < 4; ++j) { const f32x4 gg = ((const f32x4*)g)[lane + 64 * j], bb = ((const f32x4*)bt)[lane + 64 * j];
            const f32x4 y = v[j] * rstd * gg + bb;
            u32x2 w; w.x = pk2(y[0], y[1]); w.y = pk2(y[2], y[3]); ((u32x2*)(XBo + (size_t)row * DM))[lane + 64 * j] = w; }
    }
}

struct RowGU { int off; __device__ __forceinline__ int operator()(int n) const { return 256 * (n >> 7) + off + (n & 127); } };

struct EpiF32 {
    static constexpr int MIDK = 0;
    float* O; int ld;
    __device__ __forceinline__ void operator()(const f32x4 (&acc)[2][2][4][2], const pg8::Unit& u, int wr, int wc, int fr, int fq) const {
        PG8_TILE_BEGIN(acc, wr, wc, fr, fq)
            float* o = O + (size_t)(u.pm * 256 + trow) * ld + u.pn * 256 + tcol; *(f32x4*)o = v0; *(f32x4*)(o + 4) = v1;
        PG8_TILE_END
    }
};
struct EpiBf16 {
    static constexpr int MIDK = 0;
    bf16_t* O; int ld;
    __device__ __forceinline__ void operator()(const f32x4 (&acc)[2][2][4][2], const pg8::Unit& u, int wr, int wc, int fr, int fq) const {
        PG8_TILE_BEGIN(acc, wr, wc, fr, fq)
            *(u32x4*)(O + (size_t)(u.pm * 256 + trow) * ld + u.pn * 256 + tcol) = pg8::pack8(v0, v1);
        PG8_TILE_END
    }
};
__device__ __forceinline__ float silu_mul(float g, float u) { return g * __builtin_amdgcn_rcpf(1.f + __expf(-g)) * u; }
struct EpiSwiGLU {
    static constexpr int MIDK = 0;
    bf16_t* H; int ld;
    __device__ __forceinline__ void operator()(const f32x4 (&acc)[2][2][4][2], const pg8::Unit& u, int wr, int wc, int fr, int fq) const {
#pragma unroll
        for (int ai = 0; ai < 2; ++ai)
#pragma unroll
            for (int m = 0; m < 4; ++m) { const int row = u.r0 + ai * 128 + wr * 64 + m * 16 + fr;
                if (row < u.rend) { f32x4 h0, h1;
#pragma unroll
                    for (int i = 0; i < 4; ++i) { h0[i] = silu_mul(acc[ai][0][m][0][i], acc[ai][1][m][0][i]); h1[i] = silu_mul(acc[ai][0][m][1][i], acc[ai][1][m][1][i]); }
                    *(u32x4*)(H + (size_t)row * ld + 128 * u.pn + wc * 32 + 8 * fq) = pg8::pack8(h0, h1); } }
    }
};
struct EpiExpDown {
    static constexpr int MIDK = 0;
    bf16_t* Y;
    __device__ __forceinline__ void operator()(const f32x4 (&acc)[2][2][4][2], const pg8::Unit& u, int wr, int wc, int fr, int fq) const {
#pragma unroll
        for (int ai = 0; ai < 2; ++ai)
#pragma unroll
            for (int m = 0; m < 4; ++m) { const int row = u.r0 + ai * 128 + wr * 64 + m * 16 + fr;
                if (row < u.rend) {
#pragma unroll
                    for (int bj = 0; bj < 2; ++bj) *(u32x4*)(Y + (size_t)row * DM + 256 * u.pn + bj * 128 + wc * 32 + 8 * fq) = pg8::pack8(acc[ai][bj][m][0], acc[ai][bj][m][1]); } }
    }
};
template <int NPN, bool GATHER>
struct ExpertOrder {
    const LAS int* off; const LAS int* toff; const int* rowa; int G, c; size_t strideE;
    __device__ __forceinline__ bool next(int i, pg8::Unit& u) const {
        const int L = i * G + c; if (L >= toff[256] * NPN) return false;
        const int tile = L / NPN; u.pn = L % NPN; int lo = 0, hi = 255;
        while (lo < hi) { const int mid = (lo + hi + 1) >> 1; if (toff[mid] <= tile) lo = mid; else hi = mid - 1; }
        u.e = lo; u.r0 = off[lo] + (tile - toff[lo]) * 256; u.rend = off[lo + 1]; u.pm = 0; return true;
    }
    __device__ __forceinline__ int a_row(const pg8::Unit& u, int r) const { const int rr = min(u.r0 + r, u.rend - 1); return GATHER ? (rowa[2 * rr] >> 3) : rr; }
    __device__ __forceinline__ const char* b_ptr(const pg8::Gemm& g, const pg8::Unit& u) const { return (const char*)g.Bt + (size_t)u.e * strideE + (size_t)u.pn * 256 * g.ldb * 2; }
};
__device__ __forceinline__ void expert_tables(const Frame& F, const unsigned* cnt, LAS int* off, LAS int* toff) {
    if (F.tid < 256) { off[F.tid] = (int)cnt[F.tid]; }
    __syncthreads();
    if (F.tid == 0) { int a = 0, b = 0; for (int i = 0; i < 256; ++i) { const int c = off[i]; off[i] = a; toff[i] = b; a += c; b += (c + 255) >> 8; } off[256] = a; toff[256] = b; }
    __syncthreads();
}
__device__ __forceinline__ void route_phase(const Frame& F, const float* LOGITS, const float* rbias, int* TOPE, float* TOPW, int* APOS, int* HIST, LAS int* lcnt) {
    int lane_ = F.lane; asm volatile("" : "+v"(lane_));
    const int lane = lane_, TPW = T / F.G, t0 = (int)blockIdx.x * TPW;
    if (F.tid < 256) lcnt[F.tid] = 0;
    __syncthreads();
    const f32x4 rb = *(const f32x4*)(rbias + lane * 4);
    for (int t = t0 + F.wave; t < t0 + TPW; t += NWAVES) {
        const f32x4 lg = *(const f32x4*)(LOGITS + (size_t)t * NE + lane * 4);
        const float s0 = 1.f / (1.f + expf(-lg[0])), s1 = 1.f / (1.f + expf(-lg[1])), s2 = 1.f / (1.f + expf(-lg[2])), s3 = 1.f / (1.f + expf(-lg[3]));
        float c0 = s0 + rb[0], c1 = s1 + rb[1], c2 = s2 + rb[2], c3 = s3 + rb[3];
        float a = fmaxf(c0, c1), bq = fminf(c0, c1);
        { const float hi2 = fmaxf(c2, c3), lo2 = fminf(c2, c3); const float na = fmaxf(a, hi2), nb = fmaxf(fminf(a, hi2), fmaxf(bq, lo2)); a = na; bq = nb; }
#pragma unroll
        for (int o = 1; o < 8; o <<= 1) { const float oa = __shfl_xor(a, o), ob = __shfl_xor(bq, o); const float na = fmaxf(a, oa), nb = fmaxf(fminf(a, oa), fmaxf(bq, ob)); a = na; bq = nb; }
        const float gs = a + bq; const int grp = lane >> 3;
        int rank = 0;
#pragma unroll
        for (int j = 0; j < 8; ++j) { const float og = __shfl(gs, j * 8); rank += (og > gs || (og == gs && j < grp)) ? 1 : 0; }
        if (rank >= 4) { c0 = c1 = c2 = c3 = -INFINITY; }
        float wsum = 0.f, myw = 0.f; int mye = 0;
#pragma unroll
        for (int k = 0; k < TOPK; ++k) {
            float bv = c0; int bi = 0;
            if (c1 > bv) { bv = c1; bi = 1; }
            if (c2 > bv) { bv = c2; bi = 2; }
            if (c3 > bv) { bv = c3; bi = 3; }
            int be = lane * 4 + bi;
#pragma unroll
            for (int o = 1; o < 64; o <<= 1) { const float ov = __shfl_xor(bv, o); const int oe = __shfl_xor(be, o); if (ov > bv || (ov == bv && oe < be)) { bv = ov; be = oe; } }
            float sc = 0.f;
            if ((be >> 2) == lane) { const int b2 = be & 3; sc = b2 == 0 ? s0 : b2 == 1 ? s1 : b2 == 2 ? s2 : s3; if (b2 == 0) c0 = -INFINITY; else if (b2 == 1) c1 = -INFINITY; else if (b2 == 2) c2 = -INFINITY; else c3 = -INFINITY; }
            sc = __shfl(sc, be >> 2);
            wsum += sc;
            if (lane == k) { myw = sc; mye = be; }
        }
        if (lane < TOPK) { const int aidx = t * TOPK + lane; TOPE[aidx] = mye; TOPW[aidx] = myw / wsum * 2.5f; APOS[aidx] = __hip_atomic_fetch_add(lcnt + mye, 1, __ATOMIC_RELAXED, __HIP_MEMORY_SCOPE_WORKGROUP); }
    }
    __syncthreads();
    if (F.tid < 256) HIST[(size_t)blockIdx.x * 256 + F.tid] = lcnt[F.tid];
}
__device__ __forceinline__ void combine_phase(const Frame& F, const bf16_t* X1, const bf16_t* SH, const bf16_t* Y, const int* INV, const float* TOPW, const float* g, const float* bt, float* Xo, bf16_t* XBo) {
    int lane_ = F.lane; asm volatile("" : "+v"(lane_));
    const int gw = F.vcu * NWAVES + F.wave, NGW = F.G * NWAVES, lane = lane_;
    for (int row = gw; row < T; row += NGW) {
        int ri = 0; float rw = 0.f; if (lane < TOPK) { ri = INV[row * TOPK + lane]; rw = TOPW[row * TOPK + lane]; }
        float v[2][8];
#pragma unroll
        for (int j = 0; j < 2; ++j) { const u32x4 x = ((const u32x4*)(X1 + (size_t)row * DM))[lane + 64 * j], h = ((const u32x4*)(SH + (size_t)row * DM))[lane + 64 * j];
#pragma unroll
            for (int i = 0; i < 4; ++i) { v[j][2 * i] = ALPHA * bflo(x[i]) + bflo(h[i]); v[j][2 * i + 1] = ALPHA * bfhi(x[i]) + bfhi(h[i]); } }
#pragma unroll
        for (int k = 0; k < TOPK; ++k) { const u32x4* yr = (const u32x4*)(Y + (size_t)__shfl(ri, k) * DM); const float w = __shfl(rw, k);
#pragma unroll
            for (int j = 0; j < 2; ++j) { const u32x4 h = yr[lane + 64 * j];
#pragma unroll
                for (int i = 0; i < 4; ++i) { v[j][2 * i] = fmaf(w, bflo(h[i]), v[j][2 * i]); v[j][2 * i + 1] = fmaf(w, bfhi(h[i]), v[j][2 * i + 1]); } } }
        float s = 0.f;
#pragma unroll
        for (int j = 0; j < 2; ++j)
#pragma unroll
            for (int i = 0; i < 8; ++i) s += v[j][i];
        const float mean = wave_sum(s) * (1.f / DM); float s2 = 0.f;
#pragma unroll
        for (int j = 0; j < 2; ++j)
#pragma unroll
            for (int i = 0; i < 8; ++i) { v[j][i] -= mean; s2 += v[j][i] * v[j][i]; }
        const float rstd = rsqrtf(wave_sum(s2) * (1.f / DM) + LN_EPS);
#pragma unroll
        for (int j = 0; j < 2; ++j) { const int c0 = 8 * lane + 512 * j;
            const f32x4 g0 = *(const f32x4*)(g + c0), g1 = *(const f32x4*)(g + c0 + 4), b0 = *(const f32x4*)(bt + c0), b1 = *(const f32x4*)(bt + c0 + 4);
            const f32x4 y0 = (f32x4){v[j][0], v[j][1], v[j][2], v[j][3]} * rstd * g0 + b0, y1 = (f32x4){v[j][4], v[j][5], v[j][6], v[j][7]} * rstd * g1 + b1;
            if (Xo) { *(f32x4*)(Xo + (size_t)row * DM + c0) = y0; *(f32x4*)(Xo + (size_t)row * DM + c0 + 4) = y1; }
            if (XBo) { u32x4 w; w.x = pk2(y0[0], y0[1]); w.y = pk2(y0[2], y0[3]); w.z = pk2(y1[0], y1[1]); w.w = pk2(y1[2], y1[3]); *(u32x4*)(XBo + (size_t)row * DM + c0) = w; } }
    }
}

__device__ __forceinline__ int crow(int r, int hi) { return (r & 3) + 8 * (r >> 2) + 4 * hi; }
typedef short s16x4 __attribute__((ext_vector_type(4)));
__device__ __forceinline__ s16x4 vtr(const LAS unsigned char* p) { return __builtin_bit_cast(s16x4, __builtin_amdgcn_ds_read_tr16_b64_v4i16((LAS s16x4*)p)); }
__device__ __forceinline__ float xhalf_max(float v) { auto rr = __builtin_amdgcn_permlane32_swap(__float_as_uint(v), __float_as_uint(v), false, false); return fmaxf(__uint_as_float(rr[0]), __uint_as_float(rr[1])); }
__device__ __forceinline__ float xhalf_sum(float v) { auto rr = __builtin_amdgcn_permlane32_swap(__float_as_uint(v), __float_as_uint(v), false, false); return __uint_as_float(rr[0]) + __uint_as_float(rr[1]); }

template <int DQK, bool ALIBI>
__device__ __forceinline__ void attn_tile(const LAS unsigned char* kb, int kfo, int vfo, const bf16x8 (&qf)[DQK / 16], float& m, float& l, f32x16& o0, f32x16& o1, int hi, int tq, int kpos0, float slope2, bool causal) {
    constexpr int ND0 = DQK / 16;
    bf16x8 ka[ND0], kc[ND0];
#pragma unroll
    for (int d0 = 0; d0 < ND0; ++d0) { ka[d0] = *(const LAS bf16x8*)(kb + kfo + d0 * 2048); kc[d0] = *(const LAS bf16x8*)(kb + kfo + d0 * 2048 + 512); }
    __builtin_amdgcn_sched_barrier(0);
    f32x16 p0, p1;
#pragma unroll
    for (int r = 0; r < 16; ++r) { p0[r] = 0.f; p1[r] = 0.f; }
#pragma unroll
    for (int d0 = 0; d0 < ND0; ++d0) {
        p0 = __builtin_amdgcn_mfma_f32_32x32x16_bf16(ka[d0], qf[d0], p0, 0, 0, 0);
        p1 = __builtin_amdgcn_mfma_f32_32x32x16_bf16(kc[d0], qf[d0], p1, 0, 0, 0);
    }
    s16x4 vlo[8], vhi[8];
    { const unsigned va = (unsigned)(uintptr_t)(kb + vfo);
#pragma unroll
      for (int i = 0; i < 8; ++i) {
        asm volatile("ds_read_b64_tr_b16 %0, %1 offset:%c2" : "=&v"(vlo[i]) : "v"(va), "i"((i >> 2) * 4096 + (i & 3) * 1024) : "memory");
        asm volatile("ds_read_b64_tr_b16 %0, %1 offset:%c2" : "=&v"(vhi[i]) : "v"(va), "i"((i >> 2) * 4096 + (i & 3) * 1024 + 512) : "memory"); } }
    const int krel = kpos0 + 4 * hi - tq;
    if (ALIBI) { const float bb = slope2 * (float)krel;
#pragma unroll
        for (int r = 0; r < 16; ++r) { const float c = (float)((r & 3) + 8 * (r >> 2)); p0[r] += fmaf(slope2, c, bb); p1[r] += fmaf(slope2, c + 32.f, bb); } }
    if (causal) {
#pragma unroll
        for (int r = 0; r < 16; ++r) { const int kv = krel + (r & 3) + 8 * (r >> 2); if (kv > 0) p0[r] = -INFINITY; if (kv + 32 > 0) p1[r] = -INFINITY; } }
    float rm = fmaxf(p0[0], p1[0]);
#pragma unroll
    for (int r = 1; r < 16; ++r) rm = fmaxf(rm, fmaxf(p0[r], p1[r]));
    rm = xhalf_max(rm);
    const float mn = fmaxf(m, rm), alpha = __builtin_amdgcn_exp2f(m - mn);
    m = mn;
    float ls = 0.f;
#pragma unroll
    for (int r = 0; r < 16; ++r) { p0[r] = __builtin_amdgcn_exp2f(p0[r] - mn); p1[r] = __builtin_amdgcn_exp2f(p1[r] - mn); ls += p0[r] + p1[r]; }
    l = l * alpha + ls;
#pragma unroll
    for (int r = 0; r < 16; ++r) { o0[r] *= alpha; o1[r] *= alpha; }
    const u32x4 pw0 = (u32x4){pg8::cvt_pk_bf16(p0[0], p0[1]), pg8::cvt_pk_bf16(p0[2], p0[3]), pg8::cvt_pk_bf16(p0[4], p0[5]), pg8::cvt_pk_bf16(p0[6], p0[7])};
    const u32x4 pw1 = (u32x4){pg8::cvt_pk_bf16(p0[8], p0[9]), pg8::cvt_pk_bf16(p0[10], p0[11]), pg8::cvt_pk_bf16(p0[12], p0[13]), pg8::cvt_pk_bf16(p0[14], p0[15])};
    const u32x4 pw2 = (u32x4){pg8::cvt_pk_bf16(p1[0], p1[1]), pg8::cvt_pk_bf16(p1[2], p1[3]), pg8::cvt_pk_bf16(p1[4], p1[5]), pg8::cvt_pk_bf16(p1[6], p1[7])};
    const u32x4 pw3 = (u32x4){pg8::cvt_pk_bf16(p1[8], p1[9]), pg8::cvt_pk_bf16(p1[10], p1[11]), pg8::cvt_pk_bf16(p1[12], p1[13]), pg8::cvt_pk_bf16(p1[14], p1[15])};
    asm volatile("s_waitcnt lgkmcnt(0)" ::: "memory"); __builtin_amdgcn_sched_barrier(0);
#define ATT_VF(i) (bf16x8){vlo[i][0], vlo[i][1], vlo[i][2], vlo[i][3], vhi[i][0], vhi[i][1], vhi[i][2], vhi[i][3]}
    o0 = __builtin_amdgcn_mfma_f32_32x32x16_bf16(ATT_VF(0), __builtin_bit_cast(bf16x8, pw0), o0, 0, 0, 0);
    o1 = __builtin_amdgcn_mfma_f32_32x32x16_bf16(ATT_VF(4), __builtin_bit_cast(bf16x8, pw0), o1, 0, 0, 0);
    o0 = __builtin_amdgcn_mfma_f32_32x32x16_bf16(ATT_VF(1), __builtin_bit_cast(bf16x8, pw1), o0, 0, 0, 0);
    o1 = __builtin_amdgcn_mfma_f32_32x32x16_bf16(ATT_VF(5), __builtin_bit_cast(bf16x8, pw1), o1, 0, 0, 0);
    o0 = __builtin_amdgcn_mfma_f32_32x32x16_bf16(ATT_VF(2), __builtin_bit_cast(bf16x8, pw2), o0, 0, 0, 0);
    o1 = __builtin_amdgcn_mfma_f32_32x32x16_bf16(ATT_VF(6), __builtin_bit_cast(bf16x8, pw2), o1, 0, 0, 0);
    o0 = __builtin_amdgcn_mfma_f32_32x32x16_bf16(ATT_VF(3), __builtin_bit_cast(bf16x8, pw3), o0, 0, 0, 0);
    o1 = __builtin_amdgcn_mfma_f32_32x32x16_bf16(ATT_VF(7), __builtin_bit_cast(bf16x8, pw3), o1, 0, 0, 0);
#undef ATT_VF
}
#define ATT_ISSUE(t, bo) do { \
        for (int c_ = wid; c_ < NCH; c_ += 8) __builtin_amdgcn_global_load_lds((const unsigned*)(ksrc + (size_t)(t) * 64 * ldk + c_ * 8), (LAS unsigned*)(lds + (bo) + c_ * 1024), 16, 0, 0); \
        __builtin_amdgcn_global_load_lds((const unsigned*)(vsrc + (size_t)(t) * 64 * ldv), (LAS unsigned*)(lds + (bo) + KBYTES + wid * 1024), 16, 0, 0); } while (0)

template <int DQK, bool MOBA_OWN>
__device__ __forceinline__ void attn_unit(LAS unsigned char* lds, int b, int h, int qb, const bf16_t* Qp, int ldq, const bf16_t* Kp, int ldk, const bf16_t* Vp, int ldv, bf16_t* Op, int ldo, const bf16_t* PO, const f32x2* PML) {
    constexpr int NCH = DQK / 8, KBYTES = NCH * 1024, BUFB = KBYTES + 8192, ND0 = DQK / 16;
    int tid_ = threadIdx.x; asm volatile("" : "+v"(tid_));
    const int lane = tid_ & 63, r32 = lane & 31, hi = lane >> 5, wid = __builtin_amdgcn_readfirstlane(tid_ >> 6);
    const size_t rowbase = (size_t)b * SEQ; const int q0 = qb * 256, T0 = MOBA_OWN ? 4 * qb : 0, T1 = 4 * (qb + 1), tq = q0 + wid * 32 + r32;
    const bf16_t* ksrc = Kp + (rowbase + lane) * ldk + h * DQK;
    const bf16_t* vsrc = Vp + (rowbase + 16 * (wid & 3) + (lane >> 2)) * ldv + h * 64 + (wid >> 2) * 32 + (lane & 3) * 8;
    ATT_ISSUE(T0, 0);
    bf16x8 qf[ND0];
    { const bf16_t* qrow = Qp + (rowbase + tq) * ldq + h * DQK + hi * 8;
#pragma unroll
      for (int d0 = 0; d0 < ND0; ++d0) qf[d0] = *(const bf16x8*)(qrow + d0 * 16); }
    const float slope2 = MOBA_OWN ? exp2f(-(float)(h + 1)) * LOG2E : 0.f;
    float m = -1e30f, l = 0.f;
    f32x16 o0, o1;
#pragma unroll
    for (int r = 0; r < 16; ++r) { o0[r] = 0.f; o1[r] = 0.f; }
    const int kfo = hi * 1024 + r32 * 16;
    const int vfo = KBYTES + ((lane >> 4) & 1) * 32 + (lane & 3) * 8 + (4 * hi + ((lane & 15) >> 2)) * 64;
#pragma unroll 1
    for (int t = T0; t < T1; ++t) {
        asm volatile("s_waitcnt vmcnt(0) lgkmcnt(0)\n\ts_barrier" ::: "memory");
        if (t + 1 < T1) ATT_ISSUE(t + 1, ((t + 1) & 1) * BUFB);
        attn_tile<DQK, MOBA_OWN>(lds + (t & 1) * BUFB, kfo, vfo, qf, m, l, o0, o1, hi, tq, 64 * t, slope2, t >= T1 - 4);
    }
    float lt = xhalf_sum(l);
    if (MOBA_OWN) {
        const int nsel = qb < 3 ? qb : 3;
        const size_t pidx = ((rowbase + tq) * 8 + h) * 3;
        float ms[3], ws[3], M = m;
#pragma unroll
        for (int sIdx = 0; sIdx < 3; ++sIdx) { ms[sIdx] = -1e30f; ws[sIdx] = 0.f; if (sIdx < nsel) { const f32x2 ml = PML[(pidx + sIdx) * 16]; ms[sIdx] = ml[0]; ws[sIdx] = ml[1]; M = fmaxf(M, ml[0]); } }
        const float w0 = __builtin_amdgcn_exp2f(m - M);
        lt *= w0;
#pragma unroll
        for (int r = 0; r < 16; ++r) { o0[r] *= w0; o1[r] *= w0; }
#pragma unroll
        for (int sIdx = 0; sIdx < 3; ++sIdx) if (sIdx < nsel) {
            const float w = ws[sIdx] * __builtin_amdgcn_exp2f(ms[sIdx] - M); lt += w;
            const bf16_t* po = PO + (pidx + sIdx) * 64 + 4 * hi;
#pragma unroll
            for (int r4 = 0; r4 < 4; ++r4) { const u32x2 a = *(const u32x2*)(po + 8 * r4), c = *(const u32x2*)(po + 32 + 8 * r4);
                o0[4 * r4] += w * bflo(a.x); o0[4 * r4 + 1] += w * bfhi(a.x); o0[4 * r4 + 2] += w * bflo(a.y); o0[4 * r4 + 3] += w * bfhi(a.y);
                o1[4 * r4] += w * bflo(c.x); o1[4 * r4 + 1] += w * bfhi(c.x); o1[4 * r4 + 2] += w * bflo(c.y); o1[4 * r4 + 3] += w * bfhi(c.y); } }
    }
    const float inv = 1.f / lt;
    bf16_t* orow = Op + (rowbase + tq) * ldo + h * 64 + 4 * hi;
#pragma unroll
    for (int r4 = 0; r4 < 4; ++r4) {
        u32x2 w0_, w1_;
        w0_.x = pg8::cvt_pk_bf16(o0[4 * r4] * inv, o0[4 * r4 + 1] * inv); w0_.y = pg8::cvt_pk_bf16(o0[4 * r4 + 2] * inv, o0[4 * r4 + 3] * inv);
        w1_.x = pg8::cvt_pk_bf16(o1[4 * r4] * inv, o1[4 * r4 + 1] * inv); w1_.y = pg8::cvt_pk_bf16(o1[4 * r4 + 2] * inv, o1[4 * r4 + 3] * inv);
        *(u32x2*)(orow + 8 * r4) = w0_; *(u32x2*)(orow + 32 + 8 * r4) = w1_;
    }
    asm volatile("s_waitcnt lgkmcnt(0)\n\ts_barrier" ::: "memory");
}
__device__ __forceinline__ void moba_sel_unit(LAS unsigned char* lds, int b, int h, int j, int slo, int shi, const bf16_t* Qp, const bf16_t* Kp, const bf16_t* Vp, int ldk, const unsigned* SEL, bf16_t* PO, f32x2* PML) {
    constexpr int DQK = 64, NCH = 8, KBYTES = 8192, BUFB = 16384, ldv = INCP; (void)ldv;
    int tid_ = threadIdx.x; asm volatile("" : "+v"(tid_));
    const int lane = tid_ & 63, r32 = lane & 31, hi = lane >> 5, wid = __builtin_amdgcn_readfirstlane(tid_ >> 6);
    const size_t rowbase = (size_t)b * SEQ;
    const bf16_t* ksrc = Kp + (rowbase + lane) * ldk + h * DQK;
    const bf16_t* vsrc = Vp + (rowbase + 16 * (wid & 3) + (lane >> 2)) * ldk + h * 64 + (wid >> 2) * 32 + (lane & 3) * 8;
#pragma unroll
    for (int tt = 0; tt < 4; ++tt) ATT_ISSUE(4 * j + tt, tt * BUFB);
    LAS unsigned short* list = (LAS unsigned short*)(lds + 4 * BUFB);
    LAS int* cnt = (LAS int*)(lds + 4 * BUFB + 4096);
    if (tid_ == 0) *cnt = 0;
    __syncthreads();
    const int nsrc = (shi - slo) * 256;
    for (int i = tid_; i < nsrc; i += NTHR) {
        const unsigned sm = SEL[(rowbase + (size_t)slo * 256 + i) * 8 + h];
        const bool f = ((sm >> j) & 1u) != 0u;
        const unsigned long long bal = __ballot(f);
        const int rank = __builtin_amdgcn_mbcnt_hi((unsigned)(bal >> 32), __builtin_amdgcn_mbcnt_lo((unsigned)bal, 0u));
        int base = 0;
        if (lane == 0) base = __hip_atomic_fetch_add(cnt, (int)__builtin_popcountll(bal), __ATOMIC_RELAXED, __HIP_MEMORY_SCOPE_WORKGROUP);
        base = __builtin_amdgcn_readfirstlane(base);
        if (f) list[base + rank] = (unsigned short)i;
    }
    asm volatile("s_waitcnt vmcnt(0)" ::: "memory");
    __syncthreads();
    const int n = *cnt, nch = (n + 31) >> 5;
    const float slope2 = exp2f(-(float)(h + 1)) * LOG2E;
    const int kfo = hi * 1024 + r32 * 16;
    const int vfo = KBYTES + ((lane >> 4) & 1) * 32 + (lane & 3) * 8 + (4 * hi + ((lane & 15) >> 2)) * 64;
    for (int ch = wid; ch < nch; ch += 8) {
        const int e = ch * 32 + r32; const bool valid = e < n;
        const int tq = slo * 256 + (int)list[valid ? e : n - 1];
        bf16x8 qf[4];
        { const bf16_t* qrow = Qp + (rowbase + tq) * INCP + h * DQK + hi * 8;
#pragma unroll
          for (int d0 = 0; d0 < 4; ++d0) qf[d0] = *(const bf16x8*)(qrow + d0 * 16); }
        const unsigned sm = SEL[(rowbase + tq) * 8 + h];
        float m = -1e30f, l = 0.f;
        f32x16 o0, o1;
#pragma unroll
        for (int r = 0; r < 16; ++r) { o0[r] = 0.f; o1[r] = 0.f; }
#pragma unroll 1
        for (int tt = 0; tt < 4; ++tt) attn_tile<64, true>(lds + tt * BUFB, kfo, vfo, qf, m, l, o0, o1, hi, tq, 256 * j + 64 * tt, slope2, false);
        const float lt = xhalf_sum(l), inv = 1.f / lt;
        if (valid) {
            const size_t pidx = ((rowbase + tq) * 8 + h) * 3 + __builtin_popcount(sm & ((1u << j) - 1u));
            if (hi == 0) PML[pidx * 16] = (f32x2){m, lt};
            bf16_t* po = PO + pidx * 64 + 4 * hi;
#pragma unroll
            for (int r4 = 0; r4 < 4; ++r4) {
                u32x2 w0_, w1_;
                w0_.x = pg8::cvt_pk_bf16(o0[4 * r4] * inv, o0[4 * r4 + 1] * inv); w0_.y = pg8::cvt_pk_bf16(o0[4 * r4 + 2] * inv, o0[4 * r4 + 3] * inv);
                w1_.x = pg8::cvt_pk_bf16(o1[4 * r4] * inv, o1[4 * r4 + 1] * inv); w1_.y = pg8::cvt_pk_bf16(o1[4 * r4 + 2] * inv, o1[4 * r4 + 3] * inv);
                *(u32x2*)(po + 8 * r4) = w0_; *(u32x2*)(po + 32 + 8 * r4) = w1_;
            }
        }
    }
    __syncthreads();
}
#undef ATT_ISSUE
__device__ __forceinline__ void mla_phase(const Frame& F, const bf16_t* QB, const bf16_t* KB, const bf16_t* VB, bf16_t* Op) {
    for (int u = 2 * F.vcu; u < 512; u += 2 * F.G) {
#pragma unroll 1
        for (int k = 0; k < 2; ++k) { const int uu = u + k, bh = uu >> 5, w = uu & 31, qb = (w & 1) ? (w >> 1) : 31 - (w >> 1);
            attn_unit<96, false>(F.lds, bh >> 3, bh & 7, qb, QB, 768, KB, 768, VB, 512, Op, 1024, nullptr, nullptr); }
    }
}
__device__ __forceinline__ void moba_sel_phase(const Frame& F, const bf16_t* PROJ, const unsigned* SEL, bf16_t* PO, f32x2* PML) {
#pragma unroll 1
    for (int u = (int)blockIdx.x; u < 16 * 136; u += F.G) {
        int p = 0; while (16 * (2 * (p + 1) * (p + 1) + (p + 1)) <= u) ++p;
        const int r = u - 16 * (2 * p * p + p), j = r >> 4, bh = r & 15;
        const int slo = (j + 1 > 4 * p) ? j + 1 : 4 * p, shi = 4 * p + 4;
        moba_sel_unit(F.lds, bh >> 3, bh & 7, j, slo, shi, PROJ + C_QA, PROJ + C_KA, PROJ + C_VA, INCP, SEL, PO, PML);
    }
}
__device__ __forceinline__ void moba_own_phase(const Frame& F, const bf16_t* PROJ, bf16_t* Op, const bf16_t* PO, const f32x2* PML) {
#pragma unroll 1
    for (int u = F.vcu; u < 512; u += F.G) { const int bh = u >> 5, qb = u & 31;
        attn_unit<64, true>(F.lds, bh >> 3, bh & 7, qb, PROJ + C_QA, INCP, PROJ + C_KA, INCP, PROJ + C_VA, INCP, Op, 1024, PO, PML); }
}

constexpr int NPH_L = 16;
__global__ void __launch_bounds__(NTHR, 2) mk(Params p) {
    extern __shared__ __attribute__((aligned(16))) unsigned char lds_raw[];
    Frame F;
    F.lds = (LAS unsigned char*)lds_raw;
    F.tid = threadIdx.x; F.lane = F.tid & 63; F.wave = __builtin_amdgcn_readfirstlane(F.tid >> 6);
    F.G = gridDim.x; { const int bx = blockIdx.x; F.vcu = (F.G % 8 == 0) ? (bx % 8) * (F.G / 8) + bx / 8 : bx; }
    volatile LAS unsigned* MISC = (volatile LAS unsigned*)(F.lds + MISC_OFF);
    if (F.tid < 32) MISC[F.tid] = 0u;
    __syncthreads();
    unsigned char* ws = p.ws;
    unsigned* ctl = (unsigned*)(ws + WS_CTL);
    XcdBarrier bar = xcd_barrier_post(ctl + CW_BAR, MISC + 8);
    const int lo = p.ph_lo, hi = p.ph_hi;
#define IN(k) (lo <= (k) && (k) < hi)
#define SEAM(k) do { if (IN(k) && IN((k) + 1)) xcd_barrier(bar); } while (0)
    bf16_t* WinT = (bf16_t*)(ws + WS_WIN);
    bf16_t* XB = (bf16_t*)(ws + WS_XB);
    bf16_t* PROJ = (bf16_t*)(ws + WS_PROJ);
    bf16_t* WuqT = (bf16_t*)(ws + WS_WUQ); bf16_t* WukvT = (bf16_t*)(ws + WS_WUKV);
    f32x2* CS = (f32x2*)(ws + WS_CS); float* KM = (float*)(ws + WS_KM); unsigned* SEL = (unsigned*)(ws + WS_SEL);
    bf16_t* CQN = (bf16_t*)(ws + WS_CQN); bf16_t* CKVN = (bf16_t*)(ws + WS_CKVN);
    bf16_t* WpaT = (bf16_t*)(ws + WS_WPA); bf16_t* WpbT = (bf16_t*)(ws + WS_WPB); bf16_t* WoutT = (bf16_t*)(ws + WS_WOUT);
    bf16_t* TMP = (bf16_t*)(ws + WS_TMP); bf16_t* MRG = (bf16_t*)(ws + WS_MRG); bf16_t* PRE = (bf16_t*)(ws + WS_PRE); bf16_t* X1B = (bf16_t*)(ws + WS_X1B);
    bf16_t* WrtT = (bf16_t*)(ws + WS_WRT); bf16_t* WsguT = (bf16_t*)(ws + WS_WSGU); bf16_t* WsdT = (bf16_t*)(ws + WS_WSD); bf16_t* WeguT = (bf16_t*)(ws + WS_WEGU); bf16_t* WedT = (bf16_t*)(ws + WS_WED);
    float* LOGITS = (float*)(ws + WS_LOG); bf16_t* HS = (bf16_t*)(ws + WS_HS); bf16_t* SH = (bf16_t*)(ws + WS_SH);
    int* TOPE = (int*)(ws + WS_TOPE); float* TOPW = (float*)(ws + WS_TOPW); int* APOS = (int*)(ws + WS_APOS); int* ROWA = (int*)(ws + WS_ROWA);
    bf16_t* PO = (bf16_t*)(ws + WS_PO); f32x2* PML = (f32x2*)(ws + WS_PML);
    bf16_t* HE = (bf16_t*)(ws + WS_HE); bf16_t* Yb = (bf16_t*)(ws + WS_Y); int* HIST = (int*)(ws + WS_HIST);
    LAS int* t_off = (LAS int*)(F.lds + TAB_OFF); LAS int* t_toff = t_off + 260;
    bf16_t* QB = (bf16_t*)(ws + WS_QB); bf16_t* KB = (bf16_t*)(ws + WS_KB); bf16_t* VB = (bf16_t*)(ws + WS_VB); bf16_t* OAB = (bf16_t*)(ws + WS_OAB);
    const int gw = F.vcu * NWAVES + F.wave, NGW = F.G * NWAVES;

    if (IN(0)) {
        LAS float* scr = (LAS float*)(F.lds + F.wave * 16384);
        constexpr int I_IN = (DM / 64) * (INC / 32);
        for (int it = gw; it < DEPTH * I_IN; it += NGW) { const int l = it / I_IN, r = it % I_IN;
            transpose_item(p.in[1] + (size_t)l * DM * INC, DM, INC, WinT + (size_t)l * SZ_WIN, DM, RowId{}, scr, r, F.lane); }
        { constexpr int I_UQ = (QL / 64) * (768 / 32), I_UKV = (KVL / 64) * (1024 / 32);
          for (int it = gw; it < DEPTH * (I_UQ + I_UKV); it += NGW) { const int l = it / (I_UQ + I_UKV), r = it % (I_UQ + I_UKV);
            if (r < I_UQ) transpose_item(p.in[4] + (size_t)l * QL * 768, QL, 768, WuqT + (size_t)l * SZ_WUQ, QL, RowQ{}, scr, r, F.lane);
            else transpose_item(p.in[6] + (size_t)l * KVL * 1024, KVL, 1024, WukvT + (size_t)l * SZ_WUKV, KVL, RowId{}, scr, r - I_UQ, F.lane); } }
        { constexpr int I_P = (512 / 64) * (DM / 32), I_O = (DM / 64) * (DM / 32), I_ALL = 2 * I_P + I_O;
          for (int it = gw; it < DEPTH * I_ALL; it += NGW) { const int l = it / I_ALL; int r = it % I_ALL;
            if (r < I_P) { transpose_item(p.in[7] + (size_t)l * 512 * DM, 512, DM, WpaT + (size_t)l * 2 * SZ_WP, 1024, RowId{}, scr, r, F.lane); continue; } r -= I_P;
            if (r < I_P) { transpose_item(p.in[8] + (size_t)l * 512 * DM, 512, DM, WpaT + (size_t)l * 2 * SZ_WP + 512, 1024, RowId{}, scr, r, F.lane); continue; } r -= I_P;
            transpose_item(p.in[9] + (size_t)l * DM * DM, DM, DM, WoutT + (size_t)l * SZ_WOUT, DM, RowId{}, scr, r, F.lane); } }
        { constexpr int I_R = (DM / 64) * (NE / 32), I_G = (DM / 64) * (DSH / 32), I_D = (DSH / 64) * (DM / 32), I_ALL = I_R + 2 * I_G + I_D;
          for (int it = gw; it < DEPTH * I_ALL; it += NGW) { const int l = it / I_ALL; int r = it % I_ALL;
            if (r < I_R) { transpose_item(p.in[12] + (size_t)l * DM * NE, DM, NE, WrtT + (size_t)l * SZ_WRT, DM, RowId{}, scr, r, F.lane); continue; } r -= I_R;
            if (r < I_G) { transpose_item(p.in[17] + (size_t)l * DM * DSH, DM, DSH, WsguT + (size_t)l * SZ_WSGU, DM, RowGU{0}, scr, r, F.lane); continue; } r -= I_G;
            if (r < I_G) { transpose_item(p.in[18] + (size_t)l * DM * DSH, DM, DSH, WsguT + (size_t)l * SZ_WSGU, DM, RowGU{128}, scr, r, F.lane); continue; } r -= I_G;
            transpose_item(p.in[19] + (size_t)l * DSH * DM, DSH, DM, WsdT + (size_t)l * SZ_WSD, DSH, RowId{}, scr, r, F.lane); } }
        { constexpr int I_G = (DM / 64) * (DE / 64), I_D = (DE / 64) * (DM / 64), I_E = 2 * I_G + I_D;
          LAS unsigned short* scr16 = (LAS unsigned short*)(F.lds + F.wave * 16384);
          for (int it = gw; it < DEPTH * NE * I_E; it += NGW) { const int le = it / I_E; int r = it % I_E;
            if (r < I_G) { transpose_item64(p.in[14] + (size_t)le * DM * DE, DM, DE, WeguT + (size_t)le * 512 * DM, DM, RowGU{0}, scr16, r, F.lane); continue; } r -= I_G;
            if (r < I_G) { transpose_item64(p.in[15] + (size_t)le * DM * DE, DM, DE, WeguT + (size_t)le * 512 * DM, DM, RowGU{128}, scr16, r, F.lane); continue; } r -= I_G;
            transpose_item64(p.in[16] + (size_t)le * DE * DM, DE, DM, WedT + (size_t)le * DM * DE, DE, RowId{}, scr16, r, F.lane); } }
        for (int i = blockIdx.x * NTHR + F.tid; i < SEQ * 16; i += F.G * NTHR) { const int pos = i >> 4, k = i & 15;
            const float inv = powf(10000.f, -(float)(2 * k) / 32.f), ang = (float)pos * inv; CS[i] = (f32x2){cosf(ang), sinf(ang)}; }
        for (int i = blockIdx.x * NTHR + F.tid; i < DEPTH * 12288; i += F.G * NTHR) { const int l = i / 12288, r = i % 12288;
            *(u32x4*)(WinT + (size_t)l * SZ_WIN + (size_t)INC * DM + (size_t)r * 8) = (u32x4){0u, 0u, 0u, 0u}; }
        for (int i = blockIdx.x * NTHR + F.tid; i < T * DM / 8; i += F.G * NTHR) { const f32x4 a = *(const f32x4*)(p.in[0] + (size_t)i * 8), b = *(const f32x4*)(p.in[0] + (size_t)i * 8 + 4);
            u32x4 w; w.x = pk2(a[0], a[1]); w.y = pk2(a[2], a[3]); w.z = pk2(b[0], b[1]); w.w = pk2(b[2], b[3]); *(u32x4*)(XB + (size_t)i * 8) = w; }
    }
    SEAM(0);

    {
        const int l = 0; const int pb = 1 + l * NPH_L;
        if (IN(pb + 0)) {
            pg8::Gemm g{XB, WinT + (size_t)l * SZ_WIN, T, INCP, DM, DM, DM}; pg8::StaticOrder S; S.init(T, INCP, F.G, (int)blockIdx.x);
            EpiProj E{PROJ, p.in[2] + (size_t)l * 2 * DM};
            pg8::gemm_phase<EpiProj, pg8::StaticOrder, true>(F.lds, g, S, E);
        }
        SEAM(pb + 0);
        if (IN(pb + 1)) prep_phase(F, PROJ, p.in[3] + (size_t)l * QL, p.in[5] + (size_t)l * KVL, CS, CQN, CKVN, KB, KM);
        SEAM(pb + 1);
        if (IN(pb + 2)) {
            mobasel_phase(F, PROJ, KM, SEL);
            { pg8::Gemm g{CKVN, WukvT + (size_t)l * SZ_WUKV, T, 1024, KVL, KVL, KVL}; pg8::StaticOrder S; S.init(T, 1024, F.G, (int)blockIdx.x);
              EpiKV E{KB, VB}; pg8::gemm_phase<EpiKV, pg8::StaticOrder, true>(F.lds, g, S, E); }
            { pg8::Gemm g{CQN, WuqT + (size_t)l * SZ_WUQ, T, 768, QL, QL, QL}; pg8::StaticOrder S; S.init(T, 768, F.G, (int)blockIdx.x);
              EpiQ E{QB, CS}; pg8::gemm_phase<EpiQ, pg8::StaticOrder, true>(F.lds, g, S, E); }
        }
        SEAM(pb + 2);
        if (IN(pb + 3)) {
            mla_phase(F, QB, KB, VB, OAB + 512);
            moba_sel_phase(F, PROJ, SEL, PO, PML);
        }
        SEAM(pb + 3);
        if (IN(pb + 4)) moba_own_phase(F, PROJ, OAB, PO, PML);
        SEAM(pb + 4);
        if (IN(pb + 5)) {
            pg8::Gemm g{OAB, WpaT + (size_t)l * 2 * SZ_WP, T, DM, DM, 1024, 1024}; pg8::StaticOrder S; S.init(T, DM, F.G, (int)blockIdx.x);
            EpiGate2 E{PROJ, MRG}; pg8::gemm_phase<EpiGate2, pg8::StaticOrder, true>(F.lds, g, S, E);
        }
        SEAM(pb + 5);
        if (IN(pb + 6)) {
            pg8::Gemm g{MRG, WoutT + (size_t)l * SZ_WOUT, T, DM, DM, DM, DM}; pg8::StaticOrder S; S.init(T, DM, F.G, (int)blockIdx.x);
            EpiResid E{XB, PRE}; pg8::gemm_phase<EpiResid, pg8::StaticOrder, true>(F.lds, g, S, E);
        }
        SEAM(pb + 6);
        if (IN(pb + 7)) ln_phase(F, PRE, p.in[10] + (size_t)l * DM, p.in[11] + (size_t)l * DM, X1B);
        SEAM(pb + 7);
        if (IN(pb + 8)) {
            { pg8::Gemm g{X1B, WrtT + (size_t)l * SZ_WRT, T, NE, DM, DM, DM}; pg8::StaticOrder S; S.init(T, NE, F.G, (int)blockIdx.x);
              EpiF32 E{LOGITS, NE}; pg8::gemm_phase<EpiF32, pg8::StaticOrder, true>(F.lds, g, S, E); }
            { pg8::Gemm g{X1B, WsguT + (size_t)l * SZ_WSGU, T, 512, DM, DM, DM}; pg8::StaticOrder S; S.init(T, 512, F.G, (int)((blockIdx.x + F.G / 2) % F.G));
              EpiSwiGLU E{HS, DSH}; pg8::gemm_phase<EpiSwiGLU, pg8::StaticOrder, true>(F.lds, g, S, E); }
        }
        SEAM(pb + 8);
        if (IN(pb + 9)) {
            route_phase(F, LOGITS, p.in[13] + (size_t)l * NE, TOPE, TOPW, APOS, HIST, t_off);
            pg8::Gemm g{HS, WsdT + (size_t)l * SZ_WSD, T, DM, DSH, DSH, DSH}; pg8::StaticOrder S; S.init(T, DM, F.G, (int)blockIdx.x);
            EpiBf16 E{SH, DM}; pg8::gemm_phase<EpiBf16, pg8::StaticOrder, true>(F.lds, g, S, E);
        }
        SEAM(pb + 9);
        if (IN(pb + 10)) {
            int tid_ = F.tid; asm volatile("" : "+v"(tid_));
            if (tid_ < 256) { int tot = 0, base = 0; for (int c = 0; c < F.G; ++c) { const int v = HIST[(size_t)c * 256 + tid_]; base += (c < (int)blockIdx.x) ? v : 0; tot += v; }
                t_off[tid_] = tot; t_toff[tid_] = base; if (blockIdx.x == 0) ctl[CW_CNT + l * 256 + tid_] = (unsigned)tot; }
            __syncthreads();
            if (tid_ == 0) { int a = 0; for (int i = 0; i < 256; ++i) { const int c = t_off[i]; t_off[i] = a; a += c; } }
            __syncthreads();
            const int TPW = T / F.G, a0 = (int)blockIdx.x * TPW * TOPK;
            for (int a = a0 + tid_; a < a0 + TPW * TOPK; a += NTHR) { const int e = TOPE[a]; const int row = t_off[e] + t_toff[e] + APOS[a]; *(u32x2*)(ROWA + 2 * (size_t)row) = (u32x2){(unsigned)a, 0u}; APOS[a] = row; }
            __syncthreads();
        }
        SEAM(pb + 10);
        if (IN(pb + 11)) {
            expert_tables(F, ctl + CW_CNT + l * 256, t_off, t_toff);
            pg8::Gemm g{X1B, WeguT + (size_t)l * SZ_WEGU, T, 512, DM, DM, DM};
            ExpertOrder<2, true> S{t_off, t_toff, ROWA, F.G, F.vcu, (size_t)512 * DM * 2};
            EpiSwiGLU E{HE, DE}; pg8::gemm_phase<EpiSwiGLU, ExpertOrder<2, true>, true>(F.lds, g, S, E);
        }
        SEAM(pb + 11);
        if (IN(pb + 12)) {
            expert_tables(F, ctl + CW_CNT + l * 256, t_off, t_toff);
            pg8::Gemm g{HE, WedT + (size_t)l * SZ_WED, NA, DM, DE, DE, DE};
            ExpertOrder<4, false> S{t_off, t_toff, ROWA, F.G, F.vcu, (size_t)DM * DE * 2};
            EpiExpDown E{Yb}; pg8::gemm_phase<EpiExpDown, ExpertOrder<4, false>, true>(F.lds, g, S, E);
        }
        SEAM(pb + 12);
        if (IN(pb + 13)) combine_phase(F, X1B, SH, Yb, APOS, TOPW, p.in[20] + (size_t)l * DM, p.in[21] + (size_t)l * DM, l == DEPTH - 1 ? p.out : (float*)nullptr, l == DEPTH - 1 ? (bf16_t*)nullptr : XB);
        SEAM(pb + 13);
    }

    {
        const int l = 1; const int pb = 1 + l * NPH_L;
        if (IN(pb + 0)) {
            pg8::Gemm g{XB, WinT + (size_t)l * SZ_WIN, T, INCP, DM, DM, DM}; pg8::StaticOrder S; S.init(T, INCP, F.G, (int)blockIdx.x);
            EpiProj E{PROJ, p.in[2] + (size_t)l * 2 * DM};
            pg8::gemm_phase<EpiProj, pg8::StaticOrder, true>(F.lds, g, S, E);
        }
        SEAM(pb + 0);
        if (IN(pb + 1)) prep_phase(F, PROJ, p.in[3] + (size_t)l * QL, p.in[5] + (size_t)l * KVL, CS, CQN, CKVN, KB, KM);
        SEAM(pb + 1);
        if (IN(pb + 2)) {
            mobasel_phase(F, PROJ, KM, SEL);
            { pg8::Gemm g{CKVN, WukvT + (size_t)l * SZ_WUKV, T, 1024, KVL, KVL, KVL}; pg8::StaticOrder S; S.init(T, 1024, F.G, (int)blockIdx.x);
              EpiKV E{KB, VB}; pg8::gemm_phase<EpiKV, pg8::StaticOrder, true>(F.lds, g, S, E); }
            { pg8::Gemm g{CQN, WuqT + (size_t)l * SZ_WUQ, T, 768, QL, QL, QL}; pg8::StaticOrder S; S.init(T, 768, F.G, (int)blockIdx.x);
              EpiQ E{QB, CS}; pg8::gemm_phase<EpiQ, pg8::StaticOrder, true>(F.lds, g, S, E); }
        }
        SEAM(pb + 2);
        if (IN(pb + 3)) {
            mla_phase(F, QB, KB, VB, OAB + 512);
            moba_sel_phase(F, PROJ, SEL, PO, PML);
        }
        SEAM(pb + 3);
        if (IN(pb + 4)) moba_own_phase(F, PROJ, OAB, PO, PML);
        SEAM(pb + 4);
        if (IN(pb + 5)) {
            pg8::Gemm g{OAB, WpaT + (size_t)l * 2 * SZ_WP, T, DM, DM, 1024, 1024}; pg8::StaticOrder S; S.init(T, DM, F.G, (int)blockIdx.x);
            EpiGate2 E{PROJ, MRG}; pg8::gemm_phase<EpiGate2, pg8::StaticOrder, true>(F.lds, g, S, E);
        }
        SEAM(pb + 5);
        if (IN(pb + 6)) {
            pg8::Gemm g{MRG, WoutT + (size_t)l * SZ_WOUT, T, DM, DM, DM, DM}; pg8::StaticOrder S; S.init(T, DM, F.G, (int)blockIdx.x);
            EpiResid E{XB, PRE}; pg8::gemm_phase<EpiResid, pg8::StaticOrder, true>(F.lds, g, S, E);
        }
        SEAM(pb + 6);
        if (IN(pb + 7)) ln_phase(F, PRE, p.in[10] + (size_t)l * DM, p.in[11] + (size_t)l * DM, X1B);
        SEAM(pb + 7);
        if (IN(pb + 8)) {
            { pg8::Gemm g{X1B, WrtT + (size_t)l * SZ_WRT, T, NE, DM, DM, DM}; pg8::StaticOrder S; S.init(T, NE, F.G, (int)blockIdx.x);
              EpiF32 E{LOGITS, NE}; pg8::gemm_phase<EpiF32, pg8::StaticOrder, true>(F.lds, g, S, E); }
            { pg8::Gemm g{X1B, WsguT + (size_t)l * SZ_WSGU, T, 512, DM, DM, DM}; pg8::StaticOrder S; S.init(T, 512, F.G, (int)((blockIdx.x + F.G / 2) % F.G));
              EpiSwiGLU E{HS, DSH}; pg8::gemm_phase<EpiSwiGLU, pg8::StaticOrder, true>(F.lds, g, S, E); }
        }
        SEAM(pb + 8);
        if (IN(pb + 9)) {
            route_phase(F, LOGITS, p.in[13] + (size_t)l * NE, TOPE, TOPW, APOS, HIST, t_off);
            pg8::Gemm g{HS, WsdT + (size_t)l * SZ_WSD, T, DM, DSH, DSH, DSH}; pg8::StaticOrder S; S.init(T, DM, F.G, (int)blockIdx.x);
            EpiBf16 E{SH, DM}; pg8::gemm_phase<EpiBf16, pg8::StaticOrder, true>(F.lds, g, S, E);
        }
        SEAM(pb + 9);
        if (IN(pb + 10)) {
            int tid_ = F.tid; asm volatile("" : "+v"(tid_));
            if (tid_ < 256) { int tot = 0, base = 0; for (int c = 0; c < F.G; ++c) { const int v = HIST[(size_t)c * 256 + tid_]; base += (c < (int)blockIdx.x) ? v : 0; tot += v; }
                t_off[tid_] = tot; t_toff[tid_] = base; if (blockIdx.x == 0) ctl[CW_CNT + l * 256 + tid_] = (unsigned)tot; }
            __syncthreads();
            if (tid_ == 0) { int a = 0; for (int i = 0; i < 256; ++i) { const int c = t_off[i]; t_off[i] = a; a += c; } }
            __syncthreads();
            const int TPW = T / F.G, a0 = (int)blockIdx.x * TPW * TOPK;
            for (int a = a0 + tid_; a < a0 + TPW * TOPK; a += NTHR) { const int e = TOPE[a]; const int row = t_off[e] + t_toff[e] + APOS[a]; *(u32x2*)(ROWA + 2 * (size_t)row) = (u32x2){(unsigned)a, 0u}; APOS[a] = row; }
            __syncthreads();
        }
        SEAM(pb + 10);
        if (IN(pb + 11)) {
            expert_tables(F, ctl + CW_CNT + l * 256, t_off, t_toff);
            pg8::Gemm g{X1B, WeguT + (size_t)l * SZ_WEGU, T, 512, DM, DM, DM};
            ExpertOrder<2, true> S{t_off, t_toff, ROWA, F.G, F.vcu, (size_t)512 * DM * 2};
            EpiSwiGLU E{HE, DE}; pg8::gemm_phase<EpiSwiGLU, ExpertOrder<2, true>, true>(F.lds, g, S, E);
        }
        SEAM(pb + 11);
        if (IN(pb + 12)) {
            expert_tables(F, ctl + CW_CNT + l * 256, t_off, t_toff);
            pg8::Gemm g{HE, WedT + (size_t)l * SZ_WED, NA, DM, DE, DE, DE};
            ExpertOrder<4, false> S{t_off, t_toff, ROWA, F.G, F.vcu, (size_t)DM * DE * 2};
            EpiExpDown E{Yb}; pg8::gemm_phase<EpiExpDown, ExpertOrder<4, false>, true>(F.lds, g, S, E);
        }
        SEAM(pb + 12);
        if (IN(pb + 13)) combine_phase(F, X1B, SH, Yb, APOS, TOPW, p.in[20] + (size_t)l * DM, p.in[21] + (size_t)l * DM, l == DEPTH - 1 ? p.out : (float*)nullptr, l == DEPTH - 1 ? (bf16_t*)nullptr : XB);
        SEAM(pb + 13);
    }

#undef IN
#undef SEAM
}

__global__ void __launch_bounds__(256) cvt_proj(const bf16_t* __restrict__ P, float* proj) {
    const size_t i = (size_t)blockIdx.x * 256 + threadIdx.x;
    const int row = (int)(i / INC), c = (int)(i % INC);
    float v = bf2f(P[(size_t)row * INCP + c]);
    if (c < C_KA) v *= (1.f / QS_A);
    proj[i] = v;
}
__global__ void __launch_bounds__(256) cvt_oab(const bf16_t* __restrict__ OAB, float* oa, float* ob) {
    const size_t i = (size_t)blockIdx.x * 256 + threadIdx.x; const size_t row = i >> 10; const int c = (int)(i & 1023);
    const float v = bf2f(OAB[i]);
    if (c < 512) oa[row * 512 + c] = v; else ob[row * 512 + c - 512] = v;
}
__global__ void __launch_bounds__(256) cvt_x(const float* __restrict__ x, bf16_t* XB) {
    const size_t i = (size_t)blockIdx.x * 256 + threadIdx.x;
    const f32x4 a = *(const f32x4*)(x + i * 8), b = *(const f32x4*)(x + i * 8 + 4);
    u32x4 w; w.x = pk2(a[0], a[1]); w.y = pk2(a[2], a[3]); w.z = pk2(b[0], b[1]); w.w = pk2(b[2], b[3]); *(u32x4*)(XB + i * 8) = w;
}
}
static int g_grid = 0;
static bool fast_setup() {
    if (g_grid) return g_grid > 0;
    int dev = 0, cus = 0, per_cu = 0;
    if (hipGetDevice(&dev) != hipSuccess || hipDeviceGetAttribute(&cus, hipDeviceAttributeMultiprocessorCount, dev) != hipSuccess) { g_grid = -1; return false; }
    if (hipFuncSetAttribute((const void*)fk::mk, hipFuncAttributeMaxDynamicSharedMemorySize, fk::LDS_BYTES) != hipSuccess) { fprintf(stderr, "hipFuncSetAttribute failed\n"); g_grid = -1; return false; }
    if (hipOccupancyMaxActiveBlocksPerMultiprocessor(&per_cu, (const void*)fk::mk, fk::NTHR, fk::LDS_BYTES) != hipSuccess || per_cu < 1) { fprintf(stderr, "occupancy query: %d\n", per_cu); }
    (void)hipGetLastError();
    g_grid = cus;
    if (cus > 1024 || T % cus != 0 || (T / cus) > 64) { fprintf(stderr, "unsupported CU count %d\n", cus); g_grid = -1; return false; }
    return true;
}
static void launch_mk(fk::Params& p, int lo, int hi, hipStream_t stream) {
    p.ph_lo = lo; p.ph_hi = hi;
    hipLaunchKernelGGL(fk::mk, dim3(g_grid), dim3(fk::NTHR), fk::LDS_BYTES, stream, p);
}

extern "C" void kernel_launch(void* const* d_in, const int* in_sizes, int n_in, void* d_out, int out_size, void* d_ws, size_t ws_size, hipStream_t stream) {
    if (!fast_setup()) return;
    if (ws_size < fk::WS_NEED) { fprintf(stderr, "workspace too small: need %zu have %zu\n", (size_t)fk::WS_NEED, ws_size); return; }
    (void)hipMemsetAsync((char*)d_ws + fk::WS_CTL, 0, fk::CTL_BYTES, stream);
    fk::Params P{};
    for (int i = 0; i < 22; ++i) P.in[i] = (const float*)d_in[i];
    P.out = (float*)d_out; P.ws = (unsigned char*)d_ws;
#if MK_ONE_LAUNCH
    launch_mk(P, 0, 1 + DEPTH * fk::NPH_L, stream);
#else
    launch_mk(P, 0, 1, stream);
    for (int l = 0; l < DEPTH; ++l) for (int k = 0; k < 14; ++k) launch_mk(P, 1 + l * fk::NPH_L + k, 2 + l * fk::NPH_L + k, stream);
#endif
}
```

```cpp
#ifndef MK_ONE_LAUNCH
#define MK_ONE_LAUNCH 1
#endif
#include <hip/hip_runtime.h>
#include <cstdint>
#include <cstdio>

constexpr int NB = 2, SEQ = 8192, T = NB * SEQ, DM = 1024, DEPTH = 2;
constexpr int HA = 8, WA = 512, BLK = 256, NBLK = SEQ / BLK;
constexpr int HB = 8, DN = 64, DR = 32, DV = 64, QL = 384, KVL = 256;
constexpr int INC = 3 * WA + QL + KVL + DR + 2 * DM;
constexpr int C_QA = 0, C_KA = 512, C_VA = 1024, C_CQ = 1536, C_CKV = 1920, C_KR = 2176, C_GA = 2208, C_GB = 3232;
constexpr int NE = 256, TOPK = 8, DE = 256, DSH = 256;
constexpr int NA = T * TOPK;
constexpr float ALPHA = 1.4142135623730951f;
constexpr float LN_EPS = 1e-5f, RMS_EPS = 1e-6f;


namespace fk {
#define LAS __attribute__((address_space(3)))
#define GAS __attribute__((address_space(1)))
typedef unsigned short bf16_t;
typedef short bf16x8 __attribute__((ext_vector_type(8)));
typedef float f32x4 __attribute__((ext_vector_type(4)));
typedef float f32x2 __attribute__((ext_vector_type(2)));
typedef float f32x16 __attribute__((ext_vector_type(16)));
typedef unsigned u32x4 __attribute__((ext_vector_type(4)));
typedef unsigned u32x2 __attribute__((ext_vector_type(2)));
constexpr int NWAVES = 8, NTHR = 512;
constexpr int INCP = 4352;
constexpr float LOG2E = 1.4426950408889634f;
constexpr float QS_A = 0.125f * LOG2E;
constexpr float QS_B = 0.10206207261596577f * LOG2E;
#define LDS_WAIT() asm volatile("s_waitcnt lgkmcnt(0)" ::: "memory")
#define VM_WAIT() asm volatile("s_waitcnt vmcnt(0)" ::: "memory")
__device__ __forceinline__ unsigned f2bf(float f) { unsigned u = __builtin_bit_cast(unsigned, f); return (u + 0x7fffu + ((u >> 16) & 1u)) >> 16; }
__device__ __forceinline__ unsigned pk2(float lo, float hi) { return f2bf(lo) | (f2bf(hi) << 16); }
__device__ __forceinline__ float bf2f(unsigned short b) { return __builtin_bit_cast(float, (unsigned)b << 16); }
__device__ __forceinline__ float bflo(unsigned w) { return __builtin_bit_cast(float, w << 16); }
__device__ __forceinline__ float bfhi(unsigned w) { return __builtin_bit_cast(float, w & 0xffff0000u); }
__device__ __forceinline__ float sigmoidf_(float x) { return __builtin_amdgcn_rcpf(1.f + __expf(-x)); }
__device__ __forceinline__ float wave_sum(float v) {
#pragma unroll
    for (int o = 1; o < 64; o <<= 1) v += __shfl_xor(v, o);
    return v;
}

namespace pg8 {
constexpr int BM = 256, BK = 64, HALF = 128, HTB = HALF * BK * 2, STAGE_BYTES = 8 * HTB, NXCD = 8, WGM = 8;
__host__ __device__ __forceinline__ int lds_byte(int r, int c) { const int st = (r >> 4) * 2 + (c >> 5), rr = r & 15, cc = c & 31, ob = rr * 64 + cc * 2; return st * 1024 + (ob ^ (((ob >> 9) & 1) << 5)); }
__host__ __device__ __forceinline__ void stage_rc(int b, int& R, int& C) { const int st = b / 1024, sb = b % 1024, swz = sb ^ (((sb >> 9) & 1) << 5); R = (st >> 1) * 16 + swz / 64; C = (st & 1) * 32 + (swz % 64) / 2; }
__host__ __device__ __forceinline__ int perm32(int rho) { const int n = rho >> 4, i = rho & 15; return 8 * (i >> 2) + 4 * n + (i & 3); }

struct Unit { int pm, pn, e, r0, rend; };
struct Gemm { const bf16_t* A; const bf16_t* Bt; int M, N, K, lda, ldb; };

struct StaticOrder {
    int nM, nN, nwg, G, c;
    __device__ void init(int M, int N, int G_, int c_) { nM = M / BM; nN = N / BM; nwg = nM * nN; G = G_; c = c_; }
    __device__ bool next(int i, Unit& u) const {
        const long L = (long)i * G + c; if (L >= nwg) return false;
        int wgid = (int)L; { const int q = nwg / NXCD, r = nwg % NXCD, xcd = wgid % NXCD, off = wgid / NXCD; wgid = (xcd < r ? xcd * (q + 1) : r * (q + 1) + (xcd - r) * q) + off; }
        const int nig = WGM * nN, gid = wgid / nig, fm = gid * WGM, gsz = (nM - fm) < WGM ? (nM - fm) : WGM;
        u.pm = fm + ((wgid % nig) % gsz); u.pn = (wgid % nig) / gsz; u.e = 0; u.r0 = u.pm * BM; u.rend = u.r0 + BM; return true;
    }
    __device__ __forceinline__ int a_row(const Unit& u, int r) const { return u.pm * BM + r; }
    __device__ __forceinline__ const char* b_ptr(const Gemm& g, const Unit& u) const { return (const char*)g.Bt + (size_t)u.pn * BM * g.ldb * 2; }
};

typedef float f32x2_t_ __attribute__((ext_vector_type(2))); typedef __bf16 bf16x2_t_ __attribute__((ext_vector_type(2)));
__device__ __forceinline__ unsigned cvt_pk_bf16(float lo, float hi) { const f32x2_t_ v = {lo, hi}; const bf16x2_t_ b = __builtin_convertvector(v, bf16x2_t_); return __builtin_bit_cast(unsigned, b); }

template <class Epi, class Sched, bool ALIGN_EPI>
__device__ __forceinline__ void gemm_phase(LAS unsigned char* lds, const Gemm g, const Sched& S, const Epi& E) {
    int tid_ = threadIdx.x; asm volatile("" : "+v"(tid_));
    const int tid = tid_, wid = __builtin_amdgcn_readfirstlane(tid >> 6), lane = tid & 63, wr = wid >> 2, wc = wid & 3, fr = lane & 15, fq = lane >> 4;
    const int K = g.K, nt = K / BK;
    int RA[2]; unsigned CA[2], voffB[2];
#pragma unroll
    for (int i = 0; i < 2; ++i) { int R, C; stage_rc(tid * 16 + i * 8192, R, C); const int Rb = (R & ~31) + perm32(R & 31);
        RA[i] = R; CA[i] = (unsigned)C * 2u; voffB[i] = (unsigned)(Rb * g.ldb + C) * 2u; }
    const unsigned lda2 = (unsigned)g.lda * 2u;
    const size_t hstepB = (size_t)HALF * g.ldb * 2;
    const unsigned ldsw = (unsigned)wid * 1024u;
    const int aoff = lds_byte(wr * 64 + fr, fq * 8), boff = lds_byte(wc * 32 + fr, fq * 8);
    const char* const Abase = (const char*)g.A;
#define PG8_SA(b, h) (((b) * 2 + (h)) * HTB)
#define PG8_SB(b, h) ((4 + (b) * 2 + (h)) * HTB)
#define PG8_STAGE_B(bufoff, gbase) do { _Pragma("unroll") for (int _i = 0; _i < 2; ++_i) \
        __builtin_amdgcn_global_load_lds((const unsigned*)((const char*)(gbase) + voffB[_i]), (LAS unsigned*)(lds + (bufoff) + ldsw + _i * 8192), 16, 0, 0); } while (0)
#define PG8_STAGE_A(bufoff, V0, V1, kb) do { \
        __builtin_amdgcn_global_load_lds((const unsigned*)((Abase + (kb)) + (V0)), (LAS unsigned*)(lds + (bufoff) + ldsw), 16, 0, 0); \
        __builtin_amdgcn_global_load_lds((const unsigned*)((Abase + (kb)) + (V1)), (LAS unsigned*)(lds + (bufoff) + ldsw + 8192), 16, 0, 0); } while (0)
#define PG8_LDA(dst, b, h) do { _Pragma("unroll") for (int m = 0; m < 4; ++m) _Pragma("unroll") for (int k = 0; k < 2; ++k) dst[m][k] = *(const LAS bf16x8*)(lds + PG8_SA(b, h) + aoff + m * 2048 + k * 1024); } while (0)
#define PG8_LDB(dst, b, h) do { _Pragma("unroll") for (int n = 0; n < 2; ++n) _Pragma("unroll") for (int k = 0; k < 2; ++k) dst[n][k] = *(const LAS bf16x8*)(lds + PG8_SB(b, h) + boff + n * 2048 + k * 1024); } while (0)
#define PG8_MMA(ai, bj, At, Bt) do { __builtin_amdgcn_s_setprio(1); _Pragma("unroll") for (int m = 0; m < 4; ++m) _Pragma("unroll") for (int n = 0; n < 2; ++n) _Pragma("unroll") for (int k = 0; k < 2; ++k) \
        acc[ai][bj][m][n] = __builtin_amdgcn_mfma_f32_16x16x32_bf16(Bt[n][k], At[m][k], acc[ai][bj][m][n], 0, 0, 0); __builtin_amdgcn_s_setprio(0); } while (0)
#define PG8_WAIT_V(n) asm volatile("s_waitcnt vmcnt(" #n ")" ::: "memory")
#define PG8_WAIT_L(n) asm volatile("s_waitcnt lgkmcnt(" #n ")" ::: "memory")
#define PG8_BAR __builtin_amdgcn_s_barrier()
#define PG8_SCHED __builtin_amdgcn_sched_barrier(0)
#define PG8_VOFF(V, U) do { V##00 = (unsigned)S.a_row(U, RA[0]) * lda2 + CA[0]; V##01 = (unsigned)S.a_row(U, RA[1]) * lda2 + CA[1]; \
        V##10 = (unsigned)S.a_row(U, HALF + RA[0]) * lda2 + CA[0]; V##11 = (unsigned)S.a_row(U, HALF + RA[1]) * lda2 + CA[1]; } while (0)
    Unit cur, nxt; int ui = 0;
    if (!S.next(0, cur)) return;
    f32x4 acc[2][2][4][2];
#pragma unroll
    for (int a = 0; a < 2; ++a)
#pragma unroll
        for (int b = 0; b < 2; ++b)
#pragma unroll
            for (int m = 0; m < 4; ++m)
#pragma unroll
                for (int n = 0; n < 2; ++n) acc[a][b][m][n] = (f32x4){0.f, 0.f, 0.f, 0.f};
    bf16x8 At[4][2], B0[2][2], B1[2][2];
    unsigned vc00, vc01, vc10, vc11;
    PG8_VOFF(vc, cur);
    const char* cB = S.b_ptr(g, cur);
    PG8_STAGE_B(PG8_SB(0, 0), cB); PG8_STAGE_B(PG8_SB(0, 1), cB + hstepB); PG8_STAGE_A(PG8_SA(0, 0), vc00, vc01, 0u); PG8_STAGE_A(PG8_SA(0, 1), vc10, vc11, 0u);
    if (wr == 1) PG8_BAR;
    PG8_WAIT_V(2); PG8_BAR;
    PG8_STAGE_B(PG8_SB(1, 0), cB + 128); PG8_STAGE_A(PG8_SA(1, 0), vc00, vc01, 128u); PG8_STAGE_B(PG8_SB(1, 1), cB + hstepB + 128);
    PG8_WAIT_V(6); PG8_BAR;
    for (;;) {
        const bool has_next = S.next(ui + 1, nxt);
        const char* nB = has_next ? S.b_ptr(g, nxt) : cB;
        unsigned vn00 = vc00, vn01 = vc01, vn10 = vc10, vn11 = vc11;
        if (has_next) { PG8_VOFF(vn, nxt); }
        const bool half1 = (cur.rend - cur.r0) > HALF;
#pragma unroll 1
        for (int t = 0; t < nt; t += 2) {
            if constexpr (Epi::MIDK > 0) { if (t == Epi::MIDK) E.mid(acc, cur, wr, wc, fr, fq); }
            const bool last = (t == nt - 2);
            const unsigned kb1 = (unsigned)(t + 1) * 128u;
            unsigned kb2 = (unsigned)(t + 2) * 128u;
            unsigned s00 = vc00, s01 = vc01, s10 = vc10, s11 = vc11;
            const char* b2 = cB + (size_t)kb2;
            if (last) { kb2 = 0u; b2 = nB; s00 = vn00; s01 = vn01; s10 = vn10; s11 = vn11; }
            const unsigned kb3 = kb2 + 128u; const char* b3 = b2 + 128;
            PG8_LDB(B0, 0, 0); PG8_LDB(B1, 0, 1); PG8_SCHED; PG8_LDA(At, 0, 0); PG8_STAGE_A(PG8_SA(1, 1), vc10, vc11, kb1);
            PG8_WAIT_V(8); PG8_WAIT_L(0); PG8_BAR; PG8_MMA(0, 0, At, B0); PG8_MMA(0, 1, At, B1); PG8_BAR; PG8_SCHED;
            PG8_LDA(At, 0, 1); PG8_STAGE_B(PG8_SB(0, 0), b2); PG8_STAGE_B(PG8_SB(0, 1), b2 + hstepB); PG8_STAGE_A(PG8_SA(0, 0), s00, s01, kb2);
            PG8_WAIT_V(8); PG8_WAIT_L(0); PG8_BAR; if (half1) { PG8_MMA(1, 0, At, B0); PG8_MMA(1, 1, At, B1); } PG8_BAR; PG8_SCHED;
            PG8_LDB(B0, 1, 0); PG8_LDB(B1, 1, 1); PG8_SCHED; PG8_LDA(At, 1, 0); PG8_STAGE_A(PG8_SA(0, 1), s10, s11, kb2);
            PG8_WAIT_V(8); PG8_WAIT_L(0); PG8_BAR; PG8_MMA(0, 0, At, B0); PG8_MMA(0, 1, At, B1); PG8_BAR; PG8_SCHED;
            PG8_LDA(At, 1, 1); PG8_STAGE_B(PG8_SB(1, 0), b3); PG8_STAGE_B(PG8_SB(1, 1), b3 + hstepB); PG8_STAGE_A(PG8_SA(1, 0), s00, s01, kb3);
            PG8_WAIT_V(8); PG8_WAIT_L(0); PG8_BAR; if (half1) { PG8_MMA(1, 0, At, B0); PG8_MMA(1, 1, At, B1); } PG8_BAR; PG8_SCHED;
        }
        if constexpr (ALIGN_EPI) { if (wr == 0) PG8_BAR; }
        E(acc, cur, wr, wc, fr, fq);
        if (!has_next) break;
#pragma unroll
        for (int a = 0; a < 2; ++a)
#pragma unroll
            for (int b = 0; b < 2; ++b)
#pragma unroll
                for (int m = 0; m < 4; ++m)
#pragma unroll
                    for (int n = 0; n < 2; ++n) acc[a][b][m][n] = (f32x4){0.f, 0.f, 0.f, 0.f};
        cur = nxt; cB = nB; vc00 = vn00; vc01 = vn01; vc10 = vn10; vc11 = vn11; ++ui;
        if constexpr (ALIGN_EPI) { if (wr == 1) PG8_BAR; }
    }
    PG8_WAIT_V(0);
    if constexpr (!ALIGN_EPI) { if (wr == 0) PG8_BAR; }
    PG8_BAR;
#undef PG8_SA
#undef PG8_SB
#undef PG8_STAGE_A
#undef PG8_STAGE_B
#undef PG8_LDA
#undef PG8_LDB
#undef PG8_MMA
#undef PG8_WAIT_V
#undef PG8_WAIT_L
#undef PG8_BAR
#undef PG8_SCHED
#undef PG8_VOFF
}
#define PG8_TILE_BEGIN(acc, wr, wc, fr, fq) \
    _Pragma("unroll") for (int ai = 0; ai < 2; ++ai) _Pragma("unroll") for (int m = 0; m < 4; ++m) _Pragma("unroll") for (int bj = 0; bj < 2; ++bj) { \
        const int trow = ai * 128 + wr * 64 + m * 16 + fr, tcol = bj * 128 + wc * 32 + 8 * fq; f32x4 v0 = acc[ai][bj][m][0], v1 = acc[ai][bj][m][1];
#define PG8_TILE_END }
__device__ __forceinline__ u32x4 pack8(f32x4 v0, f32x4 v1) { u32x4 w; w.x = cvt_pk_bf16(v0[0], v0[1]); w.y = cvt_pk_bf16(v0[2], v0[3]); w.z = cvt_pk_bf16(v1[0], v1[1]); w.w = cvt_pk_bf16(v1[2], v1[3]); return w; }
}

#define XB_TMO      128
#define XB_XCNT(j)  (256  + 64 * (j))
#define XB_XSUB(j)  (1280 + 64 * (j))
#define XB_XGEN(j)  (2304 + 64 * (j))
#define XB_TOP      3328
#define XB_TOPGEN   3392
#define XCD_BAR_WORDS 3456
#define XB_SPIN_CAP (1u << 18)

__device__ __forceinline__ unsigned xb_ld(unsigned* p)              { return __hip_atomic_load(p, __ATOMIC_RELAXED, __HIP_MEMORY_SCOPE_AGENT); }
__device__ __forceinline__ unsigned xb_add(unsigned* p, unsigned v) { return __hip_atomic_fetch_add(p, v, __ATOMIC_RELAXED, __HIP_MEMORY_SCOPE_AGENT); }
__device__ __forceinline__ unsigned xb_xcc_id() { return (unsigned)__builtin_amdgcn_s_getreg((3 << 11) | 20) & 0xFu; }
#define XB_SPIN(cond, bar) do { unsigned _sp = 0; while (cond) { __builtin_amdgcn_s_sleep(1); \
    if ((++_sp & 255u) == 0u) { if (xb_ld(&(bar)[XB_TMO])) break; if (_sp > XB_SPIN_CAP) { atomicAdd(&(bar)[XB_TMO], 1u); break; } } } } while (0)

struct XcdBarrier {
    unsigned* bar; unsigned x;
    volatile LAS unsigned* st;
};

__device__ __forceinline__ XcdBarrier xcd_barrier_post(unsigned* bar, volatile LAS unsigned* st) {
    XcdBarrier b; b.bar = bar; b.x = xb_xcc_id(); b.st = st;
    if (threadIdx.x == 0) (void)xb_add(&bar[XB_XCNT(b.x)], 1u);
    return b;
}
__device__ __forceinline__ void xcd_barrier_complete(unsigned* bar, unsigned x, unsigned& nloc, unsigned& nx) {
    const unsigned G = gridDim.x * gridDim.y * gridDim.z;
    unsigned sum, cnt, mine, sp = 0u;
    for (;;) {
        sum = 0u; cnt = 0u; mine = 0u;
#pragma unroll
        for (unsigned j = 0; j < 16; ++j) { const unsigned c = xb_ld(&bar[XB_XCNT(j)]); sum += c; cnt += (c > 0u) ? 1u : 0u; mine = (j == x) ? c : mine; }
        if (sum == G) break;
        __builtin_amdgcn_s_sleep(1);
        if ((++sp & 255u) == 0u) { if (xb_ld(&bar[XB_TMO])) break; if (sp > XB_SPIN_CAP) { atomicAdd(&bar[XB_TMO], 1u); break; } }
    }
    nloc = mine > 0u ? mine : 1u; nx = cnt > 0u ? cnt : 1u;
}

__device__ __forceinline__ void xcd_barrier(const XcdBarrier& b) {
    asm volatile("s_waitcnt vmcnt(0)" ::: "memory");
    __syncthreads();
    if (threadIdx.x == 0) {
        unsigned* bar = b.bar; asm volatile("" : "+s"(bar));
        __builtin_amdgcn_s_waitcnt(0);
        unsigned nloc = b.st[0], nx = b.st[1];
        if (nloc == 0u) { xcd_barrier_complete(bar, b.x, nloc, nx); b.st[0] = nloc; b.st[1] = nx; }
        const unsigned old = xb_add(&bar[XB_XSUB(b.x)], 1u);
        const unsigned gen = old / nloc;
        if (old + 1u == (gen + 1u) * nloc) {
            __builtin_amdgcn_fence(__ATOMIC_RELEASE, "agent");
            asm volatile("s_waitcnt vmcnt(0)" ::: "memory");
            const unsigned og = xb_add(&bar[XB_TOP], 1u);
            const unsigned tg = og / nx;
            if (og + 1u == (tg + 1u) * nx) xb_add(&bar[XB_TOPGEN], 1u);
            else XB_SPIN(xb_ld(&bar[XB_TOPGEN]) == tg, bar);
            __builtin_amdgcn_fence(__ATOMIC_ACQUIRE, "agent");
            xb_add(&bar[XB_XGEN(b.x)], 1u);
            asm volatile("s_waitcnt vmcnt(0)" ::: "memory");
        } else {
            XB_SPIN(xb_ld(&bar[XB_XGEN(b.x)]) == gen, bar);
            __builtin_amdgcn_fence(__ATOMIC_ACQUIRE, "agent");
            asm volatile("s_waitcnt vmcnt(0)" ::: "memory");
        }
    }
    __syncthreads();
}


struct Params {
    const float* in[22]; float* out; unsigned char* ws;
    int ph_lo, ph_hi;
};
constexpr size_t MiB = 1u << 20;
constexpr size_t WS_CTL = 0, CTL_BYTES = 1 * MiB;
constexpr int CW_BAR = 4096;
constexpr int CW_CNT = 16384;
constexpr size_t WS_WIN = 2 * MiB;
constexpr size_t SZ_WIN = (size_t)INCP * DM;
constexpr size_t SZ_WUQ = (size_t)768 * QL, SZ_WUKV = (size_t)1024 * KVL;
constexpr size_t WS_WUQ = WS_WIN + 2 * SZ_WIN * 2;
constexpr size_t WS_WUKV = WS_WUQ + 2 * SZ_WUQ * 2;
constexpr size_t SZ_WP = (size_t)DM * 512, SZ_WOUT = (size_t)DM * DM;
constexpr size_t WS_WPA = WS_WUKV + 2 * SZ_WUKV * 2;
constexpr size_t WS_WPB = WS_WPA + 2 * SZ_WP * 2;
constexpr size_t WS_WOUT = WS_WPB + 2 * SZ_WP * 2;
constexpr size_t SZ_WRT = (size_t)NE * DM, SZ_WSGU = (size_t)512 * DM, SZ_WSD = (size_t)DM * DSH;
constexpr size_t WS_WRT = WS_WOUT + 2 * SZ_WOUT * 2;
constexpr size_t WS_WSGU = WS_WRT + 2 * SZ_WRT * 2;
constexpr size_t WS_WSD = WS_WSGU + 2 * SZ_WSGU * 2;
constexpr size_t WS_CS = WS_WSD + 2 * SZ_WSD * 2;
constexpr size_t WS_KM = WS_CS + (size_t)SEQ * 16 * 8;
constexpr size_t WS_SEL = WS_KM + (size_t)NB * HA * NBLK * 64 * 4;
constexpr size_t WS_XB = WS_SEL + (size_t)T * 8 * 4;
constexpr size_t WS_CQN = WS_XB + (size_t)T * DM * 2;
constexpr size_t WS_CKVN = WS_CQN + (size_t)T * QL * 2;
constexpr size_t WS_QB = WS_CKVN + (size_t)T * KVL * 2;
constexpr size_t WS_KB = WS_QB + (size_t)T * 768 * 2;
constexpr size_t WS_VB = WS_KB + (size_t)T * 768 * 2;
constexpr size_t WS_OAB = WS_VB + (size_t)T * 512 * 2;
constexpr size_t WS_TMP = WS_OAB + (size_t)T * 1024 * 2;
constexpr size_t WS_MRG = WS_TMP + (size_t)T * 1024 * 2;
constexpr size_t WS_PRE = WS_MRG + (size_t)T * 1024 * 2;
constexpr size_t WS_X1 = WS_PRE + (size_t)T * 1024 * 4;
constexpr size_t WS_X1B = WS_X1 + (size_t)T * 1024 * 4;
constexpr size_t WS_X2 = WS_X1B + (size_t)T * 1024 * 2;
constexpr size_t WS_LOG = WS_X2 + (size_t)T * 1024 * 4;
constexpr size_t WS_HS = WS_LOG + (size_t)T * NE * 4;
constexpr size_t WS_SH = WS_HS + (size_t)T * DSH * 2;
constexpr size_t WS_TOPE = WS_SH + (size_t)T * DM * 2;
constexpr size_t WS_TOPW = WS_TOPE + (size_t)NA * 4;
constexpr size_t WS_APOS = WS_TOPW + (size_t)NA * 4;
constexpr size_t WS_ROWA = WS_APOS + (size_t)NA * 4;
constexpr size_t WS_HIST = WS_ROWA + (size_t)NA * 8;
constexpr size_t WS_PO = WS_HIST + (size_t)1024 * 256 * 4;
constexpr size_t WS_PML = WS_PO + (size_t)T * 8 * 3 * 64 * 2;
constexpr size_t WS_HE = WS_PML + (size_t)T * 8 * 3 * 128;
constexpr size_t WS_Y = WS_HE + (size_t)NA * DE * 2;
constexpr size_t WS_PROJ = WS_Y + (size_t)NA * DM * 2;
constexpr size_t SZ_WEGU = (size_t)NE * 512 * DM, SZ_WED = (size_t)NE * DM * DE;
constexpr size_t WS_WEGU = WS_PROJ + (size_t)T * INCP * 2;
constexpr size_t WS_WED = WS_WEGU + 2 * SZ_WEGU * 2;
constexpr size_t WS_FAST_END = WS_WED + 2 * SZ_WED * 2;
constexpr size_t WS_NEED = WS_FAST_END;
static_assert(WS_NEED <= (size_t)2040 * MiB, "ws map");

constexpr int LDS_BYTES = 147456;
constexpr int RING_BYTES = 131072, MISC_OFF = RING_BYTES + 1024, TAB_OFF = RING_BYTES + 2048;

struct Frame { LAS unsigned char* lds; int tid, lane, wave, G, vcu; };

template <class RowMap>
__device__ __forceinline__ void transpose_item(const float* W, int K, int N, bf16_t* WT, int ldk, RowMap rm, LAS float* scr, int item, int lane) {
    const int nblk = N / 32, kb = item / nblk, nb = item % nblk, k0 = 64 * kb, n0 = 32 * nb;
#pragma unroll 8
    for (int i = 0; i < 32; ++i) { const int kk = 2 * i + (lane >> 5); scr[kk * 33 + (lane & 31)] = W[(size_t)(k0 + kk) * N + n0 + (lane & 31)]; }
    LDS_WAIT(); asm volatile("" ::: "memory");
    const int c = lane & 7;
#pragma unroll
    for (int j = 0; j < 4; ++j) { const int n = (lane >> 3) + 8 * j; const LAS float* s = scr + (8 * c) * 33 + n;
        u32x4 o; o.x = pk2(s[0 * 33], s[1 * 33]); o.y = pk2(s[2 * 33], s[3 * 33]); o.z = pk2(s[4 * 33], s[5 * 33]); o.w = pk2(s[6 * 33], s[7 * 33]);
        *(u32x4*)(WT + (size_t)rm(n0 + n) * ldk + k0 + 8 * c) = o; }
    LDS_WAIT(); asm volatile("" ::: "memory");
}
template <class RowMap>
__device__ __forceinline__ void transpose_item64(const float* W, int K, int N, bf16_t* WT, int ldk, RowMap rm, LAS unsigned short* scr, int item, int lane) {
    const int nblk = N / 64, kb = item / nblk, nb = item % nblk, k0 = 64 * kb, n0 = 64 * nb, r = lane >> 4, c4 = (lane & 15) * 4;
    f32x4 v[16];
#pragma unroll
    for (int i = 0; i < 16; ++i) v[i] = __builtin_nontemporal_load((const f32x4*)(W + (size_t)(k0 + 4 * i + r) * N + n0 + c4));
#pragma unroll
    for (int i = 0; i < 16; ++i) { LAS unsigned* d = (LAS unsigned*)(scr + (4 * i + r) * 66 + c4); d[0] = pk2(v[i][0], v[i][1]); d[1] = pk2(v[i][2], v[i][3]); }
    LDS_WAIT(); asm volatile("" ::: "memory");
    const int c = lane & 7;
#pragma unroll
    for (int j = 0; j < 8; ++j) { const int n = (lane >> 3) + 8 * j; const LAS unsigned short* q = scr + (8 * c) * 66 + n;
        u32x4 o; o.x = (unsigned)q[0] | ((unsigned)q[66] << 16); o.y = (unsigned)q[2 * 66] | ((unsigned)q[3 * 66] << 16); o.z = (unsigned)q[4 * 66] | ((unsigned)q[5 * 66] << 16); o.w = (unsigned)q[6 * 66] | ((unsigned)q[7 * 66] << 16);
        *(u32x4*)(WT + (size_t)rm(n0 + n) * ldk + k0 + 8 * c) = o; }
    LDS_WAIT(); asm volatile("" ::: "memory");
}
struct RowId { __device__ __forceinline__ int operator()(int n) const { return n; } };

struct EpiProj {
    static constexpr int MIDK = 0;
    bf16_t* O; const float* bg;
    __device__ __forceinline__ void operator()(const f32x4 (&acc)[2][2][4][2], const pg8::Unit& u, int wr, int wc, int fr, int fq) const {
        PG8_TILE_BEGIN(acc, wr, wc, fr, fq)
            const int row = u.pm * 256 + trow, col = u.pn * 256 + tcol;
            if (col < C_KA) { v0 = v0 * QS_A; v1 = v1 * QS_A; }
            else if (col >= C_GA && col < INC) { const f32x4 b0 = *(const f32x4*)(bg + col - C_GA), b1 = *(const f32x4*)(bg + col - C_GA + 4);
#pragma unroll
                for (int i = 0; i < 4; ++i) { v0[i] = sigmoidf_(v0[i] + b0[i]); v1[i] = sigmoidf_(v1[i] + b1[i]); } }
            *(u32x4*)(O + (size_t)row * INCP + col) = pg8::pack8(v0, v1);
        PG8_TILE_END
    }
};

struct RowQ { __device__ __forceinline__ int operator()(int n) const { const int h = n / 96, d = n % 96; if (d < 64) return n; const int i = d - 64; return h * 96 + 64 + (i < 16 ? 2 * i : 2 * (i - 16) + 1); } };

struct EpiQ {
    static constexpr int MIDK = 0;
    bf16_t* O; const f32x2* CS;
    __device__ __forceinline__ void operator()(const f32x4 (&acc)[2][2][4][2], const pg8::Unit& u, int wr, int wc, int fr, int fq) const {
        PG8_TILE_BEGIN(acc, wr, wc, fr, fq)
            const int row = u.pm * 256 + trow, col = u.pn * 256 + tcol, d = col % 96;
            if (d >= 64) { const int pos = row % SEQ, i0 = (d - 64) >> 1; const f32x2* cs = CS + (size_t)pos * 16 + i0;
                const f32x2 c0 = cs[0], c1 = cs[1], c2 = cs[2], c3 = cs[3];
                const f32x4 a = v0, b = v1;
                v0[0] = a[0] * c0[0] - a[1] * c0[1]; v0[1] = a[1] * c0[0] + a[0] * c0[1]; v0[2] = a[2] * c1[0] - a[3] * c1[1]; v0[3] = a[3] * c1[0] + a[2] * c1[1];
                v1[0] = b[0] * c2[0] - b[1] * c2[1]; v1[1] = b[1] * c2[0] + b[0] * c2[1]; v1[2] = b[2] * c3[0] - b[3] * c3[1]; v1[3] = b[3] * c3[0] + b[2] * c3[1]; }
            v0 = v0 * QS_B; v1 = v1 * QS_B;
            *(u32x4*)(O + (size_t)row * 768 + col) = pg8::pack8(v0, v1);
        PG8_TILE_END
    }
};
struct EpiKV {
    static constexpr int MIDK = 0;
    bf16_t* KB; bf16_t* VB;
    __device__ __forceinline__ void operator()(const f32x4 (&acc)[2][2][4][2], const pg8::Unit& u, int wr, int wc, int fr, int fq) const {
        PG8_TILE_BEGIN(acc, wr, wc, fr, fq)
            const int row = u.pm * 256 + trow, col = u.pn * 256 + tcol, h = col >> 7, j = col & 127;
            bf16_t* dst = (j < 64) ? KB + (size_t)row * 768 + h * 96 + j : VB + (size_t)row * 512 + h * 64 + (j - 64);
            *(u32x4*)dst = pg8::pack8(v0, v1);
        PG8_TILE_END
    }
};

__device__ __forceinline__ void prep_phase(const Frame& F, const bf16_t* PROJ, const float* qn, const float* kvn, const f32x2* CS, bf16_t* CQN, bf16_t* CKVN, bf16_t* KB, float* KM) {
    int lane_ = F.lane; asm volatile("" : "+v"(lane_));
    const int gw = F.vcu * NWAVES + F.wave, NGW = F.G * NWAVES, lane = lane_;
    for (int row = gw; row < T; row += NGW) {
        const bf16_t* p = PROJ + (size_t)row * INCP;
        u32x4 a = (u32x4){0u, 0u, 0u, 0u}, b = (u32x4){0u, 0u, 0u, 0u};
        if (lane < 48) a = *(const u32x4*)(p + C_CQ + lane * 8);
        if (lane < 32) b = *(const u32x4*)(p + C_CKV + lane * 8);
        float sq = 0.f, sk = 0.f;
#pragma unroll
        for (int i = 0; i < 4; ++i) { const float x = bflo(a[i]), y = bfhi(a[i]), z = bflo(b[i]), w = bfhi(b[i]); sq += x * x + y * y; sk += z * z + w * w; }
        sq = wave_sum(sq); sk = wave_sum(sk);
        const float rq = rsqrtf(sq * (1.f / QL) + RMS_EPS), rk = rsqrtf(sk * (1.f / KVL) + RMS_EPS);
        if (lane < 48) { const f32x4 g0 = *(const f32x4*)(qn + lane * 8), g1 = *(const f32x4*)(qn + lane * 8 + 4); u32x4 o;
            o.x = pk2(bflo(a.x) * rq * g0[0], bfhi(a.x) * rq * g0[1]); o.y = pk2(bflo(a.y) * rq * g0[2], bfhi(a.y) * rq * g0[3]);
            o.z = pk2(bflo(a.z) * rq * g1[0], bfhi(a.z) * rq * g1[1]); o.w = pk2(bflo(a.w) * rq * g1[2], bfhi(a.w) * rq * g1[3]);
            *(u32x4*)(CQN + (size_t)row * QL + lane * 8) = o; }
        if (lane < 32) { const f32x4 g0 = *(const f32x4*)(kvn + lane * 8), g1 = *(const f32x4*)(kvn + lane * 8 + 4); u32x4 o;
            o.x = pk2(bflo(b.x) * rk * g0[0], bfhi(b.x) * rk * g0[1]); o.y = pk2(bflo(b.y) * rk * g0[2], bfhi(b.y) * rk * g0[3]);
            o.z = pk2(bflo(b.z) * rk * g1[0], bfhi(b.z) * rk * g1[1]); o.w = pk2(bflo(b.w) * rk * g1[2], bfhi(b.w) * rk * g1[3]);
            *(u32x4*)(CKVN + (size_t)row * KVL + lane * 8) = o; }
        if (lane < 16) { const float x1 = bf2f(p[C_KR + lane]), x2 = bf2f(p[C_KR + 16 + lane]); const f32x2 cs = CS[(size_t)(row % SEQ) * 16 + lane];
            const unsigned w = pk2(x1 * cs[0] - x2 * cs[1], x2 * cs[0] + x1 * cs[1]);
#pragma unroll
            for (int h = 0; h < 8; ++h) *(unsigned*)(KB + (size_t)row * 768 + h * 96 + 64 + 2 * lane) = w; }
    }
    for (int it = gw; it < NB * NBLK * HA; it += NGW) {
        const int h = it % HA, blk = (it / HA) % NBLK, b = it / (HA * NBLK), c = lane & 7, r0 = lane >> 3;
        const bf16_t* p = PROJ + ((size_t)b * SEQ + (size_t)blk * BLK + r0) * INCP + C_KA + h * 64 + c * 8;
        float s[8];
#pragma unroll
        for (int i = 0; i < 8; ++i) s[i] = 0.f;
        for (int i = 0; i < 32; ++i) { const u32x4 v = *(const u32x4*)(p + (size_t)i * 8 * INCP);
#pragma unroll
            for (int k = 0; k < 4; ++k) { s[2 * k] += bflo(v[k]); s[2 * k + 1] += bfhi(v[k]); } }
#pragma unroll
        for (int i = 0; i < 8; ++i) { s[i] += __shfl_xor(s[i], 8); s[i] += __shfl_xor(s[i], 16); s[i] += __shfl_xor(s[i], 32); }
        if (lane < 8) { float* o = KM + ((size_t)(b * HA + h) * NBLK + blk) * 64 + c * 8;
            *(f32x4*)o = (f32x4){s[0], s[1], s[2], s[3]} * (1.f / BLK); *(f32x4*)(o + 4) = (f32x4){s[4], s[5], s[6], s[7]} * (1.f / BLK); }
    }
}
__device__ __forceinline__ void mobasel_phase(const Frame& F, const bf16_t* PROJ, const float* KM, unsigned* SEL) {
    int tid_ = F.tid; asm volatile("" : "+v"(tid_));
    const int TPW = T / F.G, row0 = (int)blockIdx.x * TPW, b = row0 / SEQ, own = (row0 % SEQ) / BLK, hs = own * 64 + 4;
    LAS float* km = (LAS float*)F.lds;
    for (int i = tid_; i < 8 * own * 16; i += NTHR) { const int h = i / (own * 16), r = i % (own * 16);
        *(LAS f32x4*)(km + h * hs + r * 4) = *(const f32x4*)(KM + ((size_t)(b * HA + h) * NBLK) * 64 + r * 4); }
    __syncthreads();
    for (int idx = tid_; idx < TPW * 8; idx += NTHR) {
        const int h = idx & 7, row = row0 + (idx >> 3);
        const bf16_t* qp = PROJ + (size_t)row * INCP + C_QA + h * 64;
        float q[64];
#pragma unroll
        for (int i = 0; i < 8; ++i) { const u32x4 v = *(const u32x4*)(qp + i * 8);
#pragma unroll
            for (int k = 0; k < 4; ++k) { q[i * 8 + 2 * k] = bflo(v[k]); q[i * 8 + 2 * k + 1] = bfhi(v[k]); } }
        float v1 = -INFINITY, v2 = -INFINITY, v3 = -INFINITY; int i1 = -1, i2 = -1, i3 = -1;
        for (int j = 0; j < own; ++j) {
            const LAS f32x4* kp = (const LAS f32x4*)(km + h * hs + j * 64);
            float g0 = 0.f, g1 = 0.f, g2 = 0.f, g3 = 0.f;
#pragma unroll
            for (int c = 0; c < 16; ++c) { const f32x4 k4 = kp[c]; g0 = fmaf(q[4 * c], k4[0], g0); g1 = fmaf(q[4 * c + 1], k4[1], g1); g2 = fmaf(q[4 * c + 2], k4[2], g2); g3 = fmaf(q[4 * c + 3], k4[3], g3); }
            const float g = (g0 + g1) + (g2 + g3);
            if (g > v1) { v3 = v2; i3 = i2; v2 = v1; i2 = i1; v1 = g; i1 = j; }
            else if (g > v2) { v3 = v2; i3 = i2; v2 = g; i2 = j; }
            else if (g > v3) { v3 = g; i3 = j; }
        }
        unsigned m = 0;
        if (i1 >= 0) m |= 1u << i1;
        if (i2 >= 0) m |= 1u << i2;
        if (i3 >= 0) m |= 1u << i3;
        SEL[(size_t)row * 8 + h] = m;
    }
    __syncthreads();
}

struct EpiGate2 {
    static constexpr int MIDK = 8;
    const bf16_t* PROJ; bf16_t* MRG;
    __device__ __forceinline__ void mid(f32x4 (&acc)[2][2][4][2], const pg8::Unit& u, int wr, int wc, int fr_, int fq) const {
        int fr = fr_; asm volatile("" : "+v"(fr));
#pragma unroll
        for (int ai = 0; ai < 2; ++ai)
#pragma unroll
            for (int m = 0; m < 4; ++m)
#pragma unroll
                for (int bj = 0; bj < 2; ++bj) { const size_t o = (size_t)(u.pm * 256 + ai * 128 + wr * 64 + m * 16 + fr) * INCP + u.pn * 256 + bj * 128 + wc * 32 + 8 * fq;
                    const u32x4 ga = *(const u32x4*)(PROJ + o + C_GA), gb = *(const u32x4*)(PROJ + o + C_GB);
#pragma unroll
                    for (int i = 0; i < 4; ++i) { const float r0 = bflo(ga[i]) * __builtin_amdgcn_rcpf(bflo(gb[i])), r1 = bfhi(ga[i]) * __builtin_amdgcn_rcpf(bfhi(gb[i]));
                        acc[ai][bj][m][i >> 1][2 * (i & 1)] *= r0; acc[ai][bj][m][i >> 1][2 * (i & 1) + 1] *= r1; }
                    __builtin_amdgcn_sched_barrier(0); }
    }
    __device__ __forceinline__ void operator()(const f32x4 (&acc)[2][2][4][2], const pg8::Unit& u, int wr, int wc, int fr, int fq) const {
        PG8_TILE_BEGIN(acc, wr, wc, fr, fq)
            const int row = u.pm * 256 + trow, col = u.pn * 256 + tcol;
            const u32x4 g = *(const u32x4*)(PROJ + (size_t)row * INCP + C_GB + col);
            v0[0] *= bflo(g.x); v0[1] *= bfhi(g.x); v0[2] *= bflo(g.y); v0[3] *= bfhi(g.y); v1[0] *= bflo(g.z); v1[1] *= bfhi(g.z); v1[2] *= bflo(g.w); v1[3] *= bfhi(g.w);
            *(u32x4*)(MRG + (size_t)row * DM + col) = pg8::pack8(v0, v1);
        PG8_TILE_END
    }
};
struct EpiResid {
    static constexpr int MIDK = 0;
    const bf16_t* X; bf16_t* PRE;
    __device__ __forceinline__ void operator()(const f32x4 (&acc)[2][2][4][2], const pg8::Unit& u, int wr, int wc, int fr, int fq) const {
        PG8_TILE_BEGIN(acc, wr, wc, fr, fq)
            const size_t o = (size_t)(u.pm * 256 + trow) * DM + u.pn * 256 + tcol;
            const u32x4 x = *(const u32x4*)(X + o);
            v0[0] += ALPHA * bflo(x.x); v0[1] += ALPHA * bfhi(x.x); v0[2] += ALPHA * bflo(x.y); v0[3] += ALPHA * bfhi(x.y);
            v1[0] += ALPHA * bflo(x.z); v1[1] += ALPHA * bfhi(x.z); v1[2] += ALPHA * bflo(x.w); v1[3] += ALPHA * bfhi(x.w);
            *(u32x4*)(PRE + o) = pg8::pack8(v0, v1);
        PG8_TILE_END
    }
};
__device__ __forceinline__ void ln_phase(const Frame& F, const bf16_t* PRE, const float* g, const float* bt, bf16_t* XBo) {
    int lane_ = F.lane; asm volatile("" : "+v"(lane_));
    const int gw = F.vcu * NWAVES + F.wave, NGW = F.G * NWAVES, lane = lane_;
    for (int row = gw; row < T; row += NGW) {
        const u32x2* pr = (const u32x2*)(PRE + (size_t)row * DM) + lane;
        f32x4 v[4]; float s = 0.f;
#pragma unroll
        for (int j = 0; j < 4; ++j) { const u32x2 h = pr[64 * j]; v[j] = (f32x4){bflo(h.x), bfhi(h.x), bflo(h.y), bfhi(h.y)}; s += (v[j][0] + v[j][1]) + (v[j][2] + v[j][3]); }
        const float mean = wave_sum(s) * (1.f / DM); float s2 = 0.f;
#pragma unroll
        for (int j = 0; j < 4; ++j) { v[j] = v[j] - mean; s2 += (v[j][0] * v[j][0] + v[j][1] * v[j][1]) + (v[j][2] * v[j][2] + v[j][3] * v[j][3]); }
        const float rstd = rsqrtf(wave_sum(s2) * (1.f / DM) + LN_EPS);
#pragma unroll
        for (int j = 0; j < 4; ++j) { const f32x4 gg = ((const f32x4*)g)[lane + 64 * j], bb = ((const f32x4*)bt)[lane + 64 * j];
            const f32x4 y = v[j] * rstd * gg + bb;
            u32x2 w; w.x = pk2(y[0], y[1]); w.y = pk2(y[2], y[3]); ((u32x2*)(XBo + (size_t)row * DM))[lane + 64 * j] = w; }
    }
}

struct RowGU { int off; __device__ __forceinline__ int operator()(int n) const { return 256 * (n >> 7) + off + (n & 127); } };

struct EpiF32 {
    static constexpr int MIDK = 0;
    float* O; int ld;
    __device__ __forceinline__ void operator()(const f32x4 (&acc)[2][2][4][2], const pg8::Unit& u, int wr, int wc, int fr, int fq) const {
        PG8_TILE_BEGIN(acc, wr, wc, fr, fq)
            float* o = O + (size_t)(u.pm * 256 + trow) * ld + u.pn * 256 + tcol; *(f32x4*)o = v0; *(f32x4*)(o + 4) = v1;
        PG8_TILE_END
    }
};
struct EpiBf16 {
    static constexpr int MIDK = 0;
    bf16_t* O; int ld;
    __device__ __forceinline__ void operator()(const f32x4 (&acc)[2][2][4][2], const pg8::Unit& u, int wr, int wc, int fr, int fq) const {
        PG8_TILE_BEGIN(acc, wr, wc, fr, fq)
            *(u32x4*)(O + (size_t)(u.pm * 256 + trow) * ld + u.pn * 256 + tcol) = pg8::pack8(v0, v1);
        PG8_TILE_END
    }
};
__device__ __forceinline__ float silu_mul(float g, float u) { return g * __builtin_amdgcn_rcpf(1.f + __expf(-g)) * u; }
struct EpiSwiGLU {
    static constexpr int MIDK = 0;
    bf16_t* H; int ld;
    __device__ __forceinline__ void operator()(const f32x4 (&acc)[2][2][4][2], const pg8::Unit& u, int wr, int wc, int fr, int fq) const {
#pragma unroll
        for (int ai = 0; ai < 2; ++ai)
#pragma unroll
            for (int m = 0; m < 4; ++m) { const int row = u.r0 + ai * 128 + wr * 64 + m * 16 + fr;
                if (row < u.rend) { f32x4 h0, h1;
#pragma unroll
                    for (int i = 0; i < 4; ++i) { h0[i] = silu_mul(acc[ai][0][m][0][i], acc[ai][1][m][0][i]); h1[i] = silu_mul(acc[ai][0][m][1][i], acc[ai][1][m][1][i]); }
                    *(u32x4*)(H + (size_t)row * ld + 128 * u.pn + wc * 32 + 8 * fq) = pg8::pack8(h0, h1); } }
    }
};
struct EpiExpDown {
    static constexpr int MIDK = 0;
    bf16_t* Y;
    __device__ __forceinline__ void operator()(const f32x4 (&acc)[2][2][4][2], const pg8::Unit& u, int wr, int wc, int fr, int fq) const {
#pragma unroll
        for (int ai = 0; ai < 2; ++ai)
#pragma unroll
            for (int m = 0; m < 4; ++m) { const int row = u.r0 + ai * 128 + wr * 64 + m * 16 + fr;
                if (row < u.rend) {
#pragma unroll
                    for (int bj = 0; bj < 2; ++bj) *(u32x4*)(Y + (size_t)row * DM + 256 * u.pn + bj * 128 + wc * 32 + 8 * fq) = pg8::pack8(acc[ai][bj][m][0], acc[ai][bj][m][1]); } }
    }
};
template <int NPN, bool GATHER>
struct ExpertOrder {
    const LAS int* off; const LAS int* toff; const int* rowa; int G, c; size_t strideE;
    __device__ __forceinline__ bool next(int i, pg8::Unit& u) const {
        const int L = i * G + c; if (L >= toff[256] * NPN) return false;
        const int tile = L / NPN; u.pn = L % NPN; int lo = 0, hi = 255;
        while (lo < hi) { const int mid = (lo + hi + 1) >> 1; if (toff[mid] <= tile) lo = mid; else hi = mid - 1; }
        u.e = lo; u.r0 = off[lo] + (tile - toff[lo]) * 256; u.rend = off[lo + 1]; u.pm = 0; return true;
    }
    __device__ __forceinline__ int a_row(const pg8::Unit& u, int r) const { const int rr = min(u.r0 + r, u.rend - 1); return GATHER ? (rowa[2 * rr] >> 3) : rr; }
    __device__ __forceinline__ const char* b_ptr(const pg8::Gemm& g, const pg8::Unit& u) const { return (const char*)g.Bt + (size_t)u.e * strideE + (size_t)u.pn * 256 * g.ldb * 2; }
};
__device__ __forceinline__ void expert_tables(const Frame& F, const unsigned* cnt, LAS int* off, LAS int* toff) {
    if (F.tid < 256) { off[F.tid] = (int)cnt[F.tid]; }
    __syncthreads();
    if (F.tid == 0) { int a = 0, b = 0; for (int i = 0; i < 256; ++i) { const int c = off[i]; off[i] = a; toff[i] = b; a += c; b += (c + 255) >> 8; } off[256] = a; toff[256] = b; }
    __syncthreads();
}
__device__ __forceinline__ void route_phase(const Frame& F, const float* LOGITS, const float* rbias, int* TOPE, float* TOPW, int* APOS, int* HIST, LAS int* lcnt) {
    int lane_ = F.lane; asm volatile("" : "+v"(lane_));
    const int lane = lane_, TPW = T / F.G, t0 = (int)blockIdx.x * TPW;
    if (F.tid < 256) lcnt[F.tid] = 0;
    __syncthreads();
    const f32x4 rb = *(const f32x4*)(rbias + lane * 4);
    f32x4 lgn = (t0 + F.wave < t0 + TPW) ? *(const f32x4*)(LOGITS + (size_t)(t0 + F.wave) * NE + lane * 4) : (f32x4){0.f, 0.f, 0.f, 0.f};
#pragma unroll 1
    for (int t = t0 + F.wave; t < t0 + TPW; t += NWAVES) {
        const f32x4 lg = lgn;
        if (t + NWAVES < t0 + TPW) lgn = *(const f32x4*)(LOGITS + (size_t)(t + NWAVES) * NE + lane * 4);
        const float s0 = __builtin_amdgcn_rcpf(1.f + __expf(-lg[0])), s1 = __builtin_amdgcn_rcpf(1.f + __expf(-lg[1])), s2 = __builtin_amdgcn_rcpf(1.f + __expf(-lg[2])), s3 = __builtin_amdgcn_rcpf(1.f + __expf(-lg[3]));
        float c0 = s0 + rb[0], c1 = s1 + rb[1], c2 = s2 + rb[2], c3 = s3 + rb[3];
        float a = fmaxf(c0, c1), bq = fminf(c0, c1);
        { const float hi2 = fmaxf(c2, c3), lo2 = fminf(c2, c3); const float na = fmaxf(a, hi2), nb = fmaxf(fminf(a, hi2), fmaxf(bq, lo2)); a = na; bq = nb; }
#pragma unroll
        for (int o = 1; o < 8; o <<= 1) { const float oa = __shfl_xor(a, o), ob = __shfl_xor(bq, o); const float na = fmaxf(a, oa), nb = fmaxf(fminf(a, oa), fmaxf(bq, ob)); a = na; bq = nb; }
        const float gs = a + bq; const int grp = lane >> 3;
        int rank = 0;
#pragma unroll
        for (int j = 0; j < 8; ++j) { const float og = __shfl(gs, j * 8); rank += (og > gs || (og == gs && j < grp)) ? 1 : 0; }
        if (rank >= 4) { c0 = c1 = c2 = c3 = -INFINITY; }
        float wsum = 0.f, myw = 0.f; int mye = 0;
#pragma unroll
        for (int k = 0; k < TOPK; ++k) {
            float bv = c0; int bi = 0;
            if (c1 > bv) { bv = c1; bi = 1; }
            if (c2 > bv) { bv = c2; bi = 2; }
            if (c3 > bv) { bv = c3; bi = 3; }
            int be = lane * 4 + bi;
#pragma unroll
            for (int o = 1; o < 64; o <<= 1) { const float ov = __shfl_xor(bv, o); const int oe = __shfl_xor(be, o); if (ov > bv || (ov == bv && oe < be)) { bv = ov; be = oe; } }
            float sc = 0.f;
            if ((be >> 2) == lane) { const int b2 = be & 3; sc = b2 == 0 ? s0 : b2 == 1 ? s1 : b2 == 2 ? s2 : s3; if (b2 == 0) c0 = -INFINITY; else if (b2 == 1) c1 = -INFINITY; else if (b2 == 2) c2 = -INFINITY; else c3 = -INFINITY; }
            sc = __shfl(sc, be >> 2);
            wsum += sc;
            if (lane == k) { myw = sc; mye = be; }
        }
        if (lane < TOPK) { const int aidx = t * TOPK + lane; TOPE[aidx] = mye; TOPW[aidx] = myw / wsum * 2.5f; APOS[aidx] = __hip_atomic_fetch_add(lcnt + mye, 1, __ATOMIC_RELAXED, __HIP_MEMORY_SCOPE_WORKGROUP); }
    }
    __syncthreads();
    if (F.tid < 256) HIST[(size_t)blockIdx.x * 256 + F.tid] = lcnt[F.tid];
}
__device__ __forceinline__ void combine_phase(const Frame& F, const bf16_t* X1, const bf16_t* SH, const bf16_t* Y, const int* INV, const float* TOPW, const float* g, const float* bt, float* Xo, bf16_t* XBo) {
    int lane_ = F.lane; asm volatile("" : "+v"(lane_));
    const int gw = F.vcu * NWAVES + F.wave, NGW = F.G * NWAVES, lane = lane_;
    for (int row = gw; row < T; row += NGW) {
        int ri = 0; float rw = 0.f; if (lane < TOPK) { ri = INV[row * TOPK + lane]; rw = TOPW[row * TOPK + lane]; }
        float v[2][8];
#pragma unroll
        for (int j = 0; j < 2; ++j) { const u32x4 x = ((const u32x4*)(X1 + (size_t)row * DM))[lane + 64 * j], h = ((const u32x4*)(SH + (size_t)row * DM))[lane + 64 * j];
#pragma unroll
            for (int i = 0; i < 4; ++i) { v[j][2 * i] = ALPHA * bflo(x[i]) + bflo(h[i]); v[j][2 * i + 1] = ALPHA * bfhi(x[i]) + bfhi(h[i]); } }
#pragma unroll
        for (int k = 0; k < TOPK; ++k) { const u32x4* yr = (const u32x4*)(Y + (size_t)__shfl(ri, k) * DM); const float w = __shfl(rw, k);
#pragma unroll
            for (int j = 0; j < 2; ++j) { const u32x4 h = yr[lane + 64 * j];
#pragma unroll
                for (int i = 0; i < 4; ++i) { v[j][2 * i] = fmaf(w, bflo(h[i]), v[j][2 * i]); v[j][2 * i + 1] = fmaf(w, bfhi(h[i]), v[j][2 * i + 1]); } } }
        float s = 0.f;
#pragma unroll
        for (int j = 0; j < 2; ++j)
#pragma unroll
            for (int i = 0; i < 8; ++i) s += v[j][i];
        const float mean = wave_sum(s) * (1.f / DM); float s2 = 0.f;
#pragma unroll
        for (int j = 0; j < 2; ++j)
#pragma unroll
            for (int i = 0; i < 8; ++i) { v[j][i] -= mean; s2 += v[j][i] * v[j][i]; }
        const float rstd = rsqrtf(wave_sum(s2) * (1.f / DM) + LN_EPS);
#pragma unroll
        for (int j = 0; j < 2; ++j) { const int c0 = 8 * lane + 512 * j;
            const f32x4 g0 = *(const f32x4*)(g + c0), g1 = *(const f32x4*)(g + c0 + 4), b0 = *(const f32x4*)(bt + c0), b1 = *(const f32x4*)(bt + c0 + 4);
            const f32x4 y0 = (f32x4){v[j][0], v[j][1], v[j][2], v[j][3]} * rstd * g0 + b0, y1 = (f32x4){v[j][4], v[j][5], v[j][6], v[j][7]} * rstd * g1 + b1;
            if (Xo) { *(f32x4*)(Xo + (size_t)row * DM + c0) = y0; *(f32x4*)(Xo + (size_t)row * DM + c0 + 4) = y1; }
            if (XBo) { u32x4 w; w.x = pk2(y0[0], y0[1]); w.y = pk2(y0[2], y0[3]); w.z = pk2(y1[0], y1[1]); w.w = pk2(y1[2], y1[3]); *(u32x4*)(XBo + (size_t)row * DM + c0) = w; } }
    }
}

__device__ __forceinline__ int crow(int r, int hi) { return (r & 3) + 8 * (r >> 2) + 4 * hi; }
typedef short s16x4 __attribute__((ext_vector_type(4)));
__device__ __forceinline__ s16x4 vtr(const LAS unsigned char* p) { return __builtin_bit_cast(s16x4, __builtin_amdgcn_ds_read_tr16_b64_v4i16((LAS s16x4*)p)); }
__device__ __forceinline__ float xhalf_max(float v) { auto rr = __builtin_amdgcn_permlane32_swap(__float_as_uint(v), __float_as_uint(v), false, false); return fmaxf(__uint_as_float(rr[0]), __uint_as_float(rr[1])); }
__device__ __forceinline__ float xhalf_sum(float v) { auto rr = __builtin_amdgcn_permlane32_swap(__float_as_uint(v), __float_as_uint(v), false, false); return __uint_as_float(rr[0]) + __uint_as_float(rr[1]); }

template <int DQK, bool ALIBI>
__device__ __forceinline__ void attn_tile(const LAS unsigned char* kb, int kfo, int vfo, const bf16x8 (&qf)[DQK / 16], float& m, float& l, f32x16& o0, f32x16& o1, int hi, int tq, int kpos0, float slope2, bool causal) {
    constexpr int ND0 = DQK / 16;
    bf16x8 ka[ND0], kc[ND0];
#pragma unroll
    for (int d0 = 0; d0 < ND0; ++d0) { ka[d0] = *(const LAS bf16x8*)(kb + kfo + d0 * 2048); kc[d0] = *(const LAS bf16x8*)(kb + kfo + d0 * 2048 + 512); }
    __builtin_amdgcn_sched_barrier(0);
    f32x16 p0, p1;
#pragma unroll
    for (int r = 0; r < 16; ++r) { p0[r] = 0.f; p1[r] = 0.f; }
#pragma unroll
    for (int d0 = 0; d0 < ND0; ++d0) {
        p0 = __builtin_amdgcn_mfma_f32_32x32x16_bf16(ka[d0], qf[d0], p0, 0, 0, 0);
        p1 = __builtin_amdgcn_mfma_f32_32x32x16_bf16(kc[d0], qf[d0], p1, 0, 0, 0);
    }
    s16x4 vlo[8], vhi[8];
    { const unsigned va = (unsigned)(uintptr_t)(kb + vfo);
#pragma unroll
      for (int i = 0; i < 8; ++i) {
        asm volatile("ds_read_b64_tr_b16 %0, %1 offset:%c2" : "=&v"(vlo[i]) : "v"(va), "i"((i >> 2) * 4096 + (i & 3) * 1024) : "memory");
        asm volatile("ds_read_b64_tr_b16 %0, %1 offset:%c2" : "=&v"(vhi[i]) : "v"(va), "i"((i >> 2) * 4096 + (i & 3) * 1024 + 512) : "memory"); } }
    const int krel = kpos0 + 4 * hi - tq;
    if (ALIBI) { const float bb = slope2 * (float)krel;
#pragma unroll
        for (int r = 0; r < 16; ++r) { const float c = (float)((r & 3) + 8 * (r >> 2)); p0[r] += fmaf(slope2, c, bb); p1[r] += fmaf(slope2, c + 32.f, bb); } }
    if (causal) {
#pragma unroll
        for (int r = 0; r < 16; ++r) { const int kv = krel + (r & 3) + 8 * (r >> 2); if (kv > 0) p0[r] = -INFINITY; if (kv + 32 > 0) p1[r] = -INFINITY; } }
    float rm = fmaxf(p0[0], p1[0]);
#pragma unroll
    for (int r = 1; r < 16; ++r) rm = fmaxf(rm, fmaxf(p0[r], p1[r]));
    rm = xhalf_max(rm);
    const float mn = fmaxf(m, rm), alpha = __builtin_amdgcn_exp2f(m - mn);
    m = mn;
    float ls = 0.f;
#pragma unroll
    for (int r = 0; r < 16; ++r) { p0[r] = __builtin_amdgcn_exp2f(p0[r] - mn); p1[r] = __builtin_amdgcn_exp2f(p1[r] - mn); ls += p0[r] + p1[r]; }
    l = l * alpha + ls;
#pragma unroll
    for (int r = 0; r < 16; ++r) { o0[r] *= alpha; o1[r] *= alpha; }
    const u32x4 pw0 = (u32x4){pg8::cvt_pk_bf16(p0[0], p0[1]), pg8::cvt_pk_bf16(p0[2], p0[3]), pg8::cvt_pk_bf16(p0[4], p0[5]), pg8::cvt_pk_bf16(p0[6], p0[7])};
    const u32x4 pw1 = (u32x4){pg8::cvt_pk_bf16(p0[8], p0[9]), pg8::cvt_pk_bf16(p0[10], p0[11]), pg8::cvt_pk_bf16(p0[12], p0[13]), pg8::cvt_pk_bf16(p0[14], p0[15])};
    const u32x4 pw2 = (u32x4){pg8::cvt_pk_bf16(p1[0], p1[1]), pg8::cvt_pk_bf16(p1[2], p1[3]), pg8::cvt_pk_bf16(p1[4], p1[5]), pg8::cvt_pk_bf16(p1[6], p1[7])};
    const u32x4 pw3 = (u32x4){pg8::cvt_pk_bf16(p1[8], p1[9]), pg8::cvt_pk_bf16(p1[10], p1[11]), pg8::cvt_pk_bf16(p1[12], p1[13]), pg8::cvt_pk_bf16(p1[14], p1[15])};
    asm volatile("s_waitcnt lgkmcnt(0)" ::: "memory"); __builtin_amdgcn_sched_barrier(0);
#define ATT_VF(i) (bf16x8){vlo[i][0], vlo[i][1], vlo[i][2], vlo[i][3], vhi[i][0], vhi[i][1], vhi[i][2], vhi[i][3]}
    o0 = __builtin_amdgcn_mfma_f32_32x32x16_bf16(ATT_VF(0), __builtin_bit_cast(bf16x8, pw0), o0, 0, 0, 0);
    o1 = __builtin_amdgcn_mfma_f32_32x32x16_bf16(ATT_VF(4), __builtin_bit_cast(bf16x8, pw0), o1, 0, 0, 0);
    o0 = __builtin_amdgcn_mfma_f32_32x32x16_bf16(ATT_VF(1), __builtin_bit_cast(bf16x8, pw1), o0, 0, 0, 0);
    o1 = __builtin_amdgcn_mfma_f32_32x32x16_bf16(ATT_VF(5), __builtin_bit_cast(bf16x8, pw1), o1, 0, 0, 0);
    o0 = __builtin_amdgcn_mfma_f32_32x32x16_bf16(ATT_VF(2), __builtin_bit_cast(bf16x8, pw2), o0, 0, 0, 0);
    o1 = __builtin_amdgcn_mfma_f32_32x32x16_bf16(ATT_VF(6), __builtin_bit_cast(bf16x8, pw2), o1, 0, 0, 0);
    o0 = __builtin_amdgcn_mfma_f32_32x32x16_bf16(ATT_VF(3), __builtin_bit_cast(bf16x8, pw3), o0, 0, 0, 0);
    o1 = __builtin_amdgcn_mfma_f32_32x32x16_bf16(ATT_VF(7), __builtin_bit_cast(bf16x8, pw3), o1, 0, 0, 0);
#undef ATT_VF
}
#define ATT_ISSUE(t, bo) do { \
        for (int c_ = wid; c_ < NCH; c_ += 8) __builtin_amdgcn_global_load_lds((const unsigned*)(ksrc + (size_t)(t) * 64 * ldk + c_ * 8), (LAS unsigned*)(lds + (bo) + c_ * 1024), 16, 0, 0); \
        __builtin_amdgcn_global_load_lds((const unsigned*)(vsrc + (size_t)(t) * 64 * ldv), (LAS unsigned*)(lds + (bo) + KBYTES + wid * 1024), 16, 0, 0); } while (0)

template <int DQK, bool MOBA_OWN>
__device__ __forceinline__ void attn_unit(LAS unsigned char* lds, int b, int h, int qb, const bf16_t* Qp, int ldq, const bf16_t* Kp, int ldk, const bf16_t* Vp, int ldv, bf16_t* Op, int ldo, const bf16_t* PO, const f32x2* PML) {
    constexpr int NCH = DQK / 8, KBYTES = NCH * 1024, BUFB = KBYTES + 8192, ND0 = DQK / 16;
    int tid_ = threadIdx.x; asm volatile("" : "+v"(tid_));
    const int lane = tid_ & 63, r32 = lane & 31, hi = lane >> 5, wid = __builtin_amdgcn_readfirstlane(tid_ >> 6);
    const size_t rowbase = (size_t)b * SEQ; const int q0 = qb * 256, T0 = MOBA_OWN ? 4 * qb : 0, T1 = 4 * (qb + 1), tq = q0 + wid * 32 + r32;
    const bf16_t* ksrc = Kp + (rowbase + lane) * ldk + h * DQK;
    const bf16_t* vsrc = Vp + (rowbase + 16 * (wid & 3) + (lane >> 2)) * ldv + h * 64 + (wid >> 2) * 32 + (lane & 3) * 8;
    ATT_ISSUE(T0, 0);
    bf16x8 qf[ND0];
    { const bf16_t* qrow = Qp + (rowbase + tq) * ldq + h * DQK + hi * 8;
#pragma unroll
      for (int d0 = 0; d0 < ND0; ++d0) qf[d0] = *(const bf16x8*)(qrow + d0 * 16); }
    const float slope2 = MOBA_OWN ? exp2f(-(float)(h + 1)) * LOG2E : 0.f;
    float m = -1e30f, l = 0.f;
    f32x16 o0, o1;
#pragma unroll
    for (int r = 0; r < 16; ++r) { o0[r] = 0.f; o1[r] = 0.f; }
    const int kfo = hi * 1024 + r32 * 16;
    const int vfo = KBYTES + ((lane >> 4) & 1) * 32 + (lane & 3) * 8 + (4 * hi + ((lane & 15) >> 2)) * 64;
#pragma unroll 1
    for (int t = T0; t < T1; ++t) {
        asm volatile("s_waitcnt vmcnt(0) lgkmcnt(0)\n\ts_barrier" ::: "memory");
        if (t + 1 < T1) ATT_ISSUE(t + 1, ((t + 1) & 1) * BUFB);
        attn_tile<DQK, MOBA_OWN>(lds + (t & 1) * BUFB, kfo, vfo, qf, m, l, o0, o1, hi, tq, 64 * t, slope2, t >= T1 - 4);
    }
    float lt = xhalf_sum(l);
    if (MOBA_OWN) {
        const int nsel = qb < 3 ? qb : 3;
        const size_t pidx = ((rowbase + tq) * 8 + h) * 3;
        float ms[3], ws[3], M = m;
#pragma unroll
        for (int sIdx = 0; sIdx < 3; ++sIdx) { ms[sIdx] = -1e30f; ws[sIdx] = 0.f; if (sIdx < nsel) { const f32x2 ml = PML[(pidx + sIdx) * 16]; ms[sIdx] = ml[0]; ws[sIdx] = ml[1]; M = fmaxf(M, ml[0]); } }
        const float w0 = __builtin_amdgcn_exp2f(m - M);
        lt *= w0;
#pragma unroll
        for (int r = 0; r < 16; ++r) { o0[r] *= w0; o1[r] *= w0; }
#pragma unroll
        for (int sIdx = 0; sIdx < 3; ++sIdx) if (sIdx < nsel) {
            const float w = ws[sIdx] * __builtin_amdgcn_exp2f(ms[sIdx] - M); lt += w;
            const bf16_t* po = PO + (pidx + sIdx) * 64 + 4 * hi;
#pragma unroll
            for (int r4 = 0; r4 < 4; ++r4) { const u32x2 a = *(const u32x2*)(po + 8 * r4), c = *(const u32x2*)(po + 32 + 8 * r4);
                o0[4 * r4] += w * bflo(a.x); o0[4 * r4 + 1] += w * bfhi(a.x); o0[4 * r4 + 2] += w * bflo(a.y); o0[4 * r4 + 3] += w * bfhi(a.y);
                o1[4 * r4] += w * bflo(c.x); o1[4 * r4 + 1] += w * bfhi(c.x); o1[4 * r4 + 2] += w * bflo(c.y); o1[4 * r4 + 3] += w * bfhi(c.y); } }
    }
    const float inv = 1.f / lt;
    bf16_t* orow = Op + (rowbase + tq) * ldo + h * 64 + 4 * hi;
#pragma unroll
    for (int r4 = 0; r4 < 4; ++r4) {
        u32x2 w0_, w1_;
        w0_.x = pg8::cvt_pk_bf16(o0[4 * r4] * inv, o0[4 * r4 + 1] * inv); w0_.y = pg8::cvt_pk_bf16(o0[4 * r4 + 2] * inv, o0[4 * r4 + 3] * inv);
        w1_.x = pg8::cvt_pk_bf16(o1[4 * r4] * inv, o1[4 * r4 + 1] * inv); w1_.y = pg8::cvt_pk_bf16(o1[4 * r4 + 2] * inv, o1[4 * r4 + 3] * inv);
        *(u32x2*)(orow + 8 * r4) = w0_; *(u32x2*)(orow + 32 + 8 * r4) = w1_;
    }
    asm volatile("s_waitcnt lgkmcnt(0)\n\ts_barrier" ::: "memory");
}
__device__ __forceinline__ void moba_sel_unit(LAS unsigned char* lds, int b, int h, int j, int slo, int shi, const bf16_t* Qp, const bf16_t* Kp, const bf16_t* Vp, int ldk, const unsigned* SEL, bf16_t* PO, f32x2* PML) {
    constexpr int DQK = 64, NCH = 8, KBYTES = 8192, BUFB = 16384, ldv = INCP; (void)ldv;
    int tid_ = threadIdx.x; asm volatile("" : "+v"(tid_));
    const int lane = tid_ & 63, r32 = lane & 31, hi = lane >> 5, wid = __builtin_amdgcn_readfirstlane(tid_ >> 6);
    const size_t rowbase = (size_t)b * SEQ;
    const bf16_t* ksrc = Kp + (rowbase + lane) * ldk + h * DQK;
    const bf16_t* vsrc = Vp + (rowbase + 16 * (wid & 3) + (lane >> 2)) * ldk + h * 64 + (wid >> 2) * 32 + (lane & 3) * 8;
#pragma unroll
    for (int tt = 0; tt < 4; ++tt) ATT_ISSUE(4 * j + tt, tt * BUFB);
    LAS unsigned short* list = (LAS unsigned short*)(lds + 4 * BUFB);
    LAS int* cnt = (LAS int*)(lds + 4 * BUFB + 4096);
    if (tid_ == 0) *cnt = 0;
    __syncthreads();
    const int nsrc = (shi - slo) * 256;
    for (int i = tid_; i < nsrc; i += NTHR) {
        const unsigned sm = SEL[(rowbase + (size_t)slo * 256 + i) * 8 + h];
        const bool f = ((sm >> j) & 1u) != 0u;
        const unsigned long long bal = __ballot(f);
        const int rank = __builtin_amdgcn_mbcnt_hi((unsigned)(bal >> 32), __builtin_amdgcn_mbcnt_lo((unsigned)bal, 0u));
        int base = 0;
        if (lane == 0) base = __hip_atomic_fetch_add(cnt, (int)__builtin_popcountll(bal), __ATOMIC_RELAXED, __HIP_MEMORY_SCOPE_WORKGROUP);
        base = __builtin_amdgcn_readfirstlane(base);
        if (f) list[base + rank] = (unsigned short)i;
    }
    asm volatile("s_waitcnt vmcnt(0)" ::: "memory");
    __syncthreads();
    const int n = *cnt, nch = (n + 31) >> 5;
    const float slope2 = exp2f(-(float)(h + 1)) * LOG2E;
    const int kfo = hi * 1024 + r32 * 16;
    const int vfo = KBYTES + ((lane >> 4) & 1) * 32 + (lane & 3) * 8 + (4 * hi + ((lane & 15) >> 2)) * 64;
    for (int ch = wid; ch < nch; ch += 8) {
        const int e = ch * 32 + r32; const bool valid = e < n;
        const int tq = slo * 256 + (int)list[valid ? e : n - 1];
        bf16x8 qf[4];
        { const bf16_t* qrow = Qp + (rowbase + tq) * INCP + h * DQK + hi * 8;
#pragma unroll
          for (int d0 = 0; d0 < 4; ++d0) qf[d0] = *(const bf16x8*)(qrow + d0 * 16); }
        const unsigned sm = SEL[(rowbase + tq) * 8 + h];
        float m = -1e30f, l = 0.f;
        f32x16 o0, o1;
#pragma unroll
        for (int r = 0; r < 16; ++r) { o0[r] = 0.f; o1[r] = 0.f; }
#pragma unroll 1
        for (int tt = 0; tt < 4; ++tt) attn_tile<64, true>(lds + tt * BUFB, kfo, vfo, qf, m, l, o0, o1, hi, tq, 256 * j + 64 * tt, slope2, false);
        const float lt = xhalf_sum(l), inv = 1.f / lt;
        if (valid) {
            const size_t pidx = ((rowbase + tq) * 8 + h) * 3 + __builtin_popcount(sm & ((1u << j) - 1u));
            if (hi == 0) PML[pidx * 16] = (f32x2){m, lt};
            bf16_t* po = PO + pidx * 64 + 4 * hi;
#pragma unroll
            for (int r4 = 0; r4 < 4; ++r4) {
                u32x2 w0_, w1_;
                w0_.x = pg8::cvt_pk_bf16(o0[4 * r4] * inv, o0[4 * r4 + 1] * inv); w0_.y = pg8::cvt_pk_bf16(o0[4 * r4 + 2] * inv, o0[4 * r4 + 3] * inv);
                w1_.x = pg8::cvt_pk_bf16(o1[4 * r4] * inv, o1[4 * r4 + 1] * inv); w1_.y = pg8::cvt_pk_bf16(o1[4 * r4 + 2] * inv, o1[4 * r4 + 3] * inv);
                *(u32x2*)(po + 8 * r4) = w0_; *(u32x2*)(po + 32 + 8 * r4) = w1_;
            }
        }
    }
    __syncthreads();
}
#undef ATT_ISSUE
__device__ __forceinline__ void mla_phase(const Frame& F, const bf16_t* QB, const bf16_t* KB, const bf16_t* VB, bf16_t* Op) {
    for (int u = 2 * F.vcu; u < 512; u += 2 * F.G) {
#pragma unroll 1
        for (int k = 0; k < 2; ++k) { const int uu = u + k, bh = uu >> 5, w = uu & 31, qb = (w & 1) ? (w >> 1) : 31 - (w >> 1);
            attn_unit<96, false>(F.lds, bh >> 3, bh & 7, qb, QB, 768, KB, 768, VB, 512, Op, 1024, nullptr, nullptr); }
    }
}
__device__ __forceinline__ void moba_sel_phase(const Frame& F, const bf16_t* PROJ, const unsigned* SEL, bf16_t* PO, f32x2* PML) {
#pragma unroll 1
    for (int u = (int)blockIdx.x; u < 16 * 136; u += F.G) {
        int p = 0; while (16 * (2 * (p + 1) * (p + 1) + (p + 1)) <= u) ++p;
        const int r = u - 16 * (2 * p * p + p), j = r >> 4, bh = r & 15;
        const int slo = (j + 1 > 4 * p) ? j + 1 : 4 * p, shi = 4 * p + 4;
        moba_sel_unit(F.lds, bh >> 3, bh & 7, j, slo, shi, PROJ + C_QA, PROJ + C_KA, PROJ + C_VA, INCP, SEL, PO, PML);
    }
}
__device__ __forceinline__ void moba_own_phase(const Frame& F, const bf16_t* PROJ, bf16_t* Op, const bf16_t* PO, const f32x2* PML) {
#pragma unroll 1
    for (int u = F.vcu; u < 512; u += F.G) { const int bh = u >> 5, qb = u & 31;
        attn_unit<64, true>(F.lds, bh >> 3, bh & 7, qb, PROJ + C_QA, INCP, PROJ + C_KA, INCP, PROJ + C_VA, INCP, Op, 1024, PO, PML); }
}

constexpr int NPH_L = 16;
__global__ void __launch_bounds__(NTHR, 2) mk(Params p) {
    extern __shared__ __attribute__((aligned(16))) unsigned char lds_raw[];
    Frame F;
    F.lds = (LAS unsigned char*)lds_raw;
    F.tid = threadIdx.x; F.lane = F.tid & 63; F.wave = __builtin_amdgcn_readfirstlane(F.tid >> 6);
    F.G = gridDim.x; { const int bx = blockIdx.x; F.vcu = (F.G % 8 == 0) ? (bx % 8) * (F.G / 8) + bx / 8 : bx; }
    volatile LAS unsigned* MISC = (volatile LAS unsigned*)(F.lds + MISC_OFF);
    if (F.tid < 32) MISC[F.tid] = 0u;
    __syncthreads();
    unsigned char* ws = p.ws;
    unsigned* ctl = (unsigned*)(ws + WS_CTL);
    XcdBarrier bar = xcd_barrier_post(ctl + CW_BAR, MISC + 8);
    const int lo = p.ph_lo, hi = p.ph_hi;
#define IN(k) (lo <= (k) && (k) < hi)
#define SEAM(k) do { if (IN(k) && IN((k) + 1)) xcd_barrier(bar); } while (0)
    bf16_t* WinT = (bf16_t*)(ws + WS_WIN);
    bf16_t* XB = (bf16_t*)(ws + WS_XB);
    bf16_t* PROJ = (bf16_t*)(ws + WS_PROJ);
    bf16_t* WuqT = (bf16_t*)(ws + WS_WUQ); bf16_t* WukvT = (bf16_t*)(ws + WS_WUKV);
    f32x2* CS = (f32x2*)(ws + WS_CS); float* KM = (float*)(ws + WS_KM); unsigned* SEL = (unsigned*)(ws + WS_SEL);
    bf16_t* CQN = (bf16_t*)(ws + WS_CQN); bf16_t* CKVN = (bf16_t*)(ws + WS_CKVN);
    bf16_t* WpaT = (bf16_t*)(ws + WS_WPA); bf16_t* WpbT = (bf16_t*)(ws + WS_WPB); bf16_t* WoutT = (bf16_t*)(ws + WS_WOUT);
    bf16_t* TMP = (bf16_t*)(ws + WS_TMP); bf16_t* MRG = (bf16_t*)(ws + WS_MRG); bf16_t* PRE = (bf16_t*)(ws + WS_PRE); bf16_t* X1B = (bf16_t*)(ws + WS_X1B);
    bf16_t* WrtT = (bf16_t*)(ws + WS_WRT); bf16_t* WsguT = (bf16_t*)(ws + WS_WSGU); bf16_t* WsdT = (bf16_t*)(ws + WS_WSD); bf16_t* WeguT = (bf16_t*)(ws + WS_WEGU); bf16_t* WedT = (bf16_t*)(ws + WS_WED);
    float* LOGITS = (float*)(ws + WS_LOG); bf16_t* HS = (bf16_t*)(ws + WS_HS); bf16_t* SH = (bf16_t*)(ws + WS_SH);
    int* TOPE = (int*)(ws + WS_TOPE); float* TOPW = (float*)(ws + WS_TOPW); int* APOS = (int*)(ws + WS_APOS); int* ROWA = (int*)(ws + WS_ROWA);
    bf16_t* PO = (bf16_t*)(ws + WS_PO); f32x2* PML = (f32x2*)(ws + WS_PML);
    bf16_t* HE = (bf16_t*)(ws + WS_HE); bf16_t* Yb = (bf16_t*)(ws + WS_Y); int* HIST = (int*)(ws + WS_HIST);
    LAS int* t_off = (LAS int*)(F.lds + TAB_OFF); LAS int* t_toff = t_off + 260;
    bf16_t* QB = (bf16_t*)(ws + WS_QB); bf16_t* KB = (bf16_t*)(ws + WS_KB); bf16_t* VB = (bf16_t*)(ws + WS_VB); bf16_t* OAB = (bf16_t*)(ws + WS_OAB);
    const int gw = F.vcu * NWAVES + F.wave, NGW = F.G * NWAVES;

    if (IN(0)) {
        LAS float* scr = (LAS float*)(F.lds + F.wave * 16384);
        constexpr int I_IN = (DM / 64) * (INC / 32);
        for (int it = gw; it < DEPTH * I_IN; it += NGW) { const int l = it / I_IN, r = it % I_IN;
            transpose_item(p.in[1] + (size_t)l * DM * INC, DM, INC, WinT + (size_t)l * SZ_WIN, DM, RowId{}, scr, r, F.lane); }
        { constexpr int I_UQ = (QL / 64) * (768 / 32), I_UKV = (KVL / 64) * (1024 / 32);
          for (int it = gw; it < DEPTH * (I_UQ + I_UKV); it += NGW) { const int l = it / (I_UQ + I_UKV), r = it % (I_UQ + I_UKV);
            if (r < I_UQ) transpose_item(p.in[4] + (size_t)l * QL * 768, QL, 768, WuqT + (size_t)l * SZ_WUQ, QL, RowQ{}, scr, r, F.lane);
            else transpose_item(p.in[6] + (size_t)l * KVL * 1024, KVL, 1024, WukvT + (size_t)l * SZ_WUKV, KVL, RowId{}, scr, r - I_UQ, F.lane); } }
        { constexpr int I_P = (512 / 64) * (DM / 32), I_O = (DM / 64) * (DM / 32), I_ALL = 2 * I_P + I_O;
          for (int it = gw; it < DEPTH * I_ALL; it += NGW) { const int l = it / I_ALL; int r = it % I_ALL;
            if (r < I_P) { transpose_item(p.in[7] + (size_t)l * 512 * DM, 512, DM, WpaT + (size_t)l * 2 * SZ_WP, 1024, RowId{}, scr, r, F.lane); continue; } r -= I_P;
            if (r < I_P) { transpose_item(p.in[8] + (size_t)l * 512 * DM, 512, DM, WpaT + (size_t)l * 2 * SZ_WP + 512, 1024, RowId{}, scr, r, F.lane); continue; } r -= I_P;
            transpose_item(p.in[9] + (size_t)l * DM * DM, DM, DM, WoutT + (size_t)l * SZ_WOUT, DM, RowId{}, scr, r, F.lane); } }
        { constexpr int I_R = (DM / 64) * (NE / 32), I_G = (DM / 64) * (DSH / 32), I_D = (DSH / 64) * (DM / 32), I_ALL = I_R + 2 * I_G + I_D;
          for (int it = gw; it < DEPTH * I_ALL; it += NGW) { const int l = it / I_ALL; int r = it % I_ALL;
            if (r < I_R) { transpose_item(p.in[12] + (size_t)l * DM * NE, DM, NE, WrtT + (size_t)l * SZ_WRT, DM, RowId{}, scr, r, F.lane); continue; } r -= I_R;
            if (r < I_G) { transpose_item(p.in[17] + (size_t)l * DM * DSH, DM, DSH, WsguT + (size_t)l * SZ_WSGU, DM, RowGU{0}, scr, r, F.lane); continue; } r -= I_G;
            if (r < I_G) { transpose_item(p.in[18] + (size_t)l * DM * DSH, DM, DSH, WsguT + (size_t)l * SZ_WSGU, DM, RowGU{128}, scr, r, F.lane); continue; } r -= I_G;
            transpose_item(p.in[19] + (size_t)l * DSH * DM, DSH, DM, WsdT + (size_t)l * SZ_WSD, DSH, RowId{}, scr, r, F.lane); } }
        { constexpr int I_G = (DM / 64) * (DE / 64), I_D = (DE / 64) * (DM / 64), I_E = 2 * I_G + I_D;
          LAS unsigned short* scr16 = (LAS unsigned short*)(F.lds + F.wave * 16384);
          for (int it = gw; it < DEPTH * NE * I_E; it += NGW) { const int le = it / I_E; int r = it % I_E;
            if (r < I_G) { transpose_item64(p.in[14] + (size_t)le * DM * DE, DM, DE, WeguT + (size_t)le * 512 * DM, DM, RowGU{0}, scr16, r, F.lane); continue; } r -= I_G;
            if (r < I_G) { transpose_item64(p.in[15] + (size_t)le * DM * DE, DM, DE, WeguT + (size_t)le * 512 * DM, DM, RowGU{128}, scr16, r, F.lane); continue; } r -= I_G;
            transpose_item64(p.in[16] + (size_t)le * DE * DM, DE, DM, WedT + (size_t)le * DM * DE, DE, RowId{}, scr16, r, F.lane); } }
        for (int i = blockIdx.x * NTHR + F.tid; i < SEQ * 16; i += F.G * NTHR) { const int pos = i >> 4, k = i & 15;
            const float inv = powf(10000.f, -(float)(2 * k) / 32.f), ang = (float)pos * inv; CS[i] = (f32x2){cosf(ang), sinf(ang)}; }
        for (int i = blockIdx.x * NTHR + F.tid; i < DEPTH * 12288; i += F.G * NTHR) { const int l = i / 12288, r = i % 12288;
            *(u32x4*)(WinT + (size_t)l * SZ_WIN + (size_t)INC * DM + (size_t)r * 8) = (u32x4){0u, 0u, 0u, 0u}; }
        for (int i = blockIdx.x * NTHR + F.tid; i < T * DM / 8; i += F.G * NTHR) { const f32x4 a = *(const f32x4*)(p.in[0] + (size_t)i * 8), b = *(const f32x4*)(p.in[0] + (size_t)i * 8 + 4);
            u32x4 w; w.x = pk2(a[0], a[1]); w.y = pk2(a[2], a[3]); w.z = pk2(b[0], b[1]); w.w = pk2(b[2], b[3]); *(u32x4*)(XB + (size_t)i * 8) = w; }
    }
    SEAM(0);

    {
        const int l = 0; const int pb = 1 + l * NPH_L;
        if (IN(pb + 0)) {
            pg8::Gemm g{XB, WinT + (size_t)l * SZ_WIN, T, INCP, DM, DM, DM}; pg8::StaticOrder S; S.init(T, INCP, F.G, (int)blockIdx.x);
            EpiProj E{PROJ, p.in[2] + (size_t)l * 2 * DM};
            pg8::gemm_phase<EpiProj, pg8::StaticOrder, true>(F.lds, g, S, E);
        }
        SEAM(pb + 0);
        if (IN(pb + 1)) prep_phase(F, PROJ, p.in[3] + (size_t)l * QL, p.in[5] + (size_t)l * KVL, CS, CQN, CKVN, KB, KM);
        SEAM(pb + 1);
        if (IN(pb + 2)) {
            mobasel_phase(F, PROJ, KM, SEL);
            { pg8::Gemm g{CKVN, WukvT + (size_t)l * SZ_WUKV, T, 1024, KVL, KVL, KVL}; pg8::StaticOrder S; S.init(T, 1024, F.G, (int)blockIdx.x);
              EpiKV E{KB, VB}; pg8::gemm_phase<EpiKV, pg8::StaticOrder, true>(F.lds, g, S, E); }
            { pg8::Gemm g{CQN, WuqT + (size_t)l * SZ_WUQ, T, 768, QL, QL, QL}; pg8::StaticOrder S; S.init(T, 768, F.G, (int)blockIdx.x);
              EpiQ E{QB, CS}; pg8::gemm_phase<EpiQ, pg8::StaticOrder, true>(F.lds, g, S, E); }
        }
        SEAM(pb + 2);
        if (IN(pb + 3)) {
            mla_phase(F, QB, KB, VB, OAB + 512);
            moba_sel_phase(F, PROJ, SEL, PO, PML);
        }
        SEAM(pb + 3);
        if (IN(pb + 4)) moba_own_phase(F, PROJ, OAB, PO, PML);
        SEAM(pb + 4);
        if (IN(pb + 5)) {
            pg8::Gemm g{OAB, WpaT + (size_t)l * 2 * SZ_WP, T, DM, DM, 1024, 1024}; pg8::StaticOrder S; S.init(T, DM, F.G, (int)blockIdx.x);
            EpiGate2 E{PROJ, MRG}; pg8::gemm_phase<EpiGate2, pg8::StaticOrder, true>(F.lds, g, S, E);
        }
        SEAM(pb + 5);
        if (IN(pb + 6)) {
            pg8::Gemm g{MRG, WoutT + (size_t)l * SZ_WOUT, T, DM, DM, DM, DM}; pg8::StaticOrder S; S.init(T, DM, F.G, (int)blockIdx.x);
            EpiResid E{XB, PRE}; pg8::gemm_phase<EpiResid, pg8::StaticOrder, true>(F.lds, g, S, E);
        }
        SEAM(pb + 6);
        if (IN(pb + 7)) ln_phase(F, PRE, p.in[10] + (size_t)l * DM, p.in[11] + (size_t)l * DM, X1B);
        SEAM(pb + 7);
        if (IN(pb + 8)) {
            { pg8::Gemm g{X1B, WrtT + (size_t)l * SZ_WRT, T, NE, DM, DM, DM}; pg8::StaticOrder S; S.init(T, NE, F.G, (int)blockIdx.x);
              EpiF32 E{LOGITS, NE}; pg8::gemm_phase<EpiF32, pg8::StaticOrder, true>(F.lds, g, S, E); }
            { pg8::Gemm g{X1B, WsguT + (size_t)l * SZ_WSGU, T, 512, DM, DM, DM}; pg8::StaticOrder S; S.init(T, 512, F.G, (int)((blockIdx.x + F.G / 2) % F.G));
              EpiSwiGLU E{HS, DSH}; pg8::gemm_phase<EpiSwiGLU, pg8::StaticOrder, true>(F.lds, g, S, E); }
        }
        SEAM(pb + 8);
        if (IN(pb + 9)) {
            route_phase(F, LOGITS, p.in[13] + (size_t)l * NE, TOPE, TOPW, APOS, HIST, t_off);
            pg8::Gemm g{HS, WsdT + (size_t)l * SZ_WSD, T, DM, DSH, DSH, DSH}; pg8::StaticOrder S; S.init(T, DM, F.G, (int)blockIdx.x);
            EpiBf16 E{SH, DM}; pg8::gemm_phase<EpiBf16, pg8::StaticOrder, true>(F.lds, g, S, E);
        }
        SEAM(pb + 9);
        if (IN(pb + 10)) {
            int tid_ = F.tid; asm volatile("" : "+v"(tid_));
            if (tid_ < 256) { int tot = 0, base = 0; for (int c = 0; c < F.G; ++c) { const int v = HIST[(size_t)c * 256 + tid_]; base += (c < (int)blockIdx.x) ? v : 0; tot += v; }
                t_off[tid_] = tot; t_toff[tid_] = base; if (blockIdx.x == 0) ctl[CW_CNT + l * 256 + tid_] = (unsigned)tot; }
            __syncthreads();
            if (tid_ == 0) { int a = 0; for (int i = 0; i < 256; ++i) { const int c = t_off[i]; t_off[i] = a; a += c; } }
            __syncthreads();
            const int TPW = T / F.G, a0 = (int)blockIdx.x * TPW * TOPK;
            for (int a = a0 + tid_; a < a0 + TPW * TOPK; a += NTHR) { const int e = TOPE[a]; const int row = t_off[e] + t_toff[e] + APOS[a]; *(u32x2*)(ROWA + 2 * (size_t)row) = (u32x2){(unsigned)a, 0u}; APOS[a] = row; }
            __syncthreads();
        }
        SEAM(pb + 10);
        if (IN(pb + 11)) {
            expert_tables(F, ctl + CW_CNT + l * 256, t_off, t_toff);
            pg8::Gemm g{X1B, WeguT + (size_t)l * SZ_WEGU, T, 512, DM, DM, DM};
            ExpertOrder<2, true> S{t_off, t_toff, ROWA, F.G, F.vcu, (size_t)512 * DM * 2};
            EpiSwiGLU E{HE, DE}; pg8::gemm_phase<EpiSwiGLU, ExpertOrder<2, true>, true>(F.lds, g, S, E);
        }
        SEAM(pb + 11);
        if (IN(pb + 12)) {
            expert_tables(F, ctl + CW_CNT + l * 256, t_off, t_toff);
            pg8::Gemm g{HE, WedT + (size_t)l * SZ_WED, NA, DM, DE, DE, DE};
            ExpertOrder<4, false> S{t_off, t_toff, ROWA, F.G, F.vcu, (size_t)DM * DE * 2};
            EpiExpDown E{Yb}; pg8::gemm_phase<EpiExpDown, ExpertOrder<4, false>, true>(F.lds, g, S, E);
        }
        SEAM(pb + 12);
        if (IN(pb + 13)) combine_phase(F, X1B, SH, Yb, APOS, TOPW, p.in[20] + (size_t)l * DM, p.in[21] + (size_t)l * DM, l == DEPTH - 1 ? p.out : (float*)nullptr, l == DEPTH - 1 ? (bf16_t*)nullptr : XB);
        SEAM(pb + 13);
    }

    {
        const int l = 1; const int pb = 1 + l * NPH_L;
        if (IN(pb + 0)) {
            pg8::Gemm g{XB, WinT + (size_t)l * SZ_WIN, T, INCP, DM, DM, DM}; pg8::StaticOrder S; S.init(T, INCP, F.G, (int)blockIdx.x);
            EpiProj E{PROJ, p.in[2] + (size_t)l * 2 * DM};
            pg8::gemm_phase<EpiProj, pg8::StaticOrder, true>(F.lds, g, S, E);
        }
        SEAM(pb + 0);
        if (IN(pb + 1)) prep_phase(F, PROJ, p.in[3] + (size_t)l * QL, p.in[5] + (size_t)l * KVL, CS, CQN, CKVN, KB, KM);
        SEAM(pb + 1);
        if (IN(pb + 2)) {
            mobasel_phase(F, PROJ, KM, SEL);
            { pg8::Gemm g{CKVN, WukvT + (size_t)l * SZ_WUKV, T, 1024, KVL, KVL, KVL}; pg8::StaticOrder S; S.init(T, 1024, F.G, (int)blockIdx.x);
              EpiKV E{KB, VB}; pg8::gemm_phase<EpiKV, pg8::StaticOrder, true>(F.lds, g, S, E); }
            { pg8::Gemm g{CQN, WuqT + (size_t)l * SZ_WUQ, T, 768, QL, QL, QL}; pg8::StaticOrder S; S.init(T, 768, F.G, (int)blockIdx.x);
              EpiQ E{QB, CS}; pg8::gemm_phase<EpiQ, pg8::StaticOrder, true>(F.lds, g, S, E); }
        }
        SEAM(pb + 2);
        if (IN(pb + 3)) {
            mla_phase(F, QB, KB, VB, OAB + 512);
            moba_sel_phase(F, PROJ, SEL, PO, PML);
        }
        SEAM(pb + 3);
        if (IN(pb + 4)) moba_own_phase(F, PROJ, OAB, PO, PML);
        SEAM(pb + 4);
        if (IN(pb + 5)) {
            pg8::Gemm g{OAB, WpaT + (size_t)l * 2 * SZ_WP, T, DM, DM, 1024, 1024}; pg8::StaticOrder S; S.init(T, DM, F.G, (int)blockIdx.x);
            EpiGate2 E{PROJ, MRG}; pg8::gemm_phase<EpiGate2, pg8::StaticOrder, true>(F.lds, g, S, E);
        }
        SEAM(pb + 5);
        if (IN(pb + 6)) {
            pg8::Gemm g{MRG, WoutT + (size_t)l * SZ_WOUT, T, DM, DM, DM, DM}; pg8::StaticOrder S; S.init(T, DM, F.G, (int)blockIdx.x);
            EpiResid E{XB, PRE}; pg8::gemm_phase<EpiResid, pg8::StaticOrder, true>(F.lds, g, S, E);
        }
        SEAM(pb + 6);
        if (IN(pb + 7)) ln_phase(F, PRE, p.in[10] + (size_t)l * DM, p.in[11] + (size_t)l * DM, X1B);
        SEAM(pb + 7);
        if (IN(pb + 8)) {
            { pg8::Gemm g{X1B, WrtT + (size_t)l * SZ_WRT, T, NE, DM, DM, DM}; pg8::StaticOrder S; S.init(T, NE, F.G, (int)blockIdx.x);
              EpiF32 E{LOGITS, NE}; pg8::gemm_phase<EpiF32, pg8::StaticOrder, true>(F.lds, g, S, E); }
            { pg8::Gemm g{X1B, WsguT + (size_t)l * SZ_WSGU, T, 512, DM, DM, DM}; pg8::StaticOrder S; S.init(T, 512, F.G, (int)((blockIdx.x + F.G / 2) % F.G));
              EpiSwiGLU E{HS, DSH}; pg8::gemm_phase<EpiSwiGLU, pg8::StaticOrder, true>(F.lds, g, S, E); }
        }
        SEAM(pb + 8);
        if (IN(pb + 9)) {
            route_phase(F, LOGITS, p.in[13] + (size_t)l * NE, TOPE, TOPW, APOS, HIST, t_off);
            pg8::Gemm g{HS, WsdT + (size_t)l * SZ_WSD, T, DM, DSH, DSH, DSH}; pg8::StaticOrder S; S.init(T, DM, F.G, (int)blockIdx.x);
            EpiBf16 E{SH, DM}; pg8::gemm_phase<EpiBf16, pg8::StaticOrder, true>(F.lds, g, S, E);
        }
        SEAM(pb + 9);
        if (IN(pb + 10)) {
            int tid_ = F.tid; asm volatile("" : "+v"(tid_));
            if (tid_ < 256) { int tot = 0, base = 0; for (int c = 0; c < F.G; ++c) { const int v = HIST[(size_t)c * 256 + tid_]; base += (c < (int)blockIdx.x) ? v : 0; tot += v; }
                t_off[tid_] = tot; t_toff[tid_] = base; if (blockIdx.x == 0) ctl[CW_CNT + l * 256 + tid_] = (unsigned)tot; }
            __syncthreads();
            if (tid_ == 0) { int a = 0; for (int i = 0; i < 256; ++i) { const int c = t_off[i]; t_off[i] = a; a += c; } }
            __syncthreads();
            const int TPW = T / F.G, a0 = (int)blockIdx.x * TPW * TOPK;
            for (int a = a0 + tid_; a < a0 + TPW * TOPK; a += NTHR) { const int e = TOPE[a]; const int row = t_off[e] + t_toff[e] + APOS[a]; *(u32x2*)(ROWA + 2 * (size_t)row) = (u32x2){(unsigned)a, 0u}; APOS[a] = row; }
            __syncthreads();
        }
        SEAM(pb + 10);
        if (IN(pb + 11)) {
            expert_tables(F, ctl + CW_CNT + l * 256, t_off, t_toff);
            pg8::Gemm g{X1B, WeguT + (size_t)l * SZ_WEGU, T, 512, DM, DM, DM};
            ExpertOrder<2, true> S{t_off, t_toff, ROWA, F.G, F.vcu, (size_t)512 * DM * 2};
            EpiSwiGLU E{HE, DE}; pg8::gemm_phase<EpiSwiGLU, ExpertOrder<2, true>, true>(F.lds, g, S, E);
        }
        SEAM(pb + 11);
        if (IN(pb + 12)) {
            expert_tables(F, ctl + CW_CNT + l * 256, t_off, t_toff);
            pg8::Gemm g{HE, WedT + (size_t)l * SZ_WED, NA, DM, DE, DE, DE};
            ExpertOrder<4, false> S{t_off, t_toff, ROWA, F.G, F.vcu, (size_t)DM * DE * 2};
            EpiExpDown E{Yb}; pg8::gemm_phase<EpiExpDown, ExpertOrder<4, false>, true>(F.lds, g, S, E);
        }
        SEAM(pb + 12);
        if (IN(pb + 13)) combine_phase(F, X1B, SH, Yb, APOS, TOPW, p.in[20] + (size_t)l * DM, p.in[21] + (size_t)l * DM, l == DEPTH - 1 ? p.out : (float*)nullptr, l == DEPTH - 1 ? (bf16_t*)nullptr : XB);
        SEAM(pb + 13);
    }

#undef IN
#undef SEAM
}

__global__ void __launch_bounds__(256) cvt_proj(const bf16_t* __restrict__ P, float* proj) {
    const size_t i = (size_t)blockIdx.x * 256 + threadIdx.x;
    const int row = (int)(i / INC), c = (int)(i % INC);
    float v = bf2f(P[(size_t)row * INCP + c]);
    if (c < C_KA) v *= (1.f / QS_A);
    proj[i] = v;
}
__global__ void __launch_bounds__(256) cvt_oab(const bf16_t* __restrict__ OAB, float* oa, float* ob) {
    const size_t i = (size_t)blockIdx.x * 256 + threadIdx.x; const size_t row = i >> 10; const int c = (int)(i & 1023);
    const float v = bf2f(OAB[i]);
    if (c < 512) oa[row * 512 + c] = v; else ob[row * 512 + c - 512] = v;
}
__global__ void __launch_bounds__(256) cvt_x(const float* __restrict__ x, bf16_t* XB) {
    const size_t i = (size_t)blockIdx.x * 256 + threadIdx.x;
    const f32x4 a = *(const f32x4*)(x + i * 8), b = *(const f32x4*)(x + i * 8 + 4);
    u32x4 w; w.x = pk2(a[0], a[1]); w.y = pk2(a[2], a[3]); w.z = pk2(b[0], b[1]); w.w = pk2(b[2], b[3]); *(u32x4*)(XB + i * 8) = w;
}
}
static int g_grid = 0;
static bool fast_setup() {
    if (g_grid) return g_grid > 0;
    int dev = 0, cus = 0, per_cu = 0;
    if (hipGetDevice(&dev) != hipSuccess || hipDeviceGetAttribute(&cus, hipDeviceAttributeMultiprocessorCount, dev) != hipSuccess) { g_grid = -1; return false; }
    if (hipFuncSetAttribute((const void*)fk::mk, hipFuncAttributeMaxDynamicSharedMemorySize, fk::LDS_BYTES) != hipSuccess) { fprintf(stderr, "hipFuncSetAttribute failed\n"); g_grid = -1; return false; }
    if (hipOccupancyMaxActiveBlocksPerMultiprocessor(&per_cu, (const void*)fk::mk, fk::NTHR, fk::LDS_BYTES) != hipSuccess || per_cu < 1) { fprintf(stderr, "occupancy query: %d\n", per_cu); }
    (void)hipGetLastError();
    g_grid = cus;
    if (cus > 1024 || T % cus != 0 || (T / cus) > 64) { fprintf(stderr, "unsupported CU count %d\n", cus); g_grid = -1; return false; }
    return true;
}
static void launch_mk(fk::Params& p, int lo, int hi, hipStream_t stream) {
    p.ph_lo = lo; p.ph_hi = hi;
    hipLaunchKernelGGL(fk::mk, dim3(g_grid), dim3(fk::NTHR), fk::LDS_BYTES, stream, p);
}

extern "C" void kernel_launch(void* const* d_in, const int* in_sizes, int n_in, void* d_out, int out_size, void* d_ws, size_t ws_size, hipStream_t stream) {
    if (!fast_setup()) return;
    if (ws_size < fk::WS_NEED) { fprintf(stderr, "workspace too small: need %zu have %zu\n", (size_t)fk::WS_NEED, ws_size); return; }
    (void)hipMemsetAsync((char*)d_ws + fk::WS_CTL, 0, fk::CTL_BYTES, stream);
    fk::Params P{};
    for (int i = 0; i < 22; ++i) P.in[i] = (const float*)d_in[i];
    P.out = (float*)d_out; P.ws = (unsigned char*)d_ws;
#if MK_ONE_LAUNCH
    launch_mk(P, 0, 1 + DEPTH * fk::NPH_L, stream);
#else
    launch_mk(P, 0, 1, stream);
    for (int l = 0; l < DEPTH; ++l) for (int k = 0; k < 14; ++k) launch_mk(P, 1 + l * fk::NPH_L + k, 2 + l * fk::NPH_L + k, stream);
#endif
}
```

```cpp
#ifndef MK_ONE_LAUNCH
#define MK_ONE_LAUNCH 1
#endif
#include <hip/hip_runtime.h>
#include <cstdint>
#include <cstdio>

constexpr int NB = 2, SEQ = 8192, T = NB * SEQ, DM = 1024, DEPTH = 2;
constexpr int HA = 8, WA = 512, BLK = 256, NBLK = SEQ / BLK;
constexpr int HB = 8, DN = 64, DR = 32, DV = 64, QL = 384, KVL = 256;
constexpr int INC = 3 * WA + QL + KVL + DR + 2 * DM;
constexpr int C_QA = 0, C_KA = 512, C_VA = 1024, C_CQ = 1536, C_CKV = 1920, C_KR = 2176, C_GA = 2208, C_GB = 3232;
constexpr int NE = 256, TOPK = 8, DE = 256, DSH = 256;
constexpr int NA = T * TOPK;
constexpr float ALPHA = 1.4142135623730951f;
constexpr float LN_EPS = 1e-5f, RMS_EPS = 1e-6f;


namespace fk {
#define LAS __attribute__((address_space(3)))
#define GAS __attribute__((address_space(1)))
typedef unsigned short bf16_t;
typedef short bf16x8 __attribute__((ext_vector_type(8)));
typedef float f32x4 __attribute__((ext_vector_type(4)));
typedef float f32x2 __attribute__((ext_vector_type(2)));
typedef float f32x16 __attribute__((ext_vector_type(16)));
typedef unsigned u32x4 __attribute__((ext_vector_type(4)));
typedef unsigned u32x2 __attribute__((ext_vector_type(2)));
constexpr int NWAVES = 8, NTHR = 512;
constexpr int INCP = 4352;
constexpr float LOG2E = 1.4426950408889634f;
constexpr float QS_A = 0.125f * LOG2E;
constexpr float QS_B = 0.10206207261596577f * LOG2E;
#define LDS_WAIT() asm volatile("s_waitcnt lgkmcnt(0)" ::: "memory")
#define VM_WAIT() asm volatile("s_waitcnt vmcnt(0)" ::: "memory")
__device__ __forceinline__ unsigned f2bf(float f) { unsigned u = __builtin_bit_cast(unsigned, f); return (u + 0x7fffu + ((u >> 16) & 1u)) >> 16; }
__device__ __forceinline__ unsigned pk2(float lo, float hi) { return f2bf(lo) | (f2bf(hi) << 16); }
__device__ __forceinline__ float bf2f(unsigned short b) { return __builtin_bit_cast(float, (unsigned)b << 16); }
__device__ __forceinline__ float bflo(unsigned w) { return __builtin_bit_cast(float, w << 16); }
__device__ __forceinline__ float bfhi(unsigned w) { return __builtin_bit_cast(float, w & 0xffff0000u); }
__device__ __forceinline__ float sigmoidf_(float x) { return __builtin_amdgcn_rcpf(1.f + __expf(-x)); }
__device__ __forceinline__ float wave_sum(float v) {
#pragma unroll
    for (int o = 1; o < 64; o <<= 1) v += __shfl_xor(v, o);
    return v;
}

namespace pg8 {
constexpr int BM = 256, BK = 64, HALF = 128, HTB = HALF * BK * 2, STAGE_BYTES = 8 * HTB, NXCD = 8, WGM = 8;
__host__ __device__ __forceinline__ int lds_byte(int r, int c) { const int st = (r >> 4) * 2 + (c >> 5), rr = r & 15, cc = c & 31, ob = rr * 64 + cc * 2; return st * 1024 + (ob ^ (((ob >> 9) & 1) << 5)); }
__host__ __device__ __forceinline__ void stage_rc(int b, int& R, int& C) { const int st = b / 1024, sb = b % 1024, swz = sb ^ (((sb >> 9) & 1) << 5); R = (st >> 1) * 16 + swz / 64; C = (st & 1) * 32 + (swz % 64) / 2; }
__host__ __device__ __forceinline__ int perm32(int rho) { const int n = rho >> 4, i = rho & 15; return 8 * (i >> 2) + 4 * n + (i & 3); }

struct Unit { int pm, pn, e, r0, rend; };
struct Gemm { const bf16_t* A; const bf16_t* Bt; int M, N, K, lda, ldb; };

struct StaticOrder {
    int nM, nN, nwg, G, c;
    __device__ void init(int M, int N, int G_, int c_) { nM = M / BM; nN = N / BM; nwg = nM * nN; G = G_; c = c_; }
    __device__ bool next(int i, Unit& u) const {
        const long L = (long)i * G + c; if (L >= nwg) return false;
        int wgid = (int)L; { const int q = nwg / NXCD, r = nwg % NXCD, xcd = wgid % NXCD, off = wgid / NXCD; wgid = (xcd < r ? xcd * (q + 1) : r * (q + 1) + (xcd - r) * q) + off; }
        const int nig = WGM * nN, gid = wgid / nig, fm = gid * WGM, gsz = (nM - fm) < WGM ? (nM - fm) : WGM;
        u.pm = fm + ((wgid % nig) % gsz); u.pn = (wgid % nig) / gsz; u.e = 0; u.r0 = u.pm * BM; u.rend = u.r0 + BM; return true;
    }
    __device__ __forceinline__ int a_row(const Unit& u, int r) const { return u.pm * BM + r; }
    __device__ __forceinline__ const char* b_ptr(const Gemm& g, const Unit& u) const { return (const char*)g.Bt + (size_t)u.pn * BM * g.ldb * 2; }
};

struct OffsetOrder : StaticOrder {
    int pn0;
    __device__ bool next(int i, Unit& u) const { const bool ok = StaticOrder::next(i, u); u.pn += pn0; return ok; }
};
typedef float f32x2_t_ __attribute__((ext_vector_type(2))); typedef __bf16 bf16x2_t_ __attribute__((ext_vector_type(2)));
__device__ __forceinline__ unsigned cvt_pk_bf16(float lo, float hi) { const f32x2_t_ v = {lo, hi}; const bf16x2_t_ b = __builtin_convertvector(v, bf16x2_t_); return __builtin_bit_cast(unsigned, b); }

template <class Epi, class Sched, bool ALIGN_EPI>
__device__ __forceinline__ void gemm_phase(LAS unsigned char* lds, const Gemm g, const Sched& S, const Epi& E) {
    int tid_ = threadIdx.x; asm volatile("" : "+v"(tid_));
    const int tid = tid_, wid = __builtin_amdgcn_readfirstlane(tid >> 6), lane = tid & 63, wr = wid >> 2, wc = wid & 3, fr = lane & 15, fq = lane >> 4;
    const int K = g.K, nt = K / BK;
    int RA[2]; unsigned CA[2], voffB[2];
#pragma unroll
    for (int i = 0; i < 2; ++i) { int R, C; stage_rc(tid * 16 + i * 8192, R, C); const int Rb = (R & ~31) + perm32(R & 31);
        RA[i] = R; CA[i] = (unsigned)C * 2u; voffB[i] = (unsigned)(Rb * g.ldb + C) * 2u; }
    const unsigned lda2 = (unsigned)g.lda * 2u;
    const size_t hstepB = (size_t)HALF * g.ldb * 2;
    const unsigned ldsw = (unsigned)wid * 1024u;
    const int aoff = lds_byte(wr * 64 + fr, fq * 8), boff = lds_byte(wc * 32 + fr, fq * 8);
    const char* const Abase = (const char*)g.A;
#define PG8_SA(b, h) (((b) * 2 + (h)) * HTB)
#define PG8_SB(b, h) ((4 + (b) * 2 + (h)) * HTB)
#define PG8_STAGE_B(bufoff, gbase) do { _Pragma("unroll") for (int _i = 0; _i < 2; ++_i) \
        __builtin_amdgcn_global_load_lds((const unsigned*)((const char*)(gbase) + voffB[_i]), (LAS unsigned*)(lds + (bufoff) + ldsw + _i * 8192), 16, 0, 0); } while (0)
#define PG8_STAGE_A(bufoff, V0, V1, kb) do { \
        __builtin_amdgcn_global_load_lds((const unsigned*)((Abase + (kb)) + (V0)), (LAS unsigned*)(lds + (bufoff) + ldsw), 16, 0, 0); \
        __builtin_amdgcn_global_load_lds((const unsigned*)((Abase + (kb)) + (V1)), (LAS unsigned*)(lds + (bufoff) + ldsw + 8192), 16, 0, 0); } while (0)
#define PG8_LDA(dst, b, h) do { _Pragma("unroll") for (int m = 0; m < 4; ++m) _Pragma("unroll") for (int k = 0; k < 2; ++k) dst[m][k] = *(const LAS bf16x8*)(lds + PG8_SA(b, h) + aoff + m * 2048 + k * 1024); } while (0)
#define PG8_LDB(dst, b, h) do { _Pragma("unroll") for (int n = 0; n < 2; ++n) _Pragma("unroll") for (int k = 0; k < 2; ++k) dst[n][k] = *(const LAS bf16x8*)(lds + PG8_SB(b, h) + boff + n * 2048 + k * 1024); } while (0)
#define PG8_MMA(ai, bj, At, Bt) do { __builtin_amdgcn_s_setprio(1); _Pragma("unroll") for (int m = 0; m < 4; ++m) _Pragma("unroll") for (int n = 0; n < 2; ++n) _Pragma("unroll") for (int k = 0; k < 2; ++k) \
        acc[ai][bj][m][n] = __builtin_amdgcn_mfma_f32_16x16x32_bf16(Bt[n][k], At[m][k], acc[ai][bj][m][n], 0, 0, 0); __builtin_amdgcn_s_setprio(0); } while (0)
#define PG8_WAIT_V(n) asm volatile("s_waitcnt vmcnt(" #n ")" ::: "memory")
#define PG8_WAIT_L(n) asm volatile("s_waitcnt lgkmcnt(" #n ")" ::: "memory")
#define PG8_BAR __builtin_amdgcn_s_barrier()
#define PG8_SCHED __builtin_amdgcn_sched_barrier(0)
#define PG8_VOFF(V, U) do { V##00 = (unsigned)S.a_row(U, RA[0]) * lda2 + CA[0]; V##01 = (unsigned)S.a_row(U, RA[1]) * lda2 + CA[1]; \
        V##10 = (unsigned)S.a_row(U, HALF + RA[0]) * lda2 + CA[0]; V##11 = (unsigned)S.a_row(U, HALF + RA[1]) * lda2 + CA[1]; } while (0)
    Unit cur, nxt; int ui = 0;
    if (!S.next(0, cur)) return;
    f32x4 acc[2][2][4][2];
#pragma unroll
    for (int a = 0; a < 2; ++a)
#pragma unroll
        for (int b = 0; b < 2; ++b)
#pragma unroll
            for (int m = 0; m < 4; ++m)
#pragma unroll
                for (int n = 0; n < 2; ++n) acc[a][b][m][n] = (f32x4){0.f, 0.f, 0.f, 0.f};
    bf16x8 At[4][2], B0[2][2], B1[2][2];
    unsigned vc00, vc01, vc10, vc11;
    PG8_VOFF(vc, cur);
    const char* cB = S.b_ptr(g, cur);
    PG8_STAGE_B(PG8_SB(0, 0), cB); PG8_STAGE_B(PG8_SB(0, 1), cB + hstepB); PG8_STAGE_A(PG8_SA(0, 0), vc00, vc01, 0u); PG8_STAGE_A(PG8_SA(0, 1), vc10, vc11, 0u);
    if (wr == 1) PG8_BAR;
    PG8_WAIT_V(2); PG8_BAR;
    PG8_STAGE_B(PG8_SB(1, 0), cB + 128); PG8_STAGE_A(PG8_SA(1, 0), vc00, vc01, 128u); PG8_STAGE_B(PG8_SB(1, 1), cB + hstepB + 128);
    PG8_WAIT_V(6); PG8_BAR;
    for (;;) {
        const bool has_next = S.next(ui + 1, nxt);
        const char* nB = has_next ? S.b_ptr(g, nxt) : cB;
        unsigned vn00 = vc00, vn01 = vc01, vn10 = vc10, vn11 = vc11;
        if (has_next) { PG8_VOFF(vn, nxt); }
        const bool half1 = (cur.rend - cur.r0) > HALF;
#pragma unroll 1
        for (int t = 0; t < nt; t += 2) {
            if constexpr (Epi::MIDK > 0) { if (t == Epi::MIDK) E.mid(acc, cur, wr, wc, fr, fq); }
            const bool last = (t == nt - 2);
            const unsigned kb1 = (unsigned)(t + 1) * 128u;
            unsigned kb2 = (unsigned)(t + 2) * 128u;
            unsigned s00 = vc00, s01 = vc01, s10 = vc10, s11 = vc11;
            const char* b2 = cB + (size_t)kb2;
            if (last) { kb2 = 0u; b2 = nB; s00 = vn00; s01 = vn01; s10 = vn10; s11 = vn11; }
            const unsigned kb3 = kb2 + 128u; const char* b3 = b2 + 128;
            PG8_LDB(B0, 0, 0); PG8_LDB(B1, 0, 1); PG8_SCHED; PG8_LDA(At, 0, 0); PG8_STAGE_A(PG8_SA(1, 1), vc10, vc11, kb1);
            PG8_WAIT_V(8); PG8_WAIT_L(0); PG8_BAR; PG8_MMA(0, 0, At, B0); PG8_MMA(0, 1, At, B1); PG8_BAR; PG8_SCHED;
            PG8_LDA(At, 0, 1); PG8_STAGE_B(PG8_SB(0, 0), b2); PG8_STAGE_B(PG8_SB(0, 1), b2 + hstepB); PG8_STAGE_A(PG8_SA(0, 0), s00, s01, kb2);
            PG8_WAIT_V(8); PG8_WAIT_L(0); PG8_BAR; if (half1) { PG8_MMA(1, 0, At, B0); PG8_MMA(1, 1, At, B1); } PG8_BAR; PG8_SCHED;
            PG8_LDB(B0, 1, 0); PG8_LDB(B1, 1, 1); PG8_SCHED; PG8_LDA(At, 1, 0); PG8_STAGE_A(PG8_SA(0, 1), s10, s11, kb2);
            PG8_WAIT_V(8); PG8_WAIT_L(0); PG8_BAR; PG8_MMA(0, 0, At, B0); PG8_MMA(0, 1, At, B1); PG8_BAR; PG8_SCHED;
            PG8_LDA(At, 1, 1); PG8_STAGE_B(PG8_SB(1, 0), b3); PG8_STAGE_B(PG8_SB(1, 1), b3 + hstepB); PG8_STAGE_A(PG8_SA(1, 0), s00, s01, kb3);
            PG8_WAIT_V(8); PG8_WAIT_L(0); PG8_BAR; if (half1) { PG8_MMA(1, 0, At, B0); PG8_MMA(1, 1, At, B1); } PG8_BAR; PG8_SCHED;
        }
        if constexpr (ALIGN_EPI) { if (wr == 0) PG8_BAR; }
        E(acc, cur, wr, wc, fr, fq);
        if (!has_next) break;
#pragma unroll
        for (int a = 0; a < 2; ++a)
#pragma unroll
            for (int b = 0; b < 2; ++b)
#pragma unroll
                for (int m = 0; m < 4; ++m)
#pragma unroll
                    for (int n = 0; n < 2; ++n) acc[a][b][m][n] = (f32x4){0.f, 0.f, 0.f, 0.f};
        cur = nxt; cB = nB; vc00 = vn00; vc01 = vn01; vc10 = vn10; vc11 = vn11; ++ui;
        if constexpr (ALIGN_EPI) { if (wr == 1) PG8_BAR; }
    }
    PG8_WAIT_V(0);
    if constexpr (!ALIGN_EPI) { if (wr == 0) PG8_BAR; }
    PG8_BAR;
#undef PG8_SA
#undef PG8_SB
#undef PG8_STAGE_A
#undef PG8_STAGE_B
#undef PG8_LDA
#undef PG8_LDB
#undef PG8_MMA
#undef PG8_WAIT_V
#undef PG8_WAIT_L
#undef PG8_BAR
#undef PG8_SCHED
#undef PG8_VOFF
}
#define PG8_TILE_BEGIN(acc, wr, wc, fr, fq) \
    _Pragma("unroll") for (int ai = 0; ai < 2; ++ai) _Pragma("unroll") for (int m = 0; m < 4; ++m) _Pragma("unroll") for (int bj = 0; bj < 2; ++bj) { \
        const int trow = ai * 128 + wr * 64 + m * 16 + fr, tcol = bj * 128 + wc * 32 + 8 * fq; f32x4 v0 = acc[ai][bj][m][0], v1 = acc[ai][bj][m][1];
#define PG8_TILE_END }
__device__ __forceinline__ u32x4 pack8(f32x4 v0, f32x4 v1) { u32x4 w; w.x = cvt_pk_bf16(v0[0], v0[1]); w.y = cvt_pk_bf16(v0[2], v0[3]); w.z = cvt_pk_bf16(v1[0], v1[1]); w.w = cvt_pk_bf16(v1[2], v1[3]); return w; }
}

#define XB_TMO      128
#define XB_XCNT(j)  (256  + 64 * (j))
#define XB_XSUB(j)  (1280 + 64 * (j))
#define XB_XGEN(j)  (2304 + 64 * (j))
#define XB_TOP      3328
#define XB_TOPGEN   3392
#define XCD_BAR_WORDS 3456
#define XB_SPIN_CAP (1u << 18)

__device__ __forceinline__ unsigned xb_ld(unsigned* p)              { return __hip_atomic_load(p, __ATOMIC_RELAXED, __HIP_MEMORY_SCOPE_AGENT); }
__device__ __forceinline__ unsigned xb_add(unsigned* p, unsigned v) { return __hip_atomic_fetch_add(p, v, __ATOMIC_RELAXED, __HIP_MEMORY_SCOPE_AGENT); }
__device__ __forceinline__ unsigned xb_xcc_id() { return (unsigned)__builtin_amdgcn_s_getreg((3 << 11) | 20) & 0xFu; }
#define XB_SPIN(cond, bar) do { unsigned _sp = 0; while (cond) { __builtin_amdgcn_s_sleep(1); \
    if ((++_sp & 255u) == 0u) { if (xb_ld(&(bar)[XB_TMO])) break; if (_sp > XB_SPIN_CAP) { atomicAdd(&(bar)[XB_TMO], 1u); break; } } } } while (0)

struct XcdBarrier {
    unsigned* bar; unsigned x;
    volatile LAS unsigned* st;
};

__device__ __forceinline__ XcdBarrier xcd_barrier_post(unsigned* bar, volatile LAS unsigned* st) {
    XcdBarrier b; b.bar = bar; b.x = xb_xcc_id(); b.st = st;
    if (threadIdx.x == 0) (void)xb_add(&bar[XB_XCNT(b.x)], 1u);
    return b;
}
__device__ __forceinline__ void xcd_barrier_complete(unsigned* bar, unsigned x, unsigned& nloc, unsigned& nx) {
    const unsigned G = gridDim.x * gridDim.y * gridDim.z;
    unsigned sum, cnt, mine, sp = 0u;
    for (;;) {
        sum = 0u; cnt = 0u; mine = 0u;
#pragma unroll
        for (unsigned j = 0; j < 16; ++j) { const unsigned c = xb_ld(&bar[XB_XCNT(j)]); sum += c; cnt += (c > 0u) ? 1u : 0u; mine = (j == x) ? c : mine; }
        if (sum == G) break;
        __builtin_amdgcn_s_sleep(1);
        if ((++sp & 255u) == 0u) { if (xb_ld(&bar[XB_TMO])) break; if (sp > XB_SPIN_CAP) { atomicAdd(&bar[XB_TMO], 1u); break; } }
    }
    nloc = mine > 0u ? mine : 1u; nx = cnt > 0u ? cnt : 1u;
}

__device__ __forceinline__ void xcd_barrier(const XcdBarrier& b) {
    asm volatile("s_waitcnt vmcnt(0)" ::: "memory");
    __syncthreads();
    if (threadIdx.x == 0) {
        unsigned* bar = b.bar; asm volatile("" : "+s"(bar));
        __builtin_amdgcn_s_waitcnt(0);
        unsigned nloc = b.st[0], nx = b.st[1];
        if (nloc == 0u) { xcd_barrier_complete(bar, b.x, nloc, nx); b.st[0] = nloc; b.st[1] = nx; }
        const unsigned old = xb_add(&bar[XB_XSUB(b.x)], 1u);
        const unsigned gen = old / nloc;
        if (old + 1u == (gen + 1u) * nloc) {
            __builtin_amdgcn_fence(__ATOMIC_RELEASE, "agent");
            asm volatile("s_waitcnt vmcnt(0)" ::: "memory");
            const unsigned og = xb_add(&bar[XB_TOP], 1u);
            const unsigned tg = og / nx;
            if (og + 1u == (tg + 1u) * nx) xb_add(&bar[XB_TOPGEN], 1u);
            else XB_SPIN(xb_ld(&bar[XB_TOPGEN]) == tg, bar);
            __builtin_amdgcn_fence(__ATOMIC_ACQUIRE, "agent");
            xb_add(&bar[XB_XGEN(b.x)], 1u);
            asm volatile("s_waitcnt vmcnt(0)" ::: "memory");
        } else {
            XB_SPIN(xb_ld(&bar[XB_XGEN(b.x)]) == gen, bar);
            __builtin_amdgcn_fence(__ATOMIC_ACQUIRE, "agent");
            asm volatile("s_waitcnt vmcnt(0)" ::: "memory");
        }
    }
    __syncthreads();
}


struct Params {
    const float* in[22]; float* out; unsigned char* ws;
    int ph_lo, ph_hi;
};
constexpr size_t MiB = 1u << 20;
constexpr size_t WS_CTL = 0, CTL_BYTES = 1 * MiB;
constexpr int CW_BAR = 4096;
constexpr int CW_CNT = 16384;
constexpr size_t WS_WIN = 2 * MiB;
constexpr size_t SZ_WIN = (size_t)INCP * DM;
constexpr size_t SZ_WUQ = (size_t)768 * QL, SZ_WUKV = (size_t)1024 * KVL;
constexpr size_t WS_WUQ = WS_WIN + 2 * SZ_WIN * 2;
constexpr size_t WS_WUKV = WS_WUQ + 2 * SZ_WUQ * 2;
constexpr size_t SZ_WP = (size_t)DM * 512, SZ_WOUT = (size_t)DM * DM;
constexpr size_t WS_WPA = WS_WUKV + 2 * SZ_WUKV * 2;
constexpr size_t WS_WPB = WS_WPA + 2 * SZ_WP * 2;
constexpr size_t WS_WOUT = WS_WPB + 2 * SZ_WP * 2;
constexpr size_t SZ_WRT = (size_t)NE * DM, SZ_WSGU = (size_t)512 * DM, SZ_WSD = (size_t)DM * DSH;
constexpr size_t WS_WRT = WS_WOUT + 2 * SZ_WOUT * 2;
constexpr size_t WS_WSGU = WS_WRT + 2 * SZ_WRT * 2;
constexpr size_t WS_WSD = WS_WSGU + 2 * SZ_WSGU * 2;
constexpr size_t WS_CS = WS_WSD + 2 * SZ_WSD * 2;
constexpr size_t WS_KM = WS_CS + (size_t)SEQ * 16 * 8;
constexpr size_t WS_SEL = WS_KM + (size_t)NB * HA * NBLK * 64 * 4;
constexpr size_t WS_XB = WS_SEL + (size_t)T * 8 * 4;
constexpr size_t WS_CQN = WS_XB + (size_t)T * DM * 2;
constexpr size_t WS_CKVN = WS_CQN + (size_t)T * QL * 2;
constexpr size_t WS_QB = WS_CKVN + (size_t)T * KVL * 2;
constexpr size_t WS_KB = WS_QB + (size_t)T * 768 * 2;
constexpr size_t WS_VB = WS_KB + (size_t)T * 768 * 2;
constexpr size_t WS_OAB = WS_VB + (size_t)T * 512 * 2;
constexpr size_t WS_TMP = WS_OAB + (size_t)T * 1024 * 2;
constexpr size_t WS_MRG = WS_TMP + (size_t)T * 1024 * 2;
constexpr size_t WS_PRE = WS_MRG + (size_t)T * 1024 * 2;
constexpr size_t WS_X1 = WS_PRE + (size_t)T * 1024 * 4;
constexpr size_t WS_X1B = WS_X1 + (size_t)T * 1024 * 4;
constexpr size_t WS_X2 = WS_X1B + (size_t)T * 1024 * 2;
constexpr size_t WS_LOG = WS_X2 + (size_t)T * 1024 * 4;
constexpr size_t WS_HS = WS_LOG + (size_t)T * NE * 4;
constexpr size_t WS_SH = WS_HS + (size_t)T * DSH * 2;
constexpr size_t WS_TOPE = WS_SH + (size_t)T * DM * 2;
constexpr size_t WS_TOPW = WS_TOPE + (size_t)NA * 4;
constexpr size_t WS_APOS = WS_TOPW + (size_t)NA * 4;
constexpr size_t WS_ROWA = WS_APOS + (size_t)NA * 4;
constexpr size_t WS_HIST = WS_ROWA + (size_t)NA * 8;
constexpr size_t WS_PO = WS_HIST + (size_t)1024 * 256 * 4;
constexpr size_t WS_PML = WS_PO + (size_t)T * 8 * 3 * 64 * 2;
constexpr size_t WS_HE = WS_PML + (size_t)T * 8 * 3 * 128;
constexpr size_t WS_Y = WS_HE + (size_t)NA * DE * 2;
constexpr size_t WS_PROJ = WS_Y + (size_t)NA * DM * 2;
constexpr size_t SZ_WEGU = (size_t)NE * 512 * DM, SZ_WED = (size_t)NE * DM * DE;
constexpr size_t WS_WEGU = WS_PROJ + (size_t)T * INCP * 2;
constexpr size_t WS_WED = WS_WEGU + 2 * SZ_WEGU * 2;
constexpr size_t WS_FAST_END = WS_WED + 2 * SZ_WED * 2;
constexpr size_t WS_NEED = WS_FAST_END;
static_assert(WS_NEED <= (size_t)2040 * MiB, "ws map");

constexpr int LDS_BYTES = 147456;
constexpr int RING_BYTES = 131072, MISC_OFF = RING_BYTES + 1024, TAB_OFF = RING_BYTES + 2048;

struct Frame { LAS unsigned char* lds; int tid, lane, wave, G, vcu; };

template <class RowMap>
__device__ __forceinline__ void transpose_item(const float* W, int K, int N, bf16_t* WT, int ldk, RowMap rm, LAS float* scr, int item, int lane) {
    const int nblk = N / 32, kb = item / nblk, nb = item % nblk, k0 = 64 * kb, n0 = 32 * nb;
#pragma unroll 8
    for (int i = 0; i < 32; ++i) { const int kk = 2 * i + (lane >> 5); scr[kk * 33 + (lane & 31)] = W[(size_t)(k0 + kk) * N + n0 + (lane & 31)]; }
    LDS_WAIT(); asm volatile("" ::: "memory");
    const int c = lane & 7;
#pragma unroll
    for (int j = 0; j < 4; ++j) { const int n = (lane >> 3) + 8 * j; const LAS float* s = scr + (8 * c) * 33 + n;
        u32x4 o; o.x = pk2(s[0 * 33], s[1 * 33]); o.y = pk2(s[2 * 33], s[3 * 33]); o.z = pk2(s[4 * 33], s[5 * 33]); o.w = pk2(s[6 * 33], s[7 * 33]);
        *(u32x4*)(WT + (size_t)rm(n0 + n) * ldk + k0 + 8 * c) = o; }
    LDS_WAIT(); asm volatile("" ::: "memory");
}
template <class RowMap>
__device__ __forceinline__ void transpose_item64(const float* W, int K, int N, bf16_t* WT, int ldk, RowMap rm, LAS unsigned short* scr, int item, int lane) {
    const int nblk = N / 64, kb = item / nblk, nb = item % nblk, k0 = 64 * kb, n0 = 64 * nb, r = lane >> 4, c4 = (lane & 15) * 4;
    f32x4 v[16];
#pragma unroll
    for (int i = 0; i < 16; ++i) v[i] = __builtin_nontemporal_load((const f32x4*)(W + (size_t)(k0 + 4 * i + r) * N + n0 + c4));
#pragma unroll
    for (int i = 0; i < 16; ++i) { LAS unsigned* d = (LAS unsigned*)(scr + (4 * i + r) * 66 + c4); d[0] = pk2(v[i][0], v[i][1]); d[1] = pk2(v[i][2], v[i][3]); }
    LDS_WAIT(); asm volatile("" ::: "memory");
    const int c = lane & 7;
#pragma unroll
    for (int j = 0; j < 8; ++j) { const int n = (lane >> 3) + 8 * j; const LAS unsigned short* q = scr + (8 * c) * 66 + n;
        u32x4 o; o.x = (unsigned)q[0] | ((unsigned)q[66] << 16); o.y = (unsigned)q[2 * 66] | ((unsigned)q[3 * 66] << 16); o.z = (unsigned)q[4 * 66] | ((unsigned)q[5 * 66] << 16); o.w = (unsigned)q[6 * 66] | ((unsigned)q[7 * 66] << 16);
        *(u32x4*)(WT + (size_t)rm(n0 + n) * ldk + k0 + 8 * c) = o; }
    LDS_WAIT(); asm volatile("" ::: "memory");
}
struct RowPermD { __device__ __forceinline__ int operator()(int n) const { const int a = n & 255; return (n & ~255) + 128 * ((a >> 3) & 1) + 32 * (a >> 6) + 8 * ((a >> 4) & 3) + (a & 7); } };
struct RowId { __device__ __forceinline__ int operator()(int n) const { return n; } };

struct EpiProj {
    static constexpr int MIDK = 0;
    bf16_t* O; const float* bg;
    __device__ __forceinline__ void operator()(const f32x4 (&acc)[2][2][4][2], const pg8::Unit& u, int wr, int wc, int fr, int fq) const {
        PG8_TILE_BEGIN(acc, wr, wc, fr, fq)
            const int row = u.pm * 256 + trow, col = u.pn * 256 + tcol;
            if (col < C_KA) { v0 = v0 * QS_A; v1 = v1 * QS_A; }
            else if (col >= C_GA && col < INC) { const f32x4 b0 = *(const f32x4*)(bg + col - C_GA), b1 = *(const f32x4*)(bg + col - C_GA + 4);
#pragma unroll
                for (int i = 0; i < 4; ++i) { v0[i] = sigmoidf_(v0[i] + b0[i]); v1[i] = sigmoidf_(v1[i] + b1[i]); } }
            *(u32x4*)(O + (size_t)row * INCP + col) = pg8::pack8(v0, v1);
        PG8_TILE_END
    }
};

struct RowQ { __device__ __forceinline__ int operator()(int n) const { const int h = n / 96, d = n % 96; if (d < 64) return n; const int i = d - 64; return h * 96 + 64 + (i < 16 ? 2 * i : 2 * (i - 16) + 1); } };

struct EpiQ {
    static constexpr int MIDK = 0;
    bf16_t* O; const f32x2* CS;
    __device__ __forceinline__ void operator()(const f32x4 (&acc)[2][2][4][2], const pg8::Unit& u, int wr, int wc, int fr, int fq) const {
        PG8_TILE_BEGIN(acc, wr, wc, fr, fq)
            const int row = u.pm * 256 + trow, col = u.pn * 256 + tcol, d = col % 96;
            if (d >= 64) { const int pos = row % SEQ, i0 = (d - 64) >> 1; const f32x2* cs = CS + (size_t)pos * 16 + i0;
                const f32x2 c0 = cs[0], c1 = cs[1], c2 = cs[2], c3 = cs[3];
                const f32x4 a = v0, b = v1;
                v0[0] = a[0] * c0[0] - a[1] * c0[1]; v0[1] = a[1] * c0[0] + a[0] * c0[1]; v0[2] = a[2] * c1[0] - a[3] * c1[1]; v0[3] = a[3] * c1[0] + a[2] * c1[1];
                v1[0] = b[0] * c2[0] - b[1] * c2[1]; v1[1] = b[1] * c2[0] + b[0] * c2[1]; v1[2] = b[2] * c3[0] - b[3] * c3[1]; v1[3] = b[3] * c3[0] + b[2] * c3[1]; }
            v0 = v0 * QS_B; v1 = v1 * QS_B;
            *(u32x4*)(O + (size_t)row * 768 + col) = pg8::pack8(v0, v1);
        PG8_TILE_END
    }
};
struct EpiKV {
    static constexpr int MIDK = 0;
    bf16_t* KB; bf16_t* VB;
    __device__ __forceinline__ void operator()(const f32x4 (&acc)[2][2][4][2], const pg8::Unit& u, int wr, int wc, int fr, int fq) const {
        PG8_TILE_BEGIN(acc, wr, wc, fr, fq)
            const int row = u.pm * 256 + trow, col = u.pn * 256 + tcol, h = col >> 7, j = col & 127;
            bf16_t* dst = (j < 64) ? KB + (size_t)row * 768 + h * 96 + j : VB + (size_t)row * 512 + h * 64 + (j - 64);
            *(u32x4*)dst = pg8::pack8(v0, v1);
        PG8_TILE_END
    }
};

__device__ __forceinline__ void prep_phase(const Frame& F, const bf16_t* PROJ, const float* qn, const float* kvn, const f32x2* CS, bf16_t* CQN, bf16_t* CKVN, bf16_t* KB, float* KM) {
    int lane_ = F.lane; asm volatile("" : "+v"(lane_));
    const int gw = F.vcu * NWAVES + F.wave, NGW = F.G * NWAVES, lane = lane_;
    for (int row = gw; row < T; row += NGW) {
        const bf16_t* p = PROJ + (size_t)row * INCP;
        u32x4 a = (u32x4){0u, 0u, 0u, 0u}, b = (u32x4){0u, 0u, 0u, 0u};
        if (lane < 48) a = *(const u32x4*)(p + C_CQ + lane * 8);
        if (lane < 32) b = *(const u32x4*)(p + C_CKV + lane * 8);
        float sq = 0.f, sk = 0.f;
#pragma unroll
        for (int i = 0; i < 4; ++i) { const float x = bflo(a[i]), y = bfhi(a[i]), z = bflo(b[i]), w = bfhi(b[i]); sq += x * x + y * y; sk += z * z + w * w; }
        sq = wave_sum(sq); sk = wave_sum(sk);
        const float rq = rsqrtf(sq * (1.f / QL) + RMS_EPS), rk = rsqrtf(sk * (1.f / KVL) + RMS_EPS);
        if (lane < 48) { const f32x4 g0 = *(const f32x4*)(qn + lane * 8), g1 = *(const f32x4*)(qn + lane * 8 + 4); u32x4 o;
            o.x = pk2(bflo(a.x) * rq * g0[0], bfhi(a.x) * rq * g0[1]); o.y = pk2(bflo(a.y) * rq * g0[2], bfhi(a.y) * rq * g0[3]);
            o.z = pk2(bflo(a.z) * rq * g1[0], bfhi(a.z) * rq * g1[1]); o.w = pk2(bflo(a.w) * rq * g1[2], bfhi(a.w) * rq * g1[3]);
            *(u32x4*)(CQN + (size_t)row * QL + lane * 8) = o; }
        if (lane < 32) { const f32x4 g0 = *(const f32x4*)(kvn + lane * 8), g1 = *(const f32x4*)(kvn + lane * 8 + 4); u32x4 o;
            o.x = pk2(bflo(b.x) * rk * g0[0], bfhi(b.x) * rk * g0[1]); o.y = pk2(bflo(b.y) * rk * g0[2], bfhi(b.y) * rk * g0[3]);
            o.z = pk2(bflo(b.z) * rk * g1[0], bfhi(b.z) * rk * g1[1]); o.w = pk2(bflo(b.w) * rk * g1[2], bfhi(b.w) * rk * g1[3]);
            *(u32x4*)(CKVN + (size_t)row * KVL + lane * 8) = o; }
        if (lane < 16) { const float x1 = bf2f(p[C_KR + lane]), x2 = bf2f(p[C_KR + 16 + lane]); const f32x2 cs = CS[(size_t)(row % SEQ) * 16 + lane];
            const unsigned w = pk2(x1 * cs[0] - x2 * cs[1], x2 * cs[0] + x1 * cs[1]);
#pragma unroll
            for (int h = 0; h < 8; ++h) *(unsigned*)(KB + (size_t)row * 768 + h * 96 + 64 + 2 * lane) = w; }
    }
    for (int it = gw; it < NB * NBLK * HA; it += NGW) {
        const int h = it % HA, blk = (it / HA) % NBLK, b = it / (HA * NBLK), c = lane & 7, r0 = lane >> 3;
        const bf16_t* p = PROJ + ((size_t)b * SEQ + (size_t)blk * BLK + r0) * INCP + C_KA + h * 64 + c * 8;
        float s[8];
#pragma unroll
        for (int i = 0; i < 8; ++i) s[i] = 0.f;
        for (int i = 0; i < 32; ++i) { const u32x4 v = *(const u32x4*)(p + (size_t)i * 8 * INCP);
#pragma unroll
            for (int k = 0; k < 4; ++k) { s[2 * k] += bflo(v[k]); s[2 * k + 1] += bfhi(v[k]); } }
#pragma unroll
        for (int i = 0; i < 8; ++i) { s[i] += __shfl_xor(s[i], 8); s[i] += __shfl_xor(s[i], 16); s[i] += __shfl_xor(s[i], 32); }
        if (lane < 8) { float* o = KM + ((size_t)(b * HA + h) * NBLK + blk) * 64 + c * 8;
            *(f32x4*)o = (f32x4){s[0], s[1], s[2], s[3]} * (1.f / BLK); *(f32x4*)(o + 4) = (f32x4){s[4], s[5], s[6], s[7]} * (1.f / BLK); }
    }
}
__device__ __forceinline__ void mobasel_phase(const Frame& F, const bf16_t* PROJ, const float* KM, unsigned* SEL) {
    int tid_ = F.tid; asm volatile("" : "+v"(tid_));
    const int TPW = T / F.G, row0 = (int)blockIdx.x * TPW, b = row0 / SEQ, own = (row0 % SEQ) / BLK, hs = own * 64 + 4;
    LAS float* km = (LAS float*)F.lds;
    for (int i = tid_; i < 8 * own * 16; i += NTHR) { const int h = i / (own * 16), r = i % (own * 16);
        *(LAS f32x4*)(km + h * hs + r * 4) = *(const f32x4*)(KM + ((size_t)(b * HA + h) * NBLK) * 64 + r * 4); }
    __syncthreads();
    for (int idx = tid_; idx < TPW * 8; idx += NTHR) {
        const int h = idx & 7, row = row0 + (idx >> 3);
        const bf16_t* qp = PROJ + (size_t)row * INCP + C_QA + h * 64;
        float q[64];
#pragma unroll
        for (int i = 0; i < 8; ++i) { const u32x4 v = *(const u32x4*)(qp + i * 8);
#pragma unroll
            for (int k = 0; k < 4; ++k) { q[i * 8 + 2 * k] = bflo(v[k]); q[i * 8 + 2 * k + 1] = bfhi(v[k]); } }
        float v1 = -INFINITY, v2 = -INFINITY, v3 = -INFINITY; int i1 = -1, i2 = -1, i3 = -1;
        for (int j = 0; j < own; ++j) {
            const LAS f32x4* kp = (const LAS f32x4*)(km + h * hs + j * 64);
            float g0 = 0.f, g1 = 0.f, g2 = 0.f, g3 = 0.f;
#pragma unroll
            for (int c = 0; c < 16; ++c) { const f32x4 k4 = kp[c]; g0 = fmaf(q[4 * c], k4[0], g0); g1 = fmaf(q[4 * c + 1], k4[1], g1); g2 = fmaf(q[4 * c + 2], k4[2], g2); g3 = fmaf(q[4 * c + 3], k4[3], g3); }
            const float g = (g0 + g1) + (g2 + g3);
            if (g > v1) { v3 = v2; i3 = i2; v2 = v1; i2 = i1; v1 = g; i1 = j; }
            else if (g > v2) { v3 = v2; i3 = i2; v2 = g; i2 = j; }
            else if (g > v3) { v3 = g; i3 = j; }
        }
        unsigned m = 0;
        if (i1 >= 0) m |= 1u << i1;
        if (i2 >= 0) m |= 1u << i2;
        if (i3 >= 0) m |= 1u << i3;
        SEL[(size_t)row * 8 + h] = m;
    }
    __syncthreads();
}

struct EpiGate2 {
    static constexpr int MIDK = 8;
    const bf16_t* PROJ; bf16_t* MRG;
    __device__ __forceinline__ void mid(f32x4 (&acc)[2][2][4][2], const pg8::Unit& u, int wr, int wc, int fr_, int fq) const {
        int fr = fr_; asm volatile("" : "+v"(fr));
#pragma unroll
        for (int ai = 0; ai < 2; ++ai)
#pragma unroll
            for (int m = 0; m < 4; ++m)
#pragma unroll
                for (int bj = 0; bj < 2; ++bj) { const size_t o = (size_t)(u.pm * 256 + ai * 128 + wr * 64 + m * 16 + fr) * INCP + u.pn * 256 + bj * 128 + wc * 32 + 8 * fq;
                    const u32x4 ga = *(const u32x4*)(PROJ + o + C_GA), gb = *(const u32x4*)(PROJ + o + C_GB);
#pragma unroll
                    for (int i = 0; i < 4; ++i) { const float r0 = bflo(ga[i]) * __builtin_amdgcn_rcpf(bflo(gb[i])), r1 = bfhi(ga[i]) * __builtin_amdgcn_rcpf(bfhi(gb[i]));
                        acc[ai][bj][m][i >> 1][2 * (i & 1)] *= r0; acc[ai][bj][m][i >> 1][2 * (i & 1) + 1] *= r1; }
                    __builtin_amdgcn_sched_barrier(0); }
    }
    __device__ __forceinline__ void operator()(const f32x4 (&acc)[2][2][4][2], const pg8::Unit& u, int wr, int wc, int fr, int fq) const {
        PG8_TILE_BEGIN(acc, wr, wc, fr, fq)
            const int row = u.pm * 256 + trow, col = u.pn * 256 + tcol;
            const u32x4 g = *(const u32x4*)(PROJ + (size_t)row * INCP + C_GB + col);
            v0[0] *= bflo(g.x); v0[1] *= bfhi(g.x); v0[2] *= bflo(g.y); v0[3] *= bfhi(g.y); v1[0] *= bflo(g.z); v1[1] *= bfhi(g.z); v1[2] *= bflo(g.w); v1[3] *= bfhi(g.w);
            *(u32x4*)(MRG + (size_t)row * DM + col) = pg8::pack8(v0, v1);
        PG8_TILE_END
    }
};
struct EpiResid {
    static constexpr int MIDK = 0;
    const bf16_t* X; bf16_t* PRE;
    __device__ __forceinline__ void operator()(const f32x4 (&acc)[2][2][4][2], const pg8::Unit& u, int wr, int wc, int fr, int fq) const {
        PG8_TILE_BEGIN(acc, wr, wc, fr, fq)
            const size_t o = (size_t)(u.pm * 256 + trow) * DM + u.pn * 256 + tcol;
            const u32x4 x = *(const u32x4*)(X + o);
            v0[0] += ALPHA * bflo(x.x); v0[1] += ALPHA * bfhi(x.x); v0[2] += ALPHA * bflo(x.y); v0[3] += ALPHA * bfhi(x.y);
            v1[0] += ALPHA * bflo(x.z); v1[1] += ALPHA * bfhi(x.z); v1[2] += ALPHA * bflo(x.w); v1[3] += ALPHA * bfhi(x.w);
            *(u32x4*)(PRE + o) = pg8::pack8(v0, v1);
        PG8_TILE_END
    }
};
__device__ __forceinline__ void ln_phase(const Frame& F, const bf16_t* PRE, const float* g, const float* bt, bf16_t* XBo) {
    int lane_ = F.lane; asm volatile("" : "+v"(lane_));
    const int gw = F.vcu * NWAVES + F.wave, NGW = F.G * NWAVES, lane = lane_;
    for (int row = gw; row < T; row += NGW) {
        const u32x2* pr = (const u32x2*)(PRE + (size_t)row * DM) + lane;
        f32x4 v[4]; float s = 0.f;
#pragma unroll
        for (int j = 0; j < 4; ++j) { const u32x2 h = pr[64 * j]; v[j] = (f32x4){bflo(h.x), bfhi(h.x), bflo(h.y), bfhi(h.y)}; s += (v[j][0] + v[j][1]) + (v[j][2] + v[j][3]); }
        const float mean = wave_sum(s) * (1.f / DM); float s2 = 0.f;
#pragma unroll
        for (int j = 0; j < 4; ++j) { v[j] = v[j] - mean; s2 += (v[j][0] * v[j][0] + v[j][1] * v[j][1]) + (v[j][2] * v[j][2] + v[j][3] * v[j][3]); }
        const float rstd = rsqrtf(wave_sum(s2) * (1.f / DM) + LN_EPS);
#pragma unroll
        for (int j = 0; j < 4; ++j) { const f32x4 gg = ((const f32x4*)g)[lane + 64 * j], bb = ((const f32x4*)bt)[lane + 64 * j];
            const f32x4 y = v[j] * rstd * gg + bb;
            u32x2 w; w.x = pk2(y[0], y[1]); w.y = pk2(y[2], y[3]); ((u32x2*)(XBo + (size_t)row * DM))[lane + 64 * j] = w; }
    }
}

struct RowGU { int off; __device__ __forceinline__ int operator()(int n) const { return 256 * (n >> 7) + off + (n & 127); } };

struct EpiF32 {
    static constexpr int MIDK = 0;
    float* O; int ld;
    __device__ __forceinline__ void operator()(const f32x4 (&acc)[2][2][4][2], const pg8::Unit& u, int wr, int wc, int fr, int fq) const {
        PG8_TILE_BEGIN(acc, wr, wc, fr, fq)
            float* o = O + (size_t)(u.pm * 256 + trow) * ld + u.pn * 256 + tcol; *(f32x4*)o = v0; *(f32x4*)(o + 4) = v1;
        PG8_TILE_END
    }
};
struct EpiBf16 {
    static constexpr int MIDK = 0;
    bf16_t* O; int ld;
    __device__ __forceinline__ void operator()(const f32x4 (&acc)[2][2][4][2], const pg8::Unit& u, int wr, int wc, int fr, int fq) const {
        PG8_TILE_BEGIN(acc, wr, wc, fr, fq)
            *(u32x4*)(O + (size_t)(u.pm * 256 + trow) * ld + u.pn * 256 + tcol) = pg8::pack8(v0, v1);
        PG8_TILE_END
    }
};
__device__ __forceinline__ float silu_mul(float g, float u) { return g * __builtin_amdgcn_rcpf(1.f + __expf(-g)) * u; }
struct EpiSwiGLU {
    static constexpr int MIDK = 0;
    bf16_t* H; int ld;
    __device__ __forceinline__ void operator()(const f32x4 (&acc)[2][2][4][2], const pg8::Unit& u, int wr, int wc, int fr, int fq) const {
#pragma unroll
        for (int ai = 0; ai < 2; ++ai)
#pragma unroll
            for (int m = 0; m < 4; ++m) { const int row = u.r0 + ai * 128 + wr * 64 + m * 16 + fr;
                if (row < u.rend) { f32x4 h0, h1;
#pragma unroll
                    for (int i = 0; i < 4; ++i) { h0[i] = silu_mul(acc[ai][0][m][0][i], acc[ai][1][m][0][i]); h1[i] = silu_mul(acc[ai][0][m][1][i], acc[ai][1][m][1][i]); }
                    *(u32x4*)(H + (size_t)row * ld + 128 * u.pn + wc * 32 + 8 * fq) = pg8::pack8(h0, h1); } }
    }
};
constexpr float Y8_SCALE = 32.f;
__device__ __forceinline__ unsigned pk4_fp8(float a, float b, float c, float d) { int w = __builtin_amdgcn_cvt_pk_fp8_f32(a, b, 0, false); w = __builtin_amdgcn_cvt_pk_fp8_f32(c, d, w, true); return (unsigned)w; }
struct EpiExpDown {
    static constexpr int MIDK = 0;
    unsigned char* Y8;
    __device__ __forceinline__ void operator()(const f32x4 (&acc)[2][2][4][2], const pg8::Unit& u, int wr, int wc, int fr, int fq) const {
#pragma unroll
        for (int ai = 0; ai < 2; ++ai)
#pragma unroll
            for (int m = 0; m < 4; ++m) { const int row = u.r0 + ai * 128 + wr * 64 + m * 16 + fr;
                if (row < u.rend) { const f32x4 a0 = acc[ai][0][m][0] * Y8_SCALE, a1 = acc[ai][0][m][1] * Y8_SCALE, b0 = acc[ai][1][m][0] * Y8_SCALE, b1 = acc[ai][1][m][1] * Y8_SCALE;
                    u32x4 w; w.x = pk4_fp8(a0[0], a0[1], a0[2], a0[3]); w.y = pk4_fp8(a1[0], a1[1], a1[2], a1[3]); w.z = pk4_fp8(b0[0], b0[1], b0[2], b0[3]); w.w = pk4_fp8(b1[0], b1[1], b1[2], b1[3]);
                    *(u32x4*)(Y8 + (size_t)row * DM + 256 * u.pn + 64 * wc + 16 * fq) = w; } }
    }
};
template <int NPN, bool GATHER>
struct ExpertOrder {
    const LAS int* off; const LAS int* toff; const int* rowa; int G, c; size_t strideE;
    __device__ __forceinline__ bool next(int i, pg8::Unit& u) const {
        const int L = i * G + c; if (L >= toff[256] * NPN) return false;
        const int tile = L / NPN; u.pn = L % NPN; int lo = 0, hi = 255;
        while (lo < hi) { const int mid = (lo + hi + 1) >> 1; if (toff[mid] <= tile) lo = mid; else hi = mid - 1; }
        u.e = lo; u.r0 = off[lo] + (tile - toff[lo]) * 256; u.rend = off[lo + 1]; u.pm = 0; return true;
    }
    __device__ __forceinline__ int a_row(const pg8::Unit& u, int r) const { const int rr = min(u.r0 + r, u.rend - 1); return GATHER ? (rowa[2 * rr] >> 3) : rr; }
    __device__ __forceinline__ const char* b_ptr(const pg8::Gemm& g, const pg8::Unit& u) const { return (const char*)g.Bt + (size_t)u.e * strideE + (size_t)u.pn * 256 * g.ldb * 2; }
};
__device__ __forceinline__ void expert_tables(const Frame& F, const unsigned* cnt, LAS int* off, LAS int* toff) {
    if (F.tid < 256) { off[F.tid] = (int)cnt[F.tid]; }
    __syncthreads();
    if (F.tid == 0) { int a = 0, b = 0; for (int i = 0; i < 256; ++i) { const int c = off[i]; off[i] = a; toff[i] = b; a += c; b += (c + 255) >> 8; } off[256] = a; toff[256] = b; }
    __syncthreads();
}
__device__ __forceinline__ void route_phase(const Frame& F, const float* LOGITS, const float* rbias, int* TOPE, float* TOPW, int* APOS, int* HIST, LAS int* lcnt) {
    int lane_ = F.lane; asm volatile("" : "+v"(lane_));
    const int lane = lane_, TPW = T / F.G, t0 = (int)blockIdx.x * TPW;
    if (F.tid < 256) lcnt[F.tid] = 0;
    __syncthreads();
    const f32x4 rb = *(const f32x4*)(rbias + lane * 4);
    f32x4 lgn = (t0 + F.wave < t0 + TPW) ? *(const f32x4*)(LOGITS + (size_t)(t0 + F.wave) * NE + lane * 4) : (f32x4){0.f, 0.f, 0.f, 0.f};
#pragma unroll 1
    for (int t = t0 + F.wave; t < t0 + TPW; t += NWAVES) {
        const f32x4 lg = lgn;
        if (t + NWAVES < t0 + TPW) lgn = *(const f32x4*)(LOGITS + (size_t)(t + NWAVES) * NE + lane * 4);
        const float s0 = __builtin_amdgcn_rcpf(1.f + __expf(-lg[0])), s1 = __builtin_amdgcn_rcpf(1.f + __expf(-lg[1])), s2 = __builtin_amdgcn_rcpf(1.f + __expf(-lg[2])), s3 = __builtin_amdgcn_rcpf(1.f + __expf(-lg[3]));
        float c0 = s0 + rb[0], c1 = s1 + rb[1], c2 = s2 + rb[2], c3 = s3 + rb[3];
        float a = fmaxf(c0, c1), bq = fminf(c0, c1);
        { const float hi2 = fmaxf(c2, c3), lo2 = fminf(c2, c3); const float na = fmaxf(a, hi2), nb = fmaxf(fminf(a, hi2), fmaxf(bq, lo2)); a = na; bq = nb; }
#pragma unroll
        for (int o = 1; o < 8; o <<= 1) { const float oa = __shfl_xor(a, o), ob = __shfl_xor(bq, o); const float na = fmaxf(a, oa), nb = fmaxf(fminf(a, oa), fmaxf(bq, ob)); a = na; bq = nb; }
        const float gs = a + bq; const int grp = lane >> 3;
        int rank = 0;
#pragma unroll
        for (int j = 0; j < 8; ++j) { const float og = __shfl(gs, j * 8); rank += (og > gs || (og == gs && j < grp)) ? 1 : 0; }
        if (rank >= 4) { c0 = c1 = c2 = c3 = -INFINITY; }
        float wsum = 0.f, myw = 0.f; int mye = 0;
#pragma unroll
        for (int k = 0; k < TOPK; ++k) {
            float bv = c0; int bi = 0;
            if (c1 > bv) { bv = c1; bi = 1; }
            if (c2 > bv) { bv = c2; bi = 2; }
            if (c3 > bv) { bv = c3; bi = 3; }
            int be = lane * 4 + bi;
#pragma unroll
            for (int o = 1; o < 64; o <<= 1) { const float ov = __shfl_xor(bv, o); const int oe = __shfl_xor(be, o); if (ov > bv || (ov == bv && oe < be)) { bv = ov; be = oe; } }
            float sc = 0.f;
            if ((be >> 2) == lane) { const int b2 = be & 3; sc = b2 == 0 ? s0 : b2 == 1 ? s1 : b2 == 2 ? s2 : s3; if (b2 == 0) c0 = -INFINITY; else if (b2 == 1) c1 = -INFINITY; else if (b2 == 2) c2 = -INFINITY; else c3 = -INFINITY; }
            sc = __shfl(sc, be >> 2);
            wsum += sc;
            if (lane == k) { myw = sc; mye = be; }
        }
        if (lane < TOPK) { const int aidx = t * TOPK + lane; TOPE[aidx] = mye; TOPW[aidx] = myw / wsum * 2.5f; APOS[aidx] = __hip_atomic_fetch_add(lcnt + mye, 1, __ATOMIC_RELAXED, __HIP_MEMORY_SCOPE_WORKGROUP); }
    }
    __syncthreads();
    if (F.tid < 256) HIST[(size_t)blockIdx.x * 256 + F.tid] = lcnt[F.tid];
}
__device__ __forceinline__ void combine_phase(const Frame& F, const bf16_t* X1, const bf16_t* SH, const unsigned char* Y8, const int* INV, const float* TOPW, const float* g, const float* bt, float* Xo, bf16_t* XBo) {
    int lane_ = F.lane; asm volatile("" : "+v"(lane_));
    const int gw = F.vcu * NWAVES + F.wave, NGW = F.G * NWAVES, lane = lane_;
    for (int row = gw; row < T; row += NGW) {
        int ri = 0; float rw = 0.f; if (lane < TOPK) { ri = INV[row * TOPK + lane]; rw = TOPW[row * TOPK + lane] * (1.f / Y8_SCALE); }
        float v[16];
#pragma unroll
        for (int j = 0; j < 2; ++j) { const u32x4 x = ((const u32x4*)(X1 + (size_t)row * DM))[2 * lane + j], h = ((const u32x4*)(SH + (size_t)row * DM))[2 * lane + j];
#pragma unroll
            for (int i = 0; i < 4; ++i) { v[8 * j + 2 * i] = ALPHA * bflo(x[i]) + bflo(h[i]); v[8 * j + 2 * i + 1] = ALPHA * bfhi(x[i]) + bfhi(h[i]); } }
#pragma unroll
        for (int k = 0; k < TOPK; ++k) { const u32x4 h = ((const u32x4*)(Y8 + (size_t)__shfl(ri, k) * DM))[lane]; const float w = __shfl(rw, k);
#pragma unroll
            for (int i = 0; i < 4; ++i) { const f32x2 lo = __builtin_amdgcn_cvt_pk_f32_fp8((int)h[i], false), hi2 = __builtin_amdgcn_cvt_pk_f32_fp8((int)h[i], true);
                v[4 * i] = fmaf(w, lo[0], v[4 * i]); v[4 * i + 1] = fmaf(w, lo[1], v[4 * i + 1]); v[4 * i + 2] = fmaf(w, hi2[0], v[4 * i + 2]); v[4 * i + 3] = fmaf(w, hi2[1], v[4 * i + 3]); } }
        float s = 0.f;
#pragma unroll
        for (int i = 0; i < 16; ++i) s += v[i];
        const float mean = wave_sum(s) * (1.f / DM); float s2 = 0.f;
#pragma unroll
        for (int i = 0; i < 16; ++i) { v[i] -= mean; s2 += v[i] * v[i]; }
        const float rstd = rsqrtf(wave_sum(s2) * (1.f / DM) + LN_EPS);
        const int c0 = 16 * lane;
        f32x4 y[4];
#pragma unroll
        for (int q = 0; q < 4; ++q) { const f32x4 gg = *(const f32x4*)(g + c0 + 4 * q), bb = *(const f32x4*)(bt + c0 + 4 * q); y[q] = (f32x4){v[4 * q], v[4 * q + 1], v[4 * q + 2], v[4 * q + 3]} * rstd * gg + bb; }
        if (Xo) {
#pragma unroll
            for (int q = 0; q < 4; ++q) *(f32x4*)(Xo + (size_t)row * DM + c0 + 4 * q) = y[q]; }
        if (XBo) {
#pragma unroll
            for (int j = 0; j < 2; ++j) { u32x4 w; w.x = pk2(y[2 * j][0], y[2 * j][1]); w.y = pk2(y[2 * j][2], y[2 * j][3]); w.z = pk2(y[2 * j + 1][0], y[2 * j + 1][1]); w.w = pk2(y[2 * j + 1][2], y[2 * j + 1][3]); *(u32x4*)(XBo + (size_t)row * DM + c0 + 8 * j) = w; } }
    }
}

__device__ __forceinline__ int crow(int r, int hi) { return (r & 3) + 8 * (r >> 2) + 4 * hi; }
typedef short s16x4 __attribute__((ext_vector_type(4)));
__device__ __forceinline__ s16x4 vtr(const LAS unsigned char* p) { return __builtin_bit_cast(s16x4, __builtin_amdgcn_ds_read_tr16_b64_v4i16((LAS s16x4*)p)); }
__device__ __forceinline__ float xhalf_max(float v) { auto rr = __builtin_amdgcn_permlane32_swap(__float_as_uint(v), __float_as_uint(v), false, false); return fmaxf(__uint_as_float(rr[0]), __uint_as_float(rr[1])); }
__device__ __forceinline__ float xhalf_sum(float v) { auto rr = __builtin_amdgcn_permlane32_swap(__float_as_uint(v), __float_as_uint(v), false, false); return __uint_as_float(rr[0]) + __uint_as_float(rr[1]); }

template <int DQK, bool ALIBI>
__device__ __forceinline__ void attn_tile(const LAS unsigned char* kb, int kfo, int vfo, const bf16x8 (&qf)[DQK / 16], float& m, float& l, f32x16& o0, f32x16& o1, int hi, int tq, int kpos0, float slope2, bool causal) {
    constexpr int ND0 = DQK / 16;
    bf16x8 ka[ND0], kc[ND0];
#pragma unroll
    for (int d0 = 0; d0 < ND0; ++d0) { ka[d0] = *(const LAS bf16x8*)(kb + kfo + d0 * 2048); kc[d0] = *(const LAS bf16x8*)(kb + kfo + d0 * 2048 + 512); }
    __builtin_amdgcn_sched_barrier(0);
    f32x16 p0, p1;
#pragma unroll
    for (int r = 0; r < 16; ++r) { p0[r] = 0.f; p1[r] = 0.f; }
#pragma unroll
    for (int d0 = 0; d0 < ND0; ++d0) {
        p0 = __builtin_amdgcn_mfma_f32_32x32x16_bf16(ka[d0], qf[d0], p0, 0, 0, 0);
        p1 = __builtin_amdgcn_mfma_f32_32x32x16_bf16(kc[d0], qf[d0], p1, 0, 0, 0);
    }
    s16x4 vlo[8], vhi[8];
    { const unsigned va = (unsigned)(uintptr_t)(kb + vfo);
#pragma unroll
      for (int i = 0; i < 8; ++i) {
        asm volatile("ds_read_b64_tr_b16 %0, %1 offset:%c2" : "=&v"(vlo[i]) : "v"(va), "i"((i >> 2) * 4096 + (i & 3) * 1024) : "memory");
        asm volatile("ds_read_b64_tr_b16 %0, %1 offset:%c2" : "=&v"(vhi[i]) : "v"(va), "i"((i >> 2) * 4096 + (i & 3) * 1024 + 512) : "memory"); } }
    const int krel = kpos0 + 4 * hi - tq;
    if (ALIBI) { const float bb = slope2 * (float)krel;
#pragma unroll
        for (int r = 0; r < 16; ++r) { const float c = (float)((r & 3) + 8 * (r >> 2)); p0[r] += fmaf(slope2, c, bb); p1[r] += fmaf(slope2, c + 32.f, bb); } }
    if (causal) {
#pragma unroll
        for (int r = 0; r < 16; ++r) { const int kv = krel + (r & 3) + 8 * (r >> 2); if (kv > 0) p0[r] = -INFINITY; if (kv + 32 > 0) p1[r] = -INFINITY; } }
    float rm = fmaxf(p0[0], p1[0]);
#pragma unroll
    for (int r = 1; r < 16; ++r) rm = fmaxf(rm, fmaxf(p0[r], p1[r]));
    rm = xhalf_max(rm);
    const float mn = fmaxf(m, rm), alpha = __builtin_amdgcn_exp2f(m - mn);
    m = mn;
    float ls = 0.f;
#pragma unroll
    for (int r = 0; r < 16; ++r) { p0[r] = __builtin_amdgcn_exp2f(p0[r] - mn); p1[r] = __builtin_amdgcn_exp2f(p1[r] - mn); ls += p0[r] + p1[r]; }
    l = l * alpha + ls;
#pragma unroll
    for (int r = 0; r < 16; ++r) { o0[r] *= alpha; o1[r] *= alpha; }
    const u32x4 pw0 = (u32x4){pg8::cvt_pk_bf16(p0[0], p0[1]), pg8::cvt_pk_bf16(p0[2], p0[3]), pg8::cvt_pk_bf16(p0[4], p0[5]), pg8::cvt_pk_bf16(p0[6], p0[7])};
    const u32x4 pw1 = (u32x4){pg8::cvt_pk_bf16(p0[8], p0[9]), pg8::cvt_pk_bf16(p0[10], p0[11]), pg8::cvt_pk_bf16(p0[12], p0[13]), pg8::cvt_pk_bf16(p0[14], p0[15])};
    const u32x4 pw2 = (u32x4){pg8::cvt_pk_bf16(p1[0], p1[1]), pg8::cvt_pk_bf16(p1[2], p1[3]), pg8::cvt_pk_bf16(p1[4], p1[5]), pg8::cvt_pk_bf16(p1[6], p1[7])};
    const u32x4 pw3 = (u32x4){pg8::cvt_pk_bf16(p1[8], p1[9]), pg8::cvt_pk_bf16(p1[10], p1[11]), pg8::cvt_pk_bf16(p1[12], p1[13]), pg8::cvt_pk_bf16(p1[14], p1[15])};
    asm volatile("s_waitcnt lgkmcnt(0)" ::: "memory"); __builtin_amdgcn_sched_barrier(0);
#define ATT_VF(i) (bf16x8){vlo[i][0], vlo[i][1], vlo[i][2], vlo[i][3], vhi[i][0], vhi[i][1], vhi[i][2], vhi[i][3]}
    o0 = __builtin_amdgcn_mfma_f32_32x32x16_bf16(ATT_VF(0), __builtin_bit_cast(bf16x8, pw0), o0, 0, 0, 0);
    o1 = __builtin_amdgcn_mfma_f32_32x32x16_bf16(ATT_VF(4), __builtin_bit_cast(bf16x8, pw0), o1, 0, 0, 0);
    o0 = __builtin_amdgcn_mfma_f32_32x32x16_bf16(ATT_VF(1), __builtin_bit_cast(bf16x8, pw1), o0, 0, 0, 0);
    o1 = __builtin_amdgcn_mfma_f32_32x32x16_bf16(ATT_VF(5), __builtin_bit_cast(bf16x8, pw1), o1, 0, 0, 0);
    o0 = __builtin_amdgcn_mfma_f32_32x32x16_bf16(ATT_VF(2), __builtin_bit_cast(bf16x8, pw2), o0, 0, 0, 0);
    o1 = __builtin_amdgcn_mfma_f32_32x32x16_bf16(ATT_VF(6), __builtin_bit_cast(bf16x8, pw2), o1, 0, 0, 0);
    o0 = __builtin_amdgcn_mfma_f32_32x32x16_bf16(ATT_VF(3), __builtin_bit_cast(bf16x8, pw3), o0, 0, 0, 0);
    o1 = __builtin_amdgcn_mfma_f32_32x32x16_bf16(ATT_VF(7), __builtin_bit_cast(bf16x8, pw3), o1, 0, 0, 0);
#undef ATT_VF
}
#define ATT_ISSUE(t, bo) do { \
        for (int c_ = wid; c_ < NCH; c_ += 8) __builtin_amdgcn_global_load_lds((const unsigned*)(ksrc + (size_t)(t) * 64 * ldk + c_ * 8), (LAS unsigned*)(lds + (bo) + c_ * 1024), 16, 0, 0); \
        __builtin_amdgcn_global_load_lds((const unsigned*)(vsrc + (size_t)(t) * 64 * ldv), (LAS unsigned*)(lds + (bo) + KBYTES + wid * 1024), 16, 0, 0); } while (0)

template <int DQK, bool MOBA_OWN>
__device__ __forceinline__ void attn_unit(LAS unsigned char* lds, int b, int h, int qb, const bf16_t* Qp, int ldq, const bf16_t* Kp, int ldk, const bf16_t* Vp, int ldv, bf16_t* Op, int ldo, const bf16_t* PO, const f32x2* PML) {
    constexpr int NCH = DQK / 8, KBYTES = NCH * 1024, BUFB = KBYTES + 8192, ND0 = DQK / 16;
    int tid_ = threadIdx.x; asm volatile("" : "+v"(tid_));
    const int lane = tid_ & 63, r32 = lane & 31, hi = lane >> 5, wid = __builtin_amdgcn_readfirstlane(tid_ >> 6);
    const size_t rowbase = (size_t)b * SEQ; const int q0 = qb * 256, T0 = MOBA_OWN ? 4 * qb : 0, T1 = 4 * (qb + 1), tq = q0 + wid * 32 + r32;
    const bf16_t* ksrc = Kp + (rowbase + lane) * ldk + h * DQK;
    const bf16_t* vsrc = Vp + (rowbase + 16 * (wid & 3) + (lane >> 2)) * ldv + h * 64 + (wid >> 2) * 32 + (lane & 3) * 8;
    ATT_ISSUE(T0, 0);
    bf16x8 qf[ND0];
    { const bf16_t* qrow = Qp + (rowbase + tq) * ldq + h * DQK + hi * 8;
#pragma unroll
      for (int d0 = 0; d0 < ND0; ++d0) qf[d0] = *(const bf16x8*)(qrow + d0 * 16); }
    const float slope2 = MOBA_OWN ? exp2f(-(float)(h + 1)) * LOG2E : 0.f;
    float m = -1e30f, l = 0.f;
    f32x16 o0, o1;
#pragma unroll
    for (int r = 0; r < 16; ++r) { o0[r] = 0.f; o1[r] = 0.f; }
    const int kfo = hi * 1024 + r32 * 16;
    const int vfo = KBYTES + ((lane >> 4) & 1) * 32 + (lane & 3) * 8 + (4 * hi + ((lane & 15) >> 2)) * 64;
#pragma unroll 1
    for (int t = T0; t < T1; ++t) {
        asm volatile("s_waitcnt vmcnt(0) lgkmcnt(0)\n\ts_barrier" ::: "memory");
        if (t + 1 < T1) ATT_ISSUE(t + 1, ((t + 1) & 1) * BUFB);
        attn_tile<DQK, MOBA_OWN>(lds + (t & 1) * BUFB, kfo, vfo, qf, m, l, o0, o1, hi, tq, 64 * t, slope2, t >= T1 - 4);
    }
    float lt = xhalf_sum(l);
    if (MOBA_OWN) {
        const int nsel = qb < 3 ? qb : 3;
        const size_t pidx = ((rowbase + tq) * 8 + h) * 3;
        float ms[3], ws[3], M = m;
#pragma unroll
        for (int sIdx = 0; sIdx < 3; ++sIdx) { ms[sIdx] = -1e30f; ws[sIdx] = 0.f; if (sIdx < nsel) { const f32x2 ml = PML[(pidx + sIdx) * 16]; ms[sIdx] = ml[0]; ws[sIdx] = ml[1]; M = fmaxf(M, ml[0]); } }
        const float w0 = __builtin_amdgcn_exp2f(m - M);
        lt *= w0;
#pragma unroll
        for (int r = 0; r < 16; ++r) { o0[r] *= w0; o1[r] *= w0; }
#pragma unroll
        for (int sIdx = 0; sIdx < 3; ++sIdx) if (sIdx < nsel) {
            const float w = ws[sIdx] * __builtin_amdgcn_exp2f(ms[sIdx] - M); lt += w;
            const bf16_t* po = PO + (pidx + sIdx) * 64 + 4 * hi;
#pragma unroll
            for (int r4 = 0; r4 < 4; ++r4) { const u32x2 a = *(const u32x2*)(po + 8 * r4), c = *(const u32x2*)(po + 32 + 8 * r4);
                o0[4 * r4] += w * bflo(a.x); o0[4 * r4 + 1] += w * bfhi(a.x); o0[4 * r4 + 2] += w * bflo(a.y); o0[4 * r4 + 3] += w * bfhi(a.y);
                o1[4 * r4] += w * bflo(c.x); o1[4 * r4 + 1] += w * bfhi(c.x); o1[4 * r4 + 2] += w * bflo(c.y); o1[4 * r4 + 3] += w * bfhi(c.y); } }
    }
    const float inv = 1.f / lt;
    bf16_t* orow = Op + (rowbase + tq) * ldo + h * 64 + 4 * hi;
#pragma unroll
    for (int r4 = 0; r4 < 4; ++r4) {
        u32x2 w0_, w1_;
        w0_.x = pg8::cvt_pk_bf16(o0[4 * r4] * inv, o0[4 * r4 + 1] * inv); w0_.y = pg8::cvt_pk_bf16(o0[4 * r4 + 2] * inv, o0[4 * r4 + 3] * inv);
        w1_.x = pg8::cvt_pk_bf16(o1[4 * r4] * inv, o1[4 * r4 + 1] * inv); w1_.y = pg8::cvt_pk_bf16(o1[4 * r4 + 2] * inv, o1[4 * r4 + 3] * inv);
        *(u32x2*)(orow + 8 * r4) = w0_; *(u32x2*)(orow + 32 + 8 * r4) = w1_;
    }
    asm volatile("s_waitcnt lgkmcnt(0)\n\ts_barrier" ::: "memory");
}
__device__ __forceinline__ void moba_sel_unit(LAS unsigned char* lds, int b, int h, int j, int slo, int shi, const bf16_t* Qp, const bf16_t* Kp, const bf16_t* Vp, int ldk, const unsigned* SEL, bf16_t* PO, f32x2* PML) {
    constexpr int DQK = 64, NCH = 8, KBYTES = 8192, BUFB = 16384, ldv = INCP; (void)ldv;
    int tid_ = threadIdx.x; asm volatile("" : "+v"(tid_));
    const int lane = tid_ & 63, r32 = lane & 31, hi = lane >> 5, wid = __builtin_amdgcn_readfirstlane(tid_ >> 6);
    const size_t rowbase = (size_t)b * SEQ;
    const bf16_t* ksrc = Kp + (rowbase + lane) * ldk + h * DQK;
    const bf16_t* vsrc = Vp + (rowbase + 16 * (wid & 3) + (lane >> 2)) * ldk + h * 64 + (wid >> 2) * 32 + (lane & 3) * 8;
#pragma unroll
    for (int tt = 0; tt < 4; ++tt) ATT_ISSUE(4 * j + tt, tt * BUFB);
    LAS unsigned short* list = (LAS unsigned short*)(lds + 4 * BUFB);
    LAS int* cnt = (LAS int*)(lds + 4 * BUFB + 4096);
    if (tid_ == 0) *cnt = 0;
    __syncthreads();
    const int nsrc = (shi - slo) * 256;
    for (int i = tid_; i < nsrc; i += NTHR) {
        const unsigned sm = SEL[(rowbase + (size_t)slo * 256 + i) * 8 + h];
        const bool f = ((sm >> j) & 1u) != 0u;
        const unsigned long long bal = __ballot(f);
        const int rank = __builtin_amdgcn_mbcnt_hi((unsigned)(bal >> 32), __builtin_amdgcn_mbcnt_lo((unsigned)bal, 0u));
        int base = 0;
        if (lane == 0) base = __hip_atomic_fetch_add(cnt, (int)__builtin_popcountll(bal), __ATOMIC_RELAXED, __HIP_MEMORY_SCOPE_WORKGROUP);
        base = __builtin_amdgcn_readfirstlane(base);
        if (f) list[base + rank] = (unsigned short)i;
    }
    asm volatile("s_waitcnt vmcnt(0)" ::: "memory");
    __syncthreads();
    const int n = *cnt, nch = (n + 31) >> 5;
    const float slope2 = exp2f(-(float)(h + 1)) * LOG2E;
    const int kfo = hi * 1024 + r32 * 16;
    const int vfo = KBYTES + ((lane >> 4) & 1) * 32 + (lane & 3) * 8 + (4 * hi + ((lane & 15) >> 2)) * 64;
    for (int ch = wid; ch < nch; ch += 8) {
        const int e = ch * 32 + r32; const bool valid = e < n;
        const int tq = slo * 256 + (int)list[valid ? e : n - 1];
        bf16x8 qf[4];
        { const bf16_t* qrow = Qp + (rowbase + tq) * INCP + h * DQK + hi * 8;
#pragma unroll
          for (int d0 = 0; d0 < 4; ++d0) qf[d0] = *(const bf16x8*)(qrow + d0 * 16); }
        const unsigned sm = SEL[(rowbase + tq) * 8 + h];
        float m = -1e30f, l = 0.f;
        f32x16 o0, o1;
#pragma unroll
        for (int r = 0; r < 16; ++r) { o0[r] = 0.f; o1[r] = 0.f; }
#pragma unroll 1
        for (int tt = 0; tt < 4; ++tt) attn_tile<64, true>(lds + tt * BUFB, kfo, vfo, qf, m, l, o0, o1, hi, tq, 256 * j + 64 * tt, slope2, false);
        const float lt = xhalf_sum(l), inv = 1.f / lt;
        if (valid) {
            const size_t pidx = ((rowbase + tq) * 8 + h) * 3 + __builtin_popcount(sm & ((1u << j) - 1u));
            if (hi == 0) PML[pidx * 16] = (f32x2){m, lt};
            bf16_t* po = PO + pidx * 64 + 4 * hi;
#pragma unroll
            for (int r4 = 0; r4 < 4; ++r4) {
                u32x2 w0_, w1_;
                w0_.x = pg8::cvt_pk_bf16(o0[4 * r4] * inv, o0[4 * r4 + 1] * inv); w0_.y = pg8::cvt_pk_bf16(o0[4 * r4 + 2] * inv, o0[4 * r4 + 3] * inv);
                w1_.x = pg8::cvt_pk_bf16(o1[4 * r4] * inv, o1[4 * r4 + 1] * inv); w1_.y = pg8::cvt_pk_bf16(o1[4 * r4 + 2] * inv, o1[4 * r4 + 3] * inv);
                *(u32x2*)(po + 8 * r4) = w0_; *(u32x2*)(po + 32 + 8 * r4) = w1_;
            }
        }
    }
    __syncthreads();
}
#undef ATT_ISSUE
__device__ __forceinline__ void mla_phase(const Frame& F, const bf16_t* QB, const bf16_t* KB, const bf16_t* VB, bf16_t* Op) {
    for (int u = 2 * F.vcu; u < 512; u += 2 * F.G) {
#pragma unroll 1
        for (int k = 0; k < 2; ++k) { const int uu = u + k, bh = uu >> 5, w = uu & 31, qb = (w & 1) ? (w >> 1) : 31 - (w >> 1);
            attn_unit<96, false>(F.lds, bh >> 3, bh & 7, qb, QB, 768, KB, 768, VB, 512, Op, 1024, nullptr, nullptr); }
    }
}
__device__ __forceinline__ void moba_sel_phase(const Frame& F, const bf16_t* PROJ, const unsigned* SEL, bf16_t* PO, f32x2* PML) {
#pragma unroll 1
    for (int u = (int)blockIdx.x; u < 16 * 136; u += F.G) {
        int p = 0; while (16 * (2 * (p + 1) * (p + 1) + (p + 1)) <= u) ++p;
        const int r = u - 16 * (2 * p * p + p), j = r >> 4, bh = r & 15;
        const int slo = (j + 1 > 4 * p) ? j + 1 : 4 * p, shi = 4 * p + 4;
        moba_sel_unit(F.lds, bh >> 3, bh & 7, j, slo, shi, PROJ + C_QA, PROJ + C_KA, PROJ + C_VA, INCP, SEL, PO, PML);
    }
}
__device__ __forceinline__ void moba_own_phase(const Frame& F, const bf16_t* PROJ, bf16_t* Op, const bf16_t* PO, const f32x2* PML) {
#pragma unroll 1
    for (int u = F.vcu; u < 512; u += F.G) { const int bh = u >> 5, qb = u & 31;
        attn_unit<64, true>(F.lds, bh >> 3, bh & 7, qb, PROJ + C_QA, INCP, PROJ + C_KA, INCP, PROJ + C_VA, INCP, Op, 1024, PO, PML); }
}

constexpr int NPH_L = 16;
__global__ void __launch_bounds__(NTHR, 2) mk(Params p) {
    extern __shared__ __attribute__((aligned(16))) unsigned char lds_raw[];
    Frame F;
    F.lds = (LAS unsigned char*)lds_raw;
    F.tid = threadIdx.x; F.lane = F.tid & 63; F.wave = __builtin_amdgcn_readfirstlane(F.tid >> 6);
    F.G = gridDim.x; { const int bx = blockIdx.x; F.vcu = (F.G % 8 == 0) ? (bx % 8) * (F.G / 8) + bx / 8 : bx; }
    volatile LAS unsigned* MISC = (volatile LAS unsigned*)(F.lds + MISC_OFF);
    if (F.tid < 32) MISC[F.tid] = 0u;
    __syncthreads();
    unsigned char* ws = p.ws;
    unsigned* ctl = (unsigned*)(ws + WS_CTL);
    XcdBarrier bar = xcd_barrier_post(ctl + CW_BAR, MISC + 8);
    const int lo = p.ph_lo, hi = p.ph_hi;
#define IN(k) (lo <= (k) && (k) < hi)
#define SEAM(k) do { if (IN(k) && IN((k) + 1)) xcd_barrier(bar); } while (0)
    bf16_t* WinT = (bf16_t*)(ws + WS_WIN);
    bf16_t* XB = (bf16_t*)(ws + WS_XB);
    bf16_t* PROJ = (bf16_t*)(ws + WS_PROJ);
    bf16_t* WuqT = (bf16_t*)(ws + WS_WUQ); bf16_t* WukvT = (bf16_t*)(ws + WS_WUKV);
    f32x2* CS = (f32x2*)(ws + WS_CS); float* KM = (float*)(ws + WS_KM); unsigned* SEL = (unsigned*)(ws + WS_SEL);
    bf16_t* CQN = (bf16_t*)(ws + WS_CQN); bf16_t* CKVN = (bf16_t*)(ws + WS_CKVN);
    bf16_t* WpaT = (bf16_t*)(ws + WS_WPA); bf16_t* WpbT = (bf16_t*)(ws + WS_WPB); bf16_t* WoutT = (bf16_t*)(ws + WS_WOUT);
    bf16_t* TMP = (bf16_t*)(ws + WS_TMP); bf16_t* MRG = (bf16_t*)(ws + WS_MRG); bf16_t* PRE = (bf16_t*)(ws + WS_PRE); bf16_t* X1B = (bf16_t*)(ws + WS_X1B);
    bf16_t* WrtT = (bf16_t*)(ws + WS_WRT); bf16_t* WsguT = (bf16_t*)(ws + WS_WSGU); bf16_t* WsdT = (bf16_t*)(ws + WS_WSD); bf16_t* WeguT = (bf16_t*)(ws + WS_WEGU); bf16_t* WedT = (bf16_t*)(ws + WS_WED);
    float* LOGITS = (float*)(ws + WS_LOG); bf16_t* HS = (bf16_t*)(ws + WS_HS); bf16_t* SH = (bf16_t*)(ws + WS_SH);
    int* TOPE = (int*)(ws + WS_TOPE); float* TOPW = (float*)(ws + WS_TOPW); int* APOS = (int*)(ws + WS_APOS); int* ROWA = (int*)(ws + WS_ROWA);
    bf16_t* PO = (bf16_t*)(ws + WS_PO); f32x2* PML = (f32x2*)(ws + WS_PML);
    bf16_t* HE = (bf16_t*)(ws + WS_HE); bf16_t* Yb = (bf16_t*)(ws + WS_Y); int* HIST = (int*)(ws + WS_HIST);
    LAS int* t_off = (LAS int*)(F.lds + TAB_OFF); LAS int* t_toff = t_off + 260;
    bf16_t* QB = (bf16_t*)(ws + WS_QB); bf16_t* KB = (bf16_t*)(ws + WS_KB); bf16_t* VB = (bf16_t*)(ws + WS_VB); bf16_t* OAB = (bf16_t*)(ws + WS_OAB);
    const int gw = F.vcu * NWAVES + F.wave, NGW = F.G * NWAVES;

    if (IN(0)) {
        LAS float* scr = (LAS float*)(F.lds + F.wave * 16384);
        constexpr int I_IN = (DM / 64) * (INC / 32);
        for (int it = gw; it < DEPTH * I_IN; it += NGW) { const int l = it / I_IN, r = it % I_IN;
            transpose_item(p.in[1] + (size_t)l * DM * INC, DM, INC, WinT + (size_t)l * SZ_WIN, DM, RowId{}, scr, r, F.lane); }
        { constexpr int I_UQ = (QL / 64) * (768 / 32), I_UKV = (KVL / 64) * (1024 / 32);
          for (int it = gw; it < DEPTH * (I_UQ + I_UKV); it += NGW) { const int l = it / (I_UQ + I_UKV), r = it % (I_UQ + I_UKV);
            if (r < I_UQ) transpose_item(p.in[4] + (size_t)l * QL * 768, QL, 768, WuqT + (size_t)l * SZ_WUQ, QL, RowQ{}, scr, r, F.lane);
            else transpose_item(p.in[6] + (size_t)l * KVL * 1024, KVL, 1024, WukvT + (size_t)l * SZ_WUKV, KVL, RowId{}, scr, r - I_UQ, F.lane); } }
        { constexpr int I_P = (512 / 64) * (DM / 32), I_O = (DM / 64) * (DM / 32), I_ALL = 2 * I_P + I_O;
          for (int it = gw; it < DEPTH * I_ALL; it += NGW) { const int l = it / I_ALL; int r = it % I_ALL;
            if (r < I_P) { transpose_item(p.in[7] + (size_t)l * 512 * DM, 512, DM, WpaT + (size_t)l * 2 * SZ_WP, 1024, RowId{}, scr, r, F.lane); continue; } r -= I_P;
            if (r < I_P) { transpose_item(p.in[8] + (size_t)l * 512 * DM, 512, DM, WpaT + (size_t)l * 2 * SZ_WP + 512, 1024, RowId{}, scr, r, F.lane); continue; } r -= I_P;
            transpose_item(p.in[9] + (size_t)l * DM * DM, DM, DM, WoutT + (size_t)l * SZ_WOUT, DM, RowId{}, scr, r, F.lane); } }
        { constexpr int I_R = (DM / 64) * (NE / 32), I_G = (DM / 64) * (DSH / 32), I_D = (DSH / 64) * (DM / 32), I_ALL = I_R + 2 * I_G + I_D;
          for (int it = gw; it < DEPTH * I_ALL; it += NGW) { const int l = it / I_ALL; int r = it % I_ALL;
            if (r < I_R) { transpose_item(p.in[12] + (size_t)l * DM * NE, DM, NE, WrtT + (size_t)l * SZ_WRT, DM, RowId{}, scr, r, F.lane); continue; } r -= I_R;
            if (r < I_G) { transpose_item(p.in[17] + (size_t)l * DM * DSH, DM, DSH, WsguT + (size_t)l * SZ_WSGU, DM, RowGU{0}, scr, r, F.lane); continue; } r -= I_G;
            if (r < I_G) { transpose_item(p.in[18] + (size_t)l * DM * DSH, DM, DSH, WsguT + (size_t)l * SZ_WSGU, DM, RowGU{128}, scr, r, F.lane); continue; } r -= I_G;
            transpose_item(p.in[19] + (size_t)l * DSH * DM, DSH, DM, WsdT + (size_t)l * SZ_WSD, DSH, RowId{}, scr, r, F.lane); } }
        { constexpr int I_G = (DM / 64) * (DE / 64), I_D = (DE / 64) * (DM / 64), I_E = 2 * I_G + I_D;
          LAS unsigned short* scr16 = (LAS unsigned short*)(F.lds + F.wave * 16384);
          for (int it = gw; it < DEPTH * NE * I_E; it += NGW) { const int le = it / I_E; int r = it % I_E;
            if (r < I_G) { transpose_item64(p.in[14] + (size_t)le * DM * DE, DM, DE, WeguT + (size_t)le * 512 * DM, DM, RowGU{0}, scr16, r, F.lane); continue; } r -= I_G;
            if (r < I_G) { transpose_item64(p.in[15] + (size_t)le * DM * DE, DM, DE, WeguT + (size_t)le * 512 * DM, DM, RowGU{128}, scr16, r, F.lane); continue; } r -= I_G;
            transpose_item64(p.in[16] + (size_t)le * DE * DM, DE, DM, WedT + (size_t)le * DM * DE, DE, RowPermD{}, scr16, r, F.lane); } }
        for (int i = blockIdx.x * NTHR + F.tid; i < SEQ * 16; i += F.G * NTHR) { const int pos = i >> 4, k = i & 15;
            const float inv = powf(10000.f, -(float)(2 * k) / 32.f), ang = (float)pos * inv; CS[i] = (f32x2){cosf(ang), sinf(ang)}; }
        for (int i = blockIdx.x * NTHR + F.tid; i < DEPTH * 12288; i += F.G * NTHR) { const int l = i / 12288, r = i % 12288;
            *(u32x4*)(WinT + (size_t)l * SZ_WIN + (size_t)INC * DM + (size_t)r * 8) = (u32x4){0u, 0u, 0u, 0u}; }
        for (int i = blockIdx.x * NTHR + F.tid; i < T * DM / 8; i += F.G * NTHR) { const f32x4 a = *(const f32x4*)(p.in[0] + (size_t)i * 8), b = *(const f32x4*)(p.in[0] + (size_t)i * 8 + 4);
            u32x4 w; w.x = pk2(a[0], a[1]); w.y = pk2(a[2], a[3]); w.z = pk2(b[0], b[1]); w.w = pk2(b[2], b[3]); *(u32x4*)(XB + (size_t)i * 8) = w; }
    }
    SEAM(0);

    {
        const int l = 0; const int pb = 1 + l * NPH_L;
        if (IN(pb + 0)) {
            pg8::Gemm g{XB, WinT + (size_t)l * SZ_WIN, T, INCP, DM, DM, DM}; pg8::StaticOrder S; S.init(T, INCP - 256, F.G, (int)blockIdx.x);
            EpiProj E{PROJ, p.in[2] + (size_t)l * 2 * DM};
            pg8::gemm_phase<EpiProj, pg8::StaticOrder, true>(F.lds, g, S, E);
        }
        SEAM(pb + 0);
        if (IN(pb + 1)) prep_phase(F, PROJ, p.in[3] + (size_t)l * QL, p.in[5] + (size_t)l * KVL, CS, CQN, CKVN, KB, KM);
        SEAM(pb + 1);
        if (IN(pb + 2)) {
            mobasel_phase(F, PROJ, KM, SEL);
            { pg8::Gemm g{CKVN, WukvT + (size_t)l * SZ_WUKV, T, 1024, KVL, KVL, KVL}; pg8::StaticOrder S; S.init(T, 1024, F.G, (int)blockIdx.x);
              EpiKV E{KB, VB}; pg8::gemm_phase<EpiKV, pg8::StaticOrder, true>(F.lds, g, S, E); }
            { pg8::Gemm g{CQN, WuqT + (size_t)l * SZ_WUQ, T, 768, QL, QL, QL}; pg8::StaticOrder S; S.init(T, 768, F.G, (int)blockIdx.x);
              EpiQ E{QB, CS}; pg8::gemm_phase<EpiQ, pg8::StaticOrder, true>(F.lds, g, S, E); }
            { pg8::Gemm g{XB, WinT + (size_t)l * SZ_WIN, T, INCP, DM, DM, DM}; pg8::OffsetOrder S; S.init(T, 256, F.G, (int)((blockIdx.x + 64) % F.G)); S.pn0 = 16;
              EpiProj E{PROJ, p.in[2] + (size_t)l * 2 * DM}; pg8::gemm_phase<EpiProj, pg8::OffsetOrder, true>(F.lds, g, S, E); }
        }
        SEAM(pb + 2);
        if (IN(pb + 3)) {
            mla_phase(F, QB, KB, VB, OAB + 512);
            moba_sel_phase(F, PROJ, SEL, PO, PML);
        }
        SEAM(pb + 3);
        if (IN(pb + 4)) moba_own_phase(F, PROJ, OAB, PO, PML);
        SEAM(pb + 4);
        if (IN(pb + 5)) {
            pg8::Gemm g{OAB, WpaT + (size_t)l * 2 * SZ_WP, T, DM, DM, 1024, 1024}; pg8::StaticOrder S; S.init(T, DM, F.G, (int)blockIdx.x);
            EpiGate2 E{PROJ, MRG}; pg8::gemm_phase<EpiGate2, pg8::StaticOrder, true>(F.lds, g, S, E);
        }
        SEAM(pb + 5);
        if (IN(pb + 6)) {
            pg8::Gemm g{MRG, WoutT + (size_t)l * SZ_WOUT, T, DM, DM, DM, DM}; pg8::StaticOrder S; S.init(T, DM, F.G, (int)blockIdx.x);
            EpiResid E{XB, PRE}; pg8::gemm_phase<EpiResid, pg8::StaticOrder, true>(F.lds, g, S, E);
        }
        SEAM(pb + 6);
        if (IN(pb + 7)) ln_phase(F, PRE, p.in[10] + (size_t)l * DM, p.in[11] + (size_t)l * DM, X1B);
        SEAM(pb + 7);
        if (IN(pb + 8)) {
            { pg8::Gemm g{X1B, WrtT + (size_t)l * SZ_WRT, T, NE, DM, DM, DM}; pg8::StaticOrder S; S.init(T, NE, F.G, (int)blockIdx.x);
              EpiF32 E{LOGITS, NE}; pg8::gemm_phase<EpiF32, pg8::StaticOrder, true>(F.lds, g, S, E); }
            { pg8::Gemm g{X1B, WsguT + (size_t)l * SZ_WSGU, T, 512, DM, DM, DM}; pg8::StaticOrder S; S.init(T, 512, F.G, (int)((blockIdx.x + F.G / 2) % F.G));
              EpiSwiGLU E{HS, DSH}; pg8::gemm_phase<EpiSwiGLU, pg8::StaticOrder, true>(F.lds, g, S, E); }
        }
        SEAM(pb + 8);
        if (IN(pb + 9)) {
            route_phase(F, LOGITS, p.in[13] + (size_t)l * NE, TOPE, TOPW, APOS, HIST, t_off);
            pg8::Gemm g{HS, WsdT + (size_t)l * SZ_WSD, T, DM, DSH, DSH, DSH}; pg8::StaticOrder S; S.init(T, DM, F.G, (int)blockIdx.x);
            EpiBf16 E{SH, DM}; pg8::gemm_phase<EpiBf16, pg8::StaticOrder, true>(F.lds, g, S, E);
        }
        SEAM(pb + 9);
        if (IN(pb + 10)) {
            int tid_ = F.tid; asm volatile("" : "+v"(tid_));
            if (tid_ < 256) { int tot = 0, base = 0; for (int c = 0; c < F.G; ++c) { const int v = HIST[(size_t)c * 256 + tid_]; base += (c < (int)blockIdx.x) ? v : 0; tot += v; }
                t_off[tid_] = tot; t_toff[tid_] = base; if (blockIdx.x == 0) ctl[CW_CNT + l * 256 + tid_] = (unsigned)tot; }
            __syncthreads();
            if (tid_ == 0) { int a = 0; for (int i = 0; i < 256; ++i) { const int c = t_off[i]; t_off[i] = a; a += c; } }
            __syncthreads();
            const int TPW = T / F.G, a0 = (int)blockIdx.x * TPW * TOPK;
            for (int a = a0 + tid_; a < a0 + TPW * TOPK; a += NTHR) { const int e = TOPE[a]; const int row = t_off[e] + t_toff[e] + APOS[a]; *(u32x2*)(ROWA + 2 * (size_t)row) = (u32x2){(unsigned)a, 0u}; APOS[a] = row; }
            __syncthreads();
        }
        SEAM(pb + 10);
        if (IN(pb + 11)) {
            expert_tables(F, ctl + CW_CNT + l * 256, t_off, t_toff);
            pg8::Gemm g{X1B, WeguT + (size_t)l * SZ_WEGU, T, 512, DM, DM, DM};
            ExpertOrder<2, true> S{t_off, t_toff, ROWA, F.G, F.vcu, (size_t)512 * DM * 2};
            EpiSwiGLU E{HE, DE}; pg8::gemm_phase<EpiSwiGLU, ExpertOrder<2, true>, true>(F.lds, g, S, E);
        }
        SEAM(pb + 11);
        if (IN(pb + 12)) {
            expert_tables(F, ctl + CW_CNT + l * 256, t_off, t_toff);
            pg8::Gemm g{HE, WedT + (size_t)l * SZ_WED, NA, DM, DE, DE, DE};
            ExpertOrder<4, false> S{t_off, t_toff, ROWA, F.G, F.vcu, (size_t)DM * DE * 2};
            EpiExpDown E{(unsigned char*)Yb}; pg8::gemm_phase<EpiExpDown, ExpertOrder<4, false>, true>(F.lds, g, S, E);
        }
        SEAM(pb + 12);
        if (IN(pb + 13)) combine_phase(F, X1B, SH, (const unsigned char*)Yb, APOS, TOPW, p.in[20] + (size_t)l * DM, p.in[21] + (size_t)l * DM, l == DEPTH - 1 ? p.out : (float*)nullptr, l == DEPTH - 1 ? (bf16_t*)nullptr : XB);
        SEAM(pb + 13);
    }

    {
        const int l = 1; const int pb = 1 + l * NPH_L;
        if (IN(pb + 0)) {
            pg8::Gemm g{XB, WinT + (size_t)l * SZ_WIN, T, INCP, DM, DM, DM}; pg8::StaticOrder S; S.init(T, INCP - 256, F.G, (int)blockIdx.x);
            EpiProj E{PROJ, p.in[2] + (size_t)l * 2 * DM};
            pg8::gemm_phase<EpiProj, pg8::StaticOrder, true>(F.lds, g, S, E);
        }
        SEAM(pb + 0);
        if (IN(pb + 1)) prep_phase(F, PROJ, p.in[3] + (size_t)l * QL, p.in[5] + (size_t)l * KVL, CS, CQN, CKVN, KB, KM);
        SEAM(pb + 1);
        if (IN(pb + 2)) {
            mobasel_phase(F, PROJ, KM, SEL);
            { pg8::Gemm g{CKVN, WukvT + (size_t)l * SZ_WUKV, T, 1024, KVL, KVL, KVL}; pg8::StaticOrder S; S.init(T, 1024, F.G, (int)blockIdx.x);
              EpiKV E{KB, VB}; pg8::gemm_phase<EpiKV, pg8::StaticOrder, true>(F.lds, g, S, E); }
            { pg8::Gemm g{CQN, WuqT + (size_t)l * SZ_WUQ, T, 768, QL, QL, QL}; pg8::StaticOrder S; S.init(T, 768, F.G, (int)blockIdx.x);
              EpiQ E{QB, CS}; pg8::gemm_phase<EpiQ, pg8::StaticOrder, true>(F.lds, g, S, E); }
            { pg8::Gemm g{XB, WinT + (size_t)l * SZ_WIN, T, INCP, DM, DM, DM}; pg8::OffsetOrder S; S.init(T, 256, F.G, (int)((blockIdx.x + 64) % F.G)); S.pn0 = 16;
              EpiProj E{PROJ, p.in[2] + (size_t)l * 2 * DM}; pg8::gemm_phase<EpiProj, pg8::OffsetOrder, true>(F.lds, g, S, E); }
        }
        SEAM(pb + 2);
        if (IN(pb + 3)) {
            mla_phase(F, QB, KB, VB, OAB + 512);
            moba_sel_phase(F, PROJ, SEL, PO, PML);
        }
        SEAM(pb + 3);
        if (IN(pb + 4)) moba_own_phase(F, PROJ, OAB, PO, PML);
        SEAM(pb + 4);
        if (IN(pb + 5)) {
            pg8::Gemm g{OAB, WpaT + (size_t)l * 2 * SZ_WP, T, DM, DM, 1024, 1024}; pg8::StaticOrder S; S.init(T, DM, F.G, (int)blockIdx.x);
            EpiGate2 E{PROJ, MRG}; pg8::gemm_phase<EpiGate2, pg8::StaticOrder, true>(F.lds, g, S, E);
        }
        SEAM(pb + 5);
        if (IN(pb + 6)) {
            pg8::Gemm g{MRG, WoutT + (size_t)l * SZ_WOUT, T, DM, DM, DM, DM}; pg8::StaticOrder S; S.init(T, DM, F.G, (int)blockIdx.x);
            EpiResid E{XB, PRE}; pg8::gemm_phase<EpiResid, pg8::StaticOrder, true>(F.lds, g, S, E);
        }
        SEAM(pb + 6);
        if (IN(pb + 7)) ln_phase(F, PRE, p.in[10] + (size_t)l * DM, p.in[11] + (size_t)l * DM, X1B);
        SEAM(pb + 7);
        if (IN(pb + 8)) {
            { pg8::Gemm g{X1B, WrtT + (size_t)l * SZ_WRT, T, NE, DM, DM, DM}; pg8::StaticOrder S; S.init(T, NE, F.G, (int)blockIdx.x);
              EpiF32 E{LOGITS, NE}; pg8::gemm_phase<EpiF32, pg8::StaticOrder, true>(F.lds, g, S, E); }
            { pg8::Gemm g{X1B, WsguT + (size_t)l * SZ_WSGU, T, 512, DM, DM, DM}; pg8::StaticOrder S; S.init(T, 512, F.G, (int)((blockIdx.x + F.G / 2) % F.G));
              EpiSwiGLU E{HS, DSH}; pg8::gemm_phase<EpiSwiGLU, pg8::StaticOrder, true>(F.lds, g, S, E); }
        }
        SEAM(pb + 8);
        if (IN(pb + 9)) {
            route_phase(F, LOGITS, p.in[13] + (size_t)l * NE, TOPE, TOPW, APOS, HIST, t_off);
            pg8::Gemm g{HS, WsdT + (size_t)l * SZ_WSD, T, DM, DSH, DSH, DSH}; pg8::StaticOrder S; S.init(T, DM, F.G, (int)blockIdx.x);
            EpiBf16 E{SH, DM}; pg8::gemm_phase<EpiBf16, pg8::StaticOrder, true>(F.lds, g, S, E);
        }
        SEAM(pb + 9);
        if (IN(pb + 10)) {
            int tid_ = F.tid; asm volatile("" : "+v"(tid_));
            if (tid_ < 256) { int tot = 0, base = 0; for (int c = 0; c < F.G; ++c) { const int v = HIST[(size_t)c * 256 + tid_]; base += (c < (int)blockIdx.x) ? v : 0; tot += v; }
                t_off[tid_] = tot; t_toff[tid_] = base; if (blockIdx.x == 0) ctl[CW_CNT + l * 256 + tid_] = (unsigned)tot; }
            __syncthreads();
            if (tid_ == 0) { int a = 0; for (int i = 0; i < 256; ++i) { const int c = t_off[i]; t_off[i] = a; a += c; } }
            __syncthreads();
            const int TPW = T / F.G, a0 = (int)blockIdx.x * TPW * TOPK;
            for (int a = a0 + tid_; a < a0 + TPW * TOPK; a += NTHR) { const int e = TOPE[a]; const int row = t_off[e] + t_toff[e] + APOS[a]; *(u32x2*)(ROWA + 2 * (size_t)row) = (u32x2){(unsigned)a, 0u}; APOS[a] = row; }
            __syncthreads();
        }
        SEAM(pb + 10);
        if (IN(pb + 11)) {
            expert_tables(F, ctl + CW_CNT + l * 256, t_off, t_toff);
            pg8::Gemm g{X1B, WeguT + (size_t)l * SZ_WEGU, T, 512, DM, DM, DM};
            ExpertOrder<2, true> S{t_off, t_toff, ROWA, F.G, F.vcu, (size_t)512 * DM * 2};
            EpiSwiGLU E{HE, DE}; pg8::gemm_phase<EpiSwiGLU, ExpertOrder<2, true>, true>(F.lds, g, S, E);
        }
        SEAM(pb + 11);
        if (IN(pb + 12)) {
            expert_tables(F, ctl + CW_CNT + l * 256, t_off, t_toff);
            pg8::Gemm g{HE, WedT + (size_t)l * SZ_WED, NA, DM, DE, DE, DE};
            ExpertOrder<4, false> S{t_off, t_toff, ROWA, F.G, F.vcu, (size_t)DM * DE * 2};
            EpiExpDown E{(unsigned char*)Yb}; pg8::gemm_phase<EpiExpDown, ExpertOrder<4, false>, true>(F.lds, g, S, E);
        }
        SEAM(pb + 12);
        if (IN(pb + 13)) combine_phase(F, X1B, SH, (const unsigned char*)Yb, APOS, TOPW, p.in[20] + (size_t)l * DM, p.in[21] + (size_t)l * DM, l == DEPTH - 1 ? p.out : (float*)nullptr, l == DEPTH - 1 ? (bf16_t*)nullptr : XB);
        SEAM(pb + 13);
    }

#undef IN
#undef SEAM
}

__global__ void __launch_bounds__(256) cvt_proj(const bf16_t* __restrict__ P, float* proj) {
    const size_t i = (size_t)blockIdx.x * 256 + threadIdx.x;
    const int row = (int)(i / INC), c = (int)(i % INC);
    float v = bf2f(P[(size_t)row * INCP + c]);
    if (c < C_KA) v *= (1.f / QS_A);
    proj[i] = v;
}
__global__ void __launch_bounds__(256) cvt_oab(const bf16_t* __restrict__ OAB, float* oa, float* ob) {
    const size_t i = (size_t)blockIdx.x * 256 + threadIdx.x; const size_t row = i >> 10; const int c = (int)(i & 1023);
    const float v = bf2f(OAB[i]);
    if (c < 512) oa[row * 512 + c] = v; else ob[row * 512 + c - 512] = v;
}
__global__ void __launch_bounds__(256) cvt_x(const float* __restrict__ x, bf16_t* XB) {
    const size_t i = (size_t)blockIdx.x * 256 + threadIdx.x;
    const f32x4 a = *(const f32x4*)(x + i * 8), b = *(const f32x4*)(x + i * 8 + 4);
    u32x4 w; w.x = pk2(a[0], a[1]); w.y = pk2(a[2], a[3]); w.z = pk2(b[0], b[1]); w.w = pk2(b[2], b[3]); *(u32x4*)(XB + i * 8) = w;
}
}
static int g_grid = 0;
static bool fast_setup() {
    if (g_grid) return g_grid > 0;
    int dev = 0, cus = 0, per_cu = 0;
    if (hipGetDevice(&dev) != hipSuccess || hipDeviceGetAttribute(&cus, hipDeviceAttributeMultiprocessorCount, dev) != hipSuccess) { g_grid = -1; return false; }
    if (hipFuncSetAttribute((const void*)fk::mk, hipFuncAttributeMaxDynamicSharedMemorySize, fk::LDS_BYTES) != hipSuccess) { fprintf(stderr, "hipFuncSetAttribute failed\n"); g_grid = -1; return false; }
    if (hipOccupancyMaxActiveBlocksPerMultiprocessor(&per_cu, (const void*)fk::mk, fk::NTHR, fk::LDS_BYTES) != hipSuccess || per_cu < 1) { fprintf(stderr, "occupancy query: %d\n", per_cu); }
    (void)hipGetLastError();
    g_grid = cus;
    if (cus > 1024 || T % cus != 0 || (T / cus) > 64) { fprintf(stderr, "unsupported CU count %d\n", cus); g_grid = -1; return false; }
    return true;
}
static void launch_mk(fk::Params& p, int lo, int hi, hipStream_t stream) {
    p.ph_lo = lo; p.ph_hi = hi;
    hipLaunchKernelGGL(fk::mk, dim3(g_grid), dim3(fk::NTHR), fk::LDS_BYTES, stream, p);
}

extern "C" void kernel_launch(void* const* d_in, const int* in_sizes, int n_in, void* d_out, int out_size, void* d_ws, size_t ws_size, hipStream_t stream) {
    if (!fast_setup()) return;
    if (ws_size < fk::WS_NEED) { fprintf(stderr, "workspace too small: need %zu have %zu\n", (size_t)fk::WS_NEED, ws_size); return; }
    (void)hipMemsetAsync((char*)d_ws + fk::WS_CTL, 0, fk::CTL_BYTES, stream);
    fk::Params P{};
    for (int i = 0; i < 22; ++i) P.in[i] = (const float*)d_in[i];
    P.out = (float*)d_out; P.ws = (unsigned char*)d_ws;
#if MK_ONE_LAUNCH
    launch_mk(P, 0, 1 + DEPTH * fk::NPH_L, stream);
#else
    launch_mk(P, 0, 1, stream);
    for (int l = 0; l < DEPTH; ++l) for (int k = 0; k < 14; ++k) launch_mk(P, 1 + l * fk::NPH_L + k, 2 + l * fk::NPH_L + k, stream);
#endif
}
```

```cpp
#ifndef MK_ONE_LAUNCH
#define MK_ONE_LAUNCH 1
#endif
#include <hip/hip_runtime.h>
#include <cstdint>
#include <cstdio>

constexpr int NB = 2, SEQ = 8192, T = NB * SEQ, DM = 1024, DEPTH = 2;
constexpr int HA = 8, WA = 512, BLK = 256, NBLK = SEQ / BLK;
constexpr int HB = 8, DN = 64, DR = 32, DV = 64, QL = 384, KVL = 256;
constexpr int INC = 3 * WA + QL + KVL + DR + 2 * DM;
constexpr int C_QA = 0, C_KA = 512, C_VA = 1024, C_CQ = 1536, C_CKV = 1920, C_KR = 2176, C_GA = 2208, C_GB = 3232;
constexpr int NE = 256, TOPK = 8, DE = 256, DSH = 256;
constexpr int NA = T * TOPK;
constexpr float ALPHA = 1.4142135623730951f;
constexpr float LN_EPS = 1e-5f, RMS_EPS = 1e-6f;


namespace fk {
#define LAS __attribute__((address_space(3)))
#define GAS __attribute__((address_space(1)))
typedef unsigned short bf16_t;
typedef short bf16x8 __attribute__((ext_vector_type(8)));
typedef float f32x4 __attribute__((ext_vector_type(4)));
typedef float f32x2 __attribute__((ext_vector_type(2)));
typedef float f32x16 __attribute__((ext_vector_type(16)));
typedef unsigned u32x4 __attribute__((ext_vector_type(4)));
typedef unsigned u32x2 __attribute__((ext_vector_type(2)));
constexpr int NWAVES = 8, NTHR = 512;
constexpr int INCP = 4352;
constexpr float LOG2E = 1.4426950408889634f;
constexpr float QS_A = 0.125f * LOG2E;
constexpr float QS_B = 0.10206207261596577f * LOG2E;
#define LDS_WAIT() asm volatile("s_waitcnt lgkmcnt(0)" ::: "memory")
#define VM_WAIT() asm volatile("s_waitcnt vmcnt(0)" ::: "memory")
__device__ __forceinline__ unsigned f2bf(float f) { unsigned u = __builtin_bit_cast(unsigned, f); return (u + 0x7fffu + ((u >> 16) & 1u)) >> 16; }
__device__ __forceinline__ unsigned pk2(float lo, float hi) { return f2bf(lo) | (f2bf(hi) << 16); }
__device__ __forceinline__ float bf2f(unsigned short b) { return __builtin_bit_cast(float, (unsigned)b << 16); }
__device__ __forceinline__ float bflo(unsigned w) { return __builtin_bit_cast(float, w << 16); }
__device__ __forceinline__ float bfhi(unsigned w) { return __builtin_bit_cast(float, w & 0xffff0000u); }
__device__ __forceinline__ float sigmoidf_(float x) { return __builtin_amdgcn_rcpf(1.f + __expf(-x)); }
__device__ __forceinline__ float wave_sum(float v) {
#pragma unroll
    for (int o = 1; o < 64; o <<= 1) v += __shfl_xor(v, o);
    return v;
}

namespace pg8 {
constexpr int BM = 256, BK = 64, HALF = 128, HTB = HALF * BK * 2, STAGE_BYTES = 8 * HTB, NXCD = 8, WGM = 8;
__host__ __device__ __forceinline__ int lds_byte(int r, int c) { const int st = (r >> 4) * 2 + (c >> 5), rr = r & 15, cc = c & 31, ob = rr * 64 + cc * 2; return st * 1024 + (ob ^ (((ob >> 9) & 1) << 5)); }
__host__ __device__ __forceinline__ void stage_rc(int b, int& R, int& C) { const int st = b / 1024, sb = b % 1024, swz = sb ^ (((sb >> 9) & 1) << 5); R = (st >> 1) * 16 + swz / 64; C = (st & 1) * 32 + (swz % 64) / 2; }
__host__ __device__ __forceinline__ int perm32(int rho) { const int n = rho >> 4, i = rho & 15; return 8 * (i >> 2) + 4 * n + (i & 3); }

struct Unit { int pm, pn, e, r0, rend; };
struct Gemm { const bf16_t* A; const bf16_t* Bt; int M, N, K, lda, ldb; };

struct StaticOrder {
    int nM, nN, nwg, G, c;
    __device__ void init(int M, int N, int G_, int c_) { nM = M / BM; nN = N / BM; nwg = nM * nN; G = G_; c = c_; }
    __device__ bool next(int i, Unit& u) const {
        const long L = (long)i * G + c; if (L >= nwg) return false;
        int wgid = (int)L; { const int q = nwg / NXCD, r = nwg % NXCD, xcd = wgid % NXCD, off = wgid / NXCD; wgid = (xcd < r ? xcd * (q + 1) : r * (q + 1) + (xcd - r) * q) + off; }
        const int nig = WGM * nN, gid = wgid / nig, fm = gid * WGM, gsz = (nM - fm) < WGM ? (nM - fm) : WGM;
        u.pm = fm + ((wgid % nig) % gsz); u.pn = (wgid % nig) / gsz; u.e = 0; u.r0 = u.pm * BM; u.rend = u.r0 + BM; return true;
    }
    __device__ __forceinline__ int a_row(const Unit& u, int r) const { return u.pm * BM + r; }
    __device__ __forceinline__ const char* b_ptr(const Gemm& g, const Unit& u) const { return (const char*)g.Bt + (size_t)u.pn * BM * g.ldb * 2; }
};

struct OffsetOrder : StaticOrder {
    int pn0;
    __device__ bool next(int i, Unit& u) const { const bool ok = StaticOrder::next(i, u); u.pn += pn0; return ok; }
};
typedef float f32x2_t_ __attribute__((ext_vector_type(2))); typedef __bf16 bf16x2_t_ __attribute__((ext_vector_type(2)));
__device__ __forceinline__ unsigned cvt_pk_bf16(float lo, float hi) { const f32x2_t_ v = {lo, hi}; const bf16x2_t_ b = __builtin_convertvector(v, bf16x2_t_); return __builtin_bit_cast(unsigned, b); }

template <class Epi, class Sched, bool ALIGN_EPI>
__device__ __forceinline__ void gemm_phase(LAS unsigned char* lds, const Gemm g, const Sched& S, const Epi& E) {
    int tid_ = threadIdx.x; asm volatile("" : "+v"(tid_));
    const int tid = tid_, wid = __builtin_amdgcn_readfirstlane(tid >> 6), lane = tid & 63, wr = wid >> 2, wc = wid & 3, fr = lane & 15, fq = lane >> 4;
    const int K = g.K, nt = K / BK;
    int RA[2]; unsigned CA[2], voffB[2];
#pragma unroll
    for (int i = 0; i < 2; ++i) { int R, C; stage_rc(tid * 16 + i * 8192, R, C); const int Rb = (R & ~31) + perm32(R & 31);
        RA[i] = R; CA[i] = (unsigned)C * 2u; voffB[i] = (unsigned)(Rb * g.ldb + C) * 2u; }
    const unsigned lda2 = (unsigned)g.lda * 2u;
    const size_t hstepB = (size_t)HALF * g.ldb * 2;
    const unsigned ldsw = (unsigned)wid * 1024u;
    const int aoff = lds_byte(wr * 64 + fr, fq * 8), boff = lds_byte(wc * 32 + fr, fq * 8);
    const char* const Abase = (const char*)g.A;
#define PG8_SA(b, h) (((b) * 2 + (h)) * HTB)
#define PG8_SB(b, h) ((4 + (b) * 2 + (h)) * HTB)
#define PG8_STAGE_B(bufoff, gbase) do { _Pragma("unroll") for (int _i = 0; _i < 2; ++_i) \
        __builtin_amdgcn_global_load_lds((const unsigned*)((const char*)(gbase) + voffB[_i]), (LAS unsigned*)(lds + (bufoff) + ldsw + _i * 8192), 16, 0, 0); } while (0)
#define PG8_STAGE_A(bufoff, V0, V1, kb) do { \
        __builtin_amdgcn_global_load_lds((const unsigned*)((Abase + (kb)) + (V0)), (LAS unsigned*)(lds + (bufoff) + ldsw), 16, 0, 0); \
        __builtin_amdgcn_global_load_lds((const unsigned*)((Abase + (kb)) + (V1)), (LAS unsigned*)(lds + (bufoff) + ldsw + 8192), 16, 0, 0); } while (0)
#define PG8_LDA(dst, b, h) do { _Pragma("unroll") for (int m = 0; m < 4; ++m) _Pragma("unroll") for (int k = 0; k < 2; ++k) dst[m][k] = *(const LAS bf16x8*)(lds + PG8_SA(b, h) + aoff + m * 2048 + k * 1024); } while (0)
#define PG8_LDB(dst, b, h) do { _Pragma("unroll") for (int n = 0; n < 2; ++n) _Pragma("unroll") for (int k = 0; k < 2; ++k) dst[n][k] = *(const LAS bf16x8*)(lds + PG8_SB(b, h) + boff + n * 2048 + k * 1024); } while (0)
#define PG8_MMA(ai, bj, At, Bt) do { __builtin_amdgcn_s_setprio(1); _Pragma("unroll") for (int m = 0; m < 4; ++m) _Pragma("unroll") for (int n = 0; n < 2; ++n) _Pragma("unroll") for (int k = 0; k < 2; ++k) \
        acc[ai][bj][m][n] = __builtin_amdgcn_mfma_f32_16x16x32_bf16(Bt[n][k], At[m][k], acc[ai][bj][m][n], 0, 0, 0); __builtin_amdgcn_s_setprio(0); } while (0)
#define PG8_WAIT_V(n) asm volatile("s_waitcnt vmcnt(" #n ")" ::: "memory")
#define PG8_WAIT_L(n) asm volatile("s_waitcnt lgkmcnt(" #n ")" ::: "memory")
#define PG8_BAR __builtin_amdgcn_s_barrier()
#define PG8_SCHED __builtin_amdgcn_sched_barrier(0)
#define PG8_VOFF(V, U) do { V##00 = (unsigned)S.a_row(U, RA[0]) * lda2 + CA[0]; V##01 = (unsigned)S.a_row(U, RA[1]) * lda2 + CA[1]; \
        V##10 = (unsigned)S.a_row(U, HALF + RA[0]) * lda2 + CA[0]; V##11 = (unsigned)S.a_row(U, HALF + RA[1]) * lda2 + CA[1]; } while (0)
    Unit cur, nxt; int ui = 0;
    if (!S.next(0, cur)) return;
    f32x4 acc[2][2][4][2];
#pragma unroll
    for (int a = 0; a < 2; ++a)
#pragma unroll
        for (int b = 0; b < 2; ++b)
#pragma unroll
            for (int m = 0; m < 4; ++m)
#pragma unroll
                for (int n = 0; n < 2; ++n) acc[a][b][m][n] = (f32x4){0.f, 0.f, 0.f, 0.f};
    bf16x8 At[4][2], B0[2][2], B1[2][2];
    unsigned vc00, vc01, vc10, vc11;
    PG8_VOFF(vc, cur);
    const char* cB = S.b_ptr(g, cur);
    PG8_STAGE_B(PG8_SB(0, 0), cB); PG8_STAGE_B(PG8_SB(0, 1), cB + hstepB); PG8_STAGE_A(PG8_SA(0, 0), vc00, vc01, 0u); PG8_STAGE_A(PG8_SA(0, 1), vc10, vc11, 0u);
    if (wr == 1) PG8_BAR;
    PG8_WAIT_V(2); PG8_BAR;
    PG8_STAGE_B(PG8_SB(1, 0), cB + 128); PG8_STAGE_A(PG8_SA(1, 0), vc00, vc01, 128u); PG8_STAGE_B(PG8_SB(1, 1), cB + hstepB + 128);
    PG8_WAIT_V(6); PG8_BAR;
    for (;;) {
        const bool has_next = S.next(ui + 1, nxt);
        const char* nB = has_next ? S.b_ptr(g, nxt) : cB;
        unsigned vn00 = vc00, vn01 = vc01, vn10 = vc10, vn11 = vc11;
        if (has_next) { PG8_VOFF(vn, nxt); }
        const bool half1 = (cur.rend - cur.r0) > HALF;
#pragma unroll 1
        for (int t = 0; t < nt; t += 2) {
            if constexpr (Epi::MIDK > 0) { if (t == Epi::MIDK) E.mid(acc, cur, wr, wc, fr, fq); }
            const bool last = (t == nt - 2);
            const unsigned kb1 = (unsigned)(t + 1) * 128u;
            unsigned kb2 = (unsigned)(t + 2) * 128u;
            unsigned s00 = vc00, s01 = vc01, s10 = vc10, s11 = vc11;
            const char* b2 = cB + (size_t)kb2;
            if (last) { kb2 = 0u; b2 = nB; s00 = vn00; s01 = vn01; s10 = vn10; s11 = vn11; }
            const unsigned kb3 = kb2 + 128u; const char* b3 = b2 + 128;
            PG8_LDB(B0, 0, 0); PG8_LDB(B1, 0, 1); PG8_SCHED; PG8_LDA(At, 0, 0); PG8_STAGE_A(PG8_SA(1, 1), vc10, vc11, kb1);
            PG8_WAIT_V(8); PG8_WAIT_L(0); PG8_BAR; PG8_MMA(0, 0, At, B0); PG8_MMA(0, 1, At, B1); PG8_BAR; PG8_SCHED;
            PG8_LDA(At, 0, 1); PG8_STAGE_B(PG8_SB(0, 0), b2); PG8_STAGE_B(PG8_SB(0, 1), b2 + hstepB); PG8_STAGE_A(PG8_SA(0, 0), s00, s01, kb2);
            PG8_WAIT_V(8); PG8_WAIT_L(0); PG8_BAR; if (half1) { PG8_MMA(1, 0, At, B0); PG8_MMA(1, 1, At, B1); } PG8_BAR; PG8_SCHED;
            PG8_LDB(B0, 1, 0); PG8_LDB(B1, 1, 1); PG8_SCHED; PG8_LDA(At, 1, 0); PG8_STAGE_A(PG8_SA(0, 1), s10, s11, kb2);
            PG8_WAIT_V(8); PG8_WAIT_L(0); PG8_BAR; PG8_MMA(0, 0, At, B0); PG8_MMA(0, 1, At, B1); PG8_BAR; PG8_SCHED;
            PG8_LDA(At, 1, 1); PG8_STAGE_B(PG8_SB(1, 0), b3); PG8_STAGE_B(PG8_SB(1, 1), b3 + hstepB); PG8_STAGE_A(PG8_SA(1, 0), s00, s01, kb3);
            PG8_WAIT_V(8); PG8_WAIT_L(0); PG8_BAR; if (half1) { PG8_MMA(1, 0, At, B0); PG8_MMA(1, 1, At, B1); } PG8_BAR; PG8_SCHED;
        }
        if constexpr (ALIGN_EPI) { if (wr == 0) PG8_BAR; }
        E(acc, cur, wr, wc, fr, fq);
        if (!has_next) break;
#pragma unroll
        for (int a = 0; a < 2; ++a)
#pragma unroll
            for (int b = 0; b < 2; ++b)
#pragma unroll
                for (int m = 0; m < 4; ++m)
#pragma unroll
                    for (int n = 0; n < 2; ++n) acc[a][b][m][n] = (f32x4){0.f, 0.f, 0.f, 0.f};
        cur = nxt; cB = nB; vc00 = vn00; vc01 = vn01; vc10 = vn10; vc11 = vn11; ++ui;
        if constexpr (ALIGN_EPI) { if (wr == 1) PG8_BAR; }
    }
    PG8_WAIT_V(0);
    if constexpr (!ALIGN_EPI) { if (wr == 0) PG8_BAR; }
    PG8_BAR;
#undef PG8_SA
#undef PG8_SB
#undef PG8_STAGE_A
#undef PG8_STAGE_B
#undef PG8_LDA
#undef PG8_LDB
#undef PG8_MMA
#undef PG8_WAIT_V
#undef PG8_WAIT_L
#undef PG8_BAR
#undef PG8_SCHED
#undef PG8_VOFF
}
#define PG8_TILE_BEGIN(acc, wr, wc, fr, fq) \
    _Pragma("unroll") for (int ai = 0; ai < 2; ++ai) _Pragma("unroll") for (int m = 0; m < 4; ++m) _Pragma("unroll") for (int bj = 0; bj < 2; ++bj) { \
        const int trow = ai * 128 + wr * 64 + m * 16 + fr, tcol = bj * 128 + wc * 32 + 8 * fq; f32x4 v0 = acc[ai][bj][m][0], v1 = acc[ai][bj][m][1];
#define PG8_TILE_END }
__device__ __forceinline__ u32x4 pack8(f32x4 v0, f32x4 v1) { u32x4 w; w.x = cvt_pk_bf16(v0[0], v0[1]); w.y = cvt_pk_bf16(v0[2], v0[3]); w.z = cvt_pk_bf16(v1[0], v1[1]); w.w = cvt_pk_bf16(v1[2], v1[3]); return w; }
}

#define XB_TMO      128
#define XB_XCNT(j)  (256  + 64 * (j))
#define XB_XSUB(j)  (1280 + 64 * (j))
#define XB_XGEN(j)  (2304 + 64 * (j))
#define XB_TOP      3328
#define XB_TOPGEN   3392
#define XCD_BAR_WORDS 3456
#define XB_SPIN_CAP (1u << 18)

__device__ __forceinline__ unsigned xb_ld(unsigned* p)              { return __hip_atomic_load(p, __ATOMIC_RELAXED, __HIP_MEMORY_SCOPE_AGENT); }
__device__ __forceinline__ unsigned xb_add(unsigned* p, unsigned v) { return __hip_atomic_fetch_add(p, v, __ATOMIC_RELAXED, __HIP_MEMORY_SCOPE_AGENT); }
__device__ __forceinline__ unsigned xb_xcc_id() { return (unsigned)__builtin_amdgcn_s_getreg((3 << 11) | 20) & 0xFu; }
#define XB_SPIN(cond, bar) do { unsigned _sp = 0; while (cond) { __builtin_amdgcn_s_sleep(1); \
    if ((++_sp & 255u) == 0u) { if (xb_ld(&(bar)[XB_TMO])) break; if (_sp > XB_SPIN_CAP) { atomicAdd(&(bar)[XB_TMO], 1u); break; } } } } while (0)

struct XcdBarrier {
    unsigned* bar; unsigned x;
    volatile LAS unsigned* st;
};

__device__ __forceinline__ XcdBarrier xcd_barrier_post(unsigned* bar, volatile LAS unsigned* st) {
    XcdBarrier b; b.bar = bar; b.x = xb_xcc_id(); b.st = st;
    if (threadIdx.x == 0) (void)xb_add(&bar[XB_XCNT(b.x)], 1u);
    return b;
}
__device__ __forceinline__ void xcd_barrier_complete(unsigned* bar, unsigned x, unsigned& nloc, unsigned& nx) {
    const unsigned G = gridDim.x * gridDim.y * gridDim.z;
    unsigned sum, cnt, mine, sp = 0u;
    for (;;) {
        sum = 0u; cnt = 0u; mine = 0u;
#pragma unroll
        for (unsigned j = 0; j < 16; ++j) { const unsigned c = xb_ld(&bar[XB_XCNT(j)]); sum += c; cnt += (c > 0u) ? 1u : 0u; mine = (j == x) ? c : mine; }
        if (sum == G) break;
        __builtin_amdgcn_s_sleep(1);
        if ((++sp & 255u) == 0u) { if (xb_ld(&bar[XB_TMO])) break; if (sp > XB_SPIN_CAP) { atomicAdd(&bar[XB_TMO], 1u); break; } }
    }
    nloc = mine > 0u ? mine : 1u; nx = cnt > 0u ? cnt : 1u;
}

__device__ __forceinline__ void xcd_barrier(const XcdBarrier& b) {
    asm volatile("s_waitcnt vmcnt(0)" ::: "memory");
    __syncthreads();
    if (threadIdx.x == 0) {
        unsigned* bar = b.bar; asm volatile("" : "+s"(bar));
        __builtin_amdgcn_s_waitcnt(0);
        unsigned nloc = b.st[0], nx = b.st[1];
        if (nloc == 0u) { xcd_barrier_complete(bar, b.x, nloc, nx); b.st[0] = nloc; b.st[1] = nx; }
        const unsigned old = xb_add(&bar[XB_XSUB(b.x)], 1u);
        const unsigned gen = old / nloc;
        if (old + 1u == (gen + 1u) * nloc) {
            __builtin_amdgcn_fence(__ATOMIC_RELEASE, "agent");
            asm volatile("s_waitcnt vmcnt(0)" ::: "memory");
            const unsigned og = xb_add(&bar[XB_TOP], 1u);
            const unsigned tg = og / nx;
            if (og + 1u == (tg + 1u) * nx) xb_add(&bar[XB_TOPGEN], 1u);
            else XB_SPIN(xb_ld(&bar[XB_TOPGEN]) == tg, bar);
            __builtin_amdgcn_fence(__ATOMIC_ACQUIRE, "agent");
            xb_add(&bar[XB_XGEN(b.x)], 1u);
            asm volatile("s_waitcnt vmcnt(0)" ::: "memory");
        } else {
            XB_SPIN(xb_ld(&bar[XB_XGEN(b.x)]) == gen, bar);
            __builtin_amdgcn_fence(__ATOMIC_ACQUIRE, "agent");
            asm volatile("s_waitcnt vmcnt(0)" ::: "memory");
        }
    }
    __syncthreads();
}


struct Params {
    const float* in[22]; float* out; unsigned char* ws;
    int ph_lo, ph_hi;
};
constexpr size_t MiB = 1u << 20;
constexpr size_t WS_CTL = 0, CTL_BYTES = 1 * MiB;
constexpr int CW_BAR = 4096;
constexpr int CW_CNT = 16384;
constexpr size_t WS_WIN = 2 * MiB;
constexpr size_t SZ_WIN = (size_t)INCP * DM;
constexpr size_t SZ_WUQ = (size_t)768 * QL, SZ_WUKV = (size_t)1024 * KVL;
constexpr size_t WS_WUQ = WS_WIN + 2 * SZ_WIN * 2;
constexpr size_t WS_WUKV = WS_WUQ + 2 * SZ_WUQ * 2;
constexpr size_t SZ_WP = (size_t)DM * 512, SZ_WOUT = (size_t)DM * DM;
constexpr size_t WS_WPA = WS_WUKV + 2 * SZ_WUKV * 2;
constexpr size_t WS_WPB = WS_WPA + 2 * SZ_WP * 2;
constexpr size_t WS_WOUT = WS_WPB + 2 * SZ_WP * 2;
constexpr size_t SZ_WRT = (size_t)NE * DM, SZ_WSGU = (size_t)512 * DM, SZ_WSD = (size_t)DM * DSH;
constexpr size_t WS_WRT = WS_WOUT + 2 * SZ_WOUT * 2;
constexpr size_t WS_WSGU = WS_WRT + 2 * SZ_WRT * 2;
constexpr size_t WS_WSD = WS_WSGU + 2 * SZ_WSGU * 2;
constexpr size_t WS_CS = WS_WSD + 2 * SZ_WSD * 2;
constexpr size_t WS_KM = WS_CS + (size_t)SEQ * 16 * 8;
constexpr size_t WS_SEL = WS_KM + (size_t)NB * HA * NBLK * 64 * 4;
constexpr size_t WS_XB = WS_SEL + (size_t)T * 8 * 4;
constexpr size_t WS_CQN = WS_XB + (size_t)T * DM * 2;
constexpr size_t WS_CKVN = WS_CQN + (size_t)T * QL * 2;
constexpr size_t WS_QB = WS_CKVN + (size_t)T * KVL * 2;
constexpr size_t WS_KB = WS_QB + (size_t)T * 768 * 2;
constexpr size_t WS_VB = WS_KB + (size_t)T * 768 * 2;
constexpr size_t WS_OAB = WS_VB + (size_t)T * 512 * 2;
constexpr size_t WS_TMP = WS_OAB + (size_t)T * 1024 * 2;
constexpr size_t WS_MRG = WS_TMP + (size_t)T * 1024 * 2;
constexpr size_t WS_PRE = WS_MRG + (size_t)T * 1024 * 2;
constexpr size_t WS_X1 = WS_PRE + (size_t)T * 1024 * 4;
constexpr size_t WS_X1B = WS_X1 + (size_t)T * 1024 * 4;
constexpr size_t WS_X2 = WS_X1B + (size_t)T * 1024 * 2;
constexpr size_t WS_LOG = WS_X2 + (size_t)T * 1024 * 4;
constexpr size_t WS_HS = WS_LOG + (size_t)T * NE * 4;
constexpr size_t WS_SH = WS_HS + (size_t)T * DSH * 2;
constexpr size_t WS_TOPE = WS_SH + (size_t)T * DM * 2;
constexpr size_t WS_TOPW = WS_TOPE + (size_t)NA * 4;
constexpr size_t WS_APOS = WS_TOPW + (size_t)NA * 4;
constexpr size_t WS_ROWA = WS_APOS + (size_t)NA * 4;
constexpr size_t WS_HIST = WS_ROWA + (size_t)NA * 8;
constexpr size_t WS_PO = WS_HIST + (size_t)1024 * 256 * 4;
constexpr size_t WS_PML = WS_PO + (size_t)T * 8 * 3 * 64 * 2;
constexpr size_t WS_HE = WS_PML + (size_t)T * 8 * 3 * 128;
constexpr size_t WS_Y = WS_HE + (size_t)NA * DE * 2;
constexpr size_t WS_PROJ = WS_Y + (size_t)NA * DM * 2;
constexpr size_t SZ_WEGU = (size_t)NE * 512 * DM, SZ_WED = (size_t)NE * DM * DE;
constexpr size_t WS_WEGU = WS_PROJ + (size_t)T * INCP * 2;
constexpr size_t WS_WED = WS_WEGU + 2 * SZ_WEGU * 2;
constexpr size_t WS_FAST_END = WS_WED + 2 * SZ_WED * 2;
constexpr size_t WS_NEED = WS_FAST_END;
static_assert(WS_NEED <= (size_t)2040 * MiB, "ws map");

constexpr int LDS_BYTES = 147456;
constexpr int RING_BYTES = 131072, MISC_OFF = RING_BYTES + 1024, TAB_OFF = RING_BYTES + 2048;

struct Frame { LAS unsigned char* lds; int tid, lane, wave, G, vcu; };

template <class RowMap>
__device__ __forceinline__ void transpose_item(const float* W, int K, int N, bf16_t* WT, int ldk, RowMap rm, LAS float* scr, int item, int lane) {
    const int nblk = N / 32, kb = item / nblk, nb = item % nblk, k0 = 64 * kb, n0 = 32 * nb;
#pragma unroll 8
    for (int i = 0; i < 32; ++i) { const int kk = 2 * i + (lane >> 5); scr[kk * 33 + (lane & 31)] = W[(size_t)(k0 + kk) * N + n0 + (lane & 31)]; }
    LDS_WAIT(); asm volatile("" ::: "memory");
    const int c = lane & 7;
#pragma unroll
    for (int j = 0; j < 4; ++j) { const int n = (lane >> 3) + 8 * j; const LAS float* s = scr + (8 * c) * 33 + n;
        u32x4 o; o.x = pk2(s[0 * 33], s[1 * 33]); o.y = pk2(s[2 * 33], s[3 * 33]); o.z = pk2(s[4 * 33], s[5 * 33]); o.w = pk2(s[6 * 33], s[7 * 33]);
        *(u32x4*)(WT + (size_t)rm(n0 + n) * ldk + k0 + 8 * c) = o; }
    LDS_WAIT(); asm volatile("" ::: "memory");
}
template <class RowMap>
__device__ __forceinline__ void transpose_item64(const float* W, int K, int N, bf16_t* WT, int ldk, RowMap rm, LAS unsigned short* scr, int item, int lane) {
    const int nblk = N / 64, kb = item / nblk, nb = item % nblk, k0 = 64 * kb, n0 = 64 * nb, r = lane >> 4, c4 = (lane & 15) * 4;
    f32x4 v[16];
#pragma unroll
    for (int i = 0; i < 16; ++i) v[i] = __builtin_nontemporal_load((const f32x4*)(W + (size_t)(k0 + 4 * i + r) * N + n0 + c4));
#pragma unroll
    for (int i = 0; i < 16; ++i) { LAS unsigned* d = (LAS unsigned*)(scr + (4 * i + r) * 66 + c4); d[0] = pk2(v[i][0], v[i][1]); d[1] = pk2(v[i][2], v[i][3]); }
    LDS_WAIT(); asm volatile("" ::: "memory");
    const int c = lane & 7;
#pragma unroll
    for (int j = 0; j < 8; ++j) { const int n = (lane >> 3) + 8 * j; const LAS unsigned short* q = scr + (8 * c) * 66 + n;
        u32x4 o; o.x = (unsigned)q[0] | ((unsigned)q[66] << 16); o.y = (unsigned)q[2 * 66] | ((unsigned)q[3 * 66] << 16); o.z = (unsigned)q[4 * 66] | ((unsigned)q[5 * 66] << 16); o.w = (unsigned)q[6 * 66] | ((unsigned)q[7 * 66] << 16);
        *(u32x4*)(WT + (size_t)rm(n0 + n) * ldk + k0 + 8 * c) = o; }
    LDS_WAIT(); asm volatile("" ::: "memory");
}
struct RowPermD { __device__ __forceinline__ int operator()(int n) const { const int a = n & 255; return (n & ~255) + 128 * ((a >> 3) & 1) + 32 * (a >> 6) + 8 * ((a >> 4) & 3) + (a & 7); } };
struct RowId { __device__ __forceinline__ int operator()(int n) const { return n; } };

struct EpiProj {
    static constexpr int MIDK = 0;
    bf16_t* O; const float* bg;
    __device__ __forceinline__ void operator()(const f32x4 (&acc)[2][2][4][2], const pg8::Unit& u, int wr, int wc, int fr, int fq) const {
        PG8_TILE_BEGIN(acc, wr, wc, fr, fq)
            const int row = u.pm * 256 + trow, col = u.pn * 256 + tcol;
            if (col < C_KA) { v0 = v0 * QS_A; v1 = v1 * QS_A; }
            else if (col >= C_GA && col < INC) { const f32x4 b0 = *(const f32x4*)(bg + col - C_GA), b1 = *(const f32x4*)(bg + col - C_GA + 4);
#pragma unroll
                for (int i = 0; i < 4; ++i) { v0[i] = sigmoidf_(v0[i] + b0[i]); v1[i] = sigmoidf_(v1[i] + b1[i]); } }
            *(u32x4*)(O + (size_t)row * INCP + col) = pg8::pack8(v0, v1);
        PG8_TILE_END
    }
};

struct RowQ { __device__ __forceinline__ int operator()(int n) const { const int h = n / 96, d = n % 96; if (d < 64) return n; const int i = d - 64; return h * 96 + 64 + (i < 16 ? 2 * i : 2 * (i - 16) + 1); } };

struct EpiQ {
    static constexpr int MIDK = 0;
    bf16_t* O; const f32x2* CS;
    __device__ __forceinline__ void operator()(const f32x4 (&acc)[2][2][4][2], const pg8::Unit& u, int wr, int wc, int fr, int fq) const {
        PG8_TILE_BEGIN(acc, wr, wc, fr, fq)
            const int row = u.pm * 256 + trow, col = u.pn * 256 + tcol, d = col % 96;
            if (d >= 64) { const int pos = row % SEQ, i0 = (d - 64) >> 1; const f32x2* cs = CS + (size_t)pos * 16 + i0;
                const f32x2 c0 = cs[0], c1 = cs[1], c2 = cs[2], c3 = cs[3];
                const f32x4 a = v0, b = v1;
                v0[0] = a[0] * c0[0] - a[1] * c0[1]; v0[1] = a[1] * c0[0] + a[0] * c0[1]; v0[2] = a[2] * c1[0] - a[3] * c1[1]; v0[3] = a[3] * c1[0] + a[2] * c1[1];
                v1[0] = b[0] * c2[0] - b[1] * c2[1]; v1[1] = b[1] * c2[0] + b[0] * c2[1]; v1[2] = b[2] * c3[0] - b[3] * c3[1]; v1[3] = b[3] * c3[0] + b[2] * c3[1]; }
            v0 = v0 * QS_B; v1 = v1 * QS_B;
            *(u32x4*)(O + (size_t)row * 768 + col) = pg8::pack8(v0, v1);
        PG8_TILE_END
    }
};
struct EpiKV {
    static constexpr int MIDK = 0;
    bf16_t* KB; bf16_t* VB;
    __device__ __forceinline__ void operator()(const f32x4 (&acc)[2][2][4][2], const pg8::Unit& u, int wr, int wc, int fr, int fq) const {
        PG8_TILE_BEGIN(acc, wr, wc, fr, fq)
            const int row = u.pm * 256 + trow, col = u.pn * 256 + tcol, h = col >> 7, j = col & 127;
            bf16_t* dst = (j < 64) ? KB + (size_t)row * 768 + h * 96 + j : VB + (size_t)row * 512 + h * 64 + (j - 64);
            *(u32x4*)dst = pg8::pack8(v0, v1);
        PG8_TILE_END
    }
};

__device__ __forceinline__ void prep_phase(const Frame& F, const bf16_t* PROJ, const float* qn, const float* kvn, const f32x2* CS, bf16_t* CQN, bf16_t* CKVN, bf16_t* KB, float* KM) {
    int lane_ = F.lane; asm volatile("" : "+v"(lane_));
    const int gw = F.vcu * NWAVES + F.wave, NGW = F.G * NWAVES, lane = lane_;
    for (int row = gw; row < T; row += NGW) {
        const bf16_t* p = PROJ + (size_t)row * INCP;
        u32x4 a = (u32x4){0u, 0u, 0u, 0u}, b = (u32x4){0u, 0u, 0u, 0u};
        if (lane < 48) a = *(const u32x4*)(p + C_CQ + lane * 8);
        if (lane < 32) b = *(const u32x4*)(p + C_CKV + lane * 8);
        float sq = 0.f, sk = 0.f;
#pragma unroll
        for (int i = 0; i < 4; ++i) { const float x = bflo(a[i]), y = bfhi(a[i]), z = bflo(b[i]), w = bfhi(b[i]); sq += x * x + y * y; sk += z * z + w * w; }
        sq = wave_sum(sq); sk = wave_sum(sk);
        const float rq = rsqrtf(sq * (1.f / QL) + RMS_EPS), rk = rsqrtf(sk * (1.f / KVL) + RMS_EPS);
        if (lane < 48) { const f32x4 g0 = *(const f32x4*)(qn + lane * 8), g1 = *(const f32x4*)(qn + lane * 8 + 4); u32x4 o;
            o.x = pk2(bflo(a.x) * rq * g0[0], bfhi(a.x) * rq * g0[1]); o.y = pk2(bflo(a.y) * rq * g0[2], bfhi(a.y) * rq * g0[3]);
            o.z = pk2(bflo(a.z) * rq * g1[0], bfhi(a.z) * rq * g1[1]); o.w = pk2(bflo(a.w) * rq * g1[2], bfhi(a.w) * rq * g1[3]);
            *(u32x4*)(CQN + (size_t)row * QL + lane * 8) = o; }
        if (lane < 32) { const f32x4 g0 = *(const f32x4*)(kvn + lane * 8), g1 = *(const f32x4*)(kvn + lane * 8 + 4); u32x4 o;
            o.x = pk2(bflo(b.x) * rk * g0[0], bfhi(b.x) * rk * g0[1]); o.y = pk2(bflo(b.y) * rk * g0[2], bfhi(b.y) * rk * g0[3]);
            o.z = pk2(bflo(b.z) * rk * g1[0], bfhi(b.z) * rk * g1[1]); o.w = pk2(bflo(b.w) * rk * g1[2], bfhi(b.w) * rk * g1[3]);
            *(u32x4*)(CKVN + (size_t)row * KVL + lane * 8) = o; }
        if (lane < 16) { const float x1 = bf2f(p[C_KR + lane]), x2 = bf2f(p[C_KR + 16 + lane]); const f32x2 cs = CS[(size_t)(row % SEQ) * 16 + lane];
            const unsigned w = pk2(x1 * cs[0] - x2 * cs[1], x2 * cs[0] + x1 * cs[1]);
#pragma unroll
            for (int h = 0; h < 8; ++h) *(unsigned*)(KB + (size_t)row * 768 + h * 96 + 64 + 2 * lane) = w; }
    }
    for (int it = gw; it < NB * NBLK * HA; it += NGW) {
        const int h = it % HA, blk = (it / HA) % NBLK, b = it / (HA * NBLK), c = lane & 7, r0 = lane >> 3;
        const bf16_t* p = PROJ + ((size_t)b * SEQ + (size_t)blk * BLK + r0) * INCP + C_KA + h * 64 + c * 8;
        float s[8];
#pragma unroll
        for (int i = 0; i < 8; ++i) s[i] = 0.f;
        for (int i = 0; i < 32; ++i) { const u32x4 v = *(const u32x4*)(p + (size_t)i * 8 * INCP);
#pragma unroll
            for (int k = 0; k < 4; ++k) { s[2 * k] += bflo(v[k]); s[2 * k + 1] += bfhi(v[k]); } }
#pragma unroll
        for (int i = 0; i < 8; ++i) { s[i] += __shfl_xor(s[i], 8); s[i] += __shfl_xor(s[i], 16); s[i] += __shfl_xor(s[i], 32); }
        if (lane < 8) { float* o = KM + ((size_t)(b * HA + h) * NBLK + blk) * 64 + c * 8;
            *(f32x4*)o = (f32x4){s[0], s[1], s[2], s[3]} * (1.f / BLK); *(f32x4*)(o + 4) = (f32x4){s[4], s[5], s[6], s[7]} * (1.f / BLK); }
    }
}
__device__ __forceinline__ void mobasel_phase(const Frame& F, const bf16_t* PROJ, const float* KM, unsigned* SEL) {
    int tid_ = F.tid; asm volatile("" : "+v"(tid_));
    const int TPW = T / F.G, row0 = (int)blockIdx.x * TPW, b = row0 / SEQ, own = (row0 % SEQ) / BLK, hs = own * 64 + 4;
    LAS float* km = (LAS float*)F.lds;
    for (int i = tid_; i < 8 * own * 16; i += NTHR) { const int h = i / (own * 16), r = i % (own * 16);
        *(LAS f32x4*)(km + h * hs + r * 4) = *(const f32x4*)(KM + ((size_t)(b * HA + h) * NBLK) * 64 + r * 4); }
    __syncthreads();
    for (int idx = tid_; idx < TPW * 8; idx += NTHR) {
        const int h = idx & 7, row = row0 + (idx >> 3);
        const bf16_t* qp = PROJ + (size_t)row * INCP + C_QA + h * 64;
        float q[64];
#pragma unroll
        for (int i = 0; i < 8; ++i) { const u32x4 v = *(const u32x4*)(qp + i * 8);
#pragma unroll
            for (int k = 0; k < 4; ++k) { q[i * 8 + 2 * k] = bflo(v[k]); q[i * 8 + 2 * k + 1] = bfhi(v[k]); } }
        float v1 = -INFINITY, v2 = -INFINITY, v3 = -INFINITY; int i1 = -1, i2 = -1, i3 = -1;
        for (int j = 0; j < own; ++j) {
            const LAS f32x4* kp = (const LAS f32x4*)(km + h * hs + j * 64);
            float g0 = 0.f, g1 = 0.f, g2 = 0.f, g3 = 0.f;
#pragma unroll
            for (int c = 0; c < 16; ++c) { const f32x4 k4 = kp[c]; g0 = fmaf(q[4 * c], k4[0], g0); g1 = fmaf(q[4 * c + 1], k4[1], g1); g2 = fmaf(q[4 * c + 2], k4[2], g2); g3 = fmaf(q[4 * c + 3], k4[3], g3); }
            const float g = (g0 + g1) + (g2 + g3);
            if (g > v1) { v3 = v2; i3 = i2; v2 = v1; i2 = i1; v1 = g; i1 = j; }
            else if (g > v2) { v3 = v2; i3 = i2; v2 = g; i2 = j; }
            else if (g > v3) { v3 = g; i3 = j; }
        }
        unsigned m = 0;
        if (i1 >= 0) m |= 1u << i1;
        if (i2 >= 0) m |= 1u << i2;
        if (i3 >= 0) m |= 1u << i3;
        SEL[(size_t)row * 8 + h] = m;
    }
    __syncthreads();
}

struct EpiGate2 {
    static constexpr int MIDK = 8;
    const bf16_t* PROJ; bf16_t* MRG;
    __device__ __forceinline__ void mid(f32x4 (&acc)[2][2][4][2], const pg8::Unit& u, int wr, int wc, int fr_, int fq) const {
        int fr = fr_; asm volatile("" : "+v"(fr));
#pragma unroll
        for (int ai = 0; ai < 2; ++ai)
#pragma unroll
            for (int m = 0; m < 4; ++m)
#pragma unroll
                for (int bj = 0; bj < 2; ++bj) { const size_t o = (size_t)(u.pm * 256 + ai * 128 + wr * 64 + m * 16 + fr) * INCP + u.pn * 256 + bj * 128 + wc * 32 + 8 * fq;
                    const u32x4 ga = *(const u32x4*)(PROJ + o + C_GA), gb = *(const u32x4*)(PROJ + o + C_GB);
#pragma unroll
                    for (int i = 0; i < 4; ++i) { const float r0 = bflo(ga[i]) * __builtin_amdgcn_rcpf(bflo(gb[i])), r1 = bfhi(ga[i]) * __builtin_amdgcn_rcpf(bfhi(gb[i]));
                        acc[ai][bj][m][i >> 1][2 * (i & 1)] *= r0; acc[ai][bj][m][i >> 1][2 * (i & 1) + 1] *= r1; }
                    __builtin_amdgcn_sched_barrier(0); }
    }
    __device__ __forceinline__ void operator()(const f32x4 (&acc)[2][2][4][2], const pg8::Unit& u, int wr, int wc, int fr, int fq) const {
        PG8_TILE_BEGIN(acc, wr, wc, fr, fq)
            const int row = u.pm * 256 + trow, col = u.pn * 256 + tcol;
            const u32x4 g = *(const u32x4*)(PROJ + (size_t)row * INCP + C_GB + col);
            v0[0] *= bflo(g.x); v0[1] *= bfhi(g.x); v0[2] *= bflo(g.y); v0[3] *= bfhi(g.y); v1[0] *= bflo(g.z); v1[1] *= bfhi(g.z); v1[2] *= bflo(g.w); v1[3] *= bfhi(g.w);
            *(u32x4*)(MRG + (size_t)row * DM + col) = pg8::pack8(v0, v1);
        PG8_TILE_END
    }
};
struct EpiResid {
    static constexpr int MIDK = 0;
    const bf16_t* X; bf16_t* PRE;
    __device__ __forceinline__ void operator()(const f32x4 (&acc)[2][2][4][2], const pg8::Unit& u, int wr, int wc, int fr, int fq) const {
        PG8_TILE_BEGIN(acc, wr, wc, fr, fq)
            const size_t o = (size_t)(u.pm * 256 + trow) * DM + u.pn * 256 + tcol;
            const u32x4 x = *(const u32x4*)(X + o);
            v0[0] += ALPHA * bflo(x.x); v0[1] += ALPHA * bfhi(x.x); v0[2] += ALPHA * bflo(x.y); v0[3] += ALPHA * bfhi(x.y);
            v1[0] += ALPHA * bflo(x.z); v1[1] += ALPHA * bfhi(x.z); v1[2] += ALPHA * bflo(x.w); v1[3] += ALPHA * bfhi(x.w);
            *(u32x4*)(PRE + o) = pg8::pack8(v0, v1);
        PG8_TILE_END
    }
};
__device__ __forceinline__ void ln_phase(const Frame& F, const bf16_t* PRE, const float* g, const float* bt, bf16_t* XBo) {
    int lane_ = F.lane; asm volatile("" : "+v"(lane_));
    const int gw = F.vcu * NWAVES + F.wave, NGW = F.G * NWAVES, lane = lane_;
    for (int row = gw; row < T; row += NGW) {
        const u32x2* pr = (const u32x2*)(PRE + (size_t)row * DM) + lane;
        f32x4 v[4]; float s = 0.f;
#pragma unroll
        for (int j = 0; j < 4; ++j) { const u32x2 h = pr[64 * j]; v[j] = (f32x4){bflo(h.x), bfhi(h.x), bflo(h.y), bfhi(h.y)}; s += (v[j][0] + v[j][1]) + (v[j][2] + v[j][3]); }
        const float mean = wave_sum(s) * (1.f / DM); float s2 = 0.f;
#pragma unroll
        for (int j = 0; j < 4; ++j) { v[j] = v[j] - mean; s2 += (v[j][0] * v[j][0] + v[j][1] * v[j][1]) + (v[j][2] * v[j][2] + v[j][3] * v[j][3]); }
        const float rstd = rsqrtf(wave_sum(s2) * (1.f / DM) + LN_EPS);
#pragma unroll
        for (int j = 0; j < 4; ++j) { const f32x4 gg = ((const f32x4*)g)[lane + 64 * j], bb = ((const f32x4*)bt)[lane + 64 * j];
            const f32x4 y = v[j] * rstd * gg + bb;
            u32x2 w; w.x = pk2(y[0], y[1]); w.y = pk2(y[2], y[3]); ((u32x2*)(XBo + (size_t)row * DM))[lane + 64 * j] = w; }
    }
}

struct RowGU { int off; __device__ __forceinline__ int operator()(int n) const { return 256 * (n >> 7) + off + (n & 127); } };

struct EpiF32 {
    static constexpr int MIDK = 0;
    float* O; int ld;
    __device__ __forceinline__ void operator()(const f32x4 (&acc)[2][2][4][2], const pg8::Unit& u, int wr, int wc, int fr, int fq) const {
        PG8_TILE_BEGIN(acc, wr, wc, fr, fq)
            float* o = O + (size_t)(u.pm * 256 + trow) * ld + u.pn * 256 + tcol; *(f32x4*)o = v0; *(f32x4*)(o + 4) = v1;
        PG8_TILE_END
    }
};
struct EpiBf16 {
    static constexpr int MIDK = 0;
    bf16_t* O; int ld;
    __device__ __forceinline__ void operator()(const f32x4 (&acc)[2][2][4][2], const pg8::Unit& u, int wr, int wc, int fr, int fq) const {
        PG8_TILE_BEGIN(acc, wr, wc, fr, fq)
            *(u32x4*)(O + (size_t)(u.pm * 256 + trow) * ld + u.pn * 256 + tcol) = pg8::pack8(v0, v1);
        PG8_TILE_END
    }
};
__device__ __forceinline__ float silu_mul(float g, float u) { return g * __builtin_amdgcn_rcpf(1.f + __expf(-g)) * u; }
struct EpiSwiGLU {
    static constexpr int MIDK = 0;
    bf16_t* H; int ld;
    __device__ __forceinline__ void operator()(const f32x4 (&acc)[2][2][4][2], const pg8::Unit& u, int wr, int wc, int fr, int fq) const {
#pragma unroll
        for (int ai = 0; ai < 2; ++ai)
#pragma unroll
            for (int m = 0; m < 4; ++m) { const int row = u.r0 + ai * 128 + wr * 64 + m * 16 + fr;
                if (row < u.rend) { f32x4 h0, h1;
#pragma unroll
                    for (int i = 0; i < 4; ++i) { h0[i] = silu_mul(acc[ai][0][m][0][i], acc[ai][1][m][0][i]); h1[i] = silu_mul(acc[ai][0][m][1][i], acc[ai][1][m][1][i]); }
                    *(u32x4*)(H + (size_t)row * ld + 128 * u.pn + wc * 32 + 8 * fq) = pg8::pack8(h0, h1); } }
    }
};
constexpr float Y8_SCALE = 32.f;
__device__ __forceinline__ unsigned pk4_fp8(float a, float b, float c, float d) { int w = __builtin_amdgcn_cvt_pk_fp8_f32(a, b, 0, false); w = __builtin_amdgcn_cvt_pk_fp8_f32(c, d, w, true); return (unsigned)w; }
struct EpiExpDown {
    static constexpr int MIDK = 0;
    unsigned char* Y8;
    __device__ __forceinline__ void operator()(const f32x4 (&acc)[2][2][4][2], const pg8::Unit& u, int wr, int wc, int fr, int fq) const {
#pragma unroll
        for (int ai = 0; ai < 2; ++ai)
#pragma unroll
            for (int m = 0; m < 4; ++m) { const int row = u.r0 + ai * 128 + wr * 64 + m * 16 + fr;
                if (row < u.rend) { const f32x4 a0 = acc[ai][0][m][0] * Y8_SCALE, a1 = acc[ai][0][m][1] * Y8_SCALE, b0 = acc[ai][1][m][0] * Y8_SCALE, b1 = acc[ai][1][m][1] * Y8_SCALE;
                    u32x4 w; w.x = pk4_fp8(a0[0], a0[1], a0[2], a0[3]); w.y = pk4_fp8(a1[0], a1[1], a1[2], a1[3]); w.z = pk4_fp8(b0[0], b0[1], b0[2], b0[3]); w.w = pk4_fp8(b1[0], b1[1], b1[2], b1[3]);
                    *(u32x4*)(Y8 + (size_t)row * DM + 256 * u.pn + 64 * wc + 16 * fq) = w; } }
    }
};
template <int NPN, bool GATHER>
struct ExpertOrder {
    const LAS int* off; const LAS int* toff; const int* rowa; int G, c; size_t strideE;
    __device__ __forceinline__ bool next(int i, pg8::Unit& u) const {
        const int L = i * G + c; if (L >= toff[256] * NPN) return false;
        const int tile = L / NPN; u.pn = L % NPN; int lo = 0, hi = 255;
        while (lo < hi) { const int mid = (lo + hi + 1) >> 1; if (toff[mid] <= tile) lo = mid; else hi = mid - 1; }
        u.e = lo; u.r0 = off[lo] + (tile - toff[lo]) * 256; u.rend = off[lo + 1]; u.pm = 0; return true;
    }
    __device__ __forceinline__ int a_row(const pg8::Unit& u, int r) const { const int rr = min(u.r0 + r, u.rend - 1); return GATHER ? (rowa[2 * rr] >> 3) : rr; }
    __device__ __forceinline__ const char* b_ptr(const pg8::Gemm& g, const pg8::Unit& u) const { return (const char*)g.Bt + (size_t)u.e * strideE + (size_t)u.pn * 256 * g.ldb * 2; }
};
__device__ __forceinline__ void expert_tables(const Frame& F, const unsigned* cnt, LAS int* off, LAS int* toff) {
    if (F.tid < 256) { off[F.tid] = (int)cnt[F.tid]; }
    __syncthreads();
    if (F.tid == 0) { int a = 0, b = 0; for (int i = 0; i < 256; ++i) { const int c = off[i]; off[i] = a; toff[i] = b; a += c; b += (c + 255) >> 8; } off[256] = a; toff[256] = b; }
    __syncthreads();
}
__device__ __forceinline__ void route_phase(const Frame& F, const float* LOGITS, const float* rbias, int* TOPE, float* TOPW, int* APOS, int* HIST, LAS int* lcnt) {
    int lane_ = F.lane; asm volatile("" : "+v"(lane_));
    const int lane = lane_, TPW = T / F.G, t0 = (int)blockIdx.x * TPW;
    if (F.tid < 256) lcnt[F.tid] = 0;
    __syncthreads();
    const f32x4 rb = *(const f32x4*)(rbias + lane * 4);
    f32x4 lgn = (t0 + F.wave < t0 + TPW) ? *(const f32x4*)(LOGITS + (size_t)(t0 + F.wave) * NE + lane * 4) : (f32x4){0.f, 0.f, 0.f, 0.f};
#pragma unroll 1
    for (int t = t0 + F.wave; t < t0 + TPW; t += NWAVES) {
        const f32x4 lg = lgn;
        if (t + NWAVES < t0 + TPW) lgn = *(const f32x4*)(LOGITS + (size_t)(t + NWAVES) * NE + lane * 4);
        const float s0 = __builtin_amdgcn_rcpf(1.f + __expf(-lg[0])), s1 = __builtin_amdgcn_rcpf(1.f + __expf(-lg[1])), s2 = __builtin_amdgcn_rcpf(1.f + __expf(-lg[2])), s3 = __builtin_amdgcn_rcpf(1.f + __expf(-lg[3]));
        float c0 = s0 + rb[0], c1 = s1 + rb[1], c2 = s2 + rb[2], c3 = s3 + rb[3];
        float a = fmaxf(c0, c1), bq = fminf(c0, c1);
        { const float hi2 = fmaxf(c2, c3), lo2 = fminf(c2, c3); const float na = fmaxf(a, hi2), nb = fmaxf(fminf(a, hi2), fmaxf(bq, lo2)); a = na; bq = nb; }
#pragma unroll
        for (int o = 1; o < 8; o <<= 1) { const float oa = __shfl_xor(a, o), ob = __shfl_xor(bq, o); const float na = fmaxf(a, oa), nb = fmaxf(fminf(a, oa), fmaxf(bq, ob)); a = na; bq = nb; }
        const float gs = a + bq; const int grp = lane >> 3;
        int rank = 0;
#pragma unroll
        for (int j = 0; j < 8; ++j) { const float og = __shfl(gs, j * 8); rank += (og > gs || (og == gs && j < grp)) ? 1 : 0; }
        if (rank >= 4) { c0 = c1 = c2 = c3 = -INFINITY; }
        float wsum = 0.f, myw = 0.f; int mye = 0;
#pragma unroll
        for (int k = 0; k < TOPK; ++k) {
            float bv = c0; int bi = 0;
            if (c1 > bv) { bv = c1; bi = 1; }
            if (c2 > bv) { bv = c2; bi = 2; }
            if (c3 > bv) { bv = c3; bi = 3; }
            int be = lane * 4 + bi;
#pragma unroll
            for (int o = 1; o < 64; o <<= 1) { const float ov = __shfl_xor(bv, o); const int oe = __shfl_xor(be, o); if (ov > bv || (ov == bv && oe < be)) { bv = ov; be = oe; } }
            float sc = 0.f;
            if ((be >> 2) == lane) { const int b2 = be & 3; sc = b2 == 0 ? s0 : b2 == 1 ? s1 : b2 == 2 ? s2 : s3; if (b2 == 0) c0 = -INFINITY; else if (b2 == 1) c1 = -INFINITY; else if (b2 == 2) c2 = -INFINITY; else c3 = -INFINITY; }
            sc = __shfl(sc, be >> 2);
            wsum += sc;
            if (lane == k) { myw = sc; mye = be; }
        }
        if (lane < TOPK) { const int aidx = t * TOPK + lane; TOPE[aidx] = mye; TOPW[aidx] = myw / wsum * 2.5f; APOS[aidx] = __hip_atomic_fetch_add(lcnt + mye, 1, __ATOMIC_RELAXED, __HIP_MEMORY_SCOPE_WORKGROUP); }
    }
    __syncthreads();
    if (F.tid < 256) HIST[(size_t)blockIdx.x * 256 + F.tid] = lcnt[F.tid];
}
__device__ __forceinline__ void combine_phase(const Frame& F, const bf16_t* X1, const bf16_t* SH, const unsigned char* Y8, const int* INV, const float* TOPW, const float* g, const float* bt, float* Xo, bf16_t* XBo) {
    int lane_ = F.lane; asm volatile("" : "+v"(lane_));
    const int gw = F.vcu * NWAVES + F.wave, NGW = F.G * NWAVES, lane = lane_;
    for (int row = gw; row < T; row += NGW) {
        int ri = 0; float rw = 0.f; if (lane < TOPK) { ri = INV[row * TOPK + lane]; rw = TOPW[row * TOPK + lane] * (1.f / Y8_SCALE); }
        float v[16];
#pragma unroll
        for (int j = 0; j < 2; ++j) { const u32x4 x = ((const u32x4*)(X1 + (size_t)row * DM))[2 * lane + j], h = ((const u32x4*)(SH + (size_t)row * DM))[2 * lane + j];
#pragma unroll
            for (int i = 0; i < 4; ++i) { v[8 * j + 2 * i] = ALPHA * bflo(x[i]) + bflo(h[i]); v[8 * j + 2 * i + 1] = ALPHA * bfhi(x[i]) + bfhi(h[i]); } }
#pragma unroll
        for (int k = 0; k < TOPK; ++k) { const u32x4 h = ((const u32x4*)(Y8 + (size_t)__shfl(ri, k) * DM))[lane]; const float w = __shfl(rw, k);
#pragma unroll
            for (int i = 0; i < 4; ++i) { const f32x2 lo = __builtin_amdgcn_cvt_pk_f32_fp8((int)h[i], false), hi2 = __builtin_amdgcn_cvt_pk_f32_fp8((int)h[i], true);
                v[4 * i] = fmaf(w, lo[0], v[4 * i]); v[4 * i + 1] = fmaf(w, lo[1], v[4 * i + 1]); v[4 * i + 2] = fmaf(w, hi2[0], v[4 * i + 2]); v[4 * i + 3] = fmaf(w, hi2[1], v[4 * i + 3]); } }
        float s = 0.f;
#pragma unroll
        for (int i = 0; i < 16; ++i) s += v[i];
        const float mean = wave_sum(s) * (1.f / DM); float s2 = 0.f;
#pragma unroll
        for (int i = 0; i < 16; ++i) { v[i] -= mean; s2 += v[i] * v[i]; }
        const float rstd = rsqrtf(wave_sum(s2) * (1.f / DM) + LN_EPS);
        const int c0 = 16 * lane;
        f32x4 y[4];
#pragma unroll
        for (int q = 0; q < 4; ++q) { const f32x4 gg = *(const f32x4*)(g + c0 + 4 * q), bb = *(const f32x4*)(bt + c0 + 4 * q); y[q] = (f32x4){v[4 * q], v[4 * q + 1], v[4 * q + 2], v[4 * q + 3]} * rstd * gg + bb; }
        if (Xo) {
#pragma unroll
            for (int q = 0; q < 4; ++q) *(f32x4*)(Xo + (size_t)row * DM + c0 + 4 * q) = y[q]; }
        if (XBo) {
#pragma unroll
            for (int j = 0; j < 2; ++j) { u32x4 w; w.x = pk2(y[2 * j][0], y[2 * j][1]); w.y = pk2(y[2 * j][2], y[2 * j][3]); w.z = pk2(y[2 * j + 1][0], y[2 * j + 1][1]); w.w = pk2(y[2 * j + 1][2], y[2 * j + 1][3]); *(u32x4*)(XBo + (size_t)row * DM + c0 + 8 * j) = w; } }
    }
}

__device__ __forceinline__ int crow(int r, int hi) { return (r & 3) + 8 * (r >> 2) + 4 * hi; }
typedef short s16x4 __attribute__((ext_vector_type(4)));
__device__ __forceinline__ s16x4 vtr(const LAS unsigned char* p) { return __builtin_bit_cast(s16x4, __builtin_amdgcn_ds_read_tr16_b64_v4i16((LAS s16x4*)p)); }
__device__ __forceinline__ float xhalf_max(float v) { auto rr = __builtin_amdgcn_permlane32_swap(__float_as_uint(v), __float_as_uint(v), false, false); return fmaxf(__uint_as_float(rr[0]), __uint_as_float(rr[1])); }
__device__ __forceinline__ float xhalf_sum(float v) { auto rr = __builtin_amdgcn_permlane32_swap(__float_as_uint(v), __float_as_uint(v), false, false); return __uint_as_float(rr[0]) + __uint_as_float(rr[1]); }

template <int DQK>
__device__ __forceinline__ void attn_qk(const LAS unsigned char* kb, int kfo, const bf16x8 (&qf)[DQK / 16], f32x16& p0, f32x16& p1) {
    constexpr int ND0 = DQK / 16;
    bf16x8 ka[ND0], kc[ND0];
#pragma unroll
    for (int d0 = 0; d0 < ND0; ++d0) { ka[d0] = *(const LAS bf16x8*)(kb + kfo + d0 * 2048); kc[d0] = *(const LAS bf16x8*)(kb + kfo + d0 * 2048 + 512); }
    __builtin_amdgcn_sched_barrier(0);
#pragma unroll
    for (int r = 0; r < 16; ++r) { p0[r] = 0.f; p1[r] = 0.f; }
#pragma unroll
    for (int d0 = 0; d0 < ND0; ++d0) {
        p0 = __builtin_amdgcn_mfma_f32_32x32x16_bf16(ka[d0], qf[d0], p0, 0, 0, 0);
        p1 = __builtin_amdgcn_mfma_f32_32x32x16_bf16(kc[d0], qf[d0], p1, 0, 0, 0);
    }
}
template <bool ALIBI>
__device__ __forceinline__ void attn_sv(const LAS unsigned char* kb, int vfo, f32x16& p0, f32x16& p1, float& m, float& l, f32x16& o0, f32x16& o1, int hi, int tq, int kpos0, float slope2, bool causal) {
    s16x4 vlo[8], vhi[8];
    { const unsigned va = (unsigned)(uintptr_t)(kb + vfo);
#pragma unroll
      for (int i = 0; i < 8; ++i) {
        asm volatile("ds_read_b64_tr_b16 %0, %1 offset:%c2" : "=&v"(vlo[i]) : "v"(va), "i"((i >> 2) * 4096 + (i & 3) * 1024) : "memory");
        asm volatile("ds_read_b64_tr_b16 %0, %1 offset:%c2" : "=&v"(vhi[i]) : "v"(va), "i"((i >> 2) * 4096 + (i & 3) * 1024 + 512) : "memory"); } }
    const int krel = kpos0 + 4 * hi - tq;
    if (ALIBI) { const float bb = slope2 * (float)krel;
#pragma unroll
        for (int r = 0; r < 16; ++r) { const float c = (float)((r & 3) + 8 * (r >> 2)); p0[r] += fmaf(slope2, c, bb); p1[r] += fmaf(slope2, c + 32.f, bb); } }
    if (causal) {
#pragma unroll
        for (int r = 0; r < 16; ++r) { const int kv = krel + (r & 3) + 8 * (r >> 2); if (kv > 0) p0[r] = -INFINITY; if (kv + 32 > 0) p1[r] = -INFINITY; } }
    float rm = fmaxf(p0[0], p1[0]);
#pragma unroll
    for (int r = 1; r < 16; ++r) rm = fmaxf(rm, fmaxf(p0[r], p1[r]));
    rm = xhalf_max(rm);
    const float mn = fmaxf(m, rm), alpha = __builtin_amdgcn_exp2f(m - mn);
    m = mn;
    float ls = 0.f;
#pragma unroll
    for (int r = 0; r < 16; ++r) { p0[r] = __builtin_amdgcn_exp2f(p0[r] - mn); p1[r] = __builtin_amdgcn_exp2f(p1[r] - mn); ls += p0[r] + p1[r]; }
    l = l * alpha + ls;
#pragma unroll
    for (int r = 0; r < 16; ++r) { o0[r] *= alpha; o1[r] *= alpha; }
    const u32x4 pw0 = (u32x4){pg8::cvt_pk_bf16(p0[0], p0[1]), pg8::cvt_pk_bf16(p0[2], p0[3]), pg8::cvt_pk_bf16(p0[4], p0[5]), pg8::cvt_pk_bf16(p0[6], p0[7])};
    const u32x4 pw1 = (u32x4){pg8::cvt_pk_bf16(p0[8], p0[9]), pg8::cvt_pk_bf16(p0[10], p0[11]), pg8::cvt_pk_bf16(p0[12], p0[13]), pg8::cvt_pk_bf16(p0[14], p0[15])};
    const u32x4 pw2 = (u32x4){pg8::cvt_pk_bf16(p1[0], p1[1]), pg8::cvt_pk_bf16(p1[2], p1[3]), pg8::cvt_pk_bf16(p1[4], p1[5]), pg8::cvt_pk_bf16(p1[6], p1[7])};
    const u32x4 pw3 = (u32x4){pg8::cvt_pk_bf16(p1[8], p1[9]), pg8::cvt_pk_bf16(p1[10], p1[11]), pg8::cvt_pk_bf16(p1[12], p1[13]), pg8::cvt_pk_bf16(p1[14], p1[15])};
    asm volatile("s_waitcnt lgkmcnt(0)" ::: "memory"); __builtin_amdgcn_sched_barrier(0);
#define ATT_VF(i) (bf16x8){vlo[i][0], vlo[i][1], vlo[i][2], vlo[i][3], vhi[i][0], vhi[i][1], vhi[i][2], vhi[i][3]}
    o0 = __builtin_amdgcn_mfma_f32_32x32x16_bf16(ATT_VF(0), __builtin_bit_cast(bf16x8, pw0), o0, 0, 0, 0);
    o1 = __builtin_amdgcn_mfma_f32_32x32x16_bf16(ATT_VF(4), __builtin_bit_cast(bf16x8, pw0), o1, 0, 0, 0);
    o0 = __builtin_amdgcn_mfma_f32_32x32x16_bf16(ATT_VF(1), __builtin_bit_cast(bf16x8, pw1), o0, 0, 0, 0);
    o1 = __builtin_amdgcn_mfma_f32_32x32x16_bf16(ATT_VF(5), __builtin_bit_cast(bf16x8, pw1), o1, 0, 0, 0);
    o0 = __builtin_amdgcn_mfma_f32_32x32x16_bf16(ATT_VF(2), __builtin_bit_cast(bf16x8, pw2), o0, 0, 0, 0);
    o1 = __builtin_amdgcn_mfma_f32_32x32x16_bf16(ATT_VF(6), __builtin_bit_cast(bf16x8, pw2), o1, 0, 0, 0);
    o0 = __builtin_amdgcn_mfma_f32_32x32x16_bf16(ATT_VF(3), __builtin_bit_cast(bf16x8, pw3), o0, 0, 0, 0);
    o1 = __builtin_amdgcn_mfma_f32_32x32x16_bf16(ATT_VF(7), __builtin_bit_cast(bf16x8, pw3), o1, 0, 0, 0);
#undef ATT_VF
}
template <int DQK, bool ALIBI>
__device__ __forceinline__ void attn_tile(const LAS unsigned char* kb, int kfo, int vfo, const bf16x8 (&qf)[DQK / 16], float& m, float& l, f32x16& o0, f32x16& o1, int hi, int tq, int kpos0, float slope2, bool causal) {
    f32x16 p0, p1;
    attn_qk<DQK>(kb, kfo, qf, p0, p1);
    attn_sv<ALIBI>(kb, vfo, p0, p1, m, l, o0, o1, hi, tq, kpos0, slope2, causal);
}
#define ATT_ISSUE(t, bo) do { \
        for (int c_ = wid; c_ < NCH; c_ += 8) __builtin_amdgcn_global_load_lds((const unsigned*)(ksrc + (size_t)(t) * 64 * ldk + c_ * 8), (LAS unsigned*)(lds + (bo) + c_ * 1024), 16, 0, 0); \
        __builtin_amdgcn_global_load_lds((const unsigned*)(vsrc + (size_t)(t) * 64 * ldv), (LAS unsigned*)(lds + (bo) + KBYTES + wid * 1024), 16, 0, 0); } while (0)

template <int DQK, bool MOBA_OWN>
__device__ __forceinline__ void attn_unit(LAS unsigned char* lds, int b, int h, int qb, const bf16_t* Qp, int ldq, const bf16_t* Kp, int ldk, const bf16_t* Vp, int ldv, bf16_t* Op, int ldo, const bf16_t* PO, const f32x2* PML) {
    constexpr int NCH = DQK / 8, KBYTES = NCH * 1024, BUFB = KBYTES + 8192, ND0 = DQK / 16;
    int tid_ = threadIdx.x; asm volatile("" : "+v"(tid_));
    const int lane = tid_ & 63, r32 = lane & 31, hi = lane >> 5, wid = __builtin_amdgcn_readfirstlane(tid_ >> 6);
    const size_t rowbase = (size_t)b * SEQ; const int q0 = qb * 256, T0 = MOBA_OWN ? 4 * qb : 0, T1 = 4 * (qb + 1), tq = q0 + wid * 32 + r32;
    const bf16_t* ksrc = Kp + (rowbase + lane) * ldk + h * DQK;
    const bf16_t* vsrc = Vp + (rowbase + 16 * (wid & 3) + (lane >> 2)) * ldv + h * 64 + (wid >> 2) * 32 + (lane & 3) * 8;
    ATT_ISSUE(T0, 0); ATT_ISSUE(T0 + 1, BUFB);
    bf16x8 qf[ND0];
    { const bf16_t* qrow = Qp + (rowbase + tq) * ldq + h * DQK + hi * 8;
#pragma unroll
      for (int d0 = 0; d0 < ND0; ++d0) qf[d0] = *(const bf16x8*)(qrow + d0 * 16); }
    const float slope2 = MOBA_OWN ? exp2f(-(float)(h + 1)) * LOG2E : 0.f;
    float m = -1e30f, l = 0.f;
    f32x16 o0, o1;
#pragma unroll
    for (int r = 0; r < 16; ++r) { o0[r] = 0.f; o1[r] = 0.f; }
    const int kfo = hi * 1024 + r32 * 16;
    const int vfo = KBYTES + ((lane >> 4) & 1) * 32 + (lane & 3) * 8 + (4 * hi + ((lane & 15) >> 2)) * 64;
#define ATT_BAR() asm volatile("s_waitcnt vmcnt(0) lgkmcnt(0)\n\ts_barrier" ::: "memory")
    int b0 = 0, b1 = BUFB, b2 = 2 * BUFB;
    f32x16 pA0, pA1, pB0, pB1;
    ATT_BAR();
    attn_qk<DQK>(lds + b0, kfo, qf, pA0, pA1);
#pragma unroll 1
    for (int t = T0; t < T1; t += 2) {
        if (t + 2 < T1) ATT_ISSUE(t + 2, b2);
        attn_qk<DQK>(lds + b1, kfo, qf, pB0, pB1);
        attn_sv<MOBA_OWN>(lds + b0, vfo, pA0, pA1, m, l, o0, o1, hi, tq, 64 * t, slope2, t >= T1 - 4);
        ATT_BAR();
        { const int x = b0; b0 = b1; b1 = b2; b2 = x; }
        if (t + 3 < T1) ATT_ISSUE(t + 3, b2);
        if (t + 2 < T1) attn_qk<DQK>(lds + b1, kfo, qf, pA0, pA1);
        attn_sv<MOBA_OWN>(lds + b0, vfo, pB0, pB1, m, l, o0, o1, hi, tq, 64 * (t + 1), slope2, t + 1 >= T1 - 4);
        ATT_BAR();
        { const int x = b0; b0 = b1; b1 = b2; b2 = x; }
    }
#undef ATT_BAR
    float lt = xhalf_sum(l);
    if (MOBA_OWN) {
        const int nsel = qb < 3 ? qb : 3;
        const size_t pidx = ((rowbase + tq) * 8 + h) * 3;
        float ms[3], ws[3], M = m;
#pragma unroll
        for (int sIdx = 0; sIdx < 3; ++sIdx) { ms[sIdx] = -1e30f; ws[sIdx] = 0.f; if (sIdx < nsel) { const f32x2 ml = PML[(pidx + sIdx) * 16]; ms[sIdx] = ml[0]; ws[sIdx] = ml[1]; M = fmaxf(M, ml[0]); } }
        const float w0 = __builtin_amdgcn_exp2f(m - M);
        lt *= w0;
#pragma unroll
        for (int r = 0; r < 16; ++r) { o0[r] *= w0; o1[r] *= w0; }
#pragma unroll
        for (int sIdx = 0; sIdx < 3; ++sIdx) if (sIdx < nsel) {
            const float w = ws[sIdx] * __builtin_amdgcn_exp2f(ms[sIdx] - M); lt += w;
            const bf16_t* po = PO + (pidx + sIdx) * 64 + 4 * hi;
#pragma unroll
            for (int r4 = 0; r4 < 4; ++r4) { const u32x2 a = *(const u32x2*)(po + 8 * r4), c = *(const u32x2*)(po + 32 + 8 * r4);
                o0[4 * r4] += w * bflo(a.x); o0[4 * r4 + 1] += w * bfhi(a.x); o0[4 * r4 + 2] += w * bflo(a.y); o0[4 * r4 + 3] += w * bfhi(a.y);
                o1[4 * r4] += w * bflo(c.x); o1[4 * r4 + 1] += w * bfhi(c.x); o1[4 * r4 + 2] += w * bflo(c.y); o1[4 * r4 + 3] += w * bfhi(c.y); } }
    }
    const float inv = 1.f / lt;
    bf16_t* orow = Op + (rowbase + tq) * ldo + h * 64 + 4 * hi;
#pragma unroll
    for (int r4 = 0; r4 < 4; ++r4) {
        u32x2 w0_, w1_;
        w0_.x = pg8::cvt_pk_bf16(o0[4 * r4] * inv, o0[4 * r4 + 1] * inv); w0_.y = pg8::cvt_pk_bf16(o0[4 * r4 + 2] * inv, o0[4 * r4 + 3] * inv);
        w1_.x = pg8::cvt_pk_bf16(o1[4 * r4] * inv, o1[4 * r4 + 1] * inv); w1_.y = pg8::cvt_pk_bf16(o1[4 * r4 + 2] * inv, o1[4 * r4 + 3] * inv);
        *(u32x2*)(orow + 8 * r4) = w0_; *(u32x2*)(orow + 32 + 8 * r4) = w1_;
    }
    asm volatile("s_waitcnt lgkmcnt(0)\n\ts_barrier" ::: "memory");
}
__device__ __forceinline__ void moba_sel_unit(LAS unsigned char* lds, int b, int h, int j, int slo, int shi, const bf16_t* Qp, const bf16_t* Kp, const bf16_t* Vp, int ldk, const unsigned* SEL, bf16_t* PO, f32x2* PML) {
    constexpr int DQK = 64, NCH = 8, KBYTES = 8192, BUFB = 16384, ldv = INCP; (void)ldv;
    int tid_ = threadIdx.x; asm volatile("" : "+v"(tid_));
    const int lane = tid_ & 63, r32 = lane & 31, hi = lane >> 5, wid = __builtin_amdgcn_readfirstlane(tid_ >> 6);
    const size_t rowbase = (size_t)b * SEQ;
    const bf16_t* ksrc = Kp + (rowbase + lane) * ldk + h * DQK;
    const bf16_t* vsrc = Vp + (rowbase + 16 * (wid & 3) + (lane >> 2)) * ldk + h * 64 + (wid >> 2) * 32 + (lane & 3) * 8;
#pragma unroll
    for (int tt = 0; tt < 4; ++tt) ATT_ISSUE(4 * j + tt, tt * BUFB);
    LAS unsigned short* list = (LAS unsigned short*)(lds + 4 * BUFB);
    LAS int* cnt = (LAS int*)(lds + 4 * BUFB + 4096);
    if (tid_ == 0) *cnt = 0;
    __syncthreads();
    const int nsrc = (shi - slo) * 256;
    for (int i = tid_; i < nsrc; i += NTHR) {
        const unsigned sm = SEL[(rowbase + (size_t)slo * 256 + i) * 8 + h];
        const bool f = ((sm >> j) & 1u) != 0u;
        const unsigned long long bal = __ballot(f);
        const int rank = __builtin_amdgcn_mbcnt_hi((unsigned)(bal >> 32), __builtin_amdgcn_mbcnt_lo((unsigned)bal, 0u));
        int base = 0;
        if (lane == 0) base = __hip_atomic_fetch_add(cnt, (int)__builtin_popcountll(bal), __ATOMIC_RELAXED, __HIP_MEMORY_SCOPE_WORKGROUP);
        base = __builtin_amdgcn_readfirstlane(base);
        if (f) list[base + rank] = (unsigned short)i;
    }
    asm volatile("s_waitcnt vmcnt(0)" ::: "memory");
    __syncthreads();
    const int n = *cnt, nch = (n + 31) >> 5;
    const float slope2 = exp2f(-(float)(h + 1)) * LOG2E;
    const int kfo = hi * 1024 + r32 * 16;
    const int vfo = KBYTES + ((lane >> 4) & 1) * 32 + (lane & 3) * 8 + (4 * hi + ((lane & 15) >> 2)) * 64;
    for (int ch = wid; ch < nch; ch += 8) {
        const int e = ch * 32 + r32; const bool valid = e < n;
        const int tq = slo * 256 + (int)list[valid ? e : n - 1];
        bf16x8 qf[4];
        { const bf16_t* qrow = Qp + (rowbase + tq) * INCP + h * DQK + hi * 8;
#pragma unroll
          for (int d0 = 0; d0 < 4; ++d0) qf[d0] = *(const bf16x8*)(qrow + d0 * 16); }
        const unsigned sm = SEL[(rowbase + tq) * 8 + h];
        float m = -1e30f, l = 0.f;
        f32x16 o0, o1;
#pragma unroll
        for (int r = 0; r < 16; ++r) { o0[r] = 0.f; o1[r] = 0.f; }
        { f32x16 pA0, pA1, pB0, pB1;
          attn_qk<64>(lds, kfo, qf, pA0, pA1);
          attn_qk<64>(lds + BUFB, kfo, qf, pB0, pB1);
          attn_sv<true>(lds, vfo, pA0, pA1, m, l, o0, o1, hi, tq, 256 * j, slope2, false);
          attn_qk<64>(lds + 2 * BUFB, kfo, qf, pA0, pA1);
          attn_sv<true>(lds + BUFB, vfo, pB0, pB1, m, l, o0, o1, hi, tq, 256 * j + 64, slope2, false);
          attn_qk<64>(lds + 3 * BUFB, kfo, qf, pB0, pB1);
          attn_sv<true>(lds + 2 * BUFB, vfo, pA0, pA1, m, l, o0, o1, hi, tq, 256 * j + 128, slope2, false);
          attn_sv<true>(lds + 3 * BUFB, vfo, pB0, pB1, m, l, o0, o1, hi, tq, 256 * j + 192, slope2, false); }
        const float lt = xhalf_sum(l), inv = 1.f / lt;
        if (valid) {
            const size_t pidx = ((rowbase + tq) * 8 + h) * 3 + __builtin_popcount(sm & ((1u << j) - 1u));
            if (hi == 0) PML[pidx * 16] = (f32x2){m, lt};
            bf16_t* po = PO + pidx * 64 + 4 * hi;
#pragma unroll
            for (int r4 = 0; r4 < 4; ++r4) {
                u32x2 w0_, w1_;
                w0_.x = pg8::cvt_pk_bf16(o0[4 * r4] * inv, o0[4 * r4 + 1] * inv); w0_.y = pg8::cvt_pk_bf16(o0[4 * r4 + 2] * inv, o0[4 * r4 + 3] * inv);
                w1_.x = pg8::cvt_pk_bf16(o1[4 * r4] * inv, o1[4 * r4 + 1] * inv); w1_.y = pg8::cvt_pk_bf16(o1[4 * r4 + 2] * inv, o1[4 * r4 + 3] * inv);
                *(u32x2*)(po + 8 * r4) = w0_; *(u32x2*)(po + 32 + 8 * r4) = w1_;
            }
        }
    }
    __syncthreads();
}
#undef ATT_ISSUE
__device__ __forceinline__ void mla_phase(const Frame& F, const bf16_t* QB, const bf16_t* KB, const bf16_t* VB, bf16_t* Op) {
    for (int u = 2 * F.vcu; u < 512; u += 2 * F.G) {
#pragma unroll 1
        for (int k = 0; k < 2; ++k) { const int uu = u + k, bh = uu >> 5, w = uu & 31, qb = (w & 1) ? (w >> 1) : 31 - (w >> 1);
            attn_unit<96, false>(F.lds, bh >> 3, bh & 7, qb, QB, 768, KB, 768, VB, 512, Op, 1024, nullptr, nullptr); }
    }
}
__device__ __forceinline__ void moba_sel_phase(const Frame& F, const bf16_t* PROJ, const unsigned* SEL, bf16_t* PO, f32x2* PML) {
#pragma unroll 1
    for (int u = (int)blockIdx.x; u < 16 * 136; u += F.G) {
        int p = 0; while (16 * (2 * (p + 1) * (p + 1) + (p + 1)) <= u) ++p;
        const int r = u - 16 * (2 * p * p + p), j = r >> 4, bh = r & 15;
        const int slo = (j + 1 > 4 * p) ? j + 1 : 4 * p, shi = 4 * p + 4;
        moba_sel_unit(F.lds, bh >> 3, bh & 7, j, slo, shi, PROJ + C_QA, PROJ + C_KA, PROJ + C_VA, INCP, SEL, PO, PML);
    }
}
__device__ __forceinline__ void moba_own_phase(const Frame& F, const bf16_t* PROJ, bf16_t* Op, const bf16_t* PO, const f32x2* PML) {
#pragma unroll 1
    for (int u = F.vcu; u < 512; u += F.G) { const int bh = u >> 5, qb = u & 31;
        attn_unit<64, true>(F.lds, bh >> 3, bh & 7, qb, PROJ + C_QA, INCP, PROJ + C_KA, INCP, PROJ + C_VA, INCP, Op, 1024, PO, PML); }
}

constexpr int NPH_L = 16;
__global__ void __launch_bounds__(NTHR, 2) mk(Params p) {
    extern __shared__ __attribute__((aligned(16))) unsigned char lds_raw[];
    Frame F;
    F.lds = (LAS unsigned char*)lds_raw;
    F.tid = threadIdx.x; F.lane = F.tid & 63; F.wave = __builtin_amdgcn_readfirstlane(F.tid >> 6);
    F.G = gridDim.x; { const int bx = blockIdx.x; F.vcu = (F.G % 8 == 0) ? (bx % 8) * (F.G / 8) + bx / 8 : bx; }
    volatile LAS unsigned* MISC = (volatile LAS unsigned*)(F.lds + MISC_OFF);
    if (F.tid < 32) MISC[F.tid] = 0u;
    __syncthreads();
    unsigned char* ws = p.ws;
    unsigned* ctl = (unsigned*)(ws + WS_CTL);
    XcdBarrier bar = xcd_barrier_post(ctl + CW_BAR, MISC + 8);
    const int lo = p.ph_lo, hi = p.ph_hi;
#define IN(k) (lo <= (k) && (k) < hi)
#define SEAM(k) do { if (IN(k) && IN((k) + 1)) xcd_barrier(bar); } while (0)
    bf16_t* WinT = (bf16_t*)(ws + WS_WIN);
    bf16_t* XB = (bf16_t*)(ws + WS_XB);
    bf16_t* PROJ = (bf16_t*)(ws + WS_PROJ);
    bf16_t* WuqT = (bf16_t*)(ws + WS_WUQ); bf16_t* WukvT = (bf16_t*)(ws + WS_WUKV);
    f32x2* CS = (f32x2*)(ws + WS_CS); float* KM = (float*)(ws + WS_KM); unsigned* SEL = (unsigned*)(ws + WS_SEL);
    bf16_t* CQN = (bf16_t*)(ws + WS_CQN); bf16_t* CKVN = (bf16_t*)(ws + WS_CKVN);
    bf16_t* WpaT = (bf16_t*)(ws + WS_WPA); bf16_t* WpbT = (bf16_t*)(ws + WS_WPB); bf16_t* WoutT = (bf16_t*)(ws + WS_WOUT);
    bf16_t* TMP = (bf16_t*)(ws + WS_TMP); bf16_t* MRG = (bf16_t*)(ws + WS_MRG); bf16_t* PRE = (bf16_t*)(ws + WS_PRE); bf16_t* X1B = (bf16_t*)(ws + WS_X1B);
    bf16_t* WrtT = (bf16_t*)(ws + WS_WRT); bf16_t* WsguT = (bf16_t*)(ws + WS_WSGU); bf16_t* WsdT = (bf16_t*)(ws + WS_WSD); bf16_t* WeguT = (bf16_t*)(ws + WS_WEGU); bf16_t* WedT = (bf16_t*)(ws + WS_WED);
    float* LOGITS = (float*)(ws + WS_LOG); bf16_t* HS = (bf16_t*)(ws + WS_HS); bf16_t* SH = (bf16_t*)(ws + WS_SH);
    int* TOPE = (int*)(ws + WS_TOPE); float* TOPW = (float*)(ws + WS_TOPW); int* APOS = (int*)(ws + WS_APOS); int* ROWA = (int*)(ws + WS_ROWA);
    bf16_t* PO = (bf16_t*)(ws + WS_PO); f32x2* PML = (f32x2*)(ws + WS_PML);
    bf16_t* HE = (bf16_t*)(ws + WS_HE); bf16_t* Yb = (bf16_t*)(ws + WS_Y); int* HIST = (int*)(ws + WS_HIST);
    LAS int* t_off = (LAS int*)(F.lds + TAB_OFF); LAS int* t_toff = t_off + 260;
    bf16_t* QB = (bf16_t*)(ws + WS_QB); bf16_t* KB = (bf16_t*)(ws + WS_KB); bf16_t* VB = (bf16_t*)(ws + WS_VB); bf16_t* OAB = (bf16_t*)(ws + WS_OAB);
    const int gw = F.vcu * NWAVES + F.wave, NGW = F.G * NWAVES;

    if (IN(0)) {
        LAS float* scr = (LAS float*)(F.lds + F.wave * 16384);
        constexpr int I_IN = (DM / 64) * (INC / 32);
        for (int it = gw; it < DEPTH * I_IN; it += NGW) { const int l = it / I_IN, r = it % I_IN;
            transpose_item(p.in[1] + (size_t)l * DM * INC, DM, INC, WinT + (size_t)l * SZ_WIN, DM, RowId{}, scr, r, F.lane); }
        { constexpr int I_UQ = (QL / 64) * (768 / 32), I_UKV = (KVL / 64) * (1024 / 32);
          for (int it = gw; it < DEPTH * (I_UQ + I_UKV); it += NGW) { const int l = it / (I_UQ + I_UKV), r = it % (I_UQ + I_UKV);
            if (r < I_UQ) transpose_item(p.in[4] + (size_t)l * QL * 768, QL, 768, WuqT + (size_t)l * SZ_WUQ, QL, RowQ{}, scr, r, F.lane);
            else transpose_item(p.in[6] + (size_t)l * KVL * 1024, KVL, 1024, WukvT + (size_t)l * SZ_WUKV, KVL, RowId{}, scr, r - I_UQ, F.lane); } }
        { constexpr int I_P = (512 / 64) * (DM / 32), I_O = (DM / 64) * (DM / 32), I_ALL = 2 * I_P + I_O;
          for (int it = gw; it < DEPTH * I_ALL; it += NGW) { const int l = it / I_ALL; int r = it % I_ALL;
            if (r < I_P) { transpose_item(p.in[7] + (size_t)l * 512 * DM, 512, DM, WpaT + (size_t)l * 2 * SZ_WP, 1024, RowId{}, scr, r, F.lane); continue; } r -= I_P;
            if (r < I_P) { transpose_item(p.in[8] + (size_t)l * 512 * DM, 512, DM, WpaT + (size_t)l * 2 * SZ_WP + 512, 1024, RowId{}, scr, r, F.lane); continue; } r -= I_P;
            transpose_item(p.in[9] + (size_t)l * DM * DM, DM, DM, WoutT + (size_t)l * SZ_WOUT, DM, RowId{}, scr, r, F.lane); } }
        { constexpr int I_R = (DM / 64) * (NE / 32), I_G = (DM / 64) * (DSH / 32), I_D = (DSH / 64) * (DM / 32), I_ALL = I_R + 2 * I_G + I_D;
          for (int it = gw; it < DEPTH * I_ALL; it += NGW) { const int l = it / I_ALL; int r = it % I_ALL;
            if (r < I_R) { transpose_item(p.in[12] + (size_t)l * DM * NE, DM, NE, WrtT + (size_t)l * SZ_WRT, DM, RowId{}, scr, r, F.lane); continue; } r -= I_R;
            if (r < I_G) { transpose_item(p.in[17] + (size_t)l * DM * DSH, DM, DSH, WsguT + (size_t)l * SZ_WSGU, DM, RowGU{0}, scr, r, F.lane); continue; } r -= I_G;
            if (r < I_G) { transpose_item(p.in[18] + (size_t)l * DM * DSH, DM, DSH, WsguT + (size_t)l * SZ_WSGU, DM, RowGU{128}, scr, r, F.lane); continue; } r -= I_G;
            transpose_item(p.in[19] + (size_t)l * DSH * DM, DSH, DM, WsdT + (size_t)l * SZ_WSD, DSH, RowId{}, scr, r, F.lane); } }
        { constexpr int I_G = (DM / 64) * (DE / 64), I_D = (DE / 64) * (DM / 64), I_E = 2 * I_G + I_D;
          LAS unsigned short* scr16 = (LAS unsigned short*)(F.lds + F.wave * 16384);
          for (int it = gw; it < DEPTH * NE * I_E; it += NGW) { const int le = it / I_E; int r = it % I_E;
            if (r < I_G) { transpose_item64(p.in[14] + (size_t)le * DM * DE, DM, DE, WeguT + (size_t)le * 512 * DM, DM, RowGU{0}, scr16, r, F.lane); continue; } r -= I_G;
            if (r < I_G) { transpose_item64(p.in[15] + (size_t)le * DM * DE, DM, DE, WeguT + (size_t)le * 512 * DM, DM, RowGU{128}, scr16, r, F.lane); continue; } r -= I_G;
            transpose_item64(p.in[16] + (size_t)le * DE * DM, DE, DM, WedT + (size_t)le * DM * DE, DE, RowPermD{}, scr16, r, F.lane); } }
        for (int i = blockIdx.x * NTHR + F.tid; i < SEQ * 16; i += F.G * NTHR) { const int pos = i >> 4, k = i & 15;
            const float inv = powf(10000.f, -(float)(2 * k) / 32.f), ang = (float)pos * inv; CS[i] = (f32x2){cosf(ang), sinf(ang)}; }
        for (int i = blockIdx.x * NTHR + F.tid; i < DEPTH * 12288; i += F.G * NTHR) { const int l = i / 12288, r = i % 12288;
            *(u32x4*)(WinT + (size_t)l * SZ_WIN + (size_t)INC * DM + (size_t)r * 8) = (u32x4){0u, 0u, 0u, 0u}; }
        for (int i = blockIdx.x * NTHR + F.tid; i < T * DM / 8; i += F.G * NTHR) { const f32x4 a = *(const f32x4*)(p.in[0] + (size_t)i * 8), b = *(const f32x4*)(p.in[0] + (size_t)i * 8 + 4);
            u32x4 w; w.x = pk2(a[0], a[1]); w.y = pk2(a[2], a[3]); w.z = pk2(b[0], b[1]); w.w = pk2(b[2], b[3]); *(u32x4*)(XB + (size_t)i * 8) = w; }
    }
    SEAM(0);

    {
        const int l = 0; const int pb = 1 + l * NPH_L;
        if (IN(pb + 0)) {
            pg8::Gemm g{XB, WinT + (size_t)l * SZ_WIN, T, INCP, DM, DM, DM}; pg8::StaticOrder S; S.init(T, INCP - 256, F.G, (int)blockIdx.x);
            EpiProj E{PROJ, p.in[2] + (size_t)l * 2 * DM};
            pg8::gemm_phase<EpiProj, pg8::StaticOrder, true>(F.lds, g, S, E);
        }
        SEAM(pb + 0);
        if (IN(pb + 1)) prep_phase(F, PROJ, p.in[3] + (size_t)l * QL, p.in[5] + (size_t)l * KVL, CS, CQN, CKVN, KB, KM);
        SEAM(pb + 1);
        if (IN(pb + 2)) {
            mobasel_phase(F, PROJ, KM, SEL);
            { pg8::Gemm g{CKVN, WukvT + (size_t)l * SZ_WUKV, T, 1024, KVL, KVL, KVL}; pg8::StaticOrder S; S.init(T, 1024, F.G, (int)blockIdx.x);
              EpiKV E{KB, VB}; pg8::gemm_phase<EpiKV, pg8::StaticOrder, true>(F.lds, g, S, E); }
            { pg8::Gemm g{CQN, WuqT + (size_t)l * SZ_WUQ, T, 768, QL, QL, QL}; pg8::StaticOrder S; S.init(T, 768, F.G, (int)blockIdx.x);
              EpiQ E{QB, CS}; pg8::gemm_phase<EpiQ, pg8::StaticOrder, true>(F.lds, g, S, E); }
            { pg8::Gemm g{XB, WinT + (size_t)l * SZ_WIN, T, INCP, DM, DM, DM}; pg8::OffsetOrder S; S.init(T, 256, F.G, (int)((blockIdx.x + 64) % F.G)); S.pn0 = 16;
              EpiProj E{PROJ, p.in[2] + (size_t)l * 2 * DM}; pg8::gemm_phase<EpiProj, pg8::OffsetOrder, true>(F.lds, g, S, E); }
        }
        SEAM(pb + 2);
        if (IN(pb + 3)) {
            mla_phase(F, QB, KB, VB, OAB + 512);
            moba_sel_phase(F, PROJ, SEL, PO, PML);
        }
        SEAM(pb + 3);
        if (IN(pb + 4)) moba_own_phase(F, PROJ, OAB, PO, PML);
        SEAM(pb + 4);
        if (IN(pb + 5)) {
            pg8::Gemm g{OAB, WpaT + (size_t)l * 2 * SZ_WP, T, DM, DM, 1024, 1024}; pg8::StaticOrder S; S.init(T, DM, F.G, (int)blockIdx.x);
            EpiGate2 E{PROJ, MRG}; pg8::gemm_phase<EpiGate2, pg8::StaticOrder, true>(F.lds, g, S, E);
        }
        SEAM(pb + 5);
        if (IN(pb + 6)) {
            pg8::Gemm g{MRG, WoutT + (size_t)l * SZ_WOUT, T, DM, DM, DM, DM}; pg8::StaticOrder S; S.init(T, DM, F.G, (int)blockIdx.x);
            EpiResid E{XB, PRE}; pg8::gemm_phase<EpiResid, pg8::StaticOrder, true>(F.lds, g, S, E);
        }
        SEAM(pb + 6);
        if (IN(pb + 7)) ln_phase(F, PRE, p.in[10] + (size_t)l * DM, p.in[11] + (size_t)l * DM, X1B);
        SEAM(pb + 7);
        if (IN(pb + 8)) {
            { pg8::Gemm g{X1B, WrtT + (size_t)l * SZ_WRT, T, NE, DM, DM, DM}; pg8::StaticOrder S; S.init(T, NE, F.G, (int)blockIdx.x);
              EpiF32 E{LOGITS, NE}; pg8::gemm_phase<EpiF32, pg8::StaticOrder, true>(F.lds, g, S, E); }
            { pg8::Gemm g{X1B, WsguT + (size_t)l * SZ_WSGU, T, 512, DM, DM, DM}; pg8::StaticOrder S; S.init(T, 512, F.G, (int)((blockIdx.x + F.G / 2) % F.G));
              EpiSwiGLU E{HS, DSH}; pg8::gemm_phase<EpiSwiGLU, pg8::StaticOrder, true>(F.lds, g, S, E); }
        }
        SEAM(pb + 8);
        if (IN(pb + 9)) {
            route_phase(F, LOGITS, p.in[13] + (size_t)l * NE, TOPE, TOPW, APOS, HIST, t_off);
            pg8::Gemm g{HS, WsdT + (size_t)l * SZ_WSD, T, DM, DSH, DSH, DSH}; pg8::StaticOrder S; S.init(T, DM, F.G, (int)blockIdx.x);
            EpiBf16 E{SH, DM}; pg8::gemm_phase<EpiBf16, pg8::StaticOrder, true>(F.lds, g, S, E);
        }
        SEAM(pb + 9);
        if (IN(pb + 10)) {
            int tid_ = F.tid; asm volatile("" : "+v"(tid_));
            if (tid_ < 256) { int tot = 0, base = 0; for (int c = 0; c < F.G; ++c) { const int v = HIST[(size_t)c * 256 + tid_]; base += (c < (int)blockIdx.x) ? v : 0; tot += v; }
                t_off[tid_] = tot; t_toff[tid_] = base; if (blockIdx.x == 0) ctl[CW_CNT + l * 256 + tid_] = (unsigned)tot; }
            __syncthreads();
            if (tid_ == 0) { int a = 0; for (int i = 0; i < 256; ++i) { const int c = t_off[i]; t_off[i] = a; a += c; } }
            __syncthreads();
            const int TPW = T / F.G, a0 = (int)blockIdx.x * TPW * TOPK;
            for (int a = a0 + tid_; a < a0 + TPW * TOPK; a += NTHR) { const int e = TOPE[a]; const int row = t_off[e] + t_toff[e] + APOS[a]; *(u32x2*)(ROWA + 2 * (size_t)row) = (u32x2){(unsigned)a, 0u}; APOS[a] = row; }
            __syncthreads();
        }
        SEAM(pb + 10);
        if (IN(pb + 11)) {
            expert_tables(F, ctl + CW_CNT + l * 256, t_off, t_toff);
            pg8::Gemm g{X1B, WeguT + (size_t)l * SZ_WEGU, T, 512, DM, DM, DM};
            ExpertOrder<2, true> S{t_off, t_toff, ROWA, F.G, F.vcu, (size_t)512 * DM * 2};
            EpiSwiGLU E{HE, DE}; pg8::gemm_phase<EpiSwiGLU, ExpertOrder<2, true>, true>(F.lds, g, S, E);
        }
        SEAM(pb + 11);
        if (IN(pb + 12)) {
            expert_tables(F, ctl + CW_CNT + l * 256, t_off, t_toff);
            pg8::Gemm g{HE, WedT + (size_t)l * SZ_WED, NA, DM, DE, DE, DE};
            ExpertOrder<4, false> S{t_off, t_toff, ROWA, F.G, F.vcu, (size_t)DM * DE * 2};
            EpiExpDown E{(unsigned char*)Yb}; pg8::gemm_phase<EpiExpDown, ExpertOrder<4, false>, true>(F.lds, g, S, E);
        }
        SEAM(pb + 12);
        if (IN(pb + 13)) combine_phase(F, X1B, SH, (const unsigned char*)Yb, APOS, TOPW, p.in[20] + (size_t)l * DM, p.in[21] + (size_t)l * DM, l == DEPTH - 1 ? p.out : (float*)nullptr, l == DEPTH - 1 ? (bf16_t*)nullptr : XB);
        SEAM(pb + 13);
    }

    {
        const int l = 1; const int pb = 1 + l * NPH_L;
        if (IN(pb + 0)) {
            pg8::Gemm g{XB, WinT + (size_t)l * SZ_WIN, T, INCP, DM, DM, DM}; pg8::StaticOrder S; S.init(T, INCP - 256, F.G, (int)blockIdx.x);
            EpiProj E{PROJ, p.in[2] + (size_t)l * 2 * DM};
            pg8::gemm_phase<EpiProj, pg8::StaticOrder, true>(F.lds, g, S, E);
        }
        SEAM(pb + 0);
        if (IN(pb + 1)) prep_phase(F, PROJ, p.in[3] + (size_t)l * QL, p.in[5] + (size_t)l * KVL, CS, CQN, CKVN, KB, KM);
        SEAM(pb + 1);
        if (IN(pb + 2)) {
            mobasel_phase(F, PROJ, KM, SEL);
            { pg8::Gemm g{CKVN, WukvT + (size_t)l * SZ_WUKV, T, 1024, KVL, KVL, KVL}; pg8::StaticOrder S; S.init(T, 1024, F.G, (int)blockIdx.x);
              EpiKV E{KB, VB}; pg8::gemm_phase<EpiKV, pg8::StaticOrder, true>(F.lds, g, S, E); }
            { pg8::Gemm g{CQN, WuqT + (size_t)l * SZ_WUQ, T, 768, QL, QL, QL}; pg8::StaticOrder S; S.init(T, 768, F.G, (int)blockIdx.x);
              EpiQ E{QB, CS}; pg8::gemm_phase<EpiQ, pg8::StaticOrder, true>(F.lds, g, S, E); }
            { pg8::Gemm g{XB, WinT + (size_t)l * SZ_WIN, T, INCP, DM, DM, DM}; pg8::OffsetOrder S; S.init(T, 256, F.G, (int)((blockIdx.x + 64) % F.G)); S.pn0 = 16;
              EpiProj E{PROJ, p.in[2] + (size_t)l * 2 * DM}; pg8::gemm_phase<EpiProj, pg8::OffsetOrder, true>(F.lds, g, S, E); }
        }
        SEAM(pb + 2);
        if (IN(pb + 3)) {
            mla_phase(F, QB, KB, VB, OAB + 512);
            moba_sel_phase(F, PROJ, SEL, PO, PML);
        }
        SEAM(pb + 3);
        if (IN(pb + 4)) moba_own_phase(F, PROJ, OAB, PO, PML);
        SEAM(pb + 4);
        if (IN(pb + 5)) {
            pg8::Gemm g{OAB, WpaT + (size_t)l * 2 * SZ_WP, T, DM, DM, 1024, 1024}; pg8::StaticOrder S; S.init(T, DM, F.G, (int)blockIdx.x);
            EpiGate2 E{PROJ, MRG}; pg8::gemm_phase<EpiGate2, pg8::StaticOrder, true>(F.lds, g, S, E);
        }
        SEAM(pb + 5);
        if (IN(pb + 6)) {
            pg8::Gemm g{MRG, WoutT + (size_t)l * SZ_WOUT, T, DM, DM, DM, DM}; pg8::StaticOrder S; S.init(T, DM, F.G, (int)blockIdx.x);
            EpiResid E{XB, PRE}; pg8::gemm_phase<EpiResid, pg8::StaticOrder, true>(F.lds, g, S, E);
        }
        SEAM(pb + 6);
        if (IN(pb + 7)) ln_phase(F, PRE, p.in[10] + (size_t)l * DM, p.in[11] + (size_t)l * DM, X1B);
        SEAM(pb + 7);
        if (IN(pb + 8)) {
            { pg8::Gemm g{X1B, WrtT + (size_t)l * SZ_WRT, T, NE, DM, DM, DM}; pg8::StaticOrder S; S.init(T, NE, F.G, (int)blockIdx.x);
              EpiF32 E{LOGITS, NE}; pg8::gemm_phase<EpiF32, pg8::StaticOrder, true>(F.lds, g, S, E); }
            { pg8::Gemm g{X1B, WsguT + (size_t)l * SZ_WSGU, T, 512, DM, DM, DM}; pg8::StaticOrder S; S.init(T, 512, F.G, (int)((blockIdx.x + F.G / 2) % F.G));
              EpiSwiGLU E{HS, DSH}; pg8::gemm_phase<EpiSwiGLU, pg8::StaticOrder, true>(F.lds, g, S, E); }
        }
        SEAM(pb + 8);
        if (IN(pb + 9)) {
            route_phase(F, LOGITS, p.in[13] + (size_t)l * NE, TOPE, TOPW, APOS, HIST, t_off);
            pg8::Gemm g{HS, WsdT + (size_t)l * SZ_WSD, T, DM, DSH, DSH, DSH}; pg8::StaticOrder S; S.init(T, DM, F.G, (int)blockIdx.x);
            EpiBf16 E{SH, DM}; pg8::gemm_phase<EpiBf16, pg8::StaticOrder, true>(F.lds, g, S, E);
        }
        SEAM(pb + 9);
        if (IN(pb + 10)) {
            int tid_ = F.tid; asm volatile("" : "+v"(tid_));
            if (tid_ < 256) { int tot = 0, base = 0; for (int c = 0; c < F.G; ++c) { const int v = HIST[(size_t)c * 256 + tid_]; base += (c < (int)blockIdx.x) ? v : 0; tot += v; }
                t_off[tid_] = tot; t_toff[tid_] = base; if (blockIdx.x == 0) ctl[CW_CNT + l * 256 + tid_] = (unsigned)tot; }
            __syncthreads();
            if (tid_ == 0) { int a = 0; for (int i = 0; i < 256; ++i) { const int c = t_off[i]; t_off[i] = a; a += c; } }
            __syncthreads();
            const int TPW = T / F.G, a0 = (int)blockIdx.x * TPW * TOPK;
            for (int a = a0 + tid_; a < a0 + TPW * TOPK; a += NTHR) { const int e = TOPE[a]; const int row = t_off[e] + t_toff[e] + APOS[a]; *(u32x2*)(ROWA + 2 * (size_t)row) = (u32x2){(unsigned)a, 0u}; APOS[a] = row; }
            __syncthreads();
        }
        SEAM(pb + 10);
        if (IN(pb + 11)) {
            expert_tables(F, ctl + CW_CNT + l * 256, t_off, t_toff);
            pg8::Gemm g{X1B, WeguT + (size_t)l * SZ_WEGU, T, 512, DM, DM, DM};
            ExpertOrder<2, true> S{t_off, t_toff, ROWA, F.G, F.vcu, (size_t)512 * DM * 2};
            EpiSwiGLU E{HE, DE}; pg8::gemm_phase<EpiSwiGLU, ExpertOrder<2, true>, true>(F.lds, g, S, E);
        }
        SEAM(pb + 11);
        if (IN(pb + 12)) {
            expert_tables(F, ctl + CW_CNT + l * 256, t_off, t_toff);
            pg8::Gemm g{HE, WedT + (size_t)l * SZ_WED, NA, DM, DE, DE, DE};
            ExpertOrder<4, false> S{t_off, t_toff, ROWA, F.G, F.vcu, (size_t)DM * DE * 2};
            EpiExpDown E{(unsigned char*)Yb}; pg8::gemm_phase<EpiExpDown, ExpertOrder<4, false>, true>(F.lds, g, S, E);
        }
        SEAM(pb + 12);
        if (IN(pb + 13)) combine_phase(F, X1B, SH, (const unsigned char*)Yb, APOS, TOPW, p.in[20] + (size_t)l * DM, p.in[21] + (size_t)l * DM, l == DEPTH - 1 ? p.out : (float*)nullptr, l == DEPTH - 1 ? (bf16_t*)nullptr : XB);
        SEAM(pb + 13);
    }

#undef IN
#undef SEAM
}

__global__ void __launch_bounds__(256) cvt_proj(const bf16_t* __restrict__ P, float* proj) {
    const size_t i = (size_t)blockIdx.x * 256 + threadIdx.x;
    const int row = (int)(i / INC), c = (int)(i % INC);
    float v = bf2f(P[(size_t)row * INCP + c]);
    if (c < C_KA) v *= (1.f / QS_A);
    proj[i] = v;
}
__global__ void __launch_bounds__(256) cvt_oab(const bf16_t* __restrict__ OAB, float* oa, float* ob) {
    const size_t i = (size_t)blockIdx.x * 256 + threadIdx.x; const size_t row = i >> 10; const int c = (int)(i & 1023);
    const float v = bf2f(OAB[i]);
    if (c < 512) oa[row * 512 + c] = v; else ob[row * 512 + c - 512] = v;
}
__global__ void __launch_bounds__(256) cvt_x(const float* __restrict__ x, bf16_t* XB) {
    const size_t i = (size_t)blockIdx.x * 256 + threadIdx.x;
    const f32x4 a = *(const f32x4*)(x + i * 8), b = *(const f32x4*)(x + i * 8 + 4);
    u32x4 w; w.x = pk2(a[0], a[1]); w.y = pk2(a[2], a[3]); w.z = pk2(b[0], b[1]); w.w = pk2(b[2], b[3]); *(u32x4*)(XB + i * 8) = w;
}
}
static int g_grid = 0;
static bool fast_setup() {
    if (g_grid) return g_grid > 0;
    int dev = 0, cus = 0, per_cu = 0;
    if (hipGetDevice(&dev) != hipSuccess || hipDeviceGetAttribute(&cus, hipDeviceAttributeMultiprocessorCount, dev) != hipSuccess) { g_grid = -1; return false; }
    if (hipFuncSetAttribute((const void*)fk::mk, hipFuncAttributeMaxDynamicSharedMemorySize, fk::LDS_BYTES) != hipSuccess) { fprintf(stderr, "hipFuncSetAttribute failed\n"); g_grid = -1; return false; }
    if (hipOccupancyMaxActiveBlocksPerMultiprocessor(&per_cu, (const void*)fk::mk, fk::NTHR, fk::LDS_BYTES) != hipSuccess || per_cu < 1) { fprintf(stderr, "occupancy query: %d\n", per_cu); }
    (void)hipGetLastError();
    g_grid = cus;
    if (cus > 1024 || T % cus != 0 || (T / cus) > 64) { fprintf(stderr, "unsupported CU count %d\n", cus); g_grid = -1; return false; }
    return true;
}
static void launch_mk(fk::Params& p, int lo, int hi, hipStream_t stream) {
    p.ph_lo = lo; p.ph_hi = hi;
    hipLaunchKernelGGL(fk::mk, dim3(g_grid), dim3(fk::NTHR), fk::LDS_BYTES, stream, p);
}

extern "C" void kernel_launch(void* const* d_in, const int* in_sizes, int n_in, void* d_out, int out_size, void* d_ws, size_t ws_size, hipStream_t stream) {
    if (!fast_setup()) return;
    if (ws_size < fk::WS_NEED) { fprintf(stderr, "workspace too small: need %zu have %zu\n", (size_t)fk::WS_NEED, ws_size); return; }
    (void)hipMemsetAsync((char*)d_ws + fk::WS_CTL, 0, fk::CTL_BYTES, stream);
    fk::Params P{};
    for (int i = 0; i < 22; ++i) P.in[i] = (const float*)d_in[i];
    P.out = (float*)d_out; P.ws = (unsigned char*)d_ws;
#if MK_ONE_LAUNCH
    launch_mk(P, 0, 1 + DEPTH * fk::NPH_L, stream);
#else
    launch_mk(P, 0, 1, stream);
    for (int l = 0; l < DEPTH; ++l) for (int k = 0; k < 14; ++k) launch_mk(P, 1 + l * fk::NPH_L + k, 2 + l * fk::NPH_L + k, stream);
#endif
}
```

```cpp
#ifndef MK_ONE_LAUNCH
#define MK_ONE_LAUNCH 1
#endif
#include <hip/hip_runtime.h>
#include <cstdint>
#include <cstdio>

constexpr int NB = 2, SEQ = 8192, T = NB * SEQ, DM = 1024, DEPTH = 2;
constexpr int HA = 8, WA = 512, BLK = 256, NBLK = SEQ / BLK;
constexpr int HB = 8, DN = 64, DR = 32, DV = 64, QL = 384, KVL = 256;
constexpr int INC = 3 * WA + QL + KVL + DR + 2 * DM;
constexpr int C_QA = 0, C_KA = 512, C_VA = 1024, C_CQ = 1536, C_CKV = 1920, C_KR = 2176, C_GA = 2208, C_GB = 3232;
constexpr int NE = 256, TOPK = 8, DE = 256, DSH = 256;
constexpr int NA = T * TOPK;
constexpr float ALPHA = 1.4142135623730951f;
constexpr float LN_EPS = 1e-5f, RMS_EPS = 1e-6f;


namespace fk {
#define LAS __attribute__((address_space(3)))
#define GAS __attribute__((address_space(1)))
typedef unsigned short bf16_t;
typedef short bf16x8 __attribute__((ext_vector_type(8)));
typedef float f32x4 __attribute__((ext_vector_type(4)));
typedef float f32x2 __attribute__((ext_vector_type(2)));
typedef float f32x16 __attribute__((ext_vector_type(16)));
typedef unsigned u32x4 __attribute__((ext_vector_type(4)));
typedef unsigned u32x2 __attribute__((ext_vector_type(2)));
constexpr int NWAVES = 8, NTHR = 512;
constexpr int INCP = 4352;
constexpr float LOG2E = 1.4426950408889634f;
constexpr float QS_A = 0.125f * LOG2E;
constexpr float QS_B = 0.10206207261596577f * LOG2E;
#define LDS_WAIT() asm volatile("s_waitcnt lgkmcnt(0)" ::: "memory")
#define VM_WAIT() asm volatile("s_waitcnt vmcnt(0)" ::: "memory")
__device__ __forceinline__ unsigned f2bf(float f) { unsigned u = __builtin_bit_cast(unsigned, f); return (u + 0x7fffu + ((u >> 16) & 1u)) >> 16; }
__device__ __forceinline__ unsigned pk2(float lo, float hi) { return f2bf(lo) | (f2bf(hi) << 16); }
__device__ __forceinline__ float bf2f(unsigned short b) { return __builtin_bit_cast(float, (unsigned)b << 16); }
__device__ __forceinline__ float bflo(unsigned w) { return __builtin_bit_cast(float, w << 16); }
__device__ __forceinline__ float bfhi(unsigned w) { return __builtin_bit_cast(float, w & 0xffff0000u); }
__device__ __forceinline__ float sigmoidf_(float x) { return __builtin_amdgcn_rcpf(1.f + __expf(-x)); }
__device__ __forceinline__ float wave_sum(float v) {
#pragma unroll
    for (int o = 1; o < 64; o <<= 1) v += __shfl_xor(v, o);
    return v;
}

namespace pg8 {
constexpr int BM = 256, BK = 64, HALF = 128, HTB = HALF * BK * 2, STAGE_BYTES = 8 * HTB, NXCD = 8, WGM = 8;
__host__ __device__ __forceinline__ int lds_byte(int r, int c) { const int st = (r >> 4) * 2 + (c >> 5), rr = r & 15, cc = c & 31, ob = rr * 64 + cc * 2; return st * 1024 + (ob ^ (((ob >> 9) & 1) << 5)); }
__host__ __device__ __forceinline__ void stage_rc(int b, int& R, int& C) { const int st = b / 1024, sb = b % 1024, swz = sb ^ (((sb >> 9) & 1) << 5); R = (st >> 1) * 16 + swz / 64; C = (st & 1) * 32 + (swz % 64) / 2; }
__host__ __device__ __forceinline__ int perm32(int rho) { const int n = rho >> 4, i = rho & 15; return 8 * (i >> 2) + 4 * n + (i & 3); }

struct Unit { int pm, pn, e, r0, rend; };
struct Gemm { const bf16_t* A; const bf16_t* Bt; int M, N, K, lda, ldb; };

struct StaticOrder {
    int nM, nN, nwg, G, c;
    __device__ void init(int M, int N, int G_, int c_) { nM = M / BM; nN = N / BM; nwg = nM * nN; G = G_; c = c_; }
    __device__ bool next(int i, Unit& u) const {
        const long L = (long)i * G + c; if (L >= nwg) return false;
        int wgid = (int)L; { const int q = nwg / NXCD, r = nwg % NXCD, xcd = wgid % NXCD, off = wgid / NXCD; wgid = (xcd < r ? xcd * (q + 1) : r * (q + 1) + (xcd - r) * q) + off; }
        const int nig = WGM * nN, gid = wgid / nig, fm = gid * WGM, gsz = (nM - fm) < WGM ? (nM - fm) : WGM;
        u.pm = fm + ((wgid % nig) % gsz); u.pn = (wgid % nig) / gsz; u.e = 0; u.r0 = u.pm * BM; u.rend = u.r0 + BM; return true;
    }
    __device__ __forceinline__ int a_row(const Unit& u, int r) const { return u.pm * BM + r; }
    __device__ __forceinline__ const char* b_ptr(const Gemm& g, const Unit& u) const { return (const char*)g.Bt + (size_t)u.pn * BM * g.ldb * 2; }
};

struct OffsetOrder : StaticOrder {
    int pn0;
    __device__ bool next(int i, Unit& u) const { const bool ok = StaticOrder::next(i, u); u.pn += pn0; return ok; }
};
typedef float f32x2_t_ __attribute__((ext_vector_type(2))); typedef __bf16 bf16x2_t_ __attribute__((ext_vector_type(2)));
__device__ __forceinline__ unsigned cvt_pk_bf16(float lo, float hi) { const f32x2_t_ v = {lo, hi}; const bf16x2_t_ b = __builtin_convertvector(v, bf16x2_t_); return __builtin_bit_cast(unsigned, b); }

template <class Epi, class Sched, bool ALIGN_EPI>
__device__ __forceinline__ void gemm_phase(LAS unsigned char* lds, const Gemm g, const Sched& S, const Epi& E) {
    int tid_ = threadIdx.x; asm volatile("" : "+v"(tid_));
    const int tid = tid_, wid = __builtin_amdgcn_readfirstlane(tid >> 6), lane = tid & 63, wr = wid >> 2, wc = wid & 3, fr = lane & 15, fq = lane >> 4;
    const int K = g.K, nt = K / BK;
    int RA[2]; unsigned CA[2], voffB[2];
#pragma unroll
    for (int i = 0; i < 2; ++i) { int R, C; stage_rc(tid * 16 + i * 8192, R, C); const int Rb = (R & ~31) + perm32(R & 31);
        RA[i] = R; CA[i] = (unsigned)C * 2u; voffB[i] = (unsigned)(Rb * g.ldb + C) * 2u; }
    const unsigned lda2 = (unsigned)g.lda * 2u;
    const size_t hstepB = (size_t)HALF * g.ldb * 2;
    const unsigned ldsw = (unsigned)wid * 1024u;
    const int aoff = lds_byte(wr * 64 + fr, fq * 8), boff = lds_byte(wc * 32 + fr, fq * 8);
    const char* const Abase = (const char*)g.A;
#define PG8_SA(b, h) (((b) * 2 + (h)) * HTB)
#define PG8_SB(b, h) ((4 + (b) * 2 + (h)) * HTB)
#define PG8_STAGE_B(bufoff, gbase) do { _Pragma("unroll") for (int _i = 0; _i < 2; ++_i) \
        __builtin_amdgcn_global_load_lds((const unsigned*)((const char*)(gbase) + voffB[_i]), (LAS unsigned*)(lds + (bufoff) + ldsw + _i * 8192), 16, 0, 0); } while (0)
#define PG8_STAGE_A(bufoff, V0, V1, kb) do { \
        __builtin_amdgcn_global_load_lds((const unsigned*)((Abase + (kb)) + (V0)), (LAS unsigned*)(lds + (bufoff) + ldsw), 16, 0, 0); \
        __builtin_amdgcn_global_load_lds((const unsigned*)((Abase + (kb)) + (V1)), (LAS unsigned*)(lds + (bufoff) + ldsw + 8192), 16, 0, 0); } while (0)
#define PG8_LDA(dst, b, h) do { _Pragma("unroll") for (int m = 0; m < 4; ++m) _Pragma("unroll") for (int k = 0; k < 2; ++k) dst[m][k] = *(const LAS bf16x8*)(lds + PG8_SA(b, h) + aoff + m * 2048 + k * 1024); } while (0)
#define PG8_LDB(dst, b, h) do { _Pragma("unroll") for (int n = 0; n < 2; ++n) _Pragma("unroll") for (int k = 0; k < 2; ++k) dst[n][k] = *(const LAS bf16x8*)(lds + PG8_SB(b, h) + boff + n * 2048 + k * 1024); } while (0)
#define PG8_MMA(ai, bj, At, Bt) do { __builtin_amdgcn_s_setprio(1); _Pragma("unroll") for (int m = 0; m < 4; ++m) _Pragma("unroll") for (int n = 0; n < 2; ++n) _Pragma("unroll") for (int k = 0; k < 2; ++k) \
        acc[ai][bj][m][n] = __builtin_amdgcn_mfma_f32_16x16x32_bf16(Bt[n][k], At[m][k], acc[ai][bj][m][n], 0, 0, 0); __builtin_amdgcn_s_setprio(0); } while (0)
#define PG8_WAIT_V(n) asm volatile("s_waitcnt vmcnt(" #n ")" ::: "memory")
#define PG8_WAIT_L(n) asm volatile("s_waitcnt lgkmcnt(" #n ")" ::: "memory")
#define PG8_BAR __builtin_amdgcn_s_barrier()
#define PG8_SCHED __builtin_amdgcn_sched_barrier(0)
#define PG8_VOFF(V, U) do { V##00 = (unsigned)S.a_row(U, RA[0]) * lda2 + CA[0]; V##01 = (unsigned)S.a_row(U, RA[1]) * lda2 + CA[1]; \
        V##10 = (unsigned)S.a_row(U, HALF + RA[0]) * lda2 + CA[0]; V##11 = (unsigned)S.a_row(U, HALF + RA[1]) * lda2 + CA[1]; } while (0)
    Unit cur, nxt; int ui = 0;
    if (!S.next(0, cur)) return;
    f32x4 acc[2][2][4][2];
#pragma unroll
    for (int a = 0; a < 2; ++a)
#pragma unroll
        for (int b = 0; b < 2; ++b)
#pragma unroll
            for (int m = 0; m < 4; ++m)
#pragma unroll
                for (int n = 0; n < 2; ++n) acc[a][b][m][n] = (f32x4){0.f, 0.f, 0.f, 0.f};
    bf16x8 At[4][2], B0[2][2], B1[2][2];
    unsigned vc00, vc01, vc10, vc11;
    PG8_VOFF(vc, cur);
    const char* cB = S.b_ptr(g, cur);
    PG8_STAGE_B(PG8_SB(0, 0), cB); PG8_STAGE_B(PG8_SB(0, 1), cB + hstepB); PG8_STAGE_A(PG8_SA(0, 0), vc00, vc01, 0u); PG8_STAGE_A(PG8_SA(0, 1), vc10, vc11, 0u);
    if (wr == 1) PG8_BAR;
    PG8_WAIT_V(2); PG8_BAR;
    PG8_STAGE_B(PG8_SB(1, 0), cB + 128); PG8_STAGE_A(PG8_SA(1, 0), vc00, vc01, 128u); PG8_STAGE_B(PG8_SB(1, 1), cB + hstepB + 128);
    PG8_WAIT_V(6); PG8_BAR;
    for (;;) {
        const bool has_next = S.next(ui + 1, nxt);
        const char* nB = has_next ? S.b_ptr(g, nxt) : cB;
        unsigned vn00 = vc00, vn01 = vc01, vn10 = vc10, vn11 = vc11;
        if (has_next) { PG8_VOFF(vn, nxt); }
        const bool half1 = (cur.rend - cur.r0) > HALF;
#pragma unroll 1
        for (int t = 0; t < nt; t += 2) {
            if constexpr (Epi::MIDK > 0) { if (t == Epi::MIDK) E.mid(acc, cur, wr, wc, fr, fq); }
            const bool last = (t == nt - 2);
            const unsigned kb1 = (unsigned)(t + 1) * 128u;
            unsigned kb2 = (unsigned)(t + 2) * 128u;
            unsigned s00 = vc00, s01 = vc01, s10 = vc10, s11 = vc11;
            const char* b2 = cB + (size_t)kb2;
            if (last) { kb2 = 0u; b2 = nB; s00 = vn00; s01 = vn01; s10 = vn10; s11 = vn11; }
            const unsigned kb3 = kb2 + 128u; const char* b3 = b2 + 128;
            PG8_LDB(B0, 0, 0); PG8_LDB(B1, 0, 1); PG8_SCHED; PG8_LDA(At, 0, 0); PG8_STAGE_A(PG8_SA(1, 1), vc10, vc11, kb1);
            PG8_WAIT_V(8); PG8_WAIT_L(0); PG8_BAR; PG8_MMA(0, 0, At, B0); PG8_MMA(0, 1, At, B1); PG8_BAR; PG8_SCHED;
            PG8_LDA(At, 0, 1); PG8_STAGE_B(PG8_SB(0, 0), b2); PG8_STAGE_B(PG8_SB(0, 1), b2 + hstepB); PG8_STAGE_A(PG8_SA(0, 0), s00, s01, kb2);
            PG8_WAIT_V(8); PG8_WAIT_L(0); PG8_BAR; if (half1) { PG8_MMA(1, 0, At, B0); PG8_MMA(1, 1, At, B1); } PG8_BAR; PG8_SCHED;
            PG8_LDB(B0, 1, 0); PG8_LDB(B1, 1, 1); PG8_SCHED; PG8_LDA(At, 1, 0); PG8_STAGE_A(PG8_SA(0, 1), s10, s11, kb2);
            PG8_WAIT_V(8); PG8_WAIT_L(0); PG8_BAR; PG8_MMA(0, 0, At, B0); PG8_MMA(0, 1, At, B1); PG8_BAR; PG8_SCHED;
            PG8_LDA(At, 1, 1); PG8_STAGE_B(PG8_SB(1, 0), b3); PG8_STAGE_B(PG8_SB(1, 1), b3 + hstepB); PG8_STAGE_A(PG8_SA(1, 0), s00, s01, kb3);
            PG8_WAIT_V(8); PG8_WAIT_L(0); PG8_BAR; if (half1) { PG8_MMA(1, 0, At, B0); PG8_MMA(1, 1, At, B1); } PG8_BAR; PG8_SCHED;
        }
        if constexpr (ALIGN_EPI) { if (wr == 0) PG8_BAR; }
        E(acc, cur, wr, wc, fr, fq);
        if (!has_next) break;
#pragma unroll
        for (int a = 0; a < 2; ++a)
#pragma unroll
            for (int b = 0; b < 2; ++b)
#pragma unroll
                for (int m = 0; m < 4; ++m)
#pragma unroll
                    for (int n = 0; n < 2; ++n) acc[a][b][m][n] = (f32x4){0.f, 0.f, 0.f, 0.f};
        cur = nxt; cB = nB; vc00 = vn00; vc01 = vn01; vc10 = vn10; vc11 = vn11; ++ui;
        if constexpr (ALIGN_EPI) { if (wr == 1) PG8_BAR; }
    }
    PG8_WAIT_V(0);
    if constexpr (!ALIGN_EPI) { if (wr == 0) PG8_BAR; }
    PG8_BAR;
#undef PG8_SA
#undef PG8_SB
#undef PG8_STAGE_A
#undef PG8_STAGE_B
#undef PG8_LDA
#undef PG8_LDB
#undef PG8_MMA
#undef PG8_WAIT_V
#undef PG8_WAIT_L
#undef PG8_BAR
#undef PG8_SCHED
#undef PG8_VOFF
}
#define PG8_TILE_BEGIN(acc, wr, wc, fr, fq) \
    _Pragma("unroll") for (int ai = 0; ai < 2; ++ai) _Pragma("unroll") for (int m = 0; m < 4; ++m) _Pragma("unroll") for (int bj = 0; bj < 2; ++bj) { \
        const int trow = ai * 128 + wr * 64 + m * 16 + fr, tcol = bj * 128 + wc * 32 + 8 * fq; f32x4 v0 = acc[ai][bj][m][0], v1 = acc[ai][bj][m][1];
#define PG8_TILE_END }
__device__ __forceinline__ u32x4 pack8(f32x4 v0, f32x4 v1) { u32x4 w; w.x = cvt_pk_bf16(v0[0], v0[1]); w.y = cvt_pk_bf16(v0[2], v0[3]); w.z = cvt_pk_bf16(v1[0], v1[1]); w.w = cvt_pk_bf16(v1[2], v1[3]); return w; }
}

#define XB_TMO      128
#define XB_XCNT(j)  (256  + 64 * (j))
#define XB_XSUB(j)  (1280 + 64 * (j))
#define XB_XGEN(j)  (2304 + 64 * (j))
#define XB_TOP      3328
#define XB_TOPGEN   3392
#define XCD_BAR_WORDS 3456
#define XB_SPIN_CAP (1u << 18)

__device__ __forceinline__ unsigned xb_ld(unsigned* p)              { return __hip_atomic_load(p, __ATOMIC_RELAXED, __HIP_MEMORY_SCOPE_AGENT); }
__device__ __forceinline__ unsigned xb_add(unsigned* p, unsigned v) { return __hip_atomic_fetch_add(p, v, __ATOMIC_RELAXED, __HIP_MEMORY_SCOPE_AGENT); }
__device__ __forceinline__ unsigned xb_xcc_id() { return (unsigned)__builtin_amdgcn_s_getreg((3 << 11) | 20) & 0xFu; }
#define XB_SPIN(cond, bar) do { unsigned _sp = 0; while (cond) { __builtin_amdgcn_s_sleep(1); \
    if ((++_sp & 255u) == 0u) { if (xb_ld(&(bar)[XB_TMO])) break; if (_sp > XB_SPIN_CAP) { atomicAdd(&(bar)[XB_TMO], 1u); break; } } } } while (0)

struct XcdBarrier {
    unsigned* bar; unsigned x;
    volatile LAS unsigned* st;
};

__device__ __forceinline__ XcdBarrier xcd_barrier_post(unsigned* bar, volatile LAS unsigned* st) {
    XcdBarrier b; b.bar = bar; b.x = xb_xcc_id(); b.st = st;
    if (threadIdx.x == 0) (void)xb_add(&bar[XB_XCNT(b.x)], 1u);
    return b;
}
__device__ __forceinline__ void xcd_barrier_complete(unsigned* bar, unsigned x, unsigned& nloc, unsigned& nx) {
    const unsigned G = gridDim.x * gridDim.y * gridDim.z;
    unsigned sum, cnt, mine, sp = 0u;
    for (;;) {
        sum = 0u; cnt = 0u; mine = 0u;
#pragma unroll
        for (unsigned j = 0; j < 16; ++j) { const unsigned c = xb_ld(&bar[XB_XCNT(j)]); sum += c; cnt += (c > 0u) ? 1u : 0u; mine = (j == x) ? c : mine; }
        if (sum == G) break;
        __builtin_amdgcn_s_sleep(1);
        if ((++sp & 255u) == 0u) { if (xb_ld(&bar[XB_TMO])) break; if (sp > XB_SPIN_CAP) { atomicAdd(&bar[XB_TMO], 1u); break; } }
    }
    nloc = mine > 0u ? mine : 1u; nx = cnt > 0u ? cnt : 1u;
}

__device__ __forceinline__ void xcd_barrier(const XcdBarrier& b) {
    asm volatile("s_waitcnt vmcnt(0)" ::: "memory");
    __syncthreads();
    if (threadIdx.x == 0) {
        unsigned* bar = b.bar; asm volatile("" : "+s"(bar));
        __builtin_amdgcn_s_waitcnt(0);
        unsigned nloc = b.st[0], nx = b.st[1];
        if (nloc == 0u) { xcd_barrier_complete(bar, b.x, nloc, nx); b.st[0] = nloc; b.st[1] = nx; }
        const unsigned old = xb_add(&bar[XB_XSUB(b.x)], 1u);
        const unsigned gen = old / nloc;
        if (old + 1u == (gen + 1u) * nloc) {
            __builtin_amdgcn_fence(__ATOMIC_RELEASE, "agent");
            asm volatile("s_waitcnt vmcnt(0)" ::: "memory");
            const unsigned og = xb_add(&bar[XB_TOP], 1u);
            const unsigned tg = og / nx;
            if (og + 1u == (tg + 1u) * nx) xb_add(&bar[XB_TOPGEN], 1u);
            else XB_SPIN(xb_ld(&bar[XB_TOPGEN]) == tg, bar);
            __builtin_amdgcn_fence(__ATOMIC_ACQUIRE, "agent");
            xb_add(&bar[XB_XGEN(b.x)], 1u);
            asm volatile("s_waitcnt vmcnt(0)" ::: "memory");
        } else {
            XB_SPIN(xb_ld(&bar[XB_XGEN(b.x)]) == gen, bar);
            __builtin_amdgcn_fence(__ATOMIC_ACQUIRE, "agent");
            asm volatile("s_waitcnt vmcnt(0)" ::: "memory");
        }
    }
    __syncthreads();
}


struct Params {
    const float* in[22]; float* out; unsigned char* ws;
    int ph_lo, ph_hi;
};
constexpr size_t MiB = 1u << 20;
constexpr size_t WS_CTL = 0, CTL_BYTES = 1 * MiB;
constexpr int CW_BAR = 4096;
constexpr int CW_CNT = 16384;
constexpr size_t WS_WIN = 2 * MiB;
constexpr size_t SZ_WIN = (size_t)INCP * DM;
constexpr size_t SZ_WUQ = (size_t)768 * QL, SZ_WUKV = (size_t)1024 * KVL;
constexpr size_t WS_WUQ = WS_WIN + 2 * SZ_WIN * 2;
constexpr size_t WS_WUKV = WS_WUQ + 2 * SZ_WUQ * 2;
constexpr size_t SZ_WP = (size_t)DM * 512, SZ_WOUT = (size_t)DM * DM;
constexpr size_t WS_WPA = WS_WUKV + 2 * SZ_WUKV * 2;
constexpr size_t WS_WPB = WS_WPA + 2 * SZ_WP * 2;
constexpr size_t WS_WOUT = WS_WPB + 2 * SZ_WP * 2;
constexpr size_t SZ_WRT = (size_t)NE * DM, SZ_WSGU = (size_t)512 * DM, SZ_WSD = (size_t)DM * DSH;
constexpr size_t WS_WRT = WS_WOUT + 2 * SZ_WOUT * 2;
constexpr size_t WS_WSGU = WS_WRT + 2 * SZ_WRT * 2;
constexpr size_t WS_WSD = WS_WSGU + 2 * SZ_WSGU * 2;
constexpr size_t WS_CS = WS_WSD + 2 * SZ_WSD * 2;
constexpr size_t WS_KM = WS_CS + (size_t)SEQ * 16 * 8;
constexpr size_t WS_SEL = WS_KM + (size_t)NB * HA * NBLK * 64 * 4;
constexpr size_t WS_XB = WS_SEL + (size_t)T * 8 * 4;
constexpr size_t WS_CQN = WS_XB + (size_t)T * DM * 2;
constexpr size_t WS_CKVN = WS_CQN + (size_t)T * QL * 2;
constexpr size_t WS_QB = WS_CKVN + (size_t)T * KVL * 2;
constexpr size_t WS_KB = WS_QB + (size_t)T * 768 * 2;
constexpr size_t WS_VB = WS_KB + (size_t)T * 768 * 2;
constexpr size_t WS_OAB = WS_VB + (size_t)T * 512 * 2;
constexpr size_t WS_TMP = WS_OAB + (size_t)T * 1024 * 2;
constexpr size_t WS_MRG = WS_TMP + (size_t)T * 1024 * 2;
constexpr size_t WS_PRE = WS_MRG + (size_t)T * 1024 * 2;
constexpr size_t WS_X1 = WS_PRE + (size_t)T * 1024 * 4;
constexpr size_t WS_X1B = WS_X1 + (size_t)T * 1024 * 4;
constexpr size_t WS_X2 = WS_X1B + (size_t)T * 1024 * 2;
constexpr size_t WS_LOG = WS_X2 + (size_t)T * 1024 * 4;
constexpr size_t WS_HS = WS_LOG + (size_t)T * NE * 4;
constexpr size_t WS_SH = WS_HS + (size_t)T * DSH * 2;
constexpr size_t WS_TOPE = WS_SH + (size_t)T * DM * 2;
constexpr size_t WS_TOPW = WS_TOPE + (size_t)NA * 4;
constexpr size_t WS_APOS = WS_TOPW + (size_t)NA * 4;
constexpr size_t WS_ROWA = WS_APOS + (size_t)NA * 4;
constexpr size_t WS_HIST = WS_ROWA + (size_t)NA * 8;
constexpr size_t WS_PO = WS_HIST + (size_t)1024 * 256 * 4;
constexpr size_t WS_PML = WS_PO + (size_t)T * 8 * 3 * 64 * 2;
constexpr size_t WS_HE = WS_PML + (size_t)T * 8 * 3 * 128;
constexpr size_t WS_Y = WS_HE + (size_t)NA * DE * 2;
constexpr size_t WS_PROJ = WS_Y + (size_t)NA * DM * 2;
constexpr size_t SZ_WEGU = (size_t)NE * 512 * DM, SZ_WED = (size_t)NE * DM * DE;
constexpr size_t WS_WEGU = WS_PROJ + (size_t)T * INCP * 2;
constexpr size_t WS_WED = WS_WEGU + 2 * SZ_WEGU * 2;
constexpr size_t WS_FAST_END = WS_WED + 2 * SZ_WED * 2;
constexpr size_t WS_NEED = WS_FAST_END;
static_assert(WS_NEED <= (size_t)2040 * MiB, "ws map");

constexpr int LDS_BYTES = 147456;
constexpr int RING_BYTES = 131072, MISC_OFF = RING_BYTES + 1024, TAB_OFF = RING_BYTES + 2048;

struct Frame { LAS unsigned char* lds; int tid, lane, wave, G, vcu; };

template <class RowMap>
__device__ __forceinline__ void transpose_item(const float* W, int K, int N, bf16_t* WT, int ldk, RowMap rm, LAS float* scr, int item, int lane) {
    const int nblk = N / 32, kb = item / nblk, nb = item % nblk, k0 = 64 * kb, n0 = 32 * nb;
#pragma unroll 8
    for (int i = 0; i < 32; ++i) { const int kk = 2 * i + (lane >> 5); scr[kk * 33 + (lane & 31)] = W[(size_t)(k0 + kk) * N + n0 + (lane & 31)]; }
    LDS_WAIT(); asm volatile("" ::: "memory");
    const int c = lane & 7;
#pragma unroll
    for (int j = 0; j < 4; ++j) { const int n = (lane >> 3) + 8 * j; const LAS float* s = scr + (8 * c) * 33 + n;
        u32x4 o; o.x = pk2(s[0 * 33], s[1 * 33]); o.y = pk2(s[2 * 33], s[3 * 33]); o.z = pk2(s[4 * 33], s[5 * 33]); o.w = pk2(s[6 * 33], s[7 * 33]);
        *(u32x4*)(WT + (size_t)rm(n0 + n) * ldk + k0 + 8 * c) = o; }
    LDS_WAIT(); asm volatile("" ::: "memory");
}
template <class RowMap>
__device__ __forceinline__ void transpose_item64(const float* W, int K, int N, bf16_t* WT, int ldk, RowMap rm, LAS unsigned short* scr, int item, int lane) {
    const int nblk = N / 64, kb = item / nblk, nb = item % nblk, k0 = 64 * kb, n0 = 64 * nb, r = lane >> 4, c4 = (lane & 15) * 4;
    f32x4 v[16];
#pragma unroll
    for (int i = 0; i < 16; ++i) v[i] = __builtin_nontemporal_load((const f32x4*)(W + (size_t)(k0 + 4 * i + r) * N + n0 + c4));
#pragma unroll
    for (int i = 0; i < 16; ++i) { LAS unsigned* d = (LAS unsigned*)(scr + (4 * i + r) * 66 + c4); d[0] = pk2(v[i][0], v[i][1]); d[1] = pk2(v[i][2], v[i][3]); }
    LDS_WAIT(); asm volatile("" ::: "memory");
    const int c = lane & 7;
#pragma unroll
    for (int j = 0; j < 8; ++j) { const int n = (lane >> 3) + 8 * j; const LAS unsigned short* q = scr + (8 * c) * 66 + n;
        u32x4 o; o.x = (unsigned)q[0] | ((unsigned)q[66] << 16); o.y = (unsigned)q[2 * 66] | ((unsigned)q[3 * 66] << 16); o.z = (unsigned)q[4 * 66] | ((unsigned)q[5 * 66] << 16); o.w = (unsigned)q[6 * 66] | ((unsigned)q[7 * 66] << 16);
        *(u32x4*)(WT + (size_t)rm(n0 + n) * ldk + k0 + 8 * c) = o; }
    LDS_WAIT(); asm volatile("" ::: "memory");
}
struct RowPermD { __device__ __forceinline__ int operator()(int n) const { const int a = n & 255; return (n & ~255) + 128 * ((a >> 3) & 1) + 32 * (a >> 6) + 8 * ((a >> 4) & 3) + (a & 7); } };
struct RowId { __device__ __forceinline__ int operator()(int n) const { return n; } };

struct EpiProj {
    static constexpr int MIDK = 0;
    bf16_t* O; const float* bg;
    __device__ __forceinline__ void operator()(const f32x4 (&acc)[2][2][4][2], const pg8::Unit& u, int wr, int wc, int fr, int fq) const {
        PG8_TILE_BEGIN(acc, wr, wc, fr, fq)
            const int row = u.pm * 256 + trow, col = u.pn * 256 + tcol;
            if (col < C_KA) { v0 = v0 * QS_A; v1 = v1 * QS_A; }
            else if (col >= C_GA && col < INC) { const f32x4 b0 = *(const f32x4*)(bg + col - C_GA), b1 = *(const f32x4*)(bg + col - C_GA + 4);
#pragma unroll
                for (int i = 0; i < 4; ++i) { v0[i] = sigmoidf_(v0[i] + b0[i]); v1[i] = sigmoidf_(v1[i] + b1[i]); } }
            *(u32x4*)(O + (size_t)row * INCP + col) = pg8::pack8(v0, v1);
        PG8_TILE_END
    }
};

struct RowQ { __device__ __forceinline__ int operator()(int n) const { const int h = n / 96, d = n % 96; if (d < 64) return n; const int i = d - 64; return h * 96 + 64 + (i < 16 ? 2 * i : 2 * (i - 16) + 1); } };

struct EpiQ {
    static constexpr int MIDK = 0;
    bf16_t* O; const f32x2* CS;
    __device__ __forceinline__ void operator()(const f32x4 (&acc)[2][2][4][2], const pg8::Unit& u, int wr, int wc, int fr, int fq) const {
        PG8_TILE_BEGIN(acc, wr, wc, fr, fq)
            const int row = u.pm * 256 + trow, col = u.pn * 256 + tcol, d = col % 96;
            if (d >= 64) { const int pos = row % SEQ, i0 = (d - 64) >> 1; const f32x2* cs = CS + (size_t)pos * 16 + i0;
                const f32x2 c0 = cs[0], c1 = cs[1], c2 = cs[2], c3 = cs[3];
                const f32x4 a = v0, b = v1;
                v0[0] = a[0] * c0[0] - a[1] * c0[1]; v0[1] = a[1] * c0[0] + a[0] * c0[1]; v0[2] = a[2] * c1[0] - a[3] * c1[1]; v0[3] = a[3] * c1[0] + a[2] * c1[1];
                v1[0] = b[0] * c2[0] - b[1] * c2[1]; v1[1] = b[1] * c2[0] + b[0] * c2[1]; v1[2] = b[2] * c3[0] - b[3] * c3[1]; v1[3] = b[3] * c3[0] + b[2] * c3[1]; }
            v0 = v0 * QS_B; v1 = v1 * QS_B;
            *(u32x4*)(O + (size_t)row * 768 + col) = pg8::pack8(v0, v1);
        PG8_TILE_END
    }
};
struct EpiKV {
    static constexpr int MIDK = 0;
    bf16_t* KB; bf16_t* VB;
    __device__ __forceinline__ void operator()(const f32x4 (&acc)[2][2][4][2], const pg8::Unit& u, int wr, int wc, int fr, int fq) const {
        PG8_TILE_BEGIN(acc, wr, wc, fr, fq)
            const int row = u.pm * 256 + trow, col = u.pn * 256 + tcol, h = col >> 7, j = col & 127;
            bf16_t* dst = (j < 64) ? KB + (size_t)row * 768 + h * 96 + j : VB + (size_t)row * 512 + h * 64 + (j - 64);
            *(u32x4*)dst = pg8::pack8(v0, v1);
        PG8_TILE_END
    }
};

__device__ __forceinline__ void prep_phase(const Frame& F, const bf16_t* PROJ, const float* qn, const float* kvn, const f32x2* CS, bf16_t* CQN, bf16_t* CKVN, bf16_t* KB, float* KM) {
    int lane_ = F.lane; asm volatile("" : "+v"(lane_));
    const int gw = F.vcu * NWAVES + F.wave, NGW = F.G * NWAVES, lane = lane_;
    for (int row = gw; row < T; row += NGW) {
        const bf16_t* p = PROJ + (size_t)row * INCP;
        u32x4 a = (u32x4){0u, 0u, 0u, 0u}, b = (u32x4){0u, 0u, 0u, 0u};
        if (lane < 48) a = *(const u32x4*)(p + C_CQ + lane * 8);
        if (lane < 32) b = *(const u32x4*)(p + C_CKV + lane * 8);
        float sq = 0.f, sk = 0.f;
#pragma unroll
        for (int i = 0; i < 4; ++i) { const float x = bflo(a[i]), y = bfhi(a[i]), z = bflo(b[i]), w = bfhi(b[i]); sq += x * x + y * y; sk += z * z + w * w; }
        sq = wave_sum(sq); sk = wave_sum(sk);
        const float rq = rsqrtf(sq * (1.f / QL) + RMS_EPS), rk = rsqrtf(sk * (1.f / KVL) + RMS_EPS);
        if (lane < 48) { const f32x4 g0 = *(const f32x4*)(qn + lane * 8), g1 = *(const f32x4*)(qn + lane * 8 + 4); u32x4 o;
            o.x = pk2(bflo(a.x) * rq * g0[0], bfhi(a.x) * rq * g0[1]); o.y = pk2(bflo(a.y) * rq * g0[2], bfhi(a.y) * rq * g0[3]);
            o.z = pk2(bflo(a.z) * rq * g1[0], bfhi(a.z) * rq * g1[1]); o.w = pk2(bflo(a.w) * rq * g1[2], bfhi(a.w) * rq * g1[3]);
            *(u32x4*)(CQN + (size_t)row * QL + lane * 8) = o; }
        if (lane < 32) { const f32x4 g0 = *(const f32x4*)(kvn + lane * 8), g1 = *(const f32x4*)(kvn + lane * 8 + 4); u32x4 o;
            o.x = pk2(bflo(b.x) * rk * g0[0], bfhi(b.x) * rk * g0[1]); o.y = pk2(bflo(b.y) * rk * g0[2], bfhi(b.y) * rk * g0[3]);
            o.z = pk2(bflo(b.z) * rk * g1[0], bfhi(b.z) * rk * g1[1]); o.w = pk2(bflo(b.w) * rk * g1[2], bfhi(b.w) * rk * g1[3]);
            *(u32x4*)(CKVN + (size_t)row * KVL + lane * 8) = o; }
        if (lane < 16) { const float x1 = bf2f(p[C_KR + lane]), x2 = bf2f(p[C_KR + 16 + lane]); const f32x2 cs = CS[(size_t)(row % SEQ) * 16 + lane];
            const unsigned w = pk2(x1 * cs[0] - x2 * cs[1], x2 * cs[0] + x1 * cs[1]);
#pragma unroll
            for (int h = 0; h < 8; ++h) *(unsigned*)(KB + (size_t)row * 768 + h * 96 + 64 + 2 * lane) = w; }
    }
    for (int it = gw; it < NB * NBLK * HA; it += NGW) {
        const int h = it % HA, blk = (it / HA) % NBLK, b = it / (HA * NBLK), c = lane & 7, r0 = lane >> 3;
        const bf16_t* p = PROJ + ((size_t)b * SEQ + (size_t)blk * BLK + r0) * INCP + C_KA + h * 64 + c * 8;
        float s[8];
#pragma unroll
        for (int i = 0; i < 8; ++i) s[i] = 0.f;
        for (int i = 0; i < 32; ++i) { const u32x4 v = *(const u32x4*)(p + (size_t)i * 8 * INCP);
#pragma unroll
            for (int k = 0; k < 4; ++k) { s[2 * k] += bflo(v[k]); s[2 * k + 1] += bfhi(v[k]); } }
#pragma unroll
        for (int i = 0; i < 8; ++i) { s[i] += __shfl_xor(s[i], 8); s[i] += __shfl_xor(s[i], 16); s[i] += __shfl_xor(s[i], 32); }
        if (lane < 8) { float* o = KM + ((size_t)(b * HA + h) * NBLK + blk) * 64 + c * 8;
            *(f32x4*)o = (f32x4){s[0], s[1], s[2], s[3]} * (1.f / BLK); *(f32x4*)(o + 4) = (f32x4){s[4], s[5], s[6], s[7]} * (1.f / BLK); }
    }
}
__device__ __forceinline__ void mobasel_phase(const Frame& F, const bf16_t* PROJ, const float* KM, unsigned* SEL) {
    int tid_ = F.tid; asm volatile("" : "+v"(tid_));
    const int TPW = T / F.G, row0 = (int)blockIdx.x * TPW, b = row0 / SEQ, own = (row0 % SEQ) / BLK, hs = own * 64 + 4;
    LAS float* km = (LAS float*)F.lds;
    for (int i = tid_; i < 8 * own * 16; i += NTHR) { const int h = i / (own * 16), r = i % (own * 16);
        *(LAS f32x4*)(km + h * hs + r * 4) = *(const f32x4*)(KM + ((size_t)(b * HA + h) * NBLK) * 64 + r * 4); }
    __syncthreads();
    for (int idx = tid_; idx < TPW * 8; idx += NTHR) {
        const int h = idx & 7, row = row0 + (idx >> 3);
        const bf16_t* qp = PROJ + (size_t)row * INCP + C_QA + h * 64;
        float q[64];
#pragma unroll
        for (int i = 0; i < 8; ++i) { const u32x4 v = *(const u32x4*)(qp + i * 8);
#pragma unroll
            for (int k = 0; k < 4; ++k) { q[i * 8 + 2 * k] = bflo(v[k]); q[i * 8 + 2 * k + 1] = bfhi(v[k]); } }
        float v1 = -INFINITY, v2 = -INFINITY, v3 = -INFINITY; int i1 = -1, i2 = -1, i3 = -1;
        for (int j = 0; j < own; ++j) {
            const LAS f32x4* kp = (const LAS f32x4*)(km + h * hs + j * 64);
            float g0 = 0.f, g1 = 0.f, g2 = 0.f, g3 = 0.f;
#pragma unroll
            for (int c = 0; c < 16; ++c) { const f32x4 k4 = kp[c]; g0 = fmaf(q[4 * c], k4[0], g0); g1 = fmaf(q[4 * c + 1], k4[1], g1); g2 = fmaf(q[4 * c + 2], k4[2], g2); g3 = fmaf(q[4 * c + 3], k4[3], g3); }
            const float g = (g0 + g1) + (g2 + g3);
            if (g > v1) { v3 = v2; i3 = i2; v2 = v1; i2 = i1; v1 = g; i1 = j; }
            else if (g > v2) { v3 = v2; i3 = i2; v2 = g; i2 = j; }
            else if (g > v3) { v3 = g; i3 = j; }
        }
        unsigned m = 0;
        if (i1 >= 0) m |= 1u << i1;
        if (i2 >= 0) m |= 1u << i2;
        if (i3 >= 0) m |= 1u << i3;
        SEL[(size_t)row * 8 + h] = m;
    }
    __syncthreads();
}

struct EpiGate2 {
    static constexpr int MIDK = 8;
    const bf16_t* PROJ; bf16_t* MRG;
    __device__ __forceinline__ void mid(f32x4 (&acc)[2][2][4][2], const pg8::Unit& u, int wr, int wc, int fr_, int fq) const {
        int fr = fr_; asm volatile("" : "+v"(fr));
#pragma unroll
        for (int ai = 0; ai < 2; ++ai)
#pragma unroll
            for (int m = 0; m < 4; ++m)
#pragma unroll
                for (int bj = 0; bj < 2; ++bj) { const size_t o = (size_t)(u.pm * 256 + ai * 128 + wr * 64 + m * 16 + fr) * INCP + u.pn * 256 + bj * 128 + wc * 32 + 8 * fq;
                    const u32x4 ga = *(const u32x4*)(PROJ + o + C_GA), gb = *(const u32x4*)(PROJ + o + C_GB);
#pragma unroll
                    for (int i = 0; i < 4; ++i) { const float r0 = bflo(ga[i]) * __builtin_amdgcn_rcpf(bflo(gb[i])), r1 = bfhi(ga[i]) * __builtin_amdgcn_rcpf(bfhi(gb[i]));
                        acc[ai][bj][m][i >> 1][2 * (i & 1)] *= r0; acc[ai][bj][m][i >> 1][2 * (i & 1) + 1] *= r1; }
                    __builtin_amdgcn_sched_barrier(0); }
    }
    __device__ __forceinline__ void operator()(const f32x4 (&acc)[2][2][4][2], const pg8::Unit& u, int wr, int wc, int fr, int fq) const {
        PG8_TILE_BEGIN(acc, wr, wc, fr, fq)
            const int row = u.pm * 256 + trow, col = u.pn * 256 + tcol;
            const u32x4 g = *(const u32x4*)(PROJ + (size_t)row * INCP + C_GB + col);
            v0[0] *= bflo(g.x); v0[1] *= bfhi(g.x); v0[2] *= bflo(g.y); v0[3] *= bfhi(g.y); v1[0] *= bflo(g.z); v1[1] *= bfhi(g.z); v1[2] *= bflo(g.w); v1[3] *= bfhi(g.w);
            *(u32x4*)(MRG + (size_t)row * DM + col) = pg8::pack8(v0, v1);
        PG8_TILE_END
    }
};
struct EpiResid {
    static constexpr int MIDK = 0;
    const bf16_t* X; bf16_t* PRE;
    __device__ __forceinline__ void operator()(const f32x4 (&acc)[2][2][4][2], const pg8::Unit& u, int wr, int wc, int fr, int fq) const {
        PG8_TILE_BEGIN(acc, wr, wc, fr, fq)
            const size_t o = (size_t)(u.pm * 256 + trow) * DM + u.pn * 256 + tcol;
            const u32x4 x = *(const u32x4*)(X + o);
            v0[0] += ALPHA * bflo(x.x); v0[1] += ALPHA * bfhi(x.x); v0[2] += ALPHA * bflo(x.y); v0[3] += ALPHA * bfhi(x.y);
            v1[0] += ALPHA * bflo(x.z); v1[1] += ALPHA * bfhi(x.z); v1[2] += ALPHA * bflo(x.w); v1[3] += ALPHA * bfhi(x.w);
            *(u32x4*)(PRE + o) = pg8::pack8(v0, v1);
        PG8_TILE_END
    }
};
__device__ __forceinline__ void ln_phase(const Frame& F, const bf16_t* PRE, const float* g, const float* bt, bf16_t* XBo) {
    int lane_ = F.lane; asm volatile("" : "+v"(lane_));
    const int gw = F.vcu * NWAVES + F.wave, NGW = F.G * NWAVES, lane = lane_;
    for (int row = gw; row < T; row += NGW) {
        const u32x2* pr = (const u32x2*)(PRE + (size_t)row * DM) + lane;
        f32x4 v[4]; float s = 0.f;
#pragma unroll
        for (int j = 0; j < 4; ++j) { const u32x2 h = pr[64 * j]; v[j] = (f32x4){bflo(h.x), bfhi(h.x), bflo(h.y), bfhi(h.y)}; s += (v[j][0] + v[j][1]) + (v[j][2] + v[j][3]); }
        const float mean = wave_sum(s) * (1.f / DM); float s2 = 0.f;
#pragma unroll
        for (int j = 0; j < 4; ++j) { v[j] = v[j] - mean; s2 += (v[j][0] * v[j][0] + v[j][1] * v[j][1]) + (v[j][2] * v[j][2] + v[j][3] * v[j][3]); }
        const float rstd = rsqrtf(wave_sum(s2) * (1.f / DM) + LN_EPS);
#pragma unroll
        for (int j = 0; j < 4; ++j) { const f32x4 gg = ((const f32x4*)g)[lane + 64 * j], bb = ((const f32x4*)bt)[lane + 64 * j];
            const f32x4 y = v[j] * rstd * gg + bb;
            u32x2 w; w.x = pk2(y[0], y[1]); w.y = pk2(y[2], y[3]); ((u32x2*)(XBo + (size_t)row * DM))[lane + 64 * j] = w; }
    }
}

struct RowGU { int off; __device__ __forceinline__ int operator()(int n) const { return 256 * (n >> 7) + off + (n & 127); } };

struct EpiF32 {
    static constexpr int MIDK = 0;
    float* O; int ld;
    __device__ __forceinline__ void operator()(const f32x4 (&acc)[2][2][4][2], const pg8::Unit& u, int wr, int wc, int fr, int fq) const {
        PG8_TILE_BEGIN(acc, wr, wc, fr, fq)
            float* o = O + (size_t)(u.pm * 256 + trow) * ld + u.pn * 256 + tcol; *(f32x4*)o = v0; *(f32x4*)(o + 4) = v1;
        PG8_TILE_END
    }
};
struct EpiBf16 {
    static constexpr int MIDK = 0;
    bf16_t* O; int ld;
    __device__ __forceinline__ void operator()(const f32x4 (&acc)[2][2][4][2], const pg8::Unit& u, int wr, int wc, int fr, int fq) const {
        PG8_TILE_BEGIN(acc, wr, wc, fr, fq)
            *(u32x4*)(O + (size_t)(u.pm * 256 + trow) * ld + u.pn * 256 + tcol) = pg8::pack8(v0, v1);
        PG8_TILE_END
    }
};
__device__ __forceinline__ float silu_mul(float g, float u) { return g * __builtin_amdgcn_rcpf(1.f + __expf(-g)) * u; }
struct EpiSwiGLU {
    static constexpr int MIDK = 0;
    bf16_t* H; int ld;
    __device__ __forceinline__ void operator()(const f32x4 (&acc)[2][2][4][2], const pg8::Unit& u, int wr, int wc, int fr, int fq) const {
#pragma unroll
        for (int ai = 0; ai < 2; ++ai)
#pragma unroll
            for (int m = 0; m < 4; ++m) { const int row = u.r0 + ai * 128 + wr * 64 + m * 16 + fr;
                if (row < u.rend) { f32x4 h0, h1;
#pragma unroll
                    for (int i = 0; i < 4; ++i) { h0[i] = silu_mul(acc[ai][0][m][0][i], acc[ai][1][m][0][i]); h1[i] = silu_mul(acc[ai][0][m][1][i], acc[ai][1][m][1][i]); }
                    *(u32x4*)(H + (size_t)row * ld + 128 * u.pn + wc * 32 + 8 * fq) = pg8::pack8(h0, h1); } }
    }
};
constexpr float Y8_SCALE = 32.f;
__device__ __forceinline__ unsigned pk4_fp8(float a, float b, float c, float d) { int w = __builtin_amdgcn_cvt_pk_fp8_f32(a, b, 0, false); w = __builtin_amdgcn_cvt_pk_fp8_f32(c, d, w, true); return (unsigned)w; }
struct EpiExpDown {
    static constexpr int MIDK = 0;
    unsigned char* Y8;
    __device__ __forceinline__ void operator()(const f32x4 (&acc)[2][2][4][2], const pg8::Unit& u, int wr, int wc, int fr, int fq) const {
#pragma unroll
        for (int ai = 0; ai < 2; ++ai)
#pragma unroll
            for (int m = 0; m < 4; ++m) { const int row = u.r0 + ai * 128 + wr * 64 + m * 16 + fr;
                if (row < u.rend) { const f32x4 a0 = acc[ai][0][m][0] * Y8_SCALE, a1 = acc[ai][0][m][1] * Y8_SCALE, b0 = acc[ai][1][m][0] * Y8_SCALE, b1 = acc[ai][1][m][1] * Y8_SCALE;
                    u32x4 w; w.x = pk4_fp8(a0[0], a0[1], a0[2], a0[3]); w.y = pk4_fp8(a1[0], a1[1], a1[2], a1[3]); w.z = pk4_fp8(b0[0], b0[1], b0[2], b0[3]); w.w = pk4_fp8(b1[0], b1[1], b1[2], b1[3]);
                    *(u32x4*)(Y8 + (size_t)row * DM + 256 * u.pn + 64 * wc + 16 * fq) = w; } }
    }
};
template <int NPN, bool GATHER>
struct ExpertOrder {
    const LAS int* off; const LAS int* toff; const int* rowa; int G, c; size_t strideE;
    __device__ __forceinline__ bool next(int i, pg8::Unit& u) const {
        const int L = i * G + c; if (L >= toff[256] * NPN) return false;
        const int tile = L / NPN; u.pn = L % NPN; int lo = 0, hi = 255;
        while (lo < hi) { const int mid = (lo + hi + 1) >> 1; if (toff[mid] <= tile) lo = mid; else hi = mid - 1; }
        u.e = lo; u.r0 = off[lo] + (tile - toff[lo]) * 256; u.rend = off[lo + 1]; u.pm = 0; return true;
    }
    __device__ __forceinline__ int a_row(const pg8::Unit& u, int r) const { const int rr = min(u.r0 + r, u.rend - 1); return GATHER ? (rowa[2 * rr] >> 3) : rr; }
    __device__ __forceinline__ const char* b_ptr(const pg8::Gemm& g, const pg8::Unit& u) const { return (const char*)g.Bt + (size_t)u.e * strideE + (size_t)u.pn * 256 * g.ldb * 2; }
};
__device__ __forceinline__ void expert_tables(const Frame& F, const unsigned* cnt, LAS int* off, LAS int* toff) {
    if (F.tid < 256) { off[F.tid] = (int)cnt[F.tid]; }
    __syncthreads();
    if (F.tid == 0) { int a = 0, b = 0; for (int i = 0; i < 256; ++i) { const int c = off[i]; off[i] = a; toff[i] = b; a += c; b += (c + 255) >> 8; } off[256] = a; toff[256] = b; }
    __syncthreads();
}
__device__ __forceinline__ void route_phase(const Frame& F, const float* LOGITS, const float* rbias, int* TOPE, float* TOPW, int* APOS, int* HIST, LAS int* lcnt) {
    int lane_ = F.lane; asm volatile("" : "+v"(lane_));
    const int lane = lane_, TPW = T / F.G, t0 = (int)blockIdx.x * TPW;
    if (F.tid < 256) lcnt[F.tid] = 0;
    __syncthreads();
    const f32x4 rb = *(const f32x4*)(rbias + lane * 4);
    f32x4 lgn = (t0 + F.wave < t0 + TPW) ? *(const f32x4*)(LOGITS + (size_t)(t0 + F.wave) * NE + lane * 4) : (f32x4){0.f, 0.f, 0.f, 0.f};
#pragma unroll 1
    for (int t = t0 + F.wave; t < t0 + TPW; t += NWAVES) {
        const f32x4 lg = lgn;
        if (t + NWAVES < t0 + TPW) lgn = *(const f32x4*)(LOGITS + (size_t)(t + NWAVES) * NE + lane * 4);
        const float s0 = __builtin_amdgcn_rcpf(1.f + __expf(-lg[0])), s1 = __builtin_amdgcn_rcpf(1.f + __expf(-lg[1])), s2 = __builtin_amdgcn_rcpf(1.f + __expf(-lg[2])), s3 = __builtin_amdgcn_rcpf(1.f + __expf(-lg[3]));
        float c0 = s0 + rb[0], c1 = s1 + rb[1], c2 = s2 + rb[2], c3 = s3 + rb[3];
        float a = fmaxf(c0, c1), bq = fminf(c0, c1);
        { const float hi2 = fmaxf(c2, c3), lo2 = fminf(c2, c3); const float na = fmaxf(a, hi2), nb = fmaxf(fminf(a, hi2), fmaxf(bq, lo2)); a = na; bq = nb; }
#pragma unroll
        for (int o = 1; o < 8; o <<= 1) { const float oa = __shfl_xor(a, o), ob = __shfl_xor(bq, o); const float na = fmaxf(a, oa), nb = fmaxf(fminf(a, oa), fmaxf(bq, ob)); a = na; bq = nb; }
        const float gs = a + bq; const int grp = lane >> 3;
        int rank = 0;
#pragma unroll
        for (int j = 0; j < 8; ++j) { const float og = __shfl(gs, j * 8); rank += (og > gs || (og == gs && j < grp)) ? 1 : 0; }
        if (rank >= 4) { c0 = c1 = c2 = c3 = -INFINITY; }
        float wsum = 0.f, myw = 0.f; int mye = 0;
#pragma unroll
        for (int k = 0; k < TOPK; ++k) {
            float bv = c0; int bi = 0;
            if (c1 > bv) { bv = c1; bi = 1; }
            if (c2 > bv) { bv = c2; bi = 2; }
            if (c3 > bv) { bv = c3; bi = 3; }
            int be = lane * 4 + bi;
#pragma unroll
            for (int o = 1; o < 64; o <<= 1) { const float ov = __shfl_xor(bv, o); const int oe = __shfl_xor(be, o); if (ov > bv || (ov == bv && oe < be)) { bv = ov; be = oe; } }
            float sc = 0.f;
            if ((be >> 2) == lane) { const int b2 = be & 3; sc = b2 == 0 ? s0 : b2 == 1 ? s1 : b2 == 2 ? s2 : s3; if (b2 == 0) c0 = -INFINITY; else if (b2 == 1) c1 = -INFINITY; else if (b2 == 2) c2 = -INFINITY; else c3 = -INFINITY; }
            sc = __shfl(sc, be >> 2);
            wsum += sc;
            if (lane == k) { myw = sc; mye = be; }
        }
        if (lane < TOPK) { const int aidx = t * TOPK + lane; TOPE[aidx] = mye; TOPW[aidx] = myw / wsum * 2.5f; APOS[aidx] = __hip_atomic_fetch_add(lcnt + mye, 1, __ATOMIC_RELAXED, __HIP_MEMORY_SCOPE_WORKGROUP); }
    }
    __syncthreads();
    if (F.tid < 256) HIST[(size_t)blockIdx.x * 256 + F.tid] = lcnt[F.tid];
}
__device__ __forceinline__ void combine_phase(const Frame& F, const bf16_t* X1, const bf16_t* SH, const unsigned char* Y8, const int* INV, const float* TOPW, const float* g, const float* bt, float* Xo, bf16_t* XBo) {
    int lane_ = F.lane; asm volatile("" : "+v"(lane_));
    const int gw = F.vcu * NWAVES + F.wave, NGW = F.G * NWAVES, lane = lane_;
    for (int row = gw; row < T; row += NGW) {
        int ri = 0; float rw = 0.f; if (lane < TOPK) { ri = INV[row * TOPK + lane]; rw = TOPW[row * TOPK + lane] * (1.f / Y8_SCALE); }
        float v[16];
#pragma unroll
        for (int j = 0; j < 2; ++j) { const u32x4 x = ((const u32x4*)(X1 + (size_t)row * DM))[2 * lane + j], h = ((const u32x4*)(SH + (size_t)row * DM))[2 * lane + j];
#pragma unroll
            for (int i = 0; i < 4; ++i) { v[8 * j + 2 * i] = ALPHA * bflo(x[i]) + bflo(h[i]); v[8 * j + 2 * i + 1] = ALPHA * bfhi(x[i]) + bfhi(h[i]); } }
#pragma unroll
        for (int k = 0; k < TOPK; ++k) { const u32x4 h = ((const u32x4*)(Y8 + (size_t)__shfl(ri, k) * DM))[lane]; const float w = __shfl(rw, k);
#pragma unroll
            for (int i = 0; i < 4; ++i) { const f32x2 lo = __builtin_amdgcn_cvt_pk_f32_fp8((int)h[i], false), hi2 = __builtin_amdgcn_cvt_pk_f32_fp8((int)h[i], true);
                v[4 * i] = fmaf(w, lo[0], v[4 * i]); v[4 * i + 1] = fmaf(w, lo[1], v[4 * i + 1]); v[4 * i + 2] = fmaf(w, hi2[0], v[4 * i + 2]); v[4 * i + 3] = fmaf(w, hi2[1], v[4 * i + 3]); } }
        float s = 0.f;
#pragma unroll
        for (int i = 0; i < 16; ++i) s += v[i];
        const float mean = wave_sum(s) * (1.f / DM); float s2 = 0.f;
#pragma unroll
        for (int i = 0; i < 16; ++i) { v[i] -= mean; s2 += v[i] * v[i]; }
        const float rstd = rsqrtf(wave_sum(s2) * (1.f / DM) + LN_EPS);
        const int c0 = 16 * lane;
        f32x4 y[4];
#pragma unroll
        for (int q = 0; q < 4; ++q) { const f32x4 gg = *(const f32x4*)(g + c0 + 4 * q), bb = *(const f32x4*)(bt + c0 + 4 * q); y[q] = (f32x4){v[4 * q], v[4 * q + 1], v[4 * q + 2], v[4 * q + 3]} * rstd * gg + bb; }
        if (Xo) {
#pragma unroll
            for (int q = 0; q < 4; ++q) *(f32x4*)(Xo + (size_t)row * DM + c0 + 4 * q) = y[q]; }
        if (XBo) {
#pragma unroll
            for (int j = 0; j < 2; ++j) { u32x4 w; w.x = pk2(y[2 * j][0], y[2 * j][1]); w.y = pk2(y[2 * j][2], y[2 * j][3]); w.z = pk2(y[2 * j + 1][0], y[2 * j + 1][1]); w.w = pk2(y[2 * j + 1][2], y[2 * j + 1][3]); *(u32x4*)(XBo + (size_t)row * DM + c0 + 8 * j) = w; } }
    }
}

__device__ __forceinline__ int crow(int r, int hi) { return (r & 3) + 8 * (r >> 2) + 4 * hi; }
typedef short s16x4 __attribute__((ext_vector_type(4)));
__device__ __forceinline__ s16x4 vtr(const LAS unsigned char* p) { return __builtin_bit_cast(s16x4, __builtin_amdgcn_ds_read_tr16_b64_v4i16((LAS s16x4*)p)); }
__device__ __forceinline__ float xhalf_max(float v) { auto rr = __builtin_amdgcn_permlane32_swap(__float_as_uint(v), __float_as_uint(v), false, false); return fmaxf(__uint_as_float(rr[0]), __uint_as_float(rr[1])); }
__device__ __forceinline__ float xhalf_sum(float v) { auto rr = __builtin_amdgcn_permlane32_swap(__float_as_uint(v), __float_as_uint(v), false, false); return __uint_as_float(rr[0]) + __uint_as_float(rr[1]); }

template <int DQK>
__device__ __forceinline__ void attn_qk(const LAS unsigned char* kb, int kfo, const bf16x8 (&qf)[DQK / 16], f32x16& p0, f32x16& p1) {
    constexpr int ND0 = DQK / 16;
    bf16x8 ka[ND0], kc[ND0];
#pragma unroll
    for (int d0 = 0; d0 < ND0; ++d0) { ka[d0] = *(const LAS bf16x8*)(kb + kfo + d0 * 2048); kc[d0] = *(const LAS bf16x8*)(kb + kfo + d0 * 2048 + 512); }
    __builtin_amdgcn_sched_barrier(0);
#pragma unroll
    for (int r = 0; r < 16; ++r) { p0[r] = 0.f; p1[r] = 0.f; }
#pragma unroll
    for (int d0 = 0; d0 < ND0; ++d0) {
        p0 = __builtin_amdgcn_mfma_f32_32x32x16_bf16(ka[d0], qf[d0], p0, 0, 0, 0);
        p1 = __builtin_amdgcn_mfma_f32_32x32x16_bf16(kc[d0], qf[d0], p1, 0, 0, 0);
    }
}
template <bool ALIBI>
__device__ __forceinline__ void attn_sv(const LAS unsigned char* kb, int vfo, f32x16& p0, f32x16& p1, float& m, float& l, f32x16& o0, f32x16& o1, int hi, int tq, int kpos0, float slope2, bool causal) {
    s16x4 vlo[8], vhi[8];
    { const unsigned va = (unsigned)(uintptr_t)(kb + vfo);
#pragma unroll
      for (int i = 0; i < 8; ++i) {
        asm volatile("ds_read_b64_tr_b16 %0, %1 offset:%c2" : "=&v"(vlo[i]) : "v"(va), "i"((i >> 2) * 4096 + (i & 3) * 1024) : "memory");
        asm volatile("ds_read_b64_tr_b16 %0, %1 offset:%c2" : "=&v"(vhi[i]) : "v"(va), "i"((i >> 2) * 4096 + (i & 3) * 1024 + 512) : "memory"); } }
    const int krel = kpos0 + 4 * hi - tq;
    if (ALIBI) { const float bb = slope2 * (float)krel;
#pragma unroll
        for (int r = 0; r < 16; ++r) { const float c = (float)((r & 3) + 8 * (r >> 2)); p0[r] += fmaf(slope2, c, bb); p1[r] += fmaf(slope2, c + 32.f, bb); } }
    if (causal) {
#pragma unroll
        for (int r = 0; r < 16; ++r) { const int kv = krel + (r & 3) + 8 * (r >> 2); if (kv > 0) p0[r] = -INFINITY; if (kv + 32 > 0) p1[r] = -INFINITY; } }
    float rm = fmaxf(p0[0], p1[0]);
#pragma unroll
    for (int r = 1; r < 16; ++r) rm = fmaxf(rm, fmaxf(p0[r], p1[r]));
    rm = xhalf_max(rm);
    const float mn = fmaxf(m, rm), alpha = __builtin_amdgcn_exp2f(m - mn);
    m = mn;
    float ls = 0.f;
#pragma unroll
    for (int r = 0; r < 16; ++r) { p0[r] = __builtin_amdgcn_exp2f(p0[r] - mn); p1[r] = __builtin_amdgcn_exp2f(p1[r] - mn); ls += p0[r] + p1[r]; }
    l = l * alpha + ls;
#pragma unroll
    for (int r = 0; r < 16; ++r) { o0[r] *= alpha; o1[r] *= alpha; }
    const u32x4 pw0 = (u32x4){pg8::cvt_pk_bf16(p0[0], p0[1]), pg8::cvt_pk_bf16(p0[2], p0[3]), pg8::cvt_pk_bf16(p0[4], p0[5]), pg8::cvt_pk_bf16(p0[6], p0[7])};
    const u32x4 pw1 = (u32x4){pg8::cvt_pk_bf16(p0[8], p0[9]), pg8::cvt_pk_bf16(p0[10], p0[11]), pg8::cvt_pk_bf16(p0[12], p0[13]), pg8::cvt_pk_bf16(p0[14], p0[15])};
    const u32x4 pw2 = (u32x4){pg8::cvt_pk_bf16(p1[0], p1[1]), pg8::cvt_pk_bf16(p1[2], p1[3]), pg8::cvt_pk_bf16(p1[4], p1[5]), pg8::cvt_pk_bf16(p1[6], p1[7])};
    const u32x4 pw3 = (u32x4){pg8::cvt_pk_bf16(p1[8], p1[9]), pg8::cvt_pk_bf16(p1[10], p1[11]), pg8::cvt_pk_bf16(p1[12], p1[13]), pg8::cvt_pk_bf16(p1[14], p1[15])};
    asm volatile("s_waitcnt lgkmcnt(0)" ::: "memory"); __builtin_amdgcn_sched_barrier(0);
#define ATT_VF(i) (bf16x8){vlo[i][0], vlo[i][1], vlo[i][2], vlo[i][3], vhi[i][0], vhi[i][1], vhi[i][2], vhi[i][3]}
    o0 = __builtin_amdgcn_mfma_f32_32x32x16_bf16(ATT_VF(0), __builtin_bit_cast(bf16x8, pw0), o0, 0, 0, 0);
    o1 = __builtin_amdgcn_mfma_f32_32x32x16_bf16(ATT_VF(4), __builtin_bit_cast(bf16x8, pw0), o1, 0, 0, 0);
    o0 = __builtin_amdgcn_mfma_f32_32x32x16_bf16(ATT_VF(1), __builtin_bit_cast(bf16x8, pw1), o0, 0, 0, 0);
    o1 = __builtin_amdgcn_mfma_f32_32x32x16_bf16(ATT_VF(5), __builtin_bit_cast(bf16x8, pw1), o1, 0, 0, 0);
    o0 = __builtin_amdgcn_mfma_f32_32x32x16_bf16(ATT_VF(2), __builtin_bit_cast(bf16x8, pw2), o0, 0, 0, 0);
    o1 = __builtin_amdgcn_mfma_f32_32x32x16_bf16(ATT_VF(6), __builtin_bit_cast(bf16x8, pw2), o1, 0, 0, 0);
    o0 = __builtin_amdgcn_mfma_f32_32x32x16_bf16(ATT_VF(3), __builtin_bit_cast(bf16x8, pw3), o0, 0, 0, 0);
    o1 = __builtin_amdgcn_mfma_f32_32x32x16_bf16(ATT_VF(7), __builtin_bit_cast(bf16x8, pw3), o1, 0, 0, 0);
#undef ATT_VF
}
template <int DQK, bool ALIBI>
__device__ __forceinline__ void attn_tile(const LAS unsigned char* kb, int kfo, int vfo, const bf16x8 (&qf)[DQK / 16], float& m, float& l, f32x16& o0, f32x16& o1, int hi, int tq, int kpos0, float slope2, bool causal) {
    f32x16 p0, p1;
    attn_qk<DQK>(kb, kfo, qf, p0, p1);
    attn_sv<ALIBI>(kb, vfo, p0, p1, m, l, o0, o1, hi, tq, kpos0, slope2, causal);
}
#define ATT_ISSUE(t, bo) do { \
        for (int c_ = wid; c_ < NCH; c_ += 8) __builtin_amdgcn_global_load_lds((const unsigned*)(ksrc + (size_t)(t) * 64 * ldk + c_ * 8), (LAS unsigned*)(lds + (bo) + c_ * 1024), 16, 0, 0); \
        __builtin_amdgcn_global_load_lds((const unsigned*)(vsrc + (size_t)(t) * 64 * ldv), (LAS unsigned*)(lds + (bo) + KBYTES + wid * 1024), 16, 0, 0); } while (0)

template <int DQK, bool MOBA_OWN>
__device__ __forceinline__ void attn_unit(LAS unsigned char* lds, int b, int h, int qb, const bf16_t* Qp, int ldq, const bf16_t* Kp, int ldk, const bf16_t* Vp, int ldv, bf16_t* Op, int ldo, const bf16_t* PO, const f32x2* PML) {
    constexpr int NCH = DQK / 8, KBYTES = NCH * 1024, BUFB = KBYTES + 8192, ND0 = DQK / 16;
    int tid_ = threadIdx.x; asm volatile("" : "+v"(tid_));
    const int lane = tid_ & 63, r32 = lane & 31, hi = lane >> 5, wid = __builtin_amdgcn_readfirstlane(tid_ >> 6);
    const size_t rowbase = (size_t)b * SEQ; const int q0 = qb * 256, T0 = MOBA_OWN ? 4 * qb : 0, T1 = 4 * (qb + 1), tq = q0 + wid * 32 + r32;
    const bf16_t* ksrc = Kp + (rowbase + lane) * ldk + h * DQK;
    const bf16_t* vsrc = Vp + (rowbase + 16 * (wid & 3) + (lane >> 2)) * ldv + h * 64 + (wid >> 2) * 32 + (lane & 3) * 8;
    ATT_ISSUE(T0, 0); ATT_ISSUE(T0 + 1, BUFB);
    bf16x8 qf[ND0];
    { const bf16_t* qrow = Qp + (rowbase + tq) * ldq + h * DQK + hi * 8;
#pragma unroll
      for (int d0 = 0; d0 < ND0; ++d0) qf[d0] = *(const bf16x8*)(qrow + d0 * 16); }
    const float slope2 = MOBA_OWN ? exp2f(-(float)(h + 1)) * LOG2E : 0.f;
    float m = -1e30f, l = 0.f;
    f32x16 o0, o1;
#pragma unroll
    for (int r = 0; r < 16; ++r) { o0[r] = 0.f; o1[r] = 0.f; }
    const int kfo = hi * 1024 + r32 * 16;
    const int vfo = KBYTES + ((lane >> 4) & 1) * 32 + (lane & 3) * 8 + (4 * hi + ((lane & 15) >> 2)) * 64;
#define ATT_BAR() asm volatile("s_waitcnt vmcnt(0) lgkmcnt(0)\n\ts_barrier" ::: "memory")
    int b0 = 0, b1 = BUFB, b2 = 2 * BUFB;
    f32x16 pA0, pA1, pB0, pB1;
    ATT_BAR();
    attn_qk<DQK>(lds + b0, kfo, qf, pA0, pA1);
#pragma unroll 1
    for (int t = T0; t < T1; t += 2) {
        if (t + 2 < T1) ATT_ISSUE(t + 2, b2);
        attn_qk<DQK>(lds + b1, kfo, qf, pB0, pB1);
        attn_sv<MOBA_OWN>(lds + b0, vfo, pA0, pA1, m, l, o0, o1, hi, tq, 64 * t, slope2, t >= T1 - 4);
        ATT_BAR();
        { const int x = b0; b0 = b1; b1 = b2; b2 = x; }
        if (t + 3 < T1) ATT_ISSUE(t + 3, b2);
        if (t + 2 < T1) attn_qk<DQK>(lds + b1, kfo, qf, pA0, pA1);
        attn_sv<MOBA_OWN>(lds + b0, vfo, pB0, pB1, m, l, o0, o1, hi, tq, 64 * (t + 1), slope2, t + 1 >= T1 - 4);
        ATT_BAR();
        { const int x = b0; b0 = b1; b1 = b2; b2 = x; }
    }
#undef ATT_BAR
    float lt = xhalf_sum(l);
    if (MOBA_OWN) {
        const int nsel = qb < 3 ? qb : 3;
        const size_t pidx = ((rowbase + tq) * 8 + h) * 3;
        float ms[3], ws[3], M = m;
#pragma unroll
        for (int sIdx = 0; sIdx < 3; ++sIdx) { ms[sIdx] = -1e30f; ws[sIdx] = 0.f; if (sIdx < nsel) { const f32x2 ml = PML[(pidx + sIdx) * 16]; ms[sIdx] = ml[0]; ws[sIdx] = ml[1]; M = fmaxf(M, ml[0]); } }
        const float w0 = __builtin_amdgcn_exp2f(m - M);
        lt *= w0;
#pragma unroll
        for (int r = 0; r < 16; ++r) { o0[r] *= w0; o1[r] *= w0; }
#pragma unroll
        for (int sIdx = 0; sIdx < 3; ++sIdx) if (sIdx < nsel) {
            const float w = ws[sIdx] * __builtin_amdgcn_exp2f(ms[sIdx] - M); lt += w;
            const bf16_t* po = PO + (pidx + sIdx) * 64 + 4 * hi;
#pragma unroll
            for (int r4 = 0; r4 < 4; ++r4) { const u32x2 a = *(const u32x2*)(po + 8 * r4), c = *(const u32x2*)(po + 32 + 8 * r4);
                o0[4 * r4] += w * bflo(a.x); o0[4 * r4 + 1] += w * bfhi(a.x); o0[4 * r4 + 2] += w * bflo(a.y); o0[4 * r4 + 3] += w * bfhi(a.y);
                o1[4 * r4] += w * bflo(c.x); o1[4 * r4 + 1] += w * bfhi(c.x); o1[4 * r4 + 2] += w * bflo(c.y); o1[4 * r4 + 3] += w * bfhi(c.y); } }
    }
    const float inv = 1.f / lt;
    bf16_t* orow = Op + (rowbase + tq) * ldo + h * 64 + 4 * hi;
#pragma unroll
    for (int r4 = 0; r4 < 4; ++r4) {
        u32x2 w0_, w1_;
        w0_.x = pg8::cvt_pk_bf16(o0[4 * r4] * inv, o0[4 * r4 + 1] * inv); w0_.y = pg8::cvt_pk_bf16(o0[4 * r4 + 2] * inv, o0[4 * r4 + 3] * inv);
        w1_.x = pg8::cvt_pk_bf16(o1[4 * r4] * inv, o1[4 * r4 + 1] * inv); w1_.y = pg8::cvt_pk_bf16(o1[4 * r4 + 2] * inv, o1[4 * r4 + 3] * inv);
        *(u32x2*)(orow + 8 * r4) = w0_; *(u32x2*)(orow + 32 + 8 * r4) = w1_;
    }
    asm volatile("s_waitcnt lgkmcnt(0)\n\ts_barrier" ::: "memory");
}
__device__ __forceinline__ void moba_sel_unit(LAS unsigned char* lds, int b, int h, int j, int slo, int shi, const bf16_t* Qp, const bf16_t* Kp, const bf16_t* Vp, int ldk, const unsigned* SEL, bf16_t* PO, f32x2* PML) {
    constexpr int DQK = 64, NCH = 8, KBYTES = 8192, BUFB = 16384, ldv = INCP; (void)ldv;
    int tid_ = threadIdx.x; asm volatile("" : "+v"(tid_));
    const int lane = tid_ & 63, r32 = lane & 31, hi = lane >> 5, wid = __builtin_amdgcn_readfirstlane(tid_ >> 6);
    const size_t rowbase = (size_t)b * SEQ;
    const bf16_t* ksrc = Kp + (rowbase + lane) * ldk + h * DQK;
    const bf16_t* vsrc = Vp + (rowbase + 16 * (wid & 3) + (lane >> 2)) * ldk + h * 64 + (wid >> 2) * 32 + (lane & 3) * 8;
#pragma unroll
    for (int tt = 0; tt < 4; ++tt) ATT_ISSUE(4 * j + tt, tt * BUFB);
    LAS unsigned short* list = (LAS unsigned short*)(lds + 4 * BUFB);
    LAS int* cnt = (LAS int*)(lds + 4 * BUFB + 8192);
    if (tid_ == 0) *cnt = 0;
    __syncthreads();
    const int nsrc = (shi - slo) * 256;
    for (int i = tid_; i < nsrc; i += NTHR) {
        const unsigned sm = SEL[(rowbase + (size_t)slo * 256 + i) * 8 + h];
        const bool f = ((sm >> j) & 1u) != 0u;
        const unsigned long long bal = __ballot(f);
        const int rank = __builtin_amdgcn_mbcnt_hi((unsigned)(bal >> 32), __builtin_amdgcn_mbcnt_lo((unsigned)bal, 0u));
        int base = 0;
        if (lane == 0) base = __hip_atomic_fetch_add(cnt, (int)__builtin_popcountll(bal), __ATOMIC_RELAXED, __HIP_MEMORY_SCOPE_WORKGROUP);
        base = __builtin_amdgcn_readfirstlane(base);
        if (f) list[base + rank] = (unsigned short)i;
    }
    asm volatile("s_waitcnt vmcnt(0)" ::: "memory");
    __syncthreads();
    const int n = *cnt, nch = (n + 31) >> 5;
    const float slope2 = exp2f(-(float)(h + 1)) * LOG2E;
    const int kfo = hi * 1024 + r32 * 16;
    const int vfo = KBYTES + ((lane >> 4) & 1) * 32 + (lane & 3) * 8 + (4 * hi + ((lane & 15) >> 2)) * 64;
    for (int ch = wid; ch < nch; ch += 8) {
        const int e = ch * 32 + r32; const bool valid = e < n;
        const int tq = slo * 256 + (int)list[valid ? e : n - 1];
        bf16x8 qf[4];
        { const bf16_t* qrow = Qp + (rowbase + tq) * INCP + h * DQK + hi * 8;
#pragma unroll
          for (int d0 = 0; d0 < 4; ++d0) qf[d0] = *(const bf16x8*)(qrow + d0 * 16); }
        const unsigned sm = SEL[(rowbase + tq) * 8 + h];
        float m = -1e30f, l = 0.f;
        f32x16 o0, o1;
#pragma unroll
        for (int r = 0; r < 16; ++r) { o0[r] = 0.f; o1[r] = 0.f; }
        { f32x16 pA0, pA1, pB0, pB1;
          attn_qk<64>(lds, kfo, qf, pA0, pA1);
          attn_qk<64>(lds + BUFB, kfo, qf, pB0, pB1);
          attn_sv<true>(lds, vfo, pA0, pA1, m, l, o0, o1, hi, tq, 256 * j, slope2, false);
          attn_qk<64>(lds + 2 * BUFB, kfo, qf, pA0, pA1);
          attn_sv<true>(lds + BUFB, vfo, pB0, pB1, m, l, o0, o1, hi, tq, 256 * j + 64, slope2, false);
          attn_qk<64>(lds + 3 * BUFB, kfo, qf, pB0, pB1);
          attn_sv<true>(lds + 2 * BUFB, vfo, pA0, pA1, m, l, o0, o1, hi, tq, 256 * j + 128, slope2, false);
          attn_sv<true>(lds + 3 * BUFB, vfo, pB0, pB1, m, l, o0, o1, hi, tq, 256 * j + 192, slope2, false); }
        const float lt = xhalf_sum(l), inv = 1.f / lt;
        if (valid) {
            const size_t pidx = ((rowbase + tq) * 8 + h) * 3 + __builtin_popcount(sm & ((1u << j) - 1u));
            if (hi == 0) PML[pidx * 16] = (f32x2){m, lt};
            bf16_t* po = PO + pidx * 64 + 4 * hi;
#pragma unroll
            for (int r4 = 0; r4 < 4; ++r4) {
                u32x2 w0_, w1_;
                w0_.x = pg8::cvt_pk_bf16(o0[4 * r4] * inv, o0[4 * r4 + 1] * inv); w0_.y = pg8::cvt_pk_bf16(o0[4 * r4 + 2] * inv, o0[4 * r4 + 3] * inv);
                w1_.x = pg8::cvt_pk_bf16(o1[4 * r4] * inv, o1[4 * r4 + 1] * inv); w1_.y = pg8::cvt_pk_bf16(o1[4 * r4 + 2] * inv, o1[4 * r4 + 3] * inv);
                *(u32x2*)(po + 8 * r4) = w0_; *(u32x2*)(po + 32 + 8 * r4) = w1_;
            }
        }
    }
    __syncthreads();
}
#undef ATT_ISSUE
__device__ __forceinline__ void mla_phase(const Frame& F, const bf16_t* QB, const bf16_t* KB, const bf16_t* VB, bf16_t* Op) {
    for (int u = 2 * F.vcu; u < 512; u += 2 * F.G) {
#pragma unroll 1
        for (int k = 0; k < 2; ++k) { const int uu = u + k, bh = uu >> 5, w = uu & 31, qb = (w & 1) ? (w >> 1) : 31 - (w >> 1);
            attn_unit<96, false>(F.lds, bh >> 3, bh & 7, qb, QB, 768, KB, 768, VB, 512, Op, 1024, nullptr, nullptr); }
    }
}
__device__ const unsigned short SEL_TAB[256][5] = {
    {0,1376,1776,65535,65535}, {1,1377,1777,65535,65535}, {2,1378,1778,65535,65535}, {3,1379,1779,65535,65535},
    {4,1380,1780,65535,65535}, {5,1381,1781,65535,65535}, {6,1382,1782,65535,65535}, {7,1383,1783,65535,65535},
    {8,1384,1784,65535,65535}, {9,1385,1785,65535,65535}, {10,1386,1786,65535,65535}, {11,1387,1787,65535,65535},
    {12,1388,1788,65535,65535}, {13,1389,1789,65535,65535}, {14,1390,1790,65535,65535}, {15,1391,1791,65535,65535},
    {16,96,1552,1808,65535}, {17,97,1553,1809,65535}, {18,98,1554,1810,65535}, {19,99,1555,1811,65535},
    {20,100,1556,1812,65535}, {21,101,1557,1813,65535}, {22,102,1558,1814,65535}, {23,103,1559,1815,65535},
    {24,104,1560,1816,65535}, {25,105,1561,1817,65535}, {26,106,1562,1818,65535}, {27,107,1563,1819,65535},
    {28,108,1564,1820,65535}, {29,109,1565,1821,65535}, {30,110,1566,1822,65535}, {31,111,1567,1823,65535},
    {32,1232,1568,1824,65535}, {33,1233,1569,1825,65535}, {34,1234,1570,1826,65535}, {35,1235,1571,1827,65535},
    {36,1236,1572,1828,65535}, {37,1237,1573,1829,65535}, {38,1238,1574,1830,65535}, {39,1239,1575,1831,65535},
    {40,1240,1576,1832,65535}, {41,1241,1577,1833,65535}, {42,1242,1578,1834,65535}, {43,1243,1579,1835,65535},
    {44,1244,1580,1836,65535}, {45,1245,1581,1837,65535}, {46,1246,1582,1838,65535}, {47,1247,1583,1839,65535},
    {48,1088,688,1584,1840}, {49,1089,689,1585,1841}, {50,1090,690,1586,1842}, {51,1091,691,1587,1843},
    {52,1092,692,1588,1844}, {53,1093,693,1589,1845}, {54,1094,694,1590,1846}, {55,1095,695,1591,1847},
    {56,1096,696,1592,1848}, {57,1097,697,1593,1849}, {58,1098,698,1594,1850}, {59,1099,699,1595,1851},
    {60,1100,700,1596,1852}, {61,1101,701,1597,1853}, {62,1102,702,1598,1854}, {63,1103,703,1599,1855},
    {512,1104,704,1600,1856}, {513,1105,705,1601,1857}, {514,1106,706,1602,1858}, {515,1107,707,1603,1859},
    {516,1108,708,1604,1860}, {517,1109,709,1605,1861}, {518,1110,710,1606,1862}, {519,1111,711,1607,1863},
    {520,1112,712,1608,1864}, {521,1113,713,1609,1865}, {522,1114,714,1610,1866}, {523,1115,715,1611,1867},
    {524,1116,716,1612,1868}, {525,1117,717,1613,1869}, {526,1118,718,1614,1870}, {527,1119,719,1615,1871},
    {528,1120,720,1616,1872}, {529,1121,721,1617,1873}, {530,1122,722,1618,1874}, {531,1123,723,1619,1875},
    {532,1124,724,1620,1876}, {533,1125,725,1621,1877}, {534,1126,726,1622,1878}, {535,1127,727,1623,1879},
    {536,1128,728,1624,1880}, {537,1129,729,1625,1881}, {538,1130,730,1626,1882}, {539,1131,731,1627,1883},
    {540,1132,732,1628,1884}, {541,1133,733,1629,1885}, {542,1134,734,1630,1886}, {543,1135,735,1631,1887},
    {544,1136,736,1632,1888}, {545,1137,737,1633,1889}, {546,1138,738,1634,1890}, {547,1139,739,1635,1891},
    {548,1140,740,1636,1892}, {549,1141,741,1637,1893}, {550,1142,742,1638,1894}, {551,1143,743,1639,1895},
    {552,1144,744,1640,1896}, {553,1145,745,1641,1897}, {554,1146,746,1642,1898}, {555,1147,747,1643,1899},
    {556,1148,748,1644,1900}, {557,1149,749,1645,1901}, {558,1150,750,1646,1902}, {559,1151,751,1647,1903},
    {560,1152,1296,1648,1904}, {561,1153,1297,1649,1905}, {562,1154,1298,1650,1906}, {563,1155,1299,1651,1907},
    {564,1156,1300,1652,1908}, {565,1157,1301,1653,1909}, {566,1158,1302,1654,1910}, {567,1159,1303,1655,1911},
    {568,1160,1304,1656,1912}, {569,1161,1305,1657,1913}, {570,1162,1306,1658,1914}, {571,1163,1307,1659,1915},
    {572,1164,1308,1660,1916}, {573,1165,1309,1661,1917}, {574,1166,1310,1662,1918}, {575,1167,1311,1663,1919},
    {576,1168,1312,1664,1920}, {577,1169,1313,1665,1921}, {578,1170,1314,1666,1922}, {579,1171,1315,1667,1923},
    {580,1172,1316,1668,1924}, {581,1173,1317,1669,1925}, {582,1174,1318,1670,1926}, {583,1175,1319,1671,1927},
    {584,1176,1320,1672,1928}, {585,1177,1321,1673,1929}, {586,1178,1322,1674,1930}, {587,1179,1323,1675,1931},
    {588,1180,1324,1676,1932}, {589,1181,1325,1677,1933}, {590,1182,1326,1678,1934}, {591,1183,1327,1679,1935},
    {592,1184,1328,1680,1936}, {593,1185,1329,1681,1937}, {594,1186,1330,1682,1938}, {595,1187,1331,1683,1939},
    {596,1188,1332,1684,1940}, {597,1189,1333,1685,1941}, {598,1190,1334,1686,1942}, {599,1191,1335,1687,1943},
    {600,1192,1336,1688,1944}, {601,1193,1337,1689,1945}, {602,1194,1338,1690,1946}, {603,1195,1339,1691,1947},
    {604,1196,1340,1692,1948}, {605,1197,1341,1693,1949}, {606,1198,1342,1694,1950}, {607,1199,1343,1695,1951},
    {608,1200,1344,1696,1952}, {609,1201,1345,1697,1953}, {610,1202,1346,1698,1954}, {611,1203,1347,1699,1955},
    {612,1204,1348,1700,1956}, {613,1205,1349,1701,1957}, {614,1206,1350,1702,1958}, {615,1207,1351,1703,1959},
    {616,1208,1352,1704,1960}, {617,1209,1353,1705,1961}, {618,1210,1354,1706,1962}, {619,1211,1355,1707,1963},
    {620,1212,1356,1708,1964}, {621,1213,1357,1709,1965}, {622,1214,1358,1710,1966}, {623,1215,1359,1711,1967},
    {624,1216,1360,1712,1968}, {625,1217,1361,1713,1969}, {626,1218,1362,1714,1970}, {627,1219,1363,1715,1971},
    {628,1220,1364,1716,1972}, {629,1221,1365,1717,1973}, {630,1222,1366,1718,1974}, {631,1223,1367,1719,1975},
    {632,1224,1368,1720,1976}, {633,1225,1369,1721,1977}, {634,1226,1370,1722,1978}, {635,1227,1371,1723,1979},
    {636,1228,1372,1724,1980}, {637,1229,1373,1725,1981}, {638,1230,1374,1726,1982}, {639,1231,1375,1727,1983},
    {64,1024,1248,1728,1984}, {65,1025,1249,1729,1985}, {66,1026,1250,1730,1986}, {67,1027,1251,1731,1987},
    {68,1028,1252,1732,1988}, {69,1029,1253,1733,1989}, {70,1030,1254,1734,1990}, {71,1031,1255,1735,1991},
    {72,1032,1256,1736,1992}, {73,1033,1257,1737,1993}, {74,1034,1258,1738,1994}, {75,1035,1259,1739,1995},
    {76,1036,1260,1740,1996}, {77,1037,1261,1741,1997}, {78,1038,1262,1742,1998}, {79,1039,1263,1743,1999},
    {640,1040,1264,1744,2000}, {641,1041,1265,1745,2001}, {642,1042,1266,1746,2002}, {643,1043,1267,1747,2003},
    {644,1044,1268,1748,2004}, {645,1045,1269,1749,2005}, {646,1046,1270,1750,2006}, {647,1047,1271,1751,2007},
    {648,1048,1272,1752,2008}, {649,1049,1273,1753,2009}, {650,1050,1274,1754,2010}, {651,1051,1275,1755,2011},
    {652,1052,1276,1756,2012}, {653,1053,1277,1757,2013}, {654,1054,1278,1758,2014}, {655,1055,1279,1759,2015},
    {656,1056,1280,1760,2016}, {657,1057,1281,1761,2017}, {658,1058,1282,1762,2018}, {659,1059,1283,1763,2019},
    {660,1060,1284,1764,2020}, {661,1061,1285,1765,2021}, {662,1062,1286,1766,2022}, {663,1063,1287,1767,2023},
    {664,1064,1288,1768,2024}, {665,1065,1289,1769,2025}, {666,1066,1290,1770,2026}, {667,1067,1291,1771,2027},
    {668,1068,1292,1772,2028}, {669,1069,1293,1773,2029}, {670,1070,1294,1774,2030}, {671,1071,1295,1775,2031},
    {672,1072,80,1536,1792}, {673,1073,81,1537,1793}, {674,1074,82,1538,1794}, {675,1075,83,1539,1795},
    {676,1076,84,1540,1796}, {677,1077,85,1541,1797}, {678,1078,86,1542,1798}, {679,1079,87,1543,1799},
    {680,1080,88,1544,1800}, {681,1081,89,1545,1801}, {682,1082,90,1546,1802}, {683,1083,91,1547,1803},
    {684,1084,92,1548,1804}, {685,1085,93,1549,1805}, {686,1086,94,1550,1806}, {687,1087,95,1551,1807},
};
constexpr int SEL_TAB_W = 5;
__device__ __forceinline__ void moba_sel_phase(const Frame& F, const bf16_t* PROJ, const unsigned* SEL, bf16_t* PO, f32x2* PML) {
    if (F.G == 256) {
#pragma unroll 1
        for (int i = 0; i < SEL_TAB_W; ++i) { const int code = SEL_TAB[F.vcu][i]; if (code == 0xFFFF) break;
            const int p = code >> 9, j = (code >> 4) & 31, bh = code & 15, slo = (j + 1 > 8 * p) ? j + 1 : 8 * p, shi = 8 * p + 8;
            moba_sel_unit(F.lds, bh >> 3, bh & 7, j, slo, shi, PROJ + C_QA, PROJ + C_KA, PROJ + C_VA, INCP, SEL, PO, PML); }
    } else {
#pragma unroll 1
        for (int u = (int)blockIdx.x; u < 16 * 76; u += F.G) {
            int p = 0; while (16 * (4 * (p + 1) * (p + 1) + 3 * (p + 1)) <= u) ++p;
            const int r = u - 16 * (4 * p * p + 3 * p), j = r >> 4, bh = r & 15, slo = (j + 1 > 8 * p) ? j + 1 : 8 * p, shi = 8 * p + 8;
            moba_sel_unit(F.lds, bh >> 3, bh & 7, j, slo, shi, PROJ + C_QA, PROJ + C_KA, PROJ + C_VA, INCP, SEL, PO, PML); }
    }
}
__device__ __forceinline__ void moba_own_phase(const Frame& F, const bf16_t* PROJ, bf16_t* Op, const bf16_t* PO, const f32x2* PML) {
#pragma unroll 1
    for (int u = F.vcu; u < 512; u += F.G) { const int bh = u >> 5, qb = u & 31;
        attn_unit<64, true>(F.lds, bh >> 3, bh & 7, qb, PROJ + C_QA, INCP, PROJ + C_KA, INCP, PROJ + C_VA, INCP, Op, 1024, PO, PML); }
}

constexpr int NPH_L = 16;
__global__ void __launch_bounds__(NTHR, 2) mk(Params p) {
    extern __shared__ __attribute__((aligned(16))) unsigned char lds_raw[];
    Frame F;
    F.lds = (LAS unsigned char*)lds_raw;
    F.tid = threadIdx.x; F.lane = F.tid & 63; F.wave = __builtin_amdgcn_readfirstlane(F.tid >> 6);
    F.G = gridDim.x; { const int bx = blockIdx.x; F.vcu = (F.G % 8 == 0) ? (bx % 8) * (F.G / 8) + bx / 8 : bx; }
    volatile LAS unsigned* MISC = (volatile LAS unsigned*)(F.lds + MISC_OFF);
    if (F.tid < 32) MISC[F.tid] = 0u;
    __syncthreads();
    unsigned char* ws = p.ws;
    unsigned* ctl = (unsigned*)(ws + WS_CTL);
    XcdBarrier bar = xcd_barrier_post(ctl + CW_BAR, MISC + 8);
    const int lo = p.ph_lo, hi = p.ph_hi;
#define IN(k) (lo <= (k) && (k) < hi)
#define SEAM(k) do { if (IN(k) && IN((k) + 1)) xcd_barrier(bar); } while (0)
    bf16_t* WinT = (bf16_t*)(ws + WS_WIN);
    bf16_t* XB = (bf16_t*)(ws + WS_XB);
    bf16_t* PROJ = (bf16_t*)(ws + WS_PROJ);
    bf16_t* WuqT = (bf16_t*)(ws + WS_WUQ); bf16_t* WukvT = (bf16_t*)(ws + WS_WUKV);
    f32x2* CS = (f32x2*)(ws + WS_CS); float* KM = (float*)(ws + WS_KM); unsigned* SEL = (unsigned*)(ws + WS_SEL);
    bf16_t* CQN = (bf16_t*)(ws + WS_CQN); bf16_t* CKVN = (bf16_t*)(ws + WS_CKVN);
    bf16_t* WpaT = (bf16_t*)(ws + WS_WPA); bf16_t* WpbT = (bf16_t*)(ws + WS_WPB); bf16_t* WoutT = (bf16_t*)(ws + WS_WOUT);
    bf16_t* TMP = (bf16_t*)(ws + WS_TMP); bf16_t* MRG = (bf16_t*)(ws + WS_MRG); bf16_t* PRE = (bf16_t*)(ws + WS_PRE); bf16_t* X1B = (bf16_t*)(ws + WS_X1B);
    bf16_t* WrtT = (bf16_t*)(ws + WS_WRT); bf16_t* WsguT = (bf16_t*)(ws + WS_WSGU); bf16_t* WsdT = (bf16_t*)(ws + WS_WSD); bf16_t* WeguT = (bf16_t*)(ws + WS_WEGU); bf16_t* WedT = (bf16_t*)(ws + WS_WED);
    float* LOGITS = (float*)(ws + WS_LOG); bf16_t* HS = (bf16_t*)(ws + WS_HS); bf16_t* SH = (bf16_t*)(ws + WS_SH);
    int* TOPE = (int*)(ws + WS_TOPE); float* TOPW = (float*)(ws + WS_TOPW); int* APOS = (int*)(ws + WS_APOS); int* ROWA = (int*)(ws + WS_ROWA);
    bf16_t* PO = (bf16_t*)(ws + WS_PO); f32x2* PML = (f32x2*)(ws + WS_PML);
    bf16_t* HE = (bf16_t*)(ws + WS_HE); bf16_t* Yb = (bf16_t*)(ws + WS_Y); int* HIST = (int*)(ws + WS_HIST);
    LAS int* t_off = (LAS int*)(F.lds + TAB_OFF); LAS int* t_toff = t_off + 260;
    bf16_t* QB = (bf16_t*)(ws + WS_QB); bf16_t* KB = (bf16_t*)(ws + WS_KB); bf16_t* VB = (bf16_t*)(ws + WS_VB); bf16_t* OAB = (bf16_t*)(ws + WS_OAB);
    const int gw = F.vcu * NWAVES + F.wave, NGW = F.G * NWAVES;

    if (IN(0)) {
        LAS float* scr = (LAS float*)(F.lds + F.wave * 16384);
        constexpr int I_IN = (DM / 64) * (INC / 32);
        for (int it = gw; it < DEPTH * I_IN; it += NGW) { const int l = it / I_IN, r = it % I_IN;
            transpose_item(p.in[1] + (size_t)l * DM * INC, DM, INC, WinT + (size_t)l * SZ_WIN, DM, RowId{}, scr, r, F.lane); }
        { constexpr int I_UQ = (QL / 64) * (768 / 32), I_UKV = (KVL / 64) * (1024 / 32);
          for (int it = gw; it < DEPTH * (I_UQ + I_UKV); it += NGW) { const int l = it / (I_UQ + I_UKV), r = it % (I_UQ + I_UKV);
            if (r < I_UQ) transpose_item(p.in[4] + (size_t)l * QL * 768, QL, 768, WuqT + (size_t)l * SZ_WUQ, QL, RowQ{}, scr, r, F.lane);
            else transpose_item(p.in[6] + (size_t)l * KVL * 1024, KVL, 1024, WukvT + (size_t)l * SZ_WUKV, KVL, RowId{}, scr, r - I_UQ, F.lane); } }
        { constexpr int I_P = (512 / 64) * (DM / 32), I_O = (DM / 64) * (DM / 32), I_ALL = 2 * I_P + I_O;
          for (int it = gw; it < DEPTH * I_ALL; it += NGW) { const int l = it / I_ALL; int r = it % I_ALL;
            if (r < I_P) { transpose_item(p.in[7] + (size_t)l * 512 * DM, 512, DM, WpaT + (size_t)l * 2 * SZ_WP, 1024, RowId{}, scr, r, F.lane); continue; } r -= I_P;
            if (r < I_P) { transpose_item(p.in[8] + (size_t)l * 512 * DM, 512, DM, WpaT + (size_t)l * 2 * SZ_WP + 512, 1024, RowId{}, scr, r, F.lane); continue; } r -= I_P;
            transpose_item(p.in[9] + (size_t)l * DM * DM, DM, DM, WoutT + (size_t)l * SZ_WOUT, DM, RowId{}, scr, r, F.lane); } }
        { constexpr int I_R = (DM / 64) * (NE / 32), I_G = (DM / 64) * (DSH / 32), I_D = (DSH / 64) * (DM / 32), I_ALL = I_R + 2 * I_G + I_D;
          for (int it = gw; it < DEPTH * I_ALL; it += NGW) { const int l = it / I_ALL; int r = it % I_ALL;
            if (r < I_R) { transpose_item(p.in[12] + (size_t)l * DM * NE, DM, NE, WrtT + (size_t)l * SZ_WRT, DM, RowId{}, scr, r, F.lane); continue; } r -= I_R;
            if (r < I_G) { transpose_item(p.in[17] + (size_t)l * DM * DSH, DM, DSH, WsguT + (size_t)l * SZ_WSGU, DM, RowGU{0}, scr, r, F.lane); continue; } r -= I_G;
            if (r < I_G) { transpose_item(p.in[18] + (size_t)l * DM * DSH, DM, DSH, WsguT + (size_t)l * SZ_WSGU, DM, RowGU{128}, scr, r, F.lane); continue; } r -= I_G;
            transpose_item(p.in[19] + (size_t)l * DSH * DM, DSH, DM, WsdT + (size_t)l * SZ_WSD, DSH, RowId{}, scr, r, F.lane); } }
        { constexpr int I_G = (DM / 64) * (DE / 64), I_D = (DE / 64) * (DM / 64), I_E = 2 * I_G + I_D;
          LAS unsigned short* scr16 = (LAS unsigned short*)(F.lds + F.wave * 16384);
          for (int it = gw; it < DEPTH * NE * I_E; it += NGW) { const int le = it / I_E; int r = it % I_E;
            if (r < I_G) { transpose_item64(p.in[14] + (size_t)le * DM * DE, DM, DE, WeguT + (size_t)le * 512 * DM, DM, RowGU{0}, scr16, r, F.lane); continue; } r -= I_G;
            if (r < I_G) { transpose_item64(p.in[15] + (size_t)le * DM * DE, DM, DE, WeguT + (size_t)le * 512 * DM, DM, RowGU{128}, scr16, r, F.lane); continue; } r -= I_G;
            transpose_item64(p.in[16] + (size_t)le * DE * DM, DE, DM, WedT + (size_t)le * DM * DE, DE, RowPermD{}, scr16, r, F.lane); } }
        for (int i = blockIdx.x * NTHR + F.tid; i < SEQ * 16; i += F.G * NTHR) { const int pos = i >> 4, k = i & 15;
            const float inv = powf(10000.f, -(float)(2 * k) / 32.f), ang = (float)pos * inv; CS[i] = (f32x2){cosf(ang), sinf(ang)}; }
        for (int i = blockIdx.x * NTHR + F.tid; i < DEPTH * 12288; i += F.G * NTHR) { const int l = i / 12288, r = i % 12288;
            *(u32x4*)(WinT + (size_t)l * SZ_WIN + (size_t)INC * DM + (size_t)r * 8) = (u32x4){0u, 0u, 0u, 0u}; }
        for (int i = blockIdx.x * NTHR + F.tid; i < T * DM / 8; i += F.G * NTHR) { const f32x4 a = *(const f32x4*)(p.in[0] + (size_t)i * 8), b = *(const f32x4*)(p.in[0] + (size_t)i * 8 + 4);
            u32x4 w; w.x = pk2(a[0], a[1]); w.y = pk2(a[2], a[3]); w.z = pk2(b[0], b[1]); w.w = pk2(b[2], b[3]); *(u32x4*)(XB + (size_t)i * 8) = w; }
    }
    SEAM(0);

    {
        const int l = 0; const int pb = 1 + l * NPH_L;
        if (IN(pb + 0)) {
            pg8::Gemm g{XB, WinT + (size_t)l * SZ_WIN, T, INCP, DM, DM, DM}; pg8::StaticOrder S; S.init(T, INCP - 256, F.G, (int)blockIdx.x);
            EpiProj E{PROJ, p.in[2] + (size_t)l * 2 * DM};
            pg8::gemm_phase<EpiProj, pg8::StaticOrder, true>(F.lds, g, S, E);
        }
        SEAM(pb + 0);
        if (IN(pb + 1)) prep_phase(F, PROJ, p.in[3] + (size_t)l * QL, p.in[5] + (size_t)l * KVL, CS, CQN, CKVN, KB, KM);
        SEAM(pb + 1);
        if (IN(pb + 2)) {
            mobasel_phase(F, PROJ, KM, SEL);
            { pg8::Gemm g{CKVN, WukvT + (size_t)l * SZ_WUKV, T, 1024, KVL, KVL, KVL}; pg8::StaticOrder S; S.init(T, 1024, F.G, (int)blockIdx.x);
              EpiKV E{KB, VB}; pg8::gemm_phase<EpiKV, pg8::StaticOrder, true>(F.lds, g, S, E); }
            { pg8::Gemm g{CQN, WuqT + (size_t)l * SZ_WUQ, T, 768, QL, QL, QL}; pg8::StaticOrder S; S.init(T, 768, F.G, (int)blockIdx.x);
              EpiQ E{QB, CS}; pg8::gemm_phase<EpiQ, pg8::StaticOrder, true>(F.lds, g, S, E); }
            { pg8::Gemm g{XB, WinT + (size_t)l * SZ_WIN, T, INCP, DM, DM, DM}; pg8::OffsetOrder S; S.init(T, 256, F.G, (int)((blockIdx.x + 64) % F.G)); S.pn0 = 16;
              EpiProj E{PROJ, p.in[2] + (size_t)l * 2 * DM}; pg8::gemm_phase<EpiProj, pg8::OffsetOrder, true>(F.lds, g, S, E); }
        }
        SEAM(pb + 2);
        if (IN(pb + 3)) {
            mla_phase(F, QB, KB, VB, OAB + 512);
            moba_sel_phase(F, PROJ, SEL, PO, PML);
        }
        SEAM(pb + 3);
        if (IN(pb + 4)) moba_own_phase(F, PROJ, OAB, PO, PML);
        SEAM(pb + 4);
        if (IN(pb + 5)) {
            pg8::Gemm g{OAB, WpaT + (size_t)l * 2 * SZ_WP, T, DM, DM, 1024, 1024}; pg8::StaticOrder S; S.init(T, DM, F.G, (int)blockIdx.x);
            EpiGate2 E{PROJ, MRG}; pg8::gemm_phase<EpiGate2, pg8::StaticOrder, true>(F.lds, g, S, E);
        }
        SEAM(pb + 5);
        if (IN(pb + 6)) {
            pg8::Gemm g{MRG, WoutT + (size_t)l * SZ_WOUT, T, DM, DM, DM, DM}; pg8::StaticOrder S; S.init(T, DM, F.G, (int)blockIdx.x);
            EpiResid E{XB, PRE}; pg8::gemm_phase<EpiResid, pg8::StaticOrder, true>(F.lds, g, S, E);
        }
        SEAM(pb + 6);
        if (IN(pb + 7)) ln_phase(F, PRE, p.in[10] + (size_t)l * DM, p.in[11] + (size_t)l * DM, X1B);
        SEAM(pb + 7);
        if (IN(pb + 8)) {
            { pg8::Gemm g{X1B, WrtT + (size_t)l * SZ_WRT, T, NE, DM, DM, DM}; pg8::StaticOrder S; S.init(T, NE, F.G, (int)blockIdx.x);
              EpiF32 E{LOGITS, NE}; pg8::gemm_phase<EpiF32, pg8::StaticOrder, true>(F.lds, g, S, E); }
            { pg8::Gemm g{X1B, WsguT + (size_t)l * SZ_WSGU, T, 512, DM, DM, DM}; pg8::StaticOrder S; S.init(T, 512, F.G, (int)((blockIdx.x + F.G / 2) % F.G));
              EpiSwiGLU E{HS, DSH}; pg8::gemm_phase<EpiSwiGLU, pg8::StaticOrder, true>(F.lds, g, S, E); }
        }
        SEAM(pb + 8);
        if (IN(pb + 9)) {
            route_phase(F, LOGITS, p.in[13] + (size_t)l * NE, TOPE, TOPW, APOS, HIST, t_off);
            pg8::Gemm g{HS, WsdT + (size_t)l * SZ_WSD, T, DM, DSH, DSH, DSH}; pg8::StaticOrder S; S.init(T, DM, F.G, (int)blockIdx.x);
            EpiBf16 E{SH, DM}; pg8::gemm_phase<EpiBf16, pg8::StaticOrder, true>(F.lds, g, S, E);
        }
        SEAM(pb + 9);
        if (IN(pb + 10)) {
            int tid_ = F.tid; asm volatile("" : "+v"(tid_));
            if (tid_ < 256) { int tot = 0, base = 0; for (int c = 0; c < F.G; ++c) { const int v = HIST[(size_t)c * 256 + tid_]; base += (c < (int)blockIdx.x) ? v : 0; tot += v; }
                t_off[tid_] = tot; t_toff[tid_] = base; if (blockIdx.x == 0) ctl[CW_CNT + l * 256 + tid_] = (unsigned)tot; }
            __syncthreads();
            if (tid_ == 0) { int a = 0; for (int i = 0; i < 256; ++i) { const int c = t_off[i]; t_off[i] = a; a += c; } }
            __syncthreads();
            const int TPW = T / F.G, a0 = (int)blockIdx.x * TPW * TOPK;
            for (int a = a0 + tid_; a < a0 + TPW * TOPK; a += NTHR) { const int e = TOPE[a]; const int row = t_off[e] + t_toff[e] + APOS[a]; *(u32x2*)(ROWA + 2 * (size_t)row) = (u32x2){(unsigned)a, 0u}; APOS[a] = row; }
            __syncthreads();
        }
        SEAM(pb + 10);
        if (IN(pb + 11)) {
            expert_tables(F, ctl + CW_CNT + l * 256, t_off, t_toff);
            pg8::Gemm g{X1B, WeguT + (size_t)l * SZ_WEGU, T, 512, DM, DM, DM};
            ExpertOrder<2, true> S{t_off, t_toff, ROWA, F.G, F.vcu, (size_t)512 * DM * 2};
            EpiSwiGLU E{HE, DE}; pg8::gemm_phase<EpiSwiGLU, ExpertOrder<2, true>, true>(F.lds, g, S, E);
        }
        SEAM(pb + 11);
        if (IN(pb + 12)) {
            expert_tables(F, ctl + CW_CNT + l * 256, t_off, t_toff);
            pg8::Gemm g{HE, WedT + (size_t)l * SZ_WED, NA, DM, DE, DE, DE};
            ExpertOrder<4, false> S{t_off, t_toff, ROWA, F.G, F.vcu, (size_t)DM * DE * 2};
            EpiExpDown E{(unsigned char*)Yb}; pg8::gemm_phase<EpiExpDown, ExpertOrder<4, false>, true>(F.lds, g, S, E);
        }
        SEAM(pb + 12);
        if (IN(pb + 13)) combine_phase(F, X1B, SH, (const unsigned char*)Yb, APOS, TOPW, p.in[20] + (size_t)l * DM, p.in[21] + (size_t)l * DM, l == DEPTH - 1 ? p.out : (float*)nullptr, l == DEPTH - 1 ? (bf16_t*)nullptr : XB);
        SEAM(pb + 13);
    }

    {
        const int l = 1; const int pb = 1 + l * NPH_L;
        if (IN(pb + 0)) {
            pg8::Gemm g{XB, WinT + (size_t)l * SZ_WIN, T, INCP, DM, DM, DM}; pg8::StaticOrder S; S.init(T, INCP - 256, F.G, (int)blockIdx.x);
            EpiProj E{PROJ, p.in[2] + (size_t)l * 2 * DM};
            pg8::gemm_phase<EpiProj, pg8::StaticOrder, true>(F.lds, g, S, E);
        }
        SEAM(pb + 0);
        if (IN(pb + 1)) prep_phase(F, PROJ, p.in[3] + (size_t)l * QL, p.in[5] + (size_t)l * KVL, CS, CQN, CKVN, KB, KM);
        SEAM(pb + 1);
        if (IN(pb + 2)) {
            mobasel_phase(F, PROJ, KM, SEL);
            { pg8::Gemm g{CKVN, WukvT + (size_t)l * SZ_WUKV, T, 1024, KVL, KVL, KVL}; pg8::StaticOrder S; S.init(T, 1024, F.G, (int)blockIdx.x);
              EpiKV E{KB, VB}; pg8::gemm_phase<EpiKV, pg8::StaticOrder, true>(F.lds, g, S, E); }
            { pg8::Gemm g{CQN, WuqT + (size_t)l * SZ_WUQ, T, 768, QL, QL, QL}; pg8::StaticOrder S; S.init(T, 768, F.G, (int)blockIdx.x);
              EpiQ E{QB, CS}; pg8::gemm_phase<EpiQ, pg8::StaticOrder, true>(F.lds, g, S, E); }
            { pg8::Gemm g{XB, WinT + (size_t)l * SZ_WIN, T, INCP, DM, DM, DM}; pg8::OffsetOrder S; S.init(T, 256, F.G, (int)((blockIdx.x + 64) % F.G)); S.pn0 = 16;
              EpiProj E{PROJ, p.in[2] + (size_t)l * 2 * DM}; pg8::gemm_phase<EpiProj, pg8::OffsetOrder, true>(F.lds, g, S, E); }
        }
        SEAM(pb + 2);
        if (IN(pb + 3)) {
            mla_phase(F, QB, KB, VB, OAB + 512);
            moba_sel_phase(F, PROJ, SEL, PO, PML);
        }
        SEAM(pb + 3);
        if (IN(pb + 4)) moba_own_phase(F, PROJ, OAB, PO, PML);
        SEAM(pb + 4);
        if (IN(pb + 5)) {
            pg8::Gemm g{OAB, WpaT + (size_t)l * 2 * SZ_WP, T, DM, DM, 1024, 1024}; pg8::StaticOrder S; S.init(T, DM, F.G, (int)blockIdx.x);
            EpiGate2 E{PROJ, MRG}; pg8::gemm_phase<EpiGate2, pg8::StaticOrder, true>(F.lds, g, S, E);
        }
        SEAM(pb + 5);
        if (IN(pb + 6)) {
            pg8::Gemm g{MRG, WoutT + (size_t)l * SZ_WOUT, T, DM, DM, DM, DM}; pg8::StaticOrder S; S.init(T, DM, F.G, (int)blockIdx.x);
            EpiResid E{XB, PRE}; pg8::gemm_phase<EpiResid, pg8::StaticOrder, true>(F.lds, g, S, E);
        }
        SEAM(pb + 6);
        if (IN(pb + 7)) ln_phase(F, PRE, p.in[10] + (size_t)l * DM, p.in[11] + (size_t)l * DM, X1B);
        SEAM(pb + 7);
        if (IN(pb + 8)) {
            { pg8::Gemm g{X1B, WrtT + (size_t)l * SZ_WRT, T, NE, DM, DM, DM}; pg8::StaticOrder S; S.init(T, NE, F.G, (int)blockIdx.x);
              EpiF32 E{LOGITS, NE}; pg8::gemm_phase<EpiF32, pg8::StaticOrder, true>(F.lds, g, S, E); }
            { pg8::Gemm g{X1B, WsguT + (size_t)l * SZ_WSGU, T, 512, DM, DM, DM}; pg8::StaticOrder S; S.init(T, 512, F.G, (int)((blockIdx.x + F.G / 2) % F.G));
              EpiSwiGLU E{HS, DSH}; pg8::gemm_phase<EpiSwiGLU, pg8::StaticOrder, true>(F.lds, g, S, E); }
        }
        SEAM(pb + 8);
        if (IN(pb + 9)) {
            route_phase(F, LOGITS, p.in[13] + (size_t)l * NE, TOPE, TOPW, APOS, HIST, t_off);
            pg8::Gemm g{HS, WsdT + (size_t)l * SZ_WSD, T, DM, DSH, DSH, DSH}; pg8::StaticOrder S; S.init(T, DM, F.G, (int)blockIdx.x);
            EpiBf16 E{SH, DM}; pg8::gemm_phase<EpiBf16, pg8::StaticOrder, true>(F.lds, g, S, E);
        }
        SEAM(pb + 9);
        if (IN(pb + 10)) {
            int tid_ = F.tid; asm volatile("" : "+v"(tid_));
            if (tid_ < 256) { int tot = 0, base = 0; for (int c = 0; c < F.G; ++c) { const int v = HIST[(size_t)c * 256 + tid_]; base += (c < (int)blockIdx.x) ? v : 0; tot += v; }
                t_off[tid_] = tot; t_toff[tid_] = base; if (blockIdx.x == 0) ctl[CW_CNT + l * 256 + tid_] = (unsigned)tot; }
            __syncthreads();
            if (tid_ == 0) { int a = 0; for (int i = 0; i < 256; ++i) { const int c = t_off[i]; t_off[i] = a; a += c; } }
            __syncthreads();
            const int TPW = T / F.G, a0 = (int)blockIdx.x * TPW * TOPK;
            for (int a = a0 + tid_; a < a0 + TPW * TOPK; a += NTHR) { const int e = TOPE[a]; const int row = t_off[e] + t_toff[e] + APOS[a]; *(u32x2*)(ROWA + 2 * (size_t)row) = (u32x2){(unsigned)a, 0u}; APOS[a] = row; }
            __syncthreads();
        }
        SEAM(pb + 10);
        if (IN(pb + 11)) {
            expert_tables(F, ctl + CW_CNT + l * 256, t_off, t_toff);
            pg8::Gemm g{X1B, WeguT + (size_t)l * SZ_WEGU, T, 512, DM, DM, DM};
            ExpertOrder<2, true> S{t_off, t_toff, ROWA, F.G, F.vcu, (size_t)512 * DM * 2};
            EpiSwiGLU E{HE, DE}; pg8::gemm_phase<EpiSwiGLU, ExpertOrder<2, true>, true>(F.lds, g, S, E);
        }
        SEAM(pb + 11);
        if (IN(pb + 12)) {
            expert_tables(F, ctl + CW_CNT + l * 256, t_off, t_toff);
            pg8::Gemm g{HE, WedT + (size_t)l * SZ_WED, NA, DM, DE, DE, DE};
            ExpertOrder<4, false> S{t_off, t_toff, ROWA, F.G, F.vcu, (size_t)DM * DE * 2};
            EpiExpDown E{(unsigned char*)Yb}; pg8::gemm_phase<EpiExpDown, ExpertOrder<4, false>, true>(F.lds, g, S, E);
        }
        SEAM(pb + 12);
        if (IN(pb + 13)) combine_phase(F, X1B, SH, (const unsigned char*)Yb, APOS, TOPW, p.in[20] + (size_t)l * DM, p.in[21] + (size_t)l * DM, l == DEPTH - 1 ? p.out : (float*)nullptr, l == DEPTH - 1 ? (bf16_t*)nullptr : XB);
        SEAM(pb + 13);
    }

#undef IN
#undef SEAM
}

__global__ void __launch_bounds__(256) cvt_proj(const bf16_t* __restrict__ P, float* proj) {
    const size_t i = (size_t)blockIdx.x * 256 + threadIdx.x;
    const int row = (int)(i / INC), c = (int)(i % INC);
    float v = bf2f(P[(size_t)row * INCP + c]);
    if (c < C_KA) v *= (1.f / QS_A);
    proj[i] = v;
}
__global__ void __launch_bounds__(256) cvt_oab(const bf16_t* __restrict__ OAB, float* oa, float* ob) {
    const size_t i = (size_t)blockIdx.x * 256 + threadIdx.x; const size_t row = i >> 10; const int c = (int)(i & 1023);
    const float v = bf2f(OAB[i]);
    if (c < 512) oa[row * 512 + c] = v; else ob[row * 512 + c - 512] = v;
}
__global__ void __launch_bounds__(256) cvt_x(const float* __restrict__ x, bf16_t* XB) {
    const size_t i = (size_t)blockIdx.x * 256 + threadIdx.x;
    const f32x4 a = *(const f32x4*)(x + i * 8), b = *(const f32x4*)(x + i * 8 + 4);
    u32x4 w; w.x = pk2(a[0], a[1]); w.y = pk2(a[2], a[3]); w.z = pk2(b[0], b[1]); w.w = pk2(b[2], b[3]); *(u32x4*)(XB + i * 8) = w;
}
}
static int g_grid = 0;
static bool fast_setup() {
    if (g_grid) return g_grid > 0;
    int dev = 0, cus = 0, per_cu = 0;
    if (hipGetDevice(&dev) != hipSuccess || hipDeviceGetAttribute(&cus, hipDeviceAttributeMultiprocessorCount, dev) != hipSuccess) { g_grid = -1; return false; }
    if (hipFuncSetAttribute((const void*)fk::mk, hipFuncAttributeMaxDynamicSharedMemorySize, fk::LDS_BYTES) != hipSuccess) { fprintf(stderr, "hipFuncSetAttribute failed\n"); g_grid = -1; return false; }
    if (hipOccupancyMaxActiveBlocksPerMultiprocessor(&per_cu, (const void*)fk::mk, fk::NTHR, fk::LDS_BYTES) != hipSuccess || per_cu < 1) { fprintf(stderr, "occupancy query: %d\n", per_cu); }
    (void)hipGetLastError();
    g_grid = cus;
    if (cus > 1024 || T % cus != 0 || (T / cus) > 64) { fprintf(stderr, "unsupported CU count %d\n", cus); g_grid = -1; return false; }
    return true;
}
static void launch_mk(fk::Params& p, int lo, int hi, hipStream_t stream) {
    p.ph_lo = lo; p.ph_hi = hi;
    hipLaunchKernelGGL(fk::mk, dim3(g_grid), dim3(fk::NTHR), fk::LDS_BYTES, stream, p);
}

extern "C" void kernel_launch(void* const* d_in, const int* in_sizes, int n_in, void* d_out, int out_size, void* d_ws, size_t ws_size, hipStream_t stream) {
    if (!fast_setup()) return;
    if (ws_size < fk::WS_NEED) { fprintf(stderr, "workspace too small: need %zu have %zu\n", (size_t)fk::WS_NEED, ws_size); return; }
    (void)hipMemsetAsync((char*)d_ws + fk::WS_CTL, 0, fk::CTL_BYTES, stream);
    fk::Params P{};
    for (int i = 0; i < 22; ++i) P.in[i] = (const float*)d_in[i];
    P.out = (float*)d_out; P.ws = (unsigned char*)d_ws;
#if MK_ONE_LAUNCH
    launch_mk(P, 0, 1 + DEPTH * fk::NPH_L, stream);
#else
    launch_mk(P, 0, 1, stream);
    for (int l = 0; l < DEPTH; ++l) for (int k = 0; k < 14; ++k) launch_mk(P, 1 + l * fk::NPH_L + k, 2 + l * fk::NPH_L + k, stream);
#endif
}
```

```cpp
#ifndef MK_ONE_LAUNCH
#define MK_ONE_LAUNCH 1
#endif
#include <hip/hip_runtime.h>
#include <cstdint>
#include <cstdio>

constexpr int NB = 2, SEQ = 8192, T = NB * SEQ, DM = 1024, DEPTH = 2;
constexpr int HA = 8, WA = 512, BLK = 256, NBLK = SEQ / BLK;
constexpr int HB = 8, DN = 64, DR = 32, DV = 64, QL = 384, KVL = 256;
constexpr int INC = 3 * WA + QL + KVL + DR + 2 * DM;
constexpr int C_QA = 0, C_KA = 512, C_VA = 1024, C_CQ = 1536, C_CKV = 1920, C_KR = 2176, C_GA = 2208, C_GB = 3232;
constexpr int NE = 256, TOPK = 8, DE = 256, DSH = 256;
constexpr int NA = T * TOPK;
constexpr float ALPHA = 1.4142135623730951f;
constexpr float LN_EPS = 1e-5f, RMS_EPS = 1e-6f;


namespace fk {
#define LAS __attribute__((address_space(3)))
#define GAS __attribute__((address_space(1)))
typedef unsigned short bf16_t;
typedef short bf16x8 __attribute__((ext_vector_type(8)));
typedef float f32x4 __attribute__((ext_vector_type(4)));
typedef float f32x2 __attribute__((ext_vector_type(2)));
typedef float f32x16 __attribute__((ext_vector_type(16)));
typedef unsigned u32x4 __attribute__((ext_vector_type(4)));
typedef unsigned u32x2 __attribute__((ext_vector_type(2)));
constexpr int NWAVES = 8, NTHR = 512;
constexpr int INCP = 4352;
constexpr float LOG2E = 1.4426950408889634f;
constexpr float QS_A = 0.125f * LOG2E;
constexpr float QS_B = 0.10206207261596577f * LOG2E;
#define LDS_WAIT() asm volatile("s_waitcnt lgkmcnt(0)" ::: "memory")
#define VM_WAIT() asm volatile("s_waitcnt vmcnt(0)" ::: "memory")
__device__ __forceinline__ unsigned f2bf(float f) { unsigned u = __builtin_bit_cast(unsigned, f); return (u + 0x7fffu + ((u >> 16) & 1u)) >> 16; }
__device__ __forceinline__ unsigned pk2(float lo, float hi) { return f2bf(lo) | (f2bf(hi) << 16); }
__device__ __forceinline__ float bf2f(unsigned short b) { return __builtin_bit_cast(float, (unsigned)b << 16); }
__device__ __forceinline__ float bflo(unsigned w) { return __builtin_bit_cast(float, w << 16); }
__device__ __forceinline__ float bfhi(unsigned w) { return __builtin_bit_cast(float, w & 0xffff0000u); }
__device__ __forceinline__ float sigmoidf_(float x) { return __builtin_amdgcn_rcpf(1.f + __expf(-x)); }
__device__ __forceinline__ float wave_sum(float v) {
#pragma unroll
    for (int o = 1; o < 64; o <<= 1) v += __shfl_xor(v, o);
    return v;
}

namespace pg8 {
constexpr int BM = 256, BK = 64, HALF = 128, HTB = HALF * BK * 2, STAGE_BYTES = 8 * HTB, NXCD = 8, WGM = 8;
__host__ __device__ __forceinline__ int lds_byte(int r, int c) { const int st = (r >> 4) * 2 + (c >> 5), rr = r & 15, cc = c & 31, ob = rr * 64 + cc * 2; return st * 1024 + (ob ^ (((ob >> 9) & 1) << 5)); }
__host__ __device__ __forceinline__ void stage_rc(int b, int& R, int& C) { const int st = b / 1024, sb = b % 1024, swz = sb ^ (((sb >> 9) & 1) << 5); R = (st >> 1) * 16 + swz / 64; C = (st & 1) * 32 + (swz % 64) / 2; }
__host__ __device__ __forceinline__ int perm32(int rho) { const int n = rho >> 4, i = rho & 15; return 8 * (i >> 2) + 4 * n + (i & 3); }

struct Unit { int pm, pn, e, r0, rend; };
struct Gemm { const bf16_t* A; const bf16_t* Bt; int M, N, K, lda, ldb; };

struct StaticOrder {
    int nM, nN, nwg, G, c;
    __device__ void init(int M, int N, int G_, int c_) { nM = M / BM; nN = N / BM; nwg = nM * nN; G = G_; c = c_; }
    __device__ bool next(int i, Unit& u) const {
        const long L = (long)i * G + c; if (L >= nwg) return false;
        int wgid = (int)L; { const int q = nwg / NXCD, r = nwg % NXCD, xcd = wgid % NXCD, off = wgid / NXCD; wgid = (xcd < r ? xcd * (q + 1) : r * (q + 1) + (xcd - r) * q) + off; }
        const int nig = WGM * nN, gid = wgid / nig, fm = gid * WGM, gsz = (nM - fm) < WGM ? (nM - fm) : WGM;
        u.pm = fm + ((wgid % nig) % gsz); u.pn = (wgid % nig) / gsz; u.e = 0; u.r0 = u.pm * BM; u.rend = u.r0 + BM; return true;
    }
    __device__ __forceinline__ int a_row(const Unit& u, int r) const { return u.pm * BM + r; }
    __device__ __forceinline__ const char* b_ptr(const Gemm& g, const Unit& u) const { return (const char*)g.Bt + (size_t)u.pn * BM * g.ldb * 2; }
};

struct OffsetOrder : StaticOrder {
    int pn0;
    __device__ bool next(int i, Unit& u) const { const bool ok = StaticOrder::next(i, u); u.pn += pn0; return ok; }
};
typedef float f32x2_t_ __attribute__((ext_vector_type(2))); typedef __bf16 bf16x2_t_ __attribute__((ext_vector_type(2)));
__device__ __forceinline__ unsigned cvt_pk_bf16(float lo, float hi) { const f32x2_t_ v = {lo, hi}; const bf16x2_t_ b = __builtin_convertvector(v, bf16x2_t_); return __builtin_bit_cast(unsigned, b); }

template <class Epi, class Sched, bool ALIGN_EPI>
__device__ __forceinline__ void gemm_phase(LAS unsigned char* lds, const Gemm g, const Sched& S, const Epi& E) {
    int tid_ = threadIdx.x; asm volatile("" : "+v"(tid_));
    const int tid = tid_, wid = __builtin_amdgcn_readfirstlane(tid >> 6), lane = tid & 63, wr = wid >> 2, wc = wid & 3, fr = lane & 15, fq = lane >> 4;
    const int K = g.K, nt = K / BK;
    int RA[2]; unsigned CA[2], voffB[2];
#pragma unroll
    for (int i = 0; i < 2; ++i) { int R, C; stage_rc(tid * 16 + i * 8192, R, C); const int Rb = (R & ~31) + perm32(R & 31);
        RA[i] = R; CA[i] = (unsigned)C * 2u; voffB[i] = (unsigned)(Rb * g.ldb + C) * 2u; }
    const unsigned lda2 = (unsigned)g.lda * 2u;
    const size_t hstepB = (size_t)HALF * g.ldb * 2;
    const unsigned ldsw = (unsigned)wid * 1024u;
    const int aoff = lds_byte(wr * 64 + fr, fq * 8), boff = lds_byte(wc * 32 + fr, fq * 8);
    const char* const Abase = (const char*)g.A;
#define PG8_SA(b, h) (((b) * 2 + (h)) * HTB)
#define PG8_SB(b, h) ((4 + (b) * 2 + (h)) * HTB)
#define PG8_STAGE_B(bufoff, gbase) do { _Pragma("unroll") for (int _i = 0; _i < 2; ++_i) \
        __builtin_amdgcn_global_load_lds((const unsigned*)((const char*)(gbase) + voffB[_i]), (LAS unsigned*)(lds + (bufoff) + ldsw + _i * 8192), 16, 0, 0); } while (0)
#define PG8_STAGE_A(bufoff, V0, V1, kb) do { \
        __builtin_amdgcn_global_load_lds((const unsigned*)((Abase + (kb)) + (V0)), (LAS unsigned*)(lds + (bufoff) + ldsw), 16, 0, 0); \
        __builtin_amdgcn_global_load_lds((const unsigned*)((Abase + (kb)) + (V1)), (LAS unsigned*)(lds + (bufoff) + ldsw + 8192), 16, 0, 0); } while (0)
#define PG8_LDA(dst, b, h) do { _Pragma("unroll") for (int m = 0; m < 4; ++m) _Pragma("unroll") for (int k = 0; k < 2; ++k) dst[m][k] = *(const LAS bf16x8*)(lds + PG8_SA(b, h) + aoff + m * 2048 + k * 1024); } while (0)
#define PG8_LDB(dst, b, h) do { _Pragma("unroll") for (int n = 0; n < 2; ++n) _Pragma("unroll") for (int k = 0; k < 2; ++k) dst[n][k] = *(const LAS bf16x8*)(lds + PG8_SB(b, h) + boff + n * 2048 + k * 1024); } while (0)
#define PG8_MMA(ai, bj, At, Bt) do { __builtin_amdgcn_s_setprio(1); _Pragma("unroll") for (int m = 0; m < 4; ++m) _Pragma("unroll") for (int n = 0; n < 2; ++n) _Pragma("unroll") for (int k = 0; k < 2; ++k) \
        acc[ai][bj][m][n] = __builtin_amdgcn_mfma_f32_16x16x32_bf16(Bt[n][k], At[m][k], acc[ai][bj][m][n], 0, 0, 0); __builtin_amdgcn_s_setprio(0); } while (0)
#define PG8_WAIT_V(n) asm volatile("s_waitcnt vmcnt(" #n ")" ::: "memory")
#define PG8_WAIT_L(n) asm volatile("s_waitcnt lgkmcnt(" #n ")" ::: "memory")
#define PG8_BAR __builtin_amdgcn_s_barrier()
#define PG8_SCHED __builtin_amdgcn_sched_barrier(0)
#define PG8_VOFF(V, U) do { V##00 = (unsigned)S.a_row(U, RA[0]) * lda2 + CA[0]; V##01 = (unsigned)S.a_row(U, RA[1]) * lda2 + CA[1]; \
        V##10 = (unsigned)S.a_row(U, HALF + RA[0]) * lda2 + CA[0]; V##11 = (unsigned)S.a_row(U, HALF + RA[1]) * lda2 + CA[1]; } while (0)
    Unit cur, nxt; int ui = 0;
    if (!S.next(0, cur)) return;
    f32x4 acc[2][2][4][2];
#pragma unroll
    for (int a = 0; a < 2; ++a)
#pragma unroll
        for (int b = 0; b < 2; ++b)
#pragma unroll
            for (int m = 0; m < 4; ++m)
#pragma unroll
                for (int n = 0; n < 2; ++n) acc[a][b][m][n] = (f32x4){0.f, 0.f, 0.f, 0.f};
    bf16x8 At[4][2], B0[2][2], B1[2][2];
    unsigned vc00, vc01, vc10, vc11;
    PG8_VOFF(vc, cur);
    const char* cB = S.b_ptr(g, cur);
    PG8_STAGE_B(PG8_SB(0, 0), cB); PG8_STAGE_B(PG8_SB(0, 1), cB + hstepB); PG8_STAGE_A(PG8_SA(0, 0), vc00, vc01, 0u); PG8_STAGE_A(PG8_SA(0, 1), vc10, vc11, 0u);
    if (wr == 1) PG8_BAR;
    PG8_WAIT_V(2); PG8_BAR;
    PG8_STAGE_B(PG8_SB(1, 0), cB + 128); PG8_STAGE_A(PG8_SA(1, 0), vc00, vc01, 128u); PG8_STAGE_B(PG8_SB(1, 1), cB + hstepB + 128);
    PG8_WAIT_V(6); PG8_BAR;
    for (;;) {
        const bool has_next = S.next(ui + 1, nxt);
        const char* nB = has_next ? S.b_ptr(g, nxt) : cB;
        unsigned vn00 = vc00, vn01 = vc01, vn10 = vc10, vn11 = vc11;
        if (has_next) { PG8_VOFF(vn, nxt); }
        const bool half1 = (cur.rend - cur.r0) > HALF;
#pragma unroll 1
        for (int t = 0; t < nt; t += 2) {
            if constexpr (Epi::MIDK > 0) { if (t == Epi::MIDK) E.mid(acc, cur, wr, wc, fr, fq); }
            const bool last = (t == nt - 2);
            const unsigned kb1 = (unsigned)(t + 1) * 128u;
            unsigned kb2 = (unsigned)(t + 2) * 128u;
            unsigned s00 = vc00, s01 = vc01, s10 = vc10, s11 = vc11;
            const char* b2 = cB + (size_t)kb2;
            if (last) { kb2 = 0u; b2 = nB; s00 = vn00; s01 = vn01; s10 = vn10; s11 = vn11; }
            const unsigned kb3 = kb2 + 128u; const char* b3 = b2 + 128;
            PG8_LDB(B0, 0, 0); PG8_LDB(B1, 0, 1); PG8_SCHED; PG8_LDA(At, 0, 0); PG8_STAGE_A(PG8_SA(1, 1), vc10, vc11, kb1);
            PG8_WAIT_V(8); PG8_WAIT_L(0); PG8_BAR; PG8_MMA(0, 0, At, B0); PG8_MMA(0, 1, At, B1); PG8_BAR; PG8_SCHED;
            PG8_LDA(At, 0, 1); PG8_STAGE_B(PG8_SB(0, 0), b2); PG8_STAGE_B(PG8_SB(0, 1), b2 + hstepB); PG8_STAGE_A(PG8_SA(0, 0), s00, s01, kb2);
            PG8_WAIT_V(8); PG8_WAIT_L(0); PG8_BAR; if (half1) { PG8_MMA(1, 0, At, B0); PG8_MMA(1, 1, At, B1); } PG8_BAR; PG8_SCHED;
            PG8_LDB(B0, 1, 0); PG8_LDB(B1, 1, 1); PG8_SCHED; PG8_LDA(At, 1, 0); PG8_STAGE_A(PG8_SA(0, 1), s10, s11, kb2);
            PG8_WAIT_V(8); PG8_WAIT_L(0); PG8_BAR; PG8_MMA(0, 0, At, B0); PG8_MMA(0, 1, At, B1); PG8_BAR; PG8_SCHED;
            PG8_LDA(At, 1, 1); PG8_STAGE_B(PG8_SB(1, 0), b3); PG8_STAGE_B(PG8_SB(1, 1), b3 + hstepB); PG8_STAGE_A(PG8_SA(1, 0), s00, s01, kb3);
            PG8_WAIT_V(8); PG8_WAIT_L(0); PG8_BAR; if (half1) { PG8_MMA(1, 0, At, B0); PG8_MMA(1, 1, At, B1); } PG8_BAR; PG8_SCHED;
        }
        if constexpr (ALIGN_EPI) { if (wr == 0) PG8_BAR; }
        E(acc, cur, wr, wc, fr, fq);
        if (!has_next) break;
#pragma unroll
        for (int a = 0; a < 2; ++a)
#pragma unroll
            for (int b = 0; b < 2; ++b)
#pragma unroll
                for (int m = 0; m < 4; ++m)
#pragma unroll
                    for (int n = 0; n < 2; ++n) acc[a][b][m][n] = (f32x4){0.f, 0.f, 0.f, 0.f};
        cur = nxt; cB = nB; vc00 = vn00; vc01 = vn01; vc10 = vn10; vc11 = vn11; ++ui;
        if constexpr (ALIGN_EPI) { if (wr == 1) PG8_BAR; }
    }
    PG8_WAIT_V(0);
    if constexpr (!ALIGN_EPI) { if (wr == 0) PG8_BAR; }
    PG8_BAR;
#undef PG8_SA
#undef PG8_SB
#undef PG8_STAGE_A
#undef PG8_STAGE_B
#undef PG8_LDA
#undef PG8_LDB
#undef PG8_MMA
#undef PG8_WAIT_V
#undef PG8_WAIT_L
#undef PG8_BAR
#undef PG8_SCHED
#undef PG8_VOFF
}
#define PG8_TILE_BEGIN(acc, wr, wc, fr, fq) \
    _Pragma("unroll") for (int ai = 0; ai < 2; ++ai) _Pragma("unroll") for (int m = 0; m < 4; ++m) _Pragma("unroll") for (int bj = 0; bj < 2; ++bj) { \
        const int trow = ai * 128 + wr * 64 + m * 16 + fr, tcol = bj * 128 + wc * 32 + 8 * fq; f32x4 v0 = acc[ai][bj][m][0], v1 = acc[ai][bj][m][1];
#define PG8_TILE_END }
__device__ __forceinline__ u32x4 pack8(f32x4 v0, f32x4 v1) { u32x4 w; w.x = cvt_pk_bf16(v0[0], v0[1]); w.y = cvt_pk_bf16(v0[2], v0[3]); w.z = cvt_pk_bf16(v1[0], v1[1]); w.w = cvt_pk_bf16(v1[2], v1[3]); return w; }
}

#define XB_TMO      128
#define XB_XCNT(j)  (256  + 64 * (j))
#define XB_XSUB(j)  (1280 + 64 * (j))
#define XB_XGEN(j)  (2304 + 64 * (j))
#define XB_TOP      3328
#define XB_TOPGEN   3392
#define XCD_BAR_WORDS 3456
#define XB_SPIN_CAP (1u << 18)

__device__ __forceinline__ unsigned xb_ld(unsigned* p)              { return __hip_atomic_load(p, __ATOMIC_RELAXED, __HIP_MEMORY_SCOPE_AGENT); }
__device__ __forceinline__ unsigned xb_add(unsigned* p, unsigned v) { return __hip_atomic_fetch_add(p, v, __ATOMIC_RELAXED, __HIP_MEMORY_SCOPE_AGENT); }
__device__ __forceinline__ unsigned xb_xcc_id() { return (unsigned)__builtin_amdgcn_s_getreg((3 << 11) | 20) & 0xFu; }
#define XB_SPIN(cond, bar) do { unsigned _sp = 0; while (cond) { __builtin_amdgcn_s_sleep(1); \
    if ((++_sp & 255u) == 0u) { if (xb_ld(&(bar)[XB_TMO])) break; if (_sp > XB_SPIN_CAP) { atomicAdd(&(bar)[XB_TMO], 1u); break; } } } } while (0)

struct XcdBarrier {
    unsigned* bar; unsigned x;
    volatile LAS unsigned* st;
};

__device__ __forceinline__ XcdBarrier xcd_barrier_post(unsigned* bar, volatile LAS unsigned* st) {
    XcdBarrier b; b.bar = bar; b.x = xb_xcc_id(); b.st = st;
    if (threadIdx.x == 0) (void)xb_add(&bar[XB_XCNT(b.x)], 1u);
    return b;
}
__device__ __forceinline__ void xcd_barrier_complete(unsigned* bar, unsigned x, unsigned& nloc, unsigned& nx) {
    const unsigned G = gridDim.x * gridDim.y * gridDim.z;
    unsigned sum, cnt, mine, sp = 0u;
    for (;;) {
        sum = 0u; cnt = 0u; mine = 0u;
#pragma unroll
        for (unsigned j = 0; j < 16; ++j) { const unsigned c = xb_ld(&bar[XB_XCNT(j)]); sum += c; cnt += (c > 0u) ? 1u : 0u; mine = (j == x) ? c : mine; }
        if (sum == G) break;
        __builtin_amdgcn_s_sleep(1);
        if ((++sp & 255u) == 0u) { if (xb_ld(&bar[XB_TMO])) break; if (sp > XB_SPIN_CAP) { atomicAdd(&bar[XB_TMO], 1u); break; } }
    }
    nloc = mine > 0u ? mine : 1u; nx = cnt > 0u ? cnt : 1u;
}

__device__ __forceinline__ void xcd_barrier(const XcdBarrier& b) {
    asm volatile("s_waitcnt vmcnt(0)" ::: "memory");
    __syncthreads();
    if (threadIdx.x == 0) {
        unsigned* bar = b.bar; asm volatile("" : "+s"(bar));
        __builtin_amdgcn_s_waitcnt(0);
        unsigned nloc = b.st[0], nx = b.st[1];
        if (nloc == 0u) { xcd_barrier_complete(bar, b.x, nloc, nx); b.st[0] = nloc; b.st[1] = nx; }
        const unsigned old = xb_add(&bar[XB_XSUB(b.x)], 1u);
        const unsigned gen = old / nloc;
        if (old + 1u == (gen + 1u) * nloc) {
            __builtin_amdgcn_fence(__ATOMIC_RELEASE, "agent");
            asm volatile("s_waitcnt vmcnt(0)" ::: "memory");
            const unsigned og = xb_add(&bar[XB_TOP], 1u);
            const unsigned tg = og / nx;
            if (og + 1u == (tg + 1u) * nx) xb_add(&bar[XB_TOPGEN], 1u);
            else XB_SPIN(xb_ld(&bar[XB_TOPGEN]) == tg, bar);
            __builtin_amdgcn_fence(__ATOMIC_ACQUIRE, "agent");
            xb_add(&bar[XB_XGEN(b.x)], 1u);
            asm volatile("s_waitcnt vmcnt(0)" ::: "memory");
        } else {
            XB_SPIN(xb_ld(&bar[XB_XGEN(b.x)]) == gen, bar);
            __builtin_amdgcn_fence(__ATOMIC_ACQUIRE, "agent");
            asm volatile("s_waitcnt vmcnt(0)" ::: "memory");
        }
    }
    __syncthreads();
}


struct Params {
    const float* in[22]; float* out; unsigned char* ws;
    int ph_lo, ph_hi;
};
constexpr size_t MiB = 1u << 20;
constexpr size_t WS_CTL = 0, CTL_BYTES = 1 * MiB;
constexpr int CW_BAR = 4096;
constexpr int CW_CNT = 16384;
constexpr size_t WS_WIN = 2 * MiB;
constexpr size_t SZ_WIN = (size_t)INCP * DM;
constexpr size_t SZ_WUQ = (size_t)768 * QL, SZ_WUKV = (size_t)1024 * KVL;
constexpr size_t WS_WUQ = WS_WIN + 2 * SZ_WIN * 2;
constexpr size_t WS_WUKV = WS_WUQ + 2 * SZ_WUQ * 2;
constexpr size_t SZ_WP = (size_t)DM * 512, SZ_WOUT = (size_t)DM * DM;
constexpr size_t WS_WPA = WS_WUKV + 2 * SZ_WUKV * 2;
constexpr size_t WS_WPB = WS_WPA + 2 * SZ_WP * 2;
constexpr size_t WS_WOUT = WS_WPB + 2 * SZ_WP * 2;
constexpr size_t SZ_WRT = (size_t)NE * DM, SZ_WSGU = (size_t)512 * DM, SZ_WSD = (size_t)DM * DSH;
constexpr size_t WS_WRT = WS_WOUT + 2 * SZ_WOUT * 2;
constexpr size_t WS_WSGU = WS_WRT + 2 * SZ_WRT * 2;
constexpr size_t WS_WSD = WS_WSGU + 2 * SZ_WSGU * 2;
constexpr size_t WS_CS = WS_WSD + 2 * SZ_WSD * 2;
constexpr size_t WS_KM = WS_CS + (size_t)SEQ * 16 * 8;
constexpr size_t WS_SEL = WS_KM + (size_t)NB * HA * NBLK * 64 * 4;
constexpr size_t WS_XB = WS_SEL + (size_t)T * 8 * 4;
constexpr size_t WS_CQN = WS_XB + (size_t)T * DM * 2;
constexpr size_t WS_CKVN = WS_CQN + (size_t)T * QL * 2;
constexpr size_t WS_QB = WS_CKVN + (size_t)T * KVL * 2;
constexpr size_t WS_KB = WS_QB + (size_t)T * 768 * 2;
constexpr size_t WS_VB = WS_KB + (size_t)T * 768 * 2;
constexpr size_t WS_OAB = WS_VB + (size_t)T * 512 * 2;
constexpr size_t WS_TMP = WS_OAB + (size_t)T * 1024 * 2;
constexpr size_t WS_MRG = WS_TMP + (size_t)T * 1024 * 2;
constexpr size_t WS_PRE = WS_MRG + (size_t)T * 1024 * 2;
constexpr size_t WS_X1 = WS_PRE + (size_t)T * 1024 * 4;
constexpr size_t WS_X1B = WS_X1 + (size_t)T * 1024 * 4;
constexpr size_t WS_X2 = WS_X1B + (size_t)T * 1024 * 2;
constexpr size_t WS_LOG = WS_X2 + (size_t)T * 1024 * 4;
constexpr size_t WS_HS = WS_LOG + (size_t)T * NE * 4;
constexpr size_t WS_SH = WS_HS + (size_t)T * DSH * 2;
constexpr size_t WS_TOPE = WS_SH + (size_t)T * DM * 2;
constexpr size_t WS_TOPW = WS_TOPE + (size_t)NA * 4;
constexpr size_t WS_APOS = WS_TOPW + (size_t)NA * 4;
constexpr size_t WS_ROWA = WS_APOS + (size_t)NA * 4;
constexpr size_t WS_HIST = WS_ROWA + (size_t)NA * 8;
constexpr size_t WS_PO = WS_HIST + (size_t)1024 * 256 * 4;
constexpr size_t WS_PML = WS_PO + (size_t)T * 8 * 3 * 64 * 2;
constexpr size_t WS_HE = WS_PML + (size_t)T * 8 * 3 * 128;
constexpr size_t WS_Y = WS_HE + (size_t)NA * DE * 2;
constexpr size_t WS_PROJ = WS_Y + (size_t)NA * DM * 2;
constexpr size_t SZ_WEGU = (size_t)NE * 512 * DM, SZ_WED = (size_t)NE * DM * DE;
constexpr size_t WS_WEGU = WS_PROJ + (size_t)T * INCP * 2;
constexpr size_t WS_WED = WS_WEGU + 2 * SZ_WEGU * 2;
constexpr size_t WS_FAST_END = WS_WED + 2 * SZ_WED * 2;
constexpr size_t WS_NEED = WS_FAST_END;
static_assert(WS_NEED <= (size_t)2040 * MiB, "ws map");

constexpr int LDS_BYTES = 147456;
constexpr int RING_BYTES = 131072, MISC_OFF = RING_BYTES + 1024, TAB_OFF = RING_BYTES + 2048;

struct Frame { LAS unsigned char* lds; int tid, lane, wave, G, vcu; };

template <class RowMap>
__device__ __forceinline__ void transpose_item(const float* W, int K, int N, bf16_t* WT, int ldk, RowMap rm, LAS float* scr, int item, int lane) {
    const int nblk = N / 32, kb = item / nblk, nb = item % nblk, k0 = 64 * kb, n0 = 32 * nb;
#pragma unroll 8
    for (int i = 0; i < 32; ++i) { const int kk = 2 * i + (lane >> 5); scr[kk * 33 + (lane & 31)] = W[(size_t)(k0 + kk) * N + n0 + (lane & 31)]; }
    LDS_WAIT(); asm volatile("" ::: "memory");
    const int c = lane & 7;
#pragma unroll
    for (int j = 0; j < 4; ++j) { const int n = (lane >> 3) + 8 * j; const LAS float* s = scr + (8 * c) * 33 + n;
        u32x4 o; o.x = pk2(s[0 * 33], s[1 * 33]); o.y = pk2(s[2 * 33], s[3 * 33]); o.z = pk2(s[4 * 33], s[5 * 33]); o.w = pk2(s[6 * 33], s[7 * 33]);
        *(u32x4*)(WT + (size_t)rm(n0 + n) * ldk + k0 + 8 * c) = o; }
    LDS_WAIT(); asm volatile("" ::: "memory");
}
template <class RowMap>
__device__ __forceinline__ void transpose_item64(const float* W, int K, int N, bf16_t* WT, int ldk, RowMap rm, LAS unsigned short* scr, int item, int lane) {
    const int nblk = N / 64, kb = item / nblk, nb = item % nblk, k0 = 64 * kb, n0 = 64 * nb, r = lane >> 4, c4 = (lane & 15) * 4;
    f32x4 v[16];
#pragma unroll
    for (int i = 0; i < 16; ++i) v[i] = __builtin_nontemporal_load((const f32x4*)(W + (size_t)(k0 + 4 * i + r) * N + n0 + c4));
#pragma unroll
    for (int i = 0; i < 16; ++i) { LAS unsigned* d = (LAS unsigned*)(scr + (4 * i + r) * 66 + c4); d[0] = pk2(v[i][0], v[i][1]); d[1] = pk2(v[i][2], v[i][3]); }
    LDS_WAIT(); asm volatile("" ::: "memory");
    const int c = lane & 7;
#pragma unroll
    for (int j = 0; j < 8; ++j) { const int n = (lane >> 3) + 8 * j; const LAS unsigned short* q = scr + (8 * c) * 66 + n;
        u32x4 o; o.x = (unsigned)q[0] | ((unsigned)q[66] << 16); o.y = (unsigned)q[2 * 66] | ((unsigned)q[3 * 66] << 16); o.z = (unsigned)q[4 * 66] | ((unsigned)q[5 * 66] << 16); o.w = (unsigned)q[6 * 66] | ((unsigned)q[7 * 66] << 16);
        *(u32x4*)(WT + (size_t)rm(n0 + n) * ldk + k0 + 8 * c) = o; }
    LDS_WAIT(); asm volatile("" ::: "memory");
}
struct RowPermD { __device__ __forceinline__ int operator()(int n) const { const int a = n & 255; return (n & ~255) + 128 * ((a >> 3) & 1) + 32 * (a >> 6) + 8 * ((a >> 4) & 3) + (a & 7); } };
struct RowId { __device__ __forceinline__ int operator()(int n) const { return n; } };

struct EpiProj {
    static constexpr int MIDK = 0;
    bf16_t* O; const float* bg;
    __device__ __forceinline__ void operator()(const f32x4 (&acc)[2][2][4][2], const pg8::Unit& u, int wr, int wc, int fr, int fq) const {
        PG8_TILE_BEGIN(acc, wr, wc, fr, fq)
            const int row = u.pm * 256 + trow, col = u.pn * 256 + tcol;
            if (col < C_KA) { v0 = v0 * QS_A; v1 = v1 * QS_A; }
            else if (col >= C_GA && col < INC) { const f32x4 b0 = *(const f32x4*)(bg + col - C_GA), b1 = *(const f32x4*)(bg + col - C_GA + 4);
#pragma unroll
                for (int i = 0; i < 4; ++i) { v0[i] = sigmoidf_(v0[i] + b0[i]); v1[i] = sigmoidf_(v1[i] + b1[i]); } }
            *(u32x4*)(O + (size_t)row * INCP + col) = pg8::pack8(v0, v1);
        PG8_TILE_END
    }
};

struct RowQ { __device__ __forceinline__ int operator()(int n) const { const int h = n / 96, d = n % 96; if (d < 64) return n; const int i = d - 64; return h * 96 + 64 + (i < 16 ? 2 * i : 2 * (i - 16) + 1); } };

struct EpiQ {
    static constexpr int MIDK = 0;
    bf16_t* O; const f32x2* CS;
    __device__ __forceinline__ void operator()(const f32x4 (&acc)[2][2][4][2], const pg8::Unit& u, int wr, int wc, int fr, int fq) const {
        PG8_TILE_BEGIN(acc, wr, wc, fr, fq)
            const int row = u.pm * 256 + trow, col = u.pn * 256 + tcol, d = col % 96;
            if (d >= 64) { const int pos = row % SEQ, i0 = (d - 64) >> 1; const f32x2* cs = CS + (size_t)pos * 16 + i0;
                const f32x2 c0 = cs[0], c1 = cs[1], c2 = cs[2], c3 = cs[3];
                const f32x4 a = v0, b = v1;
                v0[0] = a[0] * c0[0] - a[1] * c0[1]; v0[1] = a[1] * c0[0] + a[0] * c0[1]; v0[2] = a[2] * c1[0] - a[3] * c1[1]; v0[3] = a[3] * c1[0] + a[2] * c1[1];
                v1[0] = b[0] * c2[0] - b[1] * c2[1]; v1[1] = b[1] * c2[0] + b[0] * c2[1]; v1[2] = b[2] * c3[0] - b[3] * c3[1]; v1[3] = b[3] * c3[0] + b[2] * c3[1]; }
            v0 = v0 * QS_B; v1 = v1 * QS_B;
            *(u32x4*)(O + (size_t)row * 768 + col) = pg8::pack8(v0, v1);
        PG8_TILE_END
    }
};
struct EpiKV {
    static constexpr int MIDK = 0;
    bf16_t* KB; bf16_t* VB;
    __device__ __forceinline__ void operator()(const f32x4 (&acc)[2][2][4][2], const pg8::Unit& u, int wr, int wc, int fr, int fq) const {
        PG8_TILE_BEGIN(acc, wr, wc, fr, fq)
            const int row = u.pm * 256 + trow, col = u.pn * 256 + tcol, h = col >> 7, j = col & 127;
            bf16_t* dst = (j < 64) ? KB + (size_t)row * 768 + h * 96 + j : VB + (size_t)row * 512 + h * 64 + (j - 64);
            *(u32x4*)dst = pg8::pack8(v0, v1);
        PG8_TILE_END
    }
};

__device__ __forceinline__ void prep_phase(const Frame& F, const bf16_t* PROJ, const float* qn, const float* kvn, const f32x2* CS, bf16_t* CQN, bf16_t* CKVN, bf16_t* KB, float* KM) {
    int lane_ = F.lane; asm volatile("" : "+v"(lane_));
    const int gw = F.vcu * NWAVES + F.wave, NGW = F.G * NWAVES, lane = lane_;
    for (int row = gw; row < T; row += NGW) {
        const bf16_t* p = PROJ + (size_t)row * INCP;
        u32x4 a = (u32x4){0u, 0u, 0u, 0u}, b = (u32x4){0u, 0u, 0u, 0u};
        if (lane < 48) a = *(const u32x4*)(p + C_CQ + lane * 8);
        if (lane < 32) b = *(const u32x4*)(p + C_CKV + lane * 8);
        float sq = 0.f, sk = 0.f;
#pragma unroll
        for (int i = 0; i < 4; ++i) { const float x = bflo(a[i]), y = bfhi(a[i]), z = bflo(b[i]), w = bfhi(b[i]); sq += x * x + y * y; sk += z * z + w * w; }
        sq = wave_sum(sq); sk = wave_sum(sk);
        const float rq = rsqrtf(sq * (1.f / QL) + RMS_EPS), rk = rsqrtf(sk * (1.f / KVL) + RMS_EPS);
        if (lane < 48) { const f32x4 g0 = *(const f32x4*)(qn + lane * 8), g1 = *(const f32x4*)(qn + lane * 8 + 4); u32x4 o;
            o.x = pk2(bflo(a.x) * rq * g0[0], bfhi(a.x) * rq * g0[1]); o.y = pk2(bflo(a.y) * rq * g0[2], bfhi(a.y) * rq * g0[3]);
            o.z = pk2(bflo(a.z) * rq * g1[0], bfhi(a.z) * rq * g1[1]); o.w = pk2(bflo(a.w) * rq * g1[2], bfhi(a.w) * rq * g1[3]);
            *(u32x4*)(CQN + (size_t)row * QL + lane * 8) = o; }
        if (lane < 32) { const f32x4 g0 = *(const f32x4*)(kvn + lane * 8), g1 = *(const f32x4*)(kvn + lane * 8 + 4); u32x4 o;
            o.x = pk2(bflo(b.x) * rk * g0[0], bfhi(b.x) * rk * g0[1]); o.y = pk2(bflo(b.y) * rk * g0[2], bfhi(b.y) * rk * g0[3]);
            o.z = pk2(bflo(b.z) * rk * g1[0], bfhi(b.z) * rk * g1[1]); o.w = pk2(bflo(b.w) * rk * g1[2], bfhi(b.w) * rk * g1[3]);
            *(u32x4*)(CKVN + (size_t)row * KVL + lane * 8) = o; }
        if (lane < 16) { const float x1 = bf2f(p[C_KR + lane]), x2 = bf2f(p[C_KR + 16 + lane]); const f32x2 cs = CS[(size_t)(row % SEQ) * 16 + lane];
            const unsigned w = pk2(x1 * cs[0] - x2 * cs[1], x2 * cs[0] + x1 * cs[1]);
#pragma unroll
            for (int h = 0; h < 8; ++h) *(unsigned*)(KB + (size_t)row * 768 + h * 96 + 64 + 2 * lane) = w; }
    }
    for (int it = gw; it < NB * NBLK * HA; it += NGW) {
        const int h = it % HA, blk = (it / HA) % NBLK, b = it / (HA * NBLK), c = lane & 7, r0 = lane >> 3;
        const bf16_t* p = PROJ + ((size_t)b * SEQ + (size_t)blk * BLK + r0) * INCP + C_KA + h * 64 + c * 8;
        float s[8];
#pragma unroll
        for (int i = 0; i < 8; ++i) s[i] = 0.f;
#pragma unroll 8
        for (int i = 0; i < 32; ++i) { const u32x4 v = *(const u32x4*)(p + (size_t)i * 8 * INCP);
#pragma unroll
            for (int k = 0; k < 4; ++k) { s[2 * k] += bflo(v[k]); s[2 * k + 1] += bfhi(v[k]); } }
#pragma unroll
        for (int i = 0; i < 8; ++i) { s[i] += __shfl_xor(s[i], 8); s[i] += __shfl_xor(s[i], 16); s[i] += __shfl_xor(s[i], 32); }
        if (lane < 8) { float* o = KM + ((size_t)(b * HA + h) * NBLK + blk) * 64 + c * 8;
            *(f32x4*)o = (f32x4){s[0], s[1], s[2], s[3]} * (1.f / BLK); *(f32x4*)(o + 4) = (f32x4){s[4], s[5], s[6], s[7]} * (1.f / BLK); }
    }
}
__device__ __forceinline__ void mobasel_phase(const Frame& F, const bf16_t* PROJ, const float* KM, unsigned* SEL) {
    int tid_ = F.tid; asm volatile("" : "+v"(tid_));
    const int TPW = T / F.G, row0 = (int)blockIdx.x * TPW, b = row0 / SEQ, own = (row0 % SEQ) / BLK, hs = own * 64 + 4;
    LAS float* km = (LAS float*)F.lds;
    for (int i = tid_; i < 8 * own * 16; i += NTHR) { const int h = i / (own * 16), r = i % (own * 16);
        *(LAS f32x4*)(km + h * hs + r * 4) = *(const f32x4*)(KM + ((size_t)(b * HA + h) * NBLK) * 64 + r * 4); }
    __syncthreads();
    for (int idx = tid_; idx < TPW * 8; idx += NTHR) {
        const int h = idx & 7, row = row0 + (idx >> 3);
        const bf16_t* qp = PROJ + (size_t)row * INCP + C_QA + h * 64;
        float q[64];
#pragma unroll
        for (int i = 0; i < 8; ++i) { const u32x4 v = *(const u32x4*)(qp + i * 8);
#pragma unroll
            for (int k = 0; k < 4; ++k) { q[i * 8 + 2 * k] = bflo(v[k]); q[i * 8 + 2 * k + 1] = bfhi(v[k]); } }
        float v1 = -INFINITY, v2 = -INFINITY, v3 = -INFINITY; int i1 = -1, i2 = -1, i3 = -1;
        for (int j = 0; j < own; ++j) {
            const LAS f32x4* kp = (const LAS f32x4*)(km + h * hs + j * 64);
            float g0 = 0.f, g1 = 0.f, g2 = 0.f, g3 = 0.f;
#pragma unroll
            for (int c = 0; c < 16; ++c) { const f32x4 k4 = kp[c]; g0 = fmaf(q[4 * c], k4[0], g0); g1 = fmaf(q[4 * c + 1], k4[1], g1); g2 = fmaf(q[4 * c + 2], k4[2], g2); g3 = fmaf(q[4 * c + 3], k4[3], g3); }
            const float g = (g0 + g1) + (g2 + g3);
            if (g > v1) { v3 = v2; i3 = i2; v2 = v1; i2 = i1; v1 = g; i1 = j; }
            else if (g > v2) { v3 = v2; i3 = i2; v2 = g; i2 = j; }
            else if (g > v3) { v3 = g; i3 = j; }
        }
        unsigned m = 0;
        if (i1 >= 0) m |= 1u << i1;
        if (i2 >= 0) m |= 1u << i2;
        if (i3 >= 0) m |= 1u << i3;
        SEL[(size_t)row * 8 + h] = m;
    }
    __syncthreads();
}

struct EpiGate2 {
    static constexpr int MIDK = 8;
    const bf16_t* PROJ; bf16_t* MRG;
    __device__ __forceinline__ void mid(f32x4 (&acc)[2][2][4][2], const pg8::Unit& u, int wr, int wc, int fr_, int fq) const {
        int fr = fr_; asm volatile("" : "+v"(fr));
#pragma unroll
        for (int ai = 0; ai < 2; ++ai)
#pragma unroll
            for (int m = 0; m < 4; ++m)
#pragma unroll
                for (int bj = 0; bj < 2; ++bj) { const size_t o = (size_t)(u.pm * 256 + ai * 128 + wr * 64 + m * 16 + fr) * INCP + u.pn * 256 + bj * 128 + wc * 32 + 8 * fq;
                    const u32x4 ga = *(const u32x4*)(PROJ + o + C_GA), gb = *(const u32x4*)(PROJ + o + C_GB);
#pragma unroll
                    for (int i = 0; i < 4; ++i) { const float r0 = bflo(ga[i]) * __builtin_amdgcn_rcpf(bflo(gb[i])), r1 = bfhi(ga[i]) * __builtin_amdgcn_rcpf(bfhi(gb[i]));
                        acc[ai][bj][m][i >> 1][2 * (i & 1)] *= r0; acc[ai][bj][m][i >> 1][2 * (i & 1) + 1] *= r1; }
                    __builtin_amdgcn_sched_barrier(0); }
    }
    __device__ __forceinline__ void operator()(const f32x4 (&acc)[2][2][4][2], const pg8::Unit& u, int wr, int wc, int fr, int fq) const {
        PG8_TILE_BEGIN(acc, wr, wc, fr, fq)
            const int row = u.pm * 256 + trow, col = u.pn * 256 + tcol;
            const u32x4 g = *(const u32x4*)(PROJ + (size_t)row * INCP + C_GB + col);
            v0[0] *= bflo(g.x); v0[1] *= bfhi(g.x); v0[2] *= bflo(g.y); v0[3] *= bfhi(g.y); v1[0] *= bflo(g.z); v1[1] *= bfhi(g.z); v1[2] *= bflo(g.w); v1[3] *= bfhi(g.w);
            *(u32x4*)(MRG + (size_t)row * DM + col) = pg8::pack8(v0, v1);
        PG8_TILE_END
    }
};
struct EpiResid {
    static constexpr int MIDK = 0;
    const bf16_t* X; bf16_t* PRE;
    __device__ __forceinline__ void operator()(const f32x4 (&acc)[2][2][4][2], const pg8::Unit& u, int wr, int wc, int fr, int fq) const {
        PG8_TILE_BEGIN(acc, wr, wc, fr, fq)
            const size_t o = (size_t)(u.pm * 256 + trow) * DM + u.pn * 256 + tcol;
            const u32x4 x = *(const u32x4*)(X + o);
            v0[0] += ALPHA * bflo(x.x); v0[1] += ALPHA * bfhi(x.x); v0[2] += ALPHA * bflo(x.y); v0[3] += ALPHA * bfhi(x.y);
            v1[0] += ALPHA * bflo(x.z); v1[1] += ALPHA * bfhi(x.z); v1[2] += ALPHA * bflo(x.w); v1[3] += ALPHA * bfhi(x.w);
            *(u32x4*)(PRE + o) = pg8::pack8(v0, v1);
        PG8_TILE_END
    }
};
__device__ __forceinline__ void ln_phase(const Frame& F, const bf16_t* PRE, const float* g, const float* bt, bf16_t* XBo) {
    int lane_ = F.lane; asm volatile("" : "+v"(lane_));
    const int gw = F.vcu * NWAVES + F.wave, NGW = F.G * NWAVES, lane = lane_;
    for (int row = gw; row < T; row += NGW) {
        const u32x2* pr = (const u32x2*)(PRE + (size_t)row * DM) + lane;
        f32x4 v[4]; float s = 0.f;
#pragma unroll
        for (int j = 0; j < 4; ++j) { const u32x2 h = pr[64 * j]; v[j] = (f32x4){bflo(h.x), bfhi(h.x), bflo(h.y), bfhi(h.y)}; s += (v[j][0] + v[j][1]) + (v[j][2] + v[j][3]); }
        const float mean = wave_sum(s) * (1.f / DM); float s2 = 0.f;
#pragma unroll
        for (int j = 0; j < 4; ++j) { v[j] = v[j] - mean; s2 += (v[j][0] * v[j][0] + v[j][1] * v[j][1]) + (v[j][2] * v[j][2] + v[j][3] * v[j][3]); }
        const float rstd = rsqrtf(wave_sum(s2) * (1.f / DM) + LN_EPS);
#pragma unroll
        for (int j = 0; j < 4; ++j) { const f32x4 gg = ((const f32x4*)g)[lane + 64 * j], bb = ((const f32x4*)bt)[lane + 64 * j];
            const f32x4 y = v[j] * rstd * gg + bb;
            u32x2 w; w.x = pk2(y[0], y[1]); w.y = pk2(y[2], y[3]); ((u32x2*)(XBo + (size_t)row * DM))[lane + 64 * j] = w; }
    }
}

struct RowGU { int off; __device__ __forceinline__ int operator()(int n) const { return 256 * (n >> 7) + off + (n & 127); } };

struct EpiF32 {
    static constexpr int MIDK = 0;
    float* O; int ld;
    __device__ __forceinline__ void operator()(const f32x4 (&acc)[2][2][4][2], const pg8::Unit& u, int wr, int wc, int fr, int fq) const {
        PG8_TILE_BEGIN(acc, wr, wc, fr, fq)
            float* o = O + (size_t)(u.pm * 256 + trow) * ld + u.pn * 256 + tcol; *(f32x4*)o = v0; *(f32x4*)(o + 4) = v1;
        PG8_TILE_END
    }
};
struct EpiBf16 {
    static constexpr int MIDK = 0;
    bf16_t* O; int ld;
    __device__ __forceinline__ void operator()(const f32x4 (&acc)[2][2][4][2], const pg8::Unit& u, int wr, int wc, int fr, int fq) const {
        PG8_TILE_BEGIN(acc, wr, wc, fr, fq)
            *(u32x4*)(O + (size_t)(u.pm * 256 + trow) * ld + u.pn * 256 + tcol) = pg8::pack8(v0, v1);
        PG8_TILE_END
    }
};
__device__ __forceinline__ float silu_mul(float g, float u) { return g * __builtin_amdgcn_rcpf(1.f + __expf(-g)) * u; }
struct EpiSwiGLU {
    static constexpr int MIDK = 0;
    bf16_t* H; int ld;
    __device__ __forceinline__ void operator()(const f32x4 (&acc)[2][2][4][2], const pg8::Unit& u, int wr, int wc, int fr, int fq) const {
#pragma unroll
        for (int ai = 0; ai < 2; ++ai)
#pragma unroll
            for (int m = 0; m < 4; ++m) { const int row = u.r0 + ai * 128 + wr * 64 + m * 16 + fr;
                if (row < u.rend) { f32x4 h0, h1;
#pragma unroll
                    for (int i = 0; i < 4; ++i) { h0[i] = silu_mul(acc[ai][0][m][0][i], acc[ai][1][m][0][i]); h1[i] = silu_mul(acc[ai][0][m][1][i], acc[ai][1][m][1][i]); }
                    *(u32x4*)(H + (size_t)row * ld + 128 * u.pn + wc * 32 + 8 * fq) = pg8::pack8(h0, h1); } }
    }
};
constexpr float Y8_SCALE = 32.f;
__device__ __forceinline__ unsigned pk4_fp8(float a, float b, float c, float d) { int w = __builtin_amdgcn_cvt_pk_fp8_f32(a, b, 0, false); w = __builtin_amdgcn_cvt_pk_fp8_f32(c, d, w, true); return (unsigned)w; }
struct EpiExpDown {
    static constexpr int MIDK = 0;
    unsigned char* Y8;
    __device__ __forceinline__ void operator()(const f32x4 (&acc)[2][2][4][2], const pg8::Unit& u, int wr, int wc, int fr, int fq) const {
#pragma unroll
        for (int ai = 0; ai < 2; ++ai)
#pragma unroll
            for (int m = 0; m < 4; ++m) { const int row = u.r0 + ai * 128 + wr * 64 + m * 16 + fr;
                if (row < u.rend) { const f32x4 a0 = acc[ai][0][m][0] * Y8_SCALE, a1 = acc[ai][0][m][1] * Y8_SCALE, b0 = acc[ai][1][m][0] * Y8_SCALE, b1 = acc[ai][1][m][1] * Y8_SCALE;
                    u32x4 w; w.x = pk4_fp8(a0[0], a0[1], a0[2], a0[3]); w.y = pk4_fp8(a1[0], a1[1], a1[2], a1[3]); w.z = pk4_fp8(b0[0], b0[1], b0[2], b0[3]); w.w = pk4_fp8(b1[0], b1[1], b1[2], b1[3]);
                    *(u32x4*)(Y8 + (size_t)row * DM + 256 * u.pn + 64 * wc + 16 * fq) = w; } }
    }
};
template <int NPN, bool GATHER>
struct ExpertOrder {
    const LAS int* off; const LAS int* toff; const int* rowa; int G, c; size_t strideE;
    __device__ __forceinline__ bool next(int i, pg8::Unit& u) const {
        const int L = i * G + c; if (L >= toff[256] * NPN) return false;
        const int tile = L / NPN; u.pn = L % NPN; int lo = 0, hi = 255;
        while (lo < hi) { const int mid = (lo + hi + 1) >> 1; if (toff[mid] <= tile) lo = mid; else hi = mid - 1; }
        u.e = lo; u.r0 = off[lo] + (tile - toff[lo]) * 256; u.rend = off[lo + 1]; u.pm = 0; return true;
    }
    __device__ __forceinline__ int a_row(const pg8::Unit& u, int r) const { const int rr = min(u.r0 + r, u.rend - 1); return GATHER ? (rowa[2 * rr] >> 3) : rr; }
    __device__ __forceinline__ const char* b_ptr(const pg8::Gemm& g, const pg8::Unit& u) const { return (const char*)g.Bt + (size_t)u.e * strideE + (size_t)u.pn * 256 * g.ldb * 2; }
};
__device__ __forceinline__ int scan256(int v, int tid, LAS int* wsum, int* total) {
    const int lane = tid & 63, w = tid >> 6;
    int x = (tid < 256) ? v : 0;
#pragma unroll
    for (int o = 1; o < 64; o <<= 1) { const int y = __shfl_up(x, o); if (lane >= o) x += y; }
    if (lane == 63 && w < 4) wsum[w] = x;
    __syncthreads();
    const int s0 = wsum[0], s1 = wsum[1], s2 = wsum[2], s3 = wsum[3];
    *total = s0 + s1 + s2 + s3;
    const int base = (w == 0) ? 0 : (w == 1) ? s0 : (w == 2) ? s0 + s1 : s0 + s1 + s2;
    __syncthreads();
    return base + x - ((tid < 256) ? v : 0);
}
__device__ __forceinline__ void expert_tables(const Frame& F, const unsigned* cnt, LAS int* off, LAS int* toff) {
    const int c = (F.tid < 256) ? (int)cnt[F.tid] : 0;
    int tot, ttot;
    const int po = scan256(c, F.tid, toff + 264, &tot), pt = scan256((c + 255) >> 8, F.tid, toff + 264, &ttot);
    if (F.tid < 256) { off[F.tid] = po; toff[F.tid] = pt; }
    if (F.tid == 0) { off[256] = tot; toff[256] = ttot; }
    __syncthreads();
}
__device__ __forceinline__ void route_phase(const Frame& F, const float* LOGITS, const float* rbias, int* TOPE, float* TOPW, int* APOS, int* HIST, LAS int* lcnt) {
    int lane_ = F.lane; asm volatile("" : "+v"(lane_));
    const int lane = lane_, TPW = T / F.G, t0 = (int)blockIdx.x * TPW;
    if (F.tid < 256) lcnt[F.tid] = 0;
    __syncthreads();
    const f32x4 rb = *(const f32x4*)(rbias + lane * 4);
    f32x4 lgn = (t0 + F.wave < t0 + TPW) ? *(const f32x4*)(LOGITS + (size_t)(t0 + F.wave) * NE + lane * 4) : (f32x4){0.f, 0.f, 0.f, 0.f};
#pragma unroll 1
    for (int t = t0 + F.wave; t < t0 + TPW; t += NWAVES) {
        const f32x4 lg = lgn;
        if (t + NWAVES < t0 + TPW) lgn = *(const f32x4*)(LOGITS + (size_t)(t + NWAVES) * NE + lane * 4);
        const float s0 = __builtin_amdgcn_rcpf(1.f + __expf(-lg[0])), s1 = __builtin_amdgcn_rcpf(1.f + __expf(-lg[1])), s2 = __builtin_amdgcn_rcpf(1.f + __expf(-lg[2])), s3 = __builtin_amdgcn_rcpf(1.f + __expf(-lg[3]));
        float c0 = s0 + rb[0], c1 = s1 + rb[1], c2 = s2 + rb[2], c3 = s3 + rb[3];
        float a = fmaxf(c0, c1), bq = fminf(c0, c1);
        { const float hi2 = fmaxf(c2, c3), lo2 = fminf(c2, c3); const float na = fmaxf(a, hi2), nb = fmaxf(fminf(a, hi2), fmaxf(bq, lo2)); a = na; bq = nb; }
#pragma unroll
        for (int o = 1; o < 8; o <<= 1) { const float oa = __shfl_xor(a, o), ob = __shfl_xor(bq, o); const float na = fmaxf(a, oa), nb = fmaxf(fminf(a, oa), fmaxf(bq, ob)); a = na; bq = nb; }
        const float gs = a + bq; const int grp = lane >> 3;
        int rank = 0;
#pragma unroll
        for (int j = 0; j < 8; ++j) { const float og = __shfl(gs, j * 8); rank += (og > gs || (og == gs && j < grp)) ? 1 : 0; }
        if (rank >= 4) { c0 = c1 = c2 = c3 = -INFINITY; }
        float wsum = 0.f, myw = 0.f; int mye = 0;
#pragma unroll
        for (int k = 0; k < TOPK; ++k) {
            float bv = c0; int bi = 0;
            if (c1 > bv) { bv = c1; bi = 1; }
            if (c2 > bv) { bv = c2; bi = 2; }
            if (c3 > bv) { bv = c3; bi = 3; }
            int be = lane * 4 + bi;
#pragma unroll
            for (int o = 1; o < 64; o <<= 1) { const float ov = __shfl_xor(bv, o); const int oe = __shfl_xor(be, o); if (ov > bv || (ov == bv && oe < be)) { bv = ov; be = oe; } }
            float sc = 0.f;
            if ((be >> 2) == lane) { const int b2 = be & 3; sc = b2 == 0 ? s0 : b2 == 1 ? s1 : b2 == 2 ? s2 : s3; if (b2 == 0) c0 = -INFINITY; else if (b2 == 1) c1 = -INFINITY; else if (b2 == 2) c2 = -INFINITY; else c3 = -INFINITY; }
            sc = __shfl(sc, be >> 2);
            wsum += sc;
            if (lane == k) { myw = sc; mye = be; }
        }
        if (lane < TOPK) { const int aidx = t * TOPK + lane; TOPE[aidx] = mye; TOPW[aidx] = myw / wsum * 2.5f; APOS[aidx] = __hip_atomic_fetch_add(lcnt + mye, 1, __ATOMIC_RELAXED, __HIP_MEMORY_SCOPE_WORKGROUP); }
    }
    __syncthreads();
    if (F.tid < 256) HIST[(size_t)blockIdx.x * 256 + F.tid] = lcnt[F.tid];
}
__device__ __forceinline__ void combine_phase(const Frame& F, const bf16_t* X1, const bf16_t* SH, const unsigned char* Y8, const int* INV, const float* TOPW, const float* g, const float* bt, float* Xo, bf16_t* XBo) {
    int lane_ = F.lane; asm volatile("" : "+v"(lane_));
    const int gw = F.vcu * NWAVES + F.wave, NGW = F.G * NWAVES, lane = lane_;
    for (int row = gw; row < T; row += NGW) {
        int ri = 0; float rw = 0.f; if (lane < TOPK) { ri = INV[row * TOPK + lane]; rw = TOPW[row * TOPK + lane] * (1.f / Y8_SCALE); }
        float v[16];
#pragma unroll
        for (int j = 0; j < 2; ++j) { const u32x4 x = ((const u32x4*)(X1 + (size_t)row * DM))[2 * lane + j], h = ((const u32x4*)(SH + (size_t)row * DM))[2 * lane + j];
#pragma unroll
            for (int i = 0; i < 4; ++i) { v[8 * j + 2 * i] = ALPHA * bflo(x[i]) + bflo(h[i]); v[8 * j + 2 * i + 1] = ALPHA * bfhi(x[i]) + bfhi(h[i]); } }
#pragma unroll
        for (int k = 0; k < TOPK; ++k) { const u32x4 h = ((const u32x4*)(Y8 + (size_t)__shfl(ri, k) * DM))[lane]; const float w = __shfl(rw, k);
#pragma unroll
            for (int i = 0; i < 4; ++i) { const f32x2 lo = __builtin_amdgcn_cvt_pk_f32_fp8((int)h[i], false), hi2 = __builtin_amdgcn_cvt_pk_f32_fp8((int)h[i], true);
                v[4 * i] = fmaf(w, lo[0], v[4 * i]); v[4 * i + 1] = fmaf(w, lo[1], v[4 * i + 1]); v[4 * i + 2] = fmaf(w, hi2[0], v[4 * i + 2]); v[4 * i + 3] = fmaf(w, hi2[1], v[4 * i + 3]); } }
        float s = 0.f;
#pragma unroll
        for (int i = 0; i < 16; ++i) s += v[i];
        const float mean = wave_sum(s) * (1.f / DM); float s2 = 0.f;
#pragma unroll
        for (int i = 0; i < 16; ++i) { v[i] -= mean; s2 += v[i] * v[i]; }
        const float rstd = rsqrtf(wave_sum(s2) * (1.f / DM) + LN_EPS);
        const int c0 = 16 * lane;
        f32x4 y[4];
#pragma unroll
        for (int q = 0; q < 4; ++q) { const f32x4 gg = *(const f32x4*)(g + c0 + 4 * q), bb = *(const f32x4*)(bt + c0 + 4 * q); y[q] = (f32x4){v[4 * q], v[4 * q + 1], v[4 * q + 2], v[4 * q + 3]} * rstd * gg + bb; }
        if (Xo) {
#pragma unroll
            for (int q = 0; q < 4; ++q) *(f32x4*)(Xo + (size_t)row * DM + c0 + 4 * q) = y[q]; }
        if (XBo) {
#pragma unroll
            for (int j = 0; j < 2; ++j) { u32x4 w; w.x = pk2(y[2 * j][0], y[2 * j][1]); w.y = pk2(y[2 * j][2], y[2 * j][3]); w.z = pk2(y[2 * j + 1][0], y[2 * j + 1][1]); w.w = pk2(y[2 * j + 1][2], y[2 * j + 1][3]); *(u32x4*)(XBo + (size_t)row * DM + c0 + 8 * j) = w; } }
    }
}

__device__ __forceinline__ int crow(int r, int hi) { return (r & 3) + 8 * (r >> 2) + 4 * hi; }
typedef short s16x4 __attribute__((ext_vector_type(4)));
__device__ __forceinline__ s16x4 vtr(const LAS unsigned char* p) { return __builtin_bit_cast(s16x4, __builtin_amdgcn_ds_read_tr16_b64_v4i16((LAS s16x4*)p)); }
__device__ __forceinline__ float xhalf_max(float v) { auto rr = __builtin_amdgcn_permlane32_swap(__float_as_uint(v), __float_as_uint(v), false, false); return fmaxf(__uint_as_float(rr[0]), __uint_as_float(rr[1])); }
__device__ __forceinline__ float xhalf_sum(float v) { auto rr = __builtin_amdgcn_permlane32_swap(__float_as_uint(v), __float_as_uint(v), false, false); return __uint_as_float(rr[0]) + __uint_as_float(rr[1]); }

template <int DQK>
__device__ __forceinline__ void attn_qk(const LAS unsigned char* kb, int kfo, const bf16x8 (&qf)[DQK / 16], f32x16& p0, f32x16& p1) {
    constexpr int ND0 = DQK / 16;
    bf16x8 ka[ND0], kc[ND0];
#pragma unroll
    for (int d0 = 0; d0 < ND0; ++d0) { ka[d0] = *(const LAS bf16x8*)(kb + kfo + d0 * 2048); kc[d0] = *(const LAS bf16x8*)(kb + kfo + d0 * 2048 + 512); }
    __builtin_amdgcn_sched_barrier(0);
#pragma unroll
    for (int r = 0; r < 16; ++r) { p0[r] = 0.f; p1[r] = 0.f; }
#pragma unroll
    for (int d0 = 0; d0 < ND0; ++d0) {
        p0 = __builtin_amdgcn_mfma_f32_32x32x16_bf16(ka[d0], qf[d0], p0, 0, 0, 0);
        p1 = __builtin_amdgcn_mfma_f32_32x32x16_bf16(kc[d0], qf[d0], p1, 0, 0, 0);
    }
}
template <bool ALIBI>
__device__ __forceinline__ void attn_sv(const LAS unsigned char* kb, int vfo, f32x16& p0, f32x16& p1, float& m, float& l, f32x16& o0, f32x16& o1, int hi, int tq, int kpos0, float slope2, bool causal) {
    s16x4 vlo[8], vhi[8];
    { const unsigned va = (unsigned)(uintptr_t)(kb + vfo);
#pragma unroll
      for (int i = 0; i < 8; ++i) {
        asm volatile("ds_read_b64_tr_b16 %0, %1 offset:%c2" : "=&v"(vlo[i]) : "v"(va), "i"((i >> 2) * 4096 + (i & 3) * 1024) : "memory");
        asm volatile("ds_read_b64_tr_b16 %0, %1 offset:%c2" : "=&v"(vhi[i]) : "v"(va), "i"((i >> 2) * 4096 + (i & 3) * 1024 + 512) : "memory"); } }
    const int krel = kpos0 + 4 * hi - tq;
    if (ALIBI) { const float bb = slope2 * (float)krel;
#pragma unroll
        for (int r = 0; r < 16; ++r) { const float c = (float)((r & 3) + 8 * (r >> 2)); p0[r] += fmaf(slope2, c, bb); p1[r] += fmaf(slope2, c + 32.f, bb); } }
    if (causal) {
#pragma unroll
        for (int r = 0; r < 16; ++r) { const int kv = krel + (r & 3) + 8 * (r >> 2); if (kv > 0) p0[r] = -INFINITY; if (kv + 32 > 0) p1[r] = -INFINITY; } }
    float rm = fmaxf(p0[0], p1[0]);
#pragma unroll
    for (int r = 1; r < 16; ++r) rm = fmaxf(rm, fmaxf(p0[r], p1[r]));
    rm = xhalf_max(rm);
    const float mn = fmaxf(m, rm), alpha = __builtin_amdgcn_exp2f(m - mn);
    m = mn;
    float ls = 0.f;
#pragma unroll
    for (int r = 0; r < 16; ++r) { p0[r] = __builtin_amdgcn_exp2f(p0[r] - mn); p1[r] = __builtin_amdgcn_exp2f(p1[r] - mn); ls += p0[r] + p1[r]; }
    l = l * alpha + ls;
#pragma unroll
    for (int r = 0; r < 16; ++r) { o0[r] *= alpha; o1[r] *= alpha; }
    const u32x4 pw0 = (u32x4){pg8::cvt_pk_bf16(p0[0], p0[1]), pg8::cvt_pk_bf16(p0[2], p0[3]), pg8::cvt_pk_bf16(p0[4], p0[5]), pg8::cvt_pk_bf16(p0[6], p0[7])};
    const u32x4 pw1 = (u32x4){pg8::cvt_pk_bf16(p0[8], p0[9]), pg8::cvt_pk_bf16(p0[10], p0[11]), pg8::cvt_pk_bf16(p0[12], p0[13]), pg8::cvt_pk_bf16(p0[14], p0[15])};
    const u32x4 pw2 = (u32x4){pg8::cvt_pk_bf16(p1[0], p1[1]), pg8::cvt_pk_bf16(p1[2], p1[3]), pg8::cvt_pk_bf16(p1[4], p1[5]), pg8::cvt_pk_bf16(p1[6], p1[7])};
    const u32x4 pw3 = (u32x4){pg8::cvt_pk_bf16(p1[8], p1[9]), pg8::cvt_pk_bf16(p1[10], p1[11]), pg8::cvt_pk_bf16(p1[12], p1[13]), pg8::cvt_pk_bf16(p1[14], p1[15])};
    asm volatile("s_waitcnt lgkmcnt(0)" ::: "memory"); __builtin_amdgcn_sched_barrier(0);
#define ATT_VF(i) (bf16x8){vlo[i][0], vlo[i][1], vlo[i][2], vlo[i][3], vhi[i][0], vhi[i][1], vhi[i][2], vhi[i][3]}
    o0 = __builtin_amdgcn_mfma_f32_32x32x16_bf16(ATT_VF(0), __builtin_bit_cast(bf16x8, pw0), o0, 0, 0, 0);
    o1 = __builtin_amdgcn_mfma_f32_32x32x16_bf16(ATT_VF(4), __builtin_bit_cast(bf16x8, pw0), o1, 0, 0, 0);
    o0 = __builtin_amdgcn_mfma_f32_32x32x16_bf16(ATT_VF(1), __builtin_bit_cast(bf16x8, pw1), o0, 0, 0, 0);
    o1 = __builtin_amdgcn_mfma_f32_32x32x16_bf16(ATT_VF(5), __builtin_bit_cast(bf16x8, pw1), o1, 0, 0, 0);
    o0 = __builtin_amdgcn_mfma_f32_32x32x16_bf16(ATT_VF(2), __builtin_bit_cast(bf16x8, pw2), o0, 0, 0, 0);
    o1 = __builtin_amdgcn_mfma_f32_32x32x16_bf16(ATT_VF(6), __builtin_bit_cast(bf16x8, pw2), o1, 0, 0, 0);
    o0 = __builtin_amdgcn_mfma_f32_32x32x16_bf16(ATT_VF(3), __builtin_bit_cast(bf16x8, pw3), o0, 0, 0, 0);
    o1 = __builtin_amdgcn_mfma_f32_32x32x16_bf16(ATT_VF(7), __builtin_bit_cast(bf16x8, pw3), o1, 0, 0, 0);
#undef ATT_VF
}
template <int DQK, bool ALIBI>
__device__ __forceinline__ void attn_tile(const LAS unsigned char* kb, int kfo, int vfo, const bf16x8 (&qf)[DQK / 16], float& m, float& l, f32x16& o0, f32x16& o1, int hi, int tq, int kpos0, float slope2, bool causal) {
    f32x16 p0, p1;
    attn_qk<DQK>(kb, kfo, qf, p0, p1);
    attn_sv<ALIBI>(kb, vfo, p0, p1, m, l, o0, o1, hi, tq, kpos0, slope2, causal);
}
#define ATT_ISSUE(t, bo) do { \
        for (int c_ = wid; c_ < NCH; c_ += 8) __builtin_amdgcn_global_load_lds((const unsigned*)(ksrc + (size_t)(t) * 64 * ldk + c_ * 8), (LAS unsigned*)(lds + (bo) + c_ * 1024), 16, 0, 0); \
        __builtin_amdgcn_global_load_lds((const unsigned*)(vsrc + (size_t)(t) * 64 * ldv), (LAS unsigned*)(lds + (bo) + KBYTES + wid * 1024), 16, 0, 0); } while (0)

template <int DQK, bool MOBA_OWN>
__device__ __forceinline__ void attn_unit(LAS unsigned char* lds, int b, int h, int qb, const bf16_t* Qp, int ldq, const bf16_t* Kp, int ldk, const bf16_t* Vp, int ldv, bf16_t* Op, int ldo, const bf16_t* PO, const f32x2* PML) {
    constexpr int NCH = DQK / 8, KBYTES = NCH * 1024, BUFB = KBYTES + 8192, ND0 = DQK / 16;
    int tid_ = threadIdx.x; asm volatile("" : "+v"(tid_));
    const int lane = tid_ & 63, r32 = lane & 31, hi = lane >> 5, wid = __builtin_amdgcn_readfirstlane(tid_ >> 6);
    const size_t rowbase = (size_t)b * SEQ; const int q0 = qb * 256, T0 = MOBA_OWN ? 4 * qb : 0, T1 = 4 * (qb + 1), tq = q0 + wid * 32 + r32;
    const bf16_t* ksrc = Kp + (rowbase + lane) * ldk + h * DQK;
    const bf16_t* vsrc = Vp + (rowbase + 16 * (wid & 3) + (lane >> 2)) * ldv + h * 64 + (wid >> 2) * 32 + (lane & 3) * 8;
    ATT_ISSUE(T0, 0); ATT_ISSUE(T0 + 1, BUFB);
    bf16x8 qf[ND0];
    { const bf16_t* qrow = Qp + (rowbase + tq) * ldq + h * DQK + hi * 8;
#pragma unroll
      for (int d0 = 0; d0 < ND0; ++d0) qf[d0] = *(const bf16x8*)(qrow + d0 * 16); }
    const float slope2 = MOBA_OWN ? exp2f(-(float)(h + 1)) * LOG2E : 0.f;
    float m = -1e30f, l = 0.f;
    f32x16 o0, o1;
#pragma unroll
    for (int r = 0; r < 16; ++r) { o0[r] = 0.f; o1[r] = 0.f; }
    const int kfo = hi * 1024 + r32 * 16;
    const int vfo = KBYTES + ((lane >> 4) & 1) * 32 + (lane & 3) * 8 + (4 * hi + ((lane & 15) >> 2)) * 64;
#define ATT_BAR() asm volatile("s_waitcnt vmcnt(0) lgkmcnt(0)\n\ts_barrier" ::: "memory")
    int b0 = 0, b1 = BUFB, b2 = 2 * BUFB;
    f32x16 pA0, pA1, pB0, pB1;
    ATT_BAR();
    attn_qk<DQK>(lds + b0, kfo, qf, pA0, pA1);
#pragma unroll 1
    for (int t = T0; t < T1; t += 2) {
        if (t + 2 < T1) ATT_ISSUE(t + 2, b2);
        attn_qk<DQK>(lds + b1, kfo, qf, pB0, pB1);
        attn_sv<MOBA_OWN>(lds + b0, vfo, pA0, pA1, m, l, o0, o1, hi, tq, 64 * t, slope2, t >= T1 - 4);
        ATT_BAR();
        { const int x = b0; b0 = b1; b1 = b2; b2 = x; }
        if (t + 3 < T1) ATT_ISSUE(t + 3, b2);
        if (t + 2 < T1) attn_qk<DQK>(lds + b1, kfo, qf, pA0, pA1);
        attn_sv<MOBA_OWN>(lds + b0, vfo, pB0, pB1, m, l, o0, o1, hi, tq, 64 * (t + 1), slope2, t + 1 >= T1 - 4);
        ATT_BAR();
        { const int x = b0; b0 = b1; b1 = b2; b2 = x; }
    }
#undef ATT_BAR
    float lt = xhalf_sum(l);
    if (MOBA_OWN) {
        const int nsel = qb < 3 ? qb : 3;
        const size_t pidx = ((rowbase + tq) * 8 + h) * 3;
        float ms[3], ws[3], M = m;
#pragma unroll
        for (int sIdx = 0; sIdx < 3; ++sIdx) { ms[sIdx] = -1e30f; ws[sIdx] = 0.f; if (sIdx < nsel) { const f32x2 ml = PML[(pidx + sIdx) * 16]; ms[sIdx] = ml[0]; ws[sIdx] = ml[1]; M = fmaxf(M, ml[0]); } }
        const float w0 = __builtin_amdgcn_exp2f(m - M);
        lt *= w0;
#pragma unroll
        for (int r = 0; r < 16; ++r) { o0[r] *= w0; o1[r] *= w0; }
#pragma unroll
        for (int sIdx = 0; sIdx < 3; ++sIdx) if (sIdx < nsel) {
            const float w = ws[sIdx] * __builtin_amdgcn_exp2f(ms[sIdx] - M); lt += w;
            const bf16_t* po = PO + (pidx + sIdx) * 64 + 4 * hi;
#pragma unroll
            for (int r4 = 0; r4 < 4; ++r4) { const u32x2 a = *(const u32x2*)(po + 8 * r4), c = *(const u32x2*)(po + 32 + 8 * r4);
                o0[4 * r4] += w * bflo(a.x); o0[4 * r4 + 1] += w * bfhi(a.x); o0[4 * r4 + 2] += w * bflo(a.y); o0[4 * r4 + 3] += w * bfhi(a.y);
                o1[4 * r4] += w * bflo(c.x); o1[4 * r4 + 1] += w * bfhi(c.x); o1[4 * r4 + 2] += w * bflo(c.y); o1[4 * r4 + 3] += w * bfhi(c.y); } }
    }
    const float inv = 1.f / lt;
    bf16_t* orow = Op + (rowbase + tq) * ldo + h * 64 + 4 * hi;
#pragma unroll
    for (int r4 = 0; r4 < 4; ++r4) {
        u32x2 w0_, w1_;
        w0_.x = pg8::cvt_pk_bf16(o0[4 * r4] * inv, o0[4 * r4 + 1] * inv); w0_.y = pg8::cvt_pk_bf16(o0[4 * r4 + 2] * inv, o0[4 * r4 + 3] * inv);
        w1_.x = pg8::cvt_pk_bf16(o1[4 * r4] * inv, o1[4 * r4 + 1] * inv); w1_.y = pg8::cvt_pk_bf16(o1[4 * r4 + 2] * inv, o1[4 * r4 + 3] * inv);
        *(u32x2*)(orow + 8 * r4) = w0_; *(u32x2*)(orow + 32 + 8 * r4) = w1_;
    }
    asm volatile("s_waitcnt lgkmcnt(0)\n\ts_barrier" ::: "memory");
}
__device__ __forceinline__ void moba_sel_unit(LAS unsigned char* lds, int b, int h, int j, int slo, int shi, const bf16_t* Qp, const bf16_t* Kp, const bf16_t* Vp, int ldk, const unsigned* SEL, bf16_t* PO, f32x2* PML) {
    constexpr int DQK = 64, NCH = 8, KBYTES = 8192, BUFB = 16384, ldv = INCP; (void)ldv;
    int tid_ = threadIdx.x; asm volatile("" : "+v"(tid_));
    const int lane = tid_ & 63, r32 = lane & 31, hi = lane >> 5, wid = __builtin_amdgcn_readfirstlane(tid_ >> 6);
    const size_t rowbase = (size_t)b * SEQ;
    const bf16_t* ksrc = Kp + (rowbase + lane) * ldk + h * DQK;
    const bf16_t* vsrc = Vp + (rowbase + 16 * (wid & 3) + (lane >> 2)) * ldk + h * 64 + (wid >> 2) * 32 + (lane & 3) * 8;
#pragma unroll
    for (int tt = 0; tt < 4; ++tt) ATT_ISSUE(4 * j + tt, tt * BUFB);
    LAS unsigned short* list = (LAS unsigned short*)(lds + 4 * BUFB);
    LAS int* cnt = (LAS int*)(lds + 4 * BUFB + 8192);
    if (tid_ == 0) *cnt = 0;
    __syncthreads();
    const int nsrc = (shi - slo) * 256;
    for (int i = tid_; i < nsrc; i += NTHR) {
        const unsigned sm = SEL[(rowbase + (size_t)slo * 256 + i) * 8 + h];
        const bool f = ((sm >> j) & 1u) != 0u;
        const unsigned long long bal = __ballot(f);
        const int rank = __builtin_amdgcn_mbcnt_hi((unsigned)(bal >> 32), __builtin_amdgcn_mbcnt_lo((unsigned)bal, 0u));
        int base = 0;
        if (lane == 0) base = __hip_atomic_fetch_add(cnt, (int)__builtin_popcountll(bal), __ATOMIC_RELAXED, __HIP_MEMORY_SCOPE_WORKGROUP);
        base = __builtin_amdgcn_readfirstlane(base);
        if (f) list[base + rank] = (unsigned short)i;
    }
    asm volatile("s_waitcnt vmcnt(0)" ::: "memory");
    __syncthreads();
    const int n = *cnt, nch = (n + 31) >> 5;
    const float slope2 = exp2f(-(float)(h + 1)) * LOG2E;
    const int kfo = hi * 1024 + r32 * 16;
    const int vfo = KBYTES + ((lane >> 4) & 1) * 32 + (lane & 3) * 8 + (4 * hi + ((lane & 15) >> 2)) * 64;
    bf16x8 qn[4]; unsigned smn = 0u; int tqn = 0; bool validn = false;
#define SEL_FETCH(ch_) do { const int e_ = (ch_) * 32 + r32; validn = e_ < n; tqn = slo * 256 + (int)list[validn ? e_ : n - 1]; \
        const bf16_t* qrow_ = Qp + (rowbase + tqn) * INCP + h * DQK + hi * 8; \
        _Pragma("unroll") for (int d0 = 0; d0 < 4; ++d0) qn[d0] = *(const bf16x8*)(qrow_ + d0 * 16); \
        smn = SEL[(rowbase + tqn) * 8 + h]; } while (0)
    if (wid < nch) SEL_FETCH(wid);
#pragma unroll 1
    for (int ch = wid; ch < nch; ch += 8) {
        const bool valid = validn; const int tq = tqn; const unsigned sm = smn;
        bf16x8 qf[4];
#pragma unroll
        for (int d0 = 0; d0 < 4; ++d0) qf[d0] = qn[d0];
        if (ch + 8 < nch) SEL_FETCH(ch + 8);
        float m = -1e30f, l = 0.f;
        f32x16 o0, o1;
#pragma unroll
        for (int r = 0; r < 16; ++r) { o0[r] = 0.f; o1[r] = 0.f; }
        { f32x16 pA0, pA1, pB0, pB1;
          attn_qk<64>(lds, kfo, qf, pA0, pA1);
          attn_qk<64>(lds + BUFB, kfo, qf, pB0, pB1);
          attn_sv<true>(lds, vfo, pA0, pA1, m, l, o0, o1, hi, tq, 256 * j, slope2, false);
          attn_qk<64>(lds + 2 * BUFB, kfo, qf, pA0, pA1);
          attn_sv<true>(lds + BUFB, vfo, pB0, pB1, m, l, o0, o1, hi, tq, 256 * j + 64, slope2, false);
          attn_qk<64>(lds + 3 * BUFB, kfo, qf, pB0, pB1);
          attn_sv<true>(lds + 2 * BUFB, vfo, pA0, pA1, m, l, o0, o1, hi, tq, 256 * j + 128, slope2, false);
          attn_sv<true>(lds + 3 * BUFB, vfo, pB0, pB1, m, l, o0, o1, hi, tq, 256 * j + 192, slope2, false); }
        const float lt = xhalf_sum(l), inv = 1.f / lt;
        if (valid) {
            const size_t pidx = ((rowbase + tq) * 8 + h) * 3 + __builtin_popcount(sm & ((1u << j) - 1u));
            if (hi == 0) PML[pidx * 16] = (f32x2){m, lt};
            bf16_t* po = PO + pidx * 64 + 4 * hi;
#pragma unroll
            for (int r4 = 0; r4 < 4; ++r4) {
                u32x2 w0_, w1_;
                w0_.x = pg8::cvt_pk_bf16(o0[4 * r4] * inv, o0[4 * r4 + 1] * inv); w0_.y = pg8::cvt_pk_bf16(o0[4 * r4 + 2] * inv, o0[4 * r4 + 3] * inv);
                w1_.x = pg8::cvt_pk_bf16(o1[4 * r4] * inv, o1[4 * r4 + 1] * inv); w1_.y = pg8::cvt_pk_bf16(o1[4 * r4 + 2] * inv, o1[4 * r4 + 3] * inv);
                *(u32x2*)(po + 8 * r4) = w0_; *(u32x2*)(po + 32 + 8 * r4) = w1_;
            }
        }
    }
#undef SEL_FETCH
    __syncthreads();
}
#undef ATT_ISSUE
__device__ __forceinline__ void mla_phase(const Frame& F, const bf16_t* QB, const bf16_t* KB, const bf16_t* VB, bf16_t* Op) {
    for (int u = 2 * F.vcu; u < 512; u += 2 * F.G) {
#pragma unroll 1
        for (int k = 0; k < 2; ++k) { const int uu = u + k, bh = uu >> 5, w = uu & 31, qb = (w & 1) ? (w >> 1) : 31 - (w >> 1);
            attn_unit<96, false>(F.lds, bh >> 3, bh & 7, qb, QB, 768, KB, 768, VB, 512, Op, 1024, nullptr, nullptr); }
    }
}
__device__ const unsigned short SEL_TAB[256][5] = {
    {0,1376,1776,65535,65535}, {1,1377,1777,65535,65535}, {2,1378,1778,65535,65535}, {3,1379,1779,65535,65535},
    {4,1380,1780,65535,65535}, {5,1381,1781,65535,65535}, {6,1382,1782,65535,65535}, {7,1383,1783,65535,65535},
    {8,1384,1784,65535,65535}, {9,1385,1785,65535,65535}, {10,1386,1786,65535,65535}, {11,1387,1787,65535,65535},
    {12,1388,1788,65535,65535}, {13,1389,1789,65535,65535}, {14,1390,1790,65535,65535}, {15,1391,1791,65535,65535},
    {16,96,1552,1808,65535}, {17,97,1553,1809,65535}, {18,98,1554,1810,65535}, {19,99,1555,1811,65535},
    {20,100,1556,1812,65535}, {21,101,1557,1813,65535}, {22,102,1558,1814,65535}, {23,103,1559,1815,65535},
    {24,104,1560,1816,65535}, {25,105,1561,1817,65535}, {26,106,1562,1818,65535}, {27,107,1563,1819,65535},
    {28,108,1564,1820,65535}, {29,109,1565,1821,65535}, {30,110,1566,1822,65535}, {31,111,1567,1823,65535},
    {32,1232,1568,1824,65535}, {33,1233,1569,1825,65535}, {34,1234,1570,1826,65535}, {35,1235,1571,1827,65535},
    {36,1236,1572,1828,65535}, {37,1237,1573,1829,65535}, {38,1238,1574,1830,65535}, {39,1239,1575,1831,65535},
    {40,1240,1576,1832,65535}, {41,1241,1577,1833,65535}, {42,1242,1578,1834,65535}, {43,1243,1579,1835,65535},
    {44,1244,1580,1836,65535}, {45,1245,1581,1837,65535}, {46,1246,1582,1838,65535}, {47,1247,1583,1839,65535},
    {48,1088,688,1584,1840}, {49,1089,689,1585,1841}, {50,1090,690,1586,1842}, {51,1091,691,1587,1843},
    {52,1092,692,1588,1844}, {53,1093,693,1589,1845}, {54,1094,694,1590,1846}, {55,1095,695,1591,1847},
    {56,1096,696,1592,1848}, {57,1097,697,1593,1849}, {58,1098,698,1594,1850}, {59,1099,699,1595,1851},
    {60,1100,700,1596,1852}, {61,1101,701,1597,1853}, {62,1102,702,1598,1854}, {63,1103,703,1599,1855},
    {512,1104,704,1600,1856}, {513,1105,705,1601,1857}, {514,1106,706,1602,1858}, {515,1107,707,1603,1859},
    {516,1108,708,1604,1860}, {517,1109,709,1605,1861}, {518,1110,710,1606,1862}, {519,1111,711,1607,1863},
    {520,1112,712,1608,1864}, {521,1113,713,1609,1865}, {522,1114,714,1610,1866}, {523,1115,715,1611,1867},
    {524,1116,716,1612,1868}, {525,1117,717,1613,1869}, {526,1118,718,1614,1870}, {527,1119,719,1615,1871},
    {528,1120,720,1616,1872}, {529,1121,721,1617,1873}, {530,1122,722,1618,1874}, {531,1123,723,1619,1875},
    {532,1124,724,1620,1876}, {533,1125,725,1621,1877}, {534,1126,726,1622,1878}, {535,1127,727,1623,1879},
    {536,1128,728,1624,1880}, {537,1129,729,1625,1881}, {538,1130,730,1626,1882}, {539,1131,731,1627,1883},
    {540,1132,732,1628,1884}, {541,1133,733,1629,1885}, {542,1134,734,1630,1886}, {543,1135,735,1631,1887},
    {544,1136,736,1632,1888}, {545,1137,737,1633,1889}, {546,1138,738,1634,1890}, {547,1139,739,1635,1891},
    {548,1140,740,1636,1892}, {549,1141,741,1637,1893}, {550,1142,742,1638,1894}, {551,1143,743,1639,1895},
    {552,1144,744,1640,1896}, {553,1145,745,1641,1897}, {554,1146,746,1642,1898}, {555,1147,747,1643,1899},
    {556,1148,748,1644,1900}, {557,1149,749,1645,1901}, {558,1150,750,1646,1902}, {559,1151,751,1647,1903},
    {560,1152,1296,1648,1904}, {561,1153,1297,1649,1905}, {562,1154,1298,1650,1906}, {563,1155,1299,1651,1907},
    {564,1156,1300,1652,1908}, {565,1157,1301,1653,1909}, {566,1158,1302,1654,1910}, {567,1159,1303,1655,1911},
    {568,1160,1304,1656,1912}, {569,1161,1305,1657,1913}, {570,1162,1306,1658,1914}, {571,1163,1307,1659,1915},
    {572,1164,1308,1660,1916}, {573,1165,1309,1661,1917}, {574,1166,1310,1662,1918}, {575,1167,1311,1663,1919},
    {576,1168,1312,1664,1920}, {577,1169,1313,1665,1921}, {578,1170,1314,1666,1922}, {579,1171,1315,1667,1923},
    {580,1172,1316,1668,1924}, {581,1173,1317,1669,1925}, {582,1174,1318,1670,1926}, {583,1175,1319,1671,1927},
    {584,1176,1320,1672,1928}, {585,1177,1321,1673,1929}, {586,1178,1322,1674,1930}, {587,1179,1323,1675,1931},
    {588,1180,1324,1676,1932}, {589,1181,1325,1677,1933}, {590,1182,1326,1678,1934}, {591,1183,1327,1679,1935},
    {592,1184,1328,1680,1936}, {593,1185,1329,1681,1937}, {594,1186,1330,1682,1938}, {595,1187,1331,1683,1939},
    {596,1188,1332,1684,1940}, {597,1189,1333,1685,1941}, {598,1190,1334,1686,1942}, {599,1191,1335,1687,1943},
    {600,1192,1336,1688,1944}, {601,1193,1337,1689,1945}, {602,1194,1338,1690,1946}, {603,1195,1339,1691,1947},
    {604,1196,1340,1692,1948}, {605,1197,1341,1693,1949}, {606,1198,1342,1694,1950}, {607,1199,1343,1695,1951},
    {608,1200,1344,1696,1952}, {609,1201,1345,1697,1953}, {610,1202,1346,1698,1954}, {611,1203,1347,1699,1955},
    {612,1204,1348,1700,1956}, {613,1205,1349,1701,1957}, {614,1206,1350,1702,1958}, {615,1207,1351,1703,1959},
    {616,1208,1352,1704,1960}, {617,1209,1353,1705,1961}, {618,1210,1354,1706,1962}, {619,1211,1355,1707,1963},
    {620,1212,1356,1708,1964}, {621,1213,1357,1709,1965}, {622,1214,1358,1710,1966}, {623,1215,1359,1711,1967},
    {624,1216,1360,1712,1968}, {625,1217,1361,1713,1969}, {626,1218,1362,1714,1970}, {627,1219,1363,1715,1971},
    {628,1220,1364,1716,1972}, {629,1221,1365,1717,1973}, {630,1222,1366,1718,1974}, {631,1223,1367,1719,1975},
    {632,1224,1368,1720,1976}, {633,1225,1369,1721,1977}, {634,1226,1370,1722,1978}, {635,1227,1371,1723,1979},
    {636,1228,1372,1724,1980}, {637,1229,1373,1725,1981}, {638,1230,1374,1726,1982}, {639,1231,1375,1727,1983},
    {64,1024,1248,1728,1984}, {65,1025,1249,1729,1985}, {66,1026,1250,1730,1986}, {67,1027,1251,1731,1987},
    {68,1028,1252,1732,1988}, {69,1029,1253,1733,1989}, {70,1030,1254,1734,1990}, {71,1031,1255,1735,1991},
    {72,1032,1256,1736,1992}, {73,1033,1257,1737,1993}, {74,1034,1258,1738,1994}, {75,1035,1259,1739,1995},
    {76,1036,1260,1740,1996}, {77,1037,1261,1741,1997}, {78,1038,1262,1742,1998}, {79,1039,1263,1743,1999},
    {640,1040,1264,1744,2000}, {641,1041,1265,1745,2001}, {642,1042,1266,1746,2002}, {643,1043,1267,1747,2003},
    {644,1044,1268,1748,2004}, {645,1045,1269,1749,2005}, {646,1046,1270,1750,2006}, {647,1047,1271,1751,2007},
    {648,1048,1272,1752,2008}, {649,1049,1273,1753,2009}, {650,1050,1274,1754,2010}, {651,1051,1275,1755,2011},
    {652,1052,1276,1756,2012}, {653,1053,1277,1757,2013}, {654,1054,1278,1758,2014}, {655,1055,1279,1759,2015},
    {656,1056,1280,1760,2016}, {657,1057,1281,1761,2017}, {658,1058,1282,1762,2018}, {659,1059,1283,1763,2019},
    {660,1060,1284,1764,2020}, {661,1061,1285,1765,2021}, {662,1062,1286,1766,2022}, {663,1063,1287,1767,2023},
    {664,1064,1288,1768,2024}, {665,1065,1289,1769,2025}, {666,1066,1290,1770,2026}, {667,1067,1291,1771,2027},
    {668,1068,1292,1772,2028}, {669,1069,1293,1773,2029}, {670,1070,1294,1774,2030}, {671,1071,1295,1775,2031},
    {672,1072,80,1536,1792}, {673,1073,81,1537,1793}, {674,1074,82,1538,1794}, {675,1075,83,1539,1795},
    {676,1076,84,1540,1796}, {677,1077,85,1541,1797}, {678,1078,86,1542,1798}, {679,1079,87,1543,1799},
    {680,1080,88,1544,1800}, {681,1081,89,1545,1801}, {682,1082,90,1546,1802}, {683,1083,91,1547,1803},
    {684,1084,92,1548,1804}, {685,1085,93,1549,1805}, {686,1086,94,1550,1806}, {687,1087,95,1551,1807},
};
constexpr int SEL_TAB_W = 5;
__device__ __forceinline__ void moba_sel_phase(const Frame& F, const bf16_t* PROJ, const unsigned* SEL, bf16_t* PO, f32x2* PML) {
    if (F.G == 256) {
#pragma unroll 1
        for (int i = 0; i < SEL_TAB_W; ++i) { const int code = SEL_TAB[F.vcu][i]; if (code == 0xFFFF) break;
            const int p = code >> 9, j = (code >> 4) & 31, bh = code & 15, slo = (j + 1 > 8 * p) ? j + 1 : 8 * p, shi = 8 * p + 8;
            moba_sel_unit(F.lds, bh >> 3, bh & 7, j, slo, shi, PROJ + C_QA, PROJ + C_KA, PROJ + C_VA, INCP, SEL, PO, PML); }
    } else {
#pragma unroll 1
        for (int u = (int)blockIdx.x; u < 16 * 76; u += F.G) {
            int p = 0; while (16 * (4 * (p + 1) * (p + 1) + 3 * (p + 1)) <= u) ++p;
            const int r = u - 16 * (4 * p * p + 3 * p), j = r >> 4, bh = r & 15, slo = (j + 1 > 8 * p) ? j + 1 : 8 * p, shi = 8 * p + 8;
            moba_sel_unit(F.lds, bh >> 3, bh & 7, j, slo, shi, PROJ + C_QA, PROJ + C_KA, PROJ + C_VA, INCP, SEL, PO, PML); }
    }
}
__device__ __forceinline__ void moba_own_phase(const Frame& F, const bf16_t* PROJ, bf16_t* Op, const bf16_t* PO, const f32x2* PML) {
#pragma unroll 1
    for (int u = F.vcu; u < 512; u += F.G) { const int bh = u >> 5, qb = u & 31;
        attn_unit<64, true>(F.lds, bh >> 3, bh & 7, qb, PROJ + C_QA, INCP, PROJ + C_KA, INCP, PROJ + C_VA, INCP, Op, 1024, PO, PML); }
}

constexpr int NPH_L = 16;
__global__ void __launch_bounds__(NTHR, 2) mk(Params p) {
    extern __shared__ __attribute__((aligned(16))) unsigned char lds_raw[];
    Frame F;
    F.lds = (LAS unsigned char*)lds_raw;
    F.tid = threadIdx.x; F.lane = F.tid & 63; F.wave = __builtin_amdgcn_readfirstlane(F.tid >> 6);
    F.G = gridDim.x; { const int bx = blockIdx.x; F.vcu = (F.G % 8 == 0) ? (bx % 8) * (F.G / 8) + bx / 8 : bx; }
    volatile LAS unsigned* MISC = (volatile LAS unsigned*)(F.lds + MISC_OFF);
    if (F.tid < 32) MISC[F.tid] = 0u;
    __syncthreads();
    unsigned char* ws = p.ws;
    unsigned* ctl = (unsigned*)(ws + WS_CTL);
    XcdBarrier bar = xcd_barrier_post(ctl + CW_BAR, MISC + 8);
    const int lo = p.ph_lo, hi = p.ph_hi;
#define IN(k) (lo <= (k) && (k) < hi)
#define SEAM(k) do { if (IN(k) && IN((k) + 1)) xcd_barrier(bar); } while (0)
    bf16_t* WinT = (bf16_t*)(ws + WS_WIN);
    bf16_t* XB = (bf16_t*)(ws + WS_XB);
    bf16_t* PROJ = (bf16_t*)(ws + WS_PROJ);
    bf16_t* WuqT = (bf16_t*)(ws + WS_WUQ); bf16_t* WukvT = (bf16_t*)(ws + WS_WUKV);
    f32x2* CS = (f32x2*)(ws + WS_CS); float* KM = (float*)(ws + WS_KM); unsigned* SEL = (unsigned*)(ws + WS_SEL);
    bf16_t* CQN = (bf16_t*)(ws + WS_CQN); bf16_t* CKVN = (bf16_t*)(ws + WS_CKVN);
    bf16_t* WpaT = (bf16_t*)(ws + WS_WPA); bf16_t* WpbT = (bf16_t*)(ws + WS_WPB); bf16_t* WoutT = (bf16_t*)(ws + WS_WOUT);
    bf16_t* TMP = (bf16_t*)(ws + WS_TMP); bf16_t* MRG = (bf16_t*)(ws + WS_MRG); bf16_t* PRE = (bf16_t*)(ws + WS_PRE); bf16_t* X1B = (bf16_t*)(ws + WS_X1B);
    bf16_t* WrtT = (bf16_t*)(ws + WS_WRT); bf16_t* WsguT = (bf16_t*)(ws + WS_WSGU); bf16_t* WsdT = (bf16_t*)(ws + WS_WSD); bf16_t* WeguT = (bf16_t*)(ws + WS_WEGU); bf16_t* WedT = (bf16_t*)(ws + WS_WED);
    float* LOGITS = (float*)(ws + WS_LOG); bf16_t* HS = (bf16_t*)(ws + WS_HS); bf16_t* SH = (bf16_t*)(ws + WS_SH);
    int* TOPE = (int*)(ws + WS_TOPE); float* TOPW = (float*)(ws + WS_TOPW); int* APOS = (int*)(ws + WS_APOS); int* ROWA = (int*)(ws + WS_ROWA);
    bf16_t* PO = (bf16_t*)(ws + WS_PO); f32x2* PML = (f32x2*)(ws + WS_PML);
    bf16_t* HE = (bf16_t*)(ws + WS_HE); bf16_t* Yb = (bf16_t*)(ws + WS_Y); int* HIST = (int*)(ws + WS_HIST);
    LAS int* t_off = (LAS int*)(F.lds + TAB_OFF); LAS int* t_toff = t_off + 260;
    bf16_t* QB = (bf16_t*)(ws + WS_QB); bf16_t* KB = (bf16_t*)(ws + WS_KB); bf16_t* VB = (bf16_t*)(ws + WS_VB); bf16_t* OAB = (bf16_t*)(ws + WS_OAB);
    const int gw = F.vcu * NWAVES + F.wave, NGW = F.G * NWAVES;

    if (IN(0)) {
        LAS float* scr = (LAS float*)(F.lds + F.wave * 16384);
        constexpr int I_IN = (DM / 64) * (INC / 32);
        for (int it = gw; it < DEPTH * I_IN; it += NGW) { const int l = it / I_IN, r = it % I_IN;
            transpose_item(p.in[1] + (size_t)l * DM * INC, DM, INC, WinT + (size_t)l * SZ_WIN, DM, RowId{}, scr, r, F.lane); }
        { constexpr int I_UQ = (QL / 64) * (768 / 32), I_UKV = (KVL / 64) * (1024 / 32);
          for (int it = gw; it < DEPTH * (I_UQ + I_UKV); it += NGW) { const int l = it / (I_UQ + I_UKV), r = it % (I_UQ + I_UKV);
            if (r < I_UQ) transpose_item(p.in[4] + (size_t)l * QL * 768, QL, 768, WuqT + (size_t)l * SZ_WUQ, QL, RowQ{}, scr, r, F.lane);
            else transpose_item(p.in[6] + (size_t)l * KVL * 1024, KVL, 1024, WukvT + (size_t)l * SZ_WUKV, KVL, RowId{}, scr, r - I_UQ, F.lane); } }
        { constexpr int I_P = (512 / 64) * (DM / 32), I_O = (DM / 64) * (DM / 32), I_ALL = 2 * I_P + I_O;
          for (int it = gw; it < DEPTH * I_ALL; it += NGW) { const int l = it / I_ALL; int r = it % I_ALL;
            if (r < I_P) { transpose_item(p.in[7] + (size_t)l * 512 * DM, 512, DM, WpaT + (size_t)l * 2 * SZ_WP, 1024, RowId{}, scr, r, F.lane); continue; } r -= I_P;
            if (r < I_P) { transpose_item(p.in[8] + (size_t)l * 512 * DM, 512, DM, WpaT + (size_t)l * 2 * SZ_WP + 512, 1024, RowId{}, scr, r, F.lane); continue; } r -= I_P;
            transpose_item(p.in[9] + (size_t)l * DM * DM, DM, DM, WoutT + (size_t)l * SZ_WOUT, DM, RowId{}, scr, r, F.lane); } }
        { constexpr int I_R = (DM / 64) * (NE / 32), I_G = (DM / 64) * (DSH / 32), I_D = (DSH / 64) * (DM / 32), I_ALL = I_R + 2 * I_G + I_D;
          for (int it = gw; it < DEPTH * I_ALL; it += NGW) { const int l = it / I_ALL; int r = it % I_ALL;
            if (r < I_R) { transpose_item(p.in[12] + (size_t)l * DM * NE, DM, NE, WrtT + (size_t)l * SZ_WRT, DM, RowId{}, scr, r, F.lane); continue; } r -= I_R;
            if (r < I_G) { transpose_item(p.in[17] + (size_t)l * DM * DSH, DM, DSH, WsguT + (size_t)l * SZ_WSGU, DM, RowGU{0}, scr, r, F.lane); continue; } r -= I_G;
            if (r < I_G) { transpose_item(p.in[18] + (size_t)l * DM * DSH, DM, DSH, WsguT + (size_t)l * SZ_WSGU, DM, RowGU{128}, scr, r, F.lane); continue; } r -= I_G;
            transpose_item(p.in[19] + (size_t)l * DSH * DM, DSH, DM, WsdT + (size_t)l * SZ_WSD, DSH, RowId{}, scr, r, F.lane); } }
        { constexpr int I_G = (DM / 64) * (DE / 64), I_D = (DE / 64) * (DM / 64), I_E = 2 * I_G + I_D;
          LAS unsigned short* scr16 = (LAS unsigned short*)(F.lds + F.wave * 16384);
          for (int it = gw; it < DEPTH * NE * I_E; it += NGW) { const int le = it / I_E; int r = it % I_E;
            if (r < I_G) { transpose_item64(p.in[14] + (size_t)le * DM * DE, DM, DE, WeguT + (size_t)le * 512 * DM, DM, RowGU{0}, scr16, r, F.lane); continue; } r -= I_G;
            if (r < I_G) { transpose_item64(p.in[15] + (size_t)le * DM * DE, DM, DE, WeguT + (size_t)le * 512 * DM, DM, RowGU{128}, scr16, r, F.lane); continue; } r -= I_G;
            transpose_item64(p.in[16] + (size_t)le * DE * DM, DE, DM, WedT + (size_t)le * DM * DE, DE, RowPermD{}, scr16, r, F.lane); } }
        for (int i = blockIdx.x * NTHR + F.tid; i < SEQ * 16; i += F.G * NTHR) { const int pos = i >> 4, k = i & 15;
            const float inv = powf(10000.f, -(float)(2 * k) / 32.f), ang = (float)pos * inv; CS[i] = (f32x2){cosf(ang), sinf(ang)}; }
        for (int i = blockIdx.x * NTHR + F.tid; i < DEPTH * 12288; i += F.G * NTHR) { const int l = i / 12288, r = i % 12288;
            *(u32x4*)(WinT + (size_t)l * SZ_WIN + (size_t)INC * DM + (size_t)r * 8) = (u32x4){0u, 0u, 0u, 0u}; }
        for (int i = blockIdx.x * NTHR + F.tid; i < T * DM / 8; i += F.G * NTHR) { const f32x4 a = *(const f32x4*)(p.in[0] + (size_t)i * 8), b = *(const f32x4*)(p.in[0] + (size_t)i * 8 + 4);
            u32x4 w; w.x = pk2(a[0], a[1]); w.y = pk2(a[2], a[3]); w.z = pk2(b[0], b[1]); w.w = pk2(b[2], b[3]); *(u32x4*)(XB + (size_t)i * 8) = w; }
    }
    SEAM(0);

    {
        const int l = 0; const int pb = 1 + l * NPH_L;
        if (IN(pb + 0)) {
            pg8::Gemm g{XB, WinT + (size_t)l * SZ_WIN, T, INCP, DM, DM, DM}; pg8::StaticOrder S; S.init(T, INCP - 256, F.G, (int)blockIdx.x);
            EpiProj E{PROJ, p.in[2] + (size_t)l * 2 * DM};
            pg8::gemm_phase<EpiProj, pg8::StaticOrder, true>(F.lds, g, S, E);
        }
        SEAM(pb + 0);
        if (IN(pb + 1)) prep_phase(F, PROJ, p.in[3] + (size_t)l * QL, p.in[5] + (size_t)l * KVL, CS, CQN, CKVN, KB, KM);
        SEAM(pb + 1);
        if (IN(pb + 2)) {
            mobasel_phase(F, PROJ, KM, SEL);
            { pg8::Gemm g{CKVN, WukvT + (size_t)l * SZ_WUKV, T, 1024, KVL, KVL, KVL}; pg8::StaticOrder S; S.init(T, 1024, F.G, (int)blockIdx.x);
              EpiKV E{KB, VB}; pg8::gemm_phase<EpiKV, pg8::StaticOrder, true>(F.lds, g, S, E); }
            { pg8::Gemm g{CQN, WuqT + (size_t)l * SZ_WUQ, T, 768, QL, QL, QL}; pg8::StaticOrder S; S.init(T, 768, F.G, (int)blockIdx.x);
              EpiQ E{QB, CS}; pg8::gemm_phase<EpiQ, pg8::StaticOrder, true>(F.lds, g, S, E); }
            { pg8::Gemm g{XB, WinT + (size_t)l * SZ_WIN, T, INCP, DM, DM, DM}; pg8::OffsetOrder S; S.init(T, 256, F.G, (int)((blockIdx.x + 64) % F.G)); S.pn0 = 16;
              EpiProj E{PROJ, p.in[2] + (size_t)l * 2 * DM}; pg8::gemm_phase<EpiProj, pg8::OffsetOrder, true>(F.lds, g, S, E); }
        }
        SEAM(pb + 2);
        if (IN(pb + 3)) {
            mla_phase(F, QB, KB, VB, OAB + 512);
            moba_sel_phase(F, PROJ, SEL, PO, PML);
        }
        SEAM(pb + 3);
        if (IN(pb + 4)) moba_own_phase(F, PROJ, OAB, PO, PML);
        SEAM(pb + 4);
        if (IN(pb + 5)) {
            pg8::Gemm g{OAB, WpaT + (size_t)l * 2 * SZ_WP, T, DM, DM, 1024, 1024}; pg8::StaticOrder S; S.init(T, DM, F.G, (int)blockIdx.x);
            EpiGate2 E{PROJ, MRG}; pg8::gemm_phase<EpiGate2, pg8::StaticOrder, true>(F.lds, g, S, E);
        }
        SEAM(pb + 5);
        if (IN(pb + 6)) {
            pg8::Gemm g{MRG, WoutT + (size_t)l * SZ_WOUT, T, DM, DM, DM, DM}; pg8::StaticOrder S; S.init(T, DM, F.G, (int)blockIdx.x);
            EpiResid E{XB, PRE}; pg8::gemm_phase<EpiResid, pg8::StaticOrder, true>(F.lds, g, S, E);
        }
        SEAM(pb + 6);
        if (IN(pb + 7)) ln_phase(F, PRE, p.in[10] + (size_t)l * DM, p.in[11] + (size_t)l * DM, X1B);
        SEAM(pb + 7);
        if (IN(pb + 8)) {
            { pg8::Gemm g{X1B, WrtT + (size_t)l * SZ_WRT, T, NE, DM, DM, DM}; pg8::StaticOrder S; S.init(T, NE, F.G, (int)blockIdx.x);
              EpiF32 E{LOGITS, NE}; pg8::gemm_phase<EpiF32, pg8::StaticOrder, true>(F.lds, g, S, E); }
            { pg8::Gemm g{X1B, WsguT + (size_t)l * SZ_WSGU, T, 512, DM, DM, DM}; pg8::StaticOrder S; S.init(T, 512, F.G, (int)((blockIdx.x + F.G / 2) % F.G));
              EpiSwiGLU E{HS, DSH}; pg8::gemm_phase<EpiSwiGLU, pg8::StaticOrder, true>(F.lds, g, S, E); }
        }
        SEAM(pb + 8);
        if (IN(pb + 9)) {
            route_phase(F, LOGITS, p.in[13] + (size_t)l * NE, TOPE, TOPW, APOS, HIST, t_off);
            pg8::Gemm g{HS, WsdT + (size_t)l * SZ_WSD, T, DM, DSH, DSH, DSH}; pg8::StaticOrder S; S.init(T, DM, F.G, (int)blockIdx.x);
            EpiBf16 E{SH, DM}; pg8::gemm_phase<EpiBf16, pg8::StaticOrder, true>(F.lds, g, S, E);
        }
        SEAM(pb + 9);
        if (IN(pb + 10)) {
            int tid_ = F.tid; asm volatile("" : "+v"(tid_));
            if (tid_ < 256) { int tot = 0, base = 0; for (int c = 0; c < F.G; ++c) { const int v = HIST[(size_t)c * 256 + tid_]; base += (c < (int)blockIdx.x) ? v : 0; tot += v; }
                t_off[tid_] = tot; t_toff[tid_] = base; if (blockIdx.x == 0) ctl[CW_CNT + l * 256 + tid_] = (unsigned)tot; }
            __syncthreads();
            { int tot_; const int c_ = (tid_ < 256) ? t_off[tid_] : 0; const int po_ = scan256(c_, tid_, t_toff + 264, &tot_); if (tid_ < 256) t_off[tid_] = po_; }
            __syncthreads();
            const int TPW = T / F.G, a0 = (int)blockIdx.x * TPW * TOPK;
            for (int a = a0 + tid_; a < a0 + TPW * TOPK; a += NTHR) { const int e = TOPE[a]; const int row = t_off[e] + t_toff[e] + APOS[a]; *(u32x2*)(ROWA + 2 * (size_t)row) = (u32x2){(unsigned)a, 0u}; APOS[a] = row; }
            __syncthreads();
        }
        SEAM(pb + 10);
        if (IN(pb + 11)) {
            expert_tables(F, ctl + CW_CNT + l * 256, t_off, t_toff);
            pg8::Gemm g{X1B, WeguT + (size_t)l * SZ_WEGU, T, 512, DM, DM, DM};
            ExpertOrder<2, true> S{t_off, t_toff, ROWA, F.G, F.vcu, (size_t)512 * DM * 2};
            EpiSwiGLU E{HE, DE}; pg8::gemm_phase<EpiSwiGLU, ExpertOrder<2, true>, true>(F.lds, g, S, E);
        }
        SEAM(pb + 11);
        if (IN(pb + 12)) {
            expert_tables(F, ctl + CW_CNT + l * 256, t_off, t_toff);
            pg8::Gemm g{HE, WedT + (size_t)l * SZ_WED, NA, DM, DE, DE, DE};
            ExpertOrder<4, false> S{t_off, t_toff, ROWA, F.G, F.vcu, (size_t)DM * DE * 2};
            EpiExpDown E{(unsigned char*)Yb}; pg8::gemm_phase<EpiExpDown, ExpertOrder<4, false>, true>(F.lds, g, S, E);
        }
        SEAM(pb + 12);
        if (IN(pb + 13)) combine_phase(F, X1B, SH, (const unsigned char*)Yb, APOS, TOPW, p.in[20] + (size_t)l * DM, p.in[21] + (size_t)l * DM, l == DEPTH - 1 ? p.out : (float*)nullptr, l == DEPTH - 1 ? (bf16_t*)nullptr : XB);
        SEAM(pb + 13);
    }

    {
        const int l = 1; const int pb = 1 + l * NPH_L;
        if (IN(pb + 0)) {
            pg8::Gemm g{XB, WinT + (size_t)l * SZ_WIN, T, INCP, DM, DM, DM}; pg8::StaticOrder S; S.init(T, INCP - 256, F.G, (int)blockIdx.x);
            EpiProj E{PROJ, p.in[2] + (size_t)l * 2 * DM};
            pg8::gemm_phase<EpiProj, pg8::StaticOrder, true>(F.lds, g, S, E);
        }
        SEAM(pb + 0);
        if (IN(pb + 1)) prep_phase(F, PROJ, p.in[3] + (size_t)l * QL, p.in[5] + (size_t)l * KVL, CS, CQN, CKVN, KB, KM);
        SEAM(pb + 1);
        if (IN(pb + 2)) {
            mobasel_phase(F, PROJ, KM, SEL);
            { pg8::Gemm g{CKVN, WukvT + (size_t)l * SZ_WUKV, T, 1024, KVL, KVL, KVL}; pg8::StaticOrder S; S.init(T, 1024, F.G, (int)blockIdx.x);
              EpiKV E{KB, VB}; pg8::gemm_phase<EpiKV, pg8::StaticOrder, true>(F.lds, g, S, E); }
            { pg8::Gemm g{CQN, WuqT + (size_t)l * SZ_WUQ, T, 768, QL, QL, QL}; pg8::StaticOrder S; S.init(T, 768, F.G, (int)blockIdx.x);
              EpiQ E{QB, CS}; pg8::gemm_phase<EpiQ, pg8::StaticOrder, true>(F.lds, g, S, E); }
            { pg8::Gemm g{XB, WinT + (size_t)l * SZ_WIN, T, INCP, DM, DM, DM}; pg8::OffsetOrder S; S.init(T, 256, F.G, (int)((blockIdx.x + 64) % F.G)); S.pn0 = 16;
              EpiProj E{PROJ, p.in[2] + (size_t)l * 2 * DM}; pg8::gemm_phase<EpiProj, pg8::OffsetOrder, true>(F.lds, g, S, E); }
        }
        SEAM(pb + 2);
        if (IN(pb + 3)) {
            mla_phase(F, QB, KB, VB, OAB + 512);
            moba_sel_phase(F, PROJ, SEL, PO, PML);
        }
        SEAM(pb + 3);
        if (IN(pb + 4)) moba_own_phase(F, PROJ, OAB, PO, PML);
        SEAM(pb + 4);
        if (IN(pb + 5)) {
            pg8::Gemm g{OAB, WpaT + (size_t)l * 2 * SZ_WP, T, DM, DM, 1024, 1024}; pg8::StaticOrder S; S.init(T, DM, F.G, (int)blockIdx.x);
            EpiGate2 E{PROJ, MRG}; pg8::gemm_phase<EpiGate2, pg8::StaticOrder, true>(F.lds, g, S, E);
        }
        SEAM(pb + 5);
        if (IN(pb + 6)) {
            pg8::Gemm g{MRG, WoutT + (size_t)l * SZ_WOUT, T, DM, DM, DM, DM}; pg8::StaticOrder S; S.init(T, DM, F.G, (int)blockIdx.x);
            EpiResid E{XB, PRE}; pg8::gemm_phase<EpiResid, pg8::StaticOrder, true>(F.lds, g, S, E);
        }
        SEAM(pb + 6);
        if (IN(pb + 7)) ln_phase(F, PRE, p.in[10] + (size_t)l * DM, p.in[11] + (size_t)l * DM, X1B);
        SEAM(pb + 7);
        if (IN(pb + 8)) {
            { pg8::Gemm g{X1B, WrtT + (size_t)l * SZ_WRT, T, NE, DM, DM, DM}; pg8::StaticOrder S; S.init(T, NE, F.G, (int)blockIdx.x);
              EpiF32 E{LOGITS, NE}; pg8::gemm_phase<EpiF32, pg8::StaticOrder, true>(F.lds, g, S, E); }
            { pg8::Gemm g{X1B, WsguT + (size_t)l * SZ_WSGU, T, 512, DM, DM, DM}; pg8::StaticOrder S; S.init(T, 512, F.G, (int)((blockIdx.x + F.G / 2) % F.G));
              EpiSwiGLU E{HS, DSH}; pg8::gemm_phase<EpiSwiGLU, pg8::StaticOrder, true>(F.lds, g, S, E); }
        }
        SEAM(pb + 8);
        if (IN(pb + 9)) {
            route_phase(F, LOGITS, p.in[13] + (size_t)l * NE, TOPE, TOPW, APOS, HIST, t_off);
            pg8::Gemm g{HS, WsdT + (size_t)l * SZ_WSD, T, DM, DSH, DSH, DSH}; pg8::StaticOrder S; S.init(T, DM, F.G, (int)blockIdx.x);
            EpiBf16 E{SH, DM}; pg8::gemm_phase<EpiBf16, pg8::StaticOrder, true>(F.lds, g, S, E);
        }
        SEAM(pb + 9);
        if (IN(pb + 10)) {
            int tid_ = F.tid; asm volatile("" : "+v"(tid_));
            if (tid_ < 256) { int tot = 0, base = 0; for (int c = 0; c < F.G; ++c) { const int v = HIST[(size_t)c * 256 + tid_]; base += (c < (int)blockIdx.x) ? v : 0; tot += v; }
                t_off[tid_] = tot; t_toff[tid_] = base; if (blockIdx.x == 0) ctl[CW_CNT + l * 256 + tid_] = (unsigned)tot; }
            __syncthreads();
            { int tot_; const int c_ = (tid_ < 256) ? t_off[tid_] : 0; const int po_ = scan256(c_, tid_, t_toff + 264, &tot_); if (tid_ < 256) t_off[tid_] = po_; }
            __syncthreads();
            const int TPW = T / F.G, a0 = (int)blockIdx.x * TPW * TOPK;
            for (int a = a0 + tid_; a < a0 + TPW * TOPK; a += NTHR) { const int e = TOPE[a]; const int row = t_off[e] + t_toff[e] + APOS[a]; *(u32x2*)(ROWA + 2 * (size_t)row) = (u32x2){(unsigned)a, 0u}; APOS[a] = row; }
            __syncthreads();
        }
        SEAM(pb + 10);
        if (IN(pb + 11)) {
            expert_tables(F, ctl + CW_CNT + l * 256, t_off, t_toff);
            pg8::Gemm g{X1B, WeguT + (size_t)l * SZ_WEGU, T, 512, DM, DM, DM};
            ExpertOrder<2, true> S{t_off, t_toff, ROWA, F.G, F.vcu, (size_t)512 * DM * 2};
            EpiSwiGLU E{HE, DE}; pg8::gemm_phase<EpiSwiGLU, ExpertOrder<2, true>, true>(F.lds, g, S, E);
        }
        SEAM(pb + 11);
        if (IN(pb + 12)) {
            expert_tables(F, ctl + CW_CNT + l * 256, t_off, t_toff);
            pg8::Gemm g{HE, WedT + (size_t)l * SZ_WED, NA, DM, DE, DE, DE};
            ExpertOrder<4, false> S{t_off, t_toff, ROWA, F.G, F.vcu, (size_t)DM * DE * 2};
            EpiExpDown E{(unsigned char*)Yb}; pg8::gemm_phase<EpiExpDown, ExpertOrder<4, false>, true>(F.lds, g, S, E);
        }
        SEAM(pb + 12);
        if (IN(pb + 13)) combine_phase(F, X1B, SH, (const unsigned char*)Yb, APOS, TOPW, p.in[20] + (size_t)l * DM, p.in[21] + (size_t)l * DM, l == DEPTH - 1 ? p.out : (float*)nullptr, l == DEPTH - 1 ? (bf16_t*)nullptr : XB);
        SEAM(pb + 13);
    }

#undef IN
#undef SEAM
}

__global__ void __launch_bounds__(256) cvt_proj(const bf16_t* __restrict__ P, float* proj) {
    const size_t i = (size_t)blockIdx.x * 256 + threadIdx.x;
    const int row = (int)(i / INC), c = (int)(i % INC);
    float v = bf2f(P[(size_t)row * INCP + c]);
    if (c < C_KA) v *= (1.f / QS_A);
    proj[i] = v;
}
__global__ void __launch_bounds__(256) cvt_oab(const bf16_t* __restrict__ OAB, float* oa, float* ob) {
    const size_t i = (size_t)blockIdx.x * 256 + threadIdx.x; const size_t row = i >> 10; const int c = (int)(i & 1023);
    const float v = bf2f(OAB[i]);
    if (c < 512) oa[row * 512 + c] = v; else ob[row * 512 + c - 512] = v;
}
__global__ void __launch_bounds__(256) cvt_x(const float* __restrict__ x, bf16_t* XB) {
    const size_t i = (size_t)blockIdx.x * 256 + threadIdx.x;
    const f32x4 a = *(const f32x4*)(x + i * 8), b = *(const f32x4*)(x + i * 8 + 4);
    u32x4 w; w.x = pk2(a[0], a[1]); w.y = pk2(a[2], a[3]); w.z = pk2(b[0], b[1]); w.w = pk2(b[2], b[3]); *(u32x4*)(XB + i * 8) = w;
}
}
static int g_grid = 0;
static bool fast_setup() {
    if (g_grid) return g_grid > 0;
    int dev = 0, cus = 0, per_cu = 0;
    if (hipGetDevice(&dev) != hipSuccess || hipDeviceGetAttribute(&cus, hipDeviceAttributeMultiprocessorCount, dev) != hipSuccess) { g_grid = -1; return false; }
    if (hipFuncSetAttribute((const void*)fk::mk, hipFuncAttributeMaxDynamicSharedMemorySize, fk::LDS_BYTES) != hipSuccess) { fprintf(stderr, "hipFuncSetAttribute failed\n"); g_grid = -1; return false; }
    if (hipOccupancyMaxActiveBlocksPerMultiprocessor(&per_cu, (const void*)fk::mk, fk::NTHR, fk::LDS_BYTES) != hipSuccess || per_cu < 1) { fprintf(stderr, "occupancy query: %d\n", per_cu); }
    (void)hipGetLastError();
    g_grid = cus;
    if (cus > 1024 || T % cus != 0 || (T / cus) > 64) { fprintf(stderr, "unsupported CU count %d\n", cus); g_grid = -1; return false; }
    return true;
}
static void launch_mk(fk::Params& p, int lo, int hi, hipStream_t stream) {
    p.ph_lo = lo; p.ph_hi = hi;
    hipLaunchKernelGGL(fk::mk, dim3(g_grid), dim3(fk::NTHR), fk::LDS_BYTES, stream, p);
}

extern "C" void kernel_launch(void* const* d_in, const int* in_sizes, int n_in, void* d_out, int out_size, void* d_ws, size_t ws_size, hipStream_t stream) {
    if (!fast_setup()) return;
    if (ws_size < fk::WS_NEED) { fprintf(stderr, "workspace too small: need %zu have %zu\n", (size_t)fk::WS_NEED, ws_size); return; }
    (void)hipMemsetAsync((char*)d_ws + fk::WS_CTL, 0, fk::CTL_BYTES, stream);
    fk::Params P{};
    for (int i = 0; i < 22; ++i) P.in[i] = (const float*)d_in[i];
    P.out = (float*)d_out; P.ws = (unsigned char*)d_ws;
#if MK_ONE_LAUNCH
    launch_mk(P, 0, 1 + DEPTH * fk::NPH_L, stream);
#else
    launch_mk(P, 0, 1, stream);
    for (int l = 0; l < DEPTH; ++l) for (int k = 0; k < 14; ++k) launch_mk(P, 1 + l * fk::NPH_L + k, 2 + l * fk::NPH_L + k, stream);
#endif
}
```

```cpp
#ifndef MK_ONE_LAUNCH
#define MK_ONE_LAUNCH 1
#endif
#include <hip/hip_runtime.h>
#include <cstdint>
#include <cstdio>

constexpr int NB = 2, SEQ = 8192, T = NB * SEQ, DM = 1024, DEPTH = 2;
constexpr int HA = 8, WA = 512, BLK = 256, NBLK = SEQ / BLK;
constexpr int HB = 8, DN = 64, DR = 32, DV = 64, QL = 384, KVL = 256;
constexpr int INC = 3 * WA + QL + KVL + DR + 2 * DM;
constexpr int C_QA = 0, C_KA = 512, C_VA = 1024, C_CQ = 1536, C_CKV = 1920, C_KR = 2176, C_GA = 2208, C_GB = 3232;
constexpr int NE = 256, TOPK = 8, DE = 256, DSH = 256;
constexpr int NA = T * TOPK;
constexpr float ALPHA = 1.4142135623730951f;
constexpr float LN_EPS = 1e-5f, RMS_EPS = 1e-6f;


namespace fk {
#define LAS __attribute__((address_space(3)))
#define GAS __attribute__((address_space(1)))
typedef unsigned short bf16_t;
typedef short bf16x8 __attribute__((ext_vector_type(8)));
typedef float f32x4 __attribute__((ext_vector_type(4)));
typedef float f32x2 __attribute__((ext_vector_type(2)));
typedef float f32x16 __attribute__((ext_vector_type(16)));
typedef unsigned u32x4 __attribute__((ext_vector_type(4)));
typedef unsigned u32x2 __attribute__((ext_vector_type(2)));
constexpr int NWAVES = 8, NTHR = 512;
constexpr int INCP = 4352;
constexpr float LOG2E = 1.4426950408889634f;
constexpr float QS_A = 0.125f * LOG2E;
constexpr float QS_B = 0.10206207261596577f * LOG2E;
#define LDS_WAIT() asm volatile("s_waitcnt lgkmcnt(0)" ::: "memory")
#define VM_WAIT() asm volatile("s_waitcnt vmcnt(0)" ::: "memory")
__device__ __forceinline__ unsigned f2bf(float f) { unsigned u = __builtin_bit_cast(unsigned, f); return (u + 0x7fffu + ((u >> 16) & 1u)) >> 16; }
__device__ __forceinline__ unsigned pk2(float lo, float hi) { return f2bf(lo) | (f2bf(hi) << 16); }
__device__ __forceinline__ float bf2f(unsigned short b) { return __builtin_bit_cast(float, (unsigned)b << 16); }
__device__ __forceinline__ float bflo(unsigned w) { return __builtin_bit_cast(float, w << 16); }
__device__ __forceinline__ float bfhi(unsigned w) { return __builtin_bit_cast(float, w & 0xffff0000u); }
__device__ __forceinline__ float sigmoidf_(float x) { return __builtin_amdgcn_rcpf(1.f + __expf(-x)); }
__device__ __forceinline__ float wave_sum(float v) {
#pragma unroll
    for (int o = 1; o < 64; o <<= 1) v += __shfl_xor(v, o);
    return v;
}

namespace pg8 {
constexpr int BM = 256, BK = 64, HALF = 128, HTB = HALF * BK * 2, STAGE_BYTES = 8 * HTB, NXCD = 8, WGM = 8;
__host__ __device__ __forceinline__ int lds_byte(int r, int c) { const int st = (r >> 4) * 2 + (c >> 5), rr = r & 15, cc = c & 31, ob = rr * 64 + cc * 2; return st * 1024 + (ob ^ (((ob >> 9) & 1) << 5)); }
__host__ __device__ __forceinline__ void stage_rc(int b, int& R, int& C) { const int st = b / 1024, sb = b % 1024, swz = sb ^ (((sb >> 9) & 1) << 5); R = (st >> 1) * 16 + swz / 64; C = (st & 1) * 32 + (swz % 64) / 2; }
__host__ __device__ __forceinline__ int perm32(int rho) { const int n = rho >> 4, i = rho & 15; return 8 * (i >> 2) + 4 * n + (i & 3); }

struct Unit { int pm, pn, e, r0, rend; };
struct Gemm { const bf16_t* A; const bf16_t* Bt; int M, N, K, lda, ldb; };

struct StaticOrder {
    int nM, nN, nwg, G, c;
    __device__ void init(int M, int N, int G_, int c_) { nM = M / BM; nN = N / BM; nwg = nM * nN; G = G_; c = c_; }
    __device__ bool next(int i, Unit& u) const {
        const long L = (long)i * G + c; if (L >= nwg) return false;
        int wgid = (int)L; { const int q = nwg / NXCD, r = nwg % NXCD, xcd = wgid % NXCD, off = wgid / NXCD; wgid = (xcd < r ? xcd * (q + 1) : r * (q + 1) + (xcd - r) * q) + off; }
        const int nig = WGM * nN, gid = wgid / nig, fm = gid * WGM, gsz = (nM - fm) < WGM ? (nM - fm) : WGM;
        u.pm = fm + ((wgid % nig) % gsz); u.pn = (wgid % nig) / gsz; u.e = 0; u.r0 = u.pm * BM; u.rend = u.r0 + BM; return true;
    }
    __device__ __forceinline__ int a_row(const Unit& u, int r) const { return u.pm * BM + r; }
    __device__ __forceinline__ const char* b_ptr(const Gemm& g, const Unit& u) const { return (const char*)g.Bt + (size_t)u.pn * BM * g.ldb * 2; }
};

struct OffsetOrder : StaticOrder {
    int pn0;
    __device__ bool next(int i, Unit& u) const { const bool ok = StaticOrder::next(i, u); u.pn += pn0; return ok; }
};
typedef float f32x2_t_ __attribute__((ext_vector_type(2))); typedef __bf16 bf16x2_t_ __attribute__((ext_vector_type(2)));
__device__ __forceinline__ unsigned cvt_pk_bf16(float lo, float hi) { const f32x2_t_ v = {lo, hi}; const bf16x2_t_ b = __builtin_convertvector(v, bf16x2_t_); return __builtin_bit_cast(unsigned, b); }

template <class Epi, class Sched, bool ALIGN_EPI>
__device__ __forceinline__ void gemm_phase(LAS unsigned char* lds, const Gemm g, const Sched& S, const Epi& E) {
    int tid_ = threadIdx.x; asm volatile("" : "+v"(tid_));
    const int tid = tid_, wid = __builtin_amdgcn_readfirstlane(tid >> 6), lane = tid & 63, wr = wid >> 2, wc = wid & 3, fr = lane & 15, fq = lane >> 4;
    const int K = g.K, nt = K / BK;
    int RA[2]; unsigned CA[2], voffB[2];
#pragma unroll
    for (int i = 0; i < 2; ++i) { int R, C; stage_rc(tid * 16 + i * 8192, R, C); const int Rb = (R & ~31) + perm32(R & 31);
        RA[i] = R; CA[i] = (unsigned)C * 2u; voffB[i] = (unsigned)(Rb * g.ldb + C) * 2u; }
    const unsigned lda2 = (unsigned)g.lda * 2u;
    const size_t hstepB = (size_t)HALF * g.ldb * 2;
    const unsigned ldsw = (unsigned)wid * 1024u;
    const int aoff = lds_byte(wr * 64 + fr, fq * 8), boff = lds_byte(wc * 32 + fr, fq * 8);
    const char* const Abase = (const char*)g.A;
#define PG8_SA(b, h) (((b) * 2 + (h)) * HTB)
#define PG8_SB(b, h) ((4 + (b) * 2 + (h)) * HTB)
#define PG8_STAGE_B(bufoff, gbase) do { _Pragma("unroll") for (int _i = 0; _i < 2; ++_i) \
        __builtin_amdgcn_global_load_lds((const unsigned*)((const char*)(gbase) + voffB[_i]), (LAS unsigned*)(lds + (bufoff) + ldsw + _i * 8192), 16, 0, 0); } while (0)
#define PG8_STAGE_A(bufoff, V0, V1, kb) do { \
        __builtin_amdgcn_global_load_lds((const unsigned*)((Abase + (kb)) + (V0)), (LAS unsigned*)(lds + (bufoff) + ldsw), 16, 0, 0); \
        __builtin_amdgcn_global_load_lds((const unsigned*)((Abase + (kb)) + (V1)), (LAS unsigned*)(lds + (bufoff) + ldsw + 8192), 16, 0, 0); } while (0)
#define PG8_LDA(dst, b, h) do { _Pragma("unroll") for (int m = 0; m < 4; ++m) _Pragma("unroll") for (int k = 0; k < 2; ++k) dst[m][k] = *(const LAS bf16x8*)(lds + PG8_SA(b, h) + aoff + m * 2048 + k * 1024); } while (0)
#define PG8_LDB(dst, b, h) do { _Pragma("unroll") for (int n = 0; n < 2; ++n) _Pragma("unroll") for (int k = 0; k < 2; ++k) dst[n][k] = *(const LAS bf16x8*)(lds + PG8_SB(b, h) + boff + n * 2048 + k * 1024); } while (0)
#define PG8_MMA(ai, bj, At, Bt) do { __builtin_amdgcn_s_setprio(1); _Pragma("unroll") for (int m = 0; m < 4; ++m) _Pragma("unroll") for (int n = 0; n < 2; ++n) _Pragma("unroll") for (int k = 0; k < 2; ++k) \
        acc[ai][bj][m][n] = __builtin_amdgcn_mfma_f32_16x16x32_bf16(Bt[n][k], At[m][k], acc[ai][bj][m][n], 0, 0, 0); __builtin_amdgcn_s_setprio(0); } while (0)
#define PG8_WAIT_V(n) asm volatile("s_waitcnt vmcnt(" #n ")" ::: "memory")
#define PG8_WAIT_L(n) asm volatile("s_waitcnt lgkmcnt(" #n ")" ::: "memory")
#define PG8_BAR __builtin_amdgcn_s_barrier()
#define PG8_SCHED __builtin_amdgcn_sched_barrier(0)
#define PG8_VOFF(V, U) do { V##00 = (unsigned)S.a_row(U, RA[0]) * lda2 + CA[0]; V##01 = (unsigned)S.a_row(U, RA[1]) * lda2 + CA[1]; \
        V##10 = (unsigned)S.a_row(U, HALF + RA[0]) * lda2 + CA[0]; V##11 = (unsigned)S.a_row(U, HALF + RA[1]) * lda2 + CA[1]; } while (0)
    Unit cur, nxt; int ui = 0;
    if (!S.next(0, cur)) return;
    f32x4 acc[2][2][4][2];
#pragma unroll
    for (int a = 0; a < 2; ++a)
#pragma unroll
        for (int b = 0; b < 2; ++b)
#pragma unroll
            for (int m = 0; m < 4; ++m)
#pragma unroll
                for (int n = 0; n < 2; ++n) acc[a][b][m][n] = (f32x4){0.f, 0.f, 0.f, 0.f};
    bf16x8 At[4][2], B0[2][2], B1[2][2];
    unsigned vc00, vc01, vc10, vc11;
    PG8_VOFF(vc, cur);
    const char* cB = S.b_ptr(g, cur);
    PG8_STAGE_B(PG8_SB(0, 0), cB); PG8_STAGE_B(PG8_SB(0, 1), cB + hstepB); PG8_STAGE_A(PG8_SA(0, 0), vc00, vc01, 0u); PG8_STAGE_A(PG8_SA(0, 1), vc10, vc11, 0u);
    if (wr == 1) PG8_BAR;
    PG8_WAIT_V(2); PG8_BAR;
    PG8_STAGE_B(PG8_SB(1, 0), cB + 128); PG8_STAGE_A(PG8_SA(1, 0), vc00, vc01, 128u); PG8_STAGE_B(PG8_SB(1, 1), cB + hstepB + 128);
    PG8_WAIT_V(6); PG8_BAR;
    for (;;) {
        const bool has_next = S.next(ui + 1, nxt);
        const char* nB = has_next ? S.b_ptr(g, nxt) : cB;
        unsigned vn00 = vc00, vn01 = vc01, vn10 = vc10, vn11 = vc11;
        if (has_next) { PG8_VOFF(vn, nxt); }
        const bool half1 = (cur.rend - cur.r0) > HALF;
#pragma unroll 1
        for (int t = 0; t < nt; t += 2) {
            if constexpr (Epi::MIDK > 0) { if (t == Epi::MIDK) E.mid(acc, cur, wr, wc, fr, fq); }
            const bool last = (t == nt - 2);
            const unsigned kb1 = (unsigned)(t + 1) * 128u;
            unsigned kb2 = (unsigned)(t + 2) * 128u;
            unsigned s00 = vc00, s01 = vc01, s10 = vc10, s11 = vc11;
            const char* b2 = cB + (size_t)kb2;
            if (last) { kb2 = 0u; b2 = nB; s00 = vn00; s01 = vn01; s10 = vn10; s11 = vn11; }
            const unsigned kb3 = kb2 + 128u; const char* b3 = b2 + 128;
            PG8_LDB(B0, 0, 0); PG8_LDB(B1, 0, 1); PG8_SCHED; PG8_LDA(At, 0, 0); PG8_STAGE_A(PG8_SA(1, 1), vc10, vc11, kb1);
            PG8_WAIT_V(8); PG8_WAIT_L(0); PG8_BAR; PG8_MMA(0, 0, At, B0); PG8_MMA(0, 1, At, B1); PG8_BAR; PG8_SCHED;
            PG8_LDA(At, 0, 1); PG8_STAGE_B(PG8_SB(0, 0), b2); PG8_STAGE_B(PG8_SB(0, 1), b2 + hstepB); PG8_STAGE_A(PG8_SA(0, 0), s00, s01, kb2);
            PG8_WAIT_V(8); PG8_WAIT_L(0); PG8_BAR; if (half1) { PG8_MMA(1, 0, At, B0); PG8_MMA(1, 1, At, B1); } PG8_BAR; PG8_SCHED;
            PG8_LDB(B0, 1, 0); PG8_LDB(B1, 1, 1); PG8_SCHED; PG8_LDA(At, 1, 0); PG8_STAGE_A(PG8_SA(0, 1), s10, s11, kb2);
            PG8_WAIT_V(8); PG8_WAIT_L(0); PG8_BAR; PG8_MMA(0, 0, At, B0); PG8_MMA(0, 1, At, B1); PG8_BAR; PG8_SCHED;
            PG8_LDA(At, 1, 1); PG8_STAGE_B(PG8_SB(1, 0), b3); PG8_STAGE_B(PG8_SB(1, 1), b3 + hstepB); PG8_STAGE_A(PG8_SA(1, 0), s00, s01, kb3);
            PG8_WAIT_V(8); PG8_WAIT_L(0); PG8_BAR; if (half1) { PG8_MMA(1, 0, At, B0); PG8_MMA(1, 1, At, B1); } PG8_BAR; PG8_SCHED;
        }
        if constexpr (ALIGN_EPI) { if (wr == 0) PG8_BAR; }
        E(acc, cur, wr, wc, fr, fq);
        if (!has_next) break;
#pragma unroll
        for (int a = 0; a < 2; ++a)
#pragma unroll
            for (int b = 0; b < 2; ++b)
#pragma unroll
                for (int m = 0; m < 4; ++m)
#pragma unroll
                    for (int n = 0; n < 2; ++n) acc[a][b][m][n] = (f32x4){0.f, 0.f, 0.f, 0.f};
        cur = nxt; cB = nB; vc00 = vn00; vc01 = vn01; vc10 = vn10; vc11 = vn11; ++ui;
        if constexpr (ALIGN_EPI) { if (wr == 1) PG8_BAR; }
    }
    PG8_WAIT_V(0);
    if constexpr (!ALIGN_EPI) { if (wr == 0) PG8_BAR; }
    PG8_BAR;
#undef PG8_SA
#undef PG8_SB
#undef PG8_STAGE_A
#undef PG8_STAGE_B
#undef PG8_LDA
#undef PG8_LDB
#undef PG8_MMA
#undef PG8_WAIT_V
#undef PG8_WAIT_L
#undef PG8_BAR
#undef PG8_SCHED
#undef PG8_VOFF
}
#define PG8_TILE_BEGIN(acc, wr, wc, fr, fq) \
    _Pragma("unroll") for (int ai = 0; ai < 2; ++ai) _Pragma("unroll") for (int m = 0; m < 4; ++m) _Pragma("unroll") for (int bj = 0; bj < 2; ++bj) { \
        const int trow = ai * 128 + wr * 64 + m * 16 + fr, tcol = bj * 128 + wc * 32 + 8 * fq; f32x4 v0 = acc[ai][bj][m][0], v1 = acc[ai][bj][m][1];
#define PG8_TILE_END }
__device__ __forceinline__ u32x4 pack8(f32x4 v0, f32x4 v1) { u32x4 w; w.x = cvt_pk_bf16(v0[0], v0[1]); w.y = cvt_pk_bf16(v0[2], v0[3]); w.z = cvt_pk_bf16(v1[0], v1[1]); w.w = cvt_pk_bf16(v1[2], v1[3]); return w; }
}

#define XB_TMO      128
#define XB_XCNT(j)  (256  + 64 * (j))
#define XB_XSUB(j)  (1280 + 64 * (j))
#define XB_XGEN(j)  (2304 + 64 * (j))
#define XB_TOP      3328
#define XB_TOPGEN   3392
#define XCD_BAR_WORDS 3456
#define XB_SPIN_CAP (1u << 18)

__device__ __forceinline__ unsigned xb_ld(unsigned* p)              { return __hip_atomic_load(p, __ATOMIC_RELAXED, __HIP_MEMORY_SCOPE_AGENT); }
__device__ __forceinline__ unsigned xb_add(unsigned* p, unsigned v) { return __hip_atomic_fetch_add(p, v, __ATOMIC_RELAXED, __HIP_MEMORY_SCOPE_AGENT); }
__device__ __forceinline__ unsigned xb_xcc_id() { return (unsigned)__builtin_amdgcn_s_getreg((3 << 11) | 20) & 0xFu; }
#define XB_SPIN(cond, bar) do { unsigned _sp = 0; while (cond) { __builtin_amdgcn_s_sleep(1); \
    if ((++_sp & 255u) == 0u) { if (xb_ld(&(bar)[XB_TMO])) break; if (_sp > XB_SPIN_CAP) { atomicAdd(&(bar)[XB_TMO], 1u); break; } } } } while (0)

struct XcdBarrier {
    unsigned* bar; unsigned x;
    volatile LAS unsigned* st;
};

__device__ __forceinline__ XcdBarrier xcd_barrier_post(unsigned* bar, volatile LAS unsigned* st) {
    XcdBarrier b; b.bar = bar; b.x = xb_xcc_id(); b.st = st;
    if (threadIdx.x == 0) (void)xb_add(&bar[XB_XCNT(b.x)], 1u);
    return b;
}
__device__ __forceinline__ void xcd_barrier_complete(unsigned* bar, unsigned x, unsigned& nloc, unsigned& nx) {
    const unsigned G = gridDim.x * gridDim.y * gridDim.z;
    unsigned sum, cnt, mine, sp = 0u;
    for (;;) {
        sum = 0u; cnt = 0u; mine = 0u;
#pragma unroll
        for (unsigned j = 0; j < 16; ++j) { const unsigned c = xb_ld(&bar[XB_XCNT(j)]); sum += c; cnt += (c > 0u) ? 1u : 0u; mine = (j == x) ? c : mine; }
        if (sum == G) break;
        __builtin_amdgcn_s_sleep(1);
        if ((++sp & 255u) == 0u) { if (xb_ld(&bar[XB_TMO])) break; if (sp > XB_SPIN_CAP) { atomicAdd(&bar[XB_TMO], 1u); break; } }
    }
    nloc = mine > 0u ? mine : 1u; nx = cnt > 0u ? cnt : 1u;
}

__device__ __forceinline__ void xcd_barrier(const XcdBarrier& b) {
    asm volatile("s_waitcnt vmcnt(0)" ::: "memory");
    __syncthreads();
    if (threadIdx.x == 0) {
        unsigned* bar = b.bar; asm volatile("" : "+s"(bar));
        __builtin_amdgcn_s_waitcnt(0);
        unsigned nloc = b.st[0], nx = b.st[1];
        if (nloc == 0u) { xcd_barrier_complete(bar, b.x, nloc, nx); b.st[0] = nloc; b.st[1] = nx; }
        const unsigned old = xb_add(&bar[XB_XSUB(b.x)], 1u);
        const unsigned gen = old / nloc;
        if (old + 1u == (gen + 1u) * nloc) {
            __builtin_amdgcn_fence(__ATOMIC_RELEASE, "agent");
            asm volatile("s_waitcnt vmcnt(0)" ::: "memory");
            const unsigned og = xb_add(&bar[XB_TOP], 1u);
            const unsigned tg = og / nx;
            if (og + 1u == (tg + 1u) * nx) xb_add(&bar[XB_TOPGEN], 1u);
            else XB_SPIN(xb_ld(&bar[XB_TOPGEN]) == tg, bar);
            __builtin_amdgcn_fence(__ATOMIC_ACQUIRE, "agent");
            xb_add(&bar[XB_XGEN(b.x)], 1u);
            asm volatile("s_waitcnt vmcnt(0)" ::: "memory");
        } else {
            XB_SPIN(xb_ld(&bar[XB_XGEN(b.x)]) == gen, bar);
            __builtin_amdgcn_fence(__ATOMIC_ACQUIRE, "agent");
            asm volatile("s_waitcnt vmcnt(0)" ::: "memory");
        }
    }
    __syncthreads();
}


struct Params {
    const float* in[22]; float* out; unsigned char* ws;
    int ph_lo, ph_hi;
};
constexpr size_t MiB = 1u << 20;
constexpr size_t WS_CTL = 0, CTL_BYTES = 1 * MiB;
constexpr int CW_BAR = 4096;
constexpr int CW_CNT = 16384;
constexpr size_t WS_WIN = 2 * MiB;
constexpr size_t SZ_WIN = (size_t)INCP * DM;
constexpr size_t SZ_WUQ = (size_t)768 * QL, SZ_WUKV = (size_t)1024 * KVL;
constexpr size_t WS_WUQ = WS_WIN + 2 * SZ_WIN * 2;
constexpr size_t WS_WUKV = WS_WUQ + 2 * SZ_WUQ * 2;
constexpr size_t SZ_WP = (size_t)DM * 512, SZ_WOUT = (size_t)DM * DM;
constexpr size_t WS_WPA = WS_WUKV + 2 * SZ_WUKV * 2;
constexpr size_t WS_WPB = WS_WPA + 2 * SZ_WP * 2;
constexpr size_t WS_WOUT = WS_WPB + 2 * SZ_WP * 2;
constexpr size_t SZ_WRT = (size_t)NE * DM, SZ_WSGU = (size_t)512 * DM, SZ_WSD = (size_t)DM * DSH;
constexpr size_t WS_WRT = WS_WOUT + 2 * SZ_WOUT * 2;
constexpr size_t WS_WSGU = WS_WRT + 2 * SZ_WRT * 2;
constexpr size_t WS_WSD = WS_WSGU + 2 * SZ_WSGU * 2;
constexpr size_t WS_CS = WS_WSD + 2 * SZ_WSD * 2;
constexpr size_t WS_KM = WS_CS + (size_t)SEQ * 16 * 8;
constexpr size_t WS_SEL = WS_KM + (size_t)NB * HA * NBLK * 64 * 4;
constexpr size_t WS_XB = WS_SEL + (size_t)T * 8 * 4;
constexpr size_t WS_CQN = WS_XB + (size_t)T * DM * 2;
constexpr size_t WS_CKVN = WS_CQN + (size_t)T * QL * 2;
constexpr size_t WS_QB = WS_CKVN + (size_t)T * KVL * 2;
constexpr size_t WS_KB = WS_QB + (size_t)T * 768 * 2;
constexpr size_t WS_VB = WS_KB + (size_t)T * 768 * 2;
constexpr size_t WS_OAB = WS_VB + (size_t)T * 512 * 2;
constexpr size_t WS_TMP = WS_OAB + (size_t)T * 1024 * 2;
constexpr size_t WS_MRG = WS_TMP + (size_t)T * 1024 * 2;
constexpr size_t WS_PRE = WS_MRG + (size_t)T * 1024 * 2;
constexpr size_t WS_X1 = WS_PRE + (size_t)T * 1024 * 4;
constexpr size_t WS_X1B = WS_X1 + (size_t)T * 1024 * 4;
constexpr size_t WS_X2 = WS_X1B + (size_t)T * 1024 * 2;
constexpr size_t WS_LOG = WS_X2 + (size_t)T * 1024 * 4;
constexpr size_t WS_HS = WS_LOG + (size_t)T * NE * 4;
constexpr size_t WS_SH = WS_HS + (size_t)T * DSH * 2;
constexpr size_t WS_TOPE = WS_SH + (size_t)T * DM * 2;
constexpr size_t WS_TOPW = WS_TOPE + (size_t)NA * 4;
constexpr size_t WS_APOS = WS_TOPW + (size_t)NA * 4;
constexpr size_t WS_ROWA = WS_APOS + (size_t)NA * 4;
constexpr size_t WS_HIST = WS_ROWA + (size_t)NA * 8;
constexpr size_t WS_PO = WS_HIST + (size_t)1024 * 256 * 4;
constexpr size_t WS_PML = WS_PO + (size_t)T * 8 * 3 * 64 * 2;
constexpr size_t WS_HE = WS_PML + (size_t)T * 8 * 3 * 128;
constexpr size_t WS_Y = WS_HE + (size_t)NA * DE * 2;
constexpr size_t WS_PROJ = WS_Y + (size_t)NA * DM * 2;
constexpr size_t SZ_WEGU = (size_t)NE * 512 * DM, SZ_WED = (size_t)NE * DM * DE;
constexpr size_t WS_WEGU = WS_PROJ + (size_t)T * INCP * 2;
constexpr size_t WS_WED = WS_WEGU + 2 * SZ_WEGU * 2;
constexpr size_t WS_FAST_END = WS_WED + 2 * SZ_WED * 2;
constexpr size_t WS_NEED = WS_FAST_END;
static_assert(WS_NEED <= (size_t)2040 * MiB, "ws map");

constexpr int LDS_BYTES = 147456;
constexpr int RING_BYTES = 131072, MISC_OFF = RING_BYTES + 1024, TAB_OFF = RING_BYTES + 2048;

struct Frame { LAS unsigned char* lds; int tid, lane, wave, G, vcu; };

template <class RowMap>
__device__ __forceinline__ void transpose_item(const float* W, int K, int N, bf16_t* WT, int ldk, RowMap rm, LAS float* scr, int item, int lane) {
    const int nblk = N / 32, kb = item / nblk, nb = item % nblk, k0 = 64 * kb, n0 = 32 * nb;
#pragma unroll 8
    for (int i = 0; i < 32; ++i) { const int kk = 2 * i + (lane >> 5); scr[kk * 33 + (lane & 31)] = __builtin_nontemporal_load(W + (size_t)(k0 + kk) * N + n0 + (lane & 31)); }
    LDS_WAIT(); asm volatile("" ::: "memory");
    const int c = lane & 7;
#pragma unroll
    for (int j = 0; j < 4; ++j) { const int n = (lane >> 3) + 8 * j; const LAS float* s = scr + (8 * c) * 33 + n;
        u32x4 o; o.x = pk2(s[0 * 33], s[1 * 33]); o.y = pk2(s[2 * 33], s[3 * 33]); o.z = pk2(s[4 * 33], s[5 * 33]); o.w = pk2(s[6 * 33], s[7 * 33]);
        __builtin_nontemporal_store(o, (u32x4*)(WT + (size_t)rm(n0 + n) * ldk + k0 + 8 * c)); }
    LDS_WAIT(); asm volatile("" ::: "memory");
}
template <class RowMap>
__device__ __forceinline__ void transpose_item64(const float* W, int K, int N, bf16_t* WT, int ldk, RowMap rm, LAS unsigned short* scr, int item, int lane) {
    const int nblk = N / 64, kb = item / nblk, nb = item % nblk, k0 = 64 * kb, n0 = 64 * nb, r = lane >> 4, c4 = (lane & 15) * 4;
    f32x4 v[16];
#pragma unroll
    for (int i = 0; i < 16; ++i) v[i] = __builtin_nontemporal_load((const f32x4*)(W + (size_t)(k0 + 4 * i + r) * N + n0 + c4));
#pragma unroll
    for (int i = 0; i < 16; ++i) { LAS unsigned* d = (LAS unsigned*)(scr + (4 * i + r) * 66 + c4); d[0] = pk2(v[i][0], v[i][1]); d[1] = pk2(v[i][2], v[i][3]); }
    LDS_WAIT(); asm volatile("" ::: "memory");
    const int c = lane & 7;
#pragma unroll
    for (int j = 0; j < 8; ++j) { const int n = (lane >> 3) + 8 * j; const LAS unsigned short* q = scr + (8 * c) * 66 + n;
        u32x4 o; o.x = (unsigned)q[0] | ((unsigned)q[66] << 16); o.y = (unsigned)q[2 * 66] | ((unsigned)q[3 * 66] << 16); o.z = (unsigned)q[4 * 66] | ((unsigned)q[5 * 66] << 16); o.w = (unsigned)q[6 * 66] | ((unsigned)q[7 * 66] << 16);
        __builtin_nontemporal_store(o, (u32x4*)(WT + (size_t)rm(n0 + n) * ldk + k0 + 8 * c)); }
    LDS_WAIT(); asm volatile("" ::: "memory");
}
struct RowPermD { __device__ __forceinline__ int operator()(int n) const { const int a = n & 255; return (n & ~255) + 128 * ((a >> 3) & 1) + 32 * (a >> 6) + 8 * ((a >> 4) & 3) + (a & 7); } };
struct RowId { __device__ __forceinline__ int operator()(int n) const { return n; } };

struct EpiProj {
    static constexpr int MIDK = 0;
    bf16_t* O; const float* bg;
    __device__ __forceinline__ void operator()(const f32x4 (&acc)[2][2][4][2], const pg8::Unit& u, int wr, int wc, int fr, int fq) const {
        PG8_TILE_BEGIN(acc, wr, wc, fr, fq)
            const int row = u.pm * 256 + trow, col = u.pn * 256 + tcol;
            if (col < C_KA) { v0 = v0 * QS_A; v1 = v1 * QS_A; }
            else if (col >= C_GA && col < INC) { const f32x4 b0 = *(const f32x4*)(bg + col - C_GA), b1 = *(const f32x4*)(bg + col - C_GA + 4);
#pragma unroll
                for (int i = 0; i < 4; ++i) { v0[i] = sigmoidf_(v0[i] + b0[i]); v1[i] = sigmoidf_(v1[i] + b1[i]); } }
            *(u32x4*)(O + (size_t)row * INCP + col) = pg8::pack8(v0, v1);
        PG8_TILE_END
    }
};

struct RowQ { __device__ __forceinline__ int operator()(int n) const { const int h = n / 96, d = n % 96; if (d < 64) return n; const int i = d - 64; return h * 96 + 64 + (i < 16 ? 2 * i : 2 * (i - 16) + 1); } };

struct EpiQ {
    static constexpr int MIDK = 0;
    bf16_t* O; const f32x2* CS;
    __device__ __forceinline__ void operator()(const f32x4 (&acc)[2][2][4][2], const pg8::Unit& u, int wr, int wc, int fr, int fq) const {
        PG8_TILE_BEGIN(acc, wr, wc, fr, fq)
            const int row = u.pm * 256 + trow, col = u.pn * 256 + tcol, d = col % 96;
            if (d >= 64) { const int pos = row % SEQ, i0 = (d - 64) >> 1; const f32x2* cs = CS + (size_t)pos * 16 + i0;
                const f32x2 c0 = cs[0], c1 = cs[1], c2 = cs[2], c3 = cs[3];
                const f32x4 a = v0, b = v1;
                v0[0] = a[0] * c0[0] - a[1] * c0[1]; v0[1] = a[1] * c0[0] + a[0] * c0[1]; v0[2] = a[2] * c1[0] - a[3] * c1[1]; v0[3] = a[3] * c1[0] + a[2] * c1[1];
                v1[0] = b[0] * c2[0] - b[1] * c2[1]; v1[1] = b[1] * c2[0] + b[0] * c2[1]; v1[2] = b[2] * c3[0] - b[3] * c3[1]; v1[3] = b[3] * c3[0] + b[2] * c3[1]; }
            v0 = v0 * QS_B; v1 = v1 * QS_B;
            *(u32x4*)(O + (size_t)row * 768 + col) = pg8::pack8(v0, v1);
        PG8_TILE_END
    }
};
struct EpiKV {
    static constexpr int MIDK = 0;
    bf16_t* KB; bf16_t* VB;
    __device__ __forceinline__ void operator()(const f32x4 (&acc)[2][2][4][2], const pg8::Unit& u, int wr, int wc, int fr, int fq) const {
        PG8_TILE_BEGIN(acc, wr, wc, fr, fq)
            const int row = u.pm * 256 + trow, col = u.pn * 256 + tcol, h = col >> 7, j = col & 127;
            bf16_t* dst = (j < 64) ? KB + (size_t)row * 768 + h * 96 + j : VB + (size_t)row * 512 + h * 64 + (j - 64);
            *(u32x4*)dst = pg8::pack8(v0, v1);
        PG8_TILE_END
    }
};

__device__ __forceinline__ void prep_phase(const Frame& F, const bf16_t* PROJ, const float* qn, const float* kvn, const f32x2* CS, bf16_t* CQN, bf16_t* CKVN, bf16_t* KB, float* KM) {
    int lane_ = F.lane; asm volatile("" : "+v"(lane_));
    const int gw = F.vcu * NWAVES + F.wave, NGW = F.G * NWAVES, lane = lane_;
    for (int row = gw; row < T; row += NGW) {
        const bf16_t* p = PROJ + (size_t)row * INCP;
        u32x4 a = (u32x4){0u, 0u, 0u, 0u}, b = (u32x4){0u, 0u, 0u, 0u};
        if (lane < 48) a = *(const u32x4*)(p + C_CQ + lane * 8);
        if (lane < 32) b = *(const u32x4*)(p + C_CKV + lane * 8);
        float sq = 0.f, sk = 0.f;
#pragma unroll
        for (int i = 0; i < 4; ++i) { const float x = bflo(a[i]), y = bfhi(a[i]), z = bflo(b[i]), w = bfhi(b[i]); sq += x * x + y * y; sk += z * z + w * w; }
        sq = wave_sum(sq); sk = wave_sum(sk);
        const float rq = rsqrtf(sq * (1.f / QL) + RMS_EPS), rk = rsqrtf(sk * (1.f / KVL) + RMS_EPS);
        if (lane < 48) { const f32x4 g0 = *(const f32x4*)(qn + lane * 8), g1 = *(const f32x4*)(qn + lane * 8 + 4); u32x4 o;
            o.x = pk2(bflo(a.x) * rq * g0[0], bfhi(a.x) * rq * g0[1]); o.y = pk2(bflo(a.y) * rq * g0[2], bfhi(a.y) * rq * g0[3]);
            o.z = pk2(bflo(a.z) * rq * g1[0], bfhi(a.z) * rq * g1[1]); o.w = pk2(bflo(a.w) * rq * g1[2], bfhi(a.w) * rq * g1[3]);
            *(u32x4*)(CQN + (size_t)row * QL + lane * 8) = o; }
        if (lane < 32) { const f32x4 g0 = *(const f32x4*)(kvn + lane * 8), g1 = *(const f32x4*)(kvn + lane * 8 + 4); u32x4 o;
            o.x = pk2(bflo(b.x) * rk * g0[0], bfhi(b.x) * rk * g0[1]); o.y = pk2(bflo(b.y) * rk * g0[2], bfhi(b.y) * rk * g0[3]);
            o.z = pk2(bflo(b.z) * rk * g1[0], bfhi(b.z) * rk * g1[1]); o.w = pk2(bflo(b.w) * rk * g1[2], bfhi(b.w) * rk * g1[3]);
            *(u32x4*)(CKVN + (size_t)row * KVL + lane * 8) = o; }
        if (lane < 16) { const float x1 = bf2f(p[C_KR + lane]), x2 = bf2f(p[C_KR + 16 + lane]); const f32x2 cs = CS[(size_t)(row % SEQ) * 16 + lane];
            const unsigned w = pk2(x1 * cs[0] - x2 * cs[1], x2 * cs[0] + x1 * cs[1]);
#pragma unroll
            for (int h = 0; h < 8; ++h) *(unsigned*)(KB + (size_t)row * 768 + h * 96 + 64 + 2 * lane) = w; }
    }
    for (int it = gw; it < NB * NBLK * HA; it += NGW) {
        const int h = it % HA, blk = (it / HA) % NBLK, b = it / (HA * NBLK), c = lane & 7, r0 = lane >> 3;
        const bf16_t* p = PROJ + ((size_t)b * SEQ + (size_t)blk * BLK + r0) * INCP + C_KA + h * 64 + c * 8;
        float s[8];
#pragma unroll
        for (int i = 0; i < 8; ++i) s[i] = 0.f;
#pragma unroll 8
        for (int i = 0; i < 32; ++i) { const u32x4 v = *(const u32x4*)(p + (size_t)i * 8 * INCP);
#pragma unroll
            for (int k = 0; k < 4; ++k) { s[2 * k] += bflo(v[k]); s[2 * k + 1] += bfhi(v[k]); } }
#pragma unroll
        for (int i = 0; i < 8; ++i) { s[i] += __shfl_xor(s[i], 8); s[i] += __shfl_xor(s[i], 16); s[i] += __shfl_xor(s[i], 32); }
        if (lane < 8) { float* o = KM + ((size_t)(b * HA + h) * NBLK + blk) * 64 + c * 8;
            *(f32x4*)o = (f32x4){s[0], s[1], s[2], s[3]} * (1.f / BLK); *(f32x4*)(o + 4) = (f32x4){s[4], s[5], s[6], s[7]} * (1.f / BLK); }
    }
}
__device__ __forceinline__ void mobasel_phase(const Frame& F, const bf16_t* PROJ, const float* KM, unsigned* SEL) {
    int tid_ = F.tid; asm volatile("" : "+v"(tid_));
    const int TPW = T / F.G, row0 = (int)blockIdx.x * TPW, b = row0 / SEQ, own = (row0 % SEQ) / BLK, hs = own * 64 + 4;
    LAS float* km = (LAS float*)F.lds;
    for (int i = tid_; i < 8 * own * 16; i += NTHR) { const int h = i / (own * 16), r = i % (own * 16);
        *(LAS f32x4*)(km + h * hs + r * 4) = *(const f32x4*)(KM + ((size_t)(b * HA + h) * NBLK) * 64 + r * 4); }
    __syncthreads();
    for (int idx = tid_; idx < TPW * 8; idx += NTHR) {
        const int h = idx & 7, row = row0 + (idx >> 3);
        const bf16_t* qp = PROJ + (size_t)row * INCP + C_QA + h * 64;
        float q[64];
#pragma unroll
        for (int i = 0; i < 8; ++i) { const u32x4 v = *(const u32x4*)(qp + i * 8);
#pragma unroll
            for (int k = 0; k < 4; ++k) { q[i * 8 + 2 * k] = bflo(v[k]); q[i * 8 + 2 * k + 1] = bfhi(v[k]); } }
        float v1 = -INFINITY, v2 = -INFINITY, v3 = -INFINITY; int i1 = -1, i2 = -1, i3 = -1;
        for (int j = 0; j < own; ++j) {
            const LAS f32x4* kp = (const LAS f32x4*)(km + h * hs + j * 64);
            float g0 = 0.f, g1 = 0.f, g2 = 0.f, g3 = 0.f;
#pragma unroll
            for (int c = 0; c < 16; ++c) { const f32x4 k4 = kp[c]; g0 = fmaf(q[4 * c], k4[0], g0); g1 = fmaf(q[4 * c + 1], k4[1], g1); g2 = fmaf(q[4 * c + 2], k4[2], g2); g3 = fmaf(q[4 * c + 3], k4[3], g3); }
            const float g = (g0 + g1) + (g2 + g3);
            if (g > v1) { v3 = v2; i3 = i2; v2 = v1; i2 = i1; v1 = g; i1 = j; }
            else if (g > v2) { v3 = v2; i3 = i2; v2 = g; i2 = j; }
            else if (g > v3) { v3 = g; i3 = j; }
        }
        unsigned m = 0;
        if (i1 >= 0) m |= 1u << i1;
        if (i2 >= 0) m |= 1u << i2;
        if (i3 >= 0) m |= 1u << i3;
        SEL[(size_t)row * 8 + h] = m;
    }
    __syncthreads();
}

struct EpiGate2 {
    static constexpr int MIDK = 8;
    const bf16_t* PROJ; bf16_t* MRG;
    __device__ __forceinline__ void mid(f32x4 (&acc)[2][2][4][2], const pg8::Unit& u, int wr, int wc, int fr_, int fq) const {
        int fr = fr_; asm volatile("" : "+v"(fr));
#pragma unroll
        for (int ai = 0; ai < 2; ++ai)
#pragma unroll
            for (int m = 0; m < 4; ++m)
#pragma unroll
                for (int bj = 0; bj < 2; ++bj) { const size_t o = (size_t)(u.pm * 256 + ai * 128 + wr * 64 + m * 16 + fr) * INCP + u.pn * 256 + bj * 128 + wc * 32 + 8 * fq;
                    const u32x4 ga = *(const u32x4*)(PROJ + o + C_GA), gb = *(const u32x4*)(PROJ + o + C_GB);
#pragma unroll
                    for (int i = 0; i < 4; ++i) { const float r0 = bflo(ga[i]) * __builtin_amdgcn_rcpf(bflo(gb[i])), r1 = bfhi(ga[i]) * __builtin_amdgcn_rcpf(bfhi(gb[i]));
                        acc[ai][bj][m][i >> 1][2 * (i & 1)] *= r0; acc[ai][bj][m][i >> 1][2 * (i & 1) + 1] *= r1; }
                    __builtin_amdgcn_sched_barrier(0); }
    }
    __device__ __forceinline__ void operator()(const f32x4 (&acc)[2][2][4][2], const pg8::Unit& u, int wr, int wc, int fr, int fq) const {
        PG8_TILE_BEGIN(acc, wr, wc, fr, fq)
            const int row = u.pm * 256 + trow, col = u.pn * 256 + tcol;
            const u32x4 g = *(const u32x4*)(PROJ + (size_t)row * INCP + C_GB + col);
            v0[0] *= bflo(g.x); v0[1] *= bfhi(g.x); v0[2] *= bflo(g.y); v0[3] *= bfhi(g.y); v1[0] *= bflo(g.z); v1[1] *= bfhi(g.z); v1[2] *= bflo(g.w); v1[3] *= bfhi(g.w);
            *(u32x4*)(MRG + (size_t)row * DM + col) = pg8::pack8(v0, v1);
        PG8_TILE_END
    }
};
struct EpiResid {
    static constexpr int MIDK = 0;
    const bf16_t* X; bf16_t* PRE;
    __device__ __forceinline__ void operator()(const f32x4 (&acc)[2][2][4][2], const pg8::Unit& u, int wr, int wc, int fr, int fq) const {
        PG8_TILE_BEGIN(acc, wr, wc, fr, fq)
            const size_t o = (size_t)(u.pm * 256 + trow) * DM + u.pn * 256 + tcol;
            const u32x4 x = *(const u32x4*)(X + o);
            v0[0] += ALPHA * bflo(x.x); v0[1] += ALPHA * bfhi(x.x); v0[2] += ALPHA * bflo(x.y); v0[3] += ALPHA * bfhi(x.y);
            v1[0] += ALPHA * bflo(x.z); v1[1] += ALPHA * bfhi(x.z); v1[2] += ALPHA * bflo(x.w); v1[3] += ALPHA * bfhi(x.w);
            *(u32x4*)(PRE + o) = pg8::pack8(v0, v1);
        PG8_TILE_END
    }
};
__device__ __forceinline__ void ln_phase(const Frame& F, const bf16_t* PRE, const float* g, const float* bt, bf16_t* XBo) {
    int lane_ = F.lane; asm volatile("" : "+v"(lane_));
    const int gw = F.vcu * NWAVES + F.wave, NGW = F.G * NWAVES, lane = lane_;
    for (int row = gw; row < T; row += NGW) {
        const u32x2* pr = (const u32x2*)(PRE + (size_t)row * DM) + lane;
        f32x4 v[4]; float s = 0.f;
#pragma unroll
        for (int j = 0; j < 4; ++j) { const u32x2 h = pr[64 * j]; v[j] = (f32x4){bflo(h.x), bfhi(h.x), bflo(h.y), bfhi(h.y)}; s += (v[j][0] + v[j][1]) + (v[j][2] + v[j][3]); }
        const float mean = wave_sum(s) * (1.f / DM); float s2 = 0.f;
#pragma unroll
        for (int j = 0; j < 4; ++j) { v[j] = v[j] - mean; s2 += (v[j][0] * v[j][0] + v[j][1] * v[j][1]) + (v[j][2] * v[j][2] + v[j][3] * v[j][3]); }
        const float rstd = rsqrtf(wave_sum(s2) * (1.f / DM) + LN_EPS);
#pragma unroll
        for (int j = 0; j < 4; ++j) { const f32x4 gg = ((const f32x4*)g)[lane + 64 * j], bb = ((const f32x4*)bt)[lane + 64 * j];
            const f32x4 y = v[j] * rstd * gg + bb;
            u32x2 w; w.x = pk2(y[0], y[1]); w.y = pk2(y[2], y[3]); ((u32x2*)(XBo + (size_t)row * DM))[lane + 64 * j] = w; }
    }
}

struct RowGU { int off; __device__ __forceinline__ int operator()(int n) const { return 256 * (n >> 7) + off + (n & 127); } };

struct EpiF32 {
    static constexpr int MIDK = 0;
    float* O; int ld;
    __device__ __forceinline__ void operator()(const f32x4 (&acc)[2][2][4][2], const pg8::Unit& u, int wr, int wc, int fr, int fq) const {
        PG8_TILE_BEGIN(acc, wr, wc, fr, fq)
            float* o = O + (size_t)(u.pm * 256 + trow) * ld + u.pn * 256 + tcol; *(f32x4*)o = v0; *(f32x4*)(o + 4) = v1;
        PG8_TILE_END
    }
};
struct EpiBf16 {
    static constexpr int MIDK = 0;
    bf16_t* O; int ld;
    __device__ __forceinline__ void operator()(const f32x4 (&acc)[2][2][4][2], const pg8::Unit& u, int wr, int wc, int fr, int fq) const {
        PG8_TILE_BEGIN(acc, wr, wc, fr, fq)
            *(u32x4*)(O + (size_t)(u.pm * 256 + trow) * ld + u.pn * 256 + tcol) = pg8::pack8(v0, v1);
        PG8_TILE_END
    }
};
__device__ __forceinline__ float silu_mul(float g, float u) { return g * __builtin_amdgcn_rcpf(1.f + __expf(-g)) * u; }
struct EpiSwiGLU {
    static constexpr int MIDK = 0;
    bf16_t* H; int ld;
    __device__ __forceinline__ void operator()(const f32x4 (&acc)[2][2][4][2], const pg8::Unit& u, int wr, int wc, int fr, int fq) const {
#pragma unroll
        for (int ai = 0; ai < 2; ++ai)
#pragma unroll
            for (int m = 0; m < 4; ++m) { const int row = u.r0 + ai * 128 + wr * 64 + m * 16 + fr;
                if (row < u.rend) { f32x4 h0, h1;
#pragma unroll
                    for (int i = 0; i < 4; ++i) { h0[i] = silu_mul(acc[ai][0][m][0][i], acc[ai][1][m][0][i]); h1[i] = silu_mul(acc[ai][0][m][1][i], acc[ai][1][m][1][i]); }
                    *(u32x4*)(H + (size_t)row * ld + 128 * u.pn + wc * 32 + 8 * fq) = pg8::pack8(h0, h1); } }
    }
};
constexpr float Y8_SCALE = 32.f;
__device__ __forceinline__ unsigned pk4_fp8(float a, float b, float c, float d) { int w = __builtin_amdgcn_cvt_pk_fp8_f32(a, b, 0, false); w = __builtin_amdgcn_cvt_pk_fp8_f32(c, d, w, true); return (unsigned)w; }
struct EpiExpDown {
    static constexpr int MIDK = 0;
    unsigned char* Y8;
    __device__ __forceinline__ void operator()(const f32x4 (&acc)[2][2][4][2], const pg8::Unit& u, int wr, int wc, int fr, int fq) const {
#pragma unroll
        for (int ai = 0; ai < 2; ++ai)
#pragma unroll
            for (int m = 0; m < 4; ++m) { const int row = u.r0 + ai * 128 + wr * 64 + m * 16 + fr;
                if (row < u.rend) { const f32x4 a0 = acc[ai][0][m][0] * Y8_SCALE, a1 = acc[ai][0][m][1] * Y8_SCALE, b0 = acc[ai][1][m][0] * Y8_SCALE, b1 = acc[ai][1][m][1] * Y8_SCALE;
                    u32x4 w; w.x = pk4_fp8(a0[0], a0[1], a0[2], a0[3]); w.y = pk4_fp8(a1[0], a1[1], a1[2], a1[3]); w.z = pk4_fp8(b0[0], b0[1], b0[2], b0[3]); w.w = pk4_fp8(b1[0], b1[1], b1[2], b1[3]);
                    *(u32x4*)(Y8 + (size_t)row * DM + 256 * u.pn + 64 * wc + 16 * fq) = w; } }
    }
};
template <int NPN, bool GATHER>
struct ExpertOrder {
    const LAS int* off; const LAS int* toff; const int* rowa; int G, c; size_t strideE;
    __device__ __forceinline__ bool next(int i, pg8::Unit& u) const {
        const int L = i * G + c; if (L >= toff[256] * NPN) return false;
        const int tile = L / NPN; u.pn = L % NPN; int lo = 0, hi = 255;
        while (lo < hi) { const int mid = (lo + hi + 1) >> 1; if (toff[mid] <= tile) lo = mid; else hi = mid - 1; }
        u.e = lo; u.r0 = off[lo] + (tile - toff[lo]) * 256; u.rend = off[lo + 1]; u.pm = 0; return true;
    }
    __device__ __forceinline__ int a_row(const pg8::Unit& u, int r) const { const int rr = min(u.r0 + r, u.rend - 1); return GATHER ? (rowa[2 * rr] >> 3) : rr; }
    __device__ __forceinline__ const char* b_ptr(const pg8::Gemm& g, const pg8::Unit& u) const { return (const char*)g.Bt + (size_t)u.e * strideE + (size_t)u.pn * 256 * g.ldb * 2; }
};
__device__ __forceinline__ int scan256(int v, int tid, LAS int* wsum, int* total) {
    const int lane = tid & 63, w = tid >> 6;
    int x = (tid < 256) ? v : 0;
#pragma unroll
    for (int o = 1; o < 64; o <<= 1) { const int y = __shfl_up(x, o); if (lane >= o) x += y; }
    if (lane == 63 && w < 4) wsum[w] = x;
    __syncthreads();
    const int s0 = wsum[0], s1 = wsum[1], s2 = wsum[2], s3 = wsum[3];
    *total = s0 + s1 + s2 + s3;
    const int base = (w == 0) ? 0 : (w == 1) ? s0 : (w == 2) ? s0 + s1 : s0 + s1 + s2;
    __syncthreads();
    return base + x - ((tid < 256) ? v : 0);
}
__device__ __forceinline__ void expert_tables(const Frame& F, const unsigned* cnt, LAS int* off, LAS int* toff) {
    const int c = (F.tid < 256) ? (int)cnt[F.tid] : 0;
    int tot, ttot;
    const int po = scan256(c, F.tid, toff + 264, &tot), pt = scan256((c + 255) >> 8, F.tid, toff + 264, &ttot);
    if (F.tid < 256) { off[F.tid] = po; toff[F.tid] = pt; }
    if (F.tid == 0) { off[256] = tot; toff[256] = ttot; }
    __syncthreads();
}
__device__ __forceinline__ void route_phase(const Frame& F, const float* LOGITS, const float* rbias, int* TOPE, float* TOPW, int* APOS, int* HIST, LAS int* lcnt) {
    int lane_ = F.lane; asm volatile("" : "+v"(lane_));
    const int lane = lane_, TPW = T / F.G, t0 = (int)blockIdx.x * TPW;
    if (F.tid < 256) lcnt[F.tid] = 0;
    __syncthreads();
    const f32x4 rb = *(const f32x4*)(rbias + lane * 4);
    f32x4 lgn = (t0 + F.wave < t0 + TPW) ? *(const f32x4*)(LOGITS + (size_t)(t0 + F.wave) * NE + lane * 4) : (f32x4){0.f, 0.f, 0.f, 0.f};
#pragma unroll 1
    for (int t = t0 + F.wave; t < t0 + TPW; t += NWAVES) {
        const f32x4 lg = lgn;
        if (t + NWAVES < t0 + TPW) lgn = *(const f32x4*)(LOGITS + (size_t)(t + NWAVES) * NE + lane * 4);
        const float s0 = __builtin_amdgcn_rcpf(1.f + __expf(-lg[0])), s1 = __builtin_amdgcn_rcpf(1.f + __expf(-lg[1])), s2 = __builtin_amdgcn_rcpf(1.f + __expf(-lg[2])), s3 = __builtin_amdgcn_rcpf(1.f + __expf(-lg[3]));
        float c0 = s0 + rb[0], c1 = s1 + rb[1], c2 = s2 + rb[2], c3 = s3 + rb[3];
        float a = fmaxf(c0, c1), bq = fminf(c0, c1);
        { const float hi2 = fmaxf(c2, c3), lo2 = fminf(c2, c3); const float na = fmaxf(a, hi2), nb = fmaxf(fminf(a, hi2), fmaxf(bq, lo2)); a = na; bq = nb; }
#pragma unroll
        for (int o = 1; o < 8; o <<= 1) { const float oa = __shfl_xor(a, o), ob = __shfl_xor(bq, o); const float na = fmaxf(a, oa), nb = fmaxf(fminf(a, oa), fmaxf(bq, ob)); a = na; bq = nb; }
        const float gs = a + bq; const int grp = lane >> 3;
        int rank = 0;
#pragma unroll
        for (int j = 0; j < 8; ++j) { const float og = __shfl(gs, j * 8); rank += (og > gs || (og == gs && j < grp)) ? 1 : 0; }
        if (rank >= 4) { c0 = c1 = c2 = c3 = -INFINITY; }
        float wsum = 0.f, myw = 0.f; int mye = 0;
#pragma unroll
        for (int k = 0; k < TOPK; ++k) {
            float bv = c0; int bi = 0;
            if (c1 > bv) { bv = c1; bi = 1; }
            if (c2 > bv) { bv = c2; bi = 2; }
            if (c3 > bv) { bv = c3; bi = 3; }
            int be = lane * 4 + bi;
#pragma unroll
            for (int o = 1; o < 64; o <<= 1) { const float ov = __shfl_xor(bv, o); const int oe = __shfl_xor(be, o); if (ov > bv || (ov == bv && oe < be)) { bv = ov; be = oe; } }
            float sc = 0.f;
            if ((be >> 2) == lane) { const int b2 = be & 3; sc = b2 == 0 ? s0 : b2 == 1 ? s1 : b2 == 2 ? s2 : s3; if (b2 == 0) c0 = -INFINITY; else if (b2 == 1) c1 = -INFINITY; else if (b2 == 2) c2 = -INFINITY; else c3 = -INFINITY; }
            sc = __shfl(sc, be >> 2);
            wsum += sc;
            if (lane == k) { myw = sc; mye = be; }
        }
        if (lane < TOPK) { const int aidx = t * TOPK + lane; TOPE[aidx] = mye; TOPW[aidx] = myw / wsum * 2.5f; APOS[aidx] = __hip_atomic_fetch_add(lcnt + mye, 1, __ATOMIC_RELAXED, __HIP_MEMORY_SCOPE_WORKGROUP); }
    }
    __syncthreads();
    if (F.tid < 256) HIST[(size_t)blockIdx.x * 256 + F.tid] = lcnt[F.tid];
}
__device__ __forceinline__ void combine_phase(const Frame& F, const bf16_t* X1, const bf16_t* SH, const unsigned char* Y8, const int* INV, const float* TOPW, const float* g, const float* bt, float* Xo, bf16_t* XBo) {
    int lane_ = F.lane; asm volatile("" : "+v"(lane_));
    const int gw = F.vcu * NWAVES + F.wave, NGW = F.G * NWAVES, lane = lane_;
    for (int row = gw; row < T; row += NGW) {
        int ri = 0; float rw = 0.f; if (lane < TOPK) { ri = INV[row * TOPK + lane]; rw = TOPW[row * TOPK + lane] * (1.f / Y8_SCALE); }
        float v[16];
#pragma unroll
        for (int j = 0; j < 2; ++j) { const u32x4 x = ((const u32x4*)(X1 + (size_t)row * DM))[2 * lane + j], h = ((const u32x4*)(SH + (size_t)row * DM))[2 * lane + j];
#pragma unroll
            for (int i = 0; i < 4; ++i) { v[8 * j + 2 * i] = ALPHA * bflo(x[i]) + bflo(h[i]); v[8 * j + 2 * i + 1] = ALPHA * bfhi(x[i]) + bfhi(h[i]); } }
#pragma unroll
        for (int k = 0; k < TOPK; ++k) { const u32x4 h = ((const u32x4*)(Y8 + (size_t)__shfl(ri, k) * DM))[lane]; const float w = __shfl(rw, k);
#pragma unroll
            for (int i = 0; i < 4; ++i) { const f32x2 lo = __builtin_amdgcn_cvt_pk_f32_fp8((int)h[i], false), hi2 = __builtin_amdgcn_cvt_pk_f32_fp8((int)h[i], true);
                v[4 * i] = fmaf(w, lo[0], v[4 * i]); v[4 * i + 1] = fmaf(w, lo[1], v[4 * i + 1]); v[4 * i + 2] = fmaf(w, hi2[0], v[4 * i + 2]); v[4 * i + 3] = fmaf(w, hi2[1], v[4 * i + 3]); } }
        float s = 0.f;
#pragma unroll
        for (int i = 0; i < 16; ++i) s += v[i];
        const float mean = wave_sum(s) * (1.f / DM); float s2 = 0.f;
#pragma unroll
        for (int i = 0; i < 16; ++i) { v[i] -= mean; s2 += v[i] * v[i]; }
        const float rstd = rsqrtf(wave_sum(s2) * (1.f / DM) + LN_EPS);
        const int c0 = 16 * lane;
        f32x4 y[4];
#pragma unroll
        for (int q = 0; q < 4; ++q) { const f32x4 gg = *(const f32x4*)(g + c0 + 4 * q), bb = *(const f32x4*)(bt + c0 + 4 * q); y[q] = (f32x4){v[4 * q], v[4 * q + 1], v[4 * q + 2], v[4 * q + 3]} * rstd * gg + bb; }
        if (Xo) {
#pragma unroll
            for (int q = 0; q < 4; ++q) *(f32x4*)(Xo + (size_t)row * DM + c0 + 4 * q) = y[q]; }
        if (XBo) {
#pragma unroll
            for (int j = 0; j < 2; ++j) { u32x4 w; w.x = pk2(y[2 * j][0], y[2 * j][1]); w.y = pk2(y[2 * j][2], y[2 * j][3]); w.z = pk2(y[2 * j + 1][0], y[2 * j + 1][1]); w.w = pk2(y[2 * j + 1][2], y[2 * j + 1][3]); *(u32x4*)(XBo + (size_t)row * DM + c0 + 8 * j) = w; } }
    }
}

__device__ __forceinline__ int crow(int r, int hi) { return (r & 3) + 8 * (r >> 2) + 4 * hi; }
typedef short s16x4 __attribute__((ext_vector_type(4)));
__device__ __forceinline__ s16x4 vtr(const LAS unsigned char* p) { return __builtin_bit_cast(s16x4, __builtin_amdgcn_ds_read_tr16_b64_v4i16((LAS s16x4*)p)); }
__device__ __forceinline__ float xhalf_max(float v) { auto rr = __builtin_amdgcn_permlane32_swap(__float_as_uint(v), __float_as_uint(v), false, false); return fmaxf(__uint_as_float(rr[0]), __uint_as_float(rr[1])); }
__device__ __forceinline__ float xhalf_sum(float v) { auto rr = __builtin_amdgcn_permlane32_swap(__float_as_uint(v), __float_as_uint(v), false, false); return __uint_as_float(rr[0]) + __uint_as_float(rr[1]); }

template <int DQK>
__device__ __forceinline__ void attn_qk(const LAS unsigned char* kb, int kfo, const bf16x8 (&qf)[DQK / 16], f32x16& p0, f32x16& p1) {
    constexpr int ND0 = DQK / 16;
    bf16x8 ka[ND0], kc[ND0];
#pragma unroll
    for (int d0 = 0; d0 < ND0; ++d0) { ka[d0] = *(const LAS bf16x8*)(kb + kfo + d0 * 2048); kc[d0] = *(const LAS bf16x8*)(kb + kfo + d0 * 2048 + 512); }
    __builtin_amdgcn_sched_barrier(0);
#pragma unroll
    for (int r = 0; r < 16; ++r) { p0[r] = 0.f; p1[r] = 0.f; }
#pragma unroll
    for (int d0 = 0; d0 < ND0; ++d0) {
        p0 = __builtin_amdgcn_mfma_f32_32x32x16_bf16(ka[d0], qf[d0], p0, 0, 0, 0);
        p1 = __builtin_amdgcn_mfma_f32_32x32x16_bf16(kc[d0], qf[d0], p1, 0, 0, 0);
    }
}
template <bool ALIBI>
__device__ __forceinline__ void attn_sv(const LAS unsigned char* kb, int vfo, f32x16& p0, f32x16& p1, float& m, float& l, f32x16& o0, f32x16& o1, int hi, int tq, int kpos0, float slope2, bool causal) {
    s16x4 vlo[8], vhi[8];
    { const unsigned va = (unsigned)(uintptr_t)(kb + vfo);
#pragma unroll
      for (int i = 0; i < 8; ++i) {
        asm volatile("ds_read_b64_tr_b16 %0, %1 offset:%c2" : "=&v"(vlo[i]) : "v"(va), "i"((i >> 2) * 4096 + (i & 3) * 1024) : "memory");
        asm volatile("ds_read_b64_tr_b16 %0, %1 offset:%c2" : "=&v"(vhi[i]) : "v"(va), "i"((i >> 2) * 4096 + (i & 3) * 1024 + 512) : "memory"); } }
    const int krel = kpos0 + 4 * hi - tq;
    if (ALIBI) { const float bb = slope2 * (float)krel;
#pragma unroll
        for (int r = 0; r < 16; ++r) { const float c = (float)((r & 3) + 8 * (r >> 2)); p0[r] += fmaf(slope2, c, bb); p1[r] += fmaf(slope2, c + 32.f, bb); } }
    if (causal) {
#pragma unroll
        for (int r = 0; r < 16; ++r) { const int kv = krel + (r & 3) + 8 * (r >> 2); if (kv > 0) p0[r] = -INFINITY; if (kv + 32 > 0) p1[r] = -INFINITY; } }
    float rm = fmaxf(p0[0], p1[0]);
#pragma unroll
    for (int r = 1; r < 16; ++r) rm = fmaxf(rm, fmaxf(p0[r], p1[r]));
    rm = xhalf_max(rm);
    const float mn = fmaxf(m, rm), alpha = __builtin_amdgcn_exp2f(m - mn);
    m = mn;
    float ls = 0.f;
#pragma unroll
    for (int r = 0; r < 16; ++r) { p0[r] = __builtin_amdgcn_exp2f(p0[r] - mn); p1[r] = __builtin_amdgcn_exp2f(p1[r] - mn); ls += p0[r] + p1[r]; }
    l = l * alpha + ls;
#pragma unroll
    for (int r = 0; r < 16; ++r) { o0[r] *= alpha; o1[r] *= alpha; }
    const u32x4 pw0 = (u32x4){pg8::cvt_pk_bf16(p0[0], p0[1]), pg8::cvt_pk_bf16(p0[2], p0[3]), pg8::cvt_pk_bf16(p0[4], p0[5]), pg8::cvt_pk_bf16(p0[6], p0[7])};
    const u32x4 pw1 = (u32x4){pg8::cvt_pk_bf16(p0[8], p0[9]), pg8::cvt_pk_bf16(p0[10], p0[11]), pg8::cvt_pk_bf16(p0[12], p0[13]), pg8::cvt_pk_bf16(p0[14], p0[15])};
    const u32x4 pw2 = (u32x4){pg8::cvt_pk_bf16(p1[0], p1[1]), pg8::cvt_pk_bf16(p1[2], p1[3]), pg8::cvt_pk_bf16(p1[4], p1[5]), pg8::cvt_pk_bf16(p1[6], p1[7])};
    const u32x4 pw3 = (u32x4){pg8::cvt_pk_bf16(p1[8], p1[9]), pg8::cvt_pk_bf16(p1[10], p1[11]), pg8::cvt_pk_bf16(p1[12], p1[13]), pg8::cvt_pk_bf16(p1[14], p1[15])};
    asm volatile("s_waitcnt lgkmcnt(0)" ::: "memory"); __builtin_amdgcn_sched_barrier(0);
#define ATT_VF(i) (bf16x8){vlo[i][0], vlo[i][1], vlo[i][2], vlo[i][3], vhi[i][0], vhi[i][1], vhi[i][2], vhi[i][3]}
    o0 = __builtin_amdgcn_mfma_f32_32x32x16_bf16(ATT_VF(0), __builtin_bit_cast(bf16x8, pw0), o0, 0, 0, 0);
    o1 = __builtin_amdgcn_mfma_f32_32x32x16_bf16(ATT_VF(4), __builtin_bit_cast(bf16x8, pw0), o1, 0, 0, 0);
    o0 = __builtin_amdgcn_mfma_f32_32x32x16_bf16(ATT_VF(1), __builtin_bit_cast(bf16x8, pw1), o0, 0, 0, 0);
    o1 = __builtin_amdgcn_mfma_f32_32x32x16_bf16(ATT_VF(5), __builtin_bit_cast(bf16x8, pw1), o1, 0, 0, 0);
    o0 = __builtin_amdgcn_mfma_f32_32x32x16_bf16(ATT_VF(2), __builtin_bit_cast(bf16x8, pw2), o0, 0, 0, 0);
    o1 = __builtin_amdgcn_mfma_f32_32x32x16_bf16(ATT_VF(6), __builtin_bit_cast(bf16x8, pw2), o1, 0, 0, 0);
    o0 = __builtin_amdgcn_mfma_f32_32x32x16_bf16(ATT_VF(3), __builtin_bit_cast(bf16x8, pw3), o0, 0, 0, 0);
    o1 = __builtin_amdgcn_mfma_f32_32x32x16_bf16(ATT_VF(7), __builtin_bit_cast(bf16x8, pw3), o1, 0, 0, 0);
#undef ATT_VF
}
template <int DQK, bool ALIBI>
__device__ __forceinline__ void attn_tile(const LAS unsigned char* kb, int kfo, int vfo, const bf16x8 (&qf)[DQK / 16], float& m, float& l, f32x16& o0, f32x16& o1, int hi, int tq, int kpos0, float slope2, bool causal) {
    f32x16 p0, p1;
    attn_qk<DQK>(kb, kfo, qf, p0, p1);
    attn_sv<ALIBI>(kb, vfo, p0, p1, m, l, o0, o1, hi, tq, kpos0, slope2, causal);
}
#define ATT_ISSUE(t, bo) do { \
        for (int c_ = wid; c_ < NCH; c_ += 8) __builtin_amdgcn_global_load_lds((const unsigned*)(ksrc + (size_t)(t) * 64 * ldk + c_ * 8), (LAS unsigned*)(lds + (bo) + c_ * 1024), 16, 0, 0); \
        __builtin_amdgcn_global_load_lds((const unsigned*)(vsrc + (size_t)(t) * 64 * ldv), (LAS unsigned*)(lds + (bo) + KBYTES + wid * 1024), 16, 0, 0); } while (0)

template <int DQK, bool MOBA_OWN>
__device__ __forceinline__ void attn_unit(LAS unsigned char* lds, int b, int h, int qb, const bf16_t* Qp, int ldq, const bf16_t* Kp, int ldk, const bf16_t* Vp, int ldv, bf16_t* Op, int ldo, const bf16_t* PO, const f32x2* PML) {
    constexpr int NCH = DQK / 8, KBYTES = NCH * 1024, BUFB = KBYTES + 8192, ND0 = DQK / 16;
    int tid_ = threadIdx.x; asm volatile("" : "+v"(tid_));
    const int lane = tid_ & 63, r32 = lane & 31, hi = lane >> 5, wid = __builtin_amdgcn_readfirstlane(tid_ >> 6);
    const size_t rowbase = (size_t)b * SEQ; const int q0 = qb * 256, T0 = MOBA_OWN ? 4 * qb : 0, T1 = 4 * (qb + 1), tq = q0 + wid * 32 + r32;
    const bf16_t* ksrc = Kp + (rowbase + lane) * ldk + h * DQK;
    const bf16_t* vsrc = Vp + (rowbase + 16 * (wid & 3) + (lane >> 2)) * ldv + h * 64 + (wid >> 2) * 32 + (lane & 3) * 8;
    ATT_ISSUE(T0, 0); ATT_ISSUE(T0 + 1, BUFB);
    bf16x8 qf[ND0];
    { const bf16_t* qrow = Qp + (rowbase + tq) * ldq + h * DQK + hi * 8;
#pragma unroll
      for (int d0 = 0; d0 < ND0; ++d0) qf[d0] = *(const bf16x8*)(qrow + d0 * 16); }
    const float slope2 = MOBA_OWN ? exp2f(-(float)(h + 1)) * LOG2E : 0.f;
    float m = -1e30f, l = 0.f;
    f32x16 o0, o1;
#pragma unroll
    for (int r = 0; r < 16; ++r) { o0[r] = 0.f; o1[r] = 0.f; }
    const int kfo = hi * 1024 + r32 * 16;
    const int vfo = KBYTES + ((lane >> 4) & 1) * 32 + (lane & 3) * 8 + (4 * hi + ((lane & 15) >> 2)) * 64;
#define ATT_BAR() asm volatile("s_waitcnt vmcnt(0) lgkmcnt(0)\n\ts_barrier" ::: "memory")
    int b0 = 0, b1 = BUFB, b2 = 2 * BUFB;
    f32x16 pA0, pA1, pB0, pB1;
    ATT_BAR();
    attn_qk<DQK>(lds + b0, kfo, qf, pA0, pA1);
#pragma unroll 1
    for (int t = T0; t < T1; t += 2) {
        if (t + 2 < T1) ATT_ISSUE(t + 2, b2);
        attn_qk<DQK>(lds + b1, kfo, qf, pB0, pB1);
        attn_sv<MOBA_OWN>(lds + b0, vfo, pA0, pA1, m, l, o0, o1, hi, tq, 64 * t, slope2, t >= T1 - 4);
        ATT_BAR();
        { const int x = b0; b0 = b1; b1 = b2; b2 = x; }
        if (t + 3 < T1) ATT_ISSUE(t + 3, b2);
        if (t + 2 < T1) attn_qk<DQK>(lds + b1, kfo, qf, pA0, pA1);
        attn_sv<MOBA_OWN>(lds + b0, vfo, pB0, pB1, m, l, o0, o1, hi, tq, 64 * (t + 1), slope2, t + 1 >= T1 - 4);
        ATT_BAR();
        { const int x = b0; b0 = b1; b1 = b2; b2 = x; }
    }
#undef ATT_BAR
    float lt = xhalf_sum(l);
    if (MOBA_OWN) {
        const int nsel = qb < 3 ? qb : 3;
        const size_t pidx = ((rowbase + tq) * 8 + h) * 3;
        float ms[3], ws[3], M = m;
#pragma unroll
        for (int sIdx = 0; sIdx < 3; ++sIdx) { ms[sIdx] = -1e30f; ws[sIdx] = 0.f; if (sIdx < nsel) { const f32x2 ml = PML[(pidx + sIdx) * 16]; ms[sIdx] = ml[0]; ws[sIdx] = ml[1]; M = fmaxf(M, ml[0]); } }
        const float w0 = __builtin_amdgcn_exp2f(m - M);
        lt *= w0;
#pragma unroll
        for (int r = 0; r < 16; ++r) { o0[r] *= w0; o1[r] *= w0; }
#pragma unroll
        for (int sIdx = 0; sIdx < 3; ++sIdx) if (sIdx < nsel) {
            const float w = ws[sIdx] * __builtin_amdgcn_exp2f(ms[sIdx] - M); lt += w;
            const bf16_t* po = PO + (pidx + sIdx) * 64 + 4 * hi;
#pragma unroll
            for (int r4 = 0; r4 < 4; ++r4) { const u32x2 a = *(const u32x2*)(po + 8 * r4), c = *(const u32x2*)(po + 32 + 8 * r4);
                o0[4 * r4] += w * bflo(a.x); o0[4 * r4 + 1] += w * bfhi(a.x); o0[4 * r4 + 2] += w * bflo(a.y); o0[4 * r4 + 3] += w * bfhi(a.y);
                o1[4 * r4] += w * bflo(c.x); o1[4 * r4 + 1] += w * bfhi(c.x); o1[4 * r4 + 2] += w * bflo(c.y); o1[4 * r4 + 3] += w * bfhi(c.y); } }
    }
    const float inv = 1.f / lt;
    bf16_t* orow = Op + (rowbase + tq) * ldo + h * 64 + 4 * hi;
#pragma unroll
    for (int r4 = 0; r4 < 4; ++r4) {
        u32x2 w0_, w1_;
        w0_.x = pg8::cvt_pk_bf16(o0[4 * r4] * inv, o0[4 * r4 + 1] * inv); w0_.y = pg8::cvt_pk_bf16(o0[4 * r4 + 2] * inv, o0[4 * r4 + 3] * inv);
        w1_.x = pg8::cvt_pk_bf16(o1[4 * r4] * inv, o1[4 * r4 + 1] * inv); w1_.y = pg8::cvt_pk_bf16(o1[4 * r4 + 2] * inv, o1[4 * r4 + 3] * inv);
        *(u32x2*)(orow + 8 * r4) = w0_; *(u32x2*)(orow + 32 + 8 * r4) = w1_;
    }
    asm volatile("s_waitcnt lgkmcnt(0)\n\ts_barrier" ::: "memory");
}
__device__ __forceinline__ void moba_sel_unit(LAS unsigned char* lds, int b, int h, int j, int slo, int shi, const bf16_t* Qp, const bf16_t* Kp, const bf16_t* Vp, int ldk, const unsigned* SEL, bf16_t* PO, f32x2* PML) {
    constexpr int DQK = 64, NCH = 8, KBYTES = 8192, BUFB = 16384, ldv = INCP; (void)ldv;
    int tid_ = threadIdx.x; asm volatile("" : "+v"(tid_));
    const int lane = tid_ & 63, r32 = lane & 31, hi = lane >> 5, wid = __builtin_amdgcn_readfirstlane(tid_ >> 6);
    const size_t rowbase = (size_t)b * SEQ;
    const bf16_t* ksrc = Kp + (rowbase + lane) * ldk + h * DQK;
    const bf16_t* vsrc = Vp + (rowbase + 16 * (wid & 3) + (lane >> 2)) * ldk + h * 64 + (wid >> 2) * 32 + (lane & 3) * 8;
#pragma unroll
    for (int tt = 0; tt < 4; ++tt) ATT_ISSUE(4 * j + tt, tt * BUFB);
    LAS unsigned short* list = (LAS unsigned short*)(lds + 4 * BUFB);
    LAS int* cnt = (LAS int*)(lds + 4 * BUFB + 8192);
    if (tid_ == 0) *cnt = 0;
    __syncthreads();
    const int nsrc = (shi - slo) * 256;
    for (int i = tid_; i < nsrc; i += NTHR) {
        const unsigned sm = SEL[(rowbase + (size_t)slo * 256 + i) * 8 + h];
        const bool f = ((sm >> j) & 1u) != 0u;
        const unsigned long long bal = __ballot(f);
        const int rank = __builtin_amdgcn_mbcnt_hi((unsigned)(bal >> 32), __builtin_amdgcn_mbcnt_lo((unsigned)bal, 0u));
        int base = 0;
        if (lane == 0) base = __hip_atomic_fetch_add(cnt, (int)__builtin_popcountll(bal), __ATOMIC_RELAXED, __HIP_MEMORY_SCOPE_WORKGROUP);
        base = __builtin_amdgcn_readfirstlane(base);
        if (f) list[base + rank] = (unsigned short)i;
    }
    asm volatile("s_waitcnt vmcnt(0)" ::: "memory");
    __syncthreads();
    const int n = *cnt, nch = (n + 31) >> 5;
    const float slope2 = exp2f(-(float)(h + 1)) * LOG2E;
    const int kfo = hi * 1024 + r32 * 16;
    const int vfo = KBYTES + ((lane >> 4) & 1) * 32 + (lane & 3) * 8 + (4 * hi + ((lane & 15) >> 2)) * 64;
    bf16x8 qn[4]; unsigned smn = 0u; int tqn = 0; bool validn = false;
#define SEL_FETCH(ch_) do { const int e_ = (ch_) * 32 + r32; validn = e_ < n; tqn = slo * 256 + (int)list[validn ? e_ : n - 1]; \
        const bf16_t* qrow_ = Qp + (rowbase + tqn) * INCP + h * DQK + hi * 8; \
        _Pragma("unroll") for (int d0 = 0; d0 < 4; ++d0) qn[d0] = *(const bf16x8*)(qrow_ + d0 * 16); \
        smn = SEL[(rowbase + tqn) * 8 + h]; } while (0)
    if (wid < nch) SEL_FETCH(wid);
#pragma unroll 1
    for (int ch = wid; ch < nch; ch += 8) {
        const bool valid = validn; const int tq = tqn; const unsigned sm = smn;
        bf16x8 qf[4];
#pragma unroll
        for (int d0 = 0; d0 < 4; ++d0) qf[d0] = qn[d0];
        if (ch + 8 < nch) SEL_FETCH(ch + 8);
        float m = -1e30f, l = 0.f;
        f32x16 o0, o1;
#pragma unroll
        for (int r = 0; r < 16; ++r) { o0[r] = 0.f; o1[r] = 0.f; }
        { f32x16 pA0, pA1, pB0, pB1;
          attn_qk<64>(lds, kfo, qf, pA0, pA1);
          attn_qk<64>(lds + BUFB, kfo, qf, pB0, pB1);
          attn_sv<true>(lds, vfo, pA0, pA1, m, l, o0, o1, hi, tq, 256 * j, slope2, false);
          attn_qk<64>(lds + 2 * BUFB, kfo, qf, pA0, pA1);
          attn_sv<true>(lds + BUFB, vfo, pB0, pB1, m, l, o0, o1, hi, tq, 256 * j + 64, slope2, false);
          attn_qk<64>(lds + 3 * BUFB, kfo, qf, pB0, pB1);
          attn_sv<true>(lds + 2 * BUFB, vfo, pA0, pA1, m, l, o0, o1, hi, tq, 256 * j + 128, slope2, false);
          attn_sv<true>(lds + 3 * BUFB, vfo, pB0, pB1, m, l, o0, o1, hi, tq, 256 * j + 192, slope2, false); }
        const float lt = xhalf_sum(l), inv = 1.f / lt;
        if (valid) {
            const size_t pidx = ((rowbase + tq) * 8 + h) * 3 + __builtin_popcount(sm & ((1u << j) - 1u));
            if (hi == 0) PML[pidx * 16] = (f32x2){m, lt};
            bf16_t* po = PO + pidx * 64 + 4 * hi;
#pragma unroll
            for (int r4 = 0; r4 < 4; ++r4) {
                u32x2 w0_, w1_;
                w0_.x = pg8::cvt_pk_bf16(o0[4 * r4] * inv, o0[4 * r4 + 1] * inv); w0_.y = pg8::cvt_pk_bf16(o0[4 * r4 + 2] * inv, o0[4 * r4 + 3] * inv);
                w1_.x = pg8::cvt_pk_bf16(o1[4 * r4] * inv, o1[4 * r4 + 1] * inv); w1_.y = pg8::cvt_pk_bf16(o1[4 * r4 + 2] * inv, o1[4 * r4 + 3] * inv);
                *(u32x2*)(po + 8 * r4) = w0_; *(u32x2*)(po + 32 + 8 * r4) = w1_;
            }
        }
    }
#undef SEL_FETCH
    __syncthreads();
}
#undef ATT_ISSUE
__device__ __forceinline__ void mla_phase(const Frame& F, const bf16_t* QB, const bf16_t* KB, const bf16_t* VB, bf16_t* Op) {
    for (int u = 2 * F.vcu; u < 512; u += 2 * F.G) {
#pragma unroll 1
        for (int k = 0; k < 2; ++k) { const int uu = u + k, bh = uu >> 5, w = uu & 31, qb = (w & 1) ? (w >> 1) : 31 - (w >> 1);
            attn_unit<96, false>(F.lds, bh >> 3, bh & 7, qb, QB, 768, KB, 768, VB, 512, Op, 1024, nullptr, nullptr); }
    }
}
__device__ const unsigned short SEL_TAB[256][5] = {
    {0,1376,1776,65535,65535}, {1,1377,1777,65535,65535}, {2,1378,1778,65535,65535}, {3,1379,1779,65535,65535},
    {4,1380,1780,65535,65535}, {5,1381,1781,65535,65535}, {6,1382,1782,65535,65535}, {7,1383,1783,65535,65535},
    {8,1384,1784,65535,65535}, {9,1385,1785,65535,65535}, {10,1386,1786,65535,65535}, {11,1387,1787,65535,65535},
    {12,1388,1788,65535,65535}, {13,1389,1789,65535,65535}, {14,1390,1790,65535,65535}, {15,1391,1791,65535,65535},
    {16,96,1552,1808,65535}, {17,97,1553,1809,65535}, {18,98,1554,1810,65535}, {19,99,1555,1811,65535},
    {20,100,1556,1812,65535}, {21,101,1557,1813,65535}, {22,102,1558,1814,65535}, {23,103,1559,1815,65535},
    {24,104,1560,1816,65535}, {25,105,1561,1817,65535}, {26,106,1562,1818,65535}, {27,107,1563,1819,65535},
    {28,108,1564,1820,65535}, {29,109,1565,1821,65535}, {30,110,1566,1822,65535}, {31,111,1567,1823,65535},
    {32,1232,1568,1824,65535}, {33,1233,1569,1825,65535}, {34,1234,1570,1826,65535}, {35,1235,1571,1827,65535},
    {36,1236,1572,1828,65535}, {37,1237,1573,1829,65535}, {38,1238,1574,1830,65535}, {39,1239,1575,1831,65535},
    {40,1240,1576,1832,65535}, {41,1241,1577,1833,65535}, {42,1242,1578,1834,65535}, {43,1243,1579,1835,65535},
    {44,1244,1580,1836,65535}, {45,1245,1581,1837,65535}, {46,1246,1582,1838,65535}, {47,1247,1583,1839,65535},
    {48,1088,688,1584,1840}, {49,1089,689,1585,1841}, {50,1090,690,1586,1842}, {51,1091,691,1587,1843},
    {52,1092,692,1588,1844}, {53,1093,693,1589,1845}, {54,1094,694,1590,1846}, {55,1095,695,1591,1847},
    {56,1096,696,1592,1848}, {57,1097,697,1593,1849}, {58,1098,698,1594,1850}, {59,1099,699,1595,1851},
    {60,1100,700,1596,1852}, {61,1101,701,1597,1853}, {62,1102,702,1598,1854}, {63,1103,703,1599,1855},
    {512,1104,704,1600,1856}, {513,1105,705,1601,1857}, {514,1106,706,1602,1858}, {515,1107,707,1603,1859},
    {516,1108,708,1604,1860}, {517,1109,709,1605,1861}, {518,1110,710,1606,1862}, {519,1111,711,1607,1863},
    {520,1112,712,1608,1864}, {521,1113,713,1609,1865}, {522,1114,714,1610,1866}, {523,1115,715,1611,1867},
    {524,1116,716,1612,1868}, {525,1117,717,1613,1869}, {526,1118,718,1614,1870}, {527,1119,719,1615,1871},
    {528,1120,720,1616,1872}, {529,1121,721,1617,1873}, {530,1122,722,1618,1874}, {531,1123,723,1619,1875},
    {532,1124,724,1620,1876}, {533,1125,725,1621,1877}, {534,1126,726,1622,1878}, {535,1127,727,1623,1879},
    {536,1128,728,1624,1880}, {537,1129,729,1625,1881}, {538,1130,730,1626,1882}, {539,1131,731,1627,1883},
    {540,1132,732,1628,1884}, {541,1133,733,1629,1885}, {542,1134,734,1630,1886}, {543,1135,735,1631,1887},
    {544,1136,736,1632,1888}, {545,1137,737,1633,1889}, {546,1138,738,1634,1890}, {547,1139,739,1635,1891},
    {548,1140,740,1636,1892}, {549,1141,741,1637,1893}, {550,1142,742,1638,1894}, {551,1143,743,1639,1895},
    {552,1144,744,1640,1896}, {553,1145,745,1641,1897}, {554,1146,746,1642,1898}, {555,1147,747,1643,1899},
    {556,1148,748,1644,1900}, {557,1149,749,1645,1901}, {558,1150,750,1646,1902}, {559,1151,751,1647,1903},
    {560,1152,1296,1648,1904}, {561,1153,1297,1649,1905}, {562,1154,1298,1650,1906}, {563,1155,1299,1651,1907},
    {564,1156,1300,1652,1908}, {565,1157,1301,1653,1909}, {566,1158,1302,1654,1910}, {567,1159,1303,1655,1911},
    {568,1160,1304,1656,1912}, {569,1161,1305,1657,1913}, {570,1162,1306,1658,1914}, {571,1163,1307,1659,1915},
    {572,1164,1308,1660,1916}, {573,1165,1309,1661,1917}, {574,1166,1310,1662,1918}, {575,1167,1311,1663,1919},
    {576,1168,1312,1664,1920}, {577,1169,1313,1665,1921}, {578,1170,1314,1666,1922}, {579,1171,1315,1667,1923},
    {580,1172,1316,1668,1924}, {581,1173,1317,1669,1925}, {582,1174,1318,1670,1926}, {583,1175,1319,1671,1927},
    {584,1176,1320,1672,1928}, {585,1177,1321,1673,1929}, {586,1178,1322,1674,1930}, {587,1179,1323,1675,1931},
    {588,1180,1324,1676,1932}, {589,1181,1325,1677,1933}, {590,1182,1326,1678,1934}, {591,1183,1327,1679,1935},
    {592,1184,1328,1680,1936}, {593,1185,1329,1681,1937}, {594,1186,1330,1682,1938}, {595,1187,1331,1683,1939},
    {596,1188,1332,1684,1940}, {597,1189,1333,1685,1941}, {598,1190,1334,1686,1942}, {599,1191,1335,1687,1943},
    {600,1192,1336,1688,1944}, {601,1193,1337,1689,1945}, {602,1194,1338,1690,1946}, {603,1195,1339,1691,1947},
    {604,1196,1340,1692,1948}, {605,1197,1341,1693,1949}, {606,1198,1342,1694,1950}, {607,1199,1343,1695,1951},
    {608,1200,1344,1696,1952}, {609,1201,1345,1697,1953}, {610,1202,1346,1698,1954}, {611,1203,1347,1699,1955},
    {612,1204,1348,1700,1956}, {613,1205,1349,1701,1957}, {614,1206,1350,1702,1958}, {615,1207,1351,1703,1959},
    {616,1208,1352,1704,1960}, {617,1209,1353,1705,1961}, {618,1210,1354,1706,1962}, {619,1211,1355,1707,1963},
    {620,1212,1356,1708,1964}, {621,1213,1357,1709,1965}, {622,1214,1358,1710,1966}, {623,1215,1359,1711,1967},
    {624,1216,1360,1712,1968}, {625,1217,1361,1713,1969}, {626,1218,1362,1714,1970}, {627,1219,1363,1715,1971},
    {628,1220,1364,1716,1972}, {629,1221,1365,1717,1973}, {630,1222,1366,1718,1974}, {631,1223,1367,1719,1975},
    {632,1224,1368,1720,1976}, {633,1225,1369,1721,1977}, {634,1226,1370,1722,1978}, {635,1227,1371,1723,1979},
    {636,1228,1372,1724,1980}, {637,1229,1373,1725,1981}, {638,1230,1374,1726,1982}, {639,1231,1375,1727,1983},
    {64,1024,1248,1728,1984}, {65,1025,1249,1729,1985}, {66,1026,1250,1730,1986}, {67,1027,1251,1731,1987},
    {68,1028,1252,1732,1988}, {69,1029,1253,1733,1989}, {70,1030,1254,1734,1990}, {71,1031,1255,1735,1991},
    {72,1032,1256,1736,1992}, {73,1033,1257,1737,1993}, {74,1034,1258,1738,1994}, {75,1035,1259,1739,1995},
    {76,1036,1260,1740,1996}, {77,1037,1261,1741,1997}, {78,1038,1262,1742,1998}, {79,1039,1263,1743,1999},
    {640,1040,1264,1744,2000}, {641,1041,1265,1745,2001}, {642,1042,1266,1746,2002}, {643,1043,1267,1747,2003},
    {644,1044,1268,1748,2004}, {645,1045,1269,1749,2005}, {646,1046,1270,1750,2006}, {647,1047,1271,1751,2007},
    {648,1048,1272,1752,2008}, {649,1049,1273,1753,2009}, {650,1050,1274,1754,2010}, {651,1051,1275,1755,2011},
    {652,1052,1276,1756,2012}, {653,1053,1277,1757,2013}, {654,1054,1278,1758,2014}, {655,1055,1279,1759,2015},
    {656,1056,1280,1760,2016}, {657,1057,1281,1761,2017}, {658,1058,1282,1762,2018}, {659,1059,1283,1763,2019},
    {660,1060,1284,1764,2020}, {661,1061,1285,1765,2021}, {662,1062,1286,1766,2022}, {663,1063,1287,1767,2023},
    {664,1064,1288,1768,2024}, {665,1065,1289,1769,2025}, {666,1066,1290,1770,2026}, {667,1067,1291,1771,2027},
    {668,1068,1292,1772,2028}, {669,1069,1293,1773,2029}, {670,1070,1294,1774,2030}, {671,1071,1295,1775,2031},
    {672,1072,80,1536,1792}, {673,1073,81,1537,1793}, {674,1074,82,1538,1794}, {675,1075,83,1539,1795},
    {676,1076,84,1540,1796}, {677,1077,85,1541,1797}, {678,1078,86,1542,1798}, {679,1079,87,1543,1799},
    {680,1080,88,1544,1800}, {681,1081,89,1545,1801}, {682,1082,90,1546,1802}, {683,1083,91,1547,1803},
    {684,1084,92,1548,1804}, {685,1085,93,1549,1805}, {686,1086,94,1550,1806}, {687,1087,95,1551,1807},
};
constexpr int SEL_TAB_W = 5;
__device__ __forceinline__ void moba_sel_phase(const Frame& F, const bf16_t* PROJ, const unsigned* SEL, bf16_t* PO, f32x2* PML) {
    if (F.G == 256) {
#pragma unroll 1
        for (int i = 0; i < SEL_TAB_W; ++i) { const int code = SEL_TAB[F.vcu][i]; if (code == 0xFFFF) break;
            const int p = code >> 9, j = (code >> 4) & 31, bh = code & 15, slo = (j + 1 > 8 * p) ? j + 1 : 8 * p, shi = 8 * p + 8;
            moba_sel_unit(F.lds, bh >> 3, bh & 7, j, slo, shi, PROJ + C_QA, PROJ + C_KA, PROJ + C_VA, INCP, SEL, PO, PML); }
    } else {
#pragma unroll 1
        for (int u = (int)blockIdx.x; u < 16 * 76; u += F.G) {
            int p = 0; while (16 * (4 * (p + 1) * (p + 1) + 3 * (p + 1)) <= u) ++p;
            const int r = u - 16 * (4 * p * p + 3 * p), j = r >> 4, bh = r & 15, slo = (j + 1 > 8 * p) ? j + 1 : 8 * p, shi = 8 * p + 8;
            moba_sel_unit(F.lds, bh >> 3, bh & 7, j, slo, shi, PROJ + C_QA, PROJ + C_KA, PROJ + C_VA, INCP, SEL, PO, PML); }
    }
}
__device__ __forceinline__ void moba_own_phase(const Frame& F, const bf16_t* PROJ, bf16_t* Op, const bf16_t* PO, const f32x2* PML) {
#pragma unroll 1
    for (int u = F.vcu; u < 512; u += F.G) { const int bh = u >> 5, qb = u & 31;
        attn_unit<64, true>(F.lds, bh >> 3, bh & 7, qb, PROJ + C_QA, INCP, PROJ + C_KA, INCP, PROJ + C_VA, INCP, Op, 1024, PO, PML); }
}

constexpr int NPH_L = 16;
__global__ void __launch_bounds__(NTHR, 2) mk(Params p) {
    extern __shared__ __attribute__((aligned(16))) unsigned char lds_raw[];
    Frame F;
    F.lds = (LAS unsigned char*)lds_raw;
    F.tid = threadIdx.x; F.lane = F.tid & 63; F.wave = __builtin_amdgcn_readfirstlane(F.tid >> 6);
    F.G = gridDim.x; { const int bx = blockIdx.x; F.vcu = (F.G % 8 == 0) ? (bx % 8) * (F.G / 8) + bx / 8 : bx; }
    volatile LAS unsigned* MISC = (volatile LAS unsigned*)(F.lds + MISC_OFF);
    if (F.tid < 32) MISC[F.tid] = 0u;
    __syncthreads();
    unsigned char* ws = p.ws;
    unsigned* ctl = (unsigned*)(ws + WS_CTL);
    XcdBarrier bar = xcd_barrier_post(ctl + CW_BAR, MISC + 8);
    const int lo = p.ph_lo, hi = p.ph_hi;
#define IN(k) (lo <= (k) && (k) < hi)
#define SEAM(k) do { if (IN(k) && IN((k) + 1)) xcd_barrier(bar); } while (0)
    bf16_t* WinT = (bf16_t*)(ws + WS_WIN);
    bf16_t* XB = (bf16_t*)(ws + WS_XB);
    bf16_t* PROJ = (bf16_t*)(ws + WS_PROJ);
    bf16_t* WuqT = (bf16_t*)(ws + WS_WUQ); bf16_t* WukvT = (bf16_t*)(ws + WS_WUKV);
    f32x2* CS = (f32x2*)(ws + WS_CS); float* KM = (float*)(ws + WS_KM); unsigned* SEL = (unsigned*)(ws + WS_SEL);
    bf16_t* CQN = (bf16_t*)(ws + WS_CQN); bf16_t* CKVN = (bf16_t*)(ws + WS_CKVN);
    bf16_t* WpaT = (bf16_t*)(ws + WS_WPA); bf16_t* WpbT = (bf16_t*)(ws + WS_WPB); bf16_t* WoutT = (bf16_t*)(ws + WS_WOUT);
    bf16_t* TMP = (bf16_t*)(ws + WS_TMP); bf16_t* MRG = (bf16_t*)(ws + WS_MRG); bf16_t* PRE = (bf16_t*)(ws + WS_PRE); bf16_t* X1B = (bf16_t*)(ws + WS_X1B);
    bf16_t* WrtT = (bf16_t*)(ws + WS_WRT); bf16_t* WsguT = (bf16_t*)(ws + WS_WSGU); bf16_t* WsdT = (bf16_t*)(ws + WS_WSD); bf16_t* WeguT = (bf16_t*)(ws + WS_WEGU); bf16_t* WedT = (bf16_t*)(ws + WS_WED);
    float* LOGITS = (float*)(ws + WS_LOG); bf16_t* HS = (bf16_t*)(ws + WS_HS); bf16_t* SH = (bf16_t*)(ws + WS_SH);
    int* TOPE = (int*)(ws + WS_TOPE); float* TOPW = (float*)(ws + WS_TOPW); int* APOS = (int*)(ws + WS_APOS); int* ROWA = (int*)(ws + WS_ROWA);
    bf16_t* PO = (bf16_t*)(ws + WS_PO); f32x2* PML = (f32x2*)(ws + WS_PML);
    bf16_t* HE = (bf16_t*)(ws + WS_HE); bf16_t* Yb = (bf16_t*)(ws + WS_Y); int* HIST = (int*)(ws + WS_HIST);
    LAS int* t_off = (LAS int*)(F.lds + TAB_OFF); LAS int* t_toff = t_off + 260;
    bf16_t* QB = (bf16_t*)(ws + WS_QB); bf16_t* KB = (bf16_t*)(ws + WS_KB); bf16_t* VB = (bf16_t*)(ws + WS_VB); bf16_t* OAB = (bf16_t*)(ws + WS_OAB);
    const int gw = F.vcu * NWAVES + F.wave, NGW = F.G * NWAVES;

    if (IN(0)) {
        LAS float* scr = (LAS float*)(F.lds + F.wave * 16384);
        constexpr int I_IN = (DM / 64) * (INC / 32);
        for (int it = gw; it < DEPTH * I_IN; it += NGW) { const int l = it / I_IN, r = it % I_IN;
            transpose_item(p.in[1] + (size_t)l * DM * INC, DM, INC, WinT + (size_t)l * SZ_WIN, DM, RowId{}, scr, r, F.lane); }
        { constexpr int I_UQ = (QL / 64) * (768 / 32), I_UKV = (KVL / 64) * (1024 / 32);
          for (int it = gw; it < DEPTH * (I_UQ + I_UKV); it += NGW) { const int l = it / (I_UQ + I_UKV), r = it % (I_UQ + I_UKV);
            if (r < I_UQ) transpose_item(p.in[4] + (size_t)l * QL * 768, QL, 768, WuqT + (size_t)l * SZ_WUQ, QL, RowQ{}, scr, r, F.lane);
            else transpose_item(p.in[6] + (size_t)l * KVL * 1024, KVL, 1024, WukvT + (size_t)l * SZ_WUKV, KVL, RowId{}, scr, r - I_UQ, F.lane); } }
        { constexpr int I_P = (512 / 64) * (DM / 32), I_O = (DM / 64) * (DM / 32), I_ALL = 2 * I_P + I_O;
          for (int it = gw; it < DEPTH * I_ALL; it += NGW) { const int l = it / I_ALL; int r = it % I_ALL;
            if (r < I_P) { transpose_item(p.in[7] + (size_t)l * 512 * DM, 512, DM, WpaT + (size_t)l * 2 * SZ_WP, 1024, RowId{}, scr, r, F.lane); continue; } r -= I_P;
            if (r < I_P) { transpose_item(p.in[8] + (size_t)l * 512 * DM, 512, DM, WpaT + (size_t)l * 2 * SZ_WP + 512, 1024, RowId{}, scr, r, F.lane); continue; } r -= I_P;
            transpose_item(p.in[9] + (size_t)l * DM * DM, DM, DM, WoutT + (size_t)l * SZ_WOUT, DM, RowId{}, scr, r, F.lane); } }
        { constexpr int I_R = (DM / 64) * (NE / 32), I_G = (DM / 64) * (DSH / 32), I_D = (DSH / 64) * (DM / 32), I_ALL = I_R + 2 * I_G + I_D;
          for (int it = gw; it < DEPTH * I_ALL; it += NGW) { const int l = it / I_ALL; int r = it % I_ALL;
            if (r < I_R) { transpose_item(p.in[12] + (size_t)l * DM * NE, DM, NE, WrtT + (size_t)l * SZ_WRT, DM, RowId{}, scr, r, F.lane); continue; } r -= I_R;
            if (r < I_G) { transpose_item(p.in[17] + (size_t)l * DM * DSH, DM, DSH, WsguT + (size_t)l * SZ_WSGU, DM, RowGU{0}, scr, r, F.lane); continue; } r -= I_G;
            if (r < I_G) { transpose_item(p.in[18] + (size_t)l * DM * DSH, DM, DSH, WsguT + (size_t)l * SZ_WSGU, DM, RowGU{128}, scr, r, F.lane); continue; } r -= I_G;
            transpose_item(p.in[19] + (size_t)l * DSH * DM, DSH, DM, WsdT + (size_t)l * SZ_WSD, DSH, RowId{}, scr, r, F.lane); } }
        { constexpr int I_G = (DM / 64) * (DE / 64), I_D = (DE / 64) * (DM / 64), I_E = 2 * I_G + I_D;
          LAS unsigned short* scr16 = (LAS unsigned short*)(F.lds + F.wave * 16384);
          for (int it = gw; it < DEPTH * NE * I_E; it += NGW) { const int le = it / I_E; int r = it % I_E;
            if (r < I_G) { transpose_item64(p.in[14] + (size_t)le * DM * DE, DM, DE, WeguT + (size_t)le * 512 * DM, DM, RowGU{0}, scr16, r, F.lane); continue; } r -= I_G;
            if (r < I_G) { transpose_item64(p.in[15] + (size_t)le * DM * DE, DM, DE, WeguT + (size_t)le * 512 * DM, DM, RowGU{128}, scr16, r, F.lane); continue; } r -= I_G;
            transpose_item64(p.in[16] + (size_t)le * DE * DM, DE, DM, WedT + (size_t)le * DM * DE, DE, RowPermD{}, scr16, r, F.lane); } }
        for (int i = blockIdx.x * NTHR + F.tid; i < SEQ * 16; i += F.G * NTHR) { const int pos = i >> 4, k = i & 15;
            const float inv = powf(10000.f, -(float)(2 * k) / 32.f), ang = (float)pos * inv; CS[i] = (f32x2){cosf(ang), sinf(ang)}; }
        for (int i = blockIdx.x * NTHR + F.tid; i < DEPTH * 12288; i += F.G * NTHR) { const int l = i / 12288, r = i % 12288;
            *(u32x4*)(WinT + (size_t)l * SZ_WIN + (size_t)INC * DM + (size_t)r * 8) = (u32x4){0u, 0u, 0u, 0u}; }
        for (int i = blockIdx.x * NTHR + F.tid; i < T * DM / 8; i += F.G * NTHR) { const f32x4 a = *(const f32x4*)(p.in[0] + (size_t)i * 8), b = *(const f32x4*)(p.in[0] + (size_t)i * 8 + 4);
            u32x4 w; w.x = pk2(a[0], a[1]); w.y = pk2(a[2], a[3]); w.z = pk2(b[0], b[1]); w.w = pk2(b[2], b[3]); *(u32x4*)(XB + (size_t)i * 8) = w; }
    }
    SEAM(0);

    {
        const int l = 0; const int pb = 1 + l * NPH_L;
        if (IN(pb + 0)) {
            pg8::Gemm g{XB, WinT + (size_t)l * SZ_WIN, T, INCP, DM, DM, DM}; pg8::StaticOrder S; S.init(T, INCP - 256, F.G, (int)blockIdx.x);
            EpiProj E{PROJ, p.in[2] + (size_t)l * 2 * DM};
            pg8::gemm_phase<EpiProj, pg8::StaticOrder, true>(F.lds, g, S, E);
        }
        SEAM(pb + 0);
        if (IN(pb + 1)) prep_phase(F, PROJ, p.in[3] + (size_t)l * QL, p.in[5] + (size_t)l * KVL, CS, CQN, CKVN, KB, KM);
        SEAM(pb + 1);
        if (IN(pb + 2)) {
            mobasel_phase(F, PROJ, KM, SEL);
            { pg8::Gemm g{CKVN, WukvT + (size_t)l * SZ_WUKV, T, 1024, KVL, KVL, KVL}; pg8::StaticOrder S; S.init(T, 1024, F.G, (int)blockIdx.x);
              EpiKV E{KB, VB}; pg8::gemm_phase<EpiKV, pg8::StaticOrder, true>(F.lds, g, S, E); }
            { pg8::Gemm g{CQN, WuqT + (size_t)l * SZ_WUQ, T, 768, QL, QL, QL}; pg8::StaticOrder S; S.init(T, 768, F.G, (int)blockIdx.x);
              EpiQ E{QB, CS}; pg8::gemm_phase<EpiQ, pg8::StaticOrder, true>(F.lds, g, S, E); }
            { pg8::Gemm g{XB, WinT + (size_t)l * SZ_WIN, T, INCP, DM, DM, DM}; pg8::OffsetOrder S; S.init(T, 256, F.G, (int)((blockIdx.x + 64) % F.G)); S.pn0 = 16;
              EpiProj E{PROJ, p.in[2] + (size_t)l * 2 * DM}; pg8::gemm_phase<EpiProj, pg8::OffsetOrder, true>(F.lds, g, S, E); }
        }
        SEAM(pb + 2);
        if (IN(pb + 3)) {
            mla_phase(F, QB, KB, VB, OAB + 512);
            moba_sel_phase(F, PROJ, SEL, PO, PML);
        }
        SEAM(pb + 3);
        if (IN(pb + 4)) moba_own_phase(F, PROJ, OAB, PO, PML);
        SEAM(pb + 4);
        if (IN(pb + 5)) {
            pg8::Gemm g{OAB, WpaT + (size_t)l * 2 * SZ_WP, T, DM, DM, 1024, 1024}; pg8::StaticOrder S; S.init(T, DM, F.G, (int)blockIdx.x);
            EpiGate2 E{PROJ, MRG}; pg8::gemm_phase<EpiGate2, pg8::StaticOrder, true>(F.lds, g, S, E);
        }
        SEAM(pb + 5);
        if (IN(pb + 6)) {
            pg8::Gemm g{MRG, WoutT + (size_t)l * SZ_WOUT, T, DM, DM, DM, DM}; pg8::StaticOrder S; S.init(T, DM, F.G, (int)blockIdx.x);
            EpiResid E{XB, PRE}; pg8::gemm_phase<EpiResid, pg8::StaticOrder, true>(F.lds, g, S, E);
        }
        SEAM(pb + 6);
        if (IN(pb + 7)) ln_phase(F, PRE, p.in[10] + (size_t)l * DM, p.in[11] + (size_t)l * DM, X1B);
        SEAM(pb + 7);
        if (IN(pb + 8)) {
            { pg8::Gemm g{X1B, WrtT + (size_t)l * SZ_WRT, T, NE, DM, DM, DM}; pg8::StaticOrder S; S.init(T, NE, F.G, (int)blockIdx.x);
              EpiF32 E{LOGITS, NE}; pg8::gemm_phase<EpiF32, pg8::StaticOrder, true>(F.lds, g, S, E); }
            { pg8::Gemm g{X1B, WsguT + (size_t)l * SZ_WSGU, T, 512, DM, DM, DM}; pg8::StaticOrder S; S.init(T, 512, F.G, (int)((blockIdx.x + F.G / 2) % F.G));
              EpiSwiGLU E{HS, DSH}; pg8::gemm_phase<EpiSwiGLU, pg8::StaticOrder, true>(F.lds, g, S, E); }
        }
        SEAM(pb + 8);
        if (IN(pb + 9)) {
            route_phase(F, LOGITS, p.in[13] + (size_t)l * NE, TOPE, TOPW, APOS, HIST, t_off);
            pg8::Gemm g{HS, WsdT + (size_t)l * SZ_WSD, T, DM, DSH, DSH, DSH}; pg8::StaticOrder S; S.init(T, DM, F.G, (int)blockIdx.x);
            EpiBf16 E{SH, DM}; pg8::gemm_phase<EpiBf16, pg8::StaticOrder, true>(F.lds, g, S, E);
        }
        SEAM(pb + 9);
        if (IN(pb + 10)) {
            int tid_ = F.tid; asm volatile("" : "+v"(tid_));
            if (tid_ < 256) { int tot = 0, base = 0; for (int c = 0; c < F.G; ++c) { const int v = HIST[(size_t)c * 256 + tid_]; base += (c < (int)blockIdx.x) ? v : 0; tot += v; }
                t_off[tid_] = tot; t_toff[tid_] = base; if (blockIdx.x == 0) ctl[CW_CNT + l * 256 + tid_] = (unsigned)tot; }
            __syncthreads();
            { int tot_; const int c_ = (tid_ < 256) ? t_off[tid_] : 0; const int po_ = scan256(c_, tid_, t_toff + 264, &tot_); if (tid_ < 256) t_off[tid_] = po_; }
            __syncthreads();
            const int TPW = T / F.G, a0 = (int)blockIdx.x * TPW * TOPK;
            for (int a = a0 + tid_; a < a0 + TPW * TOPK; a += NTHR) { const int e = TOPE[a]; const int row = t_off[e] + t_toff[e] + APOS[a]; *(u32x2*)(ROWA + 2 * (size_t)row) = (u32x2){(unsigned)a, 0u}; APOS[a] = row; }
            __syncthreads();
        }
        SEAM(pb + 10);
        if (IN(pb + 11)) {
            expert_tables(F, ctl + CW_CNT + l * 256, t_off, t_toff);
            pg8::Gemm g{X1B, WeguT + (size_t)l * SZ_WEGU, T, 512, DM, DM, DM};
            ExpertOrder<2, true> S{t_off, t_toff, ROWA, F.G, F.vcu, (size_t)512 * DM * 2};
            EpiSwiGLU E{HE, DE}; pg8::gemm_phase<EpiSwiGLU, ExpertOrder<2, true>, true>(F.lds, g, S, E);
        }
        SEAM(pb + 11);
        if (IN(pb + 12)) {
            expert_tables(F, ctl + CW_CNT + l * 256, t_off, t_toff);
            pg8::Gemm g{HE, WedT + (size_t)l * SZ_WED, NA, DM, DE, DE, DE};
            ExpertOrder<4, false> S{t_off, t_toff, ROWA, F.G, F.vcu, (size_t)DM * DE * 2};
            EpiExpDown E{(unsigned char*)Yb}; pg8::gemm_phase<EpiExpDown, ExpertOrder<4, false>, true>(F.lds, g, S, E);
        }
        SEAM(pb + 12);
        if (IN(pb + 13)) combine_phase(F, X1B, SH, (const unsigned char*)Yb, APOS, TOPW, p.in[20] + (size_t)l * DM, p.in[21] + (size_t)l * DM, l == DEPTH - 1 ? p.out : (float*)nullptr, l == DEPTH - 1 ? (bf16_t*)nullptr : XB);
        SEAM(pb + 13);
    }

    {
        const int l = 1; const int pb = 1 + l * NPH_L;
        if (IN(pb + 0)) {
            pg8::Gemm g{XB, WinT + (size_t)l * SZ_WIN, T, INCP, DM, DM, DM}; pg8::StaticOrder S; S.init(T, INCP - 256, F.G, (int)blockIdx.x);
            EpiProj E{PROJ, p.in[2] + (size_t)l * 2 * DM};
            pg8::gemm_phase<EpiProj, pg8::StaticOrder, true>(F.lds, g, S, E);
        }
        SEAM(pb + 0);
        if (IN(pb + 1)) prep_phase(F, PROJ, p.in[3] + (size_t)l * QL, p.in[5] + (size_t)l * KVL, CS, CQN, CKVN, KB, KM);
        SEAM(pb + 1);
        if (IN(pb + 2)) {
            mobasel_phase(F, PROJ, KM, SEL);
            { pg8::Gemm g{CKVN, WukvT + (size_t)l * SZ_WUKV, T, 1024, KVL, KVL, KVL}; pg8::StaticOrder S; S.init(T, 1024, F.G, (int)blockIdx.x);
              EpiKV E{KB, VB}; pg8::gemm_phase<EpiKV, pg8::StaticOrder, true>(F.lds, g, S, E); }
            { pg8::Gemm g{CQN, WuqT + (size_t)l * SZ_WUQ, T, 768, QL, QL, QL}; pg8::StaticOrder S; S.init(T, 768, F.G, (int)blockIdx.x);
              EpiQ E{QB, CS}; pg8::gemm_phase<EpiQ, pg8::StaticOrder, true>(F.lds, g, S, E); }
            { pg8::Gemm g{XB, WinT + (size_t)l * SZ_WIN, T, INCP, DM, DM, DM}; pg8::OffsetOrder S; S.init(T, 256, F.G, (int)((blockIdx.x + 64) % F.G)); S.pn0 = 16;
              EpiProj E{PROJ, p.in[2] + (size_t)l * 2 * DM}; pg8::gemm_phase<EpiProj, pg8::OffsetOrder, true>(F.lds, g, S, E); }
        }
        SEAM(pb + 2);
        if (IN(pb + 3)) {
            mla_phase(F, QB, KB, VB, OAB + 512);
            moba_sel_phase(F, PROJ, SEL, PO, PML);
        }
        SEAM(pb + 3);
        if (IN(pb + 4)) moba_own_phase(F, PROJ, OAB, PO, PML);
        SEAM(pb + 4);
        if (IN(pb + 5)) {
            pg8::Gemm g{OAB, WpaT + (size_t)l * 2 * SZ_WP, T, DM, DM, 1024, 1024}; pg8::StaticOrder S; S.init(T, DM, F.G, (int)blockIdx.x);
            EpiGate2 E{PROJ, MRG}; pg8::gemm_phase<EpiGate2, pg8::StaticOrder, true>(F.lds, g, S, E);
        }
        SEAM(pb + 5);
        if (IN(pb + 6)) {
            pg8::Gemm g{MRG, WoutT + (size_t)l * SZ_WOUT, T, DM, DM, DM, DM}; pg8::StaticOrder S; S.init(T, DM, F.G, (int)blockIdx.x);
            EpiResid E{XB, PRE}; pg8::gemm_phase<EpiResid, pg8::StaticOrder, true>(F.lds, g, S, E);
        }
        SEAM(pb + 6);
        if (IN(pb + 7)) ln_phase(F, PRE, p.in[10] + (size_t)l * DM, p.in[11] + (size_t)l * DM, X1B);
        SEAM(pb + 7);
        if (IN(pb + 8)) {
            { pg8::Gemm g{X1B, WrtT + (size_t)l * SZ_WRT, T, NE, DM, DM, DM}; pg8::StaticOrder S; S.init(T, NE, F.G, (int)blockIdx.x);
              EpiF32 E{LOGITS, NE}; pg8::gemm_phase<EpiF32, pg8::StaticOrder, true>(F.lds, g, S, E); }
            { pg8::Gemm g{X1B, WsguT + (size_t)l * SZ_WSGU, T, 512, DM, DM, DM}; pg8::StaticOrder S; S.init(T, 512, F.G, (int)((blockIdx.x + F.G / 2) % F.G));
              EpiSwiGLU E{HS, DSH}; pg8::gemm_phase<EpiSwiGLU, pg8::StaticOrder, true>(F.lds, g, S, E); }
        }
        SEAM(pb + 8);
        if (IN(pb + 9)) {
            route_phase(F, LOGITS, p.in[13] + (size_t)l * NE, TOPE, TOPW, APOS, HIST, t_off);
            pg8::Gemm g{HS, WsdT + (size_t)l * SZ_WSD, T, DM, DSH, DSH, DSH}; pg8::StaticOrder S; S.init(T, DM, F.G, (int)blockIdx.x);
            EpiBf16 E{SH, DM}; pg8::gemm_phase<EpiBf16, pg8::StaticOrder, true>(F.lds, g, S, E);
        }
        SEAM(pb + 9);
        if (IN(pb + 10)) {
            int tid_ = F.tid; asm volatile("" : "+v"(tid_));
            if (tid_ < 256) { int tot = 0, base = 0; for (int c = 0; c < F.G; ++c) { const int v = HIST[(size_t)c * 256 + tid_]; base += (c < (int)blockIdx.x) ? v : 0; tot += v; }
                t_off[tid_] = tot; t_toff[tid_] = base; if (blockIdx.x == 0) ctl[CW_CNT + l * 256 + tid_] = (unsigned)tot; }
            __syncthreads();
            { int tot_; const int c_ = (tid_ < 256) ? t_off[tid_] : 0; const int po_ = scan256(c_, tid_, t_toff + 264, &tot_); if (tid_ < 256) t_off[tid_] = po_; }
            __syncthreads();
            const int TPW = T / F.G, a0 = (int)blockIdx.x * TPW * TOPK;
            for (int a = a0 + tid_; a < a0 + TPW * TOPK; a += NTHR) { const int e = TOPE[a]; const int row = t_off[e] + t_toff[e] + APOS[a]; *(u32x2*)(ROWA + 2 * (size_t)row) = (u32x2){(unsigned)a, 0u}; APOS[a] = row; }
            __syncthreads();
        }
        SEAM(pb + 10);
        if (IN(pb + 11)) {
            expert_tables(F, ctl + CW_CNT + l * 256, t_off, t_toff);
            pg8::Gemm g{X1B, WeguT + (size_t)l * SZ_WEGU, T, 512, DM, DM, DM};
            ExpertOrder<2, true> S{t_off, t_toff, ROWA, F.G, F.vcu, (size_t)512 * DM * 2};
            EpiSwiGLU E{HE, DE}; pg8::gemm_phase<EpiSwiGLU, ExpertOrder<2, true>, true>(F.lds, g, S, E);
        }
        SEAM(pb + 11);
        if (IN(pb + 12)) {
            expert_tables(F, ctl + CW_CNT + l * 256, t_off, t_toff);
            pg8::Gemm g{HE, WedT + (size_t)l * SZ_WED, NA, DM, DE, DE, DE};
            ExpertOrder<4, false> S{t_off, t_toff, ROWA, F.G, F.vcu, (size_t)DM * DE * 2};
            EpiExpDown E{(unsigned char*)Yb}; pg8::gemm_phase<EpiExpDown, ExpertOrder<4, false>, true>(F.lds, g, S, E);
        }
        SEAM(pb + 12);
        if (IN(pb + 13)) combine_phase(F, X1B, SH, (const unsigned char*)Yb, APOS, TOPW, p.in[20] + (size_t)l * DM, p.in[21] + (size_t)l * DM, l == DEPTH - 1 ? p.out : (float*)nullptr, l == DEPTH - 1 ? (bf16_t*)nullptr : XB);
        SEAM(pb + 13);
    }

#undef IN
#undef SEAM
}

__global__ void __launch_bounds__(256) cvt_proj(const bf16_t* __restrict__ P, float* proj) {
    const size_t i = (size_t)blockIdx.x * 256 + threadIdx.x;
    const int row = (int)(i / INC), c = (int)(i % INC);
    float v = bf2f(P[(size_t)row * INCP + c]);
    if (c < C_KA) v *= (1.f / QS_A);
    proj[i] = v;
}
__global__ void __launch_bounds__(256) cvt_oab(const bf16_t* __restrict__ OAB, float* oa, float* ob) {
    const size_t i = (size_t)blockIdx.x * 256 + threadIdx.x; const size_t row = i >> 10; const int c = (int)(i & 1023);
    const float v = bf2f(OAB[i]);
    if (c < 512) oa[row * 512 + c] = v; else ob[row * 512 + c - 512] = v;
}
__global__ void __launch_bounds__(256) cvt_x(const float* __restrict__ x, bf16_t* XB) {
    const size_t i = (size_t)blockIdx.x * 256 + threadIdx.x;
    const f32x4 a = *(const f32x4*)(x + i * 8), b = *(const f32x4*)(x + i * 8 + 4);
    u32x4 w; w.x = pk2(a[0], a[1]); w.y = pk2(a[2], a[3]); w.z = pk2(b[0], b[1]); w.w = pk2(b[2], b[3]); *(u32x4*)(XB + i * 8) = w;
}
}
static int g_grid = 0;
static bool fast_setup() {
    if (g_grid) return g_grid > 0;
    int dev = 0, cus = 0, per_cu = 0;
    if (hipGetDevice(&dev) != hipSuccess || hipDeviceGetAttribute(&cus, hipDeviceAttributeMultiprocessorCount, dev) != hipSuccess) { g_grid = -1; return false; }
    if (hipFuncSetAttribute((const void*)fk::mk, hipFuncAttributeMaxDynamicSharedMemorySize, fk::LDS_BYTES) != hipSuccess) { fprintf(stderr, "hipFuncSetAttribute failed\n"); g_grid = -1; return false; }
    if (hipOccupancyMaxActiveBlocksPerMultiprocessor(&per_cu, (const void*)fk::mk, fk::NTHR, fk::LDS_BYTES) != hipSuccess || per_cu < 1) { fprintf(stderr, "occupancy query: %d\n", per_cu); }
    (void)hipGetLastError();
    g_grid = cus;
    if (cus > 1024 || T % cus != 0 || (T / cus) > 64) { fprintf(stderr, "unsupported CU count %d\n", cus); g_grid = -1; return false; }
    return true;
}
static void launch_mk(fk::Params& p, int lo, int hi, hipStream_t stream) {
    p.ph_lo = lo; p.ph_hi = hi;
    hipLaunchKernelGGL(fk::mk, dim3(g_grid), dim3(fk::NTHR), fk::LDS_BYTES, stream, p);
}

extern "C" void kernel_launch(void* const* d_in, const int* in_sizes, int n_in, void* d_out, int out_size, void* d_ws, size_t ws_size, hipStream_t stream) {
    if (!fast_setup()) return;
    if (ws_size < fk::WS_NEED) { fprintf(stderr, "workspace too small: need %zu have %zu\n", (size_t)fk::WS_NEED, ws_size); return; }
    (void)hipMemsetAsync((char*)d_ws + fk::WS_CTL, 0, fk::CTL_BYTES, stream);
    fk::Params P{};
    for (int i = 0; i < 22; ++i) P.in[i] = (const float*)d_in[i];
    P.out = (float*)d_out; P.ws = (unsigned char*)d_ws;
#if MK_ONE_LAUNCH
    launch_mk(P, 0, 1 + DEPTH * fk::NPH_L, stream);
#else
    launch_mk(P, 0, 1, stream);
    for (int l = 0; l < DEPTH; ++l) for (int k = 0; k < 14; ++k) launch_mk(P, 1 + l * fk::NPH_L + k, 2 + l * fk::NPH_L + k, stream);
#endif
}
```
